# Optimizing an MI355X kernel written in HIP

```python
import math
import jax, jax.numpy as jnp
from jax import lax
import numpy as np

D_MODEL = 1024
BATCH = 8
SEQ = 2048
DEPTH = 2

HEAD_DIM = 64
N_HEADS_A = 8
N_HEADS_B = 8
N_KV_HEADS_B = 2
DILATED_BRANCHES = ((128, 1), (512, 4), (2048, 16))
WINDOW_B = 128
REL_BUCKETS = 32
REL_MAX_DIST = 1024
N_REL_HEADS = N_HEADS_A + N_HEADS_B
D_ATTN_IN = (3 * N_HEADS_A + N_HEADS_B + 2 * N_KV_HEADS_B) * HEAD_DIM
D_ATTN_OUT = (N_HEADS_A + N_HEADS_B) * HEAD_DIM
RWKV_HEAD = 64
RWKV_HEADS = D_MODEL // RWKV_HEAD
DECAY_LORA = 64
AAA_LORA = 64
GATE_LORA = 128
D_FF = 4 * D_MODEL
N_ATTN_LAYERS = (DEPTH + 1) // 2
N_RWKV_LAYERS = DEPTH // 2
NORM_EPS = 1e-6
GN_EPS = 64e-5
NEG_INF = -1e30

kernel_name = 'hybrid_dilated_swa_rwkv7_encoder'

F32 = jnp.float32


def rms_norm(x, g):
    x32 = x.astype(F32)
    y = x32 * lax.rsqrt(jnp.mean(x32 * x32, axis=-1, keepdims=True) + NORM_EPS)
    return (y * g.astype(F32)).astype(x.dtype)


def t5_bucket(rel):
    nb = REL_BUCKETS // 2
    max_exact = nb // 2
    bucket = jnp.where(rel > 0, nb, 0)
    n = jnp.abs(rel)
    nf = jnp.maximum(n, 1).astype(F32)
    large = max_exact + (jnp.log(nf / max_exact) / math.log(REL_MAX_DIST / max_exact)
                         * (nb - max_exact)).astype(jnp.int32)
    large = jnp.minimum(large, nb - 1)
    return bucket + jnp.where(n < max_exact, n, large)


def band_rel_bias(table_h, block, dilation):
    i = jnp.arange(block)[:, None]
    j = jnp.arange(3 * block)[None, :]
    bucket = t5_bucket((j - block - i) * dilation)
    return jnp.transpose(table_h[bucket], (2, 0, 1))


def banded_attention(q, k, v, bias, radius, block, sink=None):
    nB, H, G, L, hd = q.shape
    nb = -(-L // block)
    pad = nb * block - L
    qb = jnp.pad(q, [(0, 0)] * 3 + [(0, pad), (0, 0)]).reshape(nB, H, G, nb, block, hd)

    def windows(t):
        tb = jnp.pad(t, [(0, 0)] * 3 + [(block, block + pad), (0, 0)]).reshape(nB, H, G, nb + 2, block, hd)
        return jnp.concatenate([tb[:, :, :, :-2], tb[:, :, :, 1:-1], tb[:, :, :, 2:]], axis=-2)

    kb, vb = windows(k), windows(v)
    valid = jnp.pad(jnp.ones((L,), bool), (block, block + pad)).reshape(nb + 2, block)
    valid = jnp.concatenate([valid[:-2], valid[1:-1], valid[2:]], axis=-1)
    rel = jnp.arange(3 * block)[None, :] - block - jnp.arange(block)[:, None]
    mask = (jnp.abs(rel) <= radius)[None] & valid[:, None, :]
    s = jnp.einsum('bhgnqd,bhgnkd->bhgnqk', qb, kb).astype(F32) * (hd ** -0.5)
    s = s + bias.astype(F32)[None, :, None, None]
    s = jnp.where(mask, s, NEG_INF)
    m = jnp.max(s, axis=-1)
    if sink is not None:
        sink_b = sink.astype(F32)[None, :, None, None, None]
        m = jnp.maximum(m, sink_b)
    p = jnp.exp(s - m[..., None])
    denom = jnp.sum(p, axis=-1)
    if sink is not None:
        denom = denom + jnp.exp(sink_b - m)
    o = jnp.einsum('bhgnqk,bhgnkd->bhgnqd', p, vb.astype(F32)) / denom[..., None]
    lse = m + jnp.log(denom)
    o = o.reshape(nB, H, G, nb * block, hd)[..., :L, :]
    lse = lse.reshape(nB, H, G, nb * block)[..., :L]
    return o, lse


def dilated_attention(q, k, v, table_a):
    nB, H, S, hd = q.shape
    outs, lses = [], []
    for window, dil in DILATED_BRANCHES:
        radius = window // 2 // dil

        def split(t):
            return t.reshape(nB, H, S // dil, dil, hd).transpose(0, 1, 3, 2, 4)

        bias = band_rel_bias(table_a, radius, dil)
        o, lse = banded_attention(split(q), split(k), split(v), bias, radius, radius)
        outs.append(o.transpose(0, 1, 3, 2, 4).reshape(nB, H, S, hd))
        lses.append(lse.transpose(0, 1, 3, 2).reshape(nB, H, S))
    wts = jax.nn.softmax(jnp.stack(lses), axis=0)
    return jnp.einsum('rbhs,rbhsd->bhsd', wts, jnp.stack(outs))


def window_gqa(q, k, v, sink, table_b):
    rep = N_HEADS_B // N_KV_HEADS_B
    k = jnp.repeat(k, rep, axis=1)
    v = jnp.repeat(v, rep, axis=1)
    bias = band_rel_bias(table_b, WINDOW_B, 1)
    o, _ = banded_attention(q[:, :, None], k[:, :, None], v[:, :, None], bias, WINDOW_B, WINDOW_B, sink)
    return o[:, :, 0]


def attention_mixer(h, w_in, sink, w_out, rel_table):
    nB, S, _ = h.shape
    proj = h @ w_in
    sizes = [N_HEADS_A * HEAD_DIM] * 3 + [N_HEADS_B * HEAD_DIM, N_KV_HEADS_B * HEAD_DIM, N_KV_HEADS_B * HEAD_DIM]
    cuts = [int(c) for c in np.cumsum(sizes)[:-1]]
    qa, ka, va, qb, kb, vb = jnp.split(proj, cuts, axis=-1)

    def heads(t):
        return t.reshape(nB, S, -1, HEAD_DIM).transpose(0, 2, 1, 3)

    oa = dilated_attention(heads(qa), heads(ka), heads(va), rel_table[:, :N_HEADS_A])
    ob = window_gqa(heads(qb), heads(kb), heads(vb), sink, rel_table[:, N_HEADS_A:])
    o = jnp.concatenate([oa, ob], axis=1).astype(h.dtype)
    o = o.transpose(0, 2, 1, 3).reshape(nB, S, D_ATTN_OUT)
    return o @ w_out


def rwkv7_scan(r, w, k, v, kk, a):
    def step(state, inp):
        r_t, w_t, k_t, v_t, kk_t, a_t = inp
        sa = jnp.einsum('bhvk,bhk->bhv', state, -kk_t)
        state = (state * w_t[:, :, None, :] + sa[..., None] * (kk_t * a_t)[:, :, None, :]
                 + v_t[..., None] * k_t[:, :, None, :])
        return state, jnp.einsum('bhvk,bhk->bhv', state, r_t)

    nB, S, H, N = r.shape
    xs = tuple(jnp.moveaxis(t, 1, 0) for t in (r, w, k, v, kk, a))
    _, out = lax.scan(step, jnp.zeros((nB, H, N, N), F32), xs)
    return jnp.moveaxis(out, 0, 1)


def group_norm(o, gn_w, gn_b):
    mu = jnp.mean(o, axis=-1, keepdims=True)
    var = jnp.mean(jnp.square(o - mu), axis=-1, keepdims=True)
    y = (o - mu) * lax.rsqrt(var + GN_EPS)
    nB, S, H, N = o.shape
    return y.reshape(nB, S, H * N) * gn_w.astype(F32) + gn_b.astype(F32)


def rwkv7_mixer(h, mu_prev, mu_next, w_r, w_k, w_v, w_o, k_k, k_a, r_k, gn_w, gn_b,
                w0, w1, w2, a0, a1, a2, g1, g2):
    nB, S, D = h.shape
    H, N = RWKV_HEADS, RWKV_HEAD
    dx_p = jnp.pad(h, ((0, 0), (1, 0), (0, 0)))[:, :-1] - h
    dx_n = jnp.pad(h, ((0, 0), (0, 1), (0, 0)))[:, 1:] - h

    def mix(c):
        return h + dx_p * mu_prev[c] + dx_n * mu_next[c]

    def heads(t):
        return t.astype(F32).reshape(nB, S, H, N)

    xw, xa, xg = mix(1), mix(4), mix(5)
    r = mix(0) @ w_r
    k = mix(2) @ w_k
    v = mix(3) @ w_v
    kk = heads(k * k_k)
    kk = kk / jnp.maximum(jnp.sqrt(jnp.sum(kk * kk, axis=-1, keepdims=True)), 1e-12)
    rh, vh = heads(r), heads(v)
    dir_out = []
    for d in range(2):
        w_log = -jax.nn.softplus(-(w0[d] + jnp.tanh(xw @ w1[d]) @ w2[d])) - 0.5
        decay = jnp.exp(-jnp.exp(w_log.astype(F32)))
        a = jax.nn.sigmoid(a0[d] + (xa @ a1[d]) @ a2[d])
        g = jax.nn.sigmoid(xg @ g1[d]) @ g2[d]
        kd = heads(k * (1 + (a - 1) * k_a))
        ins = [rh, heads(decay), kd, vh, kk, heads(a)]
        if d == 1:
            ins = [jnp.flip(t, axis=1) for t in ins]
        o = rwkv7_scan(*ins)
        if d == 1:
            o = jnp.flip(o, axis=1)
        bonus = jnp.sum(rh * kd * r_k.astype(F32), axis=-1, keepdims=True) * vh
        dir_out.append((group_norm(o, gn_w, gn_b) + bonus.reshape(nB, S, D)) * g.astype(F32))
    y = dir_out[0] + dir_out[1]
    return y.astype(h.dtype) @ w_o


def setup_inputs(seed: int = 0) -> dict:
    key = jax.random.key(seed)
    ks = iter(jax.random.split(key, 40))

    def nrm(shape, scale):
        return scale * jax.random.normal(next(ks), shape, F32)

    NA, NR, D = N_ATTN_LAYERS, N_RWKV_LAYERS, D_MODEL
    return {
        'x': nrm((BATCH, SEQ, D), 1.0),
        'rel_table': nrm((REL_BUCKETS, N_REL_HEADS), 0.5),
        'norm_g': 1.0 + nrm((DEPTH, 4, D), 0.05),
        'attn_w_in': nrm((NA, D, D_ATTN_IN), D ** -0.5),
        'attn_sink': nrm((NA, N_HEADS_B), 0.5),
        'attn_w_out': nrm((NA, D_ATTN_OUT, D), D_ATTN_OUT ** -0.5),
        'rk_mu_prev': jax.random.uniform(next(ks), (NR, 6, D), F32, 0.0, 0.5),
        'rk_mu_next': jax.random.uniform(next(ks), (NR, 6, D), F32, 0.0, 0.5),
        'rk_w_r': nrm((NR, D, D), D ** -0.5),
        'rk_w_k': nrm((NR, D, D), D ** -0.5),
        'rk_w_v': nrm((NR, D, D), D ** -0.5),
        'rk_w_o': nrm((NR, D, D), D ** -0.5),
        'rk_k_k': 0.85 + nrm((NR, D), 0.05),
        'rk_k_a': 1.0 + nrm((NR, D), 0.05),
        'rk_r_k': nrm((NR, RWKV_HEADS, RWKV_HEAD), 0.1),
        'rk_gn_w': 1.0 + nrm((NR, D), 0.05),
        'rk_gn_b': nrm((NR, D), 0.02),
        'rk_w0': -2.0 + nrm((NR, 2, D), 1.0),
        'rk_w1': nrm((NR, 2, D, DECAY_LORA), D ** -0.5),
        'rk_w2': nrm((NR, 2, DECAY_LORA, D), 0.1 * DECAY_LORA ** -0.5),
        'rk_a0': nrm((NR, 2, D), 0.5),
        'rk_a1': nrm((NR, 2, D, AAA_LORA), D ** -0.5),
        'rk_a2': nrm((NR, 2, AAA_LORA, D), 0.5 * AAA_LORA ** -0.5),
        'rk_g1': nrm((NR, 2, D, GATE_LORA), D ** -0.5),
        'rk_g2': nrm((NR, 2, GATE_LORA, D), GATE_LORA ** -0.5),
        'mlp_w1': nrm((DEPTH, D, D_FF), D ** -0.5),
        'mlp_w2': nrm((DEPTH, D_FF, D), D_FF ** -0.5),
    }


def reference(x, rel_table, norm_g, attn_w_in, attn_sink, attn_w_out,
              rk_mu_prev, rk_mu_next, rk_w_r, rk_w_k, rk_w_v, rk_w_o, rk_k_k, rk_k_a, rk_r_k,
              rk_gn_w, rk_gn_b, rk_w0, rk_w1, rk_w2, rk_a0, rk_a1, rk_a2, rk_g1, rk_g2,
              mlp_w1, mlp_w2):
    h = x
    for layer in range(DEPTH):
        g = norm_g[layer]
        i = layer // 2
        u = rms_norm(h, g[0])
        if layer % 2 == 0:
            u = attention_mixer(u, attn_w_in[i], attn_sink[i], attn_w_out[i], rel_table)
        else:
            u = rwkv7_mixer(u, rk_mu_prev[i], rk_mu_next[i], rk_w_r[i], rk_w_k[i], rk_w_v[i], rk_w_o[i],
                            rk_k_k[i], rk_k_a[i], rk_r_k[i], rk_gn_w[i], rk_gn_b[i],
                            rk_w0[i], rk_w1[i], rk_w2[i], rk_a0[i], rk_a1[i], rk_a2[i], rk_g1[i], rk_g2[i])
        h = h + rms_norm(u, g[1])
        u = rms_norm(h, g[2])
        u = jnp.square(jax.nn.relu(u @ mlp_w1[layer])) @ mlp_w2[layer]
        h = h + rms_norm(u, g[3])
    return h
```

```cpp
#include <hip/hip_runtime.h>
#include <cstdint>
#include <cstdio>

constexpr int S = 2048, D = 1024, NB = 8, DFF = 4096, DIN = 2304;
constexpr float NORM_EPS = 1e-6f, GN_EPS = 64e-5f;

__device__ __forceinline__ float wave_sum(float v) {
#pragma unroll
    for (int o = 1; o < 64; o <<= 1) v += __shfl_xor(v, o);
    return v;
}
__device__ __forceinline__ int t5_bucket(int rel) {
    const int n = rel < 0 ? -rel : rel;
    int large;
    if (n < 8) large = n; else if (n < 15) large = 8; else if (n < 27) large = 9; else if (n < 50) large = 10; else if (n < 91) large = 11;
    else if (n < 166) large = 12; else if (n < 305) large = 13; else if (n < 559) large = 14; else large = 15;
    return (rel > 0 ? 16 : 0) + large;
}

__global__ void __launch_bounds__(256) rmsnorm_k(const float* __restrict__ in, const float* __restrict__ g, float* __restrict__ out, int rows) {
    const int row = blockIdx.x * 4 + (threadIdx.x >> 6), lane = threadIdx.x & 63;
    if (row >= rows) return;
    const float4* x = (const float4*)(in + (size_t)row * D);
    float4 v[4]; float s = 0.f;
#pragma unroll
    for (int j = 0; j < 4; ++j) { v[j] = x[lane + 64 * j]; s += v[j].x * v[j].x + v[j].y * v[j].y + v[j].z * v[j].z + v[j].w * v[j].w; }
    const float r = rsqrtf(wave_sum(s) * (1.f / D) + NORM_EPS);
    float4* o = (float4*)(out + (size_t)row * D);
#pragma unroll
    for (int j = 0; j < 4; ++j) { const float4 gg = ((const float4*)g)[lane + 64 * j]; o[lane + 64 * j] = make_float4(v[j].x * r * gg.x, v[j].y * r * gg.y, v[j].z * r * gg.z, v[j].w * r * gg.w); }
}
__global__ void __launch_bounds__(256) resid_rmsnorm_k(const float* base, const float* __restrict__ u, const float* __restrict__ g, float* hout, int rows) {
    const int row = blockIdx.x * 4 + (threadIdx.x >> 6), lane = threadIdx.x & 63;
    if (row >= rows) return;
    const float4* x = (const float4*)(u + (size_t)row * D);
    float4 v[4]; float s = 0.f;
#pragma unroll
    for (int j = 0; j < 4; ++j) { v[j] = x[lane + 64 * j]; s += v[j].x * v[j].x + v[j].y * v[j].y + v[j].z * v[j].z + v[j].w * v[j].w; }
    const float r = rsqrtf(wave_sum(s) * (1.f / D) + NORM_EPS);
    const float4* bs = (const float4*)(base + (size_t)row * D);
    float4* o = (float4*)(hout + (size_t)row * D);
#pragma unroll
    for (int j = 0; j < 4; ++j) { const float4 gg = ((const float4*)g)[lane + 64 * j]; const float4 b = bs[lane + 64 * j];
        o[lane + 64 * j] = make_float4(b.x + v[j].x * r * gg.x, b.y + v[j].y * r * gg.y, b.z + v[j].z * r * gg.z, b.w + v[j].w * r * gg.w); }
}

template <int EPI> __device__ __forceinline__ float epi_f(float z) {
    if (EPI == 1) { const float r = fmaxf(z, 0.f); return r * r; }
    if (EPI == 2) return tanhf(z);
    if (EPI == 3 || EPI == 5) return 1.f / (1.f + expf(-z));
    if (EPI == 4) { const float nz = -z; const float sp = nz > 20.f ? nz : log1pf(expf(nz)); return expf(-expf(-sp - 0.5f)); }
    return z;
}
template <int EPI>
__global__ void __launch_bounds__(256) gemm_f32(const float* __restrict__ A, int lda, const float* __restrict__ B, int ldb, float* __restrict__ C, int ldc, int N, int K, const float* __restrict__ bias) {
    __shared__ float As[16][132];
    __shared__ float Bs[16][132];
    const int tid = threadIdx.x, bm = blockIdx.y * 128, bn = blockIdx.x * 128, tx = tid & 15, ty = tid >> 4;
    float acc[8][8];
#pragma unroll
    for (int i = 0; i < 8; ++i)
#pragma unroll
        for (int j = 0; j < 8; ++j) acc[i][j] = 0.f;
    for (int k0 = 0; k0 < K; k0 += 16) {
#pragma unroll
        for (int i = 0; i < 2; ++i) { const int r = (tid >> 2) + i * 64, kc = (tid & 3) * 4;
            const float4 v = *(const float4*)(A + (size_t)(bm + r) * lda + k0 + kc);
            As[kc + 0][r] = v.x; As[kc + 1][r] = v.y; As[kc + 2][r] = v.z; As[kc + 3][r] = v.w; }
#pragma unroll
        for (int i = 0; i < 2; ++i) { const int kr = (tid >> 5) + i * 8, c = (tid & 31) * 4;
            float4 v = make_float4(0.f, 0.f, 0.f, 0.f);
            if (bn + c < N) v = *(const float4*)(B + (size_t)(k0 + kr) * ldb + bn + c);
            *(float4*)&Bs[kr][c] = v; }
        __syncthreads();
#pragma unroll
        for (int kk = 0; kk < 16; ++kk) {
            const float4 a0 = *(const float4*)&As[kk][ty * 4], a1 = *(const float4*)&As[kk][64 + ty * 4];
            const float4 b0 = *(const float4*)&Bs[kk][tx * 4], b1 = *(const float4*)&Bs[kk][64 + tx * 4];
            const float a[8] = {a0.x, a0.y, a0.z, a0.w, a1.x, a1.y, a1.z, a1.w};
            const float b[8] = {b0.x, b0.y, b0.z, b0.w, b1.x, b1.y, b1.z, b1.w};
#pragma unroll
            for (int i = 0; i < 8; ++i)
#pragma unroll
                for (int j = 0; j < 8; ++j) acc[i][j] = fmaf(a[i], b[j], acc[i][j]);
        }
        __syncthreads();
    }
#pragma unroll
    for (int i = 0; i < 8; ++i) { const int row = bm + (i < 4 ? ty * 4 + i : 64 + ty * 4 + i - 4);
#pragma unroll
        for (int jh = 0; jh < 2; ++jh) { const int col = bn + jh * 64 + tx * 4;
            if (col < N) { float4 o; float bz[4] = {0.f, 0.f, 0.f, 0.f};
                if (EPI >= 4) { const float4 bb = *(const float4*)(bias + col); bz[0] = bb.x; bz[1] = bb.y; bz[2] = bb.z; bz[3] = bb.w; }
                o.x = epi_f<EPI>(acc[i][jh * 4 + 0] + bz[0]); o.y = epi_f<EPI>(acc[i][jh * 4 + 1] + bz[1]); o.z = epi_f<EPI>(acc[i][jh * 4 + 2] + bz[2]); o.w = epi_f<EPI>(acc[i][jh * 4 + 3] + bz[3]);
                *(float4*)(C + (size_t)row * ldc + col) = o; } } }
}

__global__ void __launch_bounds__(256) attn_a_k(const float* __restrict__ proj, const float* __restrict__ rel_table, float* __restrict__ O) {
    const int t = blockIdx.x * 256 + threadIdx.x, h = blockIdx.y;
    float q[64], acc[64];
    const float4* qp = (const float4*)(proj + (size_t)t * DIN + h * 64);
#pragma unroll
    for (int i = 0; i < 16; ++i) { const float4 v = qp[i]; q[4 * i] = v.x; q[4 * i + 1] = v.y; q[4 * i + 2] = v.z; q[4 * i + 3] = v.w; }
#pragma unroll
    for (int i = 0; i < 64; ++i) acc[i] = 0.f;
    float m = -1e30f, l = 0.f;
    for (int br = 0; br < 3; ++br) {
        const int dil = br == 0 ? 1 : (br == 1 ? 4 : 16);
        for (int d = -64; d <= 64; ++d) {
            const int pos = t + d * dil;
            if (pos < 0 || pos >= S) continue;
            const float4* kp = (const float4*)(proj + (size_t)pos * DIN + 512 + h * 64);
            float s = 0.f;
#pragma unroll
            for (int i = 0; i < 16; ++i) { const float4 v = kp[i]; s = fmaf(q[4 * i], v.x, s); s = fmaf(q[4 * i + 1], v.y, s); s = fmaf(q[4 * i + 2], v.z, s); s = fmaf(q[4 * i + 3], v.w, s); }
            s = s * 0.125f + rel_table[t5_bucket(d * dil) * 16 + h];
            const float mn = fmaxf(m, s), f = expf(m - mn), p = expf(s - mn);
            l = l * f + p; m = mn;
            const float4* vp = (const float4*)(proj + (size_t)pos * DIN + 1024 + h * 64);
#pragma unroll
            for (int i = 0; i < 16; ++i) { const float4 v = vp[i]; acc[4 * i] = acc[4 * i] * f + p * v.x; acc[4 * i + 1] = acc[4 * i + 1] * f + p * v.y; acc[4 * i + 2] = acc[4 * i + 2] * f + p * v.z; acc[4 * i + 3] = acc[4 * i + 3] * f + p * v.w; }
        }
    }
    const float il = 1.f / l;
    float4* op = (float4*)(O + (size_t)t * D + h * 64);
#pragma unroll
    for (int i = 0; i < 16; ++i) op[i] = make_float4(acc[4 * i] * il, acc[4 * i + 1] * il, acc[4 * i + 2] * il, acc[4 * i + 3] * il);
}
__global__ void __launch_bounds__(256) attn_b_k(const float* __restrict__ proj, const float* __restrict__ rel_table, const float* __restrict__ sink, float* __restrict__ O) {
    const int t = blockIdx.x * 256 + threadIdx.x, h = blockIdx.y, g = h >> 2;
    float q[64], acc[64];
    const float4* qp = (const float4*)(proj + (size_t)t * DIN + 1536 + h * 64);
#pragma unroll
    for (int i = 0; i < 16; ++i) { const float4 v = qp[i]; q[4 * i] = v.x; q[4 * i + 1] = v.y; q[4 * i + 2] = v.z; q[4 * i + 3] = v.w; }
#pragma unroll
    for (int i = 0; i < 64; ++i) acc[i] = 0.f;
    float m = sink[h], l = 1.f;
    for (int d = -128; d <= 128; ++d) {
        const int pos = t + d;
        if (pos < 0 || pos >= S) continue;
        const float4* kp = (const float4*)(proj + (size_t)pos * DIN + 2048 + g * 64);
        float s = 0.f;
#pragma unroll
        for (int i = 0; i < 16; ++i) { const float4 v = kp[i]; s = fmaf(q[4 * i], v.x, s); s = fmaf(q[4 * i + 1], v.y, s); s = fmaf(q[4 * i + 2], v.z, s); s = fmaf(q[4 * i + 3], v.w, s); }
        s = s * 0.125f + rel_table[t5_bucket(d) * 16 + 8 + h];
        const float mn = fmaxf(m, s), f = expf(m - mn), p = expf(s - mn);
        l = l * f + p; m = mn;
        const float4* vp = (const float4*)(proj + (size_t)pos * DIN + 2176 + g * 64);
#pragma unroll
        for (int i = 0; i < 16; ++i) { const float4 v = vp[i]; acc[4 * i] = acc[4 * i] * f + p * v.x; acc[4 * i + 1] = acc[4 * i + 1] * f + p * v.y; acc[4 * i + 2] = acc[4 * i + 2] * f + p * v.z; acc[4 * i + 3] = acc[4 * i + 3] * f + p * v.w; }
    }
    const float il = 1.f / l;
    float4* op = (float4*)(O + (size_t)t * D + 512 + h * 64);
#pragma unroll
    for (int i = 0; i < 16; ++i) op[i] = make_float4(acc[4 * i] * il, acc[4 * i + 1] * il, acc[4 * i + 2] * il, acc[4 * i + 3] * il);
}

__global__ void __launch_bounds__(256) mix_k(const float* __restrict__ U, const float* __restrict__ mup, const float* __restrict__ mun, float* __restrict__ MIX) {
    const int idx = blockIdx.x * 256 + threadIdx.x;
    const int t = idx / (D / 4), c4 = idx % (D / 4);
    const float4 u = ((const float4*)U)[idx];
    float4 up = make_float4(0.f, 0.f, 0.f, 0.f), un = up;
    if (t > 0) up = ((const float4*)U)[idx - D / 4];
    if (t < S - 1) un = ((const float4*)U)[idx + D / 4];
#pragma unroll
    for (int c = 0; c < 6; ++c) { const float4 a = ((const float4*)mup)[c * (D / 4) + c4], b = ((const float4*)mun)[c * (D / 4) + c4];
        float4 o; o.x = u.x + (up.x - u.x) * a.x + (un.x - u.x) * b.x; o.y = u.y + (up.y - u.y) * a.y + (un.y - u.y) * b.y;
        o.z = u.z + (up.z - u.z) * a.z + (un.z - u.z) * b.z; o.w = u.w + (up.w - u.w) * a.w + (un.w - u.w) * b.w;
        ((float4*)MIX)[(size_t)c * (S * D / 4) + idx] = o; }
}
__global__ void __launch_bounds__(256) kprep_k(const float* __restrict__ K, const float* __restrict__ A0, const float* __restrict__ A1, const float* __restrict__ k_k, const float* __restrict__ k_a,
                                               float* __restrict__ KK, float* __restrict__ KD0, float* __restrict__ KD1) {
    const int w = blockIdx.x * 4 + (threadIdx.x >> 6), lane = threadIdx.x & 63;
    const int t = w >> 4, h = w & 15, col = h * 64 + lane; const size_t o = (size_t)t * D + col;
    const float k = K[o]; const float kk = k * k_k[col];
    const float nrm = sqrtf(wave_sum(kk * kk));
    KK[o] = kk / fmaxf(nrm, 1e-12f);
    const float ka = k_a[col];
    KD0[o] = k * (1.f + (A0[o] - 1.f) * ka);
    KD1[o] = k * (1.f + (A1[o] - 1.f) * ka);
}
__global__ void __launch_bounds__(256) scan_k(const float* __restrict__ R, const float* __restrict__ W0, const float* __restrict__ W1, const float* __restrict__ KD0, const float* __restrict__ KD1,
                                              const float* __restrict__ V, const float* __restrict__ KK, const float* __restrict__ A0, const float* __restrict__ A1, float* __restrict__ SO0, float* __restrict__ SO1) {
    const int h = blockIdx.x >> 1, dir = blockIdx.x & 1, tid = threadIdx.x, i = tid >> 2, q = tid & 3;
    const float* W = dir ? W1 : W0; const float* KD = dir ? KD1 : KD0; const float* A = dir ? A1 : A0; float* SO = dir ? SO1 : SO0;
    __shared__ float sh[6][16][64];
    __shared__ float so[16][64];
    float st[16];
#pragma unroll
    for (int e = 0; e < 16; ++e) st[e] = 0.f;
    for (int c = 0; c < S / 16; ++c) {
        for (int x = tid; x < 16 * 64; x += 256) { const int s = x >> 6, j = x & 63; const int t = dir ? (S - 1 - (c * 16 + s)) : (c * 16 + s); const size_t o = (size_t)t * D + h * 64 + j;
            sh[0][s][j] = R[o]; sh[1][s][j] = W[o]; sh[2][s][j] = KD[o]; sh[3][s][j] = V[o]; sh[4][s][j] = KK[o]; sh[5][s][j] = A[o]; }
        __syncthreads();
        for (int s = 0; s < 16; ++s) {
            float sa = 0.f;
#pragma unroll
            for (int e = 0; e < 16; ++e) sa = fmaf(st[e], sh[4][s][q * 16 + e], sa);
            sa += __shfl_xor(sa, 1); sa += __shfl_xor(sa, 2);
            sa = -sa;
            const float vi = sh[3][s][i];
            float o = 0.f;
#pragma unroll
            for (int e = 0; e < 16; ++e) { const int j = q * 16 + e; const float kkj = sh[4][s][j];
                st[e] = st[e] * sh[1][s][j] + sa * (kkj * sh[5][s][j]) + vi * sh[2][s][j];
                o = fmaf(st[e], sh[0][s][j], o); }
            o += __shfl_xor(o, 1); o += __shfl_xor(o, 2);
            if (q == 0) so[s][i] = o;
        }
        __syncthreads();
        for (int x = tid; x < 16 * 64; x += 256) { const int s = x >> 6, j = x & 63; const int t = dir ? (S - 1 - (c * 16 + s)) : (c * 16 + s); SO[(size_t)t * D + h * 64 + j] = so[s][j]; }
    }
}
__global__ void __launch_bounds__(256) post_k(const float* __restrict__ SO0, const float* __restrict__ SO1, const float* __restrict__ R, const float* __restrict__ KD0, const float* __restrict__ KD1,
                                              const float* __restrict__ V, const float* __restrict__ G0, const float* __restrict__ G1, const float* __restrict__ r_k, const float* __restrict__ gn_w,
                                              const float* __restrict__ gn_b, float* __restrict__ Y) {
    const int w = blockIdx.x * 4 + (threadIdx.x >> 6), lane = threadIdx.x & 63;
    const int t = w >> 4, h = w & 15, col = h * 64 + lane; const size_t o = (size_t)t * D + col;
    const float r = R[o], v = V[o], rk = r_k[col], gw = gn_w[col], gb = gn_b[col];
    float y = 0.f;
#pragma unroll
    for (int d = 0; d < 2; ++d) {
        const float so = (d ? SO1 : SO0)[o], kd = (d ? KD1 : KD0)[o], g = (d ? G1 : G0)[o];
        const float mu = wave_sum(so) * (1.f / 64.f); const float dv = so - mu;
        const float var = wave_sum(dv * dv) * (1.f / 64.f);
        const float gn = dv * rsqrtf(var + GN_EPS) * gw + gb;
        const float bonus = wave_sum(r * kd * rk) * v;
        y += (gn + bonus) * g;
    }
    Y[o] = y;
}

template <int EPI> static void gemm(hipStream_t st, const float* A, int lda, const float* B, int ldb, float* C, int ldc, int rows, int N, int K, const float* bias = nullptr) {
    dim3 grid((N + 127) / 128, rows / 128);
    hipLaunchKernelGGL(gemm_f32<EPI>, grid, dim3(256), 0, st, A, lda, B, ldb, C, ldc, N, K, bias);
}

extern "C" void kernel_launch(void* const* d_in, const int* in_sizes, int n_in, void* d_out, int out_size, void* d_ws, size_t ws_size, hipStream_t stream) {
    const float* x = (const float*)d_in[0];
    const float* rel_table = (const float*)d_in[1];
    const float* norm_g = (const float*)d_in[2];
    const float* attn_w_in = (const float*)d_in[3];
    const float* attn_sink = (const float*)d_in[4];
    const float* attn_w_out = (const float*)d_in[5];
    const float* mu_prev = (const float*)d_in[6];
    const float* mu_next = (const float*)d_in[7];
    const float* w_r = (const float*)d_in[8];
    const float* w_k = (const float*)d_in[9];
    const float* w_v = (const float*)d_in[10];
    const float* w_o = (const float*)d_in[11];
    const float* k_k = (const float*)d_in[12];
    const float* k_a = (const float*)d_in[13];
    const float* r_k = (const float*)d_in[14];
    const float* gn_w = (const float*)d_in[15];
    const float* gn_b = (const float*)d_in[16];
    const float* w0 = (const float*)d_in[17];
    const float* w1 = (const float*)d_in[18];
    const float* w2 = (const float*)d_in[19];
    const float* a0 = (const float*)d_in[20];
    const float* a1 = (const float*)d_in[21];
    const float* a2 = (const float*)d_in[22];
    const float* g1 = (const float*)d_in[23];
    const float* g2 = (const float*)d_in[24];
    const float* mlp_w1 = (const float*)d_in[25];
    const float* mlp_w2 = (const float*)d_in[26];
    float* out = (float*)d_out;

    float* ws = (float*)d_ws; size_t off = 0;
    auto alloc = [&](size_t n) { float* p = ws + off; off += n; return p; };
    const size_t SD = (size_t)S * D;
    float* U = alloc(SD);
    float* TMP = alloc(SD);
    float* HID = alloc((size_t)S * DFF);
    const size_t mark = off;
    float* PROJ = alloc((size_t)S * DIN);
    float* O = alloc(SD);
    off = mark;
    float* MIX = alloc(6 * SD);
    float* Rb = alloc(SD); float* Kb = alloc(SD); float* Vb = alloc(SD);
    float* LW = alloc((size_t)S * 128); float* LA = alloc((size_t)S * 128); float* LG = alloc((size_t)S * 256);
    float* DEC[2] = {alloc(SD), alloc(SD)};
    float* AA[2] = {alloc(SD), alloc(SD)};
    float* GG[2] = {alloc(SD), alloc(SD)};
    float* KD[2] = {alloc(SD), alloc(SD)};
    float* KKb = alloc(SD);
    float* SO[2] = {alloc(SD), alloc(SD)};
    float* Y = alloc(SD);
    if (off * 4 > ws_size) { fprintf(stderr, "workspace too small: need %zu have %zu\n", off * 4, ws_size); return; }

    for (int b = 0; b < NB; ++b) {
        const float* xb = x + (size_t)b * SD;
        float* hb = out + (size_t)b * SD;
        const float* g0 = norm_g;
        hipLaunchKernelGGL(rmsnorm_k, dim3(S / 4), dim3(256), 0, stream, xb, g0, U, S);
        gemm<0>(stream, U, D, attn_w_in, DIN, PROJ, DIN, S, DIN, D);
        hipLaunchKernelGGL(attn_a_k, dim3(S / 256, 8), dim3(256), 0, stream, PROJ, rel_table, O);
        hipLaunchKernelGGL(attn_b_k, dim3(S / 256, 8), dim3(256), 0, stream, PROJ, rel_table, attn_sink, O);
        gemm<0>(stream, O, D, attn_w_out, D, TMP, D, S, D, D);
        hipLaunchKernelGGL(resid_rmsnorm_k, dim3(S / 4), dim3(256), 0, stream, xb, TMP, g0 + D, hb, S);
        hipLaunchKernelGGL(rmsnorm_k, dim3(S / 4), dim3(256), 0, stream, hb, g0 + 2 * D, U, S);
        gemm<1>(stream, U, D, mlp_w1, DFF, HID, DFF, S, DFF, D);
        gemm<0>(stream, HID, DFF, mlp_w2, D, TMP, D, S, D, DFF);
        hipLaunchKernelGGL(resid_rmsnorm_k, dim3(S / 4), dim3(256), 0, stream, hb, TMP, g0 + 3 * D, hb, S);
        const float* g1n = norm_g + 4 * D;
        hipLaunchKernelGGL(rmsnorm_k, dim3(S / 4), dim3(256), 0, stream, hb, g1n, U, S);
        hipLaunchKernelGGL(mix_k, dim3(S * D / 4 / 256), dim3(256), 0, stream, U, mu_prev, mu_next, MIX);
        gemm<0>(stream, MIX + 0 * SD, D, w_r, D, Rb, D, S, D, D);
        gemm<0>(stream, MIX + 2 * SD, D, w_k, D, Kb, D, S, D, D);
        gemm<0>(stream, MIX + 3 * SD, D, w_v, D, Vb, D, S, D, D);
        for (int d = 0; d < 2; ++d) {
            gemm<2>(stream, MIX + 1 * SD, D, w1 + (size_t)d * D * 64, 64, LW + d * 64, 128, S, 64, D);
            gemm<0>(stream, MIX + 4 * SD, D, a1 + (size_t)d * D * 64, 64, LA + d * 64, 128, S, 64, D);
            gemm<3>(stream, MIX + 5 * SD, D, g1 + (size_t)d * D * 128, 128, LG + d * 128, 256, S, 128, D);
            gemm<4>(stream, LW + d * 64, 128, w2 + (size_t)d * 64 * D, D, DEC[d], D, S, D, 64, w0 + d * D);
            gemm<5>(stream, LA + d * 64, 128, a2 + (size_t)d * 64 * D, D, AA[d], D, S, D, 64, a0 + d * D);
            gemm<0>(stream, LG + d * 128, 256, g2 + (size_t)d * 128 * D, D, GG[d], D, S, D, 128);
        }
        hipLaunchKernelGGL(kprep_k, dim3(S * 16 / 4), dim3(256), 0, stream, Kb, AA[0], AA[1], k_k, k_a, KKb, KD[0], KD[1]);
        hipLaunchKernelGGL(scan_k, dim3(32), dim3(256), 0, stream, Rb, DEC[0], DEC[1], KD[0], KD[1], Vb, KKb, AA[0], AA[1], SO[0], SO[1]);
        hipLaunchKernelGGL(post_k, dim3(S * 16 / 4), dim3(256), 0, stream, SO[0], SO[1], Rb, KD[0], KD[1], Vb, GG[0], GG[1], r_k, gn_w, gn_b, Y);
        gemm<0>(stream, Y, D, w_o, D, TMP, D, S, D, D);
        hipLaunchKernelGGL(resid_rmsnorm_k, dim3(S / 4), dim3(256), 0, stream, hb, TMP, g1n + D, hb, S);
        hipLaunchKernelGGL(rmsnorm_k, dim3(S / 4), dim3(256), 0, stream, hb, g1n + 2 * D, U, S);
        gemm<1>(stream, U, D, mlp_w1 + (size_t)D * DFF, DFF, HID, DFF, S, DFF, D);
        gemm<0>(stream, HID, DFF, mlp_w2 + (size_t)DFF * D, D, TMP, D, S, D, DFF);
        hipLaunchKernelGGL(resid_rmsnorm_k, dim3(S / 4), dim3(256), 0, stream, hb, TMP, g1n + 3 * D, hb, S);
    }
}
```

```cpp
#include <hip/hip_runtime.h>
#include <cstdio>
#include <cstdint>

#define LAS __attribute__((address_space(3)))
#define GAS __attribute__((address_space(1)))
typedef unsigned short bf16_t;
typedef short bf16x8 __attribute__((ext_vector_type(8)));
typedef float f32x4 __attribute__((ext_vector_type(4)));
typedef float f32x2 __attribute__((ext_vector_type(2)));
typedef unsigned u32x4 __attribute__((ext_vector_type(4)));
typedef unsigned u32x2 __attribute__((ext_vector_type(2)));

constexpr int SEQ = 2048, D = 1024, NBATCH = 8, M = NBATCH * SEQ, DFF = 4096, DIN = 2304, NLD = 1536;
constexpr float NORM_EPS = 1e-6f, GN_EPS = 64e-5f;
constexpr int NWAVES = 8, NTHREADS = 512;

namespace pg8 {
constexpr int BM = 256, BK = 64, HALF = 128, HTB = HALF * BK * 2, STAGE_BYTES = 8 * HTB, NXCD = 8, WGM = 8;
__host__ __device__ __forceinline__ int lds_byte(int r, int c) { const int st = (r >> 4) * 2 + (c >> 5), rr = r & 15, cc = c & 31, ob = rr * 64 + cc * 2; return st * 1024 + (ob ^ (((ob >> 9) & 1) << 5)); }
__host__ __device__ __forceinline__ void stage_rc(int b, int& R, int& C) { const int st = b / 1024, sb = b % 1024, swz = sb ^ (((sb >> 9) & 1) << 5); R = (st >> 1) * 16 + swz / 64; C = (st & 1) * 32 + (swz % 64) / 2; }
__host__ __device__ __forceinline__ int perm32(int rho) { const int n = rho >> 4, i = rho & 15; return 8 * (i >> 2) + 4 * n + (i & 3); }

struct Unit { int pm, pn; };
struct StaticOrder {
    int nM, nN, nwg, G, c;
    __host__ __device__ void init(int Mr, int N, int G_, int c_) { nM = Mr / BM; nN = N / BM; nwg = nM * nN; G = G_; c = c_; }
    __host__ __device__ bool next(int i, Unit& u) const {
        const long L = (long)i * G + c; if (L >= nwg) return false;
        int wgid = (int)L; { const int q = nwg / NXCD, r = nwg % NXCD, xcd = wgid % NXCD, off = wgid / NXCD; wgid = (xcd < r ? xcd * (q + 1) : r * (q + 1) + (xcd - r) * q) + off; }
        const int nig = WGM * nN, gid = wgid / nig, fm = gid * WGM, gsz = (nM - fm) < WGM ? (nM - fm) : WGM;
        u.pm = fm + ((wgid % nig) % gsz); u.pn = (wgid % nig) / gsz; return true;
    }
};
__device__ __forceinline__ unsigned cvt_pk_bf16(float lo, float hi) { unsigned r; asm volatile("v_cvt_pk_bf16_f32 %0, %1, %2" : "=v"(r) : "v"(lo), "v"(hi)); return r; }

template <int ACT, class DstFn> struct EpiBf16 {
    static constexpr bool PERM = true;
    DstFn F;
    __device__ __forceinline__ void operator()(const f32x4 (&acc)[2][2][4][2], const Unit& u, int wr, int wc, int fr, int fq) const {
        bf16_t* base; int ldc; F(u, base, ldc);
        const int row0 = wr * 64 + fr, col0 = wc * 32 + 8 * fq;
#pragma unroll
        for (int ai = 0; ai < 2; ++ai)
#pragma unroll
            for (int m = 0; m < 4; ++m) { bf16_t* rowp = base + (size_t)(row0 + ai * HALF + m * 16) * ldc + col0;
#pragma unroll
                for (int bj = 0; bj < 2; ++bj) { f32x4 v0 = acc[ai][bj][m][0], v1 = acc[ai][bj][m][1];
                    if (ACT == 1) {
#pragma unroll
                        for (int e = 0; e < 4; ++e) { const float a = fmaxf(v0[e], 0.f), b = fmaxf(v1[e], 0.f); v0[e] = a * a; v1[e] = b * b; } }
                    u32x4 w; w.x = cvt_pk_bf16(v0[0], v0[1]); w.y = cvt_pk_bf16(v0[2], v0[3]); w.z = cvt_pk_bf16(v1[0], v1[1]); w.w = cvt_pk_bf16(v1[2], v1[3]);
                    *(u32x4*)(rowp + bj * HALF) = w; } }
    }
};

template <class Epi, class Prob, bool ALIGN_EPI, bool SP2>
__device__ __forceinline__ void gemm_phase(LAS unsigned char* lds, const Prob& P, const StaticOrder& S, const Epi& E) {
    int tid = threadIdx.x; asm volatile("" : "+v"(tid));
    const int wid = __builtin_amdgcn_readfirstlane(tid >> 6), lane = tid & 63, wr = wid >> 2, wc = wid & 3, fr = lane & 15, fq = lane >> 4;
    const int K = P.K, nt = K / BK;
    unsigned voffA[2], voffB[2];
#pragma unroll
    for (int i = 0; i < 2; ++i) { int R, C; stage_rc(tid * 16 + i * 8192, R, C); const int Rb = Epi::PERM ? ((R & ~31) + perm32(R & 31)) : R;
        voffA[i] = (unsigned)(R * K + C) * 2u; voffB[i] = (unsigned)(Rb * K + C) * 2u; }
    const size_t kstep = (size_t)(BK * 2);
    const size_t hstep = (size_t)HALF * K * 2;
    const unsigned ldsw = (unsigned)wid * 1024u;
    const int aoff = lds_byte(wr * 64 + fr, fq * 8), boff = lds_byte(wc * 32 + fr, fq * 8);
#define PG8_SA(b, h) (((b) * 2 + (h)) * HTB)
#define PG8_SB(b, h) ((4 + (b) * 2 + (h)) * HTB)
#define PG8_STAGE(bufoff, gbase, voff) do { _Pragma("unroll") for (int _i = 0; _i < 2; ++_i) \
        __builtin_amdgcn_global_load_lds((const unsigned*)((const char*)(gbase) + (voff)[_i]), (LAS unsigned*)(lds + (bufoff) + ldsw + _i * 8192), 16, 0, 0); } while (0)
#define PG8_LDA(dst, b, h) do { _Pragma("unroll") for (int m = 0; m < 4; ++m) _Pragma("unroll") for (int k = 0; k < 2; ++k) dst[m][k] = *(const LAS bf16x8*)(lds + PG8_SA(b, h) + aoff + m * 2048 + k * 1024); } while (0)
#define PG8_LDB(dst, b, h) do { _Pragma("unroll") for (int n = 0; n < 2; ++n) _Pragma("unroll") for (int k = 0; k < 2; ++k) dst[n][k] = *(const LAS bf16x8*)(lds + PG8_SB(b, h) + boff + n * 2048 + k * 1024); } while (0)
#define PG8_MMA(ai, bj, At, Bt) do { __builtin_amdgcn_s_setprio(1); _Pragma("unroll") for (int m = 0; m < 4; ++m) _Pragma("unroll") for (int n = 0; n < 2; ++n) _Pragma("unroll") for (int k = 0; k < 2; ++k) \
        acc[ai][bj][m][n] = __builtin_amdgcn_mfma_f32_16x16x32_bf16(Bt[n][k], At[m][k], acc[ai][bj][m][n], 0, 0, 0); __builtin_amdgcn_s_setprio(0); } while (0)
#define PG8_WAIT_V(n) asm volatile("s_waitcnt vmcnt(" #n ")" ::: "memory")
#define PG8_WAIT_L(n) asm volatile("s_waitcnt lgkmcnt(" #n ")" ::: "memory")
#define PG8_BAR __builtin_amdgcn_s_barrier()
#define PG8_SCHED __builtin_amdgcn_sched_barrier(0)
    Unit cur, nxt; int ui = 0;
    if (!S.next(0, cur)) return;
    f32x4 acc[2][2][4][2];
#pragma unroll
    for (int a = 0; a < 2; ++a)
#pragma unroll
        for (int b = 0; b < 2; ++b)
#pragma unroll
            for (int m = 0; m < 4; ++m)
#pragma unroll
                for (int n = 0; n < 2; ++n) acc[a][b][m][n] = (f32x4){0.f, 0.f, 0.f, 0.f};
    bf16x8 At[4][2], B0[2][2], B1[2][2];
    const char* cA = P.a_tile(cur); const char* cB = P.b_tile(cur);
    if constexpr (SP2) {
        PG8_STAGE(PG8_SB(0, 0), cB, voffB); PG8_STAGE(PG8_SB(0, 1), cB + hstep, voffB); PG8_STAGE(PG8_SA(0, 0), cA, voffA); PG8_STAGE(PG8_SA(0, 1), cA + hstep, voffA);
        if (wr == 1) PG8_BAR;
        PG8_WAIT_V(2); PG8_BAR;
        PG8_STAGE(PG8_SB(1, 0), cB + kstep, voffB); PG8_STAGE(PG8_SA(1, 0), cA + kstep, voffA); PG8_STAGE(PG8_SB(1, 1), cB + hstep + kstep, voffB);
        PG8_WAIT_V(6); PG8_BAR;
    } else {
        PG8_STAGE(PG8_SB(0, 0), cB, voffB); PG8_STAGE(PG8_SA(0, 0), cA, voffA); PG8_STAGE(PG8_SB(0, 1), cB + hstep, voffB); PG8_STAGE(PG8_SA(0, 1), cA + hstep, voffA);
        if (wr == 1) PG8_BAR;
        PG8_WAIT_V(4); PG8_BAR;
        PG8_STAGE(PG8_SB(1, 0), cB + kstep, voffB); PG8_STAGE(PG8_SA(1, 0), cA + kstep, voffA); PG8_STAGE(PG8_SB(1, 1), cB + hstep + kstep, voffB);
        PG8_WAIT_V(6); PG8_BAR;
    }
    for (;;) {
        const bool has_next = S.next(ui + 1, nxt);
        const char* nA = has_next ? P.a_tile(nxt) : cA; const char* nB = has_next ? P.b_tile(nxt) : cB;
        for (int t = 0; t < nt; t += 2) {
            const bool last = (t == nt - 2);
            const char* a1 = cA + (size_t)(t + 1) * kstep;
            const char* a2 = last ? nA : cA + (size_t)(t + 2) * kstep; const char* b2 = last ? nB : cB + (size_t)(t + 2) * kstep;
            const char* a3 = a2 + kstep; const char* b3 = b2 + kstep;
            if constexpr (SP2) {
            PG8_LDB(B0, 0, 0); PG8_LDB(B1, 0, 1); PG8_SCHED; PG8_LDA(At, 0, 0); PG8_STAGE(PG8_SA(1, 1), a1 + hstep, voffA);
            PG8_WAIT_V(8); PG8_WAIT_L(0); PG8_BAR; PG8_MMA(0, 0, At, B0); PG8_MMA(0, 1, At, B1); PG8_BAR; PG8_SCHED;
            PG8_LDA(At, 0, 1); PG8_STAGE(PG8_SB(0, 0), b2, voffB); PG8_STAGE(PG8_SB(0, 1), b2 + hstep, voffB); PG8_STAGE(PG8_SA(0, 0), a2, voffA);
            PG8_WAIT_V(8); PG8_WAIT_L(0); PG8_BAR; PG8_MMA(1, 0, At, B0); PG8_MMA(1, 1, At, B1); PG8_BAR; PG8_SCHED;
            PG8_LDB(B0, 1, 0); PG8_LDB(B1, 1, 1); PG8_SCHED; PG8_LDA(At, 1, 0); PG8_STAGE(PG8_SA(0, 1), a2 + hstep, voffA);
            PG8_WAIT_V(8); PG8_WAIT_L(0); PG8_BAR; PG8_MMA(0, 0, At, B0); PG8_MMA(0, 1, At, B1); PG8_BAR; PG8_SCHED;
            PG8_LDA(At, 1, 1); PG8_STAGE(PG8_SB(1, 0), b3, voffB); PG8_STAGE(PG8_SB(1, 1), b3 + hstep, voffB); PG8_STAGE(PG8_SA(1, 0), a3, voffA);
            PG8_WAIT_V(8); PG8_WAIT_L(0); PG8_BAR; PG8_MMA(1, 0, At, B0); PG8_MMA(1, 1, At, B1); PG8_BAR; PG8_SCHED;
            } else {
            PG8_LDB(B0, 0, 0); PG8_SCHED; PG8_LDA(At, 0, 0); PG8_STAGE(PG8_SA(1, 1), a1 + hstep, voffA);
            PG8_WAIT_L(8); PG8_BAR; PG8_WAIT_L(0); PG8_MMA(0, 0, At, B0); PG8_BAR; PG8_SCHED;
            PG8_LDB(B1, 0, 1); PG8_STAGE(PG8_SB(0, 0), b2, voffB);
            PG8_BAR; PG8_WAIT_L(0); PG8_MMA(0, 1, At, B1); PG8_BAR;
            PG8_LDA(At, 0, 1); PG8_STAGE(PG8_SA(0, 0), a2, voffA);
            PG8_BAR; PG8_WAIT_L(0); PG8_MMA(1, 0, At, B0); PG8_BAR; PG8_SCHED;
            PG8_STAGE(PG8_SB(0, 1), b2 + hstep, voffB);
            PG8_WAIT_V(6); PG8_BAR; PG8_MMA(1, 1, At, B1); PG8_BAR;
            PG8_LDB(B0, 1, 0); PG8_SCHED; PG8_LDA(At, 1, 0); PG8_STAGE(PG8_SA(0, 1), a2 + hstep, voffA);
            PG8_WAIT_L(8); PG8_BAR; PG8_WAIT_L(0); PG8_MMA(0, 0, At, B0); PG8_BAR; PG8_SCHED;
            PG8_LDB(B1, 1, 1); PG8_STAGE(PG8_SB(1, 0), b3, voffB);
            PG8_BAR; PG8_WAIT_L(0); PG8_MMA(0, 1, At, B1); PG8_BAR;
            PG8_LDA(At, 1, 1); PG8_STAGE(PG8_SA(1, 0), a3, voffA);
            PG8_BAR; PG8_WAIT_L(0); PG8_MMA(1, 0, At, B0); PG8_BAR; PG8_SCHED;
            PG8_STAGE(PG8_SB(1, 1), b3 + hstep, voffB);
            PG8_WAIT_V(6); PG8_BAR; PG8_MMA(1, 1, At, B1); PG8_BAR;
            }
        }
        if constexpr (ALIGN_EPI) { if (wr == 0) PG8_BAR; }
        E(acc, cur, wr, wc, fr, fq);
        if (!has_next) break;
#pragma unroll
        for (int a = 0; a < 2; ++a)
#pragma unroll
            for (int b = 0; b < 2; ++b)
#pragma unroll
                for (int m = 0; m < 4; ++m)
#pragma unroll
                    for (int n = 0; n < 2; ++n) acc[a][b][m][n] = (f32x4){0.f, 0.f, 0.f, 0.f};
        cur = nxt; cA = nA; cB = nB; ++ui;
        if constexpr (ALIGN_EPI) { if (wr == 1) PG8_BAR; }
    }
    PG8_WAIT_V(0);
    if constexpr (!ALIGN_EPI) { if (wr == 0) PG8_BAR; }
    PG8_BAR;
#undef PG8_SA
#undef PG8_SB
#undef PG8_STAGE
#undef PG8_LDA
#undef PG8_LDB
#undef PG8_MMA
#undef PG8_WAIT_V
#undef PG8_WAIT_L
#undef PG8_BAR
#undef PG8_SCHED
}
}

constexpr size_t MiB = 1u << 20;
constexpr size_t WS_CTL = 0, CTL_ZERO_BYTES = 64 * 1024;
constexpr size_t WS_W = 1 * MiB;
constexpr size_t WS_WIN_T = WS_W, WS_WOUT_T = WS_WIN_T + (size_t)DIN * D * 2, WS_W1_T = WS_WOUT_T + (size_t)D * D * 2, WS_W2_T = WS_W1_T + (size_t)DFF * D * 2;
constexpr size_t WS_WR_T = WS_W, WS_WK_T = WS_WR_T + 2 * MiB, WS_LDW_T = WS_WK_T + 2 * MiB, WS_WV_T = WS_LDW_T + 3 * MiB, WS_WO2_T = WS_WV_T + 2 * MiB, WS_W1B_T = WS_WO2_T + 4 * MiB, WS_W2B_T = WS_W1B_T + 8 * MiB;
static_assert(WS_W2_T + (size_t)D * DFF * 2 <= 33 * MiB && WS_W2B_T + (size_t)D * DFF * 2 <= 33 * MiB, "weight region");
constexpr size_t WS_XN = 33 * MiB, WS_QKV = 65 * MiB, WS_O = 137 * MiB, WS_TMP = 219 * MiB, WS_H = 65 * MiB;
constexpr size_t WS_MIXA = 65 * MiB, WS_MIXB = 97 * MiB, WS_R = 129 * MiB, WS_K = 161 * MiB, WS_V = 33 * MiB, WS_LDO = 193 * MiB, WS_Y = 65 * MiB;
constexpr size_t WS_END = 256 * MiB;
static_assert(WS_MIXA == WS_XN + 32 * MiB && WS_MIXB == WS_XN + 64 * MiB && WS_K == WS_R + 32 * MiB && WS_LDO == WS_R + 64 * MiB && WS_WK_T == WS_WR_T + 2 * MiB && WS_LDW_T == WS_WR_T + 4 * MiB, "grouped GEMM strides");
constexpr int CW_BAR = 4096;

constexpr int RING_BYTES = 131072, LDSCTL_OFF = RING_BYTES, MISC_OFF = LDSCTL_OFF + 320, LDS_BYTES = 147456;

__device__ __forceinline__ float bf2f(unsigned short b) { return __uint_as_float((unsigned)b << 16); }
__device__ __forceinline__ float bflo(unsigned w) { return __uint_as_float(w << 16); }
__device__ __forceinline__ float bfhi(unsigned w) { return __uint_as_float(w & 0xffff0000u); }
__device__ __forceinline__ unsigned f2bf(float f) { unsigned u = __float_as_uint(f); return (u + 0x7fffu + ((u >> 16) & 1u)) >> 16; }
__device__ __forceinline__ unsigned pk2(float lo, float hi) { return f2bf(lo) | (f2bf(hi) << 16); }
__device__ __forceinline__ float wave_sum(float v) {
#pragma unroll
    for (int o = 1; o < 64; o <<= 1) v += __shfl_xor(v, o);
    return v;
}
__device__ __forceinline__ float sigmoidf_(float z) { return 1.f / (1.f + __expf(-z)); }
__device__ __forceinline__ int t5_bucket(int rel) {
    const int n = rel < 0 ? -rel : rel;
    int large;
    if (n < 8) large = n; else if (n < 15) large = 8; else if (n < 27) large = 9; else if (n < 50) large = 10; else if (n < 91) large = 11;
    else if (n < 166) large = 12; else if (n < 305) large = 13; else if (n < 559) large = 14; else large = 15;
    return (rel > 0 ? 16 : 0) + large;
}

#define XB_TMO      128
#define XB_XCNT(j)  (256  + 64 * (j))
#define XB_XSUB(j)  (1280 + 64 * (j))
#define XB_XGEN(j)  (2304 + 64 * (j))
#define XB_TOP      3328
#define XB_TOPGEN   3392
#define XCD_BAR_WORDS 3456
#define XB_SPIN_CAP (1u << 18)
__device__ __forceinline__ unsigned xb_ld(unsigned* p)              { return __hip_atomic_load(p, __ATOMIC_RELAXED, __HIP_MEMORY_SCOPE_AGENT); }
__device__ __forceinline__ unsigned xb_add(unsigned* p, unsigned v) { return __hip_atomic_fetch_add(p, v, __ATOMIC_RELAXED, __HIP_MEMORY_SCOPE_AGENT); }
__device__ __forceinline__ unsigned xb_xcc_id() { return (unsigned)__builtin_amdgcn_s_getreg((3 << 11) | 20) & 0xFu; }
#define XB_SPIN(cond, bar) do { unsigned _sp = 0; while (cond) { __builtin_amdgcn_s_sleep(1); \
    if ((++_sp & 255u) == 0u) { if (xb_ld(&(bar)[XB_TMO])) break; if (_sp > XB_SPIN_CAP) { atomicAdd(&(bar)[XB_TMO], 1u); break; } } } } while (0)
struct XcdBarrier { unsigned* bar; unsigned x; volatile LAS unsigned* st; };
__device__ __forceinline__ XcdBarrier xcd_barrier_post(unsigned* bar, volatile LAS unsigned* st) {
    XcdBarrier b; b.bar = bar; b.x = xb_xcc_id(); b.st = st;
    if (threadIdx.x == 0) (void)xb_add(&bar[XB_XCNT(b.x)], 1u);
    return b;
}
__device__ __forceinline__ void xcd_barrier_complete(unsigned* bar, unsigned x, unsigned& nloc, unsigned& nx) {
    const unsigned G = gridDim.x * gridDim.y * gridDim.z;
    unsigned sum, cnt, mine, sp = 0u;
    for (;;) {
        sum = 0u; cnt = 0u; mine = 0u;
#pragma unroll
        for (unsigned j = 0; j < 16; ++j) { const unsigned c = xb_ld(&bar[XB_XCNT(j)]); sum += c; cnt += (c > 0u) ? 1u : 0u; mine = (j == x) ? c : mine; }
        if (sum == G) break;
        __builtin_amdgcn_s_sleep(1);
        if ((++sp & 255u) == 0u) { if (xb_ld(&bar[XB_TMO])) break; if (sp > XB_SPIN_CAP) { atomicAdd(&bar[XB_TMO], 1u); break; } }
    }
    nloc = mine > 0u ? mine : 1u; nx = cnt > 0u ? cnt : 1u;
}
__device__ __forceinline__ void xcd_barrier(const XcdBarrier& b) {
    asm volatile("s_waitcnt vmcnt(0)" ::: "memory");
    __syncthreads();
    if (threadIdx.x == 0) {
        unsigned* bar = b.bar;
        __builtin_amdgcn_s_waitcnt(0);
        unsigned nloc = b.st[0], nx = b.st[1];
        if (nloc == 0u) { xcd_barrier_complete(bar, b.x, nloc, nx); b.st[0] = nloc; b.st[1] = nx; }
        const unsigned old = xb_add(&bar[XB_XSUB(b.x)], 1u);
        const unsigned gen = old / nloc;
        if (old + 1u == (gen + 1u) * nloc) {
            __builtin_amdgcn_fence(__ATOMIC_RELEASE, "agent");
            asm volatile("s_waitcnt vmcnt(0)" ::: "memory");
            const unsigned og = xb_add(&bar[XB_TOP], 1u);
            const unsigned tg = og / nx;
            if (og + 1u == (tg + 1u) * nx) xb_add(&bar[XB_TOPGEN], 1u);
            else XB_SPIN(xb_ld(&bar[XB_TOPGEN]) == tg, bar);
            __builtin_amdgcn_fence(__ATOMIC_ACQUIRE, "agent");
            xb_add(&bar[XB_XGEN(b.x)], 1u);
            asm volatile("s_waitcnt vmcnt(0)" ::: "memory");
        } else {
            XB_SPIN(xb_ld(&bar[XB_XGEN(b.x)]) == gen, bar);
            __builtin_amdgcn_fence(__ATOMIC_ACQUIRE, "agent");
            asm volatile("s_waitcnt vmcnt(0)" ::: "memory");
        }
    }
    __syncthreads();
}

struct Row16 { f32x4 v[4]; };
__device__ __forceinline__ void row_load_f32(Row16& r, const float* p, int lane) {
#pragma unroll
    for (int j = 0; j < 4; ++j) r.v[j] = ((const f32x4*)p)[lane + 64 * j];
}
__device__ __forceinline__ void row_load_bf16(Row16& r, const bf16_t* p, int lane) {
#pragma unroll
    for (int j = 0; j < 4; ++j) { const u32x2 w = ((const u32x2*)p)[lane + 64 * j]; r.v[j] = (f32x4){bflo(w.x), bfhi(w.x), bflo(w.y), bfhi(w.y)}; }
}
__device__ __forceinline__ void row_store_f32(const Row16& r, float* p, int lane) {
#pragma unroll
    for (int j = 0; j < 4; ++j) ((f32x4*)p)[lane + 64 * j] = r.v[j];
}
__device__ __forceinline__ void row_store_bf16(const Row16& r, bf16_t* p, int lane) {
#pragma unroll
    for (int j = 0; j < 4; ++j) { u32x2 w; w.x = pk2(r.v[j][0], r.v[j][1]); w.y = pk2(r.v[j][2], r.v[j][3]); ((u32x2*)p)[lane + 64 * j] = w; }
}
__device__ __forceinline__ void row_rmsnorm(Row16& r, const float* g, int lane) {
    float s = 0.f;
#pragma unroll
    for (int j = 0; j < 4; ++j) s += r.v[j][0] * r.v[j][0] + r.v[j][1] * r.v[j][1] + r.v[j][2] * r.v[j][2] + r.v[j][3] * r.v[j][3];
    const float rs = rsqrtf(wave_sum(s) * (1.f / D) + NORM_EPS);
#pragma unroll
    for (int j = 0; j < 4; ++j) { const f32x4 gg = ((const f32x4*)g)[lane + 64 * j]; r.v[j] = r.v[j] * rs * gg; }
}

template <class ScaleFn>
__device__ __forceinline__ void transpose_item(const float* W, int ldw, int N, bf16_t* WT, int ldt, int row_off, int koff, LAS float* scr, int item, int lane, ScaleFn sc) {
    const int nblk = N / 32, kb = item / nblk, nb = item % nblk, k0 = 64 * kb, n0 = 32 * nb;
#pragma unroll 8
    for (int i = 0; i < 32; ++i) { const int kk = 2 * i + (lane >> 5); scr[kk * 33 + (lane & 31)] = W[(size_t)(k0 + kk) * ldw + n0 + (lane & 31)] * sc(k0 + kk); }
    asm volatile("s_waitcnt lgkmcnt(0)" ::: "memory");
    const int c = lane & 7;
#pragma unroll
    for (int j = 0; j < 4; ++j) { const int n = (lane >> 3) + 8 * j; const LAS float* s = scr + (8 * c) * 33 + n;
        u32x4 o; o.x = pk2(s[0 * 33], s[1 * 33]); o.y = pk2(s[2 * 33], s[3 * 33]); o.z = pk2(s[4 * 33], s[5 * 33]); o.w = pk2(s[6 * 33], s[7 * 33]);
        *(u32x4*)(WT + (size_t)(row_off + n0 + n) * ldt + koff + k0 + 8 * c) = o; }
    asm volatile("s_waitcnt lgkmcnt(0)" ::: "memory");
}
struct ScaleOne { __device__ __forceinline__ float operator()(int) const { return 1.f; } };
struct ScaleMix { const float* mp; const float* mn; int part;
    __device__ __forceinline__ float operator()(int k) const { return part == 0 ? 1.f - mp[k] - mn[k] : (part == 1 ? mp[k] : mn[k]); } };

struct Args { const float* in[27]; float* out; unsigned char* ws; };

struct ProbPlain { const bf16_t* A; const bf16_t* Bt; int K;
    __device__ __forceinline__ const char* a_tile(const pg8::Unit& u) const { return (const char*)(A + (size_t)u.pm * 256 * K); }
    __device__ __forceinline__ const char* b_tile(const pg8::Unit& u) const { return (const char*)(Bt + (size_t)u.pn * 256 * K); } };
struct DstPlain { bf16_t* C; int ldc;
    __device__ __forceinline__ void operator()(const pg8::Unit& u, bf16_t*& base, int& ld) const { base = C + (size_t)u.pm * 256 * ldc + (size_t)u.pn * 256; ld = ldc; } };
struct ProbRKL { const unsigned char* ws; int K;
    __device__ __forceinline__ const char* a_tile(const pg8::Unit& u) const { const int g = u.pn < 4 ? 0 : (u.pn < 8 ? 1 : 2); const int ga = g == 2 ? 0 : g + 1;
        return (const char*)(ws + WS_XN + (size_t)ga * (32 * MiB) + (size_t)u.pm * 256 * D * 2); }
    __device__ __forceinline__ const char* b_tile(const pg8::Unit& u) const { const int g = u.pn < 4 ? 0 : (u.pn < 8 ? 1 : 2); const int t = u.pn - 4 * g;
        return (const char*)(ws + WS_WR_T + (size_t)g * (2 * MiB) + (size_t)t * 256 * D * 2); } };
struct DstRKL { unsigned char* ws;
    __device__ __forceinline__ void operator()(const pg8::Unit& u, bf16_t*& base, int& ld) const {
        const int g = u.pn < 4 ? 0 : (u.pn < 8 ? 1 : 2); const int t = u.pn - 4 * g; ld = g == 2 ? NLD : D;
        base = (bf16_t*)(ws + WS_R + (size_t)g * (32 * MiB)) + (size_t)u.pm * 256 * ld + (size_t)t * 256; } };

template <int ACT, class Prob, class Dst>
__device__ __forceinline__ void run_gemm(LAS unsigned char* lds, const Prob& P, const Dst& Dd, int Mr, int Nv, int G) {
    pg8::StaticOrder S; S.init(Mr, Nv, G, (int)blockIdx.x);
    pg8::EpiBf16<ACT, Dst> E{Dd};
    pg8::gemm_phase<pg8::EpiBf16<ACT, Dst>, Prob, true, true>(lds, P, S, E);
}

__device__ __forceinline__ void phase_resnorm(const float* base, const bf16_t* TMP, const float* g1, const float* g2, float* hout, bf16_t* XN, int gw, int NGW, int lane) {
    for (int row = gw; row < M; row += NGW) {
        Row16 t, b; row_load_bf16(t, TMP + (size_t)row * D, lane); row_load_f32(b, base + (size_t)row * D, lane);
        row_rmsnorm(t, g1, lane);
#pragma unroll
        for (int j = 0; j < 4; ++j) b.v[j] = b.v[j] + t.v[j];
        row_store_f32(b, hout + (size_t)row * D, lane);
        if (XN) { row_rmsnorm(b, g2, lane); row_store_bf16(b, XN + (size_t)row * D, lane); }
    }
}
template <bool FIRST>
__device__ __forceinline__ void phase_mix(const float* h, const float* g, const float* mup, const float* mun, bf16_t* XN, bf16_t* MA, bf16_t* MB, int gw, int NGW, int lane) {
    for (int row = gw; row < M; row += NGW) {
        const int tt = row & (SEQ - 1);
        Row16 u, up, un;
        row_load_f32(u, h + (size_t)row * D, lane); row_rmsnorm(u, g, lane);
        if (tt > 0) { row_load_f32(up, h + (size_t)(row - 1) * D, lane); row_rmsnorm(up, g, lane); } else {
#pragma unroll
            for (int j = 0; j < 4; ++j) up.v[j] = (f32x4){0.f, 0.f, 0.f, 0.f}; }
        if (tt < SEQ - 1) { row_load_f32(un, h + (size_t)(row + 1) * D, lane); row_rmsnorm(un, g, lane); } else {
#pragma unroll
            for (int j = 0; j < 4; ++j) un.v[j] = (f32x4){0.f, 0.f, 0.f, 0.f}; }
        if (FIRST) row_store_bf16(u, XN + (size_t)row * D, lane);
        constexpr int NC = FIRST ? 2 : 1;
#pragma unroll
        for (int ci = 0; ci < NC; ++ci) { const int c = FIRST ? (ci == 0 ? 0 : 2) : 3;
            Row16 o;
#pragma unroll
            for (int j = 0; j < 4; ++j) { const f32x4 a = ((const f32x4*)(mup + c * D))[lane + 64 * j], b = ((const f32x4*)(mun + c * D))[lane + 64 * j];
                o.v[j] = u.v[j] + (up.v[j] - u.v[j]) * a + (un.v[j] - u.v[j]) * b; }
            row_store_bf16(o, (ci == 0 ? MA : MB) + (size_t)row * D, lane); }
    }
}

__device__ __forceinline__ float dot64_bf16(const float (&q)[64], const bf16_t* kp) {
    float s = 0.f;
#pragma unroll
    for (int i = 0; i < 8; ++i) { const u32x4 w = ((const u32x4*)kp)[i];
        s = fmaf(q[8 * i + 0], bflo(w.x), s); s = fmaf(q[8 * i + 1], bfhi(w.x), s); s = fmaf(q[8 * i + 2], bflo(w.y), s); s = fmaf(q[8 * i + 3], bfhi(w.y), s);
        s = fmaf(q[8 * i + 4], bflo(w.z), s); s = fmaf(q[8 * i + 5], bfhi(w.z), s); s = fmaf(q[8 * i + 6], bflo(w.w), s); s = fmaf(q[8 * i + 7], bfhi(w.w), s); }
    return s;
}
__device__ __forceinline__ void axpy64_bf16(float (&acc)[64], float f, float p, const bf16_t* vp) {
#pragma unroll
    for (int i = 0; i < 8; ++i) { const u32x4 w = ((const u32x4*)vp)[i];
        acc[8 * i + 0] = acc[8 * i + 0] * f + p * bflo(w.x); acc[8 * i + 1] = acc[8 * i + 1] * f + p * bfhi(w.x); acc[8 * i + 2] = acc[8 * i + 2] * f + p * bflo(w.y); acc[8 * i + 3] = acc[8 * i + 3] * f + p * bfhi(w.y);
        acc[8 * i + 4] = acc[8 * i + 4] * f + p * bflo(w.z); acc[8 * i + 5] = acc[8 * i + 5] * f + p * bfhi(w.z); acc[8 * i + 6] = acc[8 * i + 6] * f + p * bflo(w.w); acc[8 * i + 7] = acc[8 * i + 7] * f + p * bfhi(w.w); }
}
__device__ __forceinline__ void phase_attn_naive(const bf16_t* QKV, const float* rel_table, const float* sink, bf16_t* O, int gtid, int NGT) {
    for (int item = gtid; item < M * 16; item += NGT) {
        const int head = item / M, row = item % M, b = row / SEQ, t = row % SEQ;
        const bf16_t* base = QKV + (size_t)b * SEQ * DIN;
        float q[64], acc[64];
        const bool isA = head < 8; const int h = head & 7;
        { const bf16_t* qp = base + (size_t)t * DIN + (isA ? 0 : 1536) + h * 64;
#pragma unroll
          for (int i = 0; i < 8; ++i) { const u32x4 w = ((const u32x4*)qp)[i]; q[8 * i] = bflo(w.x); q[8 * i + 1] = bfhi(w.x); q[8 * i + 2] = bflo(w.y); q[8 * i + 3] = bfhi(w.y); q[8 * i + 4] = bflo(w.z); q[8 * i + 5] = bfhi(w.z); q[8 * i + 6] = bflo(w.w); q[8 * i + 7] = bfhi(w.w); } }
#pragma unroll
        for (int i = 0; i < 64; ++i) acc[i] = 0.f;
        float m, l;
        if (isA) {
            m = -1e30f; l = 0.f;
            for (int br = 0; br < 3; ++br) { const int dil = br == 0 ? 1 : (br == 1 ? 4 : 16);
                for (int d = -64; d <= 64; ++d) { const int pos = t + d * dil; if (pos < 0 || pos >= SEQ) continue;
                    float s = dot64_bf16(q, base + (size_t)pos * DIN + 512 + h * 64) * 0.125f + rel_table[t5_bucket(d * dil) * 16 + h];
                    const float mn = fmaxf(m, s), f = __expf(m - mn), p = __expf(s - mn); l = l * f + p; m = mn;
                    axpy64_bf16(acc, f, p, base + (size_t)pos * DIN + 1024 + h * 64); } }
        } else {
            const int g = h >> 2; m = sink[h]; l = 1.f;
            for (int d = -128; d <= 128; ++d) { const int pos = t + d; if (pos < 0 || pos >= SEQ) continue;
                float s = dot64_bf16(q, base + (size_t)pos * DIN + 2048 + g * 64) * 0.125f + rel_table[t5_bucket(d) * 16 + 8 + h];
                const float mn = fmaxf(m, s), f = __expf(m - mn), p = __expf(s - mn); l = l * f + p; m = mn;
                axpy64_bf16(acc, f, p, base + (size_t)pos * DIN + 2176 + g * 64); }
        }
        const float il = 1.f / l;
        bf16_t* op = O + (size_t)row * D + head * 64;
#pragma unroll
        for (int i = 0; i < 8; ++i) { u32x4 w; w.x = pk2(acc[8 * i] * il, acc[8 * i + 1] * il); w.y = pk2(acc[8 * i + 2] * il, acc[8 * i + 3] * il); w.z = pk2(acc[8 * i + 4] * il, acc[8 * i + 5] * il); w.w = pk2(acc[8 * i + 6] * il, acc[8 * i + 7] * il);
            ((u32x4*)op)[i] = w; }
    }
}

struct ScanPtrs { const bf16_t *R, *Kk, *V, *LDO; bf16_t* Y; const float *w2, *a2, *g2, *w0, *a0, *k_k, *k_a, *r_k, *gn_w, *gn_b; };
__device__ __forceinline__ void phase_scan(LAS unsigned char* lds, const ScanPtrs& P, int G) {
    int tid = threadIdx.x; asm volatile("" : "+v"(tid));
    const int lane = tid & 63, wid = tid >> 6;
    LAS float* w2s = (LAS float*)lds;
    LAS float* a2s = w2s + 64 * 64;
    LAS float* g2s = a2s + 64 * 64;
    LAS float* sr = g2s + 128 * 64;
    LAS float* sk = sr + 1024; LAS float* sv = sk + 1024;
    LAS float* sld = sv + 1024;
    LAS float* sw = sld + 4096; LAS float* sa_ = sw + 1024; LAS float* sg = sa_ + 1024;
    LAS float* skk = sg + 1024; LAS float* sb = skk + 1024; LAS float* skd = sb + 1024;
    LAS float* so = skd + 1024;
    LAS float* srkr = so + 1024;
    for (int unit = blockIdx.x; unit < 256; unit += G) {
        const int b = unit >> 5, h = (unit >> 1) & 15, d = unit & 1, hc = h * 64;
        __syncthreads();
        for (int x = tid; x < 64 * 64; x += NTHREADS) { const int k = x >> 6, c = x & 63; w2s[x] = P.w2[(size_t)(d * 64 + k) * D + hc + c]; a2s[x] = P.a2[(size_t)(d * 64 + k) * D + hc + c]; }
        for (int x = tid; x < 128 * 64; x += NTHREADS) { const int k = x >> 6, c = x & 63; g2s[x] = P.g2[(size_t)(d * 128 + k) * D + hc + c]; }
        float st[16];
#pragma unroll
        for (int e = 0; e < 16; ++e) st[e] = 0.f;
        const int si = tid >> 2, sq = tid & 3;
        for (int c = 0; c < SEQ / 16; ++c) {
            __syncthreads();
            for (int x = tid; x < 1024; x += NTHREADS) { const int s = x >> 6, j = x & 63; const int t = d ? (SEQ - 1 - (c * 16 + s)) : (c * 16 + s); const size_t o = (size_t)(b * SEQ + t) * D + hc + j;
                sr[x] = bf2f(P.R[o]); sk[x] = bf2f(P.Kk[o]); sv[x] = bf2f(P.V[o]); }
            for (int x = tid; x < 4096; x += NTHREADS) { const int s = x >> 8, n = x & 255; const int t = d ? (SEQ - 1 - (c * 16 + s)) : (c * 16 + s); const size_t row = (size_t)(b * SEQ + t);
                const int col = n < 64 ? (d * 64 + n) : (n < 128 ? (128 + d * 64 + (n - 64)) : (256 + d * 128 + (n - 128)));
                float v = bf2f(P.LDO[row * NLD + col]);
                if (t > 0) v += bf2f(P.LDO[(row - 1) * NLD + 512 + col]);
                if (t < SEQ - 1) v += bf2f(P.LDO[(row + 1) * NLD + 1024 + col]);
                if (n < 64) v = tanhf(v); else if (n >= 128) v = sigmoidf_(v);
                sld[x] = v; }
            __syncthreads();
            { const int s = tid >> 5, ch = 2 * (tid & 31);
              float zw0 = 0.f, zw1 = 0.f, za0 = 0.f, za1 = 0.f, gg0 = 0.f, gg1 = 0.f;
              for (int k = 0; k < 64; ++k) { const float lw = sld[s * 256 + k], la = sld[s * 256 + 64 + k];
                  const f32x2 w = *(const LAS f32x2*)(w2s + k * 64 + ch), a = *(const LAS f32x2*)(a2s + k * 64 + ch);
                  zw0 = fmaf(lw, w.x, zw0); zw1 = fmaf(lw, w.y, zw1); za0 = fmaf(la, a.x, za0); za1 = fmaf(la, a.y, za1); }
              for (int k = 0; k < 128; ++k) { const float lg = sld[s * 256 + 128 + k]; const f32x2 g = *(const LAS f32x2*)(g2s + k * 64 + ch); gg0 = fmaf(lg, g.x, gg0); gg1 = fmaf(lg, g.y, gg1); }
              const float w00 = P.w0[d * D + hc + ch], w01 = P.w0[d * D + hc + ch + 1], a00 = P.a0[d * D + hc + ch], a01 = P.a0[d * D + hc + ch + 1];
              sw[s * 64 + ch] = __expf(-0.6065306597f * sigmoidf_(w00 + zw0)); sw[s * 64 + ch + 1] = __expf(-0.6065306597f * sigmoidf_(w01 + zw1));
              sa_[s * 64 + ch] = sigmoidf_(a00 + za0); sa_[s * 64 + ch + 1] = sigmoidf_(a01 + za1);
              sg[s * 64 + ch] = gg0; sg[s * 64 + ch + 1] = gg1; }
            __syncthreads();
#pragma unroll
            for (int q2 = 0; q2 < 2; ++q2) { const int s = 2 * wid + q2;
                const float k = sk[s * 64 + lane]; float kk = k * P.k_k[hc + lane];
                const float nrm = sqrtf(wave_sum(kk * kk)); kk = kk / fmaxf(nrm, 1e-12f);
                const float a = sa_[s * 64 + lane]; const float kd = k * (1.f + (a - 1.f) * P.k_a[hc + lane]);
                skk[s * 64 + lane] = kk; sb[s * 64 + lane] = kk * a; skd[s * 64 + lane] = kd;
                const float rkr = wave_sum(sr[s * 64 + lane] * kd * P.r_k[hc + lane]);
                if (lane == 0) srkr[s] = rkr; }
            __syncthreads();
            if (tid < 256) {
                for (int s = 0; s < 16; ++s) {
                    float sa = 0.f;
#pragma unroll
                    for (int e = 0; e < 16; ++e) sa = fmaf(st[e], skk[s * 64 + sq * 16 + e], sa);
                    sa += __shfl_xor(sa, 1); sa += __shfl_xor(sa, 2);
                    sa = -sa;
                    const float vi = sv[s * 64 + si];
                    float o = 0.f;
#pragma unroll
                    for (int e = 0; e < 16; ++e) { const int j = s * 64 + sq * 16 + e;
                        st[e] = st[e] * sw[j] + sa * sb[j] + vi * skd[j];
                        o = fmaf(st[e], sr[j], o); }
                    o += __shfl_xor(o, 1); o += __shfl_xor(o, 2);
                    if (sq == 0) so[s * 64 + si] = o;
                }
            }
            __syncthreads();
#pragma unroll
            for (int q2 = 0; q2 < 2; ++q2) { const int s = 2 * wid + q2; const int t = d ? (SEQ - 1 - (c * 16 + s)) : (c * 16 + s);
                const float o = so[s * 64 + lane]; const float mu = wave_sum(o) * (1.f / 64.f); const float dv = o - mu; const float var = wave_sum(dv * dv) * (1.f / 64.f);
                const float gn = dv * rsqrtf(var + GN_EPS) * P.gn_w[hc + lane] + P.gn_b[hc + lane];
                const float y = (gn + srkr[s] * sv[s * 64 + lane]) * sg[s * 64 + lane];
                P.Y[(size_t)(b * SEQ + t) * (2 * D) + d * D + hc + lane] = (bf16_t)f2bf(y); }
        }
    }
}

__global__ void __launch_bounds__(NTHREADS, 2) fwd_megakernel(Args args) {
    extern __shared__ __attribute__((aligned(16))) unsigned char lds_raw[];
    LAS unsigned char* lds = (LAS unsigned char*)lds_raw;
    volatile LAS unsigned* MISC = (volatile LAS unsigned*)(lds + MISC_OFF);
    const int tid0 = threadIdx.x, wave = __builtin_amdgcn_readfirstlane(tid0 >> 6);
#define FRESH_LANE() int tid = tid0; asm volatile("" : "+v"(tid)); const int lane = tid & 63; (void)lane
    const int G = gridDim.x;
    const int vcu = (G % 8 == 0) ? ((int)blockIdx.x % 8) * (G / 8) + (int)blockIdx.x / 8 : (int)blockIdx.x;
    const int gw = vcu * NWAVES + wave, NGW = G * NWAVES;
    unsigned char* ws = args.ws;
    unsigned* ctl = (unsigned*)(ws + WS_CTL);
    for (int u = tid0; u < (LDS_BYTES - LDSCTL_OFF) / 4; u += NTHREADS) ((LAS unsigned*)(lds + LDSCTL_OFF))[u] = 0u;
    __syncthreads();
    XcdBarrier bar = xcd_barrier_post(ctl + CW_BAR, MISC + 8);
#define GRID_BAR() xcd_barrier(bar)

    const float* x = args.in[0]; const float* rel_table = args.in[1]; const float* norm_g = args.in[2]; const float* attn_w_in = args.in[3]; const float* attn_sink = args.in[4];
    const float* attn_w_out = args.in[5]; const float* mu_prev = args.in[6]; const float* mu_next = args.in[7]; const float* w_r = args.in[8]; const float* w_k = args.in[9];
    const float* w_v = args.in[10]; const float* w_o = args.in[11]; const float* mlp_w1 = args.in[25]; const float* mlp_w2 = args.in[26];
    float* hbuf = args.out;
    bf16_t* XN = (bf16_t*)(ws + WS_XN); bf16_t* QKV = (bf16_t*)(ws + WS_QKV); bf16_t* Ob = (bf16_t*)(ws + WS_O); bf16_t* TMP = (bf16_t*)(ws + WS_TMP); bf16_t* Hb = (bf16_t*)(ws + WS_H);
    bf16_t* MIXA = (bf16_t*)(ws + WS_MIXA); bf16_t* MIXB = (bf16_t*)(ws + WS_MIXB); bf16_t* Rb = (bf16_t*)(ws + WS_R); bf16_t* Kb = (bf16_t*)(ws + WS_K); bf16_t* Vb = (bf16_t*)(ws + WS_V);
    bf16_t* LDO = (bf16_t*)(ws + WS_LDO); bf16_t* Yb = (bf16_t*)(ws + WS_Y);
    LAS float* scr = (LAS float*)(lds + wave * 16384);

    {
        FRESH_LANE();
        constexpr int I_IN = (D / 64) * (DIN / 32), I_OUT = (D / 64) * (D / 32), I_1 = (D / 64) * (DFF / 32), I_2 = (DFF / 64) * (D / 32);
        for (int it = gw; it < I_IN + I_OUT + I_1 + I_2; it += NGW) { int r = it;
            if (r < I_IN) { transpose_item(attn_w_in, DIN, DIN, (bf16_t*)(ws + WS_WIN_T), D, 0, 0, scr, r, lane, ScaleOne{}); continue; } r -= I_IN;
            if (r < I_OUT) { transpose_item(attn_w_out, D, D, (bf16_t*)(ws + WS_WOUT_T), D, 0, 0, scr, r, lane, ScaleOne{}); continue; } r -= I_OUT;
            if (r < I_1) { transpose_item(mlp_w1, DFF, DFF, (bf16_t*)(ws + WS_W1_T), D, 0, 0, scr, r, lane, ScaleOne{}); continue; } r -= I_1;
            transpose_item(mlp_w2, D, D, (bf16_t*)(ws + WS_W2_T), DFF, 0, 0, scr, r, lane, ScaleOne{}); }
        for (int row = gw; row < M; row += NGW) { Row16 r; row_load_f32(r, x + (size_t)row * D, lane); row_rmsnorm(r, norm_g, lane); row_store_bf16(r, XN + (size_t)row * D, lane); }
    }
    GRID_BAR();
    run_gemm<0>(lds, ProbPlain{XN, (const bf16_t*)(ws + WS_WIN_T), D}, DstPlain{QKV, DIN}, M, DIN, G);
    GRID_BAR();
    { FRESH_LANE(); phase_attn_naive(QKV, rel_table, attn_sink, Ob, vcu * NTHREADS + tid, G * NTHREADS); }
    GRID_BAR();
    run_gemm<0>(lds, ProbPlain{Ob, (const bf16_t*)(ws + WS_WOUT_T), D}, DstPlain{TMP, D}, M, D, G);
    GRID_BAR();
    { FRESH_LANE(); phase_resnorm(x, TMP, norm_g + D, norm_g + 2 * D, hbuf, XN, gw, NGW, lane); }
    GRID_BAR();
    run_gemm<1>(lds, ProbPlain{XN, (const bf16_t*)(ws + WS_W1_T), D}, DstPlain{Hb, DFF}, M, DFF, G);
    GRID_BAR();
    run_gemm<0>(lds, ProbPlain{Hb, (const bf16_t*)(ws + WS_W2_T), DFF}, DstPlain{TMP, D}, M, D, G);
    GRID_BAR();
    { FRESH_LANE(); phase_resnorm(hbuf, TMP, norm_g + 3 * D, nullptr, hbuf, nullptr, gw, NGW, lane); }
    GRID_BAR();
    {
        FRESH_LANE();
        const float* g1n = norm_g + 4 * D;
        constexpr int I_SQ = (D / 64) * (D / 32), I_1 = (D / 64) * (DFF / 32), I_2 = (DFF / 64) * (D / 32), I_LD = 768;
        for (int it = gw; it < 5 * I_SQ + I_1 + I_2 + I_LD; it += NGW) { int r = it;
            if (r < I_SQ) { transpose_item(w_r, D, D, (bf16_t*)(ws + WS_WR_T), D, 0, 0, scr, r, lane, ScaleOne{}); continue; } r -= I_SQ;
            if (r < I_SQ) { transpose_item(w_k, D, D, (bf16_t*)(ws + WS_WK_T), D, 0, 0, scr, r, lane, ScaleOne{}); continue; } r -= I_SQ;
            if (r < I_SQ) { transpose_item(w_v, D, D, (bf16_t*)(ws + WS_WV_T), D, 0, 0, scr, r, lane, ScaleOne{}); continue; } r -= I_SQ;
            if (r < I_SQ) { transpose_item(w_o, D, D, (bf16_t*)(ws + WS_WO2_T), 2 * D, 0, 0, scr, r, lane, ScaleOne{}); continue; } r -= I_SQ;
            if (r < I_SQ) { transpose_item(w_o, D, D, (bf16_t*)(ws + WS_WO2_T), 2 * D, 0, D, scr, r, lane, ScaleOne{}); continue; } r -= I_SQ;
            if (r < I_1) { transpose_item(mlp_w1 + (size_t)D * DFF, DFF, DFF, (bf16_t*)(ws + WS_W1B_T), D, 0, 0, scr, r, lane, ScaleOne{}); continue; } r -= I_1;
            if (r < I_2) { transpose_item(mlp_w2 + (size_t)DFF * D, D, D, (bf16_t*)(ws + WS_W2B_T), DFF, 0, 0, scr, r, lane, ScaleOne{}); continue; } r -= I_2;
            const int part = r / 256; int q = r % 256; int sub, li;
            if (q < 128) { sub = q / 32; li = q % 32; } else { sub = 4 + (q - 128) / 64; li = (q - 128) % 64; }
            const int dd = sub & 1, kind = sub >> 1;
            const int stream = kind == 0 ? 1 : (kind == 1 ? 4 : 5), Nn = kind == 2 ? 128 : 64;
            const float* src = kind == 0 ? args.in[18] + (size_t)dd * D * 64 : (kind == 1 ? args.in[21] + (size_t)dd * D * 64 : args.in[23] + (size_t)dd * D * 128);
            const int coloff = kind == 0 ? dd * 64 : (kind == 1 ? 128 + dd * 64 : 256 + dd * 128);
            transpose_item(src, Nn, Nn, (bf16_t*)(ws + WS_LDW_T), D, part * 512 + coloff, 0, scr, li, lane, ScaleMix{mu_prev + stream * D, mu_next + stream * D, part}); }
        phase_mix<true>(hbuf, g1n, mu_prev, mu_next, XN, MIXA, MIXB, gw, NGW, lane);
    }
    GRID_BAR();
    run_gemm<0>(lds, ProbRKL{ws, D}, DstRKL{ws}, M, 14 * 256, G);
    GRID_BAR();
    { FRESH_LANE(); phase_mix<false>(hbuf, norm_g + 4 * D, mu_prev, mu_next, nullptr, MIXA, nullptr, gw, NGW, lane); }
    GRID_BAR();
    run_gemm<0>(lds, ProbPlain{MIXA, (const bf16_t*)(ws + WS_WV_T), D}, DstPlain{Vb, D}, M, D, G);
    GRID_BAR();
    { ScanPtrs sp{Rb, Kb, Vb, LDO, Yb, args.in[19], args.in[22], args.in[24], args.in[17], args.in[20], args.in[12], args.in[13], args.in[14], args.in[15], args.in[16]};
      phase_scan(lds, sp, G); }
    GRID_BAR();
    run_gemm<0>(lds, ProbPlain{Yb, (const bf16_t*)(ws + WS_WO2_T), 2 * D}, DstPlain{TMP, D}, M, D, G);
    GRID_BAR();
    { FRESH_LANE(); phase_resnorm(hbuf, TMP, norm_g + 5 * D, norm_g + 6 * D, hbuf, XN, gw, NGW, lane); }
    GRID_BAR();
    run_gemm<1>(lds, ProbPlain{XN, (const bf16_t*)(ws + WS_W1B_T), D}, DstPlain{Hb, DFF}, M, DFF, G);
    GRID_BAR();
    run_gemm<0>(lds, ProbPlain{Hb, (const bf16_t*)(ws + WS_W2B_T), DFF}, DstPlain{TMP, D}, M, D, G);
    GRID_BAR();
    { FRESH_LANE(); phase_resnorm(hbuf, TMP, norm_g + 7 * D, nullptr, hbuf, nullptr, gw, NGW, lane); }
#undef GRID_BAR
}

extern "C" void kernel_launch(void* const* d_in, const int* in_sizes, int n_in, void* d_out, int out_size, void* d_ws, size_t ws_size, hipStream_t stream) {
    static int grid = 0;
    if (grid == 0) {
        if (n_in != 27 || in_sizes[0] != M * D || out_size != M * D || ws_size < WS_END) { fprintf(stderr, "kernel_launch: unexpected shapes (n_in %d, in0 %d, out %d, ws %zu)\n", n_in, n_in > 0 ? in_sizes[0] : -1, out_size, ws_size); grid = -1; return; }
        int dev = 0, cus = 0, per_cu = 0;
        if (hipGetDevice(&dev) != hipSuccess || hipDeviceGetAttribute(&cus, hipDeviceAttributeMultiprocessorCount, dev) != hipSuccess) { grid = -1; return; }
        if (hipFuncSetAttribute((const void*)fwd_megakernel, hipFuncAttributeMaxDynamicSharedMemorySize, LDS_BYTES) != hipSuccess) { fprintf(stderr, "kernel_launch: hipFuncSetAttribute failed\n"); grid = -1; return; }
        if (hipOccupancyMaxActiveBlocksPerMultiprocessor(&per_cu, (const void*)fwd_megakernel, NTHREADS, LDS_BYTES) != hipSuccess || per_cu < 1) { fprintf(stderr, "kernel_launch: occupancy query says %d blocks/CU\n", per_cu); (void)hipGetLastError(); grid = -1; return; }
        grid = cus;
    }
    if (grid < 0) return;
    (void)hipMemsetAsync((char*)d_ws + WS_CTL, 0, CTL_ZERO_BYTES, stream);
    Args a{};
    for (int i = 0; i < 27; ++i) a.in[i] = (const float*)d_in[i];
    a.out = (float*)d_out; a.ws = (unsigned char*)d_ws;
    hipLaunchKernelGGL(fwd_megakernel, dim3(grid), dim3(NTHREADS), LDS_BYTES, stream, a);
}
```

```cpp
#include <hip/hip_runtime.h>
#include <cstdio>
#include <cstdint>

#define LAS __attribute__((address_space(3)))
#define GAS __attribute__((address_space(1)))
typedef unsigned short bf16_t;
typedef short bf16x8 __attribute__((ext_vector_type(8)));
typedef float f32x4 __attribute__((ext_vector_type(4)));
typedef float f32x2 __attribute__((ext_vector_type(2)));
typedef unsigned u32x4 __attribute__((ext_vector_type(4)));
typedef unsigned u32x2 __attribute__((ext_vector_type(2)));

#ifndef REP_SCAN
#define REP_SCAN 1
#endif
#ifndef REP_ATT
#define REP_ATT 1
#endif
#ifndef REP_GEMM
#define REP_GEMM 1
#endif
constexpr int SEQ = 2048, D = 1024, NBATCH = 8, M = NBATCH * SEQ, DFF = 4096, DIN = 2304, NLD = 1536;
constexpr float NORM_EPS = 1e-6f, GN_EPS = 64e-5f;
constexpr int NWAVES = 8, NTHREADS = 512;

namespace pg8 {
constexpr int BM = 256, BK = 64, HALF = 128, HTB = HALF * BK * 2, STAGE_BYTES = 8 * HTB, NXCD = 8, WGM = 8;
__host__ __device__ __forceinline__ int lds_byte(int r, int c) { const int st = (r >> 4) * 2 + (c >> 5), rr = r & 15, cc = c & 31, ob = rr * 64 + cc * 2; return st * 1024 + (ob ^ (((ob >> 9) & 1) << 5)); }
__host__ __device__ __forceinline__ void stage_rc(int b, int& R, int& C) { const int st = b / 1024, sb = b % 1024, swz = sb ^ (((sb >> 9) & 1) << 5); R = (st >> 1) * 16 + swz / 64; C = (st & 1) * 32 + (swz % 64) / 2; }
__host__ __device__ __forceinline__ int perm32(int rho) { const int n = rho >> 4, i = rho & 15; return 8 * (i >> 2) + 4 * n + (i & 3); }

struct Unit { int pm, pn; };
struct StaticOrder {
    int nM, nN, nwg, G, c;
    __host__ __device__ void init(int Mr, int N, int G_, int c_) { nM = Mr / BM; nN = N / BM; nwg = nM * nN; G = G_; c = c_; }
    __host__ __device__ bool next(int i, Unit& u) const {
        const long L = (long)i * G + c; if (L >= nwg) return false;
        int wgid = (int)L; { const int q = nwg / NXCD, r = nwg % NXCD, xcd = wgid % NXCD, off = wgid / NXCD; wgid = (xcd < r ? xcd * (q + 1) : r * (q + 1) + (xcd - r) * q) + off; }
        const int nig = WGM * nN, gid = wgid / nig, fm = gid * WGM, gsz = (nM - fm) < WGM ? (nM - fm) : WGM;
        u.pm = fm + ((wgid % nig) % gsz); u.pn = (wgid % nig) / gsz; return true;
    }
};
__device__ __forceinline__ unsigned cvt_pk_bf16(float lo, float hi) { unsigned r; asm volatile("v_cvt_pk_bf16_f32 %0, %1, %2" : "=v"(r) : "v"(lo), "v"(hi)); return r; }

template <int ACT, class DstFn> struct EpiBf16 {
    static constexpr bool PERM = true;
    DstFn F;
    __device__ __forceinline__ void operator()(const f32x4 (&acc)[2][2][4][2], const Unit& u, int wr, int wc, int fr, int fq) const {
        bf16_t* base; int ldc; F(u, base, ldc);
        const int row0 = wr * 64 + fr, col0 = wc * 32 + 8 * fq;
#pragma unroll
        for (int ai = 0; ai < 2; ++ai)
#pragma unroll
            for (int m = 0; m < 4; ++m) { bf16_t* rowp = base + (size_t)(row0 + ai * HALF + m * 16) * ldc + col0;
#pragma unroll
                for (int bj = 0; bj < 2; ++bj) { f32x4 v0 = acc[ai][bj][m][0], v1 = acc[ai][bj][m][1];
                    if (ACT == 1) {
#pragma unroll
                        for (int e = 0; e < 4; ++e) { const float a = fmaxf(v0[e], 0.f), b = fmaxf(v1[e], 0.f); v0[e] = a * a; v1[e] = b * b; } }
                    u32x4 w; w.x = cvt_pk_bf16(v0[0], v0[1]); w.y = cvt_pk_bf16(v0[2], v0[3]); w.z = cvt_pk_bf16(v1[0], v1[1]); w.w = cvt_pk_bf16(v1[2], v1[3]);
                    *(u32x4*)(rowp + bj * HALF) = w; } }
    }
};

template <class Epi, class Prob, bool ALIGN_EPI, bool SP2>
__device__ __forceinline__ void gemm_phase(LAS unsigned char* lds, const Prob& P, const StaticOrder& S, const Epi& E) {
    int tid = threadIdx.x; asm volatile("" : "+v"(tid));
    const int wid = __builtin_amdgcn_readfirstlane(tid >> 6), lane = tid & 63, wr = wid >> 2, wc = wid & 3, fr = lane & 15, fq = lane >> 4;
    const int K = P.K, nt = K / BK;
    unsigned voffA[2], voffB[2];
#pragma unroll
    for (int i = 0; i < 2; ++i) { int R, C; stage_rc(tid * 16 + i * 8192, R, C); const int Rb = Epi::PERM ? ((R & ~31) + perm32(R & 31)) : R;
        voffA[i] = (unsigned)(R * K + C) * 2u; voffB[i] = (unsigned)(Rb * K + C) * 2u; }
    const size_t kstep = (size_t)(BK * 2);
    const size_t hstep = (size_t)HALF * K * 2;
    const unsigned ldsw = (unsigned)wid * 1024u;
    const int aoff = lds_byte(wr * 64 + fr, fq * 8), boff = lds_byte(wc * 32 + fr, fq * 8);
#define PG8_SA(b, h) (((b) * 2 + (h)) * HTB)
#define PG8_SB(b, h) ((4 + (b) * 2 + (h)) * HTB)
#define PG8_STAGE(bufoff, gbase, voff) do { _Pragma("unroll") for (int _i = 0; _i < 2; ++_i) \
        __builtin_amdgcn_global_load_lds((const unsigned*)((const char*)(gbase) + (voff)[_i]), (LAS unsigned*)(lds + (bufoff) + ldsw + _i * 8192), 16, 0, 0); } while (0)
#define PG8_LDA(dst, b, h) do { _Pragma("unroll") for (int m = 0; m < 4; ++m) _Pragma("unroll") for (int k = 0; k < 2; ++k) dst[m][k] = *(const LAS bf16x8*)(lds + PG8_SA(b, h) + aoff + m * 2048 + k * 1024); } while (0)
#define PG8_LDB(dst, b, h) do { _Pragma("unroll") for (int n = 0; n < 2; ++n) _Pragma("unroll") for (int k = 0; k < 2; ++k) dst[n][k] = *(const LAS bf16x8*)(lds + PG8_SB(b, h) + boff + n * 2048 + k * 1024); } while (0)
#define PG8_MMA(ai, bj, At, Bt) do { __builtin_amdgcn_s_setprio(1); _Pragma("unroll") for (int m = 0; m < 4; ++m) _Pragma("unroll") for (int n = 0; n < 2; ++n) _Pragma("unroll") for (int k = 0; k < 2; ++k) \
        acc[ai][bj][m][n] = __builtin_amdgcn_mfma_f32_16x16x32_bf16(Bt[n][k], At[m][k], acc[ai][bj][m][n], 0, 0, 0); __builtin_amdgcn_s_setprio(0); } while (0)
#define PG8_WAIT_V(n) asm volatile("s_waitcnt vmcnt(" #n ")" ::: "memory")
#define PG8_WAIT_L(n) asm volatile("s_waitcnt lgkmcnt(" #n ")" ::: "memory")
#define PG8_BAR __builtin_amdgcn_s_barrier()
#define PG8_SCHED __builtin_amdgcn_sched_barrier(0)
    Unit cur, nxt; int ui = 0;
    if (!S.next(0, cur)) return;
    f32x4 acc[2][2][4][2];
#pragma unroll
    for (int a = 0; a < 2; ++a)
#pragma unroll
        for (int b = 0; b < 2; ++b)
#pragma unroll
            for (int m = 0; m < 4; ++m)
#pragma unroll
                for (int n = 0; n < 2; ++n) acc[a][b][m][n] = (f32x4){0.f, 0.f, 0.f, 0.f};
    bf16x8 At[4][2], B0[2][2], B1[2][2];
    const char* cA = P.a_tile(cur); const char* cB = P.b_tile(cur);
    if constexpr (SP2) {
        PG8_STAGE(PG8_SB(0, 0), cB, voffB); PG8_STAGE(PG8_SB(0, 1), cB + hstep, voffB); PG8_STAGE(PG8_SA(0, 0), cA, voffA); PG8_STAGE(PG8_SA(0, 1), cA + hstep, voffA);
        if (wr == 1) PG8_BAR;
        PG8_WAIT_V(2); PG8_BAR;
        PG8_STAGE(PG8_SB(1, 0), cB + kstep, voffB); PG8_STAGE(PG8_SA(1, 0), cA + kstep, voffA); PG8_STAGE(PG8_SB(1, 1), cB + hstep + kstep, voffB);
        PG8_WAIT_V(6); PG8_BAR;
    } else {
        PG8_STAGE(PG8_SB(0, 0), cB, voffB); PG8_STAGE(PG8_SA(0, 0), cA, voffA); PG8_STAGE(PG8_SB(0, 1), cB + hstep, voffB); PG8_STAGE(PG8_SA(0, 1), cA + hstep, voffA);
        if (wr == 1) PG8_BAR;
        PG8_WAIT_V(4); PG8_BAR;
        PG8_STAGE(PG8_SB(1, 0), cB + kstep, voffB); PG8_STAGE(PG8_SA(1, 0), cA + kstep, voffA); PG8_STAGE(PG8_SB(1, 1), cB + hstep + kstep, voffB);
        PG8_WAIT_V(6); PG8_BAR;
    }
    for (;;) {
        const bool has_next = S.next(ui + 1, nxt);
        const char* nA = has_next ? P.a_tile(nxt) : cA; const char* nB = has_next ? P.b_tile(nxt) : cB;
        for (int t = 0; t < nt; t += 2) {
            const bool last = (t == nt - 2);
            const char* a1 = cA + (size_t)(t + 1) * kstep;
            const char* a2 = last ? nA : cA + (size_t)(t + 2) * kstep; const char* b2 = last ? nB : cB + (size_t)(t + 2) * kstep;
            const char* a3 = a2 + kstep; const char* b3 = b2 + kstep;
            if constexpr (SP2) {
            PG8_LDB(B0, 0, 0); PG8_LDB(B1, 0, 1); PG8_SCHED; PG8_LDA(At, 0, 0); PG8_STAGE(PG8_SA(1, 1), a1 + hstep, voffA);
            PG8_WAIT_V(8); PG8_WAIT_L(0); PG8_BAR; PG8_MMA(0, 0, At, B0); PG8_MMA(0, 1, At, B1); PG8_BAR; PG8_SCHED;
            PG8_LDA(At, 0, 1); PG8_STAGE(PG8_SB(0, 0), b2, voffB); PG8_STAGE(PG8_SB(0, 1), b2 + hstep, voffB); PG8_STAGE(PG8_SA(0, 0), a2, voffA);
            PG8_WAIT_V(8); PG8_WAIT_L(0); PG8_BAR; PG8_MMA(1, 0, At, B0); PG8_MMA(1, 1, At, B1); PG8_BAR; PG8_SCHED;
            PG8_LDB(B0, 1, 0); PG8_LDB(B1, 1, 1); PG8_SCHED; PG8_LDA(At, 1, 0); PG8_STAGE(PG8_SA(0, 1), a2 + hstep, voffA);
            PG8_WAIT_V(8); PG8_WAIT_L(0); PG8_BAR; PG8_MMA(0, 0, At, B0); PG8_MMA(0, 1, At, B1); PG8_BAR; PG8_SCHED;
            PG8_LDA(At, 1, 1); PG8_STAGE(PG8_SB(1, 0), b3, voffB); PG8_STAGE(PG8_SB(1, 1), b3 + hstep, voffB); PG8_STAGE(PG8_SA(1, 0), a3, voffA);
            PG8_WAIT_V(8); PG8_WAIT_L(0); PG8_BAR; PG8_MMA(1, 0, At, B0); PG8_MMA(1, 1, At, B1); PG8_BAR; PG8_SCHED;
            } else {
            PG8_LDB(B0, 0, 0); PG8_SCHED; PG8_LDA(At, 0, 0); PG8_STAGE(PG8_SA(1, 1), a1 + hstep, voffA);
            PG8_WAIT_L(8); PG8_BAR; PG8_WAIT_L(0); PG8_MMA(0, 0, At, B0); PG8_BAR; PG8_SCHED;
            PG8_LDB(B1, 0, 1); PG8_STAGE(PG8_SB(0, 0), b2, voffB);
            PG8_BAR; PG8_WAIT_L(0); PG8_MMA(0, 1, At, B1); PG8_BAR;
            PG8_LDA(At, 0, 1); PG8_STAGE(PG8_SA(0, 0), a2, voffA);
            PG8_BAR; PG8_WAIT_L(0); PG8_MMA(1, 0, At, B0); PG8_BAR; PG8_SCHED;
            PG8_STAGE(PG8_SB(0, 1), b2 + hstep, voffB);
            PG8_WAIT_V(6); PG8_BAR; PG8_MMA(1, 1, At, B1); PG8_BAR;
            PG8_LDB(B0, 1, 0); PG8_SCHED; PG8_LDA(At, 1, 0); PG8_STAGE(PG8_SA(0, 1), a2 + hstep, voffA);
            PG8_WAIT_L(8); PG8_BAR; PG8_WAIT_L(0); PG8_MMA(0, 0, At, B0); PG8_BAR; PG8_SCHED;
            PG8_LDB(B1, 1, 1); PG8_STAGE(PG8_SB(1, 0), b3, voffB);
            PG8_BAR; PG8_WAIT_L(0); PG8_MMA(0, 1, At, B1); PG8_BAR;
            PG8_LDA(At, 1, 1); PG8_STAGE(PG8_SA(1, 0), a3, voffA);
            PG8_BAR; PG8_WAIT_L(0); PG8_MMA(1, 0, At, B0); PG8_BAR; PG8_SCHED;
            PG8_STAGE(PG8_SB(1, 1), b3 + hstep, voffB);
            PG8_WAIT_V(6); PG8_BAR; PG8_MMA(1, 1, At, B1); PG8_BAR;
            }
        }
        if constexpr (ALIGN_EPI) { if (wr == 0) PG8_BAR; }
        E(acc, cur, wr, wc, fr, fq);
        if (!has_next) break;
#pragma unroll
        for (int a = 0; a < 2; ++a)
#pragma unroll
            for (int b = 0; b < 2; ++b)
#pragma unroll
                for (int m = 0; m < 4; ++m)
#pragma unroll
                    for (int n = 0; n < 2; ++n) acc[a][b][m][n] = (f32x4){0.f, 0.f, 0.f, 0.f};
        cur = nxt; cA = nA; cB = nB; ++ui;
        if constexpr (ALIGN_EPI) { if (wr == 1) PG8_BAR; }
    }
    PG8_WAIT_V(0);
    if constexpr (!ALIGN_EPI) { if (wr == 0) PG8_BAR; }
    PG8_BAR;
#undef PG8_SA
#undef PG8_SB
#undef PG8_STAGE
#undef PG8_LDA
#undef PG8_LDB
#undef PG8_MMA
#undef PG8_WAIT_V
#undef PG8_WAIT_L
#undef PG8_BAR
#undef PG8_SCHED
}
}

constexpr size_t MiB = 1u << 20;
constexpr size_t WS_CTL = 0, CTL_ZERO_BYTES = 64 * 1024;
constexpr size_t WS_W = 1 * MiB;
constexpr size_t WS_WIN_T = WS_W, WS_WOUT_T = WS_WIN_T + (size_t)DIN * D * 2, WS_W1_T = WS_WOUT_T + (size_t)D * D * 2, WS_W2_T = WS_W1_T + (size_t)DFF * D * 2;
constexpr size_t WS_WR_T = WS_W, WS_WK_T = WS_WR_T + 2 * MiB, WS_LDW_T = WS_WK_T + 2 * MiB, WS_WV_T = WS_LDW_T + 3 * MiB, WS_WO2_T = WS_WV_T + 2 * MiB, WS_W1B_T = WS_WO2_T + 4 * MiB, WS_W2B_T = WS_W1B_T + 8 * MiB;
static_assert(WS_W2_T + (size_t)D * DFF * 2 <= 33 * MiB && WS_W2B_T + (size_t)D * DFF * 2 <= 33 * MiB, "weight region");
constexpr size_t WS_XN = 33 * MiB, WS_QKV = 65 * MiB, WS_O = 137 * MiB, WS_OBR = 169 * MiB, WS_LSE = 217 * MiB, WS_TMP = 219 * MiB, WS_H = 65 * MiB;
constexpr size_t WS_MIXA = 65 * MiB, WS_MIXB = 97 * MiB, WS_R = 129 * MiB, WS_K = 161 * MiB, WS_V = 33 * MiB, WS_LDO = 193 * MiB, WS_Y = 65 * MiB;
constexpr size_t WS_END = 256 * MiB;
static_assert(WS_MIXA == WS_XN + 32 * MiB && WS_MIXB == WS_XN + 64 * MiB && WS_K == WS_R + 32 * MiB && WS_LDO == WS_R + 64 * MiB && WS_WK_T == WS_WR_T + 2 * MiB && WS_LDW_T == WS_WR_T + 4 * MiB, "grouped GEMM strides");
constexpr int CW_BAR = 4096;

constexpr int RING_BYTES = 131072, LDSCTL_OFF = 143360, MISC_OFF = LDSCTL_OFF + 320, LDS_BYTES = 147456;

__device__ __forceinline__ float bf2f(unsigned short b) { return __uint_as_float((unsigned)b << 16); }
__device__ __forceinline__ float bflo(unsigned w) { return __uint_as_float(w << 16); }
__device__ __forceinline__ float bfhi(unsigned w) { return __uint_as_float(w & 0xffff0000u); }
__device__ __forceinline__ unsigned f2bf(float f) { unsigned u = __float_as_uint(f); return (u + 0x7fffu + ((u >> 16) & 1u)) >> 16; }
__device__ __forceinline__ unsigned pk2(float lo, float hi) { return f2bf(lo) | (f2bf(hi) << 16); }
__device__ __forceinline__ float wave_sum(float v) {
#pragma unroll
    for (int o = 1; o < 64; o <<= 1) v += __shfl_xor(v, o);
    return v;
}
__device__ __forceinline__ float sigmoidf_(float z) { return 1.f / (1.f + __expf(-z)); }
__device__ __forceinline__ int t5_bucket(int rel) {
    const int n = rel < 0 ? -rel : rel;
    int large;
    if (n < 8) large = n; else if (n < 15) large = 8; else if (n < 27) large = 9; else if (n < 50) large = 10; else if (n < 91) large = 11;
    else if (n < 166) large = 12; else if (n < 305) large = 13; else if (n < 559) large = 14; else large = 15;
    return (rel > 0 ? 16 : 0) + large;
}

#define XB_TMO      128
#define XB_XCNT(j)  (256  + 64 * (j))
#define XB_XSUB(j)  (1280 + 64 * (j))
#define XB_XGEN(j)  (2304 + 64 * (j))
#define XB_TOP      3328
#define XB_TOPGEN   3392
#define XCD_BAR_WORDS 3456
#define XB_SPIN_CAP (1u << 18)
__device__ __forceinline__ unsigned xb_ld(unsigned* p)              { return __hip_atomic_load(p, __ATOMIC_RELAXED, __HIP_MEMORY_SCOPE_AGENT); }
__device__ __forceinline__ unsigned xb_add(unsigned* p, unsigned v) { return __hip_atomic_fetch_add(p, v, __ATOMIC_RELAXED, __HIP_MEMORY_SCOPE_AGENT); }
__device__ __forceinline__ unsigned xb_xcc_id() { return (unsigned)__builtin_amdgcn_s_getreg((3 << 11) | 20) & 0xFu; }
#define XB_SPIN(cond, bar) do { unsigned _sp = 0; while (cond) { __builtin_amdgcn_s_sleep(1); \
    if ((++_sp & 255u) == 0u) { if (xb_ld(&(bar)[XB_TMO])) break; if (_sp > XB_SPIN_CAP) { atomicAdd(&(bar)[XB_TMO], 1u); break; } } } } while (0)
struct XcdBarrier { unsigned* bar; unsigned x; volatile LAS unsigned* st; };
__device__ __forceinline__ XcdBarrier xcd_barrier_post(unsigned* bar, volatile LAS unsigned* st) {
    XcdBarrier b; b.bar = bar; b.x = xb_xcc_id(); b.st = st;
    if (threadIdx.x == 0) (void)xb_add(&bar[XB_XCNT(b.x)], 1u);
    return b;
}
__device__ __forceinline__ void xcd_barrier_complete(unsigned* bar, unsigned x, unsigned& nloc, unsigned& nx) {
    const unsigned G = gridDim.x * gridDim.y * gridDim.z;
    unsigned sum, cnt, mine, sp = 0u;
    for (;;) {
        sum = 0u; cnt = 0u; mine = 0u;
#pragma unroll
        for (unsigned j = 0; j < 16; ++j) { const unsigned c = xb_ld(&bar[XB_XCNT(j)]); sum += c; cnt += (c > 0u) ? 1u : 0u; mine = (j == x) ? c : mine; }
        if (sum == G) break;
        __builtin_amdgcn_s_sleep(1);
        if ((++sp & 255u) == 0u) { if (xb_ld(&bar[XB_TMO])) break; if (sp > XB_SPIN_CAP) { atomicAdd(&bar[XB_TMO], 1u); break; } }
    }
    nloc = mine > 0u ? mine : 1u; nx = cnt > 0u ? cnt : 1u;
}
__device__ __forceinline__ void xcd_barrier(const XcdBarrier& b) {
    asm volatile("s_waitcnt vmcnt(0)" ::: "memory");
    __syncthreads();
    if (threadIdx.x == 0) {
        unsigned* bar = b.bar;
        __builtin_amdgcn_s_waitcnt(0);
        unsigned nloc = b.st[0], nx = b.st[1];
        if (nloc == 0u) { xcd_barrier_complete(bar, b.x, nloc, nx); b.st[0] = nloc; b.st[1] = nx; }
        const unsigned old = xb_add(&bar[XB_XSUB(b.x)], 1u);
        const unsigned gen = old / nloc;
        if (old + 1u == (gen + 1u) * nloc) {
            __builtin_amdgcn_fence(__ATOMIC_RELEASE, "agent");
            asm volatile("s_waitcnt vmcnt(0)" ::: "memory");
            const unsigned og = xb_add(&bar[XB_TOP], 1u);
            const unsigned tg = og / nx;
            if (og + 1u == (tg + 1u) * nx) xb_add(&bar[XB_TOPGEN], 1u);
            else XB_SPIN(xb_ld(&bar[XB_TOPGEN]) == tg, bar);
            __builtin_amdgcn_fence(__ATOMIC_ACQUIRE, "agent");
            xb_add(&bar[XB_XGEN(b.x)], 1u);
            asm volatile("s_waitcnt vmcnt(0)" ::: "memory");
        } else {
            XB_SPIN(xb_ld(&bar[XB_XGEN(b.x)]) == gen, bar);
            __builtin_amdgcn_fence(__ATOMIC_ACQUIRE, "agent");
            asm volatile("s_waitcnt vmcnt(0)" ::: "memory");
        }
    }
    __syncthreads();
}

struct Row16 { f32x4 v[4]; };
__device__ __forceinline__ void row_load_f32(Row16& r, const float* p, int lane) {
#pragma unroll
    for (int j = 0; j < 4; ++j) r.v[j] = ((const f32x4*)p)[lane + 64 * j];
}
__device__ __forceinline__ void row_load_bf16(Row16& r, const bf16_t* p, int lane) {
#pragma unroll
    for (int j = 0; j < 4; ++j) { const u32x2 w = ((const u32x2*)p)[lane + 64 * j]; r.v[j] = (f32x4){bflo(w.x), bfhi(w.x), bflo(w.y), bfhi(w.y)}; }
}
__device__ __forceinline__ void row_store_f32(const Row16& r, float* p, int lane) {
#pragma unroll
    for (int j = 0; j < 4; ++j) ((f32x4*)p)[lane + 64 * j] = r.v[j];
}
__device__ __forceinline__ void row_store_bf16(const Row16& r, bf16_t* p, int lane) {
#pragma unroll
    for (int j = 0; j < 4; ++j) { u32x2 w; w.x = pk2(r.v[j][0], r.v[j][1]); w.y = pk2(r.v[j][2], r.v[j][3]); ((u32x2*)p)[lane + 64 * j] = w; }
}
__device__ __forceinline__ void row_rmsnorm(Row16& r, const float* g, int lane) {
    float s = 0.f;
#pragma unroll
    for (int j = 0; j < 4; ++j) s += r.v[j][0] * r.v[j][0] + r.v[j][1] * r.v[j][1] + r.v[j][2] * r.v[j][2] + r.v[j][3] * r.v[j][3];
    const float rs = rsqrtf(wave_sum(s) * (1.f / D) + NORM_EPS);
#pragma unroll
    for (int j = 0; j < 4; ++j) { const f32x4 gg = ((const f32x4*)g)[lane + 64 * j]; r.v[j] = r.v[j] * rs * gg; }
}

template <class ScaleFn>
__device__ __forceinline__ void transpose_item(const float* W, int ldw, int N, bf16_t* WT, int ldt, int row_off, int koff, LAS float* scr, int item, int lane, ScaleFn sc) {
    const int nblk = N / 32, kb = item / nblk, nb = item % nblk, k0 = 64 * kb, n0 = 32 * nb;
#pragma unroll 8
    for (int i = 0; i < 32; ++i) { const int kk = 2 * i + (lane >> 5); scr[kk * 33 + (lane & 31)] = W[(size_t)(k0 + kk) * ldw + n0 + (lane & 31)] * sc(k0 + kk); }
    asm volatile("s_waitcnt lgkmcnt(0)" ::: "memory");
    const int c = lane & 7;
#pragma unroll
    for (int j = 0; j < 4; ++j) { const int n = (lane >> 3) + 8 * j; const LAS float* s = scr + (8 * c) * 33 + n;
        u32x4 o; o.x = pk2(s[0 * 33], s[1 * 33]); o.y = pk2(s[2 * 33], s[3 * 33]); o.z = pk2(s[4 * 33], s[5 * 33]); o.w = pk2(s[6 * 33], s[7 * 33]);
        *(u32x4*)(WT + (size_t)(row_off + n0 + n) * ldt + koff + k0 + 8 * c) = o; }
    asm volatile("s_waitcnt lgkmcnt(0)" ::: "memory");
}
struct ScaleOne { __device__ __forceinline__ float operator()(int) const { return 1.f; } };
struct ScaleMix { const float* mp; const float* mn; int part;
    __device__ __forceinline__ float operator()(int k) const { return part == 0 ? 1.f - mp[k] - mn[k] : (part == 1 ? mp[k] : mn[k]); } };

struct Args { const float* in[27]; float* out; unsigned char* ws; };

struct ProbPlain { const bf16_t* A; const bf16_t* Bt; int K;
    __device__ __forceinline__ const char* a_tile(const pg8::Unit& u) const { return (const char*)(A + (size_t)u.pm * 256 * K); }
    __device__ __forceinline__ const char* b_tile(const pg8::Unit& u) const { return (const char*)(Bt + (size_t)u.pn * 256 * K); } };
struct DstPlain { bf16_t* C; int ldc;
    __device__ __forceinline__ void operator()(const pg8::Unit& u, bf16_t*& base, int& ld) const { base = C + (size_t)u.pm * 256 * ldc + (size_t)u.pn * 256; ld = ldc; } };
struct ProbRKL { const unsigned char* ws; int K;
    __device__ __forceinline__ const char* a_tile(const pg8::Unit& u) const { const int g = u.pn < 4 ? 0 : (u.pn < 8 ? 1 : 2); const int ga = g == 2 ? 0 : g + 1;
        return (const char*)(ws + WS_XN + (size_t)ga * (32 * MiB) + (size_t)u.pm * 256 * D * 2); }
    __device__ __forceinline__ const char* b_tile(const pg8::Unit& u) const { const int g = u.pn < 4 ? 0 : (u.pn < 8 ? 1 : 2); const int t = u.pn - 4 * g;
        return (const char*)(ws + WS_WR_T + (size_t)g * (2 * MiB) + (size_t)t * 256 * D * 2); } };
struct DstRKL { unsigned char* ws;
    __device__ __forceinline__ void operator()(const pg8::Unit& u, bf16_t*& base, int& ld) const {
        const int g = u.pn < 4 ? 0 : (u.pn < 8 ? 1 : 2); const int t = u.pn - 4 * g; ld = g == 2 ? NLD : D;
        base = (bf16_t*)(ws + WS_R + (size_t)g * (32 * MiB)) + (size_t)u.pm * 256 * ld + (size_t)t * 256; } };

template <int ACT, class Prob, class Dst>
__device__ __forceinline__ void run_gemm(LAS unsigned char* lds, const Prob& P, const Dst& Dd, int Mr, int Nv, int G) {
    pg8::StaticOrder S; S.init(Mr, Nv, G, (int)blockIdx.x);
    pg8::EpiBf16<ACT, Dst> E{Dd};
    for (int rep = 0; rep < REP_GEMM; ++rep) pg8::gemm_phase<pg8::EpiBf16<ACT, Dst>, Prob, true, true>(lds, P, S, E);
}

__device__ __forceinline__ void phase_resnorm(const float* base, const bf16_t* TMP, const float* g1, const float* g2, float* hout, bf16_t* XN, int gw, int NGW, int lane) {
    for (int row = gw; row < M; row += NGW) {
        Row16 t, b; row_load_bf16(t, TMP + (size_t)row * D, lane); row_load_f32(b, base + (size_t)row * D, lane);
        row_rmsnorm(t, g1, lane);
#pragma unroll
        for (int j = 0; j < 4; ++j) b.v[j] = b.v[j] + t.v[j];
        row_store_f32(b, hout + (size_t)row * D, lane);
        if (XN) { row_rmsnorm(b, g2, lane); row_store_bf16(b, XN + (size_t)row * D, lane); }
    }
}
template <bool FIRST>
__device__ __forceinline__ void phase_mix(const float* h, const float* g, const float* mup, const float* mun, bf16_t* XN, bf16_t* MA, bf16_t* MB, int gw, int NGW, int lane) {
    for (int row = gw; row < M; row += NGW) {
        const int tt = row & (SEQ - 1);
        Row16 u, up, un;
        row_load_f32(u, h + (size_t)row * D, lane); row_rmsnorm(u, g, lane);
        if (tt > 0) { row_load_f32(up, h + (size_t)(row - 1) * D, lane); row_rmsnorm(up, g, lane); } else {
#pragma unroll
            for (int j = 0; j < 4; ++j) up.v[j] = (f32x4){0.f, 0.f, 0.f, 0.f}; }
        if (tt < SEQ - 1) { row_load_f32(un, h + (size_t)(row + 1) * D, lane); row_rmsnorm(un, g, lane); } else {
#pragma unroll
            for (int j = 0; j < 4; ++j) un.v[j] = (f32x4){0.f, 0.f, 0.f, 0.f}; }
        if (FIRST) row_store_bf16(u, XN + (size_t)row * D, lane);
        constexpr int NC = FIRST ? 2 : 1;
#pragma unroll
        for (int ci = 0; ci < NC; ++ci) { const int c = FIRST ? (ci == 0 ? 0 : 2) : 3;
            Row16 o;
#pragma unroll
            for (int j = 0; j < 4; ++j) { const f32x4 a = ((const f32x4*)(mup + c * D))[lane + 64 * j], b = ((const f32x4*)(mun + c * D))[lane + 64 * j];
                o.v[j] = u.v[j] + (up.v[j] - u.v[j]) * a + (un.v[j] - u.v[j]) * b; }
            row_store_bf16(o, (ci == 0 ? MA : MB) + (size_t)row * D, lane); }
    }
}

__device__ __forceinline__ float dot64_bf16(const float (&q)[64], const bf16_t* kp) {
    float s = 0.f;
#pragma unroll
    for (int i = 0; i < 8; ++i) { const u32x4 w = ((const u32x4*)kp)[i];
        s = fmaf(q[8 * i + 0], bflo(w.x), s); s = fmaf(q[8 * i + 1], bfhi(w.x), s); s = fmaf(q[8 * i + 2], bflo(w.y), s); s = fmaf(q[8 * i + 3], bfhi(w.y), s);
        s = fmaf(q[8 * i + 4], bflo(w.z), s); s = fmaf(q[8 * i + 5], bfhi(w.z), s); s = fmaf(q[8 * i + 6], bflo(w.w), s); s = fmaf(q[8 * i + 7], bfhi(w.w), s); }
    return s;
}
__device__ __forceinline__ void axpy64_bf16(float (&acc)[64], float f, float p, const bf16_t* vp) {
#pragma unroll
    for (int i = 0; i < 8; ++i) { const u32x4 w = ((const u32x4*)vp)[i];
        acc[8 * i + 0] = acc[8 * i + 0] * f + p * bflo(w.x); acc[8 * i + 1] = acc[8 * i + 1] * f + p * bfhi(w.x); acc[8 * i + 2] = acc[8 * i + 2] * f + p * bflo(w.y); acc[8 * i + 3] = acc[8 * i + 3] * f + p * bfhi(w.y);
        acc[8 * i + 4] = acc[8 * i + 4] * f + p * bflo(w.z); acc[8 * i + 5] = acc[8 * i + 5] * f + p * bfhi(w.z); acc[8 * i + 6] = acc[8 * i + 6] * f + p * bflo(w.w); acc[8 * i + 7] = acc[8 * i + 7] * f + p * bfhi(w.w); }
}
__device__ __forceinline__ void phase_attn_naive(const bf16_t* QKV, const float* rel_table, const float* sink, bf16_t* O, int gtid, int NGT) {
    for (int item = gtid; item < M * 16; item += NGT) {
        const int head = item / M, row = item % M, b = row / SEQ, t = row % SEQ;
        const bf16_t* base = QKV + (size_t)b * SEQ * DIN;
        float q[64], acc[64];
        const bool isA = head < 8; const int h = head & 7;
        { const bf16_t* qp = base + (size_t)t * DIN + (isA ? 0 : 1536) + h * 64;
#pragma unroll
          for (int i = 0; i < 8; ++i) { const u32x4 w = ((const u32x4*)qp)[i]; q[8 * i] = bflo(w.x); q[8 * i + 1] = bfhi(w.x); q[8 * i + 2] = bflo(w.y); q[8 * i + 3] = bfhi(w.y); q[8 * i + 4] = bflo(w.z); q[8 * i + 5] = bfhi(w.z); q[8 * i + 6] = bflo(w.w); q[8 * i + 7] = bfhi(w.w); } }
#pragma unroll
        for (int i = 0; i < 64; ++i) acc[i] = 0.f;
        float m, l;
        if (isA) {
            m = -1e30f; l = 0.f;
            for (int br = 0; br < 3; ++br) { const int dil = br == 0 ? 1 : (br == 1 ? 4 : 16);
                for (int d = -64; d <= 64; ++d) { const int pos = t + d * dil; if (pos < 0 || pos >= SEQ) continue;
                    float s = dot64_bf16(q, base + (size_t)pos * DIN + 512 + h * 64) * 0.125f + rel_table[t5_bucket(d * dil) * 16 + h];
                    const float mn = fmaxf(m, s), f = __expf(m - mn), p = __expf(s - mn); l = l * f + p; m = mn;
                    axpy64_bf16(acc, f, p, base + (size_t)pos * DIN + 1024 + h * 64); } }
        } else {
            const int g = h >> 2; m = sink[h]; l = 1.f;
            for (int d = -128; d <= 128; ++d) { const int pos = t + d; if (pos < 0 || pos >= SEQ) continue;
                float s = dot64_bf16(q, base + (size_t)pos * DIN + 2048 + g * 64) * 0.125f + rel_table[t5_bucket(d) * 16 + 8 + h];
                const float mn = fmaxf(m, s), f = __expf(m - mn), p = __expf(s - mn); l = l * f + p; m = mn;
                axpy64_bf16(acc, f, p, base + (size_t)pos * DIN + 2176 + g * 64); }
        }
        const float il = 1.f / l;
        bf16_t* op = O + (size_t)row * D + head * 64;
#pragma unroll
        for (int i = 0; i < 8; ++i) { u32x4 w; w.x = pk2(acc[8 * i] * il, acc[8 * i + 1] * il); w.y = pk2(acc[8 * i + 2] * il, acc[8 * i + 3] * il); w.z = pk2(acc[8 * i + 4] * il, acc[8 * i + 5] * il); w.w = pk2(acc[8 * i + 6] * il, acc[8 * i + 7] * il);
            ((u32x4*)op)[i] = w; }
    }
}


constexpr int ATT_ROWS = 400, ATT_KS = 0, ATT_VS = ATT_ROWS * 128, ATT_TAB = 2 * ATT_ROWS * 128, ATT_TABN = 320;
constexpr float LOG2E = 1.4426950408889634f;
typedef short v4i16_t __attribute__((ext_vector_type(4)));
__device__ __forceinline__ v4i16_t lds_tr16(LAS const unsigned char* p) { return __builtin_amdgcn_ds_read_tr16_b64_v4i16((LAS v4i16_t*)p); }

struct AttnIO { const bf16_t* QKV; const float* rel_table; const float* sink; bf16_t* O; bf16_t* OBR; float* LSE; };

__device__ __forceinline__ void phase_attn(LAS unsigned char* lds, const AttnIO& io, int vcu, int G) {
    int tid = threadIdx.x; asm volatile("" : "+v"(tid));
    const int lane = tid & 63, wid = __builtin_amdgcn_readfirstlane(tid >> 6), g4 = lane >> 4, qi = lane & 15;
    LAS unsigned char* Ks = lds + ATT_KS; LAS unsigned char* Vs = lds + ATT_VS; LAS float* tab = (LAS float*)(lds + ATT_TAB);
    for (int u = vcu; u < 256 + 1024 + 1024; u += G) {
        int b, dil, res, l0, nq, L, R, colK, colV, head0, ngroups, nit, branch; bool isB;
        if (u < 256) { isB = true; b = u >> 5; const int kvg = (u >> 4) & 1, blk = u & 15; dil = 1; res = 0; l0 = blk * 128; nq = 128; L = SEQ; R = 128; colK = 2048 + kvg * 64; colV = 2176 + kvg * 64; head0 = kvg * 4; ngroups = 32; nit = 9; branch = 0; }
        else if (u < 1280) { isB = false; const int a = u - 256, bh = a >> 4, k = a & 15; b = bh >> 3; head0 = bh & 7; nq = 256; R = 64; ngroups = 16; nit = 5;
            if (k < 8) { dil = 1; res = 0; l0 = k * 256; L = SEQ; branch = 0; } else { dil = 4; res = (k - 8) >> 1; l0 = ((k - 8) & 1) * 256; L = SEQ / 4; branch = 1; }
            colK = 512 + head0 * 64; colV = 1024 + head0 * 64; }
        else { isB = false; const int a = u - 1280, bh = a >> 4; b = bh >> 3; head0 = bh & 7; dil = 16; res = a & 15; l0 = 0; nq = 128; L = SEQ / 16; R = 64; ngroups = 8; nit = 5; branch = 2; colK = 512 + head0 * 64; colV = 1024 + head0 * 64; }
        const int ndata = nq + 2 * R, rv0 = (R - l0) > 0 ? (R - l0) : 0, rv1 = (L + R - l0) < ndata ? (L + R - l0) : ndata;
        const bf16_t* base = io.QKV + (size_t)b * SEQ * DIN;
        __syncthreads();
        for (int x = tid; x < ATT_ROWS * 8; x += NTHREADS) { const int row = x >> 3, c = x & 7; const int l = l0 - R + row;
            u32x4 kv = (u32x4){0u, 0u, 0u, 0u}, vv = kv;
            if (row >= rv0 && row < rv1) { const bf16_t* rp = base + (size_t)(res + dil * l) * DIN + c * 8; kv = *(const u32x4*)(rp + colK); vv = *(const u32x4*)(rp + colV); }
            const int off = row * 128 + ((c ^ (row & 7)) << 4);
            *(LAS u32x4*)(Ks + off) = kv; *(LAS u32x4*)(Vs + off) = vv; }
        { const int ntab = isB ? 4 : 1;
          for (int x = tid; x < ntab * ATT_TABN; x += NTHREADS) { const int t = x / ATT_TABN, j = x % ATT_TABN, idx = j - 16;
              float v = -1e30f;
              if (idx >= 0 && idx <= 2 * R) v = io.rel_table[t5_bucket((idx - R) * dil) * 16 + (isB ? 8 + head0 + t : head0)] * LOG2E;
              tab[x] = v; } }
        __syncthreads();
        for (int gidx = wid; gidx < ngroups; gidx += NWAVES) {
            const int hq = isB ? (gidx >> 3) : 0, gi = isB ? (gidx & 7) : gidx, head = head0 + hq;
            const int ql = 16 * gi + qi, posq = res + dil * (l0 + ql);
            const LAS float* tb = tab + hq * ATT_TABN + 16;
            bf16x8 qf[2];
            { const bf16_t* qp = base + (size_t)posq * DIN + (isB ? 1536 : 0) + head * 64 + 8 * g4; const float SC = 0.125f * LOG2E;
#pragma unroll
              for (int ks = 0; ks < 2; ++ks) { const u32x4 w = *(const u32x4*)(qp + 32 * ks); u32x4 o;
                  o.x = pg8::cvt_pk_bf16(bflo(w.x) * SC, bfhi(w.x) * SC); o.y = pg8::cvt_pk_bf16(bflo(w.y) * SC, bfhi(w.y) * SC); o.z = pg8::cvt_pk_bf16(bflo(w.z) * SC, bfhi(w.z) * SC); o.w = pg8::cvt_pk_bf16(bflo(w.w) * SC, bfhi(w.w) * SC);
                  qf[ks] = __builtin_bit_cast(bf16x8, o); } }
            f32x4 ot[4];
#pragma unroll
            for (int dt = 0; dt < 4; ++dt) ot[dt] = (f32x4){0.f, 0.f, 0.f, 0.f};
            float m = -1e20f, lsum = 0.f;
            for (int it = 0; it < nit; ++it) {
                const int rb = 16 * gi + 32 * it;
                f32x4 s0 = (f32x4){0.f, 0.f, 0.f, 0.f}, s1 = s0;
#pragma unroll
                for (int ks = 0; ks < 2; ++ks) { const int r0 = rb + qi, c = g4 + 4 * ks; const int off = r0 * 128 + ((c ^ (r0 & 7)) << 4);
                    const bf16x8 k0 = *(const LAS bf16x8*)(Ks + off), k1 = *(const LAS bf16x8*)(Ks + off + 16 * 128);
                    s0 = __builtin_amdgcn_mfma_f32_16x16x32_bf16(k0, qf[ks], s0, 0, 0, 0); s1 = __builtin_amdgcn_mfma_f32_16x16x32_bf16(k1, qf[ks], s1, 0, 0, 0); }
                float v[8]; float tmax = -1e30f;
#pragma unroll
                for (int r = 0; r < 4; ++r) { const int row0 = rb + 4 * g4 + r, row1 = row0 + 16;
                    float a = s0[r] + tb[row0 - ql], c2 = s1[r] + tb[row1 - ql];
                    a = (row0 >= rv0 && row0 < rv1) ? a : -1e30f; c2 = (row1 >= rv0 && row1 < rv1) ? c2 : -1e30f;
                    v[r] = a; v[4 + r] = c2; tmax = fmaxf(tmax, fmaxf(a, c2)); }
                tmax = fmaxf(tmax, __shfl_xor(tmax, 16)); tmax = fmaxf(tmax, __shfl_xor(tmax, 32));
                const float mn = fmaxf(m, tmax), alpha = __builtin_amdgcn_exp2f(m - mn); m = mn;
                float ps = 0.f;
#pragma unroll
                for (int i = 0; i < 8; ++i) { v[i] = __builtin_amdgcn_exp2f(v[i] - mn); ps += v[i]; }
                lsum = lsum * alpha + ps;
#pragma unroll
                for (int dt = 0; dt < 4; ++dt) ot[dt] = ot[dt] * alpha;
                u32x4 pw; pw.x = pg8::cvt_pk_bf16(v[0], v[1]); pw.y = pg8::cvt_pk_bf16(v[2], v[3]); pw.z = pg8::cvt_pk_bf16(v[4], v[5]); pw.w = pg8::cvt_pk_bf16(v[6], v[7]);
                const bf16x8 pf = __builtin_bit_cast(bf16x8, pw);
                const int ra = rb + 4 * g4 + (qi >> 2);
#pragma unroll
                for (int dt = 0; dt < 4; ++dt) { const int ch = dt * 2 + ((qi & 3) >> 1); const int off = ra * 128 + ((ch ^ (ra & 7)) << 4) + 8 * (qi & 1);
                    const v4i16_t lo = lds_tr16(Vs + off), hi = lds_tr16(Vs + off + 16 * 128);
                    const bf16x8 vf = (bf16x8){lo[0], lo[1], lo[2], lo[3], hi[0], hi[1], hi[2], hi[3]};
                    ot[dt] = __builtin_amdgcn_mfma_f32_16x16x32_bf16(vf, pf, ot[dt], 0, 0, 0); }
            }
            lsum += __shfl_xor(lsum, 16); lsum += __shfl_xor(lsum, 32);
            const size_t tok = (size_t)b * SEQ + posq;
            float scale;
            if (isB) { const float s2 = io.sink[head] * LOG2E, mf = fmaxf(m, s2), e = __builtin_amdgcn_exp2f(m - mf); scale = e / (lsum * e + __builtin_amdgcn_exp2f(s2 - mf)); }
            else { scale = 1.f / lsum; if (g4 == 0) io.LSE[((size_t)branch * M + tok) * 8 + head] = m + __builtin_amdgcn_logf(lsum); }
            bf16_t* op = isB ? io.O + tok * D + 512 + head * 64 : io.OBR + ((size_t)branch * M + tok) * 512 + head * 64;
#pragma unroll
            for (int dt = 0; dt < 4; ++dt) { const f32x4 o = ot[dt] * scale; u32x2 w; w.x = pg8::cvt_pk_bf16(o[0], o[1]); w.y = pg8::cvt_pk_bf16(o[2], o[3]); *(u32x2*)(op + dt * 16 + 4 * g4) = w; }
        }
    }
}
__device__ __forceinline__ void phase_attn_merge(const AttnIO& io, int gtid, int NGT) {
    for (int x = gtid; x < M * 64; x += NGT) { const int tok = x >> 6, head = (x >> 3) & 7, c8 = x & 7;
        const float l0 = io.LSE[((size_t)0 * M + tok) * 8 + head], l1 = io.LSE[((size_t)1 * M + tok) * 8 + head], l2 = io.LSE[((size_t)2 * M + tok) * 8 + head];
        const float mx = fmaxf(l0, fmaxf(l1, l2)); float w0 = __builtin_amdgcn_exp2f(l0 - mx), w1 = __builtin_amdgcn_exp2f(l1 - mx), w2 = __builtin_amdgcn_exp2f(l2 - mx);
        const float inv = 1.f / (w0 + w1 + w2); w0 *= inv; w1 *= inv; w2 *= inv;
        const size_t o = (size_t)tok * 512 + head * 64 + c8 * 8;
        const u32x4 a = *(const u32x4*)(io.OBR + o), bq = *(const u32x4*)(io.OBR + (size_t)M * 512 + o), c = *(const u32x4*)(io.OBR + (size_t)2 * M * 512 + o);
        u32x4 r;
        r.x = pk2(w0 * bflo(a.x) + w1 * bflo(bq.x) + w2 * bflo(c.x), w0 * bfhi(a.x) + w1 * bfhi(bq.x) + w2 * bfhi(c.x));
        r.y = pk2(w0 * bflo(a.y) + w1 * bflo(bq.y) + w2 * bflo(c.y), w0 * bfhi(a.y) + w1 * bfhi(bq.y) + w2 * bfhi(c.y));
        r.z = pk2(w0 * bflo(a.z) + w1 * bflo(bq.z) + w2 * bflo(c.z), w0 * bfhi(a.z) + w1 * bfhi(bq.z) + w2 * bfhi(c.z));
        r.w = pk2(w0 * bflo(a.w) + w1 * bflo(bq.w) + w2 * bflo(c.w), w0 * bfhi(a.w) + w1 * bfhi(bq.w) + w2 * bfhi(c.w));
        *(u32x4*)(io.O + (size_t)tok * D + head * 64 + c8 * 8) = r; }
}

constexpr int NCH = SEQ / 16;
constexpr int SC_LROW = 68;
constexpr int SC_LDROW = 528;
constexpr int SC_LSLOT = 4 * 16 * SC_LROW * 4 + 16 * SC_LDROW;
constexpr int SC_LBUF = 0, SC_SCAN = SC_LBUF + 2 * SC_LSLOT, SC_SCANSLOT = 16 * 5 * 64 * 4, SC_WEND = SC_SCAN + 2 * SC_SCANSLOT, SC_AG = SC_WEND + 512, SC_AGSLOT = 2 * 16 * 64 * 4,
              SC_OUT = SC_AG + 3 * SC_AGSLOT, SC_OUTSLOT = 2 * 16 * 64 * 4, SC_END = SC_OUT + 2 * SC_OUTSLOT;
static_assert(SC_END <= LDSCTL_OFF, "scan LDS map");
template <int CTRL> __device__ __forceinline__ float dpp_f(float x) { return __int_as_float(__builtin_amdgcn_update_dpp(0, __float_as_int(x), CTRL, 0xf, 0xf, true)); }
__device__ __forceinline__ float sum8(float x) { x += dpp_f<0xB1>(x); x += dpp_f<0x4E>(x); x += dpp_f<0x141>(x); return x; }
__device__ __forceinline__ float wave_sum_d(float x) { x = sum8(x); x += dpp_f<0x140>(x); x += __shfl_xor(x, 16); x += __shfl_xor(x, 32); return x; }
__device__ __forceinline__ float fast_sigmoid(float z) { return __builtin_amdgcn_rcpf(1.f + __builtin_amdgcn_exp2f(-LOG2E * z)); }

struct ScanPtrs { const bf16_t *R, *Kk, *V, *LDO; bf16_t* Y; const float *w2, *a2, *g2, *w0, *a0, *k_k, *k_a, *r_k, *gn_w, *gn_b; };
__device__ __forceinline__ void phase_scan(LAS unsigned char* lds, const ScanPtrs& P, int G) {
    int tid = threadIdx.x; asm volatile("" : "+v"(tid));
    const int lane = tid & 63, wid = __builtin_amdgcn_readfirstlane(tid >> 6);
    for (int unit = blockIdx.x; unit < 256; unit += G) {
        const int b = unit >> 5, h = (unit >> 1) & 15, d = unit & 1, hc = h * 64;
        __syncthreads();
        if (wid < 4) {
            __builtin_amdgcn_s_setprio(2);
            const int p = wid * 8 + (lane >> 3), c8 = lane & 7;
            f32x2 S0[4], S1[4];
#pragma unroll
            for (int e = 0; e < 4; ++e) { S0[e] = (f32x2){0.f, 0.f}; S1[e] = (f32x2){0.f, 0.f}; }
            for (int i = 0; i < NCH + 3; ++i) {
                const int j = i - 2;
                if (j >= 0 && j < NCH) {
                    const LAS float* sb = (const LAS float*)(lds + SC_SCAN + (j & 1) * SC_SCANSLOT) + 8 * c8;
                    LAS float* ob = (LAS float*)(lds + SC_OUT + (j & 1) * SC_OUTSLOT);
#pragma unroll 4
                    for (int t = 0; t < 16; ++t) {
                        const LAS float* st = sb + t * 320;
                        const f32x4 ka = *(const LAS f32x4*)(st), kb = *(const LAS f32x4*)(st + 4), ra = *(const LAS f32x4*)(st + 64), rb = *(const LAS f32x4*)(st + 68);
                        const f32x4 ba = *(const LAS f32x4*)(st + 128), bb = *(const LAS f32x4*)(st + 132), ta = *(const LAS f32x4*)(st + 192), tb = *(const LAS f32x4*)(st + 196);
                        const f32x2 v2 = *(const LAS f32x2*)(st - 8 * c8 + 256 + 2 * p);
                        const f32x2 k0 = {ka[0], ka[1]}, k1 = {ka[2], ka[3]}, k2 = {kb[0], kb[1]}, k3 = {kb[2], kb[3]};
                        const f32x2 r0 = {ra[0], ra[1]}, r1 = {ra[2], ra[3]}, r2 = {rb[0], rb[1]}, r3 = {rb[2], rb[3]};
                        f32x2 d0 = S0[0] * k0 + S0[1] * k1 + S0[2] * k2 + S0[3] * k3, d1 = S1[0] * k0 + S1[1] * k1 + S1[2] * k2 + S1[3] * k3;
                        f32x2 o0 = S0[0] * r0 + S0[1] * r1 + S0[2] * r2 + S0[3] * r3, o1 = S1[0] * r0 + S1[1] * r1 + S1[2] * r2 + S1[3] * r3;
                        const float sa0 = -sum8(d0.x + d0.y), sa1 = -sum8(d1.x + d1.y), oo0 = sum8(o0.x + o0.y), oo1 = sum8(o1.x + o1.y);
                        const f32x2 b0 = {ba[0], ba[1]}, b1 = {ba[2], ba[3]}, b2 = {bb[0], bb[1]}, b3 = {bb[2], bb[3]};
                        const f32x2 t0 = {ta[0], ta[1]}, t1 = {ta[2], ta[3]}, t2 = {tb[0], tb[1]}, t3 = {tb[2], tb[3]};
                        S0[0] = S0[0] + sa0 * b0 + v2.x * t0; S0[1] = S0[1] + sa0 * b1 + v2.x * t1; S0[2] = S0[2] + sa0 * b2 + v2.x * t2; S0[3] = S0[3] + sa0 * b3 + v2.x * t3;
                        S1[0] = S1[0] + sa1 * b0 + v2.y * t0; S1[1] = S1[1] + sa1 * b1 + v2.y * t1; S1[2] = S1[2] + sa1 * b2 + v2.y * t2; S1[3] = S1[3] + sa1 * b3 + v2.y * t3;
                        if (c8 == 0) { *(LAS f32x2*)(ob + t * 64 + 2 * p) = (f32x2){oo0, oo1}; *(LAS f32x2*)(ob + 1024 + t * 64 + 2 * p) = (f32x2){sa0, sa1}; }
                    }
                    const LAS float* we = (const LAS float*)(lds + SC_WEND + (j & 1) * 256) + 8 * c8;
                    const f32x4 wa = *(const LAS f32x4*)(we), wb = *(const LAS f32x4*)(we + 4);
                    const f32x2 w0 = {wa[0], wa[1]}, w1 = {wa[2], wa[3]}, w2 = {wb[0], wb[1]}, w3 = {wb[2], wb[3]};
                    S0[0] = S0[0] * w0; S0[1] = S0[1] * w1; S0[2] = S0[2] * w2; S0[3] = S0[3] * w3; S1[0] = S1[0] * w0; S1[1] = S1[1] * w1; S1[2] = S1[2] * w2; S1[3] = S1[3] * w3;
                }
                __syncthreads();
            }
            __builtin_amdgcn_s_setprio(0);
        } else {
            const int hw = wid - 4, c16 = lane & 15, g4 = lane >> 4;
            const int chC = hc + 16 * hw + c16, chT = hc + lane;
            bf16x8 bw[2], ba[2], bg[4];
#pragma unroll
            for (int ks = 0; ks < 2; ++ks) { u32x4 w, a;
#pragma unroll
                for (int jj = 0; jj < 4; ++jj) { const int k = 32 * ks + 8 * g4 + 2 * jj;
                    w[jj] = pk2(P.w2[(size_t)(d * 64 + k) * D + chC], P.w2[(size_t)(d * 64 + k + 1) * D + chC]); a[jj] = pk2(P.a2[(size_t)(d * 64 + k) * D + chC], P.a2[(size_t)(d * 64 + k + 1) * D + chC]); }
                bw[ks] = __builtin_bit_cast(bf16x8, w); ba[ks] = __builtin_bit_cast(bf16x8, a); }
#pragma unroll
            for (int ks = 0; ks < 4; ++ks) { u32x4 g;
#pragma unroll
                for (int jj = 0; jj < 4; ++jj) { const int k = 32 * ks + 8 * g4 + 2 * jj; g[jj] = pk2(P.g2[(size_t)(d * 128 + k) * D + chC], P.g2[(size_t)(d * 128 + k + 1) * D + chC]); }
                bg[ks] = __builtin_bit_cast(bf16x8, g); }
            const float w0c = P.w0[d * D + chC], a0c = P.a0[d * D + chC], kaC = P.k_a[chC];
            const float kkT = P.k_k[chT], kaT = P.k_a[chT], rkT = P.r_k[chT], gwT = P.gn_w[chT], gbT = P.gn_b[chT];
            const int lcol = lane < 16 ? (d * 64 + 4 * lane) : (lane < 32 ? (128 + d * 64 + 4 * (lane - 16)) : (256 + d * 128 + 4 * (lane - 32)));
            for (int i = 0; i < NCH + 3; ++i) {
                unsigned short lr[4], lk[4], lv[4], pr[4], pk[4], pv[4]; u32x2 l0[4], l1[4], l2[4];
                const bool doL = i < NCH, doC = (i >= 1 && i - 1 < NCH), doP = (i >= 3 && i - 3 < NCH);
                if (doL) {
#pragma unroll
                    for (int q = 0; q < 4; ++q) { const int s = 4 * hw + q, t = d ? (SEQ - 1 - (i * 16 + s)) : (i * 16 + s); const size_t row = (size_t)b * SEQ + t;
                        lr[q] = P.R[row * D + chT]; lk[q] = P.Kk[row * D + chT]; lv[q] = P.V[row * D + chT];
                        l0[q] = *(const u32x2*)(P.LDO + row * NLD + lcol);
                        l1[q] = t > 0 ? *(const u32x2*)(P.LDO + (row - 1) * NLD + 512 + lcol) : (u32x2){0u, 0u};
                        l2[q] = t < SEQ - 1 ? *(const u32x2*)(P.LDO + (row + 1) * NLD + 1024 + lcol) : (u32x2){0u, 0u}; } }
                if (doP) {
#pragma unroll
                    for (int q = 0; q < 4; ++q) { const int s = 4 * hw + q, t = d ? (SEQ - 1 - ((i - 3) * 16 + s)) : ((i - 3) * 16 + s); const size_t row = (size_t)b * SEQ + t;
                        pr[q] = P.R[row * D + chT]; pk[q] = P.Kk[row * D + chT]; pv[q] = P.V[row * D + chT]; } }
                if (doC) {
                    const int jc = i - 1;
                    const LAS unsigned char* Ls = lds + SC_LBUF + (jc & 1) * SC_LSLOT;
                    const LAS unsigned char* ldp = Ls + 4 * 16 * SC_LROW * 4 + c16 * SC_LDROW + 16 * g4;
                    f32x4 zw = {0.f, 0.f, 0.f, 0.f}, za = zw, gg = zw;
#pragma unroll
                    for (int ks = 0; ks < 2; ++ks) { zw = __builtin_amdgcn_mfma_f32_16x16x32_bf16(*(const LAS bf16x8*)(ldp + 64 * ks), bw[ks], zw, 0, 0, 0);
                                                     za = __builtin_amdgcn_mfma_f32_16x16x32_bf16(*(const LAS bf16x8*)(ldp + 128 + 64 * ks), ba[ks], za, 0, 0, 0); }
#pragma unroll
                    for (int ks = 0; ks < 4; ++ks) gg = __builtin_amdgcn_mfma_f32_16x16x32_bf16(*(const LAS bf16x8*)(ldp + 256 + 64 * ks), bg[ks], gg, 0, 0, 0);
                    float lw[4], cw[4]; float tot = 0.f;
#pragma unroll
                    for (int r = 0; r < 4; ++r) { lw[r] = -0.6065306597f * fast_sigmoid(w0c + zw[r]); tot += lw[r]; cw[r] = tot; }
                    const float T0 = __shfl(tot, c16), T1 = __shfl(tot, c16 + 16), T2 = __shfl(tot, c16 + 32);
                    const float pre = (g4 > 0 ? T0 : 0.f) + (g4 > 1 ? T1 : 0.f) + (g4 > 2 ? T2 : 0.f);
                    const LAS float* Lf = (const LAS float*)Ls + 16 * hw + c16;
                    LAS float* sbw = (LAS float*)(lds + SC_SCAN + (jc & 1) * SC_SCANSLOT) + 16 * hw + c16;
                    LAS float* agw = (LAS float*)(lds + SC_AG + (jc % 3) * SC_AGSLOT) + 16 * hw + c16;
#pragma unroll
                    for (int r = 0; r < 4; ++r) { const int tok = 4 * g4 + r; const float c = pre + cw[r];
                        const float Wc = __builtin_amdgcn_exp2f(LOG2E * c), Wp = __builtin_amdgcn_exp2f(LOG2E * (c - lw[r])), iW = __builtin_amdgcn_exp2f(-LOG2E * c);
                        const float a = fast_sigmoid(a0c + za[r]);
                        const float rr = Lf[tok * SC_LROW], kk_ = Lf[16 * SC_LROW + tok * SC_LROW], nk = Lf[32 * SC_LROW + tok * SC_LROW], vv = Lf[48 * SC_LROW + tok * SC_LROW];
                        sbw[tok * 320] = nk * Wp; sbw[tok * 320 + 64] = rr * Wc; sbw[tok * 320 + 128] = nk * a * iW; sbw[tok * 320 + 192] = kk_ * (1.f + (a - 1.f) * kaC) * iW; sbw[tok * 320 + 256] = vv;
                        agw[tok * 64] = a; agw[1024 + tok * 64] = gg[r];
                        if (tok == 15) ((LAS float*)(lds + SC_WEND + (jc & 1) * 256))[16 * hw + c16] = Wc; }
                }
                if (doL) {
                    LAS unsigned char* Ls = lds + SC_LBUF + (i & 1) * SC_LSLOT; LAS float* Lf = (LAS float*)Ls;
#pragma unroll
                    for (int q = 0; q < 4; ++q) { const int s = 4 * hw + q;
                        const float rr = bf2f(lr[q]), kk_ = bf2f(lk[q]), vv = bf2f(lv[q]); float nk = kk_ * kkT;
                        nk = nk / fmaxf(sqrtf(wave_sum_d(nk * nk)), 1e-12f);
                        Lf[s * SC_LROW + lane] = rr; Lf[16 * SC_LROW + s * SC_LROW + lane] = kk_; Lf[32 * SC_LROW + s * SC_LROW + lane] = nk; Lf[48 * SC_LROW + s * SC_LROW + lane] = vv;
                        float x0 = bflo(l0[q].x) + bflo(l1[q].x) + bflo(l2[q].x), x1 = bfhi(l0[q].x) + bfhi(l1[q].x) + bfhi(l2[q].x), x2 = bflo(l0[q].y) + bflo(l1[q].y) + bflo(l2[q].y), x3 = bfhi(l0[q].y) + bfhi(l1[q].y) + bfhi(l2[q].y);
                        if (lane < 16) { x0 = 2.f * fast_sigmoid(2.f * x0) - 1.f; x1 = 2.f * fast_sigmoid(2.f * x1) - 1.f; x2 = 2.f * fast_sigmoid(2.f * x2) - 1.f; x3 = 2.f * fast_sigmoid(2.f * x3) - 1.f; }
                        else if (lane >= 32) { x0 = fast_sigmoid(x0); x1 = fast_sigmoid(x1); x2 = fast_sigmoid(x2); x3 = fast_sigmoid(x3); }
                        u32x2 w; w.x = pk2(x0, x1); w.y = pk2(x2, x3);
                        *(LAS u32x2*)(Ls + 4 * 16 * SC_LROW * 4 + s * SC_LDROW + 8 * lane) = w; }
                }
                if (doP) {
                    const int jp = i - 3;
                    const LAS float* ob = (const LAS float*)(lds + SC_OUT + (jp & 1) * SC_OUTSLOT); const LAS float* ag = (const LAS float*)(lds + SC_AG + (jp % 3) * SC_AGSLOT);
#pragma unroll
                    for (int q = 0; q < 4; ++q) { const int s = 4 * hw + q, t = d ? (SEQ - 1 - (jp * 16 + s)) : (jp * 16 + s);
                        const float rr = bf2f(pr[q]), kk_ = bf2f(pk[q]), vv = bf2f(pv[q]); float nk = kk_ * kkT;
                        nk = nk / fmaxf(sqrtf(wave_sum_d(nk * nk)), 1e-12f);
                        const float a = ag[s * 64 + lane], g = ag[1024 + s * 64 + lane];
                        const float kd = kk_ * (1.f + (a - 1.f) * kaT);
                        const float br = wave_sum_d(nk * a * rr), kr = wave_sum_d(kd * rr), rkr = wave_sum_d(rr * kd * rkT);
                        const float o = ob[s * 64 + lane] + ob[1024 + s * 64 + lane] * br + vv * kr;
                        const float mu = wave_sum_d(o) * (1.f / 64.f), dv = o - mu, var = wave_sum_d(dv * dv) * (1.f / 64.f);
                        const float y = (dv * rsqrtf(var + GN_EPS) * gwT + gbT + rkr * vv) * g;
                        P.Y[((size_t)b * SEQ + t) * (2 * D) + d * D + chT] = (bf16_t)f2bf(y); }
                }
                __syncthreads();
            }
        }
    }
}

__global__ void __launch_bounds__(NTHREADS, 2) fwd_megakernel(Args args) {
    extern __shared__ __attribute__((aligned(16))) unsigned char lds_raw[];
    LAS unsigned char* lds = (LAS unsigned char*)lds_raw;
    volatile LAS unsigned* MISC = (volatile LAS unsigned*)(lds + MISC_OFF);
    const int tid0 = threadIdx.x, wave = __builtin_amdgcn_readfirstlane(tid0 >> 6);
#define FRESH_LANE() int tid = tid0; asm volatile("" : "+v"(tid)); const int lane = tid & 63; (void)lane
    const int G = gridDim.x;
    const int vcu = (G % 8 == 0) ? ((int)blockIdx.x % 8) * (G / 8) + (int)blockIdx.x / 8 : (int)blockIdx.x;
    const int gw = vcu * NWAVES + wave, NGW = G * NWAVES;
    unsigned char* ws = args.ws;
    unsigned* ctl = (unsigned*)(ws + WS_CTL);
    for (int u = tid0; u < (LDS_BYTES - LDSCTL_OFF) / 4; u += NTHREADS) ((LAS unsigned*)(lds + LDSCTL_OFF))[u] = 0u;
    __syncthreads();
    XcdBarrier bar = xcd_barrier_post(ctl + CW_BAR, MISC + 8);
#define GRID_BAR() xcd_barrier(bar)

    const float* x = args.in[0]; const float* rel_table = args.in[1]; const float* norm_g = args.in[2]; const float* attn_w_in = args.in[3]; const float* attn_sink = args.in[4];
    const float* attn_w_out = args.in[5]; const float* mu_prev = args.in[6]; const float* mu_next = args.in[7]; const float* w_r = args.in[8]; const float* w_k = args.in[9];
    const float* w_v = args.in[10]; const float* w_o = args.in[11]; const float* mlp_w1 = args.in[25]; const float* mlp_w2 = args.in[26];
    float* hbuf = args.out;
    bf16_t* XN = (bf16_t*)(ws + WS_XN); bf16_t* QKV = (bf16_t*)(ws + WS_QKV); bf16_t* Ob = (bf16_t*)(ws + WS_O); bf16_t* TMP = (bf16_t*)(ws + WS_TMP); bf16_t* Hb = (bf16_t*)(ws + WS_H);
    bf16_t* MIXA = (bf16_t*)(ws + WS_MIXA); bf16_t* MIXB = (bf16_t*)(ws + WS_MIXB); bf16_t* Rb = (bf16_t*)(ws + WS_R); bf16_t* Kb = (bf16_t*)(ws + WS_K); bf16_t* Vb = (bf16_t*)(ws + WS_V);
    bf16_t* LDO = (bf16_t*)(ws + WS_LDO); bf16_t* Yb = (bf16_t*)(ws + WS_Y);
    LAS float* scr = (LAS float*)(lds + wave * 16384);

    {
        FRESH_LANE();
        constexpr int I_IN = (D / 64) * (DIN / 32), I_OUT = (D / 64) * (D / 32), I_1 = (D / 64) * (DFF / 32), I_2 = (DFF / 64) * (D / 32);
        for (int it = gw; it < I_IN + I_OUT + I_1 + I_2; it += NGW) { int r = it;
            if (r < I_IN) { transpose_item(attn_w_in, DIN, DIN, (bf16_t*)(ws + WS_WIN_T), D, 0, 0, scr, r, lane, ScaleOne{}); continue; } r -= I_IN;
            if (r < I_OUT) { transpose_item(attn_w_out, D, D, (bf16_t*)(ws + WS_WOUT_T), D, 0, 0, scr, r, lane, ScaleOne{}); continue; } r -= I_OUT;
            if (r < I_1) { transpose_item(mlp_w1, DFF, DFF, (bf16_t*)(ws + WS_W1_T), D, 0, 0, scr, r, lane, ScaleOne{}); continue; } r -= I_1;
            transpose_item(mlp_w2, D, D, (bf16_t*)(ws + WS_W2_T), DFF, 0, 0, scr, r, lane, ScaleOne{}); }
        for (int row = gw; row < M; row += NGW) { Row16 r; row_load_f32(r, x + (size_t)row * D, lane); row_rmsnorm(r, norm_g, lane); row_store_bf16(r, XN + (size_t)row * D, lane); }
    }
    GRID_BAR();
    run_gemm<0>(lds, ProbPlain{XN, (const bf16_t*)(ws + WS_WIN_T), D}, DstPlain{QKV, DIN}, M, DIN, G);
    GRID_BAR();
#ifdef ATT_NAIVE
    { FRESH_LANE(); phase_attn_naive(QKV, rel_table, attn_sink, Ob, vcu * NTHREADS + tid, G * NTHREADS); }
    GRID_BAR();
#else
    { const AttnIO io{QKV, rel_table, attn_sink, Ob, (bf16_t*)(ws + WS_OBR), (float*)(ws + WS_LSE)};
      for (int rep = 0; rep < REP_ATT; ++rep) phase_attn(lds, io, vcu, G);
      GRID_BAR();
      { FRESH_LANE(); phase_attn_merge(io, vcu * NTHREADS + tid, G * NTHREADS); } }
    GRID_BAR();
#endif
    run_gemm<0>(lds, ProbPlain{Ob, (const bf16_t*)(ws + WS_WOUT_T), D}, DstPlain{TMP, D}, M, D, G);
    GRID_BAR();
    { FRESH_LANE(); phase_resnorm(x, TMP, norm_g + D, norm_g + 2 * D, hbuf, XN, gw, NGW, lane); }
    GRID_BAR();
    run_gemm<1>(lds, ProbPlain{XN, (const bf16_t*)(ws + WS_W1_T), D}, DstPlain{Hb, DFF}, M, DFF, G);
    GRID_BAR();
    run_gemm<0>(lds, ProbPlain{Hb, (const bf16_t*)(ws + WS_W2_T), DFF}, DstPlain{TMP, D}, M, D, G);
    GRID_BAR();
    { FRESH_LANE(); phase_resnorm(hbuf, TMP, norm_g + 3 * D, nullptr, hbuf, nullptr, gw, NGW, lane); }
    GRID_BAR();
    {
        FRESH_LANE();
        const float* g1n = norm_g + 4 * D;
        constexpr int I_SQ = (D / 64) * (D / 32), I_1 = (D / 64) * (DFF / 32), I_2 = (DFF / 64) * (D / 32), I_LD = 768;
        for (int it = gw; it < 5 * I_SQ + I_1 + I_2 + I_LD; it += NGW) { int r = it;
            if (r < I_SQ) { transpose_item(w_r, D, D, (bf16_t*)(ws + WS_WR_T), D, 0, 0, scr, r, lane, ScaleOne{}); continue; } r -= I_SQ;
            if (r < I_SQ) { transpose_item(w_k, D, D, (bf16_t*)(ws + WS_WK_T), D, 0, 0, scr, r, lane, ScaleOne{}); continue; } r -= I_SQ;
            if (r < I_SQ) { transpose_item(w_v, D, D, (bf16_t*)(ws + WS_WV_T), D, 0, 0, scr, r, lane, ScaleOne{}); continue; } r -= I_SQ;
            if (r < I_SQ) { transpose_item(w_o, D, D, (bf16_t*)(ws + WS_WO2_T), 2 * D, 0, 0, scr, r, lane, ScaleOne{}); continue; } r -= I_SQ;
            if (r < I_SQ) { transpose_item(w_o, D, D, (bf16_t*)(ws + WS_WO2_T), 2 * D, 0, D, scr, r, lane, ScaleOne{}); continue; } r -= I_SQ;
            if (r < I_1) { transpose_item(mlp_w1 + (size_t)D * DFF, DFF, DFF, (bf16_t*)(ws + WS_W1B_T), D, 0, 0, scr, r, lane, ScaleOne{}); continue; } r -= I_1;
            if (r < I_2) { transpose_item(mlp_w2 + (size_t)DFF * D, D, D, (bf16_t*)(ws + WS_W2B_T), DFF, 0, 0, scr, r, lane, ScaleOne{}); continue; } r -= I_2;
            const int part = r / 256; int q = r % 256; int sub, li;
            if (q < 128) { sub = q / 32; li = q % 32; } else { sub = 4 + (q - 128) / 64; li = (q - 128) % 64; }
            const int dd = sub & 1, kind = sub >> 1;
            const int stream = kind == 0 ? 1 : (kind == 1 ? 4 : 5), Nn = kind == 2 ? 128 : 64;
            const float* src = kind == 0 ? args.in[18] + (size_t)dd * D * 64 : (kind == 1 ? args.in[21] + (size_t)dd * D * 64 : args.in[23] + (size_t)dd * D * 128);
            const int coloff = kind == 0 ? dd * 64 : (kind == 1 ? 128 + dd * 64 : 256 + dd * 128);
            transpose_item(src, Nn, Nn, (bf16_t*)(ws + WS_LDW_T), D, part * 512 + coloff, 0, scr, li, lane, ScaleMix{mu_prev + stream * D, mu_next + stream * D, part}); }
        phase_mix<true>(hbuf, g1n, mu_prev, mu_next, XN, MIXA, MIXB, gw, NGW, lane);
    }
    GRID_BAR();
    run_gemm<0>(lds, ProbRKL{ws, D}, DstRKL{ws}, M, 14 * 256, G);
    GRID_BAR();
    { FRESH_LANE(); phase_mix<false>(hbuf, norm_g + 4 * D, mu_prev, mu_next, nullptr, MIXA, nullptr, gw, NGW, lane); }
    GRID_BAR();
    run_gemm<0>(lds, ProbPlain{MIXA, (const bf16_t*)(ws + WS_WV_T), D}, DstPlain{Vb, D}, M, D, G);
    GRID_BAR();
    { ScanPtrs sp{Rb, Kb, Vb, LDO, Yb, args.in[19], args.in[22], args.in[24], args.in[17], args.in[20], args.in[12], args.in[13], args.in[14], args.in[15], args.in[16]};
      for (int rep = 0; rep < REP_SCAN; ++rep) phase_scan(lds, sp, G); }
    GRID_BAR();
    run_gemm<0>(lds, ProbPlain{Yb, (const bf16_t*)(ws + WS_WO2_T), 2 * D}, DstPlain{TMP, D}, M, D, G);
    GRID_BAR();
    { FRESH_LANE(); phase_resnorm(hbuf, TMP, norm_g + 5 * D, norm_g + 6 * D, hbuf, XN, gw, NGW, lane); }
    GRID_BAR();
    run_gemm<1>(lds, ProbPlain{XN, (const bf16_t*)(ws + WS_W1B_T), D}, DstPlain{Hb, DFF}, M, DFF, G);
    GRID_BAR();
    run_gemm<0>(lds, ProbPlain{Hb, (const bf16_t*)(ws + WS_W2B_T), DFF}, DstPlain{TMP, D}, M, D, G);
    GRID_BAR();
    { FRESH_LANE(); phase_resnorm(hbuf, TMP, norm_g + 7 * D, nullptr, hbuf, nullptr, gw, NGW, lane); }
#undef GRID_BAR
}

extern "C" void kernel_launch(void* const* d_in, const int* in_sizes, int n_in, void* d_out, int out_size, void* d_ws, size_t ws_size, hipStream_t stream) {
    static int grid = 0;
    if (grid == 0) {
        if (n_in != 27 || in_sizes[0] != M * D || out_size != M * D || ws_size < WS_END) { fprintf(stderr, "kernel_launch: unexpected shapes (n_in %d, in0 %d, out %d, ws %zu)\n", n_in, n_in > 0 ? in_sizes[0] : -1, out_size, ws_size); grid = -1; return; }
        int dev = 0, cus = 0, per_cu = 0;
        if (hipGetDevice(&dev) != hipSuccess || hipDeviceGetAttribute(&cus, hipDeviceAttributeMultiprocessorCount, dev) != hipSuccess) { grid = -1; return; }
        if (hipFuncSetAttribute((const void*)fwd_megakernel, hipFuncAttributeMaxDynamicSharedMemorySize, LDS_BYTES) != hipSuccess) { fprintf(stderr, "kernel_launch: hipFuncSetAttribute failed\n"); grid = -1; return; }
        if (hipOccupancyMaxActiveBlocksPerMultiprocessor(&per_cu, (const void*)fwd_megakernel, NTHREADS, LDS_BYTES) != hipSuccess || per_cu < 1) { fprintf(stderr, "kernel_launch: occupancy query says %d blocks/CU\n", per_cu); (void)hipGetLastError(); grid = -1; return; }
        grid = cus;
    }
    if (grid < 0) return;
    (void)hipMemsetAsync((char*)d_ws + WS_CTL, 0, CTL_ZERO_BYTES, stream);
    Args a{};
    for (int i = 0; i < 27; ++i) a.in[i] = (const float*)d_in[i];
    a.out = (float*)d_out; a.ws = (unsigned char*)d_ws;
    hipLaunchKernelGGL(fwd_megakernel, dim3(grid), dim3(NTHREADS), LDS_BYTES, stream, a);
}
```

```cpp
#include <hip/hip_runtime.h>
#include <cstdio>
#include <cstdint>

#define LAS __attribute__((address_space(3)))
#define GAS __attribute__((address_space(1)))
typedef unsigned short bf16_t;
typedef short bf16x8 __attribute__((ext_vector_type(8)));
typedef float f32x4 __attribute__((ext_vector_type(4)));
typedef float f32x2 __attribute__((ext_vector_type(2)));
typedef unsigned u32x4 __attribute__((ext_vector_type(4)));
typedef unsigned u32x2 __attribute__((ext_vector_type(2)));

constexpr int SEQ = 2048, D = 1024, NBATCH = 8, M = NBATCH * SEQ, DFF = 4096, DIN = 2304, NLD = 1536;
constexpr float NORM_EPS = 1e-6f, GN_EPS = 64e-5f;
constexpr int NWAVES = 8, NTHREADS = 512;

namespace pg8 {
constexpr int BM = 256, BK = 64, HALF = 128, HTB = HALF * BK * 2, STAGE_BYTES = 8 * HTB, NXCD = 8, WGM = 8;
__host__ __device__ __forceinline__ int lds_byte(int r, int c) { const int st = (r >> 4) * 2 + (c >> 5), rr = r & 15, cc = c & 31, ob = rr * 64 + cc * 2; return st * 1024 + (ob ^ (((ob >> 9) & 1) << 5)); }
__host__ __device__ __forceinline__ void stage_rc(int b, int& R, int& C) { const int st = b / 1024, sb = b % 1024, swz = sb ^ (((sb >> 9) & 1) << 5); R = (st >> 1) * 16 + swz / 64; C = (st & 1) * 32 + (swz % 64) / 2; }
__host__ __device__ __forceinline__ int perm32(int rho) { const int n = rho >> 4, i = rho & 15; return 8 * (i >> 2) + 4 * n + (i & 3); }

struct Unit { int pm, pn; };
struct StaticOrder {
    int nM, nN, nwg, G, c;
    __host__ __device__ void init(int Mr, int N, int G_, int c_) { nM = Mr / BM; nN = N / BM; nwg = nM * nN; G = G_; c = c_; }
    __host__ __device__ bool next(int i, Unit& u) const {
        const long L = (long)i * G + c; if (L >= nwg) return false;
        int wgid = (int)L; { const int q = nwg / NXCD, r = nwg % NXCD, xcd = wgid % NXCD, off = wgid / NXCD; wgid = (xcd < r ? xcd * (q + 1) : r * (q + 1) + (xcd - r) * q) + off; }
        const int nig = WGM * nN, gid = wgid / nig, fm = gid * WGM, gsz = (nM - fm) < WGM ? (nM - fm) : WGM;
        u.pm = fm + ((wgid % nig) % gsz); u.pn = (wgid % nig) / gsz; return true;
    }
};
__device__ __forceinline__ unsigned cvt_pk_bf16(float lo, float hi) { unsigned r; asm volatile("v_cvt_pk_bf16_f32 %0, %1, %2" : "=v"(r) : "v"(lo), "v"(hi)); return r; }

__device__ __forceinline__ void store16_wt(void* p, u32x4 v) { asm volatile("global_store_dwordx4 %0, %1, off sc1\n\ts_nop 1" :: "v"(p), "v"(v) : "memory"); }
template <int ACT, class DstFn> struct EpiBf16 {
    static constexpr bool PERM = true;
    DstFn F;
    __device__ __forceinline__ void operator()(const f32x4 (&acc)[2][2][4][2], const Unit& u, int wr, int wc, int fr, int fq) const {
        bf16_t* base; int ldc; F(u, base, ldc);
        const int row0 = wr * 64 + fr, col0 = wc * 32 + 8 * fq;
#pragma unroll
        for (int ai = 0; ai < 2; ++ai)
#pragma unroll
            for (int m = 0; m < 4; ++m) { bf16_t* rowp = base + (size_t)(row0 + ai * HALF + m * 16) * ldc + col0;
#pragma unroll
                for (int bj = 0; bj < 2; ++bj) { f32x4 v0 = acc[ai][bj][m][0], v1 = acc[ai][bj][m][1];
                    if (ACT == 1) {
#pragma unroll
                        for (int e = 0; e < 4; ++e) { const float a = fmaxf(v0[e], 0.f), b = fmaxf(v1[e], 0.f); v0[e] = a * a; v1[e] = b * b; } }
                    u32x4 w; w.x = cvt_pk_bf16(v0[0], v0[1]); w.y = cvt_pk_bf16(v0[2], v0[3]); w.z = cvt_pk_bf16(v1[0], v1[1]); w.w = cvt_pk_bf16(v1[2], v1[3]);
                    store16_wt(rowp + bj * HALF, w); } }
    }
};

template <class Epi, class Prob, bool ALIGN_EPI, bool SP2>
__device__ __forceinline__ void gemm_phase(LAS unsigned char* lds, const Prob& P, const StaticOrder& S, const Epi& E) {
    int tid = threadIdx.x; asm volatile("" : "+v"(tid));
    const int wid = __builtin_amdgcn_readfirstlane(tid >> 6), lane = tid & 63, wr = wid >> 2, wc = wid & 3, fr = lane & 15, fq = lane >> 4;
    const int K = P.K, nt = K / BK;
    unsigned voffA[2], voffB[2];
#pragma unroll
    for (int i = 0; i < 2; ++i) { int R, C; stage_rc(tid * 16 + i * 8192, R, C); const int Rb = Epi::PERM ? ((R & ~31) + perm32(R & 31)) : R;
        voffA[i] = (unsigned)(R * K + C) * 2u; voffB[i] = (unsigned)(Rb * K + C) * 2u; }
    const size_t kstep = (size_t)(BK * 2);
    const size_t hstep = (size_t)HALF * K * 2;
    const unsigned ldsw = (unsigned)wid * 1024u;
    const int aoff = lds_byte(wr * 64 + fr, fq * 8), boff = lds_byte(wc * 32 + fr, fq * 8);
#define PG8_SA(b, h) (((b) * 2 + (h)) * HTB)
#define PG8_SB(b, h) ((4 + (b) * 2 + (h)) * HTB)
#define PG8_STAGE(bufoff, gbase, voff) do { _Pragma("unroll") for (int _i = 0; _i < 2; ++_i) \
        __builtin_amdgcn_global_load_lds((const unsigned*)((const char*)(gbase) + (voff)[_i]), (LAS unsigned*)(lds + (bufoff) + ldsw + _i * 8192), 16, 0, 0); } while (0)
#define PG8_LDA(dst, b, h) do { _Pragma("unroll") for (int m = 0; m < 4; ++m) _Pragma("unroll") for (int k = 0; k < 2; ++k) dst[m][k] = *(const LAS bf16x8*)(lds + PG8_SA(b, h) + aoff + m * 2048 + k * 1024); } while (0)
#define PG8_LDB(dst, b, h) do { _Pragma("unroll") for (int n = 0; n < 2; ++n) _Pragma("unroll") for (int k = 0; k < 2; ++k) dst[n][k] = *(const LAS bf16x8*)(lds + PG8_SB(b, h) + boff + n * 2048 + k * 1024); } while (0)
#define PG8_MMA(ai, bj, At, Bt) do { __builtin_amdgcn_s_setprio(1); _Pragma("unroll") for (int m = 0; m < 4; ++m) _Pragma("unroll") for (int n = 0; n < 2; ++n) _Pragma("unroll") for (int k = 0; k < 2; ++k) \
        acc[ai][bj][m][n] = __builtin_amdgcn_mfma_f32_16x16x32_bf16(Bt[n][k], At[m][k], acc[ai][bj][m][n], 0, 0, 0); __builtin_amdgcn_s_setprio(0); } while (0)
#define PG8_WAIT_V(n) asm volatile("s_waitcnt vmcnt(" #n ")" ::: "memory")
#define PG8_WAIT_L(n) asm volatile("s_waitcnt lgkmcnt(" #n ")" ::: "memory")
#define PG8_BAR __builtin_amdgcn_s_barrier()
#define PG8_SCHED __builtin_amdgcn_sched_barrier(0)
    Unit cur, nxt; int ui = 0;
    if (!S.next(0, cur)) return;
    f32x4 acc[2][2][4][2];
#pragma unroll
    for (int a = 0; a < 2; ++a)
#pragma unroll
        for (int b = 0; b < 2; ++b)
#pragma unroll
            for (int m = 0; m < 4; ++m)
#pragma unroll
                for (int n = 0; n < 2; ++n) acc[a][b][m][n] = (f32x4){0.f, 0.f, 0.f, 0.f};
    bf16x8 At[4][2], B0[2][2], B1[2][2];
    const char* cA = P.a_tile(cur); const char* cB = P.b_tile(cur);
    if constexpr (SP2) {
        PG8_STAGE(PG8_SB(0, 0), cB, voffB); PG8_STAGE(PG8_SB(0, 1), cB + hstep, voffB); PG8_STAGE(PG8_SA(0, 0), cA, voffA); PG8_STAGE(PG8_SA(0, 1), cA + hstep, voffA);
        if (wr == 1) PG8_BAR;
        PG8_WAIT_V(2); PG8_BAR;
        PG8_STAGE(PG8_SB(1, 0), cB + kstep, voffB); PG8_STAGE(PG8_SA(1, 0), cA + kstep, voffA); PG8_STAGE(PG8_SB(1, 1), cB + hstep + kstep, voffB);
        PG8_WAIT_V(6); PG8_BAR;
    } else {
        PG8_STAGE(PG8_SB(0, 0), cB, voffB); PG8_STAGE(PG8_SA(0, 0), cA, voffA); PG8_STAGE(PG8_SB(0, 1), cB + hstep, voffB); PG8_STAGE(PG8_SA(0, 1), cA + hstep, voffA);
        if (wr == 1) PG8_BAR;
        PG8_WAIT_V(4); PG8_BAR;
        PG8_STAGE(PG8_SB(1, 0), cB + kstep, voffB); PG8_STAGE(PG8_SA(1, 0), cA + kstep, voffA); PG8_STAGE(PG8_SB(1, 1), cB + hstep + kstep, voffB);
        PG8_WAIT_V(6); PG8_BAR;
    }
    for (;;) {
        const bool has_next = S.next(ui + 1, nxt);
        const char* nA = has_next ? P.a_tile(nxt) : cA; const char* nB = has_next ? P.b_tile(nxt) : cB;
        for (int t = 0; t < nt; t += 2) {
            const bool last = (t == nt - 2);
            const char* a1 = cA + (size_t)(t + 1) * kstep;
            const char* a2 = last ? nA : cA + (size_t)(t + 2) * kstep; const char* b2 = last ? nB : cB + (size_t)(t + 2) * kstep;
            const char* a3 = a2 + kstep; const char* b3 = b2 + kstep;
            if constexpr (SP2) {
            PG8_LDB(B0, 0, 0); PG8_LDB(B1, 0, 1); PG8_SCHED; PG8_LDA(At, 0, 0); PG8_STAGE(PG8_SA(1, 1), a1 + hstep, voffA);
            PG8_WAIT_V(8); PG8_WAIT_L(0); PG8_BAR; PG8_MMA(0, 0, At, B0); PG8_MMA(0, 1, At, B1); PG8_BAR; PG8_SCHED;
            PG8_LDA(At, 0, 1); PG8_STAGE(PG8_SB(0, 0), b2, voffB); PG8_STAGE(PG8_SB(0, 1), b2 + hstep, voffB); PG8_STAGE(PG8_SA(0, 0), a2, voffA);
            PG8_WAIT_V(8); PG8_WAIT_L(0); PG8_BAR; PG8_MMA(1, 0, At, B0); PG8_MMA(1, 1, At, B1); PG8_BAR; PG8_SCHED;
            PG8_LDB(B0, 1, 0); PG8_LDB(B1, 1, 1); PG8_SCHED; PG8_LDA(At, 1, 0); PG8_STAGE(PG8_SA(0, 1), a2 + hstep, voffA);
            PG8_WAIT_V(8); PG8_WAIT_L(0); PG8_BAR; PG8_MMA(0, 0, At, B0); PG8_MMA(0, 1, At, B1); PG8_BAR; PG8_SCHED;
            PG8_LDA(At, 1, 1); PG8_STAGE(PG8_SB(1, 0), b3, voffB); PG8_STAGE(PG8_SB(1, 1), b3 + hstep, voffB); PG8_STAGE(PG8_SA(1, 0), a3, voffA);
            PG8_WAIT_V(8); PG8_WAIT_L(0); PG8_BAR; PG8_MMA(1, 0, At, B0); PG8_MMA(1, 1, At, B1); PG8_BAR; PG8_SCHED;
            } else {
            PG8_LDB(B0, 0, 0); PG8_SCHED; PG8_LDA(At, 0, 0); PG8_STAGE(PG8_SA(1, 1), a1 + hstep, voffA);
            PG8_WAIT_L(8); PG8_BAR; PG8_WAIT_L(0); PG8_MMA(0, 0, At, B0); PG8_BAR; PG8_SCHED;
            PG8_LDB(B1, 0, 1); PG8_STAGE(PG8_SB(0, 0), b2, voffB);
            PG8_BAR; PG8_WAIT_L(0); PG8_MMA(0, 1, At, B1); PG8_BAR;
            PG8_LDA(At, 0, 1); PG8_STAGE(PG8_SA(0, 0), a2, voffA);
            PG8_BAR; PG8_WAIT_L(0); PG8_MMA(1, 0, At, B0); PG8_BAR; PG8_SCHED;
            PG8_STAGE(PG8_SB(0, 1), b2 + hstep, voffB);
            PG8_WAIT_V(6); PG8_BAR; PG8_MMA(1, 1, At, B1); PG8_BAR;
            PG8_LDB(B0, 1, 0); PG8_SCHED; PG8_LDA(At, 1, 0); PG8_STAGE(PG8_SA(0, 1), a2 + hstep, voffA);
            PG8_WAIT_L(8); PG8_BAR; PG8_WAIT_L(0); PG8_MMA(0, 0, At, B0); PG8_BAR; PG8_SCHED;
            PG8_LDB(B1, 1, 1); PG8_STAGE(PG8_SB(1, 0), b3, voffB);
            PG8_BAR; PG8_WAIT_L(0); PG8_MMA(0, 1, At, B1); PG8_BAR;
            PG8_LDA(At, 1, 1); PG8_STAGE(PG8_SA(1, 0), a3, voffA);
            PG8_BAR; PG8_WAIT_L(0); PG8_MMA(1, 0, At, B0); PG8_BAR; PG8_SCHED;
            PG8_STAGE(PG8_SB(1, 1), b3 + hstep, voffB);
            PG8_WAIT_V(6); PG8_BAR; PG8_MMA(1, 1, At, B1); PG8_BAR;
            }
        }
        if constexpr (ALIGN_EPI) { if (wr == 0) PG8_BAR; }
        E(acc, cur, wr, wc, fr, fq);
        if (!has_next) break;
#pragma unroll
        for (int a = 0; a < 2; ++a)
#pragma unroll
            for (int b = 0; b < 2; ++b)
#pragma unroll
                for (int m = 0; m < 4; ++m)
#pragma unroll
                    for (int n = 0; n < 2; ++n) acc[a][b][m][n] = (f32x4){0.f, 0.f, 0.f, 0.f};
        cur = nxt; cA = nA; cB = nB; ++ui;
        if constexpr (ALIGN_EPI) { if (wr == 1) PG8_BAR; }
    }
    PG8_WAIT_V(0);
    if constexpr (!ALIGN_EPI) { if (wr == 0) PG8_BAR; }
    PG8_BAR;
#undef PG8_SA
#undef PG8_SB
#undef PG8_STAGE
#undef PG8_LDA
#undef PG8_LDB
#undef PG8_MMA
#undef PG8_WAIT_V
#undef PG8_WAIT_L
#undef PG8_BAR
#undef PG8_SCHED
}
}

constexpr size_t MiB = 1u << 20;
constexpr size_t WS_CTL = 0, CTL_ZERO_BYTES = 64 * 1024;
constexpr size_t WS_W = 1 * MiB;
constexpr size_t WS_WIN_T = WS_W, WS_WOUT_T = WS_WIN_T + (size_t)DIN * D * 2, WS_W1_T = WS_WOUT_T + (size_t)D * D * 2, WS_W2_T = WS_W1_T + (size_t)DFF * D * 2;
constexpr size_t WS_WR_T = WS_W, WS_WK_T = WS_WR_T + 2 * MiB, WS_LDW_T = WS_WK_T + 2 * MiB, WS_WV_T = WS_LDW_T + 3 * MiB, WS_WO2_T = WS_WV_T + 2 * MiB, WS_W1B_T = WS_WO2_T + 4 * MiB, WS_W2B_T = WS_W1B_T + 8 * MiB;
static_assert(WS_W2_T + (size_t)D * DFF * 2 <= 31 * MiB && WS_W2B_T + (size_t)D * DFF * 2 <= 31 * MiB, "weight region");
constexpr size_t WS_XN = 31 * MiB, WS_QKV = 63 * MiB, WS_O = 135 * MiB, WS_OBR = 167 * MiB, WS_LSE = 215 * MiB, WS_TMP = 217 * MiB, WS_H = 63 * MiB;
constexpr size_t WS_MIXA = 63 * MiB, WS_MIXB = 95 * MiB, WS_R = 127 * MiB, WS_K = 159 * MiB, WS_V = 31 * MiB, WS_LDO = 191 * MiB, WS_Y = 63 * MiB, WS_LDA = 239 * MiB;
constexpr size_t WS_END = 256 * MiB;
static_assert(WS_LDO + (size_t)M * NLD * 2 <= WS_LDA && WS_LDA + (size_t)M * 512 * 2 <= WS_END && WS_TMP + (size_t)M * D * 2 <= WS_END, "tail of the map");
static_assert(WS_MIXA == WS_XN + 32 * MiB && WS_MIXB == WS_XN + 64 * MiB && WS_K == WS_R + 32 * MiB && WS_LDO == WS_R + 64 * MiB && WS_WK_T == WS_WR_T + 2 * MiB && WS_LDW_T == WS_WR_T + 4 * MiB, "grouped GEMM strides");
constexpr int CW_BAR = 4096;

constexpr int RING_BYTES = 131072, LDSCTL_OFF = 143360, MISC_OFF = LDSCTL_OFF + 320, LDS_BYTES = 147456;

typedef __bf16 bf16x2_t __attribute__((ext_vector_type(2)));
__device__ __forceinline__ unsigned cvtpk(float lo, float hi) { const f32x2 v = {lo, hi}; const bf16x2_t b = __builtin_convertvector(v, bf16x2_t); return __builtin_bit_cast(unsigned, b); }
__device__ __forceinline__ float bf2f(unsigned short b) { return __uint_as_float((unsigned)b << 16); }
__device__ __forceinline__ float bflo(unsigned w) { return __uint_as_float(w << 16); }
__device__ __forceinline__ float bfhi(unsigned w) { return __uint_as_float(w & 0xffff0000u); }
__device__ __forceinline__ unsigned f2bf(float f) { unsigned u = __float_as_uint(f); return (u + 0x7fffu + ((u >> 16) & 1u)) >> 16; }
__device__ __forceinline__ unsigned pk2(float lo, float hi) { return f2bf(lo) | (f2bf(hi) << 16); }
__device__ __forceinline__ float wave_sum(float v) {
#pragma unroll
    for (int o = 1; o < 64; o <<= 1) v += __shfl_xor(v, o);
    return v;
}
__device__ __forceinline__ float sigmoidf_(float z) { return 1.f / (1.f + __expf(-z)); }
__device__ __forceinline__ int t5_bucket(int rel) {
    const int n = rel < 0 ? -rel : rel;
    int large;
    if (n < 8) large = n; else if (n < 15) large = 8; else if (n < 27) large = 9; else if (n < 50) large = 10; else if (n < 91) large = 11;
    else if (n < 166) large = 12; else if (n < 305) large = 13; else if (n < 559) large = 14; else large = 15;
    return (rel > 0 ? 16 : 0) + large;
}

#define XB_TMO      128
#define XB_XCNT(j)  (256  + 64 * (j))
#define XB_XSUB(j)  (1280 + 64 * (j))
#define XB_XGEN(j)  (2304 + 64 * (j))
#define XB_TOP      3328
#define XB_TOPGEN   3392
#define XCD_BAR_WORDS 3456
#define XB_SPIN_CAP (1u << 18)
__device__ __forceinline__ unsigned xb_ld(unsigned* p)              { return __hip_atomic_load(p, __ATOMIC_RELAXED, __HIP_MEMORY_SCOPE_AGENT); }
__device__ __forceinline__ unsigned xb_add(unsigned* p, unsigned v) { return __hip_atomic_fetch_add(p, v, __ATOMIC_RELAXED, __HIP_MEMORY_SCOPE_AGENT); }
__device__ __forceinline__ unsigned xb_xcc_id() { return (unsigned)__builtin_amdgcn_s_getreg((3 << 11) | 20) & 0xFu; }
#define XB_SPIN(cond, bar) do { unsigned _sp = 0; while (cond) { __builtin_amdgcn_s_sleep(1); \
    if ((++_sp & 255u) == 0u) { if (xb_ld(&(bar)[XB_TMO])) break; if (_sp > XB_SPIN_CAP) { atomicAdd(&(bar)[XB_TMO], 1u); break; } } } } while (0)
struct XcdBarrier { unsigned* bar; unsigned x; volatile LAS unsigned* st; };
__device__ __forceinline__ XcdBarrier xcd_barrier_post(unsigned* bar, volatile LAS unsigned* st) {
    XcdBarrier b; b.bar = bar; b.x = xb_xcc_id(); b.st = st;
    if (threadIdx.x == 0) (void)xb_add(&bar[XB_XCNT(b.x)], 1u);
    return b;
}
__device__ __forceinline__ void xcd_barrier_complete(unsigned* bar, unsigned x, unsigned& nloc, unsigned& nx) {
    const unsigned G = gridDim.x * gridDim.y * gridDim.z;
    unsigned sum, cnt, mine, sp = 0u;
    for (;;) {
        sum = 0u; cnt = 0u; mine = 0u;
#pragma unroll
        for (unsigned j = 0; j < 16; ++j) { const unsigned c = xb_ld(&bar[XB_XCNT(j)]); sum += c; cnt += (c > 0u) ? 1u : 0u; mine = (j == x) ? c : mine; }
        if (sum == G) break;
        __builtin_amdgcn_s_sleep(1);
        if ((++sp & 255u) == 0u) { if (xb_ld(&bar[XB_TMO])) break; if (sp > XB_SPIN_CAP) { atomicAdd(&bar[XB_TMO], 1u); break; } }
    }
    nloc = mine > 0u ? mine : 1u; nx = cnt > 0u ? cnt : 1u;
}
__device__ __forceinline__ void xcd_barrier(const XcdBarrier& b) {
    asm volatile("s_waitcnt vmcnt(0)" ::: "memory");
    __syncthreads();
    if (threadIdx.x == 0) {
        unsigned* bar = b.bar;
        __builtin_amdgcn_s_waitcnt(0);
        unsigned nloc = b.st[0], nx = b.st[1];
        if (nloc == 0u) { xcd_barrier_complete(bar, b.x, nloc, nx); b.st[0] = nloc; b.st[1] = nx; }
        const unsigned old = xb_add(&bar[XB_XSUB(b.x)], 1u);
        const unsigned gen = old / nloc;
        if (old + 1u == (gen + 1u) * nloc) {
            __builtin_amdgcn_fence(__ATOMIC_RELEASE, "agent");
            asm volatile("s_waitcnt vmcnt(0)" ::: "memory");
            const unsigned og = xb_add(&bar[XB_TOP], 1u);
            const unsigned tg = og / nx;
            if (og + 1u == (tg + 1u) * nx) xb_add(&bar[XB_TOPGEN], 1u);
            else XB_SPIN(xb_ld(&bar[XB_TOPGEN]) == tg, bar);
            __builtin_amdgcn_fence(__ATOMIC_ACQUIRE, "agent");
            xb_add(&bar[XB_XGEN(b.x)], 1u);
            asm volatile("s_waitcnt vmcnt(0)" ::: "memory");
        } else {
            XB_SPIN(xb_ld(&bar[XB_XGEN(b.x)]) == gen, bar);
            __builtin_amdgcn_fence(__ATOMIC_ACQUIRE, "agent");
            asm volatile("s_waitcnt vmcnt(0)" ::: "memory");
        }
    }
    __syncthreads();
}

struct Row16 { f32x4 v[4]; };
__device__ __forceinline__ void row_load_f32(Row16& r, const float* p, int lane) {
#pragma unroll
    for (int j = 0; j < 4; ++j) r.v[j] = ((const f32x4*)p)[lane + 64 * j];
}
__device__ __forceinline__ void row_load_bf16(Row16& r, const bf16_t* p, int lane) {
#pragma unroll
    for (int j = 0; j < 4; ++j) { const u32x2 w = ((const u32x2*)p)[lane + 64 * j]; r.v[j] = (f32x4){bflo(w.x), bfhi(w.x), bflo(w.y), bfhi(w.y)}; }
}
__device__ __forceinline__ void row_store_f32(const Row16& r, float* p, int lane) {
#pragma unroll
    for (int j = 0; j < 4; ++j) pg8::store16_wt((f32x4*)p + lane + 64 * j, __builtin_bit_cast(u32x4, r.v[j]));
}
__device__ __forceinline__ void row_store_bf16(const Row16& r, bf16_t* p, int lane) {
#pragma unroll
    for (int j = 0; j < 4; ++j) { u32x2 w; w.x = pk2(r.v[j][0], r.v[j][1]); w.y = pk2(r.v[j][2], r.v[j][3]); ((u32x2*)p)[lane + 64 * j] = w; }
}
__device__ __forceinline__ void row_rmsnorm(Row16& r, const float* g, int lane) {
    float s = 0.f;
#pragma unroll
    for (int j = 0; j < 4; ++j) s += r.v[j][0] * r.v[j][0] + r.v[j][1] * r.v[j][1] + r.v[j][2] * r.v[j][2] + r.v[j][3] * r.v[j][3];
    const float rs = rsqrtf(wave_sum(s) * (1.f / D) + NORM_EPS);
#pragma unroll
    for (int j = 0; j < 4; ++j) { const f32x4 gg = ((const f32x4*)g)[lane + 64 * j]; r.v[j] = r.v[j] * rs * gg; }
}

constexpr int TR_SCR_BYTES = 64 * 65 * 4;
template <class ScaleFn>
__device__ __forceinline__ void transpose_item(const float* W, int ldw, int N, bf16_t* WT, int ldt, int row_off, int koff, LAS float* scr, int item, int lane, ScaleFn sc) {
    const int nblk = N / 64, kb = item / nblk, nb = item % nblk, k0 = 64 * kb, n0 = 64 * nb;
    const int lk = lane >> 4, ln4 = (lane & 15) * 4;
    f32x4 v[16];
#pragma unroll
    for (int i = 0; i < 16; ++i) v[i] = *(const f32x4*)(W + (size_t)(k0 + 4 * i + lk) * ldw + n0 + ln4);
#pragma unroll
    for (int i = 0; i < 16; ++i) { const int kk = 4 * i + lk; const float s = sc(k0 + kk); LAS float* d = scr + kk * 65 + ln4; d[0] = v[i][0] * s; d[1] = v[i][1] * s; d[2] = v[i][2] * s; d[3] = v[i][3] * s; }
    asm volatile("s_waitcnt lgkmcnt(0)" ::: "memory");
    const int c = lane >> 3, nn = lane & 7;
#pragma unroll
    for (int j = 0; j < 8; ++j) { const int n = nn + 8 * j; const LAS float* s = scr + (8 * c) * 65 + n;
        u32x4 o; o.x = cvtpk(s[0 * 65], s[1 * 65]); o.y = cvtpk(s[2 * 65], s[3 * 65]); o.z = cvtpk(s[4 * 65], s[5 * 65]); o.w = cvtpk(s[6 * 65], s[7 * 65]);
        pg8::store16_wt(WT + (size_t)(row_off + n0 + n) * ldt + koff + k0 + 8 * c, o); }
    asm volatile("s_waitcnt lgkmcnt(0)" ::: "memory");
}
struct ScaleOne { __device__ __forceinline__ float operator()(int) const { return 1.f; } };
struct ScaleMix { const float* mp; const float* mn; int part;
    __device__ __forceinline__ float operator()(int k) const { return part == 0 ? 1.f - mp[k] - mn[k] : (part == 1 ? mp[k] : mn[k]); } };

struct Args { const float* in[27]; float* out; unsigned char* ws; };

struct ProbPlain { const bf16_t* A; const bf16_t* Bt; int K;
    __device__ __forceinline__ const char* a_tile(const pg8::Unit& u) const { return (const char*)(A + (size_t)u.pm * 256 * K); }
    __device__ __forceinline__ const char* b_tile(const pg8::Unit& u) const { return (const char*)(Bt + (size_t)u.pn * 256 * K); } };
struct DstPlain { bf16_t* C; int ldc;
    __device__ __forceinline__ void operator()(const pg8::Unit& u, bf16_t*& base, int& ld) const { base = C + (size_t)u.pm * 256 * ldc + (size_t)u.pn * 256; ld = ldc; } };
struct ProbRKL { const unsigned char* ws; int K;
    __device__ __forceinline__ const char* a_tile(const pg8::Unit& u) const { const int g = u.pn < 4 ? 0 : (u.pn < 8 ? 1 : 2); const int ga = g == 2 ? 0 : g + 1;
        return (const char*)(ws + WS_XN + (size_t)ga * (32 * MiB) + (size_t)u.pm * 256 * D * 2); }
    __device__ __forceinline__ const char* b_tile(const pg8::Unit& u) const { const int g = u.pn < 4 ? 0 : (u.pn < 8 ? 1 : 2); const int t = u.pn - 4 * g;
        return (const char*)(ws + WS_WR_T + (size_t)g * (2 * MiB) + (size_t)t * 256 * D * 2); } };
struct DstRKL { unsigned char* ws;
    __device__ __forceinline__ void operator()(const pg8::Unit& u, bf16_t*& base, int& ld) const {
        const int g = u.pn < 4 ? 0 : (u.pn < 8 ? 1 : 2); const int t = u.pn - 4 * g; ld = g == 2 ? NLD : D;
        base = (bf16_t*)(ws + WS_R + (size_t)g * (32 * MiB)) + (size_t)u.pm * 256 * ld + (size_t)t * 256; } };


struct EpiHeadMajor {
    static constexpr bool PERM = true;
    bf16_t* O;
    __device__ __forceinline__ void operator()(const f32x4 (&acc)[2][2][4][2], const pg8::Unit& u, int wr, int wc, int fr, int fq) const {
        const int row0 = u.pm * 256 + wr * 64 + fr, col = (wc & 1) * 32 + 8 * fq;
#pragma unroll
        for (int bj = 0; bj < 2; ++bj) { bf16_t* hb = O + ((size_t)(u.pn * 4 + bj * 2 + (wc >> 1)) * M + row0) * 64 + col;
#pragma unroll
            for (int ai = 0; ai < 2; ++ai)
#pragma unroll
                for (int m = 0; m < 4; ++m) { const f32x4 v0 = acc[ai][bj][m][0], v1 = acc[ai][bj][m][1];
                    u32x4 w; w.x = cvtpk(v0[0], v0[1]); w.y = cvtpk(v0[2], v0[3]); w.z = cvtpk(v1[0], v1[1]); w.w = cvtpk(v1[2], v1[3]);
                    pg8::store16_wt(hb + (size_t)(ai * 128 + m * 16) * 64, w); } }
    }
};

template <int ACT, class Prob, class Dst>
__device__ __forceinline__ void run_gemm(LAS unsigned char* lds, const Prob& P, const Dst& Dd, int Mr, int Nv, int G) {
    pg8::StaticOrder S; S.init(Mr, Nv, G, (int)blockIdx.x);
    pg8::EpiBf16<ACT, Dst> E{Dd};
    pg8::gemm_phase<pg8::EpiBf16<ACT, Dst>, Prob, true, true>(lds, P, S, E);
}

__device__ __forceinline__ void phase_resnorm(const float* base, const bf16_t* TMP, const float* g1, const float* g2, float* hout, bf16_t* XN, int gw, int NGW, int lane) {
    for (int row = gw; row < M; row += NGW) {
        Row16 t, b; row_load_bf16(t, TMP + (size_t)row * D, lane); row_load_f32(b, base + (size_t)row * D, lane);
        row_rmsnorm(t, g1, lane);
#pragma unroll
        for (int j = 0; j < 4; ++j) b.v[j] = b.v[j] + t.v[j];
        row_store_f32(b, hout + (size_t)row * D, lane);
        if (XN) { row_rmsnorm(b, g2, lane); row_store_bf16(b, XN + (size_t)row * D, lane); }
    }
}
__device__ __forceinline__ void phase_lda(const bf16_t* LDO, bf16_t* LDA, int gw, int NGW, int lane) {
    const float A = lane < 16 ? 2.f : 1.f, C = lane < 16 ? -1.f : 0.f; const bool id = lane >= 16 && lane < 32;
    for (int row = gw; row < M; row += NGW) { const int tt = row & (SEQ - 1);
        const u32x4 p0 = *(const u32x4*)(LDO + (size_t)row * NLD + 8 * lane);
        const u32x4 p1 = *(const u32x4*)(LDO + (size_t)(tt > 0 ? row - 1 : row) * NLD + 512 + 8 * lane), p2 = *(const u32x4*)(LDO + (size_t)(tt < SEQ - 1 ? row + 1 : row) * NLD + 1024 + 8 * lane);
        const float mp = tt > 0 ? 1.f : 0.f, mn = tt < SEQ - 1 ? 1.f : 0.f;
        u32x4 o;
#pragma unroll
        for (int w = 0; w < 4; ++w) { const float x0 = bflo(p0[w]) + mp * bflo(p1[w]) + mn * bflo(p2[w]), x1 = bfhi(p0[w]) + mp * bfhi(p1[w]) + mn * bfhi(p2[w]);
            const float y0 = A * __builtin_amdgcn_rcpf(1.f + __builtin_amdgcn_exp2f(-1.4426950408889634f * A * x0)) + C, y1 = A * __builtin_amdgcn_rcpf(1.f + __builtin_amdgcn_exp2f(-1.4426950408889634f * A * x1)) + C;
            o[w] = cvtpk(id ? x0 : y0, id ? x1 : y1); }
        pg8::store16_wt(LDA + (size_t)row * 512 + 8 * lane, o); }
}
template <bool FIRST>
__device__ __forceinline__ void phase_mix(const float* h, const float* g, const float* mup, const float* mun, bf16_t* XN, bf16_t* MA, bf16_t* MB, int gw, int NGW, int lane) {
    for (int row = gw; row < M; row += NGW) {
        const int tt = row & (SEQ - 1);
        Row16 u, up, un;
        row_load_f32(u, h + (size_t)row * D, lane); row_rmsnorm(u, g, lane);
        if (tt > 0) { row_load_f32(up, h + (size_t)(row - 1) * D, lane); row_rmsnorm(up, g, lane); } else {
#pragma unroll
            for (int j = 0; j < 4; ++j) up.v[j] = (f32x4){0.f, 0.f, 0.f, 0.f}; }
        if (tt < SEQ - 1) { row_load_f32(un, h + (size_t)(row + 1) * D, lane); row_rmsnorm(un, g, lane); } else {
#pragma unroll
            for (int j = 0; j < 4; ++j) un.v[j] = (f32x4){0.f, 0.f, 0.f, 0.f}; }
        if (FIRST) row_store_bf16(u, XN + (size_t)row * D, lane);
        constexpr int NC = FIRST ? 2 : 1;
#pragma unroll
        for (int ci = 0; ci < NC; ++ci) { const int c = FIRST ? (ci == 0 ? 0 : 2) : 3;
            Row16 o;
#pragma unroll
            for (int j = 0; j < 4; ++j) { const f32x4 a = ((const f32x4*)(mup + c * D))[lane + 64 * j], b = ((const f32x4*)(mun + c * D))[lane + 64 * j];
                o.v[j] = u.v[j] + (up.v[j] - u.v[j]) * a + (un.v[j] - u.v[j]) * b; }
            row_store_bf16(o, (ci == 0 ? MA : MB) + (size_t)row * D, lane); }
    }
}

constexpr int ATT_ROWS = 400, ATT_KS = 0, ATT_VS = ATT_ROWS * 128, ATT_TAB = 2 * ATT_ROWS * 128, ATT_TABN = 320;
constexpr float LOG2E = 1.4426950408889634f;
typedef short v4i16_t __attribute__((ext_vector_type(4)));
__device__ __forceinline__ v4i16_t lds_tr16(LAS const unsigned char* p) { return __builtin_amdgcn_ds_read_tr16_b64_v4i16((LAS v4i16_t*)p); }

__device__ __forceinline__ float rows_max(float x) {
    auto a = __builtin_amdgcn_permlane16_swap(__float_as_uint(x), __float_as_uint(x), false, false); x = fmaxf(__uint_as_float(a[0]), __uint_as_float(a[1]));
    auto b = __builtin_amdgcn_permlane32_swap(__float_as_uint(x), __float_as_uint(x), false, false); return fmaxf(__uint_as_float(b[0]), __uint_as_float(b[1])); }
__device__ __forceinline__ float rows_sum(float x) {
    auto a = __builtin_amdgcn_permlane16_swap(__float_as_uint(x), __float_as_uint(x), false, false); x = __uint_as_float(a[0]) + __uint_as_float(a[1]);
    auto b = __builtin_amdgcn_permlane32_swap(__float_as_uint(x), __float_as_uint(x), false, false); return __uint_as_float(b[0]) + __uint_as_float(b[1]); }
struct AttnIO { const bf16_t* QKV; const float* rel_table; const float* sink; bf16_t* O; bf16_t* OBR; float* LSE; };
struct AttnUnitD { int b, dil, res, l0, nq, L, R, colK, colV, head0, ngroups, nit, branch, isB; };
__device__ __forceinline__ AttnUnitD attn_decode(int u) {
    AttnUnitD A;
    if (u < 256) { A.isB = 1; A.b = u >> 5; const int kvg = (u >> 4) & 1, blk = u & 15; A.dil = 1; A.res = 0; A.l0 = blk * 128; A.nq = 128; A.L = SEQ; A.R = 128; A.colK = 32 + kvg; A.colV = 34 + kvg; A.head0 = kvg * 4; A.ngroups = 32; A.nit = 9; A.branch = 0; }
    else if (u < 1280) { A.isB = 0; const int a = u - 256, bh = a >> 4, k = a & 15; A.b = bh >> 3; A.head0 = bh & 7; A.nq = 256; A.R = 64; A.ngroups = 16; A.nit = 5;
        if (k < 8) { A.dil = 1; A.res = 0; A.l0 = k * 256; A.L = SEQ; A.branch = 0; } else { A.dil = 4; A.res = (k - 8) >> 1; A.l0 = ((k - 8) & 1) * 256; A.L = SEQ / 4; A.branch = 1; }
        A.colK = 8 + A.head0; A.colV = 16 + A.head0; }
    else { A.isB = 0; const int a = u - 1280, bh = a >> 4; A.b = bh >> 3; A.head0 = bh & 7; A.dil = 16; A.res = a & 15; A.l0 = 0; A.nq = 128; A.L = SEQ / 16; A.R = 64; A.ngroups = 8; A.nit = 5; A.branch = 2; A.colK = 8 + A.head0; A.colV = 16 + A.head0; }
    return A;
}
constexpr int ATT_NST = 7;
__device__ __forceinline__ void attn_issue(const AttnUnitD& A, const bf16_t* QKV, int tid, u32x4 (&kr)[ATT_NST], u32x4 (&vr)[ATT_NST]) {
    const int ndata = A.nq + 2 * A.R, rv0 = (A.R - A.l0) > 0 ? (A.R - A.l0) : 0, rv1 = (A.L + A.R - A.l0) < ndata ? (A.L + A.R - A.l0) : ndata;
    const bf16_t* kb = QKV + ((size_t)A.colK * M + (size_t)A.b * SEQ) * 64; const bf16_t* vb = QKV + ((size_t)A.colV * M + (size_t)A.b * SEQ) * 64;
#pragma unroll
    for (int i = 0; i < ATT_NST; ++i) { const int x = tid + NTHREADS * i, c = x & 7; int row = x >> 3; row = row < rv0 ? rv0 : (row >= rv1 ? rv1 - 1 : row);
        const size_t o = (size_t)(A.res + A.dil * (A.l0 - A.R + row)) * 64 + c * 8; kr[i] = *(const u32x4*)(kb + o); vr[i] = *(const u32x4*)(vb + o); }
}

__device__ __forceinline__ void phase_attn(LAS unsigned char* lds, const AttnIO& io, int vcu, int G) {
    int tid = threadIdx.x; asm volatile("" : "+v"(tid));
    const int lane = tid & 63, wid = __builtin_amdgcn_readfirstlane(tid >> 6), g4 = lane >> 4, qi = lane & 15;
    LAS unsigned char* Ks = lds + ATT_KS; LAS unsigned char* Vs = lds + ATT_VS; LAS float* tab = (LAS float*)(lds + ATT_TAB);
    constexpr int NU = 256 + 1024 + 1024;
    u32x4 kr[ATT_NST], vr[ATT_NST];
    if (vcu < NU) { const AttnUnitD A0 = attn_decode(vcu); attn_issue(A0, io.QKV, tid, kr, vr); }
    for (int u = vcu; u < NU; u += G) {
        const AttnUnitD A = attn_decode(u);
        const int b = A.b, dil = A.dil, res = A.res, l0 = A.l0, R = A.R, head0 = A.head0, ngroups = A.ngroups, nit = A.nit, branch = A.branch; const bool isB = A.isB != 0;
        const int ndata = A.nq + 2 * R, rv0 = (R - l0) > 0 ? (R - l0) : 0, rv1 = (A.L + R - l0) < ndata ? (A.L + R - l0) : ndata;
        {
        __syncthreads();
#pragma unroll
        for (int i = 0; i < ATT_NST; ++i) { const int x = tid + NTHREADS * i, row = x >> 3, c = x & 7;
            if (x < ATT_ROWS * 8) { const int off = row * 128 + ((c ^ (row & 7)) << 4); const bool ok = row >= rv0 && row < rv1; const u32x4 z = (u32x4){0u, 0u, 0u, 0u};
                *(LAS u32x4*)(Ks + off) = ok ? kr[i] : z; *(LAS u32x4*)(Vs + off) = ok ? vr[i] : z; } }
        { const int ntab = isB ? 4 : 1;
          for (int x = tid; x < ntab * ATT_TABN; x += NTHREADS) { const int t = x / ATT_TABN, j = x % ATT_TABN, idx = j - 16;
              float v = -1e30f;
              if (idx >= 0 && idx <= 2 * R) v = io.rel_table[t5_bucket((idx - R) * dil) * 16 + (isB ? 8 + head0 + t : head0)] * LOG2E;
              tab[x] = v; } }
        }
        if (u + G < NU) { const AttnUnitD An = attn_decode(u + G); attn_issue(An, io.QKV, tid, kr, vr); }
        __syncthreads();
        for (int gidx = wid; gidx < ngroups; gidx += NWAVES) {
            const int hq = isB ? (gidx >> 3) : 0, gi = isB ? (gidx & 7) : gidx, head = head0 + hq;
            const int ql = 16 * gi + qi, posq = res + dil * (l0 + ql);
            const LAS float* tb = tab + hq * ATT_TABN + 16;
            bf16x8 qf[2];
            { const bf16_t* qp = io.QKV + ((size_t)((isB ? 24 : 0) + head) * M + (size_t)b * SEQ + posq) * 64 + 8 * g4; const float SC = 0.125f * LOG2E;
#pragma unroll
              for (int ks = 0; ks < 2; ++ks) { const u32x4 w = *(const u32x4*)(qp + 32 * ks); u32x4 o;
                  o.x = cvtpk(bflo(w.x) * SC, bfhi(w.x) * SC); o.y = cvtpk(bflo(w.y) * SC, bfhi(w.y) * SC); o.z = cvtpk(bflo(w.z) * SC, bfhi(w.z) * SC); o.w = cvtpk(bflo(w.w) * SC, bfhi(w.w) * SC);
                  qf[ks] = __builtin_bit_cast(bf16x8, o); } }
            f32x4 ot[4];
#pragma unroll
            for (int dt = 0; dt < 4; ++dt) ot[dt] = (f32x4){0.f, 0.f, 0.f, 0.f};
            float m = -1e20f, lsum = 0.f;
            bf16x8 kf[2][2];
            { const int r0 = 16 * gi + qi;
#pragma unroll
              for (int ks = 0; ks < 2; ++ks) { const int c = g4 + 4 * ks; const int off = r0 * 128 + ((c ^ (r0 & 7)) << 4); kf[ks][0] = *(const LAS bf16x8*)(Ks + off); kf[ks][1] = *(const LAS bf16x8*)(Ks + off + 16 * 128); } }
            for (int it = 0; it < nit; ++it) {
                const int rb = 16 * gi + 32 * it;
                v4i16_t vlo[4], vhi[4];
                { const int ra = rb + 4 * g4 + (qi >> 2);
#pragma unroll
                  for (int dt = 0; dt < 4; ++dt) { const int ch = dt * 2 + ((qi & 3) >> 1); const int off = ra * 128 + ((ch ^ (ra & 7)) << 4) + 8 * (qi & 1); vlo[dt] = lds_tr16(Vs + off); vhi[dt] = lds_tr16(Vs + off + 16 * 128); } }
                f32x4 s0 = (f32x4){0.f, 0.f, 0.f, 0.f}, s1 = s0;
#pragma unroll
                for (int ks = 0; ks < 2; ++ks) { s0 = __builtin_amdgcn_mfma_f32_16x16x32_bf16(kf[ks][0], qf[ks], s0, 0, 0, 0); s1 = __builtin_amdgcn_mfma_f32_16x16x32_bf16(kf[ks][1], qf[ks], s1, 0, 0, 0); }
                if (it + 1 < nit) { const int r0 = rb + 32 + qi;
#pragma unroll
                    for (int ks = 0; ks < 2; ++ks) { const int c = g4 + 4 * ks; const int off = r0 * 128 + ((c ^ (r0 & 7)) << 4); kf[ks][0] = *(const LAS bf16x8*)(Ks + off); kf[ks][1] = *(const LAS bf16x8*)(Ks + off + 16 * 128); } }
                float v[8]; float tmax = -1e30f;
                float tb0[4], tb1[4];
#pragma unroll
                for (int r = 0; r < 4; ++r) { tb0[r] = tb[rb + 4 * g4 + r - ql]; tb1[r] = tb[rb + 4 * g4 + r + 16 - ql]; }
#pragma unroll
                for (int r = 0; r < 4; ++r) { const int row0 = rb + 4 * g4 + r, row1 = row0 + 16;
                    const bool ok0 = (unsigned)(row0 - rv0) < (unsigned)(rv1 - rv0), ok1 = (unsigned)(row1 - rv0) < (unsigned)(rv1 - rv0);
                    const float a = ok0 ? s0[r] + tb0[r] : -1e30f, c2 = ok1 ? s1[r] + tb1[r] : -1e30f;
                    v[r] = a; v[4 + r] = c2; tmax = fmaxf(tmax, fmaxf(a, c2)); }
                tmax = rows_max(tmax);
                const float mn = fmaxf(m, tmax), alpha = __builtin_amdgcn_exp2f(m - mn); m = mn;
                float ps = 0.f;
#pragma unroll
                for (int i = 0; i < 8; ++i) { v[i] = __builtin_amdgcn_exp2f(v[i] - mn); ps += v[i]; }
                lsum = lsum * alpha + ps;
#pragma unroll
                for (int dt = 0; dt < 4; ++dt) ot[dt] = ot[dt] * alpha;
                u32x4 pw; pw.x = cvtpk(v[0], v[1]); pw.y = cvtpk(v[2], v[3]); pw.z = cvtpk(v[4], v[5]); pw.w = cvtpk(v[6], v[7]);
                const bf16x8 pf = __builtin_bit_cast(bf16x8, pw);
#pragma unroll
                for (int dt = 0; dt < 4; ++dt) { const bf16x8 vf = (bf16x8){vlo[dt][0], vlo[dt][1], vlo[dt][2], vlo[dt][3], vhi[dt][0], vhi[dt][1], vhi[dt][2], vhi[dt][3]};
                    ot[dt] = __builtin_amdgcn_mfma_f32_16x16x32_bf16(vf, pf, ot[dt], 0, 0, 0); }
            }
            lsum = rows_sum(lsum);
            const size_t tok = (size_t)b * SEQ + posq;
            float scale;
            if (isB) { const float s2 = io.sink[head] * LOG2E, mf = fmaxf(m, s2), e = __builtin_amdgcn_exp2f(m - mf); scale = e / (lsum * e + __builtin_amdgcn_exp2f(s2 - mf)); }
            else { scale = 1.f / lsum; if (g4 == 0) io.LSE[((size_t)branch * M + tok) * 8 + head] = m + __builtin_amdgcn_logf(lsum); }
            bf16_t* op = isB ? io.O + tok * D + 512 + head * 64 : io.OBR + ((size_t)branch * M + tok) * 512 + head * 64;
#pragma unroll
            for (int dt = 0; dt < 4; ++dt) { const f32x4 o = ot[dt] * scale; u32x2 w; w.x = cvtpk(o[0], o[1]); w.y = cvtpk(o[2], o[3]); *(u32x2*)(op + dt * 16 + 4 * g4) = w; }
        }
    }
}
__device__ __forceinline__ void phase_attn_merge(const AttnIO& io, int gtid, int NGT) {
    for (int x = gtid; x < M * 64; x += NGT) { const int tok = x >> 6, head = (x >> 3) & 7, c8 = x & 7;
        const float l0 = io.LSE[((size_t)0 * M + tok) * 8 + head], l1 = io.LSE[((size_t)1 * M + tok) * 8 + head], l2 = io.LSE[((size_t)2 * M + tok) * 8 + head];
        const float mx = fmaxf(l0, fmaxf(l1, l2)); float w0 = __builtin_amdgcn_exp2f(l0 - mx), w1 = __builtin_amdgcn_exp2f(l1 - mx), w2 = __builtin_amdgcn_exp2f(l2 - mx);
        const float inv = 1.f / (w0 + w1 + w2); w0 *= inv; w1 *= inv; w2 *= inv;
        const size_t o = (size_t)tok * 512 + head * 64 + c8 * 8;
        const u32x4 a = *(const u32x4*)(io.OBR + o), bq = *(const u32x4*)(io.OBR + (size_t)M * 512 + o), c = *(const u32x4*)(io.OBR + (size_t)2 * M * 512 + o);
        u32x4 r;
        r.x = pk2(w0 * bflo(a.x) + w1 * bflo(bq.x) + w2 * bflo(c.x), w0 * bfhi(a.x) + w1 * bfhi(bq.x) + w2 * bfhi(c.x));
        r.y = pk2(w0 * bflo(a.y) + w1 * bflo(bq.y) + w2 * bflo(c.y), w0 * bfhi(a.y) + w1 * bfhi(bq.y) + w2 * bfhi(c.y));
        r.z = pk2(w0 * bflo(a.z) + w1 * bflo(bq.z) + w2 * bflo(c.z), w0 * bfhi(a.z) + w1 * bfhi(bq.z) + w2 * bfhi(c.z));
        r.w = pk2(w0 * bflo(a.w) + w1 * bflo(bq.w) + w2 * bflo(c.w), w0 * bfhi(a.w) + w1 * bfhi(bq.w) + w2 * bfhi(c.w));
        pg8::store16_wt(io.O + (size_t)tok * D + head * 64 + c8 * 8, r); }
}

constexpr int NCH = SEQ / 16;
constexpr int SC_LROW = 68, SC_LDROW = 528, SC_LSLOT = 4 * 16 * SC_LROW * 4 + 16 * SC_LDROW;
constexpr int CT_KHT = 0, CT_RHT = 2048, CT_BTT = 4096, CT_KTT = 6144, CT_VT = 8192, CT_WEND = 10240, CT_SLOT = CT_WEND + 256;
constexpr int GT_AKK = 0, GT_BB = 512, GT_BK = 1024, GT_TT = 1536, GT_SLOT = 2048;
constexpr int SC_LBUF = 0, SC_CT = SC_LBUF + 2 * SC_LSLOT, SC_GG = SC_CT + 3 * CT_SLOT, SC_RKR = SC_GG + 4 * 4096, SC_GT = SC_RKR + 4 * 256, SC_NB = SC_GT + 2 * GT_SLOT, SC_OUT = SC_NB + 1024, SC_END = SC_OUT + 2 * 4096;
static_assert(SC_END <= LDSCTL_OFF, "scan LDS map");
template <int CTRL> __device__ __forceinline__ float dpp_f(float x) { return __int_as_float(__builtin_amdgcn_update_dpp(0, __float_as_int(x), CTRL, 0xf, 0xf, true)); }
__device__ __forceinline__ float sum8(float x) { x += dpp_f<0xB1>(x); x += dpp_f<0x4E>(x); x += dpp_f<0x141>(x); return x; }
__device__ __forceinline__ float sum16(float x) { x += dpp_f<0xB1>(x); x += dpp_f<0x4E>(x); x += dpp_f<0x141>(x); x += dpp_f<0x140>(x); return x; }
__device__ __forceinline__ float fast_sigmoid(float z) { return __builtin_amdgcn_rcpf(1.f + __builtin_amdgcn_exp2f(-LOG2E * z)); }
__device__ __forceinline__ bf16x8 mk8(unsigned a, unsigned b, unsigned c, unsigned d) { return __builtin_bit_cast(bf16x8, (u32x4){a, b, c, d}); }

struct ScanPtrs { const bf16_t *R, *Kk, *V, *LDA; bf16_t* Y; const float *w2, *a2, *g2, *w0, *a0, *k_k, *k_a, *r_k, *gn_w, *gn_b; };
__device__ __forceinline__ void phase_scan(LAS unsigned char* lds, const ScanPtrs& P, int G) {
    int tid = threadIdx.x; asm volatile("" : "+v"(tid));
    const int lane = tid & 63, wid = __builtin_amdgcn_readfirstlane(tid >> 6), g4 = lane >> 4, c16 = lane & 15;
    for (int unit = blockIdx.x; unit < 256; unit += G) {
        const int b = unit >> 5, h = (unit >> 1) & 15, d = unit & 1, hc = h * 64;
        __syncthreads();
        if (wid < 4) {
            f32x4 ST[4];
#pragma unroll
            for (int mt = 0; mt < 4; ++mt) ST[mt] = (f32x4){0.f, 0.f, 0.f, 0.f};
            const int pch = hc + 8 * (lane & 7);
            const f32x4 gw0 = *(const f32x4*)(P.gn_w + pch), gw1 = *(const f32x4*)(P.gn_w + pch + 4), gb0 = *(const f32x4*)(P.gn_b + pch), gb1 = *(const f32x4*)(P.gn_b + pch + 4);
            u32x4 pvA = {0u, 0u, 0u, 0u}, pvB = pvA;
            auto issueV = [&](int ch_, u32x4& dst) { const int s = 8 * (wid - 1) + (lane >> 3), t = d ? (SEQ - 1 - (ch_ * 16 + s)) : (ch_ * 16 + s); dst = *(const u32x4*)(P.V + ((size_t)b * SEQ + t) * D + pch); };
            if (wid == 1 || wid == 2) { issueV(0, pvA); issueV(1, pvB); }
            auto sw_interval = [&](int i, u32x4& pvset) {
                const int c = i - 3;
                int ln = lane; asm volatile("" : "+v"(ln)); const int g4 = ln >> 4, c16 = ln & 15;
                if (c >= 0 && c < NCH) {
                    const LAS unsigned char* Ct = lds + SC_CT + (c % 3) * CT_SLOT; const LAS unsigned char* Gt = lds + SC_GT + (c & 1) * GT_SLOT;
                    v4i16_t kha[2][2], rha[2][2];
#pragma unroll
                    for (int p = 0; p < 2; ++p)
#pragma unroll
                        for (int hh = 0; hh < 2; ++hh) { const int off = (32 * p + 16 * hh + 4 * g4 + (c16 >> 2)) * 32 + 8 * (c16 & 3); kha[p][hh] = lds_tr16(Ct + CT_KHT + off); rha[p][hh] = lds_tr16(Ct + CT_RHT + off); }
                    const u32x2 gakk = *(const LAS u32x2*)(Gt + GT_AKK + c16 * 32 + 8 * g4), gtt = *(const LAS u32x2*)(Gt + GT_TT + c16 * 32 + 8 * g4);
                    const u32x2 gbb = *(const LAS u32x2*)(Gt + GT_BB + c16 * 32 + 8 * g4), gbk = *(const LAS u32x2*)(Gt + GT_BK + c16 * 32 + 8 * g4);
                    const u32x2 vt = *(const LAS u32x2*)(Ct + CT_VT + (16 * wid + c16) * 32 + 8 * g4);
                    u32x2 btt[4], ktt[4]; f32x4 we[4];
#pragma unroll
                    for (int mt = 0; mt < 4; ++mt) { btt[mt] = *(const LAS u32x2*)(Ct + CT_BTT + (16 * mt + c16) * 32 + 8 * g4); ktt[mt] = *(const LAS u32x2*)(Ct + CT_KTT + (16 * mt + c16) * 32 + 8 * g4);
                        we[mt] = *(const LAS f32x4*)(Ct + CT_WEND + (16 * mt + 4 * g4) * 4); }
                    f32x4 pt = {0.f, 0.f, 0.f, 0.f}, prt = pt;
#pragma unroll
                    for (int p = 0; p < 2; ++p) { const bf16x8 sb = mk8(cvtpk(ST[2 * p][0], ST[2 * p][1]), cvtpk(ST[2 * p][2], ST[2 * p][3]), cvtpk(ST[2 * p + 1][0], ST[2 * p + 1][1]), cvtpk(ST[2 * p + 1][2], ST[2 * p + 1][3]));
                        pt = __builtin_amdgcn_mfma_f32_16x16x32_bf16((bf16x8){kha[p][0][0], kha[p][0][1], kha[p][0][2], kha[p][0][3], kha[p][1][0], kha[p][1][1], kha[p][1][2], kha[p][1][3]}, sb, pt, 0, 0, 0);
                        prt = __builtin_amdgcn_mfma_f32_16x16x32_bf16((bf16x8){rha[p][0][0], rha[p][0][1], rha[p][0][2], rha[p][0][3], rha[p][1][0], rha[p][1][1], rha[p][1][2], rha[p][1][3]}, sb, prt, 0, 0, 0); }
                    const f32x4 qt = __builtin_amdgcn_mfma_f32_16x16x32_bf16(mk8(gakk.x, gakk.y, 0u, 0u), mk8(vt.x, vt.y, 0u, 0u), pt, 0, 0, 0);
                    const f32x4 sat = __builtin_amdgcn_mfma_f32_16x16x32_bf16(mk8(gtt.x, gtt.y, 0u, 0u), mk8(cvtpk(qt[0], qt[1]), cvtpk(qt[2], qt[3]), 0u, 0u), (f32x4){0.f, 0.f, 0.f, 0.f}, 0, 0, 0);
                    const bf16x8 sv = mk8(cvtpk(sat[0], sat[1]), cvtpk(sat[2], sat[3]), vt.x, vt.y);
                    const f32x4 outt = __builtin_amdgcn_mfma_f32_16x16x32_bf16(mk8(gbb.x, gbb.y, gbk.x, gbk.y), sv, prt, 0, 0, 0);
#pragma unroll
                    for (int mt = 0; mt < 4; ++mt) { ST[mt] = __builtin_amdgcn_mfma_f32_16x16x32_bf16(mk8(btt[mt].x, btt[mt].y, ktt[mt].x, ktt[mt].y), sv, ST[mt], 0, 0, 0); ST[mt] = ST[mt] * we[mt]; }
                    LAS float* ob = (LAS float*)(lds + SC_OUT + (c & 1) * 4096) + 16 * wid + c16;
#pragma unroll
                    for (int r = 0; r < 4; ++r) ob[(4 * g4 + r) * 64] = outt[r];
                }
                if (i >= 2 && i - 2 < NCH) {
                    const int jg = i - 2, hw = wid;
                    const LAS unsigned char* Ct = lds + SC_CT + (jg % 3) * CT_SLOT; LAS unsigned char* Gt = lds + SC_GT + (jg & 1) * GT_SLOT;
                    const int aoff = (hw & 1) ? CT_KTT : CT_BTT, boff = (hw & 2) ? CT_RHT : CT_KHT;
                    f32x4 gm = {0.f, 0.f, 0.f, 0.f}, gmT = gm;
#pragma unroll
                    for (int ks = 0; ks < 2; ++ks) { const int o1 = (8 * g4 + 32 * ks + (c16 >> 2)) * 32 + 8 * (c16 & 3), o2 = o1 + 4 * 32;
                        const v4i16_t a0 = lds_tr16(Ct + aoff + o1), a1 = lds_tr16(Ct + aoff + o2), b0 = lds_tr16(Ct + boff + o1), b1 = lds_tr16(Ct + boff + o2);
                        const bf16x8 af = {a0[0], a0[1], a0[2], a0[3], a1[0], a1[1], a1[2], a1[3]}, bfr = {b0[0], b0[1], b0[2], b0[3], b1[0], b1[1], b1[2], b1[3]};
                        gm = __builtin_amdgcn_mfma_f32_16x16x32_bf16(af, bfr, gm, 0, 0, 0);
                        if (hw == 0) gmT = __builtin_amdgcn_mfma_f32_16x16x32_bf16(bfr, af, gmT, 0, 0, 0); }
#pragma unroll
                    for (int r = 0; r < 4; ++r) { const int s = 4 * g4 + r; const bool keep = (hw & 2) ? (s <= c16) : (s < c16); gm[r] = keep ? gm[r] : 0.f; gmT[r] = (c16 < s) ? gmT[r] : 0.f; }
                    if (hw != 0) { *(LAS u32x2*)(Gt + (hw == 1 ? GT_AKK : (hw == 2 ? GT_BB : GT_BK)) + c16 * 32 + 8 * g4) = (u32x2){cvtpk(gm[0], gm[1]), cvtpk(gm[2], gm[3])}; }
                    else {
#define SC_OPA(x) mk8(cvtpk((x)[0], (x)[1]), cvtpk((x)[2], (x)[3]), 0u, 0u)
                        const f32x4 z4 = {0.f, 0.f, 0.f, 0.f};
                        f32x4 Rm, RTm;
#pragma unroll
                        for (int r = 0; r < 4; ++r) { const float idn = (4 * g4 + r == c16) ? 1.f : 0.f; Rm[r] = idn - gm[r]; RTm[r] = idn - gmT[r]; }
                        const f32x4 N2 = __builtin_amdgcn_mfma_f32_16x16x32_bf16(SC_OPA(gmT), SC_OPA(gm), z4, 0, 0, 0), N2T = __builtin_amdgcn_mfma_f32_16x16x32_bf16(SC_OPA(gm), SC_OPA(gmT), z4, 0, 0, 0);
                        f32x4 R1 = __builtin_amdgcn_mfma_f32_16x16x32_bf16(SC_OPA(RTm), SC_OPA(N2), Rm, 0, 0, 0), R1T = __builtin_amdgcn_mfma_f32_16x16x32_bf16(SC_OPA(N2), SC_OPA(RTm), RTm, 0, 0, 0);
                        const f32x4 N4 = __builtin_amdgcn_mfma_f32_16x16x32_bf16(SC_OPA(N2T), SC_OPA(N2), z4, 0, 0, 0), N4T = __builtin_amdgcn_mfma_f32_16x16x32_bf16(SC_OPA(N2), SC_OPA(N2T), z4, 0, 0, 0);
                        f32x4 R2 = __builtin_amdgcn_mfma_f32_16x16x32_bf16(SC_OPA(R1T), SC_OPA(N4), R1, 0, 0, 0), R2T = __builtin_amdgcn_mfma_f32_16x16x32_bf16(SC_OPA(N4), SC_OPA(R1T), R1T, 0, 0, 0);
                        const f32x4 N8 = __builtin_amdgcn_mfma_f32_16x16x32_bf16(SC_OPA(N4T), SC_OPA(N4), z4, 0, 0, 0);
                        const f32x4 Tm = __builtin_amdgcn_mfma_f32_16x16x32_bf16(SC_OPA(R2T), SC_OPA(N8), R2, 0, 0, 0);
#undef SC_OPA
                        *(LAS u32x2*)(Gt + GT_TT + c16 * 32 + 8 * g4) = (u32x2){cvtpk(-Tm[0], -Tm[1]), cvtpk(-Tm[2], -Tm[3])};
                    }
                }
                if ((wid == 1 || wid == 2) && i >= 4 && i - 4 < NCH) {
                    const int jp = i - 4, tl = ln >> 3, c8 = ln & 7;
                    const int s = 8 * (wid - 1) + tl, t = d ? (SEQ - 1 - (jp * 16 + s)) : (jp * 16 + s);
                    const LAS float* ob = (const LAS float*)(lds + SC_OUT + (jp & 1) * 4096) + s * 64 + 8 * c8; const LAS float* gp = (const LAS float*)(lds + SC_GG + (jp & 3) * 4096) + s * 64 + 8 * c8;
                    const f32x4 o0 = *(const LAS f32x4*)(ob), o1 = *(const LAS f32x4*)(ob + 4), g0 = *(const LAS f32x4*)(gp), g1 = *(const LAS f32x4*)(gp + 4);
                    const f32x4 rk4 = *(const LAS f32x4*)((const LAS float*)(lds + SC_RKR + (jp & 3) * 256) + s * 4); const float rkr = (rk4[0] + rk4[1]) + (rk4[2] + rk4[3]);
                    const u32x4 pv = pvset; issueV(jp + 2 < NCH ? jp + 2 : NCH - 1, pvset);
                    const f32x4 v0 = {bflo(pv.x), bfhi(pv.x), bflo(pv.y), bfhi(pv.y)}, v1 = {bflo(pv.z), bfhi(pv.z), bflo(pv.w), bfhi(pv.w)};
                    float mu = ((o0[0] + o0[1]) + (o0[2] + o0[3])) + ((o1[0] + o1[1]) + (o1[2] + o1[3])); mu = sum8(mu) * (1.f / 64.f);
                    const f32x4 d0 = o0 - mu, d1 = o1 - mu; float var = ((d0[0] * d0[0] + d0[1] * d0[1]) + (d0[2] * d0[2] + d0[3] * d0[3])) + ((d1[0] * d1[0] + d1[1] * d1[1]) + (d1[2] * d1[2] + d1[3] * d1[3])); var = sum8(var) * (1.f / 64.f);
                    const float rs = rsqrtf(var + GN_EPS);
                    const f32x4 y0 = (d0 * rs * gw0 + gb0 + rkr * v0) * g0, y1 = (d1 * rs * gw1 + gb1 + rkr * v1) * g1;
                    pg8::store16_wt(P.Y + ((size_t)b * SEQ + t) * (2 * D) + d * D + hc + 8 * c8, (u32x4){cvtpk(y0[0], y0[1]), cvtpk(y0[2], y0[3]), cvtpk(y1[0], y1[1]), cvtpk(y1[2], y1[3])});
                }
                __syncthreads();
            };
            static_assert((NCH + 4) % 2 == 0, "interval loop is unrolled by two");
            for (int i = 0; i < NCH + 4; i += 2) { sw_interval(i, pvA); sw_interval(i + 1, pvB); }
        } else {
            const int hw = wid - 4;
            const int chC = hc + 16 * hw + c16, chT = hc + 4 * c16;
            bf16x8 bw[2], ba[2], bg[4];
#pragma unroll
            for (int ks = 0; ks < 2; ++ks) { u32x4 w, a;
#pragma unroll
                for (int jj = 0; jj < 4; ++jj) { const int k = 32 * ks + 8 * g4 + 2 * jj;
                    w[jj] = pk2(P.w2[(size_t)(d * 64 + k) * D + chC], P.w2[(size_t)(d * 64 + k + 1) * D + chC]); a[jj] = pk2(P.a2[(size_t)(d * 64 + k) * D + chC], P.a2[(size_t)(d * 64 + k + 1) * D + chC]); }
                bw[ks] = __builtin_bit_cast(bf16x8, w); ba[ks] = __builtin_bit_cast(bf16x8, a); }
#pragma unroll
            for (int ks = 0; ks < 4; ++ks) { u32x4 g;
#pragma unroll
                for (int jj = 0; jj < 4; ++jj) { const int k = 32 * ks + 8 * g4 + 2 * jj; g[jj] = pk2(P.g2[(size_t)(d * 128 + k) * D + chC], P.g2[(size_t)(d * 128 + k + 1) * D + chC]); }
                bg[ks] = __builtin_bit_cast(bf16x8, g); }
            const float w0c = P.w0[d * D + chC], a0c = P.a0[d * D + chC], kaC = P.k_a[chC], rkC = P.r_k[chC];
            const f32x4 kkT = *(const f32x4*)(P.k_k + chT);
            const int n0 = 16 * c16, lcol = n0 < 64 ? (d * 64 + n0) : (n0 < 128 ? (128 + d * 64 + (n0 - 64)) : (256 + d * 128 + (n0 - 128)));
            struct LSet { u32x2 r, k, v; u32x4 l0, l1; };
            LSet setA, setB;
            auto issueL = [&](int ch_, LSet& S) { const int s = 4 * hw + g4, t = d ? (SEQ - 1 - (ch_ * 16 + s)) : (ch_ * 16 + s); const size_t row = (size_t)b * SEQ + t;
                S.r = *(const u32x2*)(P.R + row * D + chT); S.k = *(const u32x2*)(P.Kk + row * D + chT); S.v = *(const u32x2*)(P.V + row * D + chT);
                S.l0 = *(const u32x4*)(P.LDA + row * 512 + lcol); S.l1 = *(const u32x4*)(P.LDA + row * 512 + lcol + 8); };
            issueL(0, setA); issueL(1, setB);
            auto hw_interval = [&](int i, LSet& LS) {
                const bool doL = i < NCH, doC = (i >= 1 && i - 1 < NCH);
                int ln = lane; asm volatile("" : "+v"(ln)); const int g4 = ln >> 4, c16 = ln & 15;
                if (doC) {
                    const int jc = i - 1;
                    const LAS unsigned char* Ls = lds + SC_LBUF + (jc & 1) * SC_LSLOT;
                    const LAS unsigned char* ldp = Ls + 4 * 16 * SC_LROW * 4 + c16 * SC_LDROW + 16 * g4;
                    f32x4 zw = {0.f, 0.f, 0.f, 0.f}, za = zw, gg = zw;
#pragma unroll
                    for (int ks = 0; ks < 2; ++ks) { zw = __builtin_amdgcn_mfma_f32_16x16x32_bf16(*(const LAS bf16x8*)(ldp + 64 * ks), bw[ks], zw, 0, 0, 0);
                                                     za = __builtin_amdgcn_mfma_f32_16x16x32_bf16(*(const LAS bf16x8*)(ldp + 128 + 64 * ks), ba[ks], za, 0, 0, 0); }
#pragma unroll
                    for (int ks = 0; ks < 4; ++ks) gg = __builtin_amdgcn_mfma_f32_16x16x32_bf16(*(const LAS bf16x8*)(ldp + 256 + 64 * ks), bg[ks], gg, 0, 0, 0);
                    float lw[4], cw[4]; float tot = 0.f;
#pragma unroll
                    for (int r = 0; r < 4; ++r) { lw[r] = -0.6065306597f * fast_sigmoid(w0c + zw[r]); tot += lw[r]; cw[r] = tot; }
                    float pre;
                    { auto e = __builtin_amdgcn_permlane16_swap(__float_as_uint(tot), __float_as_uint(tot), false, false); const float e0 = __uint_as_float(e[0]), s01 = e0 + __uint_as_float(e[1]);
                      auto f = __builtin_amdgcn_permlane32_swap(__float_as_uint(s01), __float_as_uint(s01), false, false);
                      pre = ((g4 & 1) ? e0 : 0.f) + ((g4 & 2) ? __uint_as_float(f[0]) : 0.f); }
                    const LAS float* Lf = (const LAS float*)Ls + 16 * hw + c16;
                    LAS unsigned char* Ct = lds + SC_CT + (jc % 3) * CT_SLOT;
                    LAS float* ggw = (LAS float*)(lds + SC_GG + (jc & 3) * 4096) + 16 * hw + c16;
                    float kh[4], rh[4], bt[4], kt[4], vv[4], rkp[4];
#pragma unroll
                    for (int r = 0; r < 4; ++r) { const int tok = 4 * g4 + r; const float c = pre + cw[r];
                        const float Wc = __builtin_amdgcn_exp2f(LOG2E * c), Wp = __builtin_amdgcn_exp2f(LOG2E * (c - lw[r])), iW = __builtin_amdgcn_exp2f(-LOG2E * c);
                        const float a = fast_sigmoid(a0c + za[r]);
                        const float rr = Lf[tok * SC_LROW], kk_ = Lf[16 * SC_LROW + tok * SC_LROW], nk = Lf[32 * SC_LROW + tok * SC_LROW]; vv[r] = Lf[48 * SC_LROW + tok * SC_LROW];
                        const float kd = kk_ * (1.f + (a - 1.f) * kaC);
                        kh[r] = nk * Wp; rh[r] = rr * Wc; bt[r] = nk * a * iW; kt[r] = kd * iW; rkp[r] = rr * kd * rkC;
                        ggw[tok * 64] = gg[r];
                        if (tok == 15) ((LAS float*)(Ct + CT_WEND))[16 * hw + c16] = Wc; }
                    { LAS unsigned char* tq = Ct + (16 * hw + c16) * 32 + 8 * g4;
                      *(LAS u32x2*)(tq + CT_KHT) = (u32x2){cvtpk(kh[0], kh[1]), cvtpk(kh[2], kh[3])}; *(LAS u32x2*)(tq + CT_RHT) = (u32x2){cvtpk(rh[0], rh[1]), cvtpk(rh[2], rh[3])};
                      *(LAS u32x2*)(tq + CT_BTT) = (u32x2){cvtpk(bt[0], bt[1]), cvtpk(bt[2], bt[3])}; *(LAS u32x2*)(tq + CT_KTT) = (u32x2){cvtpk(kt[0], kt[1]), cvtpk(kt[2], kt[3])};
                      *(LAS u32x2*)(tq + CT_VT) = (u32x2){cvtpk(vv[0], vv[1]), cvtpk(vv[2], vv[3])}; }
#pragma unroll
                    for (int r = 0; r < 4; ++r) rkp[r] = sum16(rkp[r]);
                    if (c16 == 0) { LAS float* rk = (LAS float*)(lds + SC_RKR + (jc & 3) * 256) + hw;
#pragma unroll
                        for (int r = 0; r < 4; ++r) rk[(4 * g4 + r) * 4] = rkp[r]; }
                }
                if (doL) {
                    LAS unsigned char* Ls = lds + SC_LBUF + (i & 1) * SC_LSLOT; LAS float* Lf = (LAS float*)Ls;
                    const int s = 4 * hw + g4;
                    const u32x2 lr = LS.r, lk = LS.k, lv = LS.v; const u32x4 l00 = LS.l0, l01 = LS.l1;
                    issueL(i + 2 < NCH ? i + 2 : NCH - 1, LS);
                    const f32x4 rr = {bflo(lr.x), bfhi(lr.x), bflo(lr.y), bfhi(lr.y)}, kk_ = {bflo(lk.x), bfhi(lk.x), bflo(lk.y), bfhi(lk.y)}, vv = {bflo(lv.x), bfhi(lv.x), bflo(lv.y), bfhi(lv.y)};
                    f32x4 nk = kk_ * kkT; float ss = nk[0] * nk[0] + nk[1] * nk[1] + nk[2] * nk[2] + nk[3] * nk[3];
                    ss = sum16(ss);
                    nk = nk * (1.f / fmaxf(sqrtf(ss), 1e-12f));
                    *(LAS f32x4*)(Lf + s * SC_LROW + 4 * c16) = rr; *(LAS f32x4*)(Lf + 16 * SC_LROW + s * SC_LROW + 4 * c16) = kk_;
                    *(LAS f32x4*)(Lf + 32 * SC_LROW + s * SC_LROW + 4 * c16) = nk; *(LAS f32x4*)(Lf + 48 * SC_LROW + s * SC_LROW + 4 * c16) = vv;
                    *(LAS u32x4*)(Ls + 4 * 16 * SC_LROW * 4 + s * SC_LDROW + 32 * c16) = l00; *(LAS u32x4*)(Ls + 4 * 16 * SC_LROW * 4 + s * SC_LDROW + 32 * c16 + 16) = l01;
                }
                __syncthreads();
            };
            for (int i = 0; i < NCH + 4; i += 2) { hw_interval(i, setA); hw_interval(i + 1, setB); }
        }
    }
}

__global__ void __launch_bounds__(NTHREADS, 2) fwd_megakernel(Args args) {
    extern __shared__ __attribute__((aligned(16))) unsigned char lds_raw[];
    LAS unsigned char* lds = (LAS unsigned char*)lds_raw;
    volatile LAS unsigned* MISC = (volatile LAS unsigned*)(lds + MISC_OFF);
    const int tid0 = threadIdx.x, wave = __builtin_amdgcn_readfirstlane(tid0 >> 6);
#define FRESH_LANE() int tid = tid0; asm volatile("" : "+v"(tid)); const int lane = tid & 63; (void)lane
    const int G = gridDim.x;
    const int vcu = (G % 8 == 0) ? ((int)blockIdx.x % 8) * (G / 8) + (int)blockIdx.x / 8 : (int)blockIdx.x;
    const int gw = vcu * NWAVES + wave, NGW = G * NWAVES;
    unsigned char* ws = args.ws;
    unsigned* ctl = (unsigned*)(ws + WS_CTL);
    for (int u = tid0; u < (LDS_BYTES - LDSCTL_OFF) / 4; u += NTHREADS) ((LAS unsigned*)(lds + LDSCTL_OFF))[u] = 0u;
    __syncthreads();
    XcdBarrier bar = xcd_barrier_post(ctl + CW_BAR, MISC + 8);
#define GRID_BAR() xcd_barrier(bar)

    const float* x = args.in[0]; const float* rel_table = args.in[1]; const float* norm_g = args.in[2]; const float* attn_w_in = args.in[3]; const float* attn_sink = args.in[4];
    const float* attn_w_out = args.in[5]; const float* mu_prev = args.in[6]; const float* mu_next = args.in[7]; const float* w_r = args.in[8]; const float* w_k = args.in[9];
    const float* w_v = args.in[10]; const float* w_o = args.in[11]; const float* mlp_w1 = args.in[25]; const float* mlp_w2 = args.in[26];
    float* hbuf = args.out;
    bf16_t* XN = (bf16_t*)(ws + WS_XN); bf16_t* QKV = (bf16_t*)(ws + WS_QKV); bf16_t* Ob = (bf16_t*)(ws + WS_O); bf16_t* TMP = (bf16_t*)(ws + WS_TMP); bf16_t* Hb = (bf16_t*)(ws + WS_H);
    bf16_t* MIXA = (bf16_t*)(ws + WS_MIXA); bf16_t* MIXB = (bf16_t*)(ws + WS_MIXB); bf16_t* Rb = (bf16_t*)(ws + WS_R); bf16_t* Kb = (bf16_t*)(ws + WS_K); bf16_t* Vb = (bf16_t*)(ws + WS_V);
    bf16_t* LDO = (bf16_t*)(ws + WS_LDO); bf16_t* Yb = (bf16_t*)(ws + WS_Y);
    LAS float* scr = (LAS float*)(lds + wave * TR_SCR_BYTES);

    {
        FRESH_LANE();
        constexpr int I_IN = (D / 64) * (DIN / 64), I_OUT = (D / 64) * (D / 64), I_1 = (D / 64) * (DFF / 64), I_2 = (DFF / 64) * (D / 64);
        for (int it = gw; it < I_IN + I_OUT + I_1 + I_2; it += NGW) { int r = it;
            if (r < I_IN) { transpose_item(attn_w_in, DIN, DIN, (bf16_t*)(ws + WS_WIN_T), D, 0, 0, scr, r, lane, ScaleOne{}); continue; } r -= I_IN;
            if (r < I_OUT) { transpose_item(attn_w_out, D, D, (bf16_t*)(ws + WS_WOUT_T), D, 0, 0, scr, r, lane, ScaleOne{}); continue; } r -= I_OUT;
            if (r < I_1) { transpose_item(mlp_w1, DFF, DFF, (bf16_t*)(ws + WS_W1_T), D, 0, 0, scr, r, lane, ScaleOne{}); continue; } r -= I_1;
            transpose_item(mlp_w2, D, D, (bf16_t*)(ws + WS_W2_T), DFF, 0, 0, scr, r, lane, ScaleOne{}); }
        for (int row = gw; row < M; row += NGW) { Row16 r; row_load_f32(r, x + (size_t)row * D, lane); row_rmsnorm(r, norm_g, lane); row_store_bf16(r, XN + (size_t)row * D, lane); }
    }
    GRID_BAR();
    { pg8::StaticOrder S; S.init(M, DIN, G, (int)blockIdx.x); const EpiHeadMajor E{QKV};
      pg8::gemm_phase<EpiHeadMajor, ProbPlain, true, true>(lds, ProbPlain{XN, (const bf16_t*)(ws + WS_WIN_T), D}, S, E); }
    GRID_BAR();
    { const AttnIO io{QKV, rel_table, attn_sink, Ob, (bf16_t*)(ws + WS_OBR), (float*)(ws + WS_LSE)};
      phase_attn(lds, io, vcu, G);
      GRID_BAR();
      { FRESH_LANE(); phase_attn_merge(io, vcu * NTHREADS + tid, G * NTHREADS); } }
    GRID_BAR();
    run_gemm<0>(lds, ProbPlain{Ob, (const bf16_t*)(ws + WS_WOUT_T), D}, DstPlain{TMP, D}, M, D, G);
    GRID_BAR();
    { FRESH_LANE(); phase_resnorm(x, TMP, norm_g + D, norm_g + 2 * D, hbuf, XN, gw, NGW, lane); }
    GRID_BAR();
    run_gemm<1>(lds, ProbPlain{XN, (const bf16_t*)(ws + WS_W1_T), D}, DstPlain{Hb, DFF}, M, DFF, G);
    GRID_BAR();
    run_gemm<0>(lds, ProbPlain{Hb, (const bf16_t*)(ws + WS_W2_T), DFF}, DstPlain{TMP, D}, M, D, G);
    GRID_BAR();
    { FRESH_LANE(); phase_resnorm(hbuf, TMP, norm_g + 3 * D, nullptr, hbuf, nullptr, gw, NGW, lane); }
    GRID_BAR();
    {
        FRESH_LANE();
        const float* g1n = norm_g + 4 * D;
        constexpr int I_SQ = (D / 64) * (D / 64), I_1 = (D / 64) * (DFF / 64), I_2 = (DFF / 64) * (D / 64), I_LD = 384;
        for (int it = gw; it < 5 * I_SQ + I_1 + I_2 + I_LD; it += NGW) { int r = it;
            if (r < I_SQ) { transpose_item(w_r, D, D, (bf16_t*)(ws + WS_WR_T), D, 0, 0, scr, r, lane, ScaleOne{}); continue; } r -= I_SQ;
            if (r < I_SQ) { transpose_item(w_k, D, D, (bf16_t*)(ws + WS_WK_T), D, 0, 0, scr, r, lane, ScaleOne{}); continue; } r -= I_SQ;
            if (r < I_SQ) { transpose_item(w_v, D, D, (bf16_t*)(ws + WS_WV_T), D, 0, 0, scr, r, lane, ScaleOne{}); continue; } r -= I_SQ;
            if (r < I_SQ) { transpose_item(w_o, D, D, (bf16_t*)(ws + WS_WO2_T), 2 * D, 0, 0, scr, r, lane, ScaleOne{}); continue; } r -= I_SQ;
            if (r < I_SQ) { transpose_item(w_o, D, D, (bf16_t*)(ws + WS_WO2_T), 2 * D, 0, D, scr, r, lane, ScaleOne{}); continue; } r -= I_SQ;
            if (r < I_1) { transpose_item(mlp_w1 + (size_t)D * DFF, DFF, DFF, (bf16_t*)(ws + WS_W1B_T), D, 0, 0, scr, r, lane, ScaleOne{}); continue; } r -= I_1;
            if (r < I_2) { transpose_item(mlp_w2 + (size_t)DFF * D, D, D, (bf16_t*)(ws + WS_W2B_T), DFF, 0, 0, scr, r, lane, ScaleOne{}); continue; } r -= I_2;
            const int part = r / 128; int q = r % 128; int sub, li;
            if (q < 64) { sub = q / 16; li = q % 16; } else { sub = 4 + (q - 64) / 32; li = (q - 64) % 32; }
            const int dd = sub & 1, kind = sub >> 1;
            const int stream = kind == 0 ? 1 : (kind == 1 ? 4 : 5), Nn = kind == 2 ? 128 : 64;
            const float* src = kind == 0 ? args.in[18] + (size_t)dd * D * 64 : (kind == 1 ? args.in[21] + (size_t)dd * D * 64 : args.in[23] + (size_t)dd * D * 128);
            const int coloff = kind == 0 ? dd * 64 : (kind == 1 ? 128 + dd * 64 : 256 + dd * 128);
            transpose_item(src, Nn, Nn, (bf16_t*)(ws + WS_LDW_T), D, part * 512 + coloff, 0, scr, li, lane, ScaleMix{mu_prev + stream * D, mu_next + stream * D, part}); }
        phase_mix<true>(hbuf, g1n, mu_prev, mu_next, XN, MIXA, MIXB, gw, NGW, lane);
    }
    GRID_BAR();
    run_gemm<0>(lds, ProbRKL{ws, D}, DstRKL{ws}, M, 14 * 256, G);
    GRID_BAR();
    { FRESH_LANE(); phase_mix<false>(hbuf, norm_g + 4 * D, mu_prev, mu_next, nullptr, MIXA, nullptr, gw, NGW, lane); phase_lda(LDO, (bf16_t*)(ws + WS_LDA), gw, NGW, lane); }
    GRID_BAR();
    run_gemm<0>(lds, ProbPlain{MIXA, (const bf16_t*)(ws + WS_WV_T), D}, DstPlain{Vb, D}, M, D, G);
    GRID_BAR();
    { ScanPtrs sp{Rb, Kb, Vb, (const bf16_t*)(ws + WS_LDA), Yb, args.in[19], args.in[22], args.in[24], args.in[17], args.in[20], args.in[12], args.in[13], args.in[14], args.in[15], args.in[16]};
      phase_scan(lds, sp, G); }
    GRID_BAR();
    run_gemm<0>(lds, ProbPlain{Yb, (const bf16_t*)(ws + WS_WO2_T), 2 * D}, DstPlain{TMP, D}, M, D, G);
    GRID_BAR();
    { FRESH_LANE(); phase_resnorm(hbuf, TMP, norm_g + 5 * D, norm_g + 6 * D, hbuf, XN, gw, NGW, lane); }
    GRID_BAR();
    run_gemm<1>(lds, ProbPlain{XN, (const bf16_t*)(ws + WS_W1B_T), D}, DstPlain{Hb, DFF}, M, DFF, G);
    GRID_BAR();
    run_gemm<0>(lds, ProbPlain{Hb, (const bf16_t*)(ws + WS_W2B_T), DFF}, DstPlain{TMP, D}, M, D, G);
    GRID_BAR();
    { FRESH_LANE(); phase_resnorm(hbuf, TMP, norm_g + 7 * D, nullptr, hbuf, nullptr, gw, NGW, lane); }
#undef GRID_BAR
}

extern "C" void kernel_launch(void* const* d_in, const int* in_sizes, int n_in, void* d_out, int out_size, void* d_ws, size_t ws_size, hipStream_t stream) {
    static int grid = 0;
    if (grid == 0) {
        if (n_in != 27 || in_sizes[0] != M * D || out_size != M * D || ws_size < WS_END) { fprintf(stderr, "kernel_launch: unexpected shapes (n_in %d, in0 %d, out %d, ws %zu)\n", n_in, n_in > 0 ? in_sizes[0] : -1, out_size, ws_size); grid = -1; return; }
        int dev = 0, cus = 0, per_cu = 0;
        if (hipGetDevice(&dev) != hipSuccess || hipDeviceGetAttribute(&cus, hipDeviceAttributeMultiprocessorCount, dev) != hipSuccess) { grid = -1; return; }
        if (hipFuncSetAttribute((const void*)fwd_megakernel, hipFuncAttributeMaxDynamicSharedMemorySize, LDS_BYTES) != hipSuccess) { fprintf(stderr, "kernel_launch: hipFuncSetAttribute failed\n"); grid = -1; return; }
        if (hipOccupancyMaxActiveBlocksPerMultiprocessor(&per_cu, (const void*)fwd_megakernel, NTHREADS, LDS_BYTES) != hipSuccess || per_cu < 1) { fprintf(stderr, "kernel_launch: occupancy query says %d blocks/CU\n", per_cu); (void)hipGetLastError(); grid = -1; return; }
        grid = cus;
    }
    if (grid < 0) return;
    (void)hipMemsetAsync((char*)d_ws + WS_CTL, 0, CTL_ZERO_BYTES, stream);
    Args a{};
    for (int i = 0; i < 27; ++i) a.in[i] = (const float*)d_in[i];
    a.out = (float*)d_out; a.ws = (unsigned char*)d_ws;
    hipLaunchKernelGGL(fwd_megakernel, dim3(grid), dim3(NTHREADS), LDS_BYTES, stream, a);
}
```

```cpp
#include <hip/hip_runtime.h>
#include <cstdio>
#include <cstdint>

#define LAS __attribute__((address_space(3)))
#define GAS __attribute__((address_space(1)))
typedef unsigned short bf16_t;
typedef short bf16x8 __attribute__((ext_vector_type(8)));
typedef float f32x4 __attribute__((ext_vector_type(4)));
typedef float f32x2 __attribute__((ext_vector_type(2)));
typedef unsigned u32x4 __attribute__((ext_vector_type(4)));
typedef unsigned u32x2 __attribute__((ext_vector_type(2)));

#ifndef REP_SCAN
#define REP_SCAN 1
#endif
#ifndef REP_ATT
#define REP_ATT 1
#endif
#ifndef REP_GEMM
#define REP_GEMM 1
#endif
#ifndef REP_ATTC
#define REP_ATTC 1
#endif
#ifndef REP_BAR
#define REP_BAR 0
#endif
#ifndef REP_ATTS
#define REP_ATTS 1
#endif
#ifndef REP_HC
#define REP_HC 1
#endif
#ifndef REP_ST
#define REP_ST 1
#endif
#ifndef REP_HL
#define REP_HL 1
#endif
#ifndef REP_SYNC
#define REP_SYNC 0
#endif
#ifndef SECPROBE
#define SECPROBE -1
#endif
#ifndef WAITPROBE
#define WAITPROBE -1
#endif
#ifndef TS_A
#define TS_A -1
#endif
#ifndef TS_B
#define TS_B -1
#endif
constexpr int SEQ = 2048, D = 1024, NBATCH = 8, M = NBATCH * SEQ, DFF = 4096, DIN = 2304, NLD = 1536;
constexpr float NORM_EPS = 1e-6f, GN_EPS = 64e-5f;
constexpr int NWAVES = 8, NTHREADS = 512;

namespace pg8 {
constexpr int BM = 256, BK = 64, HALF = 128, HTB = HALF * BK * 2, STAGE_BYTES = 8 * HTB, NXCD = 8, WGM = 8;
__host__ __device__ __forceinline__ int lds_byte(int r, int c) { const int st = (r >> 4) * 2 + (c >> 5), rr = r & 15, cc = c & 31, ob = rr * 64 + cc * 2; return st * 1024 + (ob ^ (((ob >> 9) & 1) << 5)); }
__host__ __device__ __forceinline__ void stage_rc(int b, int& R, int& C) { const int st = b / 1024, sb = b % 1024, swz = sb ^ (((sb >> 9) & 1) << 5); R = (st >> 1) * 16 + swz / 64; C = (st & 1) * 32 + (swz % 64) / 2; }
__host__ __device__ __forceinline__ int perm32(int rho) { const int n = rho >> 4, i = rho & 15; return 8 * (i >> 2) + 4 * n + (i & 3); }

struct Unit { int pm, pn; };
struct StaticOrder {
    int nM, nN, nwg, G, c;
    __host__ __device__ void init(int Mr, int N, int G_, int c_) { nM = Mr / BM; nN = N / BM; nwg = nM * nN; G = G_; c = c_; }
    __host__ __device__ bool next(int i, Unit& u) const {
        const long L = (long)i * G + c; if (L >= nwg) return false;
        int wgid = (int)L; { const int q = nwg / NXCD, r = nwg % NXCD, xcd = wgid % NXCD, off = wgid / NXCD; wgid = (xcd < r ? xcd * (q + 1) : r * (q + 1) + (xcd - r) * q) + off; }
        const int nig = WGM * nN, gid = wgid / nig, fm = gid * WGM, gsz = (nM - fm) < WGM ? (nM - fm) : WGM;
        u.pm = fm + ((wgid % nig) % gsz); u.pn = (wgid % nig) / gsz; return true;
    }
};
__device__ __forceinline__ unsigned cvt_pk_bf16(float lo, float hi) { unsigned r; asm volatile("v_cvt_pk_bf16_f32 %0, %1, %2" : "=v"(r) : "v"(lo), "v"(hi)); return r; }

__device__ __forceinline__ void store16_wt(void* p, u32x4 v) { asm volatile("global_store_dwordx4 %0, %1, off sc1\n\ts_nop 1" :: "v"(p), "v"(v) : "memory"); }
template <int ACT, class DstFn, bool RS = false> struct EpiBf16 {
    static constexpr bool PERM = true;
    DstFn F; const float* rs;
    __device__ __forceinline__ void operator()(const f32x4 (&acc)[2][2][4][2], const Unit& u, int wr, int wc, int fr, int fq) const {
        bf16_t* base; int ldc; F(u, base, ldc);
        const int row0 = wr * 64 + fr, col0 = wc * 32 + 8 * fq;
        float rsc[2][4];
        if (RS) {
#pragma unroll
            for (int ai = 0; ai < 2; ++ai)
#pragma unroll
                for (int m = 0; m < 4; ++m) rsc[ai][m] = rs[u.pm * BM + row0 + ai * HALF + m * 16]; }
        if (RS && ACT == 1) {
            f32x4 t[2][2][4][2];
#pragma unroll
            for (int ai = 0; ai < 2; ++ai)
#pragma unroll
                for (int bj = 0; bj < 2; ++bj)
#pragma unroll
                    for (int m = 0; m < 4; ++m)
#pragma unroll
                        for (int n = 0; n < 2; ++n)
#pragma unroll
                            for (int e = 0; e < 4; ++e) { const float a = fmaxf(acc[ai][bj][m][n][e], 0.f); t[ai][bj][m][n][e] = a * a; }
#pragma unroll
            for (int ai = 0; ai < 2; ++ai)
#pragma unroll
                for (int m = 0; m < 4; ++m) { bf16_t* rowp = base + (size_t)(row0 + ai * HALF + m * 16) * ldc + col0; const float r2 = rsc[ai][m] * rsc[ai][m];
#pragma unroll
                    for (int bj = 0; bj < 2; ++bj) { const f32x4 v0 = t[ai][bj][m][0] * r2, v1 = t[ai][bj][m][1] * r2;
                        u32x4 w; w.x = cvt_pk_bf16(v0[0], v0[1]); w.y = cvt_pk_bf16(v0[2], v0[3]); w.z = cvt_pk_bf16(v1[0], v1[1]); w.w = cvt_pk_bf16(v1[2], v1[3]);
                        store16_wt(rowp + bj * HALF, w); } }
            return;
        }
#pragma unroll
        for (int ai = 0; ai < 2; ++ai)
#pragma unroll
            for (int m = 0; m < 4; ++m) { bf16_t* rowp = base + (size_t)(row0 + ai * HALF + m * 16) * ldc + col0;
#pragma unroll
                for (int bj = 0; bj < 2; ++bj) { f32x4 v0 = acc[ai][bj][m][0], v1 = acc[ai][bj][m][1];
                    if (RS) { v0 = v0 * rsc[ai][m]; v1 = v1 * rsc[ai][m]; }
                    if (ACT == 1) {
#pragma unroll
                        for (int e = 0; e < 4; ++e) { const float a = fmaxf(v0[e], 0.f), b = fmaxf(v1[e], 0.f); v0[e] = a * a; v1[e] = b * b; } }
                    u32x4 w; w.x = cvt_pk_bf16(v0[0], v0[1]); w.y = cvt_pk_bf16(v0[2], v0[3]); w.z = cvt_pk_bf16(v1[0], v1[1]); w.w = cvt_pk_bf16(v1[2], v1[3]);
                    store16_wt(rowp + bj * HALF, w); } }
    }
};

template <class Epi, class Prob, bool ALIGN_EPI, bool SP2>
__device__ __forceinline__ void gemm_phase(LAS unsigned char* lds, const Prob& P, const StaticOrder& S, const Epi& E) {
    int tid = threadIdx.x; asm volatile("" : "+v"(tid));
    const int wid = __builtin_amdgcn_readfirstlane(tid >> 6), lane = tid & 63, wr = wid >> 2, wc = wid & 3, fr = lane & 15, fq = lane >> 4;
    const int K = P.K, nt = K / BK;
    unsigned voffA[2], voffB[2];
#pragma unroll
    for (int i = 0; i < 2; ++i) { int R, C; stage_rc(tid * 16 + i * 8192, R, C); const int Rb = Epi::PERM ? ((R & ~31) + perm32(R & 31)) : R;
        voffA[i] = (unsigned)(R * K + C) * 2u; voffB[i] = (unsigned)(Rb * K + C) * 2u; }
    const size_t kstep = (size_t)(BK * 2);
    const size_t hstep = (size_t)HALF * K * 2;
    const unsigned ldsw = (unsigned)wid * 1024u;
    const int aoff = lds_byte(wr * 64 + fr, fq * 8), boff = lds_byte(wc * 32 + fr, fq * 8);
#define PG8_SA(b, h) (((b) * 2 + (h)) * HTB)
#define PG8_SB(b, h) ((4 + (b) * 2 + (h)) * HTB)
#define PG8_STAGE(bufoff, gbase, voff) do { _Pragma("unroll") for (int _i = 0; _i < 2; ++_i) \
        __builtin_amdgcn_global_load_lds((const unsigned*)((const char*)(gbase) + (voff)[_i]), (LAS unsigned*)(lds + (bufoff) + ldsw + _i * 8192), 16, 0, 0); } while (0)
#define PG8_LDA(dst, b, h) do { _Pragma("unroll") for (int m = 0; m < 4; ++m) _Pragma("unroll") for (int k = 0; k < 2; ++k) dst[m][k] = *(const LAS bf16x8*)(lds + PG8_SA(b, h) + aoff + m * 2048 + k * 1024); } while (0)
#define PG8_LDB(dst, b, h) do { _Pragma("unroll") for (int n = 0; n < 2; ++n) _Pragma("unroll") for (int k = 0; k < 2; ++k) dst[n][k] = *(const LAS bf16x8*)(lds + PG8_SB(b, h) + boff + n * 2048 + k * 1024); } while (0)
#define PG8_MMA(ai, bj, At, Bt) do { __builtin_amdgcn_s_setprio(1); _Pragma("unroll") for (int m = 0; m < 4; ++m) _Pragma("unroll") for (int n = 0; n < 2; ++n) _Pragma("unroll") for (int k = 0; k < 2; ++k) \
        acc[ai][bj][m][n] = __builtin_amdgcn_mfma_f32_16x16x32_bf16(Bt[n][k], At[m][k], acc[ai][bj][m][n], 0, 0, 0); __builtin_amdgcn_s_setprio(0); } while (0)
#define PG8_WAIT_V(n) asm volatile("s_waitcnt vmcnt(" #n ")" ::: "memory")
#define PG8_WAIT_L(n) asm volatile("s_waitcnt lgkmcnt(" #n ")" ::: "memory")
#define PG8_BAR __builtin_amdgcn_s_barrier()
#define PG8_SCHED __builtin_amdgcn_sched_barrier(0)
    Unit cur, nxt; int ui = 0;
    if (!S.next(0, cur)) return;
    f32x4 acc[2][2][4][2];
#pragma unroll
    for (int a = 0; a < 2; ++a)
#pragma unroll
        for (int b = 0; b < 2; ++b)
#pragma unroll
            for (int m = 0; m < 4; ++m)
#pragma unroll
                for (int n = 0; n < 2; ++n) acc[a][b][m][n] = (f32x4){0.f, 0.f, 0.f, 0.f};
    bf16x8 At[4][2], B0[2][2], B1[2][2];
    const char* cA = P.a_tile(cur); const char* cB = P.b_tile(cur);
    if constexpr (SP2) {
        PG8_STAGE(PG8_SB(0, 0), cB, voffB); PG8_STAGE(PG8_SB(0, 1), cB + hstep, voffB); PG8_STAGE(PG8_SA(0, 0), cA, voffA); PG8_STAGE(PG8_SA(0, 1), cA + hstep, voffA);
        if (wr == 1) PG8_BAR;
        PG8_WAIT_V(2); PG8_BAR;
        PG8_STAGE(PG8_SB(1, 0), cB + kstep, voffB); PG8_STAGE(PG8_SA(1, 0), cA + kstep, voffA); PG8_STAGE(PG8_SB(1, 1), cB + hstep + kstep, voffB);
        PG8_WAIT_V(6); PG8_BAR;
    } else {
        PG8_STAGE(PG8_SB(0, 0), cB, voffB); PG8_STAGE(PG8_SA(0, 0), cA, voffA); PG8_STAGE(PG8_SB(0, 1), cB + hstep, voffB); PG8_STAGE(PG8_SA(0, 1), cA + hstep, voffA);
        if (wr == 1) PG8_BAR;
        PG8_WAIT_V(4); PG8_BAR;
        PG8_STAGE(PG8_SB(1, 0), cB + kstep, voffB); PG8_STAGE(PG8_SA(1, 0), cA + kstep, voffA); PG8_STAGE(PG8_SB(1, 1), cB + hstep + kstep, voffB);
        PG8_WAIT_V(6); PG8_BAR;
    }
    for (;;) {
        const bool has_next = S.next(ui + 1, nxt);
        const char* nA = has_next ? P.a_tile(nxt) : cA; const char* nB = has_next ? P.b_tile(nxt) : cB;
        for (int t = 0; t < nt; t += 2) {
            const bool last = (t == nt - 2);
            const char* a1 = cA + (size_t)(t + 1) * kstep;
            const char* a2 = last ? nA : cA + (size_t)(t + 2) * kstep; const char* b2 = last ? nB : cB + (size_t)(t + 2) * kstep;
            const char* a3 = a2 + kstep; const char* b3 = b2 + kstep;
            if constexpr (SP2) {
            PG8_LDB(B0, 0, 0); PG8_LDB(B1, 0, 1); PG8_SCHED; PG8_LDA(At, 0, 0); PG8_STAGE(PG8_SA(1, 1), a1 + hstep, voffA);
            PG8_WAIT_V(8); PG8_WAIT_L(0); PG8_BAR; PG8_MMA(0, 0, At, B0); PG8_MMA(0, 1, At, B1); PG8_BAR; PG8_SCHED;
            PG8_LDA(At, 0, 1); PG8_STAGE(PG8_SB(0, 0), b2, voffB); PG8_STAGE(PG8_SB(0, 1), b2 + hstep, voffB); PG8_STAGE(PG8_SA(0, 0), a2, voffA);
            PG8_WAIT_V(8); PG8_WAIT_L(0); PG8_BAR; PG8_MMA(1, 0, At, B0); PG8_MMA(1, 1, At, B1); PG8_BAR; PG8_SCHED;
            PG8_LDB(B0, 1, 0); PG8_LDB(B1, 1, 1); PG8_SCHED; PG8_LDA(At, 1, 0); PG8_STAGE(PG8_SA(0, 1), a2 + hstep, voffA);
            PG8_WAIT_V(8); PG8_WAIT_L(0); PG8_BAR; PG8_MMA(0, 0, At, B0); PG8_MMA(0, 1, At, B1); PG8_BAR; PG8_SCHED;
            PG8_LDA(At, 1, 1); PG8_STAGE(PG8_SB(1, 0), b3, voffB); PG8_STAGE(PG8_SB(1, 1), b3 + hstep, voffB); PG8_STAGE(PG8_SA(1, 0), a3, voffA);
            PG8_WAIT_V(8); PG8_WAIT_L(0); PG8_BAR; PG8_MMA(1, 0, At, B0); PG8_MMA(1, 1, At, B1); PG8_BAR; PG8_SCHED;
            } else {
            PG8_LDB(B0, 0, 0); PG8_SCHED; PG8_LDA(At, 0, 0); PG8_STAGE(PG8_SA(1, 1), a1 + hstep, voffA);
            PG8_WAIT_L(8); PG8_BAR; PG8_WAIT_L(0); PG8_MMA(0, 0, At, B0); PG8_BAR; PG8_SCHED;
            PG8_LDB(B1, 0, 1); PG8_STAGE(PG8_SB(0, 0), b2, voffB);
            PG8_BAR; PG8_WAIT_L(0); PG8_MMA(0, 1, At, B1); PG8_BAR;
            PG8_LDA(At, 0, 1); PG8_STAGE(PG8_SA(0, 0), a2, voffA);
            PG8_BAR; PG8_WAIT_L(0); PG8_MMA(1, 0, At, B0); PG8_BAR; PG8_SCHED;
            PG8_STAGE(PG8_SB(0, 1), b2 + hstep, voffB);
            PG8_WAIT_V(6); PG8_BAR; PG8_MMA(1, 1, At, B1); PG8_BAR;
            PG8_LDB(B0, 1, 0); PG8_SCHED; PG8_LDA(At, 1, 0); PG8_STAGE(PG8_SA(0, 1), a2 + hstep, voffA);
            PG8_WAIT_L(8); PG8_BAR; PG8_WAIT_L(0); PG8_MMA(0, 0, At, B0); PG8_BAR; PG8_SCHED;
            PG8_LDB(B1, 1, 1); PG8_STAGE(PG8_SB(1, 0), b3, voffB);
            PG8_BAR; PG8_WAIT_L(0); PG8_MMA(0, 1, At, B1); PG8_BAR;
            PG8_LDA(At, 1, 1); PG8_STAGE(PG8_SA(1, 0), a3, voffA);
            PG8_BAR; PG8_WAIT_L(0); PG8_MMA(1, 0, At, B0); PG8_BAR; PG8_SCHED;
            PG8_STAGE(PG8_SB(1, 1), b3 + hstep, voffB);
            PG8_WAIT_V(6); PG8_BAR; PG8_MMA(1, 1, At, B1); PG8_BAR;
            }
        }
        if constexpr (ALIGN_EPI) { if (wr == 0) PG8_BAR; }
        E(acc, cur, wr, wc, fr, fq);
        if (!has_next) break;
#pragma unroll
        for (int a = 0; a < 2; ++a)
#pragma unroll
            for (int b = 0; b < 2; ++b)
#pragma unroll
                for (int m = 0; m < 4; ++m)
#pragma unroll
                    for (int n = 0; n < 2; ++n) acc[a][b][m][n] = (f32x4){0.f, 0.f, 0.f, 0.f};
        cur = nxt; cA = nA; cB = nB; ++ui;
        if constexpr (ALIGN_EPI) { if (wr == 1) PG8_BAR; }
    }
    PG8_WAIT_V(0);
    if constexpr (!ALIGN_EPI) { if (wr == 0) PG8_BAR; }
    PG8_BAR;
#undef PG8_SA
#undef PG8_SB
#undef PG8_STAGE
#undef PG8_LDA
#undef PG8_LDB
#undef PG8_MMA
#undef PG8_WAIT_V
#undef PG8_WAIT_L
#undef PG8_BAR
#undef PG8_SCHED
}
}

constexpr size_t MiB = 1u << 20;
constexpr size_t WS_CTL = 0, CTL_ZERO_BYTES = 64 * 1024;
constexpr size_t WS_W = 1 * MiB;
constexpr size_t WS_WIN_T = WS_W, WS_WOUT_T = WS_WIN_T + (size_t)DIN * D * 2, WS_W1_T = WS_WOUT_T + (size_t)D * D * 2, WS_W2_T = WS_W1_T + (size_t)DFF * D * 2;
constexpr size_t WS_WR_T = WS_W, WS_WK_T = WS_WR_T + 2 * MiB, WS_LDW_T = WS_WK_T + 2 * MiB, WS_WV_T = WS_LDW_T + 3 * MiB, WS_WO2_T = WS_WV_T + 2 * MiB, WS_W1B_T = WS_WO2_T + 4 * MiB, WS_W2B_T = WS_W1B_T + 8 * MiB;
static_assert(WS_W2_T + (size_t)D * DFF * 2 <= 31 * MiB && WS_W2B_T + (size_t)D * DFF * 2 <= 31 * MiB, "weight region");
constexpr size_t WS_XN = 31 * MiB, WS_QKV = 63 * MiB, WS_O = 135 * MiB, WS_OBR = 167 * MiB, WS_LSE = 215 * MiB, WS_TMP = 217 * MiB, WS_H = 63 * MiB;
constexpr size_t WS_MIXA = 63 * MiB, WS_MIXB = 95 * MiB, WS_R = 127 * MiB, WS_K = 159 * MiB, WS_V = 31 * MiB, WS_LDO = 191 * MiB, WS_Y = 63 * MiB, WS_LDA = 239 * MiB;
constexpr size_t WS_YSUM = 127 * MiB;
constexpr size_t WS_HBC = 191 * MiB, WS_TMP2 = 223 * MiB;
constexpr size_t WS_END = 256 * MiB;
static_assert(WS_HBC >= WS_H + (size_t)M * DFF * 2 && WS_HBC + (size_t)M * D * 2 <= WS_TMP2 && WS_TMP2 + (size_t)M * D * 2 <= WS_END, "layer-1 tail");
static_assert(WS_LDO + (size_t)M * NLD * 2 <= WS_LDA && WS_LDA + (size_t)M * 512 * 2 <= WS_END && WS_TMP + (size_t)M * D * 2 <= WS_END, "tail of the map");
static_assert(WS_MIXA == WS_XN + 32 * MiB && WS_MIXB == WS_XN + 64 * MiB && WS_K == WS_R + 32 * MiB && WS_LDO == WS_R + 64 * MiB && WS_WK_T == WS_WR_T + 2 * MiB && WS_LDW_T == WS_WR_T + 4 * MiB, "grouped GEMM strides");
constexpr int CW_BAR = 4096;

constexpr int RING_BYTES = 131072, LDSCTL_OFF = 143360, MISC_OFF = LDSCTL_OFF + 320, LDS_BYTES = 147456;

typedef __bf16 bf16x2_t __attribute__((ext_vector_type(2)));
__device__ __forceinline__ unsigned cvtpk(float lo, float hi) { const f32x2 v = {lo, hi}; const bf16x2_t b = __builtin_convertvector(v, bf16x2_t); return __builtin_bit_cast(unsigned, b); }
__device__ __forceinline__ float bf2f(unsigned short b) { return __uint_as_float((unsigned)b << 16); }
__device__ __forceinline__ float bflo(unsigned w) { return __uint_as_float(w << 16); }
__device__ __forceinline__ float bfhi(unsigned w) { return __uint_as_float(w & 0xffff0000u); }
__device__ __forceinline__ unsigned f2bf(float f) { unsigned u = __float_as_uint(f); return (u + 0x7fffu + ((u >> 16) & 1u)) >> 16; }
__device__ __forceinline__ unsigned pk2(float lo, float hi) { return f2bf(lo) | (f2bf(hi) << 16); }
__device__ __forceinline__ float wave_sum(float v) {
#pragma unroll
    for (int o = 1; o < 64; o <<= 1) v += __shfl_xor(v, o);
    return v;
}
__device__ __forceinline__ float sigmoidf_(float z) { return 1.f / (1.f + __expf(-z)); }
__device__ __forceinline__ int t5_bucket(int rel) {
    const int n = rel < 0 ? -rel : rel;
    int large;
    if (n < 8) large = n; else if (n < 15) large = 8; else if (n < 27) large = 9; else if (n < 50) large = 10; else if (n < 91) large = 11;
    else if (n < 166) large = 12; else if (n < 305) large = 13; else if (n < 559) large = 14; else large = 15;
    return (rel > 0 ? 16 : 0) + large;
}

#define XB_TMO      128
#define XB_XCNT(j)  (256  + 64 * (j))
#define XB_XSUB(j)  (1280 + 64 * (j))
#define XB_XGEN(j)  (2304 + 64 * (j))
#define XB_TOP      3328
#define XB_TOPGEN   3392
#define XCD_BAR_WORDS 3456
#define XB_SPIN_CAP (1u << 18)
__device__ __forceinline__ unsigned xb_ld(unsigned* p)              { return __hip_atomic_load(p, __ATOMIC_RELAXED, __HIP_MEMORY_SCOPE_AGENT); }
__device__ __forceinline__ unsigned xb_add(unsigned* p, unsigned v) { return __hip_atomic_fetch_add(p, v, __ATOMIC_RELAXED, __HIP_MEMORY_SCOPE_AGENT); }
__device__ __forceinline__ unsigned xb_xcc_id() { return (unsigned)__builtin_amdgcn_s_getreg((3 << 11) | 20) & 0xFu; }
#define XB_SPIN(cond, bar) do { unsigned _sp = 0; while (cond) { __builtin_amdgcn_s_sleep(1); \
    if ((++_sp & 255u) == 0u) { if (xb_ld(&(bar)[XB_TMO])) break; if (_sp > XB_SPIN_CAP) { atomicAdd(&(bar)[XB_TMO], 1u); break; } } } } while (0)
struct XcdBarrier { unsigned* bar; unsigned x; volatile LAS unsigned* st; };
__device__ __forceinline__ XcdBarrier xcd_barrier_post(unsigned* bar, volatile LAS unsigned* st) {
    XcdBarrier b; b.bar = bar; b.x = xb_xcc_id(); b.st = st;
    if (threadIdx.x == 0) (void)xb_add(&bar[XB_XCNT(b.x)], 1u);
    return b;
}
__device__ __forceinline__ void xcd_barrier_complete(unsigned* bar, unsigned x, unsigned& nloc, unsigned& nx) {
    const unsigned G = gridDim.x * gridDim.y * gridDim.z;
    unsigned sum, cnt, mine, sp = 0u;
    for (;;) {
        sum = 0u; cnt = 0u; mine = 0u;
#pragma unroll
        for (unsigned j = 0; j < 16; ++j) { const unsigned c = xb_ld(&bar[XB_XCNT(j)]); sum += c; cnt += (c > 0u) ? 1u : 0u; mine = (j == x) ? c : mine; }
        if (sum == G) break;
        __builtin_amdgcn_s_sleep(1);
        if ((++sp & 255u) == 0u) { if (xb_ld(&bar[XB_TMO])) break; if (sp > XB_SPIN_CAP) { atomicAdd(&bar[XB_TMO], 1u); break; } }
    }
    nloc = mine > 0u ? mine : 1u; nx = cnt > 0u ? cnt : 1u;
}
__device__ __forceinline__ void xcd_barrier(const XcdBarrier& b) {
    asm volatile("s_waitcnt vmcnt(0)" ::: "memory");
    __syncthreads();
    if (threadIdx.x == 0) {
        unsigned* bar = b.bar;
        __builtin_amdgcn_s_waitcnt(0);
        unsigned nloc = b.st[0], nx = b.st[1];
        if (nloc == 0u) { xcd_barrier_complete(bar, b.x, nloc, nx); b.st[0] = nloc; b.st[1] = nx; }
        const unsigned old = xb_add(&bar[XB_XSUB(b.x)], 1u);
        const unsigned gen = old / nloc;
        if (old + 1u == (gen + 1u) * nloc) {
            __builtin_amdgcn_fence(__ATOMIC_RELEASE, "agent");
            asm volatile("s_waitcnt vmcnt(0)" ::: "memory");
            const unsigned og = xb_add(&bar[XB_TOP], 1u);
            const unsigned tg = og / nx;
            if (og + 1u == (tg + 1u) * nx) xb_add(&bar[XB_TOPGEN], 1u);
            else XB_SPIN(xb_ld(&bar[XB_TOPGEN]) == tg, bar);
            __builtin_amdgcn_fence(__ATOMIC_ACQUIRE, "agent");
            xb_add(&bar[XB_XGEN(b.x)], 1u);
            asm volatile("s_waitcnt vmcnt(0)" ::: "memory");
        } else {
            XB_SPIN(xb_ld(&bar[XB_XGEN(b.x)]) == gen, bar);
            __builtin_amdgcn_fence(__ATOMIC_ACQUIRE, "agent");
            asm volatile("s_waitcnt vmcnt(0)" ::: "memory");
        }
    }
    __syncthreads();
}

#define XB_GRP(g)   (4096 + 16 * (g))
__device__ __forceinline__ void grp_barrier(unsigned* bar, unsigned g, unsigned& epoch) {
    asm volatile("s_waitcnt vmcnt(0)" ::: "memory");
    __syncthreads();
    ++epoch;
    if (threadIdx.x == 0) {
        unsigned* word = &bar[XB_GRP(g)];
        (void)xb_add(word, 1u);
        const unsigned tgt = 4u * epoch;
        XB_SPIN(xb_ld(word) < tgt, bar);
        __builtin_amdgcn_fence(__ATOMIC_ACQUIRE, "agent");
        asm volatile("s_waitcnt vmcnt(0)" ::: "memory");
    }
    __syncthreads();
}

struct Row16 { f32x4 v[4]; };
__device__ __forceinline__ int row_q(int lane, int j) { return 2 * lane + 128 * (j >> 1) + (j & 1); }
__device__ __forceinline__ void row_load_f32(Row16& r, const float* p, int lane) {
#pragma unroll
    for (int j = 0; j < 4; ++j) r.v[j] = ((const f32x4*)p)[row_q(lane, j)];
}
struct RowRaw { u32x4 w[2]; };
__device__ __forceinline__ void row_raw_load(RowRaw& r, const bf16_t* p, int lane) { r.w[0] = ((const u32x4*)p)[lane]; r.w[1] = ((const u32x4*)p)[lane + 64]; }
__device__ __forceinline__ void row_from_raw(Row16& r, const RowRaw& q) {
#pragma unroll
    for (int b = 0; b < 2; ++b) { const u32x4 w = q.w[b]; r.v[2 * b] = (f32x4){bflo(w.x), bfhi(w.x), bflo(w.y), bfhi(w.y)}; r.v[2 * b + 1] = (f32x4){bflo(w.z), bfhi(w.z), bflo(w.w), bfhi(w.w)}; }
}
__device__ __forceinline__ void row_load_bf16(Row16& r, const bf16_t* p, int lane) { RowRaw q; row_raw_load(q, p, lane); row_from_raw(r, q); }
__device__ __forceinline__ void row_store_f32(const Row16& r, float* p, int lane) {
#pragma unroll
    for (int j = 0; j < 4; ++j) pg8::store16_wt((f32x4*)p + row_q(lane, j), __builtin_bit_cast(u32x4, r.v[j]));
}
__device__ __forceinline__ void row_store_bf16(const Row16& r, bf16_t* p, int lane) {
#pragma unroll
    for (int b = 0; b < 2; ++b) { u32x4 w; w.x = cvtpk(r.v[2 * b][0], r.v[2 * b][1]); w.y = cvtpk(r.v[2 * b][2], r.v[2 * b][3]); w.z = cvtpk(r.v[2 * b + 1][0], r.v[2 * b + 1][1]); w.w = cvtpk(r.v[2 * b + 1][2], r.v[2 * b + 1][3]);
        pg8::store16_wt((u32x4*)p + lane + 64 * b, w); }
}
__device__ __forceinline__ void vec_load(Row16& r, const float* g, int lane) { row_load_f32(r, g, lane); }
__device__ __forceinline__ void row_rmsnorm_v(Row16& r, const Row16& g) {
    float s = 0.f;
#pragma unroll
    for (int j = 0; j < 4; ++j) s += r.v[j][0] * r.v[j][0] + r.v[j][1] * r.v[j][1] + r.v[j][2] * r.v[j][2] + r.v[j][3] * r.v[j][3];
    const float rs = rsqrtf(wave_sum(s) * (1.f / D) + NORM_EPS);
#pragma unroll
    for (int j = 0; j < 4; ++j) r.v[j] = r.v[j] * rs * g.v[j];
}
__device__ __forceinline__ void row_rmsnorm(Row16& r, const float* g, int lane) { Row16 gg; vec_load(gg, g, lane); row_rmsnorm_v(r, gg); }

constexpr int TR_SCR_BYTES = 64 * 65 * 4;
template <class ScaleFn>
__device__ __forceinline__ void transpose_item(const float* W, int ldw, int N, bf16_t* WT, int ldt, int row_off, int koff, LAS float* scr, int item, int lane, ScaleFn sc) {
    const int nblk = N / 64, kb = item / nblk, nb = item % nblk, k0 = 64 * kb, n0 = 64 * nb;
    const int lk = lane >> 4, ln4 = (lane & 15) * 4;
    f32x4 v[16];
#pragma unroll
    for (int i = 0; i < 16; ++i) v[i] = *(const f32x4*)(W + (size_t)(k0 + 4 * i + lk) * ldw + n0 + ln4);
#pragma unroll
    for (int i = 0; i < 16; ++i) { const int kk = 4 * i + lk; const float s = sc(k0 + kk); LAS float* d = scr + kk * 65 + ln4; d[0] = v[i][0] * s; d[1] = v[i][1] * s; d[2] = v[i][2] * s; d[3] = v[i][3] * s; }
    asm volatile("s_waitcnt lgkmcnt(0)" ::: "memory");
    const int c = lane >> 3, nn = lane & 7;
#pragma unroll
    for (int j = 0; j < 8; ++j) { const int n = nn + 8 * j; const LAS float* s = scr + (8 * c) * 65 + n;
        u32x4 o; o.x = cvtpk(s[0 * 65], s[1 * 65]); o.y = cvtpk(s[2 * 65], s[3 * 65]); o.z = cvtpk(s[4 * 65], s[5 * 65]); o.w = cvtpk(s[6 * 65], s[7 * 65]);
        pg8::store16_wt(WT + (size_t)(row_off + n0 + n) * ldt + koff + k0 + 8 * c, o); }
    asm volatile("s_waitcnt lgkmcnt(0)" ::: "memory");
}
struct ScaleOne { __device__ __forceinline__ float operator()(int) const { return 1.f; } };
struct ScaleVec { const float* g; __device__ __forceinline__ float operator()(int k) const { return g[k]; } };
struct ScaleMix { const float* mp; const float* mn; int part;
    __device__ __forceinline__ float operator()(int k) const { return part == 0 ? 1.f - mp[k] - mn[k] : (part == 1 ? mp[k] : mn[k]); } };

struct Args { const float* in[27]; float* out; unsigned char* ws; };

struct ProbPlain { const bf16_t* A; const bf16_t* Bt; int K;
    __device__ __forceinline__ const char* a_tile(const pg8::Unit& u) const { return (const char*)(A + (size_t)u.pm * 256 * K); }
    __device__ __forceinline__ const char* b_tile(const pg8::Unit& u) const { return (const char*)(Bt + (size_t)u.pn * 256 * K); } };
struct DstPlain { bf16_t* C; int ldc;
    __device__ __forceinline__ void operator()(const pg8::Unit& u, bf16_t*& base, int& ld) const { base = C + (size_t)u.pm * 256 * ldc + (size_t)u.pn * 256; ld = ldc; } };
struct ProbRKL { const unsigned char* ws; int K;
    __device__ __forceinline__ const char* a_tile(const pg8::Unit& u) const { const int g = u.pn < 4 ? 0 : (u.pn < 8 ? 1 : 2); const int ga = g == 2 ? 0 : g + 1;
        return (const char*)(ws + WS_XN + (size_t)ga * (32 * MiB) + (size_t)u.pm * 256 * D * 2); }
    __device__ __forceinline__ const char* b_tile(const pg8::Unit& u) const { const int g = u.pn < 4 ? 0 : (u.pn < 8 ? 1 : 2); const int t = u.pn - 4 * g;
        return (const char*)(ws + WS_WR_T + (size_t)g * (2 * MiB) + (size_t)t * 256 * D * 2); } };
struct DstRKL { unsigned char* ws;
    __device__ __forceinline__ void operator()(const pg8::Unit& u, bf16_t*& base, int& ld) const {
        const int g = u.pn < 4 ? 0 : (u.pn < 8 ? 1 : 2); const int t = u.pn - 4 * g; ld = g == 2 ? NLD : D;
        base = (bf16_t*)(ws + WS_R + (size_t)g * (32 * MiB)) + (size_t)u.pm * 256 * ld + (size_t)t * 256; } };


struct EpiHeadMajor {
    static constexpr bool PERM = true;
    bf16_t* O;
    __device__ __forceinline__ void operator()(const f32x4 (&acc)[2][2][4][2], const pg8::Unit& u, int wr, int wc, int fr, int fq) const {
        const int row0 = u.pm * 256 + wr * 64 + fr, col = (wc & 1) * 32 + 8 * fq;
#pragma unroll
        for (int bj = 0; bj < 2; ++bj) { bf16_t* hb = O + ((size_t)(u.pn * 4 + bj * 2 + (wc >> 1)) * M + row0) * 64 + col;
#pragma unroll
            for (int ai = 0; ai < 2; ++ai)
#pragma unroll
                for (int m = 0; m < 4; ++m) { const f32x4 v0 = acc[ai][bj][m][0], v1 = acc[ai][bj][m][1];
                    u32x4 w; w.x = cvtpk(v0[0], v0[1]); w.y = cvtpk(v0[2], v0[3]); w.z = cvtpk(v1[0], v1[1]); w.w = cvtpk(v1[2], v1[3]);
                    pg8::store16_wt(hb + (size_t)(ai * 128 + m * 16) * 64, w); } }
    }
};

template <int ACT, class Prob, class Dst>
__device__ __forceinline__ void run_gemm(LAS unsigned char* lds, const Prob& P, const Dst& Dd, int Mr, int Nv, int G) {
    pg8::StaticOrder S; S.init(Mr, Nv, G, (int)blockIdx.x);
    pg8::EpiBf16<ACT, Dst> E{Dd, nullptr};
    for (int rep = 0; rep < REP_GEMM; ++rep) pg8::gemm_phase<pg8::EpiBf16<ACT, Dst>, Prob, true, true>(lds, P, S, E);
}
template <int ACT, class Prob, class Dst>
__device__ __forceinline__ void run_gemm_rs(LAS unsigned char* lds, const Prob& P, const Dst& Dd, const float* rs, int Mr, int Nv, int G) {
    pg8::StaticOrder S; S.init(Mr, Nv, G, (int)blockIdx.x);
    pg8::EpiBf16<ACT, Dst, true> E{Dd, rs};
    pg8::gemm_phase<pg8::EpiBf16<ACT, Dst, true>, Prob, true, true>(lds, P, S, E);
}

template <bool BASE_F32, bool OUT_F32>
__device__ __forceinline__ void phase_resnorm(const void* base, const bf16_t* TMP, const float* g1, const float* g2, void* hout, bf16_t* XN, float* rs_out, int gw, int NGW, int lane) {
    Row16 G1, G2; vec_load(G1, g1, lane); if (XN) vec_load(G2, g2, lane);
    for (int row = gw; row < M; row += NGW) {
        Row16 t, b; row_load_bf16(t, TMP + (size_t)row * D, lane);
        if (BASE_F32) row_load_f32(b, (const float*)base + (size_t)row * D, lane); else row_load_bf16(b, (const bf16_t*)base + (size_t)row * D, lane);
        row_rmsnorm_v(t, G1);
#pragma unroll
        for (int j = 0; j < 4; ++j) b.v[j] = b.v[j] + t.v[j];
        if (OUT_F32) row_store_f32(b, (float*)hout + (size_t)row * D, lane); else row_store_bf16(b, (bf16_t*)hout + (size_t)row * D, lane);
        if (XN) { row_rmsnorm_v(b, G2); row_store_bf16(b, XN + (size_t)row * D, lane); }
        if (rs_out) {
            float s = 0.f;
#pragma unroll
            for (int j = 0; j < 4; ++j) s += b.v[j][0] * b.v[j][0] + b.v[j][1] * b.v[j][1] + b.v[j][2] * b.v[j][2] + b.v[j][3] * b.v[j][3];
            const float rsv = rsqrtf(wave_sum(s) * (1.f / D) + NORM_EPS);
            if (lane == 0) rs_out[row] = rsv; }
    }
}
__device__ __forceinline__ void phase_lda(const bf16_t* LDO, bf16_t* LDA, int gw, int NGW, int lane) {
    const float A = lane < 16 ? 2.f : 1.f, C = lane < 16 ? -1.f : 0.f; const bool id = lane >= 16 && lane < 32;
    for (int row = gw; row < M; row += NGW) { const int tt = row & (SEQ - 1);
        const u32x4 p0 = *(const u32x4*)(LDO + (size_t)row * NLD + 8 * lane);
        const u32x4 p1 = *(const u32x4*)(LDO + (size_t)(tt > 0 ? row - 1 : row) * NLD + 512 + 8 * lane), p2 = *(const u32x4*)(LDO + (size_t)(tt < SEQ - 1 ? row + 1 : row) * NLD + 1024 + 8 * lane);
        const float mp = tt > 0 ? 1.f : 0.f, mn = tt < SEQ - 1 ? 1.f : 0.f;
        u32x4 o;
#pragma unroll
        for (int w = 0; w < 4; ++w) { const float x0 = bflo(p0[w]) + mp * bflo(p1[w]) + mn * bflo(p2[w]), x1 = bfhi(p0[w]) + mp * bfhi(p1[w]) + mn * bfhi(p2[w]);
            const float y0 = A * __builtin_amdgcn_rcpf(1.f + __builtin_amdgcn_exp2f(-1.4426950408889634f * A * x0)) + C, y1 = A * __builtin_amdgcn_rcpf(1.f + __builtin_amdgcn_exp2f(-1.4426950408889634f * A * x1)) + C;
            o[w] = cvtpk(id ? x0 : y0, id ? x1 : y1); }
        pg8::store16_wt(LDA + (size_t)row * 512 + 8 * lane, o); }
}
__device__ __forceinline__ void mix_out(const Row16& up, const Row16& u, const Row16& un, const LAS f32x4* a, const LAS f32x4* b, bf16_t* dst, int lane) {
    Row16 o;
#pragma unroll
    for (int j = 0; j < 4; ++j) { const f32x4 av = a[j * 64 + lane], bv = b[j * 64 + lane]; o.v[j] = u.v[j] + (up.v[j] - u.v[j]) * av + (un.v[j] - u.v[j]) * bv; }
    row_store_bf16(o, dst, lane);
}
__device__ __forceinline__ void phase_mix3(LAS unsigned char* lds, const bf16_t* h, const float* g, const float* mup, const float* mun, bf16_t* XN, bf16_t* MR, bf16_t* MK, bf16_t* MV, int gw, int NGW, int tid, int lane) {
    LAS f32x4* mv = (LAS f32x4*)lds;
    __syncthreads();
    for (int x = tid; x < 6 * 256; x += NTHREADS) { const int vec = x >> 8, q = x & 255, c = vec < 2 ? 0 : (vec < 4 ? 2 : 3);
        const f32x4 val = ((const f32x4*)(((vec & 1) ? mun : mup) + c * D))[q];
        mv[vec * 256 + (2 * (q >> 7) + (q & 1)) * 64 + ((q & 127) >> 1)] = val; }
    __syncthreads();
    Row16 Gn; vec_load(Gn, g, lane);
    for (int ch = gw; ch < M / 8; ch += NGW) {
        const int r0 = ch * 8, t0 = r0 & (SEQ - 1);
        const bool hasp = t0 > 0, hasn = t0 + 8 < SEQ;
        const int rlast = hasn ? r0 + 8 : r0 + 7;
        RowRaw r0w, rA, rB, rC;
        row_raw_load(r0w, h + (size_t)(hasp ? r0 - 1 : r0) * D, lane);
        row_raw_load(rA, h + (size_t)r0 * D, lane); row_raw_load(rB, h + (size_t)(r0 + 1) * D, lane); row_raw_load(rC, h + (size_t)(r0 + 2) * D, lane);
        Row16 up, u, un;
        row_from_raw(up, r0w); row_rmsnorm_v(up, Gn);
        { const float m = hasp ? 1.f : 0.f;
#pragma unroll
          for (int j = 0; j < 4; ++j) up.v[j] = up.v[j] * m; }
        row_from_raw(u, rA); row_rmsnorm_v(u, Gn);
        rA = rB; rB = rC;
#pragma unroll 1
        for (int k = 1; k <= 8; ++k) {
            const int row = r0 - 1 + k;
            { const int nx = row + 3; row_raw_load(rC, h + (size_t)(nx < rlast ? nx : rlast) * D, lane); }
            row_from_raw(un, rA); row_rmsnorm_v(un, Gn);
            { const float m = (k == 8 && !hasn) ? 0.f : 1.f;
#pragma unroll
              for (int j = 0; j < 4; ++j) un.v[j] = un.v[j] * m; }
            row_store_bf16(u, XN + (size_t)row * D, lane);
            mix_out(up, u, un, mv, mv + 256, MR + (size_t)row * D, lane);
            mix_out(up, u, un, mv + 512, mv + 768, MK + (size_t)row * D, lane);
            mix_out(up, u, un, mv + 1024, mv + 1280, MV + (size_t)row * D, lane);
            up = u; u = un; rA = rB; rB = rC;
        }
    }
}

constexpr int ATT_ROWS = 400, ATT_KS = 0, ATT_VS = ATT_ROWS * 128, ATT_TAB = 2 * ATT_ROWS * 128, ATT_TABN = 320;
constexpr float LOG2E = 1.4426950408889634f;
typedef short v4i16_t __attribute__((ext_vector_type(4)));
__device__ __forceinline__ v4i16_t lds_tr16(LAS const unsigned char* p) { return __builtin_amdgcn_ds_read_tr16_b64_v4i16((LAS v4i16_t*)p); }

__device__ __forceinline__ float rows_max(float x) {
    auto a = __builtin_amdgcn_permlane16_swap(__float_as_uint(x), __float_as_uint(x), false, false); x = fmaxf(__uint_as_float(a[0]), __uint_as_float(a[1]));
    auto b = __builtin_amdgcn_permlane32_swap(__float_as_uint(x), __float_as_uint(x), false, false); return fmaxf(__uint_as_float(b[0]), __uint_as_float(b[1])); }
__device__ __forceinline__ float rows_sum(float x) {
    auto a = __builtin_amdgcn_permlane16_swap(__float_as_uint(x), __float_as_uint(x), false, false); x = __uint_as_float(a[0]) + __uint_as_float(a[1]);
    auto b = __builtin_amdgcn_permlane32_swap(__float_as_uint(x), __float_as_uint(x), false, false); return __uint_as_float(b[0]) + __uint_as_float(b[1]); }
struct AttnIO { const bf16_t* QKV; const float* rel_table; const float* sink; bf16_t* O; bf16_t* OBR; float* LSE; };
struct AttnUnitD { int b, dil, res, l0, nq, L, R, colK, colV, head0, ngroups, nit, branch, isB; };
__device__ __forceinline__ AttnUnitD attn_decode(int u) {
    AttnUnitD A;
    if (u < 256) { A.isB = 1; A.b = u >> 5; const int kvg = (u >> 4) & 1, blk = u & 15; A.dil = 1; A.res = 0; A.l0 = blk * 128; A.nq = 128; A.L = SEQ; A.R = 128; A.colK = 32 + kvg; A.colV = 34 + kvg; A.head0 = kvg * 4; A.ngroups = 32; A.nit = 9; A.branch = 0; }
    else if (u < 1280) { A.isB = 0; const int a = u - 256, bh = a >> 4, k = a & 15; A.b = bh >> 3; A.head0 = bh & 7; A.nq = 256; A.R = 64; A.ngroups = 16; A.nit = 5;
        if (k < 8) { A.dil = 1; A.res = 0; A.l0 = k * 256; A.L = SEQ; A.branch = 0; } else { A.dil = 4; A.res = (k - 8) >> 1; A.l0 = ((k - 8) & 1) * 256; A.L = SEQ / 4; A.branch = 1; }
        A.colK = 8 + A.head0; A.colV = 16 + A.head0; }
    else { A.isB = 0; const int a = u - 1280, bh = a >> 4; A.b = bh >> 3; A.head0 = bh & 7; A.dil = 16; A.res = a & 15; A.l0 = 0; A.nq = 128; A.L = SEQ / 16; A.R = 64; A.ngroups = 8; A.nit = 5; A.branch = 2; A.colK = 8 + A.head0; A.colV = 16 + A.head0; }
    return A;
}
constexpr int ATT_NST = 7;
__device__ __forceinline__ void attn_issue(const AttnUnitD& A, const bf16_t* QKV, int tid, u32x4 (&kr)[ATT_NST], u32x4 (&vr)[ATT_NST]) {
    const int ndata = A.nq + 2 * A.R, rv0 = (A.R - A.l0) > 0 ? (A.R - A.l0) : 0, rv1 = (A.L + A.R - A.l0) < ndata ? (A.L + A.R - A.l0) : ndata;
    const bf16_t* kb = QKV + ((size_t)A.colK * M + (size_t)A.b * SEQ) * 64; const bf16_t* vb = QKV + ((size_t)A.colV * M + (size_t)A.b * SEQ) * 64;
#pragma unroll
    for (int i = 0; i < ATT_NST; ++i) { const int x = tid + NTHREADS * i, c = x & 7; int row = x >> 3; row = row < rv0 ? rv0 : (row >= rv1 ? rv1 - 1 : row);
        const size_t o = (size_t)(A.res + A.dil * (A.l0 - A.R + row)) * 64 + c * 8; kr[i] = *(const u32x4*)(kb + o); vr[i] = *(const u32x4*)(vb + o); }
}

__device__ __forceinline__ void phase_attn(LAS unsigned char* lds, const AttnIO& io, int vcu, int G) {
    int tid = threadIdx.x; asm volatile("" : "+v"(tid));
    const int lane = tid & 63, wid = __builtin_amdgcn_readfirstlane(tid >> 6), g4 = lane >> 4, qi = lane & 15;
    LAS unsigned char* Ks = lds + ATT_KS; LAS unsigned char* Vs = lds + ATT_VS; LAS float* tab = (LAS float*)(lds + ATT_TAB);
    constexpr int NU = 256 + 1024 + 1024;
    u32x4 kr[ATT_NST], vr[ATT_NST];
    if (vcu < NU) { const AttnUnitD A0 = attn_decode(vcu); attn_issue(A0, io.QKV, tid, kr, vr); }
    for (int u = vcu; u < NU; u += G) {
        const AttnUnitD A = attn_decode(u);
        const int b = A.b, dil = A.dil, res = A.res, l0 = A.l0, R = A.R, head0 = A.head0, ngroups = A.ngroups, nit = A.nit, branch = A.branch; const bool isB = A.isB != 0;
        const int ndata = A.nq + 2 * R, rv0 = (R - l0) > 0 ? (R - l0) : 0, rv1 = (A.L + R - l0) < ndata ? (A.L + R - l0) : ndata;
        auto qptr = [&](int gx) -> const bf16_t* { const int hq_ = isB ? (gx >> 3) : 0, gi_ = isB ? (gx & 7) : gx; const int posq_ = res + dil * (l0 + 16 * gi_ + qi);
            return io.QKV + ((size_t)((isB ? 24 : 0) + head0 + hq_) * M + (size_t)b * SEQ + posq_) * 64 + 8 * g4; };
        u32x4 qr0, qr1; { const bf16_t* qp0 = qptr(wid); qr0 = *(const u32x4*)qp0; qr1 = *(const u32x4*)(qp0 + 32); }
        for (int reps = 0; reps < REP_ATTS; ++reps) {
        __syncthreads();
#pragma unroll
        for (int i = 0; i < ATT_NST; ++i) { const int x = tid + NTHREADS * i, row = x >> 3, c = x & 7;
            if (x < ATT_ROWS * 8) { const int off = row * 128 + ((c ^ (row & 7)) << 4); const bool ok = row >= rv0 && row < rv1; const u32x4 z = (u32x4){0u, 0u, 0u, 0u};
                *(LAS u32x4*)(Ks + off) = ok ? kr[i] : z; *(LAS u32x4*)(Vs + off) = ok ? vr[i] : z; } }
        { const int ntab = isB ? 4 : 1;
          for (int x = tid; x < ntab * ATT_TABN; x += NTHREADS) { const int t = x / ATT_TABN, j = x % ATT_TABN, idx = j - 16;
              float v = -1e30f;
              if (idx >= 0 && idx <= 2 * R) v = io.rel_table[t5_bucket((idx - R) * dil) * 16 + (isB ? 8 + head0 + t : head0)] * LOG2E;
              tab[x] = v; } }
        }
        if (u + G < NU) { const AttnUnitD An = attn_decode(u + G); attn_issue(An, io.QKV, tid, kr, vr); }
        __syncthreads();
        for (int rep = 0; rep < REP_ATTC; ++rep)
        for (int gidx = wid; gidx < ngroups; gidx += NWAVES) {
            const int hq = isB ? (gidx >> 3) : 0, gi = isB ? (gidx & 7) : gidx, head = head0 + hq;
            const int ql = 16 * gi + qi, posq = res + dil * (l0 + ql);
            const LAS float* tb = tab + hq * ATT_TABN + 16;
            bf16x8 qf[2];
            { const u32x4 wq[2] = {qr0, qr1}; const float SC = 0.125f * LOG2E;
              { const int gn = gidx + NWAVES < ngroups ? gidx + NWAVES : gidx; const bf16_t* qpn = qptr(gn); qr0 = *(const u32x4*)qpn; qr1 = *(const u32x4*)(qpn + 32); }
#pragma unroll
              for (int ks = 0; ks < 2; ++ks) { const u32x4 w = wq[ks]; u32x4 o;
                  o.x = cvtpk(bflo(w.x) * SC, bfhi(w.x) * SC); o.y = cvtpk(bflo(w.y) * SC, bfhi(w.y) * SC); o.z = cvtpk(bflo(w.z) * SC, bfhi(w.z) * SC); o.w = cvtpk(bflo(w.w) * SC, bfhi(w.w) * SC);
                  qf[ks] = __builtin_bit_cast(bf16x8, o); } }
            f32x4 ot[4];
#pragma unroll
            for (int dt = 0; dt < 4; ++dt) ot[dt] = (f32x4){0.f, 0.f, 0.f, 0.f};
            float m = -1e20f, lsum = 0.f;
            bf16x8 kf[2][2];
            { const int r0 = 16 * gi + qi;
#pragma unroll
              for (int ks = 0; ks < 2; ++ks) { const int c = g4 + 4 * ks; const int off = r0 * 128 + ((c ^ (r0 & 7)) << 4); kf[ks][0] = *(const LAS bf16x8*)(Ks + off); kf[ks][1] = *(const LAS bf16x8*)(Ks + off + 16 * 128); } }
            for (int it = 0; it < nit; ++it) {
                const int rb = 16 * gi + 32 * it;
                v4i16_t vlo[4], vhi[4];
                { const int ra = rb + 4 * g4 + (qi >> 2);
#pragma unroll
                  for (int dt = 0; dt < 4; ++dt) { const int ch = dt * 2 + ((qi & 3) >> 1); const int off = ra * 128 + ((ch ^ (ra & 7)) << 4) + 8 * (qi & 1); vlo[dt] = lds_tr16(Vs + off); vhi[dt] = lds_tr16(Vs + off + 16 * 128); } }
                f32x4 s0 = (f32x4){0.f, 0.f, 0.f, 0.f}, s1 = s0;
#pragma unroll
                for (int ks = 0; ks < 2; ++ks) { s0 = __builtin_amdgcn_mfma_f32_16x16x32_bf16(kf[ks][0], qf[ks], s0, 0, 0, 0); s1 = __builtin_amdgcn_mfma_f32_16x16x32_bf16(kf[ks][1], qf[ks], s1, 0, 0, 0); }
                if (it + 1 < nit) { const int r0 = rb + 32 + qi;
#pragma unroll
                    for (int ks = 0; ks < 2; ++ks) { const int c = g4 + 4 * ks; const int off = r0 * 128 + ((c ^ (r0 & 7)) << 4); kf[ks][0] = *(const LAS bf16x8*)(Ks + off); kf[ks][1] = *(const LAS bf16x8*)(Ks + off + 16 * 128); } }
                float v[8]; float tmax = -1e30f;
                float tb0[4], tb1[4];
#pragma unroll
                for (int r = 0; r < 4; ++r) { tb0[r] = tb[rb + 4 * g4 + r - ql]; tb1[r] = tb[rb + 4 * g4 + r + 16 - ql]; }
#pragma unroll
                for (int r = 0; r < 4; ++r) { const int row0 = rb + 4 * g4 + r, row1 = row0 + 16;
                    const bool ok0 = (unsigned)(row0 - rv0) < (unsigned)(rv1 - rv0), ok1 = (unsigned)(row1 - rv0) < (unsigned)(rv1 - rv0);
                    const float a = ok0 ? s0[r] + tb0[r] : -1e30f, c2 = ok1 ? s1[r] + tb1[r] : -1e30f;
                    v[r] = a; v[4 + r] = c2; tmax = fmaxf(tmax, fmaxf(a, c2)); }
                tmax = rows_max(tmax);
                const float mn = fmaxf(m, tmax), alpha = __builtin_amdgcn_exp2f(m - mn); m = mn;
                float ps = 0.f;
#pragma unroll
                for (int i = 0; i < 8; ++i) { v[i] = __builtin_amdgcn_exp2f(v[i] - mn); ps += v[i]; }
                lsum = lsum * alpha + ps;
#pragma unroll
                for (int dt = 0; dt < 4; ++dt) ot[dt] = ot[dt] * alpha;
                u32x4 pw; pw.x = cvtpk(v[0], v[1]); pw.y = cvtpk(v[2], v[3]); pw.z = cvtpk(v[4], v[5]); pw.w = cvtpk(v[6], v[7]);
                const bf16x8 pf = __builtin_bit_cast(bf16x8, pw);
#pragma unroll
                for (int dt = 0; dt < 4; ++dt) { const bf16x8 vf = (bf16x8){vlo[dt][0], vlo[dt][1], vlo[dt][2], vlo[dt][3], vhi[dt][0], vhi[dt][1], vhi[dt][2], vhi[dt][3]};
                    ot[dt] = __builtin_amdgcn_mfma_f32_16x16x32_bf16(vf, pf, ot[dt], 0, 0, 0); }
            }
            lsum = rows_sum(lsum);
            const size_t tok = (size_t)b * SEQ + posq;
            float scale;
            if (isB) { const float s2 = io.sink[head] * LOG2E, mf = fmaxf(m, s2), e = __builtin_amdgcn_exp2f(m - mf); scale = e / (lsum * e + __builtin_amdgcn_exp2f(s2 - mf)); }
            else { scale = 1.f / lsum; if (g4 == 0) io.LSE[((size_t)branch * M + tok) * 8 + head] = m + __builtin_amdgcn_logf(lsum); }
            bf16_t* op = isB ? io.O + tok * D + 512 + head * 64 : io.OBR + ((size_t)branch * M + tok) * 512 + head * 64;
#pragma unroll
            for (int dt = 0; dt < 4; ++dt) { const f32x4 o = ot[dt] * scale; u32x2 w; w.x = cvtpk(o[0], o[1]); w.y = cvtpk(o[2], o[3]); *(u32x2*)(op + dt * 16 + 4 * g4) = w; }
        }
    }
}
__device__ __forceinline__ void phase_attn_merge(const AttnIO& io, int gtid, int NGT) {
    for (int x = gtid; x < M * 64; x += NGT) { const int tok = x >> 6, head = (x >> 3) & 7, c8 = x & 7;
        const float l0 = io.LSE[((size_t)0 * M + tok) * 8 + head], l1 = io.LSE[((size_t)1 * M + tok) * 8 + head], l2 = io.LSE[((size_t)2 * M + tok) * 8 + head];
        const float mx = fmaxf(l0, fmaxf(l1, l2)); float w0 = __builtin_amdgcn_exp2f(l0 - mx), w1 = __builtin_amdgcn_exp2f(l1 - mx), w2 = __builtin_amdgcn_exp2f(l2 - mx);
        const float inv = 1.f / (w0 + w1 + w2); w0 *= inv; w1 *= inv; w2 *= inv;
        const size_t o = (size_t)tok * 512 + head * 64 + c8 * 8;
        const u32x4 a = *(const u32x4*)(io.OBR + o), bq = *(const u32x4*)(io.OBR + (size_t)M * 512 + o), c = *(const u32x4*)(io.OBR + (size_t)2 * M * 512 + o);
        u32x4 r;
        r.x = pk2(w0 * bflo(a.x) + w1 * bflo(bq.x) + w2 * bflo(c.x), w0 * bfhi(a.x) + w1 * bfhi(bq.x) + w2 * bfhi(c.x));
        r.y = pk2(w0 * bflo(a.y) + w1 * bflo(bq.y) + w2 * bflo(c.y), w0 * bfhi(a.y) + w1 * bfhi(bq.y) + w2 * bfhi(c.y));
        r.z = pk2(w0 * bflo(a.z) + w1 * bflo(bq.z) + w2 * bflo(c.z), w0 * bfhi(a.z) + w1 * bfhi(bq.z) + w2 * bfhi(c.z));
        r.w = pk2(w0 * bflo(a.w) + w1 * bflo(bq.w) + w2 * bflo(c.w), w0 * bfhi(a.w) + w1 * bfhi(bq.w) + w2 * bfhi(c.w));
        pg8::store16_wt(io.O + (size_t)tok * D + head * 64 + c8 * 8, r); }
}

constexpr int NCH = SEQ / 16;
constexpr int SC_LROW = 68, SC_LDROW = 528, SC_LSLOT = 4 * 16 * SC_LROW * 4 + 16 * SC_LDROW;
constexpr int CT_KHT = 0, CT_RHT = 2048, CT_BTT = 4096, CT_KTT = 6144, CT_VT = 8192, CT_WEND = 10240, CT_SLOT = CT_WEND + 256;
constexpr int GT_AKK = 0, GT_BB = 512, GT_BK = 1024, GT_TT = 1536, GT_SLOT = 2048;
constexpr int SC_LBUF = 0, SC_CT = SC_LBUF + 2 * SC_LSLOT, SC_GG = SC_CT + 3 * CT_SLOT, SC_RKR = SC_GG + 4 * 4096, SC_GT = SC_RKR + 4 * 256, SC_NB = SC_GT + 2 * GT_SLOT, SC_OUT = SC_NB + 1024, SC_END = SC_OUT + 2 * 4096;
static_assert(SC_END <= LDSCTL_OFF, "scan LDS map");
template <int CTRL> __device__ __forceinline__ float dpp_f(float x) { return __int_as_float(__builtin_amdgcn_update_dpp(0, __float_as_int(x), CTRL, 0xf, 0xf, true)); }
__device__ __forceinline__ float sum8(float x) { x += dpp_f<0xB1>(x); x += dpp_f<0x4E>(x); x += dpp_f<0x141>(x); return x; }
__device__ __forceinline__ float sum16(float x) { x += dpp_f<0xB1>(x); x += dpp_f<0x4E>(x); x += dpp_f<0x141>(x); x += dpp_f<0x140>(x); return x; }
__device__ __forceinline__ float fast_sigmoid(float z) { return __builtin_amdgcn_rcpf(1.f + __builtin_amdgcn_exp2f(-LOG2E * z)); }
__device__ __forceinline__ bf16x8 mk8(unsigned a, unsigned b, unsigned c, unsigned d) { return __builtin_bit_cast(bf16x8, (u32x4){a, b, c, d}); }

struct ScanPtrs { const bf16_t *R, *Kk, *V, *LDA; bf16_t* Y; const float *w2, *a2, *g2, *w0, *a0, *k_k, *k_a, *r_k, *gn_w, *gn_b; };
__device__ __forceinline__ void phase_scan(LAS unsigned char* lds, const ScanPtrs& P, int G) {
    int tid = threadIdx.x; asm volatile("" : "+v"(tid));
    const int lane = tid & 63, wid = __builtin_amdgcn_readfirstlane(tid >> 6), g4 = lane >> 4, c16 = lane & 15;
    for (int unit = blockIdx.x; unit < 256; unit += G) {
        const int b = unit >> 5, h = (unit >> 1) & 15, d = unit & 1, hc = h * 64;
        unsigned long long wait_acc = 0ull;
        __syncthreads();
        if (wid < 4) {
            f32x4 ST[4];
#pragma unroll
            for (int mt = 0; mt < 4; ++mt) ST[mt] = (f32x4){0.f, 0.f, 0.f, 0.f};
            const int pch = hc + 8 * (lane & 7);
            const f32x4 gw0 = *(const f32x4*)(P.gn_w + pch), gw1 = *(const f32x4*)(P.gn_w + pch + 4), gb0 = *(const f32x4*)(P.gn_b + pch), gb1 = *(const f32x4*)(P.gn_b + pch + 4);
            u32x4 pvA = {0u, 0u, 0u, 0u}, pvB = pvA;
            auto issueV = [&](int ch_, u32x4& dst) { const int s = 8 * (wid - 1) + (lane >> 3), t = d ? (SEQ - 1 - (ch_ * 16 + s)) : (ch_ * 16 + s); dst = *(const u32x4*)(P.V + ((size_t)b * SEQ + t) * D + pch); };
            if (wid == 1 || wid == 2) { issueV(0, pvA); issueV(1, pvB); }
            auto sw_interval = [&](int i, u32x4& pvset) {
                const int c = i - 3;
                int ln = lane; asm volatile("" : "+v"(ln)); const int g4 = ln >> 4, c16 = ln & 15;
                if (c >= 0 && c < NCH) {
                    const LAS unsigned char* Ct = lds + SC_CT + (c % 3) * CT_SLOT; const LAS unsigned char* Gt = lds + SC_GT + (c & 1) * GT_SLOT;
                    v4i16_t kha[2][2], rha[2][2];
#pragma unroll
                    for (int p = 0; p < 2; ++p)
#pragma unroll
                        for (int hh = 0; hh < 2; ++hh) { const int off = (32 * p + 16 * hh + 4 * g4 + (c16 >> 2)) * 32 + 8 * (c16 & 3); kha[p][hh] = lds_tr16(Ct + CT_KHT + off); rha[p][hh] = lds_tr16(Ct + CT_RHT + off); }
                    const u32x2 gakk = *(const LAS u32x2*)(Gt + GT_AKK + c16 * 32 + 8 * g4), gtt = *(const LAS u32x2*)(Gt + GT_TT + c16 * 32 + 8 * g4);
                    const u32x2 gbb = *(const LAS u32x2*)(Gt + GT_BB + c16 * 32 + 8 * g4), gbk = *(const LAS u32x2*)(Gt + GT_BK + c16 * 32 + 8 * g4);
                    const u32x2 vt = *(const LAS u32x2*)(Ct + CT_VT + (16 * wid + c16) * 32 + 8 * g4);
                    u32x2 btt[4], ktt[4]; f32x4 we[4];
#pragma unroll
                    for (int mt = 0; mt < 4; ++mt) { btt[mt] = *(const LAS u32x2*)(Ct + CT_BTT + (16 * mt + c16) * 32 + 8 * g4); ktt[mt] = *(const LAS u32x2*)(Ct + CT_KTT + (16 * mt + c16) * 32 + 8 * g4);
                        we[mt] = *(const LAS f32x4*)(Ct + CT_WEND + (16 * mt + 4 * g4) * 4); }
                    f32x4 pt = {0.f, 0.f, 0.f, 0.f}, prt = pt;
#pragma unroll
                    for (int p = 0; p < 2; ++p) { const bf16x8 sb = mk8(cvtpk(ST[2 * p][0], ST[2 * p][1]), cvtpk(ST[2 * p][2], ST[2 * p][3]), cvtpk(ST[2 * p + 1][0], ST[2 * p + 1][1]), cvtpk(ST[2 * p + 1][2], ST[2 * p + 1][3]));
                        pt = __builtin_amdgcn_mfma_f32_16x16x32_bf16((bf16x8){kha[p][0][0], kha[p][0][1], kha[p][0][2], kha[p][0][3], kha[p][1][0], kha[p][1][1], kha[p][1][2], kha[p][1][3]}, sb, pt, 0, 0, 0);
                        prt = __builtin_amdgcn_mfma_f32_16x16x32_bf16((bf16x8){rha[p][0][0], rha[p][0][1], rha[p][0][2], rha[p][0][3], rha[p][1][0], rha[p][1][1], rha[p][1][2], rha[p][1][3]}, sb, prt, 0, 0, 0); }
                    const f32x4 qt = __builtin_amdgcn_mfma_f32_16x16x32_bf16(mk8(gakk.x, gakk.y, 0u, 0u), mk8(vt.x, vt.y, 0u, 0u), pt, 0, 0, 0);
                    const f32x4 sat = __builtin_amdgcn_mfma_f32_16x16x32_bf16(mk8(gtt.x, gtt.y, 0u, 0u), mk8(cvtpk(qt[0], qt[1]), cvtpk(qt[2], qt[3]), 0u, 0u), (f32x4){0.f, 0.f, 0.f, 0.f}, 0, 0, 0);
                    const bf16x8 sv = mk8(cvtpk(sat[0], sat[1]), cvtpk(sat[2], sat[3]), vt.x, vt.y);
                    const f32x4 outt = __builtin_amdgcn_mfma_f32_16x16x32_bf16(mk8(gbb.x, gbb.y, gbk.x, gbk.y), sv, prt, 0, 0, 0);
#pragma unroll
                    for (int mt = 0; mt < 4; ++mt) { ST[mt] = __builtin_amdgcn_mfma_f32_16x16x32_bf16(mk8(btt[mt].x, btt[mt].y, ktt[mt].x, ktt[mt].y), sv, ST[mt], 0, 0, 0); ST[mt] = ST[mt] * we[mt]; }
                    LAS float* ob = (LAS float*)(lds + SC_OUT + (c & 1) * 4096) + 16 * wid + c16;
#pragma unroll
                    for (int r = 0; r < 4; ++r) ob[(4 * g4 + r) * 64] = outt[r];
                }
                for (int rep_ = 0; rep_ < REP_ST; ++rep_)
                if (i >= 2 && i - 2 < NCH) {
                    const int jg = i - 2, hw = wid;
                    const LAS unsigned char* Ct = lds + SC_CT + (jg % 3) * CT_SLOT; LAS unsigned char* Gt = lds + SC_GT + (jg & 1) * GT_SLOT;
                    const int aoff = (hw & 1) ? CT_KTT : CT_BTT, boff = (hw & 2) ? CT_RHT : CT_KHT;
                    f32x4 gm = {0.f, 0.f, 0.f, 0.f}, gmT = gm;
#pragma unroll
                    for (int ks = 0; ks < 2; ++ks) { const int o1 = (8 * g4 + 32 * ks + (c16 >> 2)) * 32 + 8 * (c16 & 3), o2 = o1 + 4 * 32;
                        const v4i16_t a0 = lds_tr16(Ct + aoff + o1), a1 = lds_tr16(Ct + aoff + o2), b0 = lds_tr16(Ct + boff + o1), b1 = lds_tr16(Ct + boff + o2);
                        const bf16x8 af = {a0[0], a0[1], a0[2], a0[3], a1[0], a1[1], a1[2], a1[3]}, bfr = {b0[0], b0[1], b0[2], b0[3], b1[0], b1[1], b1[2], b1[3]};
                        gm = __builtin_amdgcn_mfma_f32_16x16x32_bf16(af, bfr, gm, 0, 0, 0);
                        if (hw == 0) gmT = __builtin_amdgcn_mfma_f32_16x16x32_bf16(bfr, af, gmT, 0, 0, 0); }
#pragma unroll
                    for (int r = 0; r < 4; ++r) { const int s = 4 * g4 + r; const bool keep = (hw & 2) ? (s <= c16) : (s < c16); gm[r] = keep ? gm[r] : 0.f; gmT[r] = (c16 < s) ? gmT[r] : 0.f; }
                    if (hw != 0) { *(LAS u32x2*)(Gt + (hw == 1 ? GT_AKK : (hw == 2 ? GT_BB : GT_BK)) + c16 * 32 + 8 * g4) = (u32x2){cvtpk(gm[0], gm[1]), cvtpk(gm[2], gm[3])}; }
                    else {
#define SC_OPA(x) mk8(cvtpk((x)[0], (x)[1]), cvtpk((x)[2], (x)[3]), 0u, 0u)
                        const f32x4 z4 = {0.f, 0.f, 0.f, 0.f};
                        f32x4 Rm, RTm;
#pragma unroll
                        for (int r = 0; r < 4; ++r) { const float idn = (4 * g4 + r == c16) ? 1.f : 0.f; Rm[r] = idn - gm[r]; RTm[r] = idn - gmT[r]; }
                        const f32x4 N2 = __builtin_amdgcn_mfma_f32_16x16x32_bf16(SC_OPA(gmT), SC_OPA(gm), z4, 0, 0, 0), N2T = __builtin_amdgcn_mfma_f32_16x16x32_bf16(SC_OPA(gm), SC_OPA(gmT), z4, 0, 0, 0);
                        f32x4 R1 = __builtin_amdgcn_mfma_f32_16x16x32_bf16(SC_OPA(RTm), SC_OPA(N2), Rm, 0, 0, 0), R1T = __builtin_amdgcn_mfma_f32_16x16x32_bf16(SC_OPA(N2), SC_OPA(RTm), RTm, 0, 0, 0);
                        const f32x4 N4 = __builtin_amdgcn_mfma_f32_16x16x32_bf16(SC_OPA(N2T), SC_OPA(N2), z4, 0, 0, 0), N4T = __builtin_amdgcn_mfma_f32_16x16x32_bf16(SC_OPA(N2), SC_OPA(N2T), z4, 0, 0, 0);
                        f32x4 R2 = __builtin_amdgcn_mfma_f32_16x16x32_bf16(SC_OPA(R1T), SC_OPA(N4), R1, 0, 0, 0), R2T = __builtin_amdgcn_mfma_f32_16x16x32_bf16(SC_OPA(N4), SC_OPA(R1T), R1T, 0, 0, 0);
                        const f32x4 N8 = __builtin_amdgcn_mfma_f32_16x16x32_bf16(SC_OPA(N4T), SC_OPA(N4), z4, 0, 0, 0);
                        const f32x4 Tm = __builtin_amdgcn_mfma_f32_16x16x32_bf16(SC_OPA(R2T), SC_OPA(N8), R2, 0, 0, 0);
#undef SC_OPA
                        *(LAS u32x2*)(Gt + GT_TT + c16 * 32 + 8 * g4) = (u32x2){cvtpk(-Tm[0], -Tm[1]), cvtpk(-Tm[2], -Tm[3])};
                    }
                }
                if ((wid == 1 || wid == 2) && i >= 4 && i - 4 < NCH) {
                    const int jp = i - 4, tl = ln >> 3, c8 = ln & 7;
                    const int s = 8 * (wid - 1) + tl, t = d ? (SEQ - 1 - (jp * 16 + s)) : (jp * 16 + s);
                    const LAS float* ob = (const LAS float*)(lds + SC_OUT + (jp & 1) * 4096) + s * 64 + 8 * c8; const LAS float* gp = (const LAS float*)(lds + SC_GG + (jp & 3) * 4096) + s * 64 + 8 * c8;
                    const f32x4 o0 = *(const LAS f32x4*)(ob), o1 = *(const LAS f32x4*)(ob + 4), g0 = *(const LAS f32x4*)(gp), g1 = *(const LAS f32x4*)(gp + 4);
                    const f32x4 rk4 = *(const LAS f32x4*)((const LAS float*)(lds + SC_RKR + (jp & 3) * 256) + s * 4); const float rkr = (rk4[0] + rk4[1]) + (rk4[2] + rk4[3]);
                    const u32x4 pv = pvset; issueV(jp + 2 < NCH ? jp + 2 : NCH - 1, pvset);
                    const f32x4 v0 = {bflo(pv.x), bfhi(pv.x), bflo(pv.y), bfhi(pv.y)}, v1 = {bflo(pv.z), bfhi(pv.z), bflo(pv.w), bfhi(pv.w)};
                    float mu = ((o0[0] + o0[1]) + (o0[2] + o0[3])) + ((o1[0] + o1[1]) + (o1[2] + o1[3])); mu = sum8(mu) * (1.f / 64.f);
                    const f32x4 d0 = o0 - mu, d1 = o1 - mu; float var = ((d0[0] * d0[0] + d0[1] * d0[1]) + (d0[2] * d0[2] + d0[3] * d0[3])) + ((d1[0] * d1[0] + d1[1] * d1[1]) + (d1[2] * d1[2] + d1[3] * d1[3])); var = sum8(var) * (1.f / 64.f);
                    const float rs = rsqrtf(var + GN_EPS);
                    const f32x4 y0 = (d0 * rs * gw0 + gb0 + rkr * v0) * g0, y1 = (d1 * rs * gw1 + gb1 + rkr * v1) * g1;
                    pg8::store16_wt(P.Y + ((size_t)b * SEQ + t) * (2 * D) + d * D + hc + 8 * c8, (u32x4){cvtpk(y0[0], y0[1]), cvtpk(y0[2], y0[3]), cvtpk(y1[0], y1[1]), cvtpk(y1[2], y1[3])});
                }
                for (int rep_ = 0; rep_ < REP_SYNC; ++rep_) __syncthreads();
                if (WAITPROBE >= 0) { const unsigned long long t0_ = __builtin_amdgcn_s_memrealtime(); __syncthreads(); wait_acc += __builtin_amdgcn_s_memrealtime() - t0_; } else
                __syncthreads();
            };
            static_assert((NCH + 4) % 2 == 0, "interval loop is unrolled by two");
            __builtin_amdgcn_s_setprio(2);
            for (int i = 0; i < NCH + 4; i += 2) { sw_interval(i, pvA); sw_interval(i + 1, pvB); }
            __builtin_amdgcn_s_setprio(0);
        } else {
            const int hw = wid - 4;
            const int chC = hc + 16 * hw + c16, chT = hc + 4 * c16;
            bf16x8 bw[2], ba[2], bg[4];
#pragma unroll
            for (int ks = 0; ks < 2; ++ks) { u32x4 w, a;
#pragma unroll
                for (int jj = 0; jj < 4; ++jj) { const int k = 32 * ks + 8 * g4 + 2 * jj;
                    w[jj] = pk2(P.w2[(size_t)(d * 64 + k) * D + chC], P.w2[(size_t)(d * 64 + k + 1) * D + chC]); a[jj] = pk2(P.a2[(size_t)(d * 64 + k) * D + chC], P.a2[(size_t)(d * 64 + k + 1) * D + chC]); }
                bw[ks] = __builtin_bit_cast(bf16x8, w); ba[ks] = __builtin_bit_cast(bf16x8, a); }
#pragma unroll
            for (int ks = 0; ks < 4; ++ks) { u32x4 g;
#pragma unroll
                for (int jj = 0; jj < 4; ++jj) { const int k = 32 * ks + 8 * g4 + 2 * jj; g[jj] = pk2(P.g2[(size_t)(d * 128 + k) * D + chC], P.g2[(size_t)(d * 128 + k + 1) * D + chC]); }
                bg[ks] = __builtin_bit_cast(bf16x8, g); }
            const float w0c = P.w0[d * D + chC], a0c = P.a0[d * D + chC], kaC = P.k_a[chC], rkC = P.r_k[chC];
            const f32x4 kkT = *(const f32x4*)(P.k_k + chT);
            const int n0 = 16 * c16, lcol = n0 < 64 ? (d * 64 + n0) : (n0 < 128 ? (128 + d * 64 + (n0 - 64)) : (256 + d * 128 + (n0 - 128)));
            struct LSet { u32x2 r, k, v; u32x4 l0, l1; };
            LSet setA, setB;
            auto issueL = [&](int ch_, LSet& S) { const int s = 4 * hw + g4, t = d ? (SEQ - 1 - (ch_ * 16 + s)) : (ch_ * 16 + s); const size_t row = (size_t)b * SEQ + t;
                S.r = *(const u32x2*)(P.R + row * D + chT); S.k = *(const u32x2*)(P.Kk + row * D + chT); S.v = *(const u32x2*)(P.V + row * D + chT);
                S.l0 = *(const u32x4*)(P.LDA + row * 512 + lcol); S.l1 = *(const u32x4*)(P.LDA + row * 512 + lcol + 8); };
            issueL(0, setA); issueL(1, setB);
            auto hw_interval = [&](int i, LSet& LS) {
                const bool doL = i < NCH, doC = (i >= 1 && i - 1 < NCH);
                int ln = lane; asm volatile("" : "+v"(ln)); const int g4 = ln >> 4, c16 = ln & 15;
                const unsigned long long tb_ = (SECPROBE >= 0) ? __builtin_amdgcn_s_memrealtime() : 0ull;
                for (int rep_ = 0; rep_ < REP_HC; ++rep_)
                if (doC) {
                    const int jc = i - 1;
                    const LAS unsigned char* Ls = lds + SC_LBUF + (jc & 1) * SC_LSLOT;
                    const LAS unsigned char* ldp = Ls + 4 * 16 * SC_LROW * 4 + c16 * SC_LDROW + 16 * g4;
                    f32x4 zw = {0.f, 0.f, 0.f, 0.f}, za = zw, gg = zw;
#pragma unroll
                    for (int ks = 0; ks < 2; ++ks) { zw = __builtin_amdgcn_mfma_f32_16x16x32_bf16(*(const LAS bf16x8*)(ldp + 64 * ks), bw[ks], zw, 0, 0, 0);
                                                     za = __builtin_amdgcn_mfma_f32_16x16x32_bf16(*(const LAS bf16x8*)(ldp + 128 + 64 * ks), ba[ks], za, 0, 0, 0); }
#pragma unroll
                    for (int ks = 0; ks < 4; ++ks) gg = __builtin_amdgcn_mfma_f32_16x16x32_bf16(*(const LAS bf16x8*)(ldp + 256 + 64 * ks), bg[ks], gg, 0, 0, 0);
                    float lw[4], cw[4]; float tot = 0.f;
#pragma unroll
                    for (int r = 0; r < 4; ++r) { lw[r] = -0.6065306597f * fast_sigmoid(w0c + zw[r]); tot += lw[r]; cw[r] = tot; }
                    float pre;
                    { auto e = __builtin_amdgcn_permlane16_swap(__float_as_uint(tot), __float_as_uint(tot), false, false); const float e0 = __uint_as_float(e[0]), s01 = e0 + __uint_as_float(e[1]);
                      auto f = __builtin_amdgcn_permlane32_swap(__float_as_uint(s01), __float_as_uint(s01), false, false);
                      pre = ((g4 & 1) ? e0 : 0.f) + ((g4 & 2) ? __uint_as_float(f[0]) : 0.f); }
                    const LAS float* Lf = (const LAS float*)Ls + 16 * hw + c16;
                    LAS unsigned char* Ct = lds + SC_CT + (jc % 3) * CT_SLOT;
                    LAS float* ggw = (LAS float*)(lds + SC_GG + (jc & 3) * 4096) + 16 * hw + c16;
                    float kh[4], rh[4], bt[4], kt[4], vv[4], rkp[4];
#pragma unroll
                    for (int r = 0; r < 4; ++r) { const int tok = 4 * g4 + r; const float c = pre + cw[r];
                        const float Wc = __builtin_amdgcn_exp2f(LOG2E * c), Wp = __builtin_amdgcn_exp2f(LOG2E * (c - lw[r])), iW = __builtin_amdgcn_exp2f(-LOG2E * c);
                        const float a = fast_sigmoid(a0c + za[r]);
                        const float rr = Lf[tok * SC_LROW], kk_ = Lf[16 * SC_LROW + tok * SC_LROW], nk = Lf[32 * SC_LROW + tok * SC_LROW]; vv[r] = Lf[48 * SC_LROW + tok * SC_LROW];
                        const float kd = kk_ * (1.f + (a - 1.f) * kaC);
                        kh[r] = nk * Wp; rh[r] = rr * Wc; bt[r] = nk * a * iW; kt[r] = kd * iW; rkp[r] = rr * kd * rkC;
                        ggw[tok * 64] = gg[r];
                        if (tok == 15) ((LAS float*)(Ct + CT_WEND))[16 * hw + c16] = Wc; }
                    { LAS unsigned char* tq = Ct + (16 * hw + c16) * 32 + 8 * g4;
                      *(LAS u32x2*)(tq + CT_KHT) = (u32x2){cvtpk(kh[0], kh[1]), cvtpk(kh[2], kh[3])}; *(LAS u32x2*)(tq + CT_RHT) = (u32x2){cvtpk(rh[0], rh[1]), cvtpk(rh[2], rh[3])};
                      *(LAS u32x2*)(tq + CT_BTT) = (u32x2){cvtpk(bt[0], bt[1]), cvtpk(bt[2], bt[3])}; *(LAS u32x2*)(tq + CT_KTT) = (u32x2){cvtpk(kt[0], kt[1]), cvtpk(kt[2], kt[3])};
                      *(LAS u32x2*)(tq + CT_VT) = (u32x2){cvtpk(vv[0], vv[1]), cvtpk(vv[2], vv[3])}; }
#pragma unroll
                    for (int r = 0; r < 4; ++r) rkp[r] = sum16(rkp[r]);
                    if (c16 == 0) { LAS float* rk = (LAS float*)(lds + SC_RKR + (jc & 3) * 256) + hw;
#pragma unroll
                        for (int r = 0; r < 4; ++r) rk[(4 * g4 + r) * 4] = rkp[r]; }
                }
                const unsigned long long tc_ = (SECPROBE >= 0) ? __builtin_amdgcn_s_memrealtime() : 0ull;
                for (int rep_ = 0; rep_ < REP_HL; ++rep_)
                if (doL) {
                    LAS unsigned char* Ls = lds + SC_LBUF + (i & 1) * SC_LSLOT; LAS float* Lf = (LAS float*)Ls;
                    const int s = 4 * hw + g4;
                    const u32x2 lr = LS.r, lk = LS.k, lv = LS.v; const u32x4 l00 = LS.l0, l01 = LS.l1;
                    issueL(i + 2 < NCH ? i + 2 : NCH - 1, LS);
                    const f32x4 rr = {bflo(lr.x), bfhi(lr.x), bflo(lr.y), bfhi(lr.y)}, kk_ = {bflo(lk.x), bfhi(lk.x), bflo(lk.y), bfhi(lk.y)}, vv = {bflo(lv.x), bfhi(lv.x), bflo(lv.y), bfhi(lv.y)};
                    f32x4 nk = kk_ * kkT; float ss = nk[0] * nk[0] + nk[1] * nk[1] + nk[2] * nk[2] + nk[3] * nk[3];
                    ss = sum16(ss);
                    nk = nk * (1.f / fmaxf(sqrtf(ss), 1e-12f));
                    *(LAS f32x4*)(Lf + s * SC_LROW + 4 * c16) = rr; *(LAS f32x4*)(Lf + 16 * SC_LROW + s * SC_LROW + 4 * c16) = kk_;
                    *(LAS f32x4*)(Lf + 32 * SC_LROW + s * SC_LROW + 4 * c16) = nk; *(LAS f32x4*)(Lf + 48 * SC_LROW + s * SC_LROW + 4 * c16) = vv;
                    *(LAS u32x4*)(Ls + 4 * 16 * SC_LROW * 4 + s * SC_LDROW + 32 * c16) = l00; *(LAS u32x4*)(Ls + 4 * 16 * SC_LROW * 4 + s * SC_LDROW + 32 * c16 + 16) = l01;
                }
                for (int rep_ = 0; rep_ < REP_SYNC; ++rep_) __syncthreads();
                if (SECPROBE >= 0) { asm volatile("s_waitcnt vmcnt(0) lgkmcnt(0)" ::: "memory"); const unsigned long long te_ = __builtin_amdgcn_s_memrealtime(); wait_acc += (SECPROBE == 0) ? (tc_ - tb_) : ((SECPROBE == 1) ? (te_ - tc_) : (te_ - tb_)); __syncthreads(); } else
                if (WAITPROBE >= 0) { const unsigned long long t0_ = __builtin_amdgcn_s_memrealtime(); __syncthreads(); wait_acc += __builtin_amdgcn_s_memrealtime() - t0_; } else
                __syncthreads();
            };
            for (int i = 0; i < NCH + 4; i += 2) { hw_interval(i, setA); hw_interval(i + 1, setB); }
        }
        if ((WAITPROBE >= 0 || SECPROBE >= 0) && blockIdx.x == 0 && wid == (SECPROBE >= 0 ? 4 : WAITPROBE)) { const unsigned long long tgt_ = __builtin_amdgcn_s_memrealtime() + 4ull * wait_acc; while (__builtin_amdgcn_s_memrealtime() < tgt_) __builtin_amdgcn_s_sleep(8); }
    }
}

__global__ void __launch_bounds__(NTHREADS, 2) fwd_megakernel(Args args) {
    extern __shared__ __attribute__((aligned(16))) unsigned char lds_raw[];
    LAS unsigned char* lds = (LAS unsigned char*)lds_raw;
    volatile LAS unsigned* MISC = (volatile LAS unsigned*)(lds + MISC_OFF);
    const int tid0 = threadIdx.x, wave = __builtin_amdgcn_readfirstlane(tid0 >> 6);
#define FRESH_LANE() int tid = tid0; asm volatile("" : "+v"(tid)); const int lane = tid & 63; (void)lane
    const int G = gridDim.x;
    const int vcu = (G % 8 == 0) ? ((int)blockIdx.x % 8) * (G / 8) + (int)blockIdx.x / 8 : (int)blockIdx.x;
    const int gw = vcu * NWAVES + wave, NGW = G * NWAVES;
    unsigned char* ws = args.ws;
    unsigned* ctl = (unsigned*)(ws + WS_CTL);
    for (int u = tid0; u < (LDS_BYTES - LDSCTL_OFF) / 4; u += NTHREADS) ((LAS unsigned*)(lds + LDSCTL_OFF))[u] = 0u;
    __syncthreads();
    XcdBarrier bar = xcd_barrier_post(ctl + CW_BAR, MISC + 8);
    unsigned long long ts_a = 0ull; int ts_n = 0;
#define STAMP() do { if (TS_A >= 0) { const unsigned long long t_ = __builtin_amdgcn_s_memrealtime(); if (ts_n == TS_A) ts_a = t_; \
    if (ts_n == TS_B && blockIdx.x == 0) { const unsigned long long tgt_ = t_ + 4ull * (t_ - ts_a); while (__builtin_amdgcn_s_memrealtime() < tgt_) __builtin_amdgcn_s_sleep(8); } ++ts_n; } } while (0)
#define GRID_BAR() do { xcd_barrier(bar); STAMP(); } while (0)
    STAMP();

    const float* x = args.in[0]; const float* rel_table = args.in[1]; const float* norm_g = args.in[2]; const float* attn_w_in = args.in[3]; const float* attn_sink = args.in[4];
    const float* attn_w_out = args.in[5]; const float* mu_prev = args.in[6]; const float* mu_next = args.in[7]; const float* w_r = args.in[8]; const float* w_k = args.in[9];
    const float* w_v = args.in[10]; const float* w_o = args.in[11]; const float* mlp_w1 = args.in[25]; const float* mlp_w2 = args.in[26];
    bf16_t* HBa = (bf16_t*)args.out; bf16_t* HBb = HBa + (size_t)M * D; bf16_t* HBc = (bf16_t*)(ws + WS_HBC); bf16_t* TMP2 = (bf16_t*)(ws + WS_TMP2);
    bf16_t* XN = (bf16_t*)(ws + WS_XN); bf16_t* QKV = (bf16_t*)(ws + WS_QKV); bf16_t* Ob = (bf16_t*)(ws + WS_O); bf16_t* TMP = (bf16_t*)(ws + WS_TMP); bf16_t* Hb = (bf16_t*)(ws + WS_H);
    bf16_t* MIXA = (bf16_t*)(ws + WS_MIXA); bf16_t* MIXB = (bf16_t*)(ws + WS_MIXB); bf16_t* Rb = (bf16_t*)(ws + WS_R); bf16_t* Kb = (bf16_t*)(ws + WS_K); bf16_t* Vb = (bf16_t*)(ws + WS_V);
    bf16_t* LDO = (bf16_t*)(ws + WS_LDO); bf16_t* Yb = (bf16_t*)(ws + WS_Y);
    LAS float* scr = (LAS float*)(lds + wave * TR_SCR_BYTES);
    float* RS = (float*)(ws + WS_CTL + 128 * 1024);

    {
        FRESH_LANE();
        constexpr int I_IN = (D / 64) * (DIN / 64), I_OUT = (D / 64) * (D / 64), I_1 = (D / 64) * (DFF / 64), I_2 = (DFF / 64) * (D / 64);
        const bool tail = (G == 256);
        for (int it = gw; it < (tail ? I_IN : I_IN + I_OUT + I_1 + I_2); it += NGW) { int r = it;
            if (r < I_IN) { transpose_item(attn_w_in, DIN, DIN, (bf16_t*)(ws + WS_WIN_T), D, 0, 0, scr, r, lane, ScaleOne{}); continue; } r -= I_IN;
            if (r < I_OUT) { transpose_item(attn_w_out, D, D, (bf16_t*)(ws + WS_WOUT_T), D, 0, 0, scr, r, lane, ScaleOne{}); continue; } r -= I_OUT;
            if (r < I_1) { transpose_item(mlp_w1, DFF, DFF, (bf16_t*)(ws + WS_W1_T), D, 0, 0, scr, r, lane, ScaleVec{norm_g + 2 * D}); continue; } r -= I_1;
            transpose_item(mlp_w2, D, D, (bf16_t*)(ws + WS_W2_T), DFF, 0, 0, scr, r, lane, ScaleOne{}); }
        for (int row = gw; row < M; row += NGW) { Row16 r; row_load_f32(r, x + (size_t)row * D, lane); row_rmsnorm(r, norm_g, lane); row_store_bf16(r, XN + (size_t)row * D, lane); }
    }
    GRID_BAR();
    { pg8::StaticOrder S; S.init(M, DIN, G, (int)blockIdx.x); const EpiHeadMajor E{QKV};
      for (int rep = 0; rep < REP_GEMM; ++rep) pg8::gemm_phase<EpiHeadMajor, ProbPlain, true, true>(lds, ProbPlain{XN, (const bf16_t*)(ws + WS_WIN_T), D}, S, E); }
    if (G == 256 && blockIdx.x >= 64) {
        FRESH_LANE();
        constexpr int I_OUT = (D / 64) * (D / 64), I_1 = (D / 64) * (DFF / 64), I_2 = (DFF / 64) * (D / 64);
        for (int it = ((int)blockIdx.x - 64) * NWAVES + wave; it < I_OUT + I_1 + I_2; it += 192 * NWAVES) { int r = it;
            if (r < I_OUT) { transpose_item(attn_w_out, D, D, (bf16_t*)(ws + WS_WOUT_T), D, 0, 0, scr, r, lane, ScaleOne{}); continue; } r -= I_OUT;
            if (r < I_1) { transpose_item(mlp_w1, DFF, DFF, (bf16_t*)(ws + WS_W1_T), D, 0, 0, scr, r, lane, ScaleVec{norm_g + 2 * D}); continue; } r -= I_1;
            transpose_item(mlp_w2, D, D, (bf16_t*)(ws + WS_W2_T), DFF, 0, 0, scr, r, lane, ScaleOne{}); }
    }
    GRID_BAR();
    { const AttnIO io{QKV, rel_table, attn_sink, Ob, (bf16_t*)(ws + WS_OBR), (float*)(ws + WS_LSE)};
      for (int rep = 0; rep < REP_ATT; ++rep) phase_attn(lds, io, vcu, G);
      GRID_BAR();
      { FRESH_LANE(); phase_attn_merge(io, vcu * NTHREADS + tid, G * NTHREADS); } }
    GRID_BAR();
    for (int rep = 0; rep < REP_BAR; ++rep) GRID_BAR();
    run_gemm<0>(lds, ProbPlain{Ob, (const bf16_t*)(ws + WS_WOUT_T), D}, DstPlain{TMP, D}, M, D, G);
    GRID_BAR();
    { FRESH_LANE(); phase_resnorm<true, false>(x, TMP, norm_g + D, nullptr, HBa, nullptr, RS, gw, NGW, lane); }
    GRID_BAR();
    run_gemm_rs<1>(lds, ProbPlain{HBa, (const bf16_t*)(ws + WS_W1_T), D}, DstPlain{Hb, DFF}, RS, M, DFF, G);
    GRID_BAR();
    run_gemm<0>(lds, ProbPlain{Hb, (const bf16_t*)(ws + WS_W2_T), DFF}, DstPlain{TMP, D}, M, D, G);
    GRID_BAR();
    { FRESH_LANE(); phase_resnorm<false, false>(HBa, TMP, norm_g + 3 * D, nullptr, HBb, nullptr, nullptr, gw, NGW, lane); }
    GRID_BAR();
    {
        FRESH_LANE();
        const float* g1n = norm_g + 4 * D;
        constexpr int I_SQ = (D / 64) * (D / 64), I_1 = (D / 64) * (DFF / 64), I_2 = (DFF / 64) * (D / 64), I_LD = 384;
        const bool tail = (G == 256);
        for (int it = gw; it < (tail ? 2 * I_SQ + I_2 + I_LD : 4 * I_SQ + I_1 + I_2 + I_LD); it += NGW) { int r = it;
            if (r < I_SQ) { transpose_item(w_r, D, D, (bf16_t*)(ws + WS_WR_T), D, 0, 0, scr, r, lane, ScaleOne{}); continue; } r -= I_SQ;
            if (r < I_SQ) { transpose_item(w_k, D, D, (bf16_t*)(ws + WS_WK_T), D, 0, 0, scr, r, lane, ScaleOne{}); continue; } r -= I_SQ;
            if (!tail) {
                if (r < I_SQ) { transpose_item(w_v, D, D, (bf16_t*)(ws + WS_WV_T), D, 0, 0, scr, r, lane, ScaleOne{}); continue; } r -= I_SQ;
                if (r < I_SQ) { transpose_item(w_o, D, D, (bf16_t*)(ws + WS_WO2_T), D, 0, 0, scr, r, lane, ScaleOne{}); continue; } r -= I_SQ;
                if (r < I_1) { transpose_item(mlp_w1 + (size_t)D * DFF, DFF, DFF, (bf16_t*)(ws + WS_W1B_T), D, 0, 0, scr, r, lane, ScaleVec{norm_g + 6 * D}); continue; } r -= I_1; }
            if (r < I_2) { transpose_item(mlp_w2 + (size_t)DFF * D, D, D, (bf16_t*)(ws + WS_W2B_T), DFF, 0, 0, scr, r, lane, ScaleOne{}); continue; } r -= I_2;
            const int part = r / 128; int q = r % 128; int sub, li;
            if (q < 64) { sub = q / 16; li = q % 16; } else { sub = 4 + (q - 64) / 32; li = (q - 64) % 32; }
            const int dd = sub & 1, kind = sub >> 1;
            const int stream = kind == 0 ? 1 : (kind == 1 ? 4 : 5), Nn = kind == 2 ? 128 : 64;
            const float* src = kind == 0 ? args.in[18] + (size_t)dd * D * 64 : (kind == 1 ? args.in[21] + (size_t)dd * D * 64 : args.in[23] + (size_t)dd * D * 128);
            const int coloff = kind == 0 ? dd * 64 : (kind == 1 ? 128 + dd * 64 : 256 + dd * 128);
            transpose_item(src, Nn, Nn, (bf16_t*)(ws + WS_LDW_T), D, part * 512 + coloff, 0, scr, li, lane, ScaleMix{mu_prev + stream * D, mu_next + stream * D, part}); }
        phase_mix3(lds, HBb, g1n, mu_prev, mu_next, XN, MIXA, MIXB, HBa, gw, NGW, tid, lane);
    }
    GRID_BAR();
    run_gemm<0>(lds, ProbRKL{ws, D}, DstRKL{ws}, M, 14 * 256, G);
    if (G == 256 && blockIdx.x >= 128) {
        FRESH_LANE();
        constexpr int I_SQ = (D / 64) * (D / 64), I_1 = (D / 64) * (DFF / 64);
        for (int it = ((int)blockIdx.x - 128) * NWAVES + wave; it < 2 * I_SQ + I_1; it += 128 * NWAVES) { int r = it;
            if (r < I_SQ) { transpose_item(w_v, D, D, (bf16_t*)(ws + WS_WV_T), D, 0, 0, scr, r, lane, ScaleOne{}); continue; } r -= I_SQ;
            if (r < I_SQ) { transpose_item(w_o, D, D, (bf16_t*)(ws + WS_WO2_T), D, 0, 0, scr, r, lane, ScaleOne{}); continue; } r -= I_SQ;
            transpose_item(mlp_w1 + (size_t)D * DFF, DFF, DFF, (bf16_t*)(ws + WS_W1B_T), D, 0, 0, scr, r, lane, ScaleVec{norm_g + 6 * D}); }
    }
    GRID_BAR();
    run_gemm<0>(lds, ProbPlain{HBa, (const bf16_t*)(ws + WS_WV_T), D}, DstPlain{Vb, D}, M, D, G);
    { FRESH_LANE(); phase_lda(LDO, (bf16_t*)(ws + WS_LDA), gw, NGW, lane); }
    GRID_BAR();
    { ScanPtrs sp{Rb, Kb, Vb, (const bf16_t*)(ws + WS_LDA), Yb, args.in[19], args.in[22], args.in[24], args.in[17], args.in[20], args.in[12], args.in[13], args.in[14], args.in[15], args.in[16]};
      for (int rep = 0; rep < REP_SCAN; ++rep) phase_scan(lds, sp, G); }
    GRID_BAR();
    { FRESH_LANE();
      bf16_t* Ys = (bf16_t*)(ws + WS_YSUM);
      const bool grp_on = (G == 256);
      const int grow0 = 256 * (8 * ((int)blockIdx.x % 8) + ((int)blockIdx.x / 8) % 8) + 64 * ((int)blockIdx.x / 64);
      const int rfirst = grp_on ? grow0 + wave : gw, rend = grp_on ? grow0 + 64 : M, rstride = grp_on ? NWAVES : NGW;
      for (int row = rfirst; row < rend; row += rstride) {
          const u32x4* y0 = (const u32x4*)(Yb + (size_t)row * 2 * D); const u32x4* y1 = (const u32x4*)(Yb + (size_t)row * 2 * D + D);
#pragma unroll
          for (int hb = 0; hb < 2; ++hb) { const u32x4 a = y0[lane + 64 * hb], c = y1[lane + 64 * hb]; u32x4 o;
              o.x = cvtpk(bflo(a.x) + bflo(c.x), bfhi(a.x) + bfhi(c.x)); o.y = cvtpk(bflo(a.y) + bflo(c.y), bfhi(a.y) + bfhi(c.y));
              o.z = cvtpk(bflo(a.z) + bflo(c.z), bfhi(a.z) + bfhi(c.z)); o.w = cvtpk(bflo(a.w) + bflo(c.w), bfhi(a.w) + bfhi(c.w));
              pg8::store16_wt((u32x4*)(Ys + (size_t)row * D) + lane + 64 * hb, o); } }
      if (grp_on) { unsigned ep = 0u; grp_barrier(ctl + CW_BAR, (unsigned)blockIdx.x % 64u, ep); } else GRID_BAR();
      run_gemm<0>(lds, ProbPlain{Ys, (const bf16_t*)(ws + WS_WO2_T), D}, DstPlain{TMP2, D}, M, D, G); }
    GRID_BAR();
    { FRESH_LANE(); phase_resnorm<false, false>(HBb, TMP2, norm_g + 5 * D, nullptr, HBc, nullptr, RS, gw, NGW, lane); }
    GRID_BAR();
    run_gemm_rs<1>(lds, ProbPlain{HBc, (const bf16_t*)(ws + WS_W1B_T), D}, DstPlain{Hb, DFF}, RS, M, DFF, G);
    GRID_BAR();
    run_gemm<0>(lds, ProbPlain{Hb, (const bf16_t*)(ws + WS_W2B_T), DFF}, DstPlain{TMP2, D}, M, D, G);
    GRID_BAR();
    { FRESH_LANE(); phase_resnorm<false, true>(HBc, TMP2, norm_g + 7 * D, nullptr, args.out, nullptr, nullptr, gw, NGW, lane); }
    if (TS_A >= 0) { GRID_BAR(); }
#undef GRID_BAR
}

extern "C" void kernel_launch(void* const* d_in, const int* in_sizes, int n_in, void* d_out, int out_size, void* d_ws, size_t ws_size, hipStream_t stream) {
    static int grid = 0;
    if (grid == 0) {
        if (n_in != 27 || in_sizes[0] != M * D || out_size != M * D || ws_size < WS_END) { fprintf(stderr, "kernel_launch: unexpected shapes (n_in %d, in0 %d, out %d, ws %zu)\n", n_in, n_in > 0 ? in_sizes[0] : -1, out_size, ws_size); grid = -1; return; }
        int dev = 0, cus = 0, per_cu = 0;
        if (hipGetDevice(&dev) != hipSuccess || hipDeviceGetAttribute(&cus, hipDeviceAttributeMultiprocessorCount, dev) != hipSuccess) { grid = -1; return; }
        if (hipFuncSetAttribute((const void*)fwd_megakernel, hipFuncAttributeMaxDynamicSharedMemorySize, LDS_BYTES) != hipSuccess) { fprintf(stderr, "kernel_launch: hipFuncSetAttribute failed\n"); grid = -1; return; }
        if (hipOccupancyMaxActiveBlocksPerMultiprocessor(&per_cu, (const void*)fwd_megakernel, NTHREADS, LDS_BYTES) != hipSuccess || per_cu < 1) { fprintf(stderr, "kernel_launch: occupancy query says %d blocks/CU\n", per_cu); (void)hipGetLastError(); grid = -1; return; }
        grid = cus;
    }
    if (grid < 0) return;
    (void)hipMemsetAsync((char*)d_ws + WS_CTL, 0, CTL_ZERO_BYTES, stream);
    Args a{};
    for (int i = 0; i < 27; ++i) a.in[i] = (const float*)d_in[i];
    a.out = (float*)d_out; a.ws = (unsigned char*)d_ws;
    hipLaunchKernelGGL(fwd_megakernel, dim3(grid), dim3(NTHREADS), LDS_BYTES, stream, a);
}
```

```cpp
#include <hip/hip_runtime.h>
#include <cstdio>
#include <cstdint>

#define LAS __attribute__((address_space(3)))
#define GAS __attribute__((address_space(1)))
typedef unsigned short bf16_t;
typedef short bf16x8 __attribute__((ext_vector_type(8)));
typedef float f32x4 __attribute__((ext_vector_type(4)));
typedef float f32x2 __attribute__((ext_vector_type(2)));
typedef unsigned u32x4 __attribute__((ext_vector_type(4)));
typedef unsigned u32x2 __attribute__((ext_vector_type(2)));

#ifndef REP_SCAN
#define REP_SCAN 1
#endif
#ifndef REP_ATT
#define REP_ATT 1
#endif
#ifndef REP_GEMM
#define REP_GEMM 1
#endif
#ifndef REP_ATTC
#define REP_ATTC 1
#endif
#ifndef REP_BAR
#define REP_BAR 0
#endif
#ifndef REP_ATTS
#define REP_ATTS 1
#endif
#ifndef REP_HC
#define REP_HC 1
#endif
#ifndef REP_ST
#define REP_ST 1
#endif
#ifndef REP_HL
#define REP_HL 1
#endif
#ifndef REP_SYNC
#define REP_SYNC 0
#endif
#ifndef SECPROBE
#define SECPROBE -1
#endif
#ifndef WAITPROBE
#define WAITPROBE -1
#endif
#ifndef TS_A
#define TS_A -1
#endif
#ifndef TS_B
#define TS_B -1
#endif
constexpr int SEQ = 2048, D = 1024, NBATCH = 8, M = NBATCH * SEQ, DFF = 4096, DIN = 2304, NLD = 1536;
constexpr float NORM_EPS = 1e-6f, GN_EPS = 64e-5f;
constexpr int NWAVES = 8, NTHREADS = 512;

namespace pg8 {
constexpr int BM = 256, BK = 64, HALF = 128, HTB = HALF * BK * 2, STAGE_BYTES = 8 * HTB, NXCD = 8, WGM = 8;
__host__ __device__ __forceinline__ int lds_byte(int r, int c) { const int st = (r >> 4) * 2 + (c >> 5), rr = r & 15, cc = c & 31, ob = rr * 64 + cc * 2; return st * 1024 + (ob ^ (((ob >> 9) & 1) << 5)); }
__host__ __device__ __forceinline__ void stage_rc(int b, int& R, int& C) { const int st = b / 1024, sb = b % 1024, swz = sb ^ (((sb >> 9) & 1) << 5); R = (st >> 1) * 16 + swz / 64; C = (st & 1) * 32 + (swz % 64) / 2; }
__host__ __device__ __forceinline__ int perm32(int rho) { const int n = rho >> 4, i = rho & 15; return 8 * (i >> 2) + 4 * n + (i & 3); }

struct Unit { int pm, pn; };
struct StaticOrder {
    int nM, nN, nwg, G, c;
    __host__ __device__ void init(int Mr, int N, int G_, int c_) { nM = Mr / BM; nN = N / BM; nwg = nM * nN; G = G_; c = c_; }
    __host__ __device__ bool next(int i, Unit& u) const {
        const long L = (long)i * G + c; if (L >= nwg) return false;
        int wgid = (int)L; { const int q = nwg / NXCD, r = nwg % NXCD, xcd = wgid % NXCD, off = wgid / NXCD; wgid = (xcd < r ? xcd * (q + 1) : r * (q + 1) + (xcd - r) * q) + off; }
        const int nig = WGM * nN, gid = wgid / nig, fm = gid * WGM, gsz = (nM - fm) < WGM ? (nM - fm) : WGM;
        u.pm = fm + ((wgid % nig) % gsz); u.pn = (wgid % nig) / gsz; return true;
    }
};
__device__ __forceinline__ unsigned cvt_pk_bf16(float lo, float hi) { unsigned r; asm volatile("v_cvt_pk_bf16_f32 %0, %1, %2" : "=v"(r) : "v"(lo), "v"(hi)); return r; }

__device__ __forceinline__ void store16_wt(void* p, u32x4 v) { asm volatile("global_store_dwordx4 %0, %1, off sc1\n\ts_nop 1" :: "v"(p), "v"(v) : "memory"); }
template <int ACT, class DstFn, bool RS = false> struct EpiBf16 {
    static constexpr bool PERM = true;
    DstFn F; const float* rs;
    __device__ __forceinline__ void operator()(const f32x4 (&acc)[2][2][4][2], const Unit& u, int wr, int wc, int fr, int fq) const {
        bf16_t* base; int ldc; F(u, base, ldc);
        const int row0 = wr * 64 + fr, col0 = wc * 32 + 8 * fq;
        float rsc[2][4];
        if (RS) {
#pragma unroll
            for (int ai = 0; ai < 2; ++ai)
#pragma unroll
                for (int m = 0; m < 4; ++m) rsc[ai][m] = rs[u.pm * BM + row0 + ai * HALF + m * 16]; }
        if (RS && ACT == 1) {
            f32x4 t[2][2][4][2];
#pragma unroll
            for (int ai = 0; ai < 2; ++ai)
#pragma unroll
                for (int bj = 0; bj < 2; ++bj)
#pragma unroll
                    for (int m = 0; m < 4; ++m)
#pragma unroll
                        for (int n = 0; n < 2; ++n)
#pragma unroll
                            for (int e = 0; e < 4; ++e) { const float a = fmaxf(acc[ai][bj][m][n][e], 0.f); t[ai][bj][m][n][e] = a * a; }
#pragma unroll
            for (int ai = 0; ai < 2; ++ai)
#pragma unroll
                for (int m = 0; m < 4; ++m) { bf16_t* rowp = base + (size_t)(row0 + ai * HALF + m * 16) * ldc + col0; const float r2 = rsc[ai][m] * rsc[ai][m];
#pragma unroll
                    for (int bj = 0; bj < 2; ++bj) { const f32x4 v0 = t[ai][bj][m][0] * r2, v1 = t[ai][bj][m][1] * r2;
                        u32x4 w; w.x = cvt_pk_bf16(v0[0], v0[1]); w.y = cvt_pk_bf16(v0[2], v0[3]); w.z = cvt_pk_bf16(v1[0], v1[1]); w.w = cvt_pk_bf16(v1[2], v1[3]);
                        store16_wt(rowp + bj * HALF, w); } }
            return;
        }
#pragma unroll
        for (int ai = 0; ai < 2; ++ai)
#pragma unroll
            for (int m = 0; m < 4; ++m) { bf16_t* rowp = base + (size_t)(row0 + ai * HALF + m * 16) * ldc + col0;
#pragma unroll
                for (int bj = 0; bj < 2; ++bj) { f32x4 v0 = acc[ai][bj][m][0], v1 = acc[ai][bj][m][1];
                    if (RS) { v0 = v0 * rsc[ai][m]; v1 = v1 * rsc[ai][m]; }
                    if (ACT == 1) {
#pragma unroll
                        for (int e = 0; e < 4; ++e) { const float a = fmaxf(v0[e], 0.f), b = fmaxf(v1[e], 0.f); v0[e] = a * a; v1[e] = b * b; } }
                    u32x4 w; w.x = cvt_pk_bf16(v0[0], v0[1]); w.y = cvt_pk_bf16(v0[2], v0[3]); w.z = cvt_pk_bf16(v1[0], v1[1]); w.w = cvt_pk_bf16(v1[2], v1[3]);
                    store16_wt(rowp + bj * HALF, w); } }
    }
};

template <class Epi, class Prob, bool ALIGN_EPI, bool SP2>
__device__ __forceinline__ void gemm_phase(LAS unsigned char* lds, const Prob& P, const StaticOrder& S, const Epi& E) {
    int tid = threadIdx.x; asm volatile("" : "+v"(tid));
    const int wid = __builtin_amdgcn_readfirstlane(tid >> 6), lane = tid & 63, wr = wid >> 2, wc = wid & 3, fr = lane & 15, fq = lane >> 4;
    const int K = P.K, nt = K / BK;
    unsigned voffA[2], voffB[2];
#pragma unroll
    for (int i = 0; i < 2; ++i) { int R, C; stage_rc(tid * 16 + i * 8192, R, C); const int Rb = Epi::PERM ? ((R & ~31) + perm32(R & 31)) : R;
        voffA[i] = (unsigned)(R * K + C) * 2u; voffB[i] = (unsigned)(Rb * K + C) * 2u; }
    const size_t kstep = (size_t)(BK * 2);
    const size_t hstep = (size_t)HALF * K * 2;
    const unsigned ldsw = (unsigned)wid * 1024u;
    const int aoff = lds_byte(wr * 64 + fr, fq * 8), boff = lds_byte(wc * 32 + fr, fq * 8);
#define PG8_SA(b, h) (((b) * 2 + (h)) * HTB)
#define PG8_SB(b, h) ((4 + (b) * 2 + (h)) * HTB)
#define PG8_STAGE(bufoff, gbase, voff) do { _Pragma("unroll") for (int _i = 0; _i < 2; ++_i) \
        __builtin_amdgcn_global_load_lds((const unsigned*)((const char*)(gbase) + (voff)[_i]), (LAS unsigned*)(lds + (bufoff) + ldsw + _i * 8192), 16, 0, 0); } while (0)
#define PG8_LDA(dst, b, h) do { _Pragma("unroll") for (int m = 0; m < 4; ++m) _Pragma("unroll") for (int k = 0; k < 2; ++k) dst[m][k] = *(const LAS bf16x8*)(lds + PG8_SA(b, h) + aoff + m * 2048 + k * 1024); } while (0)
#define PG8_LDB(dst, b, h) do { _Pragma("unroll") for (int n = 0; n < 2; ++n) _Pragma("unroll") for (int k = 0; k < 2; ++k) dst[n][k] = *(const LAS bf16x8*)(lds + PG8_SB(b, h) + boff + n * 2048 + k * 1024); } while (0)
#define PG8_MMA(ai, bj, At, Bt) do { __builtin_amdgcn_s_setprio(1); _Pragma("unroll") for (int m = 0; m < 4; ++m) _Pragma("unroll") for (int n = 0; n < 2; ++n) _Pragma("unroll") for (int k = 0; k < 2; ++k) \
        acc[ai][bj][m][n] = __builtin_amdgcn_mfma_f32_16x16x32_bf16(Bt[n][k], At[m][k], acc[ai][bj][m][n], 0, 0, 0); __builtin_amdgcn_s_setprio(0); } while (0)
#define PG8_WAIT_V(n) asm volatile("s_waitcnt vmcnt(" #n ")" ::: "memory")
#define PG8_WAIT_L(n) asm volatile("s_waitcnt lgkmcnt(" #n ")" ::: "memory")
#define PG8_BAR __builtin_amdgcn_s_barrier()
#define PG8_SCHED __builtin_amdgcn_sched_barrier(0)
    Unit cur, nxt; int ui = 0;
    if (!S.next(0, cur)) return;
    f32x4 acc[2][2][4][2];
#pragma unroll
    for (int a = 0; a < 2; ++a)
#pragma unroll
        for (int b = 0; b < 2; ++b)
#pragma unroll
            for (int m = 0; m < 4; ++m)
#pragma unroll
                for (int n = 0; n < 2; ++n) acc[a][b][m][n] = (f32x4){0.f, 0.f, 0.f, 0.f};
    bf16x8 At[4][2], B0[2][2], B1[2][2];
    const char* cA = P.a_tile(cur); const char* cB = P.b_tile(cur);
    if constexpr (SP2) {
        PG8_STAGE(PG8_SB(0, 0), cB, voffB); PG8_STAGE(PG8_SB(0, 1), cB + hstep, voffB); PG8_STAGE(PG8_SA(0, 0), cA, voffA); PG8_STAGE(PG8_SA(0, 1), cA + hstep, voffA);
        if (wr == 1) PG8_BAR;
        PG8_WAIT_V(2); PG8_BAR;
        PG8_STAGE(PG8_SB(1, 0), cB + kstep, voffB); PG8_STAGE(PG8_SA(1, 0), cA + kstep, voffA); PG8_STAGE(PG8_SB(1, 1), cB + hstep + kstep, voffB);
        PG8_WAIT_V(6); PG8_BAR;
    } else {
        PG8_STAGE(PG8_SB(0, 0), cB, voffB); PG8_STAGE(PG8_SA(0, 0), cA, voffA); PG8_STAGE(PG8_SB(0, 1), cB + hstep, voffB); PG8_STAGE(PG8_SA(0, 1), cA + hstep, voffA);
        if (wr == 1) PG8_BAR;
        PG8_WAIT_V(4); PG8_BAR;
        PG8_STAGE(PG8_SB(1, 0), cB + kstep, voffB); PG8_STAGE(PG8_SA(1, 0), cA + kstep, voffA); PG8_STAGE(PG8_SB(1, 1), cB + hstep + kstep, voffB);
        PG8_WAIT_V(6); PG8_BAR;
    }
    for (;;) {
        const bool has_next = S.next(ui + 1, nxt);
        const char* nA = has_next ? P.a_tile(nxt) : cA; const char* nB = has_next ? P.b_tile(nxt) : cB;
        for (int t = 0; t < nt; t += 2) {
            const bool last = (t == nt - 2);
            const char* a1 = cA + (size_t)(t + 1) * kstep;
            const char* a2 = last ? nA : cA + (size_t)(t + 2) * kstep; const char* b2 = last ? nB : cB + (size_t)(t + 2) * kstep;
            const char* a3 = a2 + kstep; const char* b3 = b2 + kstep;
            if constexpr (SP2) {
            PG8_LDB(B0, 0, 0); PG8_LDB(B1, 0, 1); PG8_SCHED; PG8_LDA(At, 0, 0); PG8_STAGE(PG8_SA(1, 1), a1 + hstep, voffA);
            PG8_WAIT_V(8); PG8_WAIT_L(0); PG8_BAR; PG8_MMA(0, 0, At, B0); PG8_MMA(0, 1, At, B1); PG8_BAR; PG8_SCHED;
            PG8_LDA(At, 0, 1); PG8_STAGE(PG8_SB(0, 0), b2, voffB); PG8_STAGE(PG8_SB(0, 1), b2 + hstep, voffB); PG8_STAGE(PG8_SA(0, 0), a2, voffA);
            PG8_WAIT_V(8); PG8_WAIT_L(0); PG8_BAR; PG8_MMA(1, 0, At, B0); PG8_MMA(1, 1, At, B1); PG8_BAR; PG8_SCHED;
            PG8_LDB(B0, 1, 0); PG8_LDB(B1, 1, 1); PG8_SCHED; PG8_LDA(At, 1, 0); PG8_STAGE(PG8_SA(0, 1), a2 + hstep, voffA);
            PG8_WAIT_V(8); PG8_WAIT_L(0); PG8_BAR; PG8_MMA(0, 0, At, B0); PG8_MMA(0, 1, At, B1); PG8_BAR; PG8_SCHED;
            PG8_LDA(At, 1, 1); PG8_STAGE(PG8_SB(1, 0), b3, voffB); PG8_STAGE(PG8_SB(1, 1), b3 + hstep, voffB); PG8_STAGE(PG8_SA(1, 0), a3, voffA);
            PG8_WAIT_V(8); PG8_WAIT_L(0); PG8_BAR; PG8_MMA(1, 0, At, B0); PG8_MMA(1, 1, At, B1); PG8_BAR; PG8_SCHED;
            } else {
            PG8_LDB(B0, 0, 0); PG8_SCHED; PG8_LDA(At, 0, 0); PG8_STAGE(PG8_SA(1, 1), a1 + hstep, voffA);
            PG8_WAIT_L(8); PG8_BAR; PG8_WAIT_L(0); PG8_MMA(0, 0, At, B0); PG8_BAR; PG8_SCHED;
            PG8_LDB(B1, 0, 1); PG8_STAGE(PG8_SB(0, 0), b2, voffB);
            PG8_BAR; PG8_WAIT_L(0); PG8_MMA(0, 1, At, B1); PG8_BAR;
            PG8_LDA(At, 0, 1); PG8_STAGE(PG8_SA(0, 0), a2, voffA);
            PG8_BAR; PG8_WAIT_L(0); PG8_MMA(1, 0, At, B0); PG8_BAR; PG8_SCHED;
            PG8_STAGE(PG8_SB(0, 1), b2 + hstep, voffB);
            PG8_WAIT_V(6); PG8_BAR; PG8_MMA(1, 1, At, B1); PG8_BAR;
            PG8_LDB(B0, 1, 0); PG8_SCHED; PG8_LDA(At, 1, 0); PG8_STAGE(PG8_SA(0, 1), a2 + hstep, voffA);
            PG8_WAIT_L(8); PG8_BAR; PG8_WAIT_L(0); PG8_MMA(0, 0, At, B0); PG8_BAR; PG8_SCHED;
            PG8_LDB(B1, 1, 1); PG8_STAGE(PG8_SB(1, 0), b3, voffB);
            PG8_BAR; PG8_WAIT_L(0); PG8_MMA(0, 1, At, B1); PG8_BAR;
            PG8_LDA(At, 1, 1); PG8_STAGE(PG8_SA(1, 0), a3, voffA);
            PG8_BAR; PG8_WAIT_L(0); PG8_MMA(1, 0, At, B0); PG8_BAR; PG8_SCHED;
            PG8_STAGE(PG8_SB(1, 1), b3 + hstep, voffB);
            PG8_WAIT_V(6); PG8_BAR; PG8_MMA(1, 1, At, B1); PG8_BAR;
            }
        }
        if constexpr (ALIGN_EPI) { if (wr == 0) PG8_BAR; }
        E(acc, cur, wr, wc, fr, fq);
        if (!has_next) break;
#pragma unroll
        for (int a = 0; a < 2; ++a)
#pragma unroll
            for (int b = 0; b < 2; ++b)
#pragma unroll
                for (int m = 0; m < 4; ++m)
#pragma unroll
                    for (int n = 0; n < 2; ++n) acc[a][b][m][n] = (f32x4){0.f, 0.f, 0.f, 0.f};
        cur = nxt; cA = nA; cB = nB; ++ui;
        if constexpr (ALIGN_EPI) { if (wr == 1) PG8_BAR; }
    }
    PG8_WAIT_V(0);
    if constexpr (!ALIGN_EPI) { if (wr == 0) PG8_BAR; }
    PG8_BAR;
#undef PG8_SA
#undef PG8_SB
#undef PG8_STAGE
#undef PG8_LDA
#undef PG8_LDB
#undef PG8_MMA
#undef PG8_WAIT_V
#undef PG8_WAIT_L
#undef PG8_BAR
#undef PG8_SCHED
}
}

constexpr size_t MiB = 1u << 20;
constexpr size_t WS_CTL = 0, CTL_ZERO_BYTES = 64 * 1024;
constexpr size_t WS_W = 1 * MiB;
constexpr size_t WS_WIN_T = WS_W, WS_WOUT_T = WS_WIN_T + (size_t)DIN * D * 2, WS_W1_T = WS_WOUT_T + (size_t)D * D * 2, WS_W2_T = WS_W1_T + (size_t)DFF * D * 2;
constexpr size_t WS_WR_T = WS_W, WS_WK_T = WS_WR_T + 2 * MiB, WS_LDW_T = WS_WK_T + 2 * MiB, WS_WV_T = WS_LDW_T + 3 * MiB, WS_WO2_T = WS_WV_T + 2 * MiB, WS_W1B_T = WS_WO2_T + 4 * MiB, WS_W2B_T = WS_W1B_T + 8 * MiB;
static_assert(WS_W2_T + (size_t)D * DFF * 2 <= 31 * MiB && WS_W2B_T + (size_t)D * DFF * 2 <= 31 * MiB, "weight region");
constexpr size_t WS_XN = 31 * MiB, WS_QKV = 63 * MiB, WS_O = 135 * MiB, WS_OBR = 167 * MiB, WS_LSE = 215 * MiB, WS_TMP = 217 * MiB, WS_H = 63 * MiB;
constexpr size_t WS_MIXA = 63 * MiB, WS_MIXB = 95 * MiB, WS_R = 127 * MiB, WS_K = 159 * MiB, WS_V = 31 * MiB, WS_LDO = 191 * MiB, WS_Y = 63 * MiB, WS_LDA = 239 * MiB;
constexpr size_t WS_YSUM = 127 * MiB;
constexpr size_t WS_HBC = 191 * MiB, WS_TMP2 = 223 * MiB;
constexpr size_t WS_END = 256 * MiB;
static_assert(WS_HBC >= WS_H + (size_t)M * DFF * 2 && WS_HBC + (size_t)M * D * 2 <= WS_TMP2 && WS_TMP2 + (size_t)M * D * 2 <= WS_END, "layer-1 tail");
static_assert(WS_LDO + (size_t)M * NLD * 2 <= WS_LDA && WS_LDA + (size_t)M * 512 * 2 <= WS_END && WS_TMP + (size_t)M * D * 2 <= WS_END, "tail of the map");
static_assert(WS_MIXA == WS_XN + 32 * MiB && WS_MIXB == WS_XN + 64 * MiB && WS_K == WS_R + 32 * MiB && WS_LDO == WS_R + 64 * MiB && WS_WK_T == WS_WR_T + 2 * MiB && WS_LDW_T == WS_WR_T + 4 * MiB, "grouped GEMM strides");
constexpr int CW_BAR = 4096;

constexpr int RING_BYTES = 131072, LDSCTL_OFF = 143360, MISC_OFF = LDSCTL_OFF + 320, LDS_BYTES = 147456;

typedef __bf16 bf16x2_t __attribute__((ext_vector_type(2)));
__device__ __forceinline__ unsigned cvtpk(float lo, float hi) { const f32x2 v = {lo, hi}; const bf16x2_t b = __builtin_convertvector(v, bf16x2_t); return __builtin_bit_cast(unsigned, b); }
__device__ __forceinline__ float bf2f(unsigned short b) { return __uint_as_float((unsigned)b << 16); }
__device__ __forceinline__ float bflo(unsigned w) { return __uint_as_float(w << 16); }
__device__ __forceinline__ float bfhi(unsigned w) { return __uint_as_float(w & 0xffff0000u); }
__device__ __forceinline__ unsigned f2bf(float f) { unsigned u = __float_as_uint(f); return (u + 0x7fffu + ((u >> 16) & 1u)) >> 16; }
__device__ __forceinline__ unsigned pk2(float lo, float hi) { return f2bf(lo) | (f2bf(hi) << 16); }
__device__ __forceinline__ float wave_sum(float v) {
#pragma unroll
    for (int o = 1; o < 64; o <<= 1) v += __shfl_xor(v, o);
    return v;
}
__device__ __forceinline__ float sigmoidf_(float z) { return 1.f / (1.f + __expf(-z)); }
__device__ __forceinline__ int t5_bucket(int rel) {
    const int n = rel < 0 ? -rel : rel;
    int large;
    if (n < 8) large = n; else if (n < 15) large = 8; else if (n < 27) large = 9; else if (n < 50) large = 10; else if (n < 91) large = 11;
    else if (n < 166) large = 12; else if (n < 305) large = 13; else if (n < 559) large = 14; else large = 15;
    return (rel > 0 ? 16 : 0) + large;
}

#define XB_TMO      128
#define XB_XCNT(j)  (256  + 64 * (j))
#define XB_XSUB(j)  (1280 + 64 * (j))
#define XB_XGEN(j)  (2304 + 64 * (j))
#define XB_TOP      3328
#define XB_TOPGEN   3392
#define XCD_BAR_WORDS 3456
#define XB_SPIN_CAP (1u << 18)
__device__ __forceinline__ unsigned xb_ld(unsigned* p)              { return __hip_atomic_load(p, __ATOMIC_RELAXED, __HIP_MEMORY_SCOPE_AGENT); }
__device__ __forceinline__ unsigned xb_add(unsigned* p, unsigned v) { return __hip_atomic_fetch_add(p, v, __ATOMIC_RELAXED, __HIP_MEMORY_SCOPE_AGENT); }
__device__ __forceinline__ unsigned xb_xcc_id() { return (unsigned)__builtin_amdgcn_s_getreg((3 << 11) | 20) & 0xFu; }
#define XB_SPIN(cond, bar) do { unsigned _sp = 0; while (cond) { __builtin_amdgcn_s_sleep(1); \
    if ((++_sp & 255u) == 0u) { if (xb_ld(&(bar)[XB_TMO])) break; if (_sp > XB_SPIN_CAP) { atomicAdd(&(bar)[XB_TMO], 1u); break; } } } } while (0)
struct XcdBarrier { unsigned* bar; unsigned x; volatile LAS unsigned* st; };
__device__ __forceinline__ XcdBarrier xcd_barrier_post(unsigned* bar, volatile LAS unsigned* st) {
    XcdBarrier b; b.bar = bar; b.x = xb_xcc_id(); b.st = st;
    if (threadIdx.x == 0) (void)xb_add(&bar[XB_XCNT(b.x)], 1u);
    return b;
}
__device__ __forceinline__ void xcd_barrier_complete(unsigned* bar, unsigned x, unsigned& nloc, unsigned& nx) {
    const unsigned G = gridDim.x * gridDim.y * gridDim.z;
    unsigned sum, cnt, mine, sp = 0u;
    for (;;) {
        sum = 0u; cnt = 0u; mine = 0u;
#pragma unroll
        for (unsigned j = 0; j < 16; ++j) { const unsigned c = xb_ld(&bar[XB_XCNT(j)]); sum += c; cnt += (c > 0u) ? 1u : 0u; mine = (j == x) ? c : mine; }
        if (sum == G) break;
        __builtin_amdgcn_s_sleep(1);
        if ((++sp & 255u) == 0u) { if (xb_ld(&bar[XB_TMO])) break; if (sp > XB_SPIN_CAP) { atomicAdd(&bar[XB_TMO], 1u); break; } }
    }
    nloc = mine > 0u ? mine : 1u; nx = cnt > 0u ? cnt : 1u;
}
__device__ __forceinline__ void xcd_barrier(const XcdBarrier& b) {
    asm volatile("s_waitcnt vmcnt(0)" ::: "memory");
    __syncthreads();
    if (threadIdx.x == 0) {
        unsigned* bar = b.bar;
        __builtin_amdgcn_s_waitcnt(0);
        unsigned nloc = b.st[0], nx = b.st[1];
        if (nloc == 0u) { xcd_barrier_complete(bar, b.x, nloc, nx); b.st[0] = nloc; b.st[1] = nx; }
        const unsigned old = xb_add(&bar[XB_XSUB(b.x)], 1u);
        const unsigned gen = old / nloc;
        if (old + 1u == (gen + 1u) * nloc) {
            __builtin_amdgcn_fence(__ATOMIC_RELEASE, "agent");
            asm volatile("s_waitcnt vmcnt(0)" ::: "memory");
            const unsigned og = xb_add(&bar[XB_TOP], 1u);
            const unsigned tg = og / nx;
            if (og + 1u == (tg + 1u) * nx) xb_add(&bar[XB_TOPGEN], 1u);
            else XB_SPIN(xb_ld(&bar[XB_TOPGEN]) == tg, bar);
            __builtin_amdgcn_fence(__ATOMIC_ACQUIRE, "agent");
            xb_add(&bar[XB_XGEN(b.x)], 1u);
            asm volatile("s_waitcnt vmcnt(0)" ::: "memory");
        } else {
            XB_SPIN(xb_ld(&bar[XB_XGEN(b.x)]) == gen, bar);
            __builtin_amdgcn_fence(__ATOMIC_ACQUIRE, "agent");
            asm volatile("s_waitcnt vmcnt(0)" ::: "memory");
        }
    }
    __syncthreads();
}

#define XB_GRP(g)   (4096 + 16 * (g))
__device__ __forceinline__ void grp_barrier(unsigned* bar, unsigned g, unsigned& epoch) {
    asm volatile("s_waitcnt vmcnt(0)" ::: "memory");
    __syncthreads();
    ++epoch;
    if (threadIdx.x == 0) {
        unsigned* word = &bar[XB_GRP(g)];
        (void)xb_add(word, 1u);
        const unsigned tgt = 4u * epoch;
        XB_SPIN(xb_ld(word) < tgt, bar);
        __builtin_amdgcn_fence(__ATOMIC_ACQUIRE, "agent");
        asm volatile("s_waitcnt vmcnt(0)" ::: "memory");
    }
    __syncthreads();
}

struct Row16 { f32x4 v[4]; };
__device__ __forceinline__ int row_q(int lane, int j) { return 2 * lane + 128 * (j >> 1) + (j & 1); }
__device__ __forceinline__ void row_load_f32(Row16& r, const float* p, int lane) {
#pragma unroll
    for (int j = 0; j < 4; ++j) r.v[j] = ((const f32x4*)p)[row_q(lane, j)];
}
struct RowRaw { u32x4 w[2]; };
__device__ __forceinline__ void row_raw_load(RowRaw& r, const bf16_t* p, int lane) { r.w[0] = ((const u32x4*)p)[lane]; r.w[1] = ((const u32x4*)p)[lane + 64]; }
__device__ __forceinline__ void row_from_raw(Row16& r, const RowRaw& q) {
#pragma unroll
    for (int b = 0; b < 2; ++b) { const u32x4 w = q.w[b]; r.v[2 * b] = (f32x4){bflo(w.x), bfhi(w.x), bflo(w.y), bfhi(w.y)}; r.v[2 * b + 1] = (f32x4){bflo(w.z), bfhi(w.z), bflo(w.w), bfhi(w.w)}; }
}
__device__ __forceinline__ void row_load_bf16(Row16& r, const bf16_t* p, int lane) { RowRaw q; row_raw_load(q, p, lane); row_from_raw(r, q); }
__device__ __forceinline__ void row_store_f32(const Row16& r, float* p, int lane) {
#pragma unroll
    for (int j = 0; j < 4; ++j) pg8::store16_wt((f32x4*)p + row_q(lane, j), __builtin_bit_cast(u32x4, r.v[j]));
}
__device__ __forceinline__ void row_store_bf16(const Row16& r, bf16_t* p, int lane) {
#pragma unroll
    for (int b = 0; b < 2; ++b) { u32x4 w; w.x = cvtpk(r.v[2 * b][0], r.v[2 * b][1]); w.y = cvtpk(r.v[2 * b][2], r.v[2 * b][3]); w.z = cvtpk(r.v[2 * b + 1][0], r.v[2 * b + 1][1]); w.w = cvtpk(r.v[2 * b + 1][2], r.v[2 * b + 1][3]);
        pg8::store16_wt((u32x4*)p + lane + 64 * b, w); }
}
__device__ __forceinline__ void vec_load(Row16& r, const float* g, int lane) { row_load_f32(r, g, lane); }
__device__ __forceinline__ void row_rmsnorm_v(Row16& r, const Row16& g) {
    float s = 0.f;
#pragma unroll
    for (int j = 0; j < 4; ++j) s += r.v[j][0] * r.v[j][0] + r.v[j][1] * r.v[j][1] + r.v[j][2] * r.v[j][2] + r.v[j][3] * r.v[j][3];
    const float rs = rsqrtf(wave_sum(s) * (1.f / D) + NORM_EPS);
#pragma unroll
    for (int j = 0; j < 4; ++j) r.v[j] = r.v[j] * rs * g.v[j];
}
__device__ __forceinline__ void row_rmsnorm(Row16& r, const float* g, int lane) { Row16 gg; vec_load(gg, g, lane); row_rmsnorm_v(r, gg); }

constexpr int TR_SCR_BYTES = 64 * 65 * 4;
template <class ScaleFn>
__device__ __forceinline__ void transpose_item(const float* W, int ldw, int N, bf16_t* WT, int ldt, int row_off, int koff, LAS float* scr, int item, int lane, ScaleFn sc) {
    const int nblk = N / 64, kb = item / nblk, nb = item % nblk, k0 = 64 * kb, n0 = 64 * nb;
    const int lk = lane >> 4, ln4 = (lane & 15) * 4;
    f32x4 v[16];
#pragma unroll
    for (int i = 0; i < 16; ++i) v[i] = *(const f32x4*)(W + (size_t)(k0 + 4 * i + lk) * ldw + n0 + ln4);
#pragma unroll
    for (int i = 0; i < 16; ++i) { const int kk = 4 * i + lk; const float s = sc(k0 + kk); LAS float* d = scr + kk * 65 + ln4; d[0] = v[i][0] * s; d[1] = v[i][1] * s; d[2] = v[i][2] * s; d[3] = v[i][3] * s; }
    asm volatile("s_waitcnt lgkmcnt(0)" ::: "memory");
    const int c = lane >> 3, nn = lane & 7;
#pragma unroll
    for (int j = 0; j < 8; ++j) { const int n = nn + 8 * j; const LAS float* s = scr + (8 * c) * 65 + n;
        u32x4 o; o.x = cvtpk(s[0 * 65], s[1 * 65]); o.y = cvtpk(s[2 * 65], s[3 * 65]); o.z = cvtpk(s[4 * 65], s[5 * 65]); o.w = cvtpk(s[6 * 65], s[7 * 65]);
        pg8::store16_wt(WT + (size_t)(row_off + n0 + n) * ldt + koff + k0 + 8 * c, o); }
    asm volatile("s_waitcnt lgkmcnt(0)" ::: "memory");
}
struct ScaleOne { __device__ __forceinline__ float operator()(int) const { return 1.f; } };
struct ScaleVec { const float* g; __device__ __forceinline__ float operator()(int k) const { return g[k]; } };
struct ScaleMix { const float* mp; const float* mn; int part;
    __device__ __forceinline__ float operator()(int k) const { return part == 0 ? 1.f - mp[k] - mn[k] : (part == 1 ? mp[k] : mn[k]); } };

struct Args { const float* in[27]; float* out; unsigned char* ws; };

struct ProbPlain { const bf16_t* A; const bf16_t* Bt; int K;
    __device__ __forceinline__ const char* a_tile(const pg8::Unit& u) const { return (const char*)(A + (size_t)u.pm * 256 * K); }
    __device__ __forceinline__ const char* b_tile(const pg8::Unit& u) const { return (const char*)(Bt + (size_t)u.pn * 256 * K); } };
struct DstPlain { bf16_t* C; int ldc;
    __device__ __forceinline__ void operator()(const pg8::Unit& u, bf16_t*& base, int& ld) const { base = C + (size_t)u.pm * 256 * ldc + (size_t)u.pn * 256; ld = ldc; } };
struct ProbRKL { const unsigned char* ws; int K;
    __device__ __forceinline__ const char* a_tile(const pg8::Unit& u) const { const int g = u.pn < 4 ? 0 : (u.pn < 8 ? 1 : 2); const int ga = g == 2 ? 0 : g + 1;
        return (const char*)(ws + WS_XN + (size_t)ga * (32 * MiB) + (size_t)u.pm * 256 * D * 2); }
    __device__ __forceinline__ const char* b_tile(const pg8::Unit& u) const { const int g = u.pn < 4 ? 0 : (u.pn < 8 ? 1 : 2); const int t = u.pn - 4 * g;
        return (const char*)(ws + WS_WR_T + (size_t)g * (2 * MiB) + (size_t)t * 256 * D * 2); } };
struct DstRKL { unsigned char* ws;
    __device__ __forceinline__ void operator()(const pg8::Unit& u, bf16_t*& base, int& ld) const {
        const int g = u.pn < 4 ? 0 : (u.pn < 8 ? 1 : 2); const int t = u.pn - 4 * g; ld = g == 2 ? NLD : D;
        base = (bf16_t*)(ws + WS_R + (size_t)g * (32 * MiB)) + (size_t)u.pm * 256 * ld + (size_t)t * 256; } };


struct EpiHeadMajor {
    static constexpr bool PERM = true;
    bf16_t* O;
    __device__ __forceinline__ void operator()(const f32x4 (&acc)[2][2][4][2], const pg8::Unit& u, int wr, int wc, int fr, int fq) const {
        const int row0 = u.pm * 256 + wr * 64 + fr, col = (wc & 1) * 32 + 8 * fq;
#pragma unroll
        for (int bj = 0; bj < 2; ++bj) { bf16_t* hb = O + ((size_t)(u.pn * 4 + bj * 2 + (wc >> 1)) * M + row0) * 64 + col;
#pragma unroll
            for (int ai = 0; ai < 2; ++ai)
#pragma unroll
                for (int m = 0; m < 4; ++m) { const f32x4 v0 = acc[ai][bj][m][0], v1 = acc[ai][bj][m][1];
                    u32x4 w; w.x = cvtpk(v0[0], v0[1]); w.y = cvtpk(v0[2], v0[3]); w.z = cvtpk(v1[0], v1[1]); w.w = cvtpk(v1[2], v1[3]);
                    pg8::store16_wt(hb + (size_t)(ai * 128 + m * 16) * 64, w); } }
    }
};

template <int ACT, class Prob, class Dst>
__device__ __forceinline__ void run_gemm(LAS unsigned char* lds, const Prob& P, const Dst& Dd, int Mr, int Nv, int G) {
    pg8::StaticOrder S; S.init(Mr, Nv, G, (int)blockIdx.x);
    pg8::EpiBf16<ACT, Dst> E{Dd, nullptr};
    for (int rep = 0; rep < REP_GEMM; ++rep) pg8::gemm_phase<pg8::EpiBf16<ACT, Dst>, Prob, true, true>(lds, P, S, E);
}
template <int ACT, class Prob, class Dst>
__device__ __forceinline__ void run_gemm_rs(LAS unsigned char* lds, const Prob& P, const Dst& Dd, const float* rs, int Mr, int Nv, int G) {
    pg8::StaticOrder S; S.init(Mr, Nv, G, (int)blockIdx.x);
    pg8::EpiBf16<ACT, Dst, true> E{Dd, rs};
    pg8::gemm_phase<pg8::EpiBf16<ACT, Dst, true>, Prob, true, true>(lds, P, S, E);
}

template <bool BASE_F32, bool OUT_F32>
__device__ __forceinline__ void phase_resnorm(const void* base, const bf16_t* TMP, const float* g1, const float* g2, void* hout, bf16_t* XN, float* rs_out, int gw, int NGW, int lane) {
    Row16 G1, G2; vec_load(G1, g1, lane); if (XN) vec_load(G2, g2, lane);
    for (int row = gw; row < M; row += NGW) {
        Row16 t, b; row_load_bf16(t, TMP + (size_t)row * D, lane);
        if (BASE_F32) row_load_f32(b, (const float*)base + (size_t)row * D, lane); else row_load_bf16(b, (const bf16_t*)base + (size_t)row * D, lane);
        row_rmsnorm_v(t, G1);
#pragma unroll
        for (int j = 0; j < 4; ++j) b.v[j] = b.v[j] + t.v[j];
        if (OUT_F32) row_store_f32(b, (float*)hout + (size_t)row * D, lane); else row_store_bf16(b, (bf16_t*)hout + (size_t)row * D, lane);
        if (XN) { row_rmsnorm_v(b, G2); row_store_bf16(b, XN + (size_t)row * D, lane); }
        if (rs_out) {
            float s = 0.f;
#pragma unroll
            for (int j = 0; j < 4; ++j) s += b.v[j][0] * b.v[j][0] + b.v[j][1] * b.v[j][1] + b.v[j][2] * b.v[j][2] + b.v[j][3] * b.v[j][3];
            const float rsv = rsqrtf(wave_sum(s) * (1.f / D) + NORM_EPS);
            if (lane == 0) rs_out[row] = rsv; }
    }
}
__device__ __forceinline__ void phase_lda(const bf16_t* LDO, bf16_t* LDA, int gw, int NGW, int lane) {
    const float A = lane < 16 ? 2.f : 1.f, C = lane < 16 ? -1.f : 0.f; const bool id = lane >= 16 && lane < 32;
    for (int row = gw; row < M; row += NGW) { const int tt = row & (SEQ - 1);
        const u32x4 p0 = *(const u32x4*)(LDO + (size_t)row * NLD + 8 * lane);
        const u32x4 p1 = *(const u32x4*)(LDO + (size_t)(tt > 0 ? row - 1 : row) * NLD + 512 + 8 * lane), p2 = *(const u32x4*)(LDO + (size_t)(tt < SEQ - 1 ? row + 1 : row) * NLD + 1024 + 8 * lane);
        const float mp = tt > 0 ? 1.f : 0.f, mn = tt < SEQ - 1 ? 1.f : 0.f;
        u32x4 o;
#pragma unroll
        for (int w = 0; w < 4; ++w) { const float x0 = bflo(p0[w]) + mp * bflo(p1[w]) + mn * bflo(p2[w]), x1 = bfhi(p0[w]) + mp * bfhi(p1[w]) + mn * bfhi(p2[w]);
            const float y0 = A * __builtin_amdgcn_rcpf(1.f + __builtin_amdgcn_exp2f(-1.4426950408889634f * A * x0)) + C, y1 = A * __builtin_amdgcn_rcpf(1.f + __builtin_amdgcn_exp2f(-1.4426950408889634f * A * x1)) + C;
            o[w] = cvtpk(id ? x0 : y0, id ? x1 : y1); }
        pg8::store16_wt(LDA + (size_t)row * 512 + 8 * lane, o); }
}
__device__ __forceinline__ void mix_out(const Row16& up, const Row16& u, const Row16& un, const LAS f32x4* a, const LAS f32x4* b, bf16_t* dst, int lane) {
    Row16 o;
#pragma unroll
    for (int j = 0; j < 4; ++j) { const f32x4 av = a[j * 64 + lane], bv = b[j * 64 + lane]; o.v[j] = u.v[j] + (up.v[j] - u.v[j]) * av + (un.v[j] - u.v[j]) * bv; }
    row_store_bf16(o, dst, lane);
}
__device__ __forceinline__ void phase_mix3(LAS unsigned char* lds, const bf16_t* h, const float* g, const float* mup, const float* mun, bf16_t* XN, bf16_t* MR, bf16_t* MK, bf16_t* MV, int gw, int NGW, int tid, int lane) {
    LAS f32x4* mv = (LAS f32x4*)lds;
    __syncthreads();
    for (int x = tid; x < 6 * 256; x += NTHREADS) { const int vec = x >> 8, q = x & 255, c = vec < 2 ? 0 : (vec < 4 ? 2 : 3);
        const f32x4 val = ((const f32x4*)(((vec & 1) ? mun : mup) + c * D))[q];
        mv[vec * 256 + (2 * (q >> 7) + (q & 1)) * 64 + ((q & 127) >> 1)] = val; }
    __syncthreads();
    Row16 Gn; vec_load(Gn, g, lane);
    for (int ch = gw; ch < M / 8; ch += NGW) {
        const int r0 = ch * 8, t0 = r0 & (SEQ - 1);
        const bool hasp = t0 > 0, hasn = t0 + 8 < SEQ;
        const int rlast = hasn ? r0 + 8 : r0 + 7;
        RowRaw r0w, rA, rB, rC;
        row_raw_load(r0w, h + (size_t)(hasp ? r0 - 1 : r0) * D, lane);
        row_raw_load(rA, h + (size_t)r0 * D, lane); row_raw_load(rB, h + (size_t)(r0 + 1) * D, lane); row_raw_load(rC, h + (size_t)(r0 + 2) * D, lane);
        Row16 up, u, un;
        row_from_raw(up, r0w); row_rmsnorm_v(up, Gn);
        { const float m = hasp ? 1.f : 0.f;
#pragma unroll
          for (int j = 0; j < 4; ++j) up.v[j] = up.v[j] * m; }
        row_from_raw(u, rA); row_rmsnorm_v(u, Gn);
        rA = rB; rB = rC;
#pragma unroll 1
        for (int k = 1; k <= 8; ++k) {
            const int row = r0 - 1 + k;
            { const int nx = row + 3; row_raw_load(rC, h + (size_t)(nx < rlast ? nx : rlast) * D, lane); }
            row_from_raw(un, rA); row_rmsnorm_v(un, Gn);
            { const float m = (k == 8 && !hasn) ? 0.f : 1.f;
#pragma unroll
              for (int j = 0; j < 4; ++j) un.v[j] = un.v[j] * m; }
            row_store_bf16(u, XN + (size_t)row * D, lane);
            mix_out(up, u, un, mv, mv + 256, MR + (size_t)row * D, lane);
            mix_out(up, u, un, mv + 512, mv + 768, MK + (size_t)row * D, lane);
            mix_out(up, u, un, mv + 1024, mv + 1280, MV + (size_t)row * D, lane);
            up = u; u = un; rA = rB; rB = rC;
        }
    }
}

constexpr int ATT_ROWS = 400, ATT_KS = 0, ATT_VS = ATT_ROWS * 128, ATT_TAB = 2 * ATT_ROWS * 128, ATT_TABN = 320;
constexpr float LOG2E = 1.4426950408889634f;
typedef short v4i16_t __attribute__((ext_vector_type(4)));
__device__ __forceinline__ v4i16_t lds_tr16(LAS const unsigned char* p) { return __builtin_amdgcn_ds_read_tr16_b64_v4i16((LAS v4i16_t*)p); }

__device__ __forceinline__ float rows_max(float x) {
    auto a = __builtin_amdgcn_permlane16_swap(__float_as_uint(x), __float_as_uint(x), false, false); x = fmaxf(__uint_as_float(a[0]), __uint_as_float(a[1]));
    auto b = __builtin_amdgcn_permlane32_swap(__float_as_uint(x), __float_as_uint(x), false, false); return fmaxf(__uint_as_float(b[0]), __uint_as_float(b[1])); }
__device__ __forceinline__ float rows_sum(float x) {
    auto a = __builtin_amdgcn_permlane16_swap(__float_as_uint(x), __float_as_uint(x), false, false); x = __uint_as_float(a[0]) + __uint_as_float(a[1]);
    auto b = __builtin_amdgcn_permlane32_swap(__float_as_uint(x), __float_as_uint(x), false, false); return __uint_as_float(b[0]) + __uint_as_float(b[1]); }
struct AttnIO { const bf16_t* QKV; const float* rel_table; const float* sink; bf16_t* O; bf16_t* OBR; float* LSE; };
struct AttnUnitD { int b, dil, res, l0, nq, L, R, colK, colV, head0, ngroups, nit, branch, isB; };
__device__ __forceinline__ AttnUnitD attn_decode(int u) {
    AttnUnitD A;
    if (u < 256) { A.isB = 1; A.b = u >> 5; const int kvg = (u >> 4) & 1, blk = u & 15; A.dil = 1; A.res = 0; A.l0 = blk * 128; A.nq = 128; A.L = SEQ; A.R = 128; A.colK = 32 + kvg; A.colV = 34 + kvg; A.head0 = kvg * 4; A.ngroups = 32; A.nit = 9; A.branch = 0; }
    else if (u < 1280) { A.isB = 0; const int a = u - 256, bh = a >> 4, k = a & 15; A.b = bh >> 3; A.head0 = bh & 7; A.nq = 256; A.R = 64; A.ngroups = 16; A.nit = 5;
        if (k < 8) { A.dil = 1; A.res = 0; A.l0 = k * 256; A.L = SEQ; A.branch = 0; } else { A.dil = 4; A.res = (k - 8) >> 1; A.l0 = ((k - 8) & 1) * 256; A.L = SEQ / 4; A.branch = 1; }
        A.colK = 8 + A.head0; A.colV = 16 + A.head0; }
    else { A.isB = 0; const int a = u - 1280, bh = a >> 4; A.b = bh >> 3; A.head0 = bh & 7; A.dil = 16; A.res = a & 15; A.l0 = 0; A.nq = 128; A.L = SEQ / 16; A.R = 64; A.ngroups = 8; A.nit = 5; A.branch = 2; A.colK = 8 + A.head0; A.colV = 16 + A.head0; }
    return A;
}
constexpr int ATT_NST = 7;
__device__ __forceinline__ void attn_issue(const AttnUnitD& A, const bf16_t* QKV, int tid, u32x4 (&kr)[ATT_NST], u32x4 (&vr)[ATT_NST]) {
    const int ndata = A.nq + 2 * A.R, rv0 = (A.R - A.l0) > 0 ? (A.R - A.l0) : 0, rv1 = (A.L + A.R - A.l0) < ndata ? (A.L + A.R - A.l0) : ndata;
    const bf16_t* kb = QKV + ((size_t)A.colK * M + (size_t)A.b * SEQ) * 64; const bf16_t* vb = QKV + ((size_t)A.colV * M + (size_t)A.b * SEQ) * 64;
#pragma unroll
    for (int i = 0; i < ATT_NST; ++i) { const int x = tid + NTHREADS * i, c = x & 7; int row = x >> 3; row = row < rv0 ? rv0 : (row >= rv1 ? rv1 - 1 : row);
        const size_t o = (size_t)(A.res + A.dil * (A.l0 - A.R + row)) * 64 + c * 8; kr[i] = *(const u32x4*)(kb + o); vr[i] = *(const u32x4*)(vb + o); }
}

__device__ __forceinline__ void phase_attn(LAS unsigned char* lds, const AttnIO& io, int vcu, int G) {
    int tid = threadIdx.x; asm volatile("" : "+v"(tid));
    const int lane = tid & 63, wid = __builtin_amdgcn_readfirstlane(tid >> 6), g4 = lane >> 4, qi = lane & 15;
    LAS unsigned char* Ks = lds + ATT_KS; LAS unsigned char* Vs = lds + ATT_VS; LAS float* tab = (LAS float*)(lds + ATT_TAB);
    constexpr int NU = 256 + 1024 + 1024;
    u32x4 kr[ATT_NST], vr[ATT_NST];
    if (vcu < NU) { const AttnUnitD A0 = attn_decode(vcu); attn_issue(A0, io.QKV, tid, kr, vr); }
    for (int u = vcu; u < NU; u += G) {
        const AttnUnitD A = attn_decode(u);
        const int b = A.b, dil = A.dil, res = A.res, l0 = A.l0, R = A.R, head0 = A.head0, ngroups = A.ngroups, nit = A.nit, branch = A.branch; const bool isB = A.isB != 0;
        const int ndata = A.nq + 2 * R, rv0 = (R - l0) > 0 ? (R - l0) : 0, rv1 = (A.L + R - l0) < ndata ? (A.L + R - l0) : ndata;
        auto qptr = [&](int gx) -> const bf16_t* { const int hq_ = isB ? (gx >> 3) : 0, gi_ = isB ? (gx & 7) : gx; const int posq_ = res + dil * (l0 + 16 * gi_ + qi);
            return io.QKV + ((size_t)((isB ? 24 : 0) + head0 + hq_) * M + (size_t)b * SEQ + posq_) * 64 + 8 * g4; };
        u32x4 qr0, qr1; { const bf16_t* qp0 = qptr(wid); qr0 = *(const u32x4*)qp0; qr1 = *(const u32x4*)(qp0 + 32); }
        for (int reps = 0; reps < REP_ATTS; ++reps) {
        __syncthreads();
#pragma unroll
        for (int i = 0; i < ATT_NST; ++i) { const int x = tid + NTHREADS * i, row = x >> 3, c = x & 7;
            if (x < ATT_ROWS * 8) { const int off = row * 128 + ((c ^ (row & 7)) << 4); const bool ok = row >= rv0 && row < rv1; const u32x4 z = (u32x4){0u, 0u, 0u, 0u};
                *(LAS u32x4*)(Ks + off) = ok ? kr[i] : z; *(LAS u32x4*)(Vs + off) = ok ? vr[i] : z; } }
        { const int ntab = isB ? 4 : 1;
          for (int x = tid; x < ntab * ATT_TABN; x += NTHREADS) { const int t = x / ATT_TABN, j = x % ATT_TABN, idx = j - 16;
              float v = -1e30f;
              if (idx >= 0 && idx <= 2 * R) v = io.rel_table[t5_bucket((idx - R) * dil) * 16 + (isB ? 8 + head0 + t : head0)] * LOG2E;
              tab[x] = v; } }
        }
        if (u + G < NU) { const AttnUnitD An = attn_decode(u + G); attn_issue(An, io.QKV, tid, kr, vr); }
        __syncthreads();
        for (int rep = 0; rep < REP_ATTC; ++rep)
        for (int gidx = wid; gidx < ngroups; gidx += NWAVES) {
            const int hq = isB ? (gidx >> 3) : 0, gi = isB ? (gidx & 7) : gidx, head = head0 + hq;
            const int ql = 16 * gi + qi, posq = res + dil * (l0 + ql);
            const LAS float* tb = tab + hq * ATT_TABN + 16;
            bf16x8 qf[2];
            { const u32x4 wq[2] = {qr0, qr1}; const float SC = 0.125f * LOG2E;
              { const int gn = gidx + NWAVES < ngroups ? gidx + NWAVES : gidx; const bf16_t* qpn = qptr(gn); qr0 = *(const u32x4*)qpn; qr1 = *(const u32x4*)(qpn + 32); }
#pragma unroll
              for (int ks = 0; ks < 2; ++ks) { const u32x4 w = wq[ks]; u32x4 o;
                  o.x = cvtpk(bflo(w.x) * SC, bfhi(w.x) * SC); o.y = cvtpk(bflo(w.y) * SC, bfhi(w.y) * SC); o.z = cvtpk(bflo(w.z) * SC, bfhi(w.z) * SC); o.w = cvtpk(bflo(w.w) * SC, bfhi(w.w) * SC);
                  qf[ks] = __builtin_bit_cast(bf16x8, o); } }
            f32x4 ot[4];
#pragma unroll
            for (int dt = 0; dt < 4; ++dt) ot[dt] = (f32x4){0.f, 0.f, 0.f, 0.f};
            float m = -1e20f, lsum = 0.f;
            bf16x8 kf[2][2];
            { const int r0 = 16 * gi + qi;
#pragma unroll
              for (int ks = 0; ks < 2; ++ks) { const int c = g4 + 4 * ks; const int off = r0 * 128 + ((c ^ (r0 & 7)) << 4); kf[ks][0] = *(const LAS bf16x8*)(Ks + off); kf[ks][1] = *(const LAS bf16x8*)(Ks + off + 16 * 128); } }
            for (int it = 0; it < nit; ++it) {
                const int rb = 16 * gi + 32 * it;
                float tb0[4], tb1[4];
#pragma unroll
                for (int r = 0; r < 4; ++r) { tb0[r] = tb[rb + 4 * g4 + r - ql]; tb1[r] = tb[rb + 4 * g4 + r + 16 - ql]; }
                v4i16_t vlo[4], vhi[4];
                { const int ra = rb + 4 * g4 + (qi >> 2);
#pragma unroll
                  for (int dt = 0; dt < 4; ++dt) { const int ch = dt * 2 + ((qi & 3) >> 1); const int off = ra * 128 + ((ch ^ (ra & 7)) << 4) + 8 * (qi & 1); vlo[dt] = lds_tr16(Vs + off); vhi[dt] = lds_tr16(Vs + off + 16 * 128); } }
                f32x4 s0 = (f32x4){0.f, 0.f, 0.f, 0.f}, s1 = s0;
#pragma unroll
                for (int ks = 0; ks < 2; ++ks) { s0 = __builtin_amdgcn_mfma_f32_16x16x32_bf16(kf[ks][0], qf[ks], s0, 0, 0, 0); s1 = __builtin_amdgcn_mfma_f32_16x16x32_bf16(kf[ks][1], qf[ks], s1, 0, 0, 0); }
                if (it + 1 < nit) { const int r0 = rb + 32 + qi;
#pragma unroll
                    for (int ks = 0; ks < 2; ++ks) { const int c = g4 + 4 * ks; const int off = r0 * 128 + ((c ^ (r0 & 7)) << 4); kf[ks][0] = *(const LAS bf16x8*)(Ks + off); kf[ks][1] = *(const LAS bf16x8*)(Ks + off + 16 * 128); } }
                float v[8]; float tmax = -1e30f;
                asm volatile("" : "+v"(tb0[0]), "+v"(tb0[1]), "+v"(tb0[2]), "+v"(tb0[3]), "+v"(tb1[0]), "+v"(tb1[1]), "+v"(tb1[2]), "+v"(tb1[3]));
#pragma unroll
                for (int r = 0; r < 4; ++r) { const int row0 = rb + 4 * g4 + r, row1 = row0 + 16;
                    const bool ok0 = (unsigned)(row0 - rv0) < (unsigned)(rv1 - rv0), ok1 = (unsigned)(row1 - rv0) < (unsigned)(rv1 - rv0);
                    const float a = ok0 ? s0[r] + tb0[r] : -1e30f, c2 = ok1 ? s1[r] + tb1[r] : -1e30f;
                    v[r] = a; v[4 + r] = c2; tmax = fmaxf(tmax, fmaxf(a, c2)); }
                tmax = rows_max(tmax);
                const float mn = fmaxf(m, tmax), alpha = __builtin_amdgcn_exp2f(m - mn); m = mn;
                float ps = 0.f;
#pragma unroll
                for (int i = 0; i < 8; ++i) { v[i] = __builtin_amdgcn_exp2f(v[i] - mn); ps += v[i]; }
                lsum = lsum * alpha + ps;
#pragma unroll
                for (int dt = 0; dt < 4; ++dt) ot[dt] = ot[dt] * alpha;
                u32x4 pw; pw.x = cvtpk(v[0], v[1]); pw.y = cvtpk(v[2], v[3]); pw.z = cvtpk(v[4], v[5]); pw.w = cvtpk(v[6], v[7]);
                const bf16x8 pf = __builtin_bit_cast(bf16x8, pw);
#pragma unroll
                for (int dt = 0; dt < 4; ++dt) { const bf16x8 vf = (bf16x8){vlo[dt][0], vlo[dt][1], vlo[dt][2], vlo[dt][3], vhi[dt][0], vhi[dt][1], vhi[dt][2], vhi[dt][3]};
                    ot[dt] = __builtin_amdgcn_mfma_f32_16x16x32_bf16(vf, pf, ot[dt], 0, 0, 0); }
            }
            lsum = rows_sum(lsum);
            const size_t tok = (size_t)b * SEQ + posq;
            float scale;
            if (isB) { const float s2 = io.sink[head] * LOG2E, mf = fmaxf(m, s2), e = __builtin_amdgcn_exp2f(m - mf); scale = e / (lsum * e + __builtin_amdgcn_exp2f(s2 - mf)); }
            else { scale = 1.f / lsum; if (g4 == 0) io.LSE[((size_t)branch * M + tok) * 8 + head] = m + __builtin_amdgcn_logf(lsum); }
            bf16_t* op = isB ? io.O + tok * D + 512 + head * 64 : io.OBR + ((size_t)branch * M + tok) * 512 + head * 64;
#pragma unroll
            for (int dt = 0; dt < 4; ++dt) { const f32x4 o = ot[dt] * scale; u32x2 w; w.x = cvtpk(o[0], o[1]); w.y = cvtpk(o[2], o[3]); *(u32x2*)(op + dt * 16 + 4 * g4) = w; }
        }
    }
}
__device__ __forceinline__ void phase_attn_merge(const AttnIO& io, int gtid, int NGT) {
    for (int x = gtid; x < M * 64; x += NGT) { const int tok = x >> 6, head = (x >> 3) & 7, c8 = x & 7;
        const float l0 = io.LSE[((size_t)0 * M + tok) * 8 + head], l1 = io.LSE[((size_t)1 * M + tok) * 8 + head], l2 = io.LSE[((size_t)2 * M + tok) * 8 + head];
        const float mx = fmaxf(l0, fmaxf(l1, l2)); float w0 = __builtin_amdgcn_exp2f(l0 - mx), w1 = __builtin_amdgcn_exp2f(l1 - mx), w2 = __builtin_amdgcn_exp2f(l2 - mx);
        const float inv = 1.f / (w0 + w1 + w2); w0 *= inv; w1 *= inv; w2 *= inv;
        const size_t o = (size_t)tok * 512 + head * 64 + c8 * 8;
        const u32x4 a = *(const u32x4*)(io.OBR + o), bq = *(const u32x4*)(io.OBR + (size_t)M * 512 + o), c = *(const u32x4*)(io.OBR + (size_t)2 * M * 512 + o);
        u32x4 r;
        r.x = pk2(w0 * bflo(a.x) + w1 * bflo(bq.x) + w2 * bflo(c.x), w0 * bfhi(a.x) + w1 * bfhi(bq.x) + w2 * bfhi(c.x));
        r.y = pk2(w0 * bflo(a.y) + w1 * bflo(bq.y) + w2 * bflo(c.y), w0 * bfhi(a.y) + w1 * bfhi(bq.y) + w2 * bfhi(c.y));
        r.z = pk2(w0 * bflo(a.z) + w1 * bflo(bq.z) + w2 * bflo(c.z), w0 * bfhi(a.z) + w1 * bfhi(bq.z) + w2 * bfhi(c.z));
        r.w = pk2(w0 * bflo(a.w) + w1 * bflo(bq.w) + w2 * bflo(c.w), w0 * bfhi(a.w) + w1 * bfhi(bq.w) + w2 * bfhi(c.w));
        pg8::store16_wt(io.O + (size_t)tok * D + head * 64 + c8 * 8, r); }
}

constexpr int NCH = SEQ / 16;
constexpr int SC_LROW = 68, SC_LDROW = 528, SC_LSLOT = 4 * 16 * SC_LROW * 4 + 16 * SC_LDROW;
constexpr int CT_KHT = 0, CT_RHT = 2048, CT_BTT = 4096, CT_KTT = 6144, CT_VT = 8192, CT_WEND = 10240, CT_SLOT = CT_WEND + 256;
constexpr int GT_AKK = 0, GT_BB = 512, GT_BK = 1024, GT_TT = 1536, GT_SLOT = 2048;
constexpr int SC_LBUF = 0, SC_CT = SC_LBUF + 2 * SC_LSLOT, SC_GG = SC_CT + 3 * CT_SLOT, SC_RKR = SC_GG + 4 * 4096, SC_GT = SC_RKR + 4 * 256, SC_NB = SC_GT + 2 * GT_SLOT, SC_OUT = SC_NB + 1024, SC_END = SC_OUT + 2 * 4096;
static_assert(SC_END <= LDSCTL_OFF, "scan LDS map");
template <int CTRL> __device__ __forceinline__ float dpp_f(float x) { return __int_as_float(__builtin_amdgcn_update_dpp(0, __float_as_int(x), CTRL, 0xf, 0xf, true)); }
__device__ __forceinline__ float sum8(float x) { x += dpp_f<0xB1>(x); x += dpp_f<0x4E>(x); x += dpp_f<0x141>(x); return x; }
__device__ __forceinline__ float sum16(float x) { x += dpp_f<0xB1>(x); x += dpp_f<0x4E>(x); x += dpp_f<0x141>(x); x += dpp_f<0x140>(x); return x; }
__device__ __forceinline__ float fast_sigmoid(float z) { return __builtin_amdgcn_rcpf(1.f + __builtin_amdgcn_exp2f(-LOG2E * z)); }
__device__ __forceinline__ bf16x8 mk8(unsigned a, unsigned b, unsigned c, unsigned d) { return __builtin_bit_cast(bf16x8, (u32x4){a, b, c, d}); }

struct ScanPtrs { const bf16_t *R, *Kk, *V, *LDA; bf16_t* Y; const float *w2, *a2, *g2, *w0, *a0, *k_k, *k_a, *r_k, *gn_w, *gn_b; };
__device__ __forceinline__ void phase_scan(LAS unsigned char* lds, const ScanPtrs& P, int G) {
    int tid = threadIdx.x; asm volatile("" : "+v"(tid));
    const int lane = tid & 63, wid = __builtin_amdgcn_readfirstlane(tid >> 6), g4 = lane >> 4, c16 = lane & 15;
    for (int unit = blockIdx.x; unit < 256; unit += G) {
        const int b = unit >> 5, h = (unit >> 1) & 15, d = unit & 1, hc = h * 64;
        unsigned long long wait_acc = 0ull;
        __syncthreads();
        if (wid < 4) {
            f32x4 ST[4];
#pragma unroll
            for (int mt = 0; mt < 4; ++mt) ST[mt] = (f32x4){0.f, 0.f, 0.f, 0.f};
            const int pch = hc + 8 * (lane & 7);
            const f32x4 gw0 = *(const f32x4*)(P.gn_w + pch), gw1 = *(const f32x4*)(P.gn_w + pch + 4), gb0 = *(const f32x4*)(P.gn_b + pch), gb1 = *(const f32x4*)(P.gn_b + pch + 4);
            u32x4 pvA = {0u, 0u, 0u, 0u}, pvB = pvA;
            auto issueV = [&](int ch_, u32x4& dst) { const int s = 8 * (wid - 1) + (lane >> 3), t = d ? (SEQ - 1 - (ch_ * 16 + s)) : (ch_ * 16 + s); dst = *(const u32x4*)(P.V + ((size_t)b * SEQ + t) * D + pch); };
            if (wid == 1 || wid == 2) { issueV(0, pvA); issueV(1, pvB); }
            auto sw_interval = [&](int i, u32x4& pvset) {
                const int c = i - 3;
                int ln = lane; asm volatile("" : "+v"(ln)); const int g4 = ln >> 4, c16 = ln & 15;
                if (c >= 0 && c < NCH) {
                    const LAS unsigned char* Ct = lds + SC_CT + (c % 3) * CT_SLOT; const LAS unsigned char* Gt = lds + SC_GT + (c & 1) * GT_SLOT;
                    v4i16_t kha[2][2], rha[2][2];
#pragma unroll
                    for (int p = 0; p < 2; ++p)
#pragma unroll
                        for (int hh = 0; hh < 2; ++hh) { const int off = (32 * p + 16 * hh + 4 * g4 + (c16 >> 2)) * 32 + 8 * (c16 & 3); kha[p][hh] = lds_tr16(Ct + CT_KHT + off); rha[p][hh] = lds_tr16(Ct + CT_RHT + off); }
                    const u32x2 gakk = *(const LAS u32x2*)(Gt + GT_AKK + c16 * 32 + 8 * g4), gtt = *(const LAS u32x2*)(Gt + GT_TT + c16 * 32 + 8 * g4);
                    const u32x2 gbb = *(const LAS u32x2*)(Gt + GT_BB + c16 * 32 + 8 * g4), gbk = *(const LAS u32x2*)(Gt + GT_BK + c16 * 32 + 8 * g4);
                    const u32x2 vt = *(const LAS u32x2*)(Ct + CT_VT + (16 * wid + c16) * 32 + 8 * g4);
                    u32x2 btt[4], ktt[4]; f32x4 we[4];
#pragma unroll
                    for (int mt = 0; mt < 4; ++mt) { btt[mt] = *(const LAS u32x2*)(Ct + CT_BTT + (16 * mt + c16) * 32 + 8 * g4); ktt[mt] = *(const LAS u32x2*)(Ct + CT_KTT + (16 * mt + c16) * 32 + 8 * g4);
                        we[mt] = *(const LAS f32x4*)(Ct + CT_WEND + (16 * mt + 4 * g4) * 4); }
                    f32x4 pt = {0.f, 0.f, 0.f, 0.f}, prt = pt;
#pragma unroll
                    for (int p = 0; p < 2; ++p) { const bf16x8 sb = mk8(cvtpk(ST[2 * p][0], ST[2 * p][1]), cvtpk(ST[2 * p][2], ST[2 * p][3]), cvtpk(ST[2 * p + 1][0], ST[2 * p + 1][1]), cvtpk(ST[2 * p + 1][2], ST[2 * p + 1][3]));
                        pt = __builtin_amdgcn_mfma_f32_16x16x32_bf16((bf16x8){kha[p][0][0], kha[p][0][1], kha[p][0][2], kha[p][0][3], kha[p][1][0], kha[p][1][1], kha[p][1][2], kha[p][1][3]}, sb, pt, 0, 0, 0);
                        prt = __builtin_amdgcn_mfma_f32_16x16x32_bf16((bf16x8){rha[p][0][0], rha[p][0][1], rha[p][0][2], rha[p][0][3], rha[p][1][0], rha[p][1][1], rha[p][1][2], rha[p][1][3]}, sb, prt, 0, 0, 0); }
                    const f32x4 qt = __builtin_amdgcn_mfma_f32_16x16x32_bf16(mk8(gakk.x, gakk.y, 0u, 0u), mk8(vt.x, vt.y, 0u, 0u), pt, 0, 0, 0);
                    const f32x4 sat = __builtin_amdgcn_mfma_f32_16x16x32_bf16(mk8(gtt.x, gtt.y, 0u, 0u), mk8(cvtpk(qt[0], qt[1]), cvtpk(qt[2], qt[3]), 0u, 0u), (f32x4){0.f, 0.f, 0.f, 0.f}, 0, 0, 0);
                    const bf16x8 sv = mk8(cvtpk(sat[0], sat[1]), cvtpk(sat[2], sat[3]), vt.x, vt.y);
                    const f32x4 outt = __builtin_amdgcn_mfma_f32_16x16x32_bf16(mk8(gbb.x, gbb.y, gbk.x, gbk.y), sv, prt, 0, 0, 0);
#pragma unroll
                    for (int mt = 0; mt < 4; ++mt) { ST[mt] = __builtin_amdgcn_mfma_f32_16x16x32_bf16(mk8(btt[mt].x, btt[mt].y, ktt[mt].x, ktt[mt].y), sv, ST[mt], 0, 0, 0); ST[mt] = ST[mt] * we[mt]; }
                    LAS float* ob = (LAS float*)(lds + SC_OUT + (c & 1) * 4096) + 16 * wid + c16;
#pragma unroll
                    for (int r = 0; r < 4; ++r) ob[(4 * g4 + r) * 64] = outt[r];
                }
                for (int rep_ = 0; rep_ < REP_ST; ++rep_)
                if (i >= 2 && i - 2 < NCH) {
                    const int jg = i - 2, hw = wid;
                    const LAS unsigned char* Ct = lds + SC_CT + (jg % 3) * CT_SLOT; LAS unsigned char* Gt = lds + SC_GT + (jg & 1) * GT_SLOT;
                    const int aoff = (hw & 1) ? CT_KTT : CT_BTT, boff = (hw & 2) ? CT_RHT : CT_KHT;
                    f32x4 gm = {0.f, 0.f, 0.f, 0.f}, gmT = gm;
#pragma unroll
                    for (int ks = 0; ks < 2; ++ks) { const int o1 = (8 * g4 + 32 * ks + (c16 >> 2)) * 32 + 8 * (c16 & 3), o2 = o1 + 4 * 32;
                        const v4i16_t a0 = lds_tr16(Ct + aoff + o1), a1 = lds_tr16(Ct + aoff + o2), b0 = lds_tr16(Ct + boff + o1), b1 = lds_tr16(Ct + boff + o2);
                        const bf16x8 af = {a0[0], a0[1], a0[2], a0[3], a1[0], a1[1], a1[2], a1[3]}, bfr = {b0[0], b0[1], b0[2], b0[3], b1[0], b1[1], b1[2], b1[3]};
                        gm = __builtin_amdgcn_mfma_f32_16x16x32_bf16(af, bfr, gm, 0, 0, 0);
                        if (hw == 0) gmT = __builtin_amdgcn_mfma_f32_16x16x32_bf16(bfr, af, gmT, 0, 0, 0); }
#pragma unroll
                    for (int r = 0; r < 4; ++r) { const int s = 4 * g4 + r; const bool keep = (hw & 2) ? (s <= c16) : (s < c16); gm[r] = keep ? gm[r] : 0.f; gmT[r] = (c16 < s) ? gmT[r] : 0.f; }
                    if (hw != 0) { *(LAS u32x2*)(Gt + (hw == 1 ? GT_AKK : (hw == 2 ? GT_BB : GT_BK)) + c16 * 32 + 8 * g4) = (u32x2){cvtpk(gm[0], gm[1]), cvtpk(gm[2], gm[3])}; }
                    else {
#define SC_OPA(x) mk8(cvtpk((x)[0], (x)[1]), cvtpk((x)[2], (x)[3]), 0u, 0u)
                        const f32x4 z4 = {0.f, 0.f, 0.f, 0.f};
                        f32x4 Rm, RTm;
#pragma unroll
                        for (int r = 0; r < 4; ++r) { const float idn = (4 * g4 + r == c16) ? 1.f : 0.f; Rm[r] = idn - gm[r]; RTm[r] = idn - gmT[r]; }
                        const f32x4 N2 = __builtin_amdgcn_mfma_f32_16x16x32_bf16(SC_OPA(gmT), SC_OPA(gm), z4, 0, 0, 0), N2T = __builtin_amdgcn_mfma_f32_16x16x32_bf16(SC_OPA(gm), SC_OPA(gmT), z4, 0, 0, 0);
                        f32x4 R1 = __builtin_amdgcn_mfma_f32_16x16x32_bf16(SC_OPA(RTm), SC_OPA(N2), Rm, 0, 0, 0), R1T = __builtin_amdgcn_mfma_f32_16x16x32_bf16(SC_OPA(N2), SC_OPA(RTm), RTm, 0, 0, 0);
                        const f32x4 N4 = __builtin_amdgcn_mfma_f32_16x16x32_bf16(SC_OPA(N2T), SC_OPA(N2), z4, 0, 0, 0), N4T = __builtin_amdgcn_mfma_f32_16x16x32_bf16(SC_OPA(N2), SC_OPA(N2T), z4, 0, 0, 0);
                        f32x4 R2 = __builtin_amdgcn_mfma_f32_16x16x32_bf16(SC_OPA(R1T), SC_OPA(N4), R1, 0, 0, 0), R2T = __builtin_amdgcn_mfma_f32_16x16x32_bf16(SC_OPA(N4), SC_OPA(R1T), R1T, 0, 0, 0);
                        const f32x4 N8 = __builtin_amdgcn_mfma_f32_16x16x32_bf16(SC_OPA(N4T), SC_OPA(N4), z4, 0, 0, 0);
                        const f32x4 Tm = __builtin_amdgcn_mfma_f32_16x16x32_bf16(SC_OPA(R2T), SC_OPA(N8), R2, 0, 0, 0);
#undef SC_OPA
                        *(LAS u32x2*)(Gt + GT_TT + c16 * 32 + 8 * g4) = (u32x2){cvtpk(-Tm[0], -Tm[1]), cvtpk(-Tm[2], -Tm[3])};
                    }
                }
                if ((wid == 1 || wid == 2) && i >= 4 && i - 4 < NCH) {
                    const int jp = i - 4, tl = ln >> 3, c8 = ln & 7;
                    const int s = 8 * (wid - 1) + tl, t = d ? (SEQ - 1 - (jp * 16 + s)) : (jp * 16 + s);
                    const LAS float* ob = (const LAS float*)(lds + SC_OUT + (jp & 1) * 4096) + s * 64 + 8 * c8; const LAS float* gp = (const LAS float*)(lds + SC_GG + (jp & 3) * 4096) + s * 64 + 8 * c8;
                    const f32x4 o0 = *(const LAS f32x4*)(ob), o1 = *(const LAS f32x4*)(ob + 4), g0 = *(const LAS f32x4*)(gp), g1 = *(const LAS f32x4*)(gp + 4);
                    const f32x4 rk4 = *(const LAS f32x4*)((const LAS float*)(lds + SC_RKR + (jp & 3) * 256) + s * 4); const float rkr = (rk4[0] + rk4[1]) + (rk4[2] + rk4[3]);
                    const u32x4 pv = pvset; issueV(jp + 2 < NCH ? jp + 2 : NCH - 1, pvset);
                    const f32x4 v0 = {bflo(pv.x), bfhi(pv.x), bflo(pv.y), bfhi(pv.y)}, v1 = {bflo(pv.z), bfhi(pv.z), bflo(pv.w), bfhi(pv.w)};
                    float mu = ((o0[0] + o0[1]) + (o0[2] + o0[3])) + ((o1[0] + o1[1]) + (o1[2] + o1[3])); mu = sum8(mu) * (1.f / 64.f);
                    const f32x4 d0 = o0 - mu, d1 = o1 - mu; float var = ((d0[0] * d0[0] + d0[1] * d0[1]) + (d0[2] * d0[2] + d0[3] * d0[3])) + ((d1[0] * d1[0] + d1[1] * d1[1]) + (d1[2] * d1[2] + d1[3] * d1[3])); var = sum8(var) * (1.f / 64.f);
                    const float rs = rsqrtf(var + GN_EPS);
                    const f32x4 y0 = (d0 * rs * gw0 + gb0 + rkr * v0) * g0, y1 = (d1 * rs * gw1 + gb1 + rkr * v1) * g1;
                    pg8::store16_wt(P.Y + ((size_t)b * SEQ + t) * (2 * D) + d * D + hc + 8 * c8, (u32x4){cvtpk(y0[0], y0[1]), cvtpk(y0[2], y0[3]), cvtpk(y1[0], y1[1]), cvtpk(y1[2], y1[3])});
                }
                for (int rep_ = 0; rep_ < REP_SYNC; ++rep_) __syncthreads();
                if (WAITPROBE >= 0) { const unsigned long long t0_ = __builtin_amdgcn_s_memrealtime(); __syncthreads(); wait_acc += __builtin_amdgcn_s_memrealtime() - t0_; } else
                __syncthreads();
            };
            static_assert((NCH + 4) % 2 == 0, "interval loop is unrolled by two");
            __builtin_amdgcn_s_setprio(2);
            for (int i = 0; i < NCH + 4; i += 2) { sw_interval(i, pvA); sw_interval(i + 1, pvB); }
            __builtin_amdgcn_s_setprio(0);
        } else {
            const int hw = wid - 4;
            const int chC = hc + 16 * hw + c16, chT = hc + 4 * c16;
            bf16x8 bw[2], ba[2], bg[4];
#pragma unroll
            for (int ks = 0; ks < 2; ++ks) { u32x4 w, a;
#pragma unroll
                for (int jj = 0; jj < 4; ++jj) { const int k = 32 * ks + 8 * g4 + 2 * jj;
                    w[jj] = pk2(P.w2[(size_t)(d * 64 + k) * D + chC], P.w2[(size_t)(d * 64 + k + 1) * D + chC]); a[jj] = pk2(P.a2[(size_t)(d * 64 + k) * D + chC], P.a2[(size_t)(d * 64 + k + 1) * D + chC]); }
                bw[ks] = __builtin_bit_cast(bf16x8, w); ba[ks] = __builtin_bit_cast(bf16x8, a); }
#pragma unroll
            for (int ks = 0; ks < 4; ++ks) { u32x4 g;
#pragma unroll
                for (int jj = 0; jj < 4; ++jj) { const int k = 32 * ks + 8 * g4 + 2 * jj; g[jj] = pk2(P.g2[(size_t)(d * 128 + k) * D + chC], P.g2[(size_t)(d * 128 + k + 1) * D + chC]); }
                bg[ks] = __builtin_bit_cast(bf16x8, g); }
            const float w0c = P.w0[d * D + chC], a0c = P.a0[d * D + chC], kaC = P.k_a[chC], rkC = P.r_k[chC];
            const f32x4 kkT = *(const f32x4*)(P.k_k + chT);
            const int n0 = 16 * c16, lcol = n0 < 64 ? (d * 64 + n0) : (n0 < 128 ? (128 + d * 64 + (n0 - 64)) : (256 + d * 128 + (n0 - 128)));
            struct LSet { u32x2 r, k, v; u32x4 l0, l1; };
            LSet setA, setB;
            auto issueL = [&](int ch_, LSet& S) { const int s = 4 * hw + g4, t = d ? (SEQ - 1 - (ch_ * 16 + s)) : (ch_ * 16 + s); const size_t row = (size_t)b * SEQ + t;
                S.r = *(const u32x2*)(P.R + row * D + chT); S.k = *(const u32x2*)(P.Kk + row * D + chT); S.v = *(const u32x2*)(P.V + row * D + chT);
                S.l0 = *(const u32x4*)(P.LDA + row * 512 + lcol); S.l1 = *(const u32x4*)(P.LDA + row * 512 + lcol + 8); };
            issueL(0, setA); issueL(1, setB);
            auto hw_interval = [&](int i, LSet& LS) {
                const bool doL = i < NCH, doC = (i >= 1 && i - 1 < NCH);
                int ln = lane; asm volatile("" : "+v"(ln)); const int g4 = ln >> 4, c16 = ln & 15;
                const unsigned long long tb_ = (SECPROBE >= 0) ? __builtin_amdgcn_s_memrealtime() : 0ull;
                for (int rep_ = 0; rep_ < REP_HC; ++rep_)
                if (doC) {
                    const int jc = i - 1;
                    const LAS unsigned char* Ls = lds + SC_LBUF + (jc & 1) * SC_LSLOT;
                    const LAS unsigned char* ldp = Ls + 4 * 16 * SC_LROW * 4 + c16 * SC_LDROW + 16 * g4;
                    f32x4 zw = {0.f, 0.f, 0.f, 0.f}, za = zw, gg = zw;
#pragma unroll
                    for (int ks = 0; ks < 2; ++ks) { zw = __builtin_amdgcn_mfma_f32_16x16x32_bf16(*(const LAS bf16x8*)(ldp + 64 * ks), bw[ks], zw, 0, 0, 0);
                                                     za = __builtin_amdgcn_mfma_f32_16x16x32_bf16(*(const LAS bf16x8*)(ldp + 128 + 64 * ks), ba[ks], za, 0, 0, 0); }
#pragma unroll
                    for (int ks = 0; ks < 4; ++ks) gg = __builtin_amdgcn_mfma_f32_16x16x32_bf16(*(const LAS bf16x8*)(ldp + 256 + 64 * ks), bg[ks], gg, 0, 0, 0);
                    float lw[4], cw[4]; float tot = 0.f;
#pragma unroll
                    for (int r = 0; r < 4; ++r) { lw[r] = -0.6065306597f * fast_sigmoid(w0c + zw[r]); tot += lw[r]; cw[r] = tot; }
                    float pre;
                    { auto e = __builtin_amdgcn_permlane16_swap(__float_as_uint(tot), __float_as_uint(tot), false, false); const float e0 = __uint_as_float(e[0]), s01 = e0 + __uint_as_float(e[1]);
                      auto f = __builtin_amdgcn_permlane32_swap(__float_as_uint(s01), __float_as_uint(s01), false, false);
                      pre = ((g4 & 1) ? e0 : 0.f) + ((g4 & 2) ? __uint_as_float(f[0]) : 0.f); }
                    const LAS float* Lf = (const LAS float*)Ls + 16 * hw + c16;
                    LAS unsigned char* Ct = lds + SC_CT + (jc % 3) * CT_SLOT;
                    LAS float* ggw = (LAS float*)(lds + SC_GG + (jc & 3) * 4096) + 16 * hw + c16;
                    float kh[4], rh[4], bt[4], kt[4], vv[4], rkp[4];
#pragma unroll
                    for (int r = 0; r < 4; ++r) { const int tok = 4 * g4 + r; const float c = pre + cw[r];
                        const float Wc = __builtin_amdgcn_exp2f(LOG2E * c), Wp = __builtin_amdgcn_exp2f(LOG2E * (c - lw[r])), iW = __builtin_amdgcn_exp2f(-LOG2E * c);
                        const float a = fast_sigmoid(a0c + za[r]);
                        const float rr = Lf[tok * SC_LROW], kk_ = Lf[16 * SC_LROW + tok * SC_LROW], nk = Lf[32 * SC_LROW + tok * SC_LROW]; vv[r] = Lf[48 * SC_LROW + tok * SC_LROW];
                        const float kd = kk_ * (1.f + (a - 1.f) * kaC);
                        kh[r] = nk * Wp; rh[r] = rr * Wc; bt[r] = nk * a * iW; kt[r] = kd * iW; rkp[r] = rr * kd * rkC;
                        ggw[tok * 64] = gg[r];
                        if (tok == 15) ((LAS float*)(Ct + CT_WEND))[16 * hw + c16] = Wc; }
                    { LAS unsigned char* tq = Ct + (16 * hw + c16) * 32 + 8 * g4;
                      *(LAS u32x2*)(tq + CT_KHT) = (u32x2){cvtpk(kh[0], kh[1]), cvtpk(kh[2], kh[3])}; *(LAS u32x2*)(tq + CT_RHT) = (u32x2){cvtpk(rh[0], rh[1]), cvtpk(rh[2], rh[3])};
                      *(LAS u32x2*)(tq + CT_BTT) = (u32x2){cvtpk(bt[0], bt[1]), cvtpk(bt[2], bt[3])}; *(LAS u32x2*)(tq + CT_KTT) = (u32x2){cvtpk(kt[0], kt[1]), cvtpk(kt[2], kt[3])};
                      *(LAS u32x2*)(tq + CT_VT) = (u32x2){cvtpk(vv[0], vv[1]), cvtpk(vv[2], vv[3])}; }
#pragma unroll
                    for (int r = 0; r < 4; ++r) rkp[r] = sum16(rkp[r]);
                    if (c16 == 0) { LAS float* rk = (LAS float*)(lds + SC_RKR + (jc & 3) * 256) + hw;
#pragma unroll
                        for (int r = 0; r < 4; ++r) rk[(4 * g4 + r) * 4] = rkp[r]; }
                }
                const unsigned long long tc_ = (SECPROBE >= 0) ? __builtin_amdgcn_s_memrealtime() : 0ull;
                for (int rep_ = 0; rep_ < REP_HL; ++rep_)
                if (doL) {
                    LAS unsigned char* Ls = lds + SC_LBUF + (i & 1) * SC_LSLOT; LAS float* Lf = (LAS float*)Ls;
                    const int s = 4 * hw + g4;
                    const u32x2 lr = LS.r, lk = LS.k, lv = LS.v; const u32x4 l00 = LS.l0, l01 = LS.l1;
                    issueL(i + 2 < NCH ? i + 2 : NCH - 1, LS);
                    const f32x4 rr = {bflo(lr.x), bfhi(lr.x), bflo(lr.y), bfhi(lr.y)}, kk_ = {bflo(lk.x), bfhi(lk.x), bflo(lk.y), bfhi(lk.y)}, vv = {bflo(lv.x), bfhi(lv.x), bflo(lv.y), bfhi(lv.y)};
                    f32x4 nk = kk_ * kkT; float ss = nk[0] * nk[0] + nk[1] * nk[1] + nk[2] * nk[2] + nk[3] * nk[3];
                    ss = sum16(ss);
                    nk = nk * (1.f / fmaxf(sqrtf(ss), 1e-12f));
                    *(LAS f32x4*)(Lf + s * SC_LROW + 4 * c16) = rr; *(LAS f32x4*)(Lf + 16 * SC_LROW + s * SC_LROW + 4 * c16) = kk_;
                    *(LAS f32x4*)(Lf + 32 * SC_LROW + s * SC_LROW + 4 * c16) = nk; *(LAS f32x4*)(Lf + 48 * SC_LROW + s * SC_LROW + 4 * c16) = vv;
                    *(LAS u32x4*)(Ls + 4 * 16 * SC_LROW * 4 + s * SC_LDROW + 32 * c16) = l00; *(LAS u32x4*)(Ls + 4 * 16 * SC_LROW * 4 + s * SC_LDROW + 32 * c16 + 16) = l01;
                }
                for (int rep_ = 0; rep_ < REP_SYNC; ++rep_) __syncthreads();
                if (SECPROBE >= 0) { asm volatile("s_waitcnt vmcnt(0) lgkmcnt(0)" ::: "memory"); const unsigned long long te_ = __builtin_amdgcn_s_memrealtime(); wait_acc += (SECPROBE == 0) ? (tc_ - tb_) : ((SECPROBE == 1) ? (te_ - tc_) : (te_ - tb_)); __syncthreads(); } else
                if (WAITPROBE >= 0) { const unsigned long long t0_ = __builtin_amdgcn_s_memrealtime(); __syncthreads(); wait_acc += __builtin_amdgcn_s_memrealtime() - t0_; } else
                __syncthreads();
            };
            for (int i = 0; i < NCH + 4; i += 2) { hw_interval(i, setA); hw_interval(i + 1, setB); }
        }
        if ((WAITPROBE >= 0 || SECPROBE >= 0) && blockIdx.x == 0 && wid == (SECPROBE >= 0 ? 4 : WAITPROBE)) { const unsigned long long tgt_ = __builtin_amdgcn_s_memrealtime() + 4ull * wait_acc; while (__builtin_amdgcn_s_memrealtime() < tgt_) __builtin_amdgcn_s_sleep(8); }
    }
}

__global__ void __launch_bounds__(NTHREADS, 2) fwd_megakernel(Args args) {
    extern __shared__ __attribute__((aligned(16))) unsigned char lds_raw[];
    LAS unsigned char* lds = (LAS unsigned char*)lds_raw;
    volatile LAS unsigned* MISC = (volatile LAS unsigned*)(lds + MISC_OFF);
    const int tid0 = threadIdx.x, wave = __builtin_amdgcn_readfirstlane(tid0 >> 6);
#define FRESH_LANE() int tid = tid0; asm volatile("" : "+v"(tid)); const int lane = tid & 63; (void)lane
    const int G = gridDim.x;
    const int vcu = (G % 8 == 0) ? ((int)blockIdx.x % 8) * (G / 8) + (int)blockIdx.x / 8 : (int)blockIdx.x;
    const int gw = vcu * NWAVES + wave, NGW = G * NWAVES;
    unsigned char* ws = args.ws;
    unsigned* ctl = (unsigned*)(ws + WS_CTL);
    for (int u = tid0; u < (LDS_BYTES - LDSCTL_OFF) / 4; u += NTHREADS) ((LAS unsigned*)(lds + LDSCTL_OFF))[u] = 0u;
    __syncthreads();
    XcdBarrier bar = xcd_barrier_post(ctl + CW_BAR, MISC + 8);
    unsigned long long ts_a = 0ull; int ts_n = 0;
#define STAMP() do { if (TS_A >= 0) { const unsigned long long t_ = __builtin_amdgcn_s_memrealtime(); if (ts_n == TS_A) ts_a = t_; \
    if (ts_n == TS_B && blockIdx.x == 0) { const unsigned long long tgt_ = t_ + 4ull * (t_ - ts_a); while (__builtin_amdgcn_s_memrealtime() < tgt_) __builtin_amdgcn_s_sleep(8); } ++ts_n; } } while (0)
#define GRID_BAR() do { xcd_barrier(bar); STAMP(); } while (0)
    STAMP();

    const float* x = args.in[0]; const float* rel_table = args.in[1]; const float* norm_g = args.in[2]; const float* attn_w_in = args.in[3]; const float* attn_sink = args.in[4];
    const float* attn_w_out = args.in[5]; const float* mu_prev = args.in[6]; const float* mu_next = args.in[7]; const float* w_r = args.in[8]; const float* w_k = args.in[9];
    const float* w_v = args.in[10]; const float* w_o = args.in[11]; const float* mlp_w1 = args.in[25]; const float* mlp_w2 = args.in[26];
    bf16_t* HBa = (bf16_t*)args.out; bf16_t* HBb = HBa + (size_t)M * D; bf16_t* HBc = (bf16_t*)(ws + WS_HBC); bf16_t* TMP2 = (bf16_t*)(ws + WS_TMP2);
    bf16_t* XN = (bf16_t*)(ws + WS_XN); bf16_t* QKV = (bf16_t*)(ws + WS_QKV); bf16_t* Ob = (bf16_t*)(ws + WS_O); bf16_t* TMP = (bf16_t*)(ws + WS_TMP); bf16_t* Hb = (bf16_t*)(ws + WS_H);
    bf16_t* MIXA = (bf16_t*)(ws + WS_MIXA); bf16_t* MIXB = (bf16_t*)(ws + WS_MIXB); bf16_t* Rb = (bf16_t*)(ws + WS_R); bf16_t* Kb = (bf16_t*)(ws + WS_K); bf16_t* Vb = (bf16_t*)(ws + WS_V);
    bf16_t* LDO = (bf16_t*)(ws + WS_LDO); bf16_t* Yb = (bf16_t*)(ws + WS_Y);
    LAS float* scr = (LAS float*)(lds + wave * TR_SCR_BYTES);
    float* RS = (float*)(ws + WS_CTL + 128 * 1024);

    {
        FRESH_LANE();
        constexpr int I_IN = (D / 64) * (DIN / 64), I_OUT = (D / 64) * (D / 64), I_1 = (D / 64) * (DFF / 64), I_2 = (DFF / 64) * (D / 64);
        const bool tail = (G == 256);
        for (int it = gw; it < (tail ? I_IN : I_IN + I_OUT + I_1 + I_2); it += NGW) { int r = it;
            if (r < I_IN) { transpose_item(attn_w_in, DIN, DIN, (bf16_t*)(ws + WS_WIN_T), D, 0, 0, scr, r, lane, ScaleOne{}); continue; } r -= I_IN;
            if (r < I_OUT) { transpose_item(attn_w_out, D, D, (bf16_t*)(ws + WS_WOUT_T), D, 0, 0, scr, r, lane, ScaleOne{}); continue; } r -= I_OUT;
            if (r < I_1) { transpose_item(mlp_w1, DFF, DFF, (bf16_t*)(ws + WS_W1_T), D, 0, 0, scr, r, lane, ScaleVec{norm_g + 2 * D}); continue; } r -= I_1;
            transpose_item(mlp_w2, D, D, (bf16_t*)(ws + WS_W2_T), DFF, 0, 0, scr, r, lane, ScaleOne{}); }
        for (int row = gw; row < M; row += NGW) { Row16 r; row_load_f32(r, x + (size_t)row * D, lane); row_rmsnorm(r, norm_g, lane); row_store_bf16(r, XN + (size_t)row * D, lane); }
    }
    GRID_BAR();
    { pg8::StaticOrder S; S.init(M, DIN, G, (int)blockIdx.x); const EpiHeadMajor E{QKV};
      for (int rep = 0; rep < REP_GEMM; ++rep) pg8::gemm_phase<EpiHeadMajor, ProbPlain, true, true>(lds, ProbPlain{XN, (const bf16_t*)(ws + WS_WIN_T), D}, S, E); }
    if (G == 256 && blockIdx.x >= 64) {
        FRESH_LANE();
        constexpr int I_OUT = (D / 64) * (D / 64), I_1 = (D / 64) * (DFF / 64), I_2 = (DFF / 64) * (D / 64);
        for (int it = ((int)blockIdx.x - 64) * NWAVES + wave; it < I_OUT + I_1 + I_2; it += 192 * NWAVES) { int r = it;
            if (r < I_OUT) { transpose_item(attn_w_out, D, D, (bf16_t*)(ws + WS_WOUT_T), D, 0, 0, scr, r, lane, ScaleOne{}); continue; } r -= I_OUT;
            if (r < I_1) { transpose_item(mlp_w1, DFF, DFF, (bf16_t*)(ws + WS_W1_T), D, 0, 0, scr, r, lane, ScaleVec{norm_g + 2 * D}); continue; } r -= I_1;
            transpose_item(mlp_w2, D, D, (bf16_t*)(ws + WS_W2_T), DFF, 0, 0, scr, r, lane, ScaleOne{}); }
    }
    GRID_BAR();
    { const AttnIO io{QKV, rel_table, attn_sink, Ob, (bf16_t*)(ws + WS_OBR), (float*)(ws + WS_LSE)};
      for (int rep = 0; rep < REP_ATT; ++rep) phase_attn(lds, io, vcu, G);
      GRID_BAR();
      { FRESH_LANE(); phase_attn_merge(io, vcu * NTHREADS + tid, G * NTHREADS); } }
    GRID_BAR();
    for (int rep = 0; rep < REP_BAR; ++rep) GRID_BAR();
    run_gemm<0>(lds, ProbPlain{Ob, (const bf16_t*)(ws + WS_WOUT_T), D}, DstPlain{TMP, D}, M, D, G);
    GRID_BAR();
    { FRESH_LANE(); phase_resnorm<true, false>(x, TMP, norm_g + D, nullptr, HBa, nullptr, RS, gw, NGW, lane); }
    GRID_BAR();
    run_gemm_rs<1>(lds, ProbPlain{HBa, (const bf16_t*)(ws + WS_W1_T), D}, DstPlain{Hb, DFF}, RS, M, DFF, G);
    GRID_BAR();
    run_gemm<0>(lds, ProbPlain{Hb, (const bf16_t*)(ws + WS_W2_T), DFF}, DstPlain{TMP, D}, M, D, G);
    GRID_BAR();
    { FRESH_LANE(); phase_resnorm<false, false>(HBa, TMP, norm_g + 3 * D, nullptr, HBb, nullptr, nullptr, gw, NGW, lane); }
    GRID_BAR();
    {
        FRESH_LANE();
        const float* g1n = norm_g + 4 * D;
        constexpr int I_SQ = (D / 64) * (D / 64), I_1 = (D / 64) * (DFF / 64), I_2 = (DFF / 64) * (D / 64), I_LD = 384;
        const bool tail = (G == 256);
        for (int it = gw; it < (tail ? 2 * I_SQ + I_2 + I_LD : 4 * I_SQ + I_1 + I_2 + I_LD); it += NGW) { int r = it;
            if (r < I_SQ) { transpose_item(w_r, D, D, (bf16_t*)(ws + WS_WR_T), D, 0, 0, scr, r, lane, ScaleOne{}); continue; } r -= I_SQ;
            if (r < I_SQ) { transpose_item(w_k, D, D, (bf16_t*)(ws + WS_WK_T), D, 0, 0, scr, r, lane, ScaleOne{}); continue; } r -= I_SQ;
            if (!tail) {
                if (r < I_SQ) { transpose_item(w_v, D, D, (bf16_t*)(ws + WS_WV_T), D, 0, 0, scr, r, lane, ScaleOne{}); continue; } r -= I_SQ;
                if (r < I_SQ) { transpose_item(w_o, D, D, (bf16_t*)(ws + WS_WO2_T), D, 0, 0, scr, r, lane, ScaleOne{}); continue; } r -= I_SQ;
                if (r < I_1) { transpose_item(mlp_w1 + (size_t)D * DFF, DFF, DFF, (bf16_t*)(ws + WS_W1B_T), D, 0, 0, scr, r, lane, ScaleVec{norm_g + 6 * D}); continue; } r -= I_1; }
            if (r < I_2) { transpose_item(mlp_w2 + (size_t)DFF * D, D, D, (bf16_t*)(ws + WS_W2B_T), DFF, 0, 0, scr, r, lane, ScaleOne{}); continue; } r -= I_2;
            const int part = r / 128; int q = r % 128; int sub, li;
            if (q < 64) { sub = q / 16; li = q % 16; } else { sub = 4 + (q - 64) / 32; li = (q - 64) % 32; }
            const int dd = sub & 1, kind = sub >> 1;
            const int stream = kind == 0 ? 1 : (kind == 1 ? 4 : 5), Nn = kind == 2 ? 128 : 64;
            const float* src = kind == 0 ? args.in[18] + (size_t)dd * D * 64 : (kind == 1 ? args.in[21] + (size_t)dd * D * 64 : args.in[23] + (size_t)dd * D * 128);
            const int coloff = kind == 0 ? dd * 64 : (kind == 1 ? 128 + dd * 64 : 256 + dd * 128);
            transpose_item(src, Nn, Nn, (bf16_t*)(ws + WS_LDW_T), D, part * 512 + coloff, 0, scr, li, lane, ScaleMix{mu_prev + stream * D, mu_next + stream * D, part}); }
        phase_mix3(lds, HBb, g1n, mu_prev, mu_next, XN, MIXA, MIXB, HBa, gw, NGW, tid, lane);
    }
    GRID_BAR();
    run_gemm<0>(lds, ProbRKL{ws, D}, DstRKL{ws}, M, 14 * 256, G);
    if (G == 256 && blockIdx.x >= 128) {
        FRESH_LANE();
        constexpr int I_SQ = (D / 64) * (D / 64), I_1 = (D / 64) * (DFF / 64);
        for (int it = ((int)blockIdx.x - 128) * NWAVES + wave; it < 2 * I_SQ + I_1; it += 128 * NWAVES) { int r = it;
            if (r < I_SQ) { transpose_item(w_v, D, D, (bf16_t*)(ws + WS_WV_T), D, 0, 0, scr, r, lane, ScaleOne{}); continue; } r -= I_SQ;
            if (r < I_SQ) { transpose_item(w_o, D, D, (bf16_t*)(ws + WS_WO2_T), D, 0, 0, scr, r, lane, ScaleOne{}); continue; } r -= I_SQ;
            transpose_item(mlp_w1 + (size_t)D * DFF, DFF, DFF, (bf16_t*)(ws + WS_W1B_T), D, 0, 0, scr, r, lane, ScaleVec{norm_g + 6 * D}); }
    }
    GRID_BAR();
    { FRESH_LANE(); phase_lda(LDO, (bf16_t*)(ws + WS_LDA), gw, NGW, lane); }
    run_gemm<0>(lds, ProbPlain{HBa, (const bf16_t*)(ws + WS_WV_T), D}, DstPlain{Vb, D}, M, D, G);
    GRID_BAR();
    { ScanPtrs sp{Rb, Kb, Vb, (const bf16_t*)(ws + WS_LDA), Yb, args.in[19], args.in[22], args.in[24], args.in[17], args.in[20], args.in[12], args.in[13], args.in[14], args.in[15], args.in[16]};
      for (int rep = 0; rep < REP_SCAN; ++rep) phase_scan(lds, sp, G); }
    GRID_BAR();
    { FRESH_LANE();
      bf16_t* Ys = (bf16_t*)(ws + WS_YSUM);
      const bool grp_on = (G == 256);
      const int grow0 = 256 * (8 * ((int)blockIdx.x % 8) + ((int)blockIdx.x / 8) % 8) + 64 * ((int)blockIdx.x / 64);
      const int rfirst = grp_on ? grow0 + wave : gw, rend = grp_on ? grow0 + 64 : M, rstride = grp_on ? NWAVES : NGW;
      for (int row = rfirst; row < rend; row += rstride) {
          const u32x4* y0 = (const u32x4*)(Yb + (size_t)row * 2 * D); const u32x4* y1 = (const u32x4*)(Yb + (size_t)row * 2 * D + D);
#pragma unroll
          for (int hb = 0; hb < 2; ++hb) { const u32x4 a = y0[lane + 64 * hb], c = y1[lane + 64 * hb]; u32x4 o;
              o.x = cvtpk(bflo(a.x) + bflo(c.x), bfhi(a.x) + bfhi(c.x)); o.y = cvtpk(bflo(a.y) + bflo(c.y), bfhi(a.y) + bfhi(c.y));
              o.z = cvtpk(bflo(a.z) + bflo(c.z), bfhi(a.z) + bfhi(c.z)); o.w = cvtpk(bflo(a.w) + bflo(c.w), bfhi(a.w) + bfhi(c.w));
              pg8::store16_wt((u32x4*)(Ys + (size_t)row * D) + lane + 64 * hb, o); } }
      if (grp_on) { unsigned ep = 0u; grp_barrier(ctl + CW_BAR, (unsigned)blockIdx.x % 64u, ep); } else GRID_BAR();
      run_gemm<0>(lds, ProbPlain{Ys, (const bf16_t*)(ws + WS_WO2_T), D}, DstPlain{TMP2, D}, M, D, G); }
    GRID_BAR();
    { FRESH_LANE(); phase_resnorm<false, false>(HBb, TMP2, norm_g + 5 * D, nullptr, HBc, nullptr, RS, gw, NGW, lane); }
    GRID_BAR();
    run_gemm_rs<1>(lds, ProbPlain{HBc, (const bf16_t*)(ws + WS_W1B_T), D}, DstPlain{Hb, DFF}, RS, M, DFF, G);
    GRID_BAR();
    run_gemm<0>(lds, ProbPlain{Hb, (const bf16_t*)(ws + WS_W2B_T), DFF}, DstPlain{TMP2, D}, M, D, G);
    GRID_BAR();
    { FRESH_LANE(); phase_resnorm<false, true>(HBc, TMP2, norm_g + 7 * D, nullptr, args.out, nullptr, nullptr, gw, NGW, lane); }
    if (TS_A >= 0) { GRID_BAR(); }
#undef GRID_BAR
}

extern "C" void kernel_launch(void* const* d_in, const int* in_sizes, int n_in, void* d_out, int out_size, void* d_ws, size_t ws_size, hipStream_t stream) {
    static int grid = 0;
    if (grid == 0) {
        if (n_in != 27 || in_sizes[0] != M * D || out_size != M * D || ws_size < WS_END) { fprintf(stderr, "kernel_launch: unexpected shapes (n_in %d, in0 %d, out %d, ws %zu)\n", n_in, n_in > 0 ? in_sizes[0] : -1, out_size, ws_size); grid = -1; return; }
        int dev = 0, cus = 0, per_cu = 0;
        if (hipGetDevice(&dev) != hipSuccess || hipDeviceGetAttribute(&cus, hipDeviceAttributeMultiprocessorCount, dev) != hipSuccess) { grid = -1; return; }
        if (hipFuncSetAttribute((const void*)fwd_megakernel, hipFuncAttributeMaxDynamicSharedMemorySize, LDS_BYTES) != hipSuccess) { fprintf(stderr, "kernel_launch: hipFuncSetAttribute failed\n"); grid = -1; return; }
        if (hipOccupancyMaxActiveBlocksPerMultiprocessor(&per_cu, (const void*)fwd_megakernel, NTHREADS, LDS_BYTES) != hipSuccess || per_cu < 1) { fprintf(stderr, "kernel_launch: occupancy query says %d blocks/CU\n", per_cu); (void)hipGetLastError(); grid = -1; return; }
        grid = cus;
    }
    if (grid < 0) return;
    (void)hipMemsetAsync((char*)d_ws + WS_CTL, 0, CTL_ZERO_BYTES, stream);
    Args a{};
    for (int i = 0; i < 27; ++i) a.in[i] = (const float*)d_in[i];
    a.out = (float*)d_out; a.ws = (unsigned char*)d_ws;
    hipLaunchKernelGGL(fwd_megakernel, dim3(grid), dim3(NTHREADS), LDS_BYTES, stream, a);
}
```

```cpp
#include <hip/hip_runtime.h>
#include <cstdio>
#include <cstdint>

#define LAS __attribute__((address_space(3)))
#define GAS __attribute__((address_space(1)))
typedef unsigned short bf16_t;
typedef short bf16x8 __attribute__((ext_vector_type(8)));
typedef float f32x4 __attribute__((ext_vector_type(4)));
typedef float f32x2 __attribute__((ext_vector_type(2)));
typedef unsigned u32x4 __attribute__((ext_vector_type(4)));
typedef unsigned u32x2 __attribute__((ext_vector_type(2)));

#ifndef REP_SCAN
#define REP_SCAN 1
#endif
#ifndef REP_ATT
#define REP_ATT 1
#endif
#ifndef REP_GEMM
#define REP_GEMM 1
#endif
#ifndef REP_ATTC
#define REP_ATTC 1
#endif
#ifndef REP_BAR
#define REP_BAR 0
#endif
#ifndef REP_ATTS
#define REP_ATTS 1
#endif
#ifndef REP_HC
#define REP_HC 1
#endif
#ifndef REP_ST
#define REP_ST 1
#endif
#ifndef REP_HL
#define REP_HL 1
#endif
#ifndef REP_SYNC
#define REP_SYNC 0
#endif
#ifndef SECPROBE
#define SECPROBE -1
#endif
#ifndef WAITPROBE
#define WAITPROBE -1
#endif
#ifndef TS_A
#define TS_A -1
#endif
#ifndef TS_B
#define TS_B -1
#endif
constexpr int SEQ = 2048, D = 1024, NBATCH = 8, M = NBATCH * SEQ, DFF = 4096, DIN = 2304, NLD = 1536;
constexpr float NORM_EPS = 1e-6f, GN_EPS = 64e-5f;
constexpr int NWAVES = 8, NTHREADS = 512;

namespace pg8 {
constexpr int BM = 256, BK = 64, HALF = 128, HTB = HALF * BK * 2, STAGE_BYTES = 8 * HTB, NXCD = 8, WGM = 8;
__host__ __device__ __forceinline__ int lds_byte(int r, int c) { const int st = (r >> 4) * 2 + (c >> 5), rr = r & 15, cc = c & 31, ob = rr * 64 + cc * 2; return st * 1024 + (ob ^ (((ob >> 9) & 1) << 5)); }
__host__ __device__ __forceinline__ void stage_rc(int b, int& R, int& C) { const int st = b / 1024, sb = b % 1024, swz = sb ^ (((sb >> 9) & 1) << 5); R = (st >> 1) * 16 + swz / 64; C = (st & 1) * 32 + (swz % 64) / 2; }
__host__ __device__ __forceinline__ int perm32(int rho) { const int n = rho >> 4, i = rho & 15; return 8 * (i >> 2) + 4 * n + (i & 3); }

struct Unit { int pm, pn; };
struct StaticOrder {
    int nM, nN, nwg, G, c;
    __host__ __device__ void init(int Mr, int N, int G_, int c_) { nM = Mr / BM; nN = N / BM; nwg = nM * nN; G = G_; c = c_; }
    __host__ __device__ bool next(int i, Unit& u) const {
        const long L = (long)i * G + c; if (L >= nwg) return false;
        int wgid = (int)L; { const int q = nwg / NXCD, r = nwg % NXCD, xcd = wgid % NXCD, off = wgid / NXCD; wgid = (xcd < r ? xcd * (q + 1) : r * (q + 1) + (xcd - r) * q) + off; }
        const int nig = WGM * nN, gid = wgid / nig, fm = gid * WGM, gsz = (nM - fm) < WGM ? (nM - fm) : WGM;
        u.pm = fm + ((wgid % nig) % gsz); u.pn = (wgid % nig) / gsz; return true;
    }
};
__device__ __forceinline__ unsigned cvt_pk_bf16(float lo, float hi) { unsigned r; asm volatile("v_cvt_pk_bf16_f32 %0, %1, %2" : "=v"(r) : "v"(lo), "v"(hi)); return r; }

__device__ __forceinline__ void store16_wt(void* p, u32x4 v) { asm volatile("global_store_dwordx4 %0, %1, off sc1\n\ts_nop 1" :: "v"(p), "v"(v) : "memory"); }
template <int ACT, class DstFn, bool RS = false> struct EpiBf16 {
    static constexpr bool PERM = true;
    DstFn F; const float* rs;
    __device__ __forceinline__ void operator()(const f32x4 (&acc)[2][2][4][2], const Unit& u, int wr, int wc, int fr, int fq) const {
        bf16_t* base; int ldc; F(u, base, ldc);
        const int row0 = wr * 64 + fr, col0 = wc * 32 + 8 * fq;
        float rsc[2][4];
        if (RS) {
#pragma unroll
            for (int ai = 0; ai < 2; ++ai)
#pragma unroll
                for (int m = 0; m < 4; ++m) rsc[ai][m] = rs[u.pm * BM + row0 + ai * HALF + m * 16]; }
        if (RS && ACT == 1) {
            f32x4 t[2][2][4][2];
#pragma unroll
            for (int ai = 0; ai < 2; ++ai)
#pragma unroll
                for (int bj = 0; bj < 2; ++bj)
#pragma unroll
                    for (int m = 0; m < 4; ++m)
#pragma unroll
                        for (int n = 0; n < 2; ++n)
#pragma unroll
                            for (int e = 0; e < 4; ++e) { const float a = fmaxf(acc[ai][bj][m][n][e], 0.f); t[ai][bj][m][n][e] = a * a; }
#pragma unroll
            for (int ai = 0; ai < 2; ++ai)
#pragma unroll
                for (int m = 0; m < 4; ++m) { bf16_t* rowp = base + (size_t)(row0 + ai * HALF + m * 16) * ldc + col0; const float r2 = rsc[ai][m] * rsc[ai][m];
#pragma unroll
                    for (int bj = 0; bj < 2; ++bj) { const f32x4 v0 = t[ai][bj][m][0] * r2, v1 = t[ai][bj][m][1] * r2;
                        u32x4 w; w.x = cvt_pk_bf16(v0[0], v0[1]); w.y = cvt_pk_bf16(v0[2], v0[3]); w.z = cvt_pk_bf16(v1[0], v1[1]); w.w = cvt_pk_bf16(v1[2], v1[3]);
                        store16_wt(rowp + bj * HALF, w); } }
            return;
        }
#pragma unroll
        for (int ai = 0; ai < 2; ++ai)
#pragma unroll
            for (int m = 0; m < 4; ++m) { bf16_t* rowp = base + (size_t)(row0 + ai * HALF + m * 16) * ldc + col0;
#pragma unroll
                for (int bj = 0; bj < 2; ++bj) { f32x4 v0 = acc[ai][bj][m][0], v1 = acc[ai][bj][m][1];
                    if (RS) { v0 = v0 * rsc[ai][m]; v1 = v1 * rsc[ai][m]; }
                    if (ACT == 1) {
#pragma unroll
                        for (int e = 0; e < 4; ++e) { const float a = fmaxf(v0[e], 0.f), b = fmaxf(v1[e], 0.f); v0[e] = a * a; v1[e] = b * b; } }
                    u32x4 w; w.x = cvt_pk_bf16(v0[0], v0[1]); w.y = cvt_pk_bf16(v0[2], v0[3]); w.z = cvt_pk_bf16(v1[0], v1[1]); w.w = cvt_pk_bf16(v1[2], v1[3]);
                    store16_wt(rowp + bj * HALF, w); } }
    }
};

template <class Epi, class Prob, bool ALIGN_EPI, bool SP2>
__device__ __forceinline__ void gemm_phase(LAS unsigned char* lds, const Prob& P, const StaticOrder& S, const Epi& E) {
    int tid = threadIdx.x; asm volatile("" : "+v"(tid));
    const int wid = __builtin_amdgcn_readfirstlane(tid >> 6), lane = tid & 63, wr = wid >> 2, wc = wid & 3, fr = lane & 15, fq = lane >> 4;
    const int K = P.K, nt = K / BK;
    unsigned voffA[2], voffB[2];
#pragma unroll
    for (int i = 0; i < 2; ++i) { int R, C; stage_rc(tid * 16 + i * 8192, R, C); const int Rb = Epi::PERM ? ((R & ~31) + perm32(R & 31)) : R;
        voffA[i] = (unsigned)(R * K + C) * 2u; voffB[i] = (unsigned)(Rb * K + C) * 2u; }
    const size_t kstep = (size_t)(BK * 2);
    const size_t hstep = (size_t)HALF * K * 2;
    const unsigned ldsw = (unsigned)wid * 1024u;
    const int aoff = lds_byte(wr * 64 + fr, fq * 8), boff = lds_byte(wc * 32 + fr, fq * 8);
#define PG8_SA(b, h) (((b) * 2 + (h)) * HTB)
#define PG8_SB(b, h) ((4 + (b) * 2 + (h)) * HTB)
#define PG8_STAGE(bufoff, gbase, voff) do { _Pragma("unroll") for (int _i = 0; _i < 2; ++_i) \
        __builtin_amdgcn_global_load_lds((const unsigned*)((const char*)(gbase) + (voff)[_i]), (LAS unsigned*)(lds + (bufoff) + ldsw + _i * 8192), 16, 0, 0); } while (0)
#define PG8_LDA(dst, b, h) do { _Pragma("unroll") for (int m = 0; m < 4; ++m) _Pragma("unroll") for (int k = 0; k < 2; ++k) dst[m][k] = *(const LAS bf16x8*)(lds + PG8_SA(b, h) + aoff + m * 2048 + k * 1024); } while (0)
#define PG8_LDB(dst, b, h) do { _Pragma("unroll") for (int n = 0; n < 2; ++n) _Pragma("unroll") for (int k = 0; k < 2; ++k) dst[n][k] = *(const LAS bf16x8*)(lds + PG8_SB(b, h) + boff + n * 2048 + k * 1024); } while (0)
#define PG8_MMA(ai, bj, At, Bt) do { __builtin_amdgcn_s_setprio(1); _Pragma("unroll") for (int m = 0; m < 4; ++m) _Pragma("unroll") for (int n = 0; n < 2; ++n) _Pragma("unroll") for (int k = 0; k < 2; ++k) \
        acc[ai][bj][m][n] = __builtin_amdgcn_mfma_f32_16x16x32_bf16(Bt[n][k], At[m][k], acc[ai][bj][m][n], 0, 0, 0); __builtin_amdgcn_s_setprio(0); } while (0)
#define PG8_WAIT_V(n) asm volatile("s_waitcnt vmcnt(" #n ")" ::: "memory")
#define PG8_WAIT_L(n) asm volatile("s_waitcnt lgkmcnt(" #n ")" ::: "memory")
#define PG8_BAR __builtin_amdgcn_s_barrier()
#define PG8_SCHED __builtin_amdgcn_sched_barrier(0)
    Unit cur, nxt; int ui = 0;
    if (!S.next(0, cur)) return;
    f32x4 acc[2][2][4][2];
#pragma unroll
    for (int a = 0; a < 2; ++a)
#pragma unroll
        for (int b = 0; b < 2; ++b)
#pragma unroll
            for (int m = 0; m < 4; ++m)
#pragma unroll
                for (int n = 0; n < 2; ++n) acc[a][b][m][n] = (f32x4){0.f, 0.f, 0.f, 0.f};
    bf16x8 At[4][2], B0[2][2], B1[2][2];
    const char* cA = P.a_tile(cur); const char* cB = P.b_tile(cur);
    if constexpr (SP2) {
        PG8_STAGE(PG8_SB(0, 0), cB, voffB); PG8_STAGE(PG8_SB(0, 1), cB + hstep, voffB); PG8_STAGE(PG8_SA(0, 0), cA, voffA); PG8_STAGE(PG8_SA(0, 1), cA + hstep, voffA);
        if (wr == 1) PG8_BAR;
        PG8_WAIT_V(2); PG8_BAR;
        PG8_STAGE(PG8_SB(1, 0), cB + kstep, voffB); PG8_STAGE(PG8_SA(1, 0), cA + kstep, voffA); PG8_STAGE(PG8_SB(1, 1), cB + hstep + kstep, voffB);
        PG8_WAIT_V(6); PG8_BAR;
    } else {
        PG8_STAGE(PG8_SB(0, 0), cB, voffB); PG8_STAGE(PG8_SA(0, 0), cA, voffA); PG8_STAGE(PG8_SB(0, 1), cB + hstep, voffB); PG8_STAGE(PG8_SA(0, 1), cA + hstep, voffA);
        if (wr == 1) PG8_BAR;
        PG8_WAIT_V(4); PG8_BAR;
        PG8_STAGE(PG8_SB(1, 0), cB + kstep, voffB); PG8_STAGE(PG8_SA(1, 0), cA + kstep, voffA); PG8_STAGE(PG8_SB(1, 1), cB + hstep + kstep, voffB);
        PG8_WAIT_V(6); PG8_BAR;
    }
    for (;;) {
        const bool has_next = S.next(ui + 1, nxt);
        const char* nA = has_next ? P.a_tile(nxt) : cA; const char* nB = has_next ? P.b_tile(nxt) : cB;
        for (int t = 0; t < nt; t += 2) {
            const bool last = (t == nt - 2);
            const char* a1 = cA + (size_t)(t + 1) * kstep;
            const char* a2 = last ? nA : cA + (size_t)(t + 2) * kstep; const char* b2 = last ? nB : cB + (size_t)(t + 2) * kstep;
            const char* a3 = a2 + kstep; const char* b3 = b2 + kstep;
            if constexpr (SP2) {
            PG8_LDB(B0, 0, 0); PG8_LDB(B1, 0, 1); PG8_SCHED; PG8_LDA(At, 0, 0); PG8_STAGE(PG8_SA(1, 1), a1 + hstep, voffA);
            PG8_WAIT_V(8); PG8_WAIT_L(0); PG8_BAR; PG8_MMA(0, 0, At, B0); PG8_MMA(0, 1, At, B1); PG8_BAR; PG8_SCHED;
            PG8_LDA(At, 0, 1); PG8_STAGE(PG8_SB(0, 0), b2, voffB); PG8_STAGE(PG8_SB(0, 1), b2 + hstep, voffB); PG8_STAGE(PG8_SA(0, 0), a2, voffA);
            PG8_WAIT_V(8); PG8_WAIT_L(0); PG8_BAR; PG8_MMA(1, 0, At, B0); PG8_MMA(1, 1, At, B1); PG8_BAR; PG8_SCHED;
            PG8_LDB(B0, 1, 0); PG8_LDB(B1, 1, 1); PG8_SCHED; PG8_LDA(At, 1, 0); PG8_STAGE(PG8_SA(0, 1), a2 + hstep, voffA);
            PG8_WAIT_V(8); PG8_WAIT_L(0); PG8_BAR; PG8_MMA(0, 0, At, B0); PG8_MMA(0, 1, At, B1); PG8_BAR; PG8_SCHED;
            PG8_LDA(At, 1, 1); PG8_STAGE(PG8_SB(1, 0), b3, voffB); PG8_STAGE(PG8_SB(1, 1), b3 + hstep, voffB); PG8_STAGE(PG8_SA(1, 0), a3, voffA);
            PG8_WAIT_V(8); PG8_WAIT_L(0); PG8_BAR; PG8_MMA(1, 0, At, B0); PG8_MMA(1, 1, At, B1); PG8_BAR; PG8_SCHED;
            } else {
            PG8_LDB(B0, 0, 0); PG8_SCHED; PG8_LDA(At, 0, 0); PG8_STAGE(PG8_SA(1, 1), a1 + hstep, voffA);
            PG8_WAIT_L(8); PG8_BAR; PG8_WAIT_L(0); PG8_MMA(0, 0, At, B0); PG8_BAR; PG8_SCHED;
            PG8_LDB(B1, 0, 1); PG8_STAGE(PG8_SB(0, 0), b2, voffB);
            PG8_BAR; PG8_WAIT_L(0); PG8_MMA(0, 1, At, B1); PG8_BAR;
            PG8_LDA(At, 0, 1); PG8_STAGE(PG8_SA(0, 0), a2, voffA);
            PG8_BAR; PG8_WAIT_L(0); PG8_MMA(1, 0, At, B0); PG8_BAR; PG8_SCHED;
            PG8_STAGE(PG8_SB(0, 1), b2 + hstep, voffB);
            PG8_WAIT_V(6); PG8_BAR; PG8_MMA(1, 1, At, B1); PG8_BAR;
            PG8_LDB(B0, 1, 0); PG8_SCHED; PG8_LDA(At, 1, 0); PG8_STAGE(PG8_SA(0, 1), a2 + hstep, voffA);
            PG8_WAIT_L(8); PG8_BAR; PG8_WAIT_L(0); PG8_MMA(0, 0, At, B0); PG8_BAR; PG8_SCHED;
            PG8_LDB(B1, 1, 1); PG8_STAGE(PG8_SB(1, 0), b3, voffB);
            PG8_BAR; PG8_WAIT_L(0); PG8_MMA(0, 1, At, B1); PG8_BAR;
            PG8_LDA(At, 1, 1); PG8_STAGE(PG8_SA(1, 0), a3, voffA);
            PG8_BAR; PG8_WAIT_L(0); PG8_MMA(1, 0, At, B0); PG8_BAR; PG8_SCHED;
            PG8_STAGE(PG8_SB(1, 1), b3 + hstep, voffB);
            PG8_WAIT_V(6); PG8_BAR; PG8_MMA(1, 1, At, B1); PG8_BAR;
            }
        }
        if constexpr (ALIGN_EPI) { if (wr == 0) PG8_BAR; }
        E(acc, cur, wr, wc, fr, fq);
        if (!has_next) break;
#pragma unroll
        for (int a = 0; a < 2; ++a)
#pragma unroll
            for (int b = 0; b < 2; ++b)
#pragma unroll
                for (int m = 0; m < 4; ++m)
#pragma unroll
                    for (int n = 0; n < 2; ++n) acc[a][b][m][n] = (f32x4){0.f, 0.f, 0.f, 0.f};
        cur = nxt; cA = nA; cB = nB; ++ui;
        if constexpr (ALIGN_EPI) { if (wr == 1) PG8_BAR; }
    }
    PG8_WAIT_V(0);
    if constexpr (!ALIGN_EPI) { if (wr == 0) PG8_BAR; }
    PG8_BAR;
#undef PG8_SA
#undef PG8_SB
#undef PG8_STAGE
#undef PG8_LDA
#undef PG8_LDB
#undef PG8_MMA
#undef PG8_WAIT_V
#undef PG8_WAIT_L
#undef PG8_BAR
#undef PG8_SCHED
}
}

constexpr size_t MiB = 1u << 20;
constexpr size_t WS_CTL = 0, CTL_ZERO_BYTES = 64 * 1024;
constexpr size_t WS_W = 1 * MiB;
constexpr size_t WS_WIN_T = WS_W, WS_WOUT_T = WS_WIN_T + (size_t)DIN * D * 2, WS_W1_T = WS_WOUT_T + (size_t)D * D * 2, WS_W2_T = WS_W1_T + (size_t)DFF * D * 2;
constexpr size_t WS_WR_T = WS_W, WS_WK_T = WS_WR_T + 2 * MiB, WS_LDW_T = WS_WK_T + 2 * MiB, WS_WV_T = WS_LDW_T + 3 * MiB, WS_WO2_T = WS_WV_T + 2 * MiB, WS_W1B_T = WS_WO2_T + 4 * MiB, WS_W2B_T = WS_W1B_T + 8 * MiB;
static_assert(WS_W2_T + (size_t)D * DFF * 2 <= 31 * MiB && WS_W2B_T + (size_t)D * DFF * 2 <= 31 * MiB, "weight region");
constexpr size_t WS_XN = 31 * MiB, WS_QKV = 63 * MiB, WS_O = 135 * MiB, WS_OBR = 167 * MiB, WS_LSE = 215 * MiB, WS_TMP = 217 * MiB, WS_H = 63 * MiB;
constexpr size_t WS_MIXA = 63 * MiB, WS_MIXB = 95 * MiB, WS_R = 127 * MiB, WS_K = 159 * MiB, WS_V = 31 * MiB, WS_LDO = 191 * MiB, WS_Y = 63 * MiB, WS_LDA = 239 * MiB;
constexpr size_t WS_YSUM = 127 * MiB;
constexpr size_t WS_HBC = 191 * MiB, WS_TMP2 = 223 * MiB;
constexpr size_t WS_END = 256 * MiB;
static_assert(WS_HBC >= WS_H + (size_t)M * DFF * 2 && WS_HBC + (size_t)M * D * 2 <= WS_TMP2 && WS_TMP2 + (size_t)M * D * 2 <= WS_END, "layer-1 tail");
static_assert(WS_LDO + (size_t)M * NLD * 2 <= WS_LDA && WS_LDA + (size_t)M * 512 * 2 <= WS_END && WS_TMP + (size_t)M * D * 2 <= WS_END, "tail of the map");
static_assert(WS_MIXA == WS_XN + 32 * MiB && WS_MIXB == WS_XN + 64 * MiB && WS_K == WS_R + 32 * MiB && WS_LDO == WS_R + 64 * MiB && WS_WK_T == WS_WR_T + 2 * MiB && WS_LDW_T == WS_WR_T + 4 * MiB, "grouped GEMM strides");
constexpr int CW_BAR = 4096;

constexpr int RING_BYTES = 131072, LDSCTL_OFF = 143360, MISC_OFF = LDSCTL_OFF + 320, LDS_BYTES = 147456;

typedef __bf16 bf16x2_t __attribute__((ext_vector_type(2)));
__device__ __forceinline__ unsigned cvtpk(float lo, float hi) { const f32x2 v = {lo, hi}; const bf16x2_t b = __builtin_convertvector(v, bf16x2_t); return __builtin_bit_cast(unsigned, b); }
__device__ __forceinline__ float bf2f(unsigned short b) { return __uint_as_float((unsigned)b << 16); }
__device__ __forceinline__ float bflo(unsigned w) { return __uint_as_float(w << 16); }
__device__ __forceinline__ float bfhi(unsigned w) { return __uint_as_float(w & 0xffff0000u); }
__device__ __forceinline__ unsigned f2bf(float f) { unsigned u = __float_as_uint(f); return (u + 0x7fffu + ((u >> 16) & 1u)) >> 16; }
__device__ __forceinline__ unsigned pk2(float lo, float hi) { return f2bf(lo) | (f2bf(hi) << 16); }
__device__ __forceinline__ float wave_sum(float v) {
#pragma unroll
    for (int o = 1; o < 64; o <<= 1) v += __shfl_xor(v, o);
    return v;
}
__device__ __forceinline__ float sigmoidf_(float z) { return 1.f / (1.f + __expf(-z)); }
__device__ __forceinline__ int t5_bucket(int rel) {
    const int n = rel < 0 ? -rel : rel;
    int large;
    if (n < 8) large = n; else if (n < 15) large = 8; else if (n < 27) large = 9; else if (n < 50) large = 10; else if (n < 91) large = 11;
    else if (n < 166) large = 12; else if (n < 305) large = 13; else if (n < 559) large = 14; else large = 15;
    return (rel > 0 ? 16 : 0) + large;
}

#define XB_TMO      128
#define XB_XCNT(j)  (256  + 64 * (j))
#define XB_XSUB(j)  (1280 + 64 * (j))
#define XB_XGEN(j)  (2304 + 64 * (j))
#define XB_TOP      3328
#define XB_TOPGEN   3392
#define XCD_BAR_WORDS 3456
#define XB_SPIN_CAP (1u << 18)
__device__ __forceinline__ unsigned xb_ld(unsigned* p)              { return __hip_atomic_load(p, __ATOMIC_RELAXED, __HIP_MEMORY_SCOPE_AGENT); }
__device__ __forceinline__ unsigned xb_add(unsigned* p, unsigned v) { return __hip_atomic_fetch_add(p, v, __ATOMIC_RELAXED, __HIP_MEMORY_SCOPE_AGENT); }
__device__ __forceinline__ unsigned xb_xcc_id() { return (unsigned)__builtin_amdgcn_s_getreg((3 << 11) | 20) & 0xFu; }
#define XB_SPIN(cond, bar) do { unsigned _sp = 0; while (cond) { __builtin_amdgcn_s_sleep(1); \
    if ((++_sp & 255u) == 0u) { if (xb_ld(&(bar)[XB_TMO])) break; if (_sp > XB_SPIN_CAP) { atomicAdd(&(bar)[XB_TMO], 1u); break; } } } } while (0)
struct XcdBarrier { unsigned* bar; unsigned x; volatile LAS unsigned* st; };
__device__ __forceinline__ XcdBarrier xcd_barrier_post(unsigned* bar, volatile LAS unsigned* st) {
    XcdBarrier b; b.bar = bar; b.x = xb_xcc_id(); b.st = st;
    if (threadIdx.x == 0) (void)xb_add(&bar[XB_XCNT(b.x)], 1u);
    return b;
}
__device__ __forceinline__ void xcd_barrier_complete(unsigned* bar, unsigned x, unsigned& nloc, unsigned& nx) {
    const unsigned G = gridDim.x * gridDim.y * gridDim.z;
    unsigned sum, cnt, mine, sp = 0u;
    for (;;) {
        sum = 0u; cnt = 0u; mine = 0u;
#pragma unroll
        for (unsigned j = 0; j < 16; ++j) { const unsigned c = xb_ld(&bar[XB_XCNT(j)]); sum += c; cnt += (c > 0u) ? 1u : 0u; mine = (j == x) ? c : mine; }
        if (sum == G) break;
        __builtin_amdgcn_s_sleep(1);
        if ((++sp & 255u) == 0u) { if (xb_ld(&bar[XB_TMO])) break; if (sp > XB_SPIN_CAP) { atomicAdd(&bar[XB_TMO], 1u); break; } }
    }
    nloc = mine > 0u ? mine : 1u; nx = cnt > 0u ? cnt : 1u;
}
__device__ __forceinline__ void xcd_barrier(const XcdBarrier& b) {
    asm volatile("s_waitcnt vmcnt(0)" ::: "memory");
    __syncthreads();
    if (threadIdx.x == 0) {
        unsigned* bar = b.bar;
        __builtin_amdgcn_s_waitcnt(0);
        unsigned nloc = b.st[0], nx = b.st[1];
        if (nloc == 0u) { xcd_barrier_complete(bar, b.x, nloc, nx); b.st[0] = nloc; b.st[1] = nx; }
        const unsigned old = xb_add(&bar[XB_XSUB(b.x)], 1u);
        const unsigned gen = old / nloc;
        if (old + 1u == (gen + 1u) * nloc) {
            __builtin_amdgcn_fence(__ATOMIC_RELEASE, "agent");
            asm volatile("s_waitcnt vmcnt(0)" ::: "memory");
            const unsigned og = xb_add(&bar[XB_TOP], 1u);
            const unsigned tg = og / nx;
            if (og + 1u == (tg + 1u) * nx) xb_add(&bar[XB_TOPGEN], 1u);
            else XB_SPIN(xb_ld(&bar[XB_TOPGEN]) == tg, bar);
            __builtin_amdgcn_fence(__ATOMIC_ACQUIRE, "agent");
            xb_add(&bar[XB_XGEN(b.x)], 1u);
            asm volatile("s_waitcnt vmcnt(0)" ::: "memory");
        } else {
            XB_SPIN(xb_ld(&bar[XB_XGEN(b.x)]) == gen, bar);
            __builtin_amdgcn_fence(__ATOMIC_ACQUIRE, "agent");
            asm volatile("s_waitcnt vmcnt(0)" ::: "memory");
        }
    }
    __syncthreads();
}

#define XB_GRP(g)   (4096 + 16 * (g))
__device__ __forceinline__ void grp_barrier(unsigned* bar, unsigned g, unsigned& epoch) {
    asm volatile("s_waitcnt vmcnt(0)" ::: "memory");
    __syncthreads();
    ++epoch;
    if (threadIdx.x == 0) {
        unsigned* word = &bar[XB_GRP(g)];
        (void)xb_add(word, 1u);
        const unsigned tgt = 4u * epoch;
        XB_SPIN(xb_ld(word) < tgt, bar);
        __builtin_amdgcn_fence(__ATOMIC_ACQUIRE, "agent");
        asm volatile("s_waitcnt vmcnt(0)" ::: "memory");
    }
    __syncthreads();
}

struct Row16 { f32x4 v[4]; };
__device__ __forceinline__ int row_q(int lane, int j) { return 2 * lane + 128 * (j >> 1) + (j & 1); }
__device__ __forceinline__ void row_load_f32(Row16& r, const float* p, int lane) {
#pragma unroll
    for (int j = 0; j < 4; ++j) r.v[j] = ((const f32x4*)p)[row_q(lane, j)];
}
struct RowRaw { u32x4 w[2]; };
__device__ __forceinline__ void row_raw_load(RowRaw& r, const bf16_t* p, int lane) { r.w[0] = ((const u32x4*)p)[lane]; r.w[1] = ((const u32x4*)p)[lane + 64]; }
__device__ __forceinline__ void row_from_raw(Row16& r, const RowRaw& q) {
#pragma unroll
    for (int b = 0; b < 2; ++b) { const u32x4 w = q.w[b]; r.v[2 * b] = (f32x4){bflo(w.x), bfhi(w.x), bflo(w.y), bfhi(w.y)}; r.v[2 * b + 1] = (f32x4){bflo(w.z), bfhi(w.z), bflo(w.w), bfhi(w.w)}; }
}
__device__ __forceinline__ void row_load_bf16(Row16& r, const bf16_t* p, int lane) { RowRaw q; row_raw_load(q, p, lane); row_from_raw(r, q); }
__device__ __forceinline__ void row_store_f32(const Row16& r, float* p, int lane) {
#pragma unroll
    for (int j = 0; j < 4; ++j) pg8::store16_wt((f32x4*)p + row_q(lane, j), __builtin_bit_cast(u32x4, r.v[j]));
}
__device__ __forceinline__ void row_store_bf16(const Row16& r, bf16_t* p, int lane) {
#pragma unroll
    for (int b = 0; b < 2; ++b) { u32x4 w; w.x = cvtpk(r.v[2 * b][0], r.v[2 * b][1]); w.y = cvtpk(r.v[2 * b][2], r.v[2 * b][3]); w.z = cvtpk(r.v[2 * b + 1][0], r.v[2 * b + 1][1]); w.w = cvtpk(r.v[2 * b + 1][2], r.v[2 * b + 1][3]);
        pg8::store16_wt((u32x4*)p + lane + 64 * b, w); }
}
__device__ __forceinline__ void vec_load(Row16& r, const float* g, int lane) { row_load_f32(r, g, lane); }
__device__ __forceinline__ void row_rmsnorm_v(Row16& r, const Row16& g) {
    float s = 0.f;
#pragma unroll
    for (int j = 0; j < 4; ++j) s += r.v[j][0] * r.v[j][0] + r.v[j][1] * r.v[j][1] + r.v[j][2] * r.v[j][2] + r.v[j][3] * r.v[j][3];
    const float rs = rsqrtf(wave_sum(s) * (1.f / D) + NORM_EPS);
#pragma unroll
    for (int j = 0; j < 4; ++j) r.v[j] = r.v[j] * rs * g.v[j];
}
__device__ __forceinline__ void row_rmsnorm(Row16& r, const float* g, int lane) { Row16 gg; vec_load(gg, g, lane); row_rmsnorm_v(r, gg); }

constexpr int TR_SCR_BYTES = 64 * 65 * 4;
template <class ScaleFn>
__device__ __forceinline__ void transpose_item(const float* W, int ldw, int N, bf16_t* WT, int ldt, int row_off, int koff, LAS float* scr, int item, int lane, ScaleFn sc) {
    const int nblk = N / 64, kb = item / nblk, nb = item % nblk, k0 = 64 * kb, n0 = 64 * nb;
    const int lk = lane >> 4, ln4 = (lane & 15) * 4;
    f32x4 v[16];
#pragma unroll
    for (int i = 0; i < 16; ++i) v[i] = *(const f32x4*)(W + (size_t)(k0 + 4 * i + lk) * ldw + n0 + ln4);
#pragma unroll
    for (int i = 0; i < 16; ++i) { const int kk = 4 * i + lk; const float s = sc(k0 + kk); LAS float* d = scr + kk * 65 + ln4; d[0] = v[i][0] * s; d[1] = v[i][1] * s; d[2] = v[i][2] * s; d[3] = v[i][3] * s; }
    asm volatile("s_waitcnt lgkmcnt(0)" ::: "memory");
    const int c = lane >> 3, nn = lane & 7;
#pragma unroll
    for (int j = 0; j < 8; ++j) { const int n = nn + 8 * j; const LAS float* s = scr + (8 * c) * 65 + n;
        u32x4 o; o.x = cvtpk(s[0 * 65], s[1 * 65]); o.y = cvtpk(s[2 * 65], s[3 * 65]); o.z = cvtpk(s[4 * 65], s[5 * 65]); o.w = cvtpk(s[6 * 65], s[7 * 65]);
        pg8::store16_wt(WT + (size_t)(row_off + n0 + n) * ldt + koff + k0 + 8 * c, o); }
    asm volatile("s_waitcnt lgkmcnt(0)" ::: "memory");
}
struct ScaleOne { __device__ __forceinline__ float operator()(int) const { return 1.f; } };
struct ScaleVec { const float* g; __device__ __forceinline__ float operator()(int k) const { return g[k]; } };
struct ScaleMix { const float* mp; const float* mn; int part;
    __device__ __forceinline__ float operator()(int k) const { return part == 0 ? 1.f - mp[k] - mn[k] : (part == 1 ? mp[k] : mn[k]); } };

struct Args { const float* in[27]; float* out; unsigned char* ws; };

struct ProbPlain { const bf16_t* A; const bf16_t* Bt; int K;
    __device__ __forceinline__ const char* a_tile(const pg8::Unit& u) const { return (const char*)(A + (size_t)u.pm * 256 * K); }
    __device__ __forceinline__ const char* b_tile(const pg8::Unit& u) const { return (const char*)(Bt + (size_t)u.pn * 256 * K); } };
struct DstPlain { bf16_t* C; int ldc;
    __device__ __forceinline__ void operator()(const pg8::Unit& u, bf16_t*& base, int& ld) const { base = C + (size_t)u.pm * 256 * ldc + (size_t)u.pn * 256; ld = ldc; } };
struct ProbRKL { const unsigned char* ws; int K;
    __device__ __forceinline__ const char* a_tile(const pg8::Unit& u) const { const int g = u.pn < 4 ? 0 : (u.pn < 8 ? 1 : 2); const int ga = g == 2 ? 0 : g + 1;
        return (const char*)(ws + WS_XN + (size_t)ga * (32 * MiB) + (size_t)u.pm * 256 * D * 2); }
    __device__ __forceinline__ const char* b_tile(const pg8::Unit& u) const { const int g = u.pn < 4 ? 0 : (u.pn < 8 ? 1 : 2); const int t = u.pn - 4 * g;
        return (const char*)(ws + WS_WR_T + (size_t)g * (2 * MiB) + (size_t)t * 256 * D * 2); } };
struct DstRKL { unsigned char* ws;
    __device__ __forceinline__ void operator()(const pg8::Unit& u, bf16_t*& base, int& ld) const {
        const int g = u.pn < 4 ? 0 : (u.pn < 8 ? 1 : 2); const int t = u.pn - 4 * g; ld = g == 2 ? NLD : D;
        base = (bf16_t*)(ws + WS_R + (size_t)g * (32 * MiB)) + (size_t)u.pm * 256 * ld + (size_t)t * 256; } };


struct EpiHeadMajor {
    static constexpr bool PERM = true;
    bf16_t* O;
    __device__ __forceinline__ void operator()(const f32x4 (&acc)[2][2][4][2], const pg8::Unit& u, int wr, int wc, int fr, int fq) const {
        const int row0 = u.pm * 256 + wr * 64 + fr, col = (wc & 1) * 32 + 8 * fq;
#pragma unroll
        for (int bj = 0; bj < 2; ++bj) { bf16_t* hb = O + ((size_t)(u.pn * 4 + bj * 2 + (wc >> 1)) * M + row0) * 64 + col;
#pragma unroll
            for (int ai = 0; ai < 2; ++ai)
#pragma unroll
                for (int m = 0; m < 4; ++m) { const f32x4 v0 = acc[ai][bj][m][0], v1 = acc[ai][bj][m][1];
                    u32x4 w; w.x = cvtpk(v0[0], v0[1]); w.y = cvtpk(v0[2], v0[3]); w.z = cvtpk(v1[0], v1[1]); w.w = cvtpk(v1[2], v1[3]);
                    pg8::store16_wt(hb + (size_t)(ai * 128 + m * 16) * 64, w); } }
    }
};

template <int ACT, class Prob, class Dst>
__device__ __forceinline__ void run_gemm(LAS unsigned char* lds, const Prob& P, const Dst& Dd, int Mr, int Nv, int G) {
    pg8::StaticOrder S; S.init(Mr, Nv, G, (int)blockIdx.x);
    pg8::EpiBf16<ACT, Dst> E{Dd, nullptr};
    for (int rep = 0; rep < REP_GEMM; ++rep) pg8::gemm_phase<pg8::EpiBf16<ACT, Dst>, Prob, true, true>(lds, P, S, E);
}
template <int ACT, class Prob, class Dst>
__device__ __forceinline__ void run_gemm_rs(LAS unsigned char* lds, const Prob& P, const Dst& Dd, const float* rs, int Mr, int Nv, int G) {
    pg8::StaticOrder S; S.init(Mr, Nv, G, (int)blockIdx.x);
    pg8::EpiBf16<ACT, Dst, true> E{Dd, rs};
    pg8::gemm_phase<pg8::EpiBf16<ACT, Dst, true>, Prob, true, true>(lds, P, S, E);
}

template <bool BASE_F32, bool OUT_F32>
__device__ __forceinline__ void phase_resnorm(const void* base, const bf16_t* TMP, const float* g1, const float* g2, void* hout, bf16_t* XN, float* rs_out, int gw, int NGW, int lane) {
    Row16 G1, G2; vec_load(G1, g1, lane); if (XN) vec_load(G2, g2, lane);
    for (int row = gw; row < M; row += NGW) {
        Row16 t, b; row_load_bf16(t, TMP + (size_t)row * D, lane);
        if (BASE_F32) row_load_f32(b, (const float*)base + (size_t)row * D, lane); else row_load_bf16(b, (const bf16_t*)base + (size_t)row * D, lane);
        row_rmsnorm_v(t, G1);
#pragma unroll
        for (int j = 0; j < 4; ++j) b.v[j] = b.v[j] + t.v[j];
        if (OUT_F32) row_store_f32(b, (float*)hout + (size_t)row * D, lane); else row_store_bf16(b, (bf16_t*)hout + (size_t)row * D, lane);
        if (XN) { row_rmsnorm_v(b, G2); row_store_bf16(b, XN + (size_t)row * D, lane); }
        if (rs_out) {
            float s = 0.f;
#pragma unroll
            for (int j = 0; j < 4; ++j) s += b.v[j][0] * b.v[j][0] + b.v[j][1] * b.v[j][1] + b.v[j][2] * b.v[j][2] + b.v[j][3] * b.v[j][3];
            const float rsv = rsqrtf(wave_sum(s) * (1.f / D) + NORM_EPS);
            if (lane == 0) rs_out[row] = rsv; }
    }
}
__device__ __forceinline__ void phase_lda(const bf16_t* LDO, bf16_t* LDA, int gw, int NGW, int lane) {
    const float A = lane < 16 ? 2.f : 1.f, C = lane < 16 ? -1.f : 0.f; const bool id = lane >= 16 && lane < 32;
    for (int row = gw; row < M; row += NGW) { const int tt = row & (SEQ - 1);
        const u32x4 p0 = *(const u32x4*)(LDO + (size_t)row * NLD + 8 * lane);
        const u32x4 p1 = *(const u32x4*)(LDO + (size_t)(tt > 0 ? row - 1 : row) * NLD + 512 + 8 * lane), p2 = *(const u32x4*)(LDO + (size_t)(tt < SEQ - 1 ? row + 1 : row) * NLD + 1024 + 8 * lane);
        const float mp = tt > 0 ? 1.f : 0.f, mn = tt < SEQ - 1 ? 1.f : 0.f;
        u32x4 o;
#pragma unroll
        for (int w = 0; w < 4; ++w) { const float x0 = bflo(p0[w]) + mp * bflo(p1[w]) + mn * bflo(p2[w]), x1 = bfhi(p0[w]) + mp * bfhi(p1[w]) + mn * bfhi(p2[w]);
            const float y0 = A * __builtin_amdgcn_rcpf(1.f + __builtin_amdgcn_exp2f(-1.4426950408889634f * A * x0)) + C, y1 = A * __builtin_amdgcn_rcpf(1.f + __builtin_amdgcn_exp2f(-1.4426950408889634f * A * x1)) + C;
            o[w] = cvtpk(id ? x0 : y0, id ? x1 : y1); }
        pg8::store16_wt(LDA + (size_t)row * 512 + 8 * lane, o); }
}
__device__ __forceinline__ void mix_out(const Row16& up, const Row16& u, const Row16& un, const LAS f32x4* a, const LAS f32x4* b, bf16_t* dst, int lane) {
    Row16 o;
#pragma unroll
    for (int j = 0; j < 4; ++j) { const f32x4 av = a[j * 64 + lane], bv = b[j * 64 + lane]; o.v[j] = u.v[j] + (up.v[j] - u.v[j]) * av + (un.v[j] - u.v[j]) * bv; }
    row_store_bf16(o, dst, lane);
}
__device__ __forceinline__ void phase_mix3(LAS unsigned char* lds, const bf16_t* h, const float* g, const float* mup, const float* mun, bf16_t* XN, bf16_t* MR, bf16_t* MK, bf16_t* MV, int gw, int NGW, int tid, int lane) {
    LAS f32x4* mv = (LAS f32x4*)lds;
    __syncthreads();
    for (int x = tid; x < 6 * 256; x += NTHREADS) { const int vec = x >> 8, q = x & 255, c = vec < 2 ? 0 : (vec < 4 ? 2 : 3);
        const f32x4 val = ((const f32x4*)(((vec & 1) ? mun : mup) + c * D))[q];
        mv[vec * 256 + (2 * (q >> 7) + (q & 1)) * 64 + ((q & 127) >> 1)] = val; }
    __syncthreads();
    Row16 Gn; vec_load(Gn, g, lane);
    for (int ch = gw; ch < M / 8; ch += NGW) {
        const int r0 = ch * 8, t0 = r0 & (SEQ - 1);
        const bool hasp = t0 > 0, hasn = t0 + 8 < SEQ;
        const int rlast = hasn ? r0 + 8 : r0 + 7;
        RowRaw r0w, rA, rB, rC;
        row_raw_load(r0w, h + (size_t)(hasp ? r0 - 1 : r0) * D, lane);
        row_raw_load(rA, h + (size_t)r0 * D, lane); row_raw_load(rB, h + (size_t)(r0 + 1) * D, lane); row_raw_load(rC, h + (size_t)(r0 + 2) * D, lane);
        Row16 up, u, un;
        row_from_raw(up, r0w); row_rmsnorm_v(up, Gn);
        { const float m = hasp ? 1.f : 0.f;
#pragma unroll
          for (int j = 0; j < 4; ++j) up.v[j] = up.v[j] * m; }
        row_from_raw(u, rA); row_rmsnorm_v(u, Gn);
        rA = rB; rB = rC;
#pragma unroll 1
        for (int k = 1; k <= 8; ++k) {
            const int row = r0 - 1 + k;
            { const int nx = row + 3; row_raw_load(rC, h + (size_t)(nx < rlast ? nx : rlast) * D, lane); }
            row_from_raw(un, rA); row_rmsnorm_v(un, Gn);
            { const float m = (k == 8 && !hasn) ? 0.f : 1.f;
#pragma unroll
              for (int j = 0; j < 4; ++j) un.v[j] = un.v[j] * m; }
            row_store_bf16(u, XN + (size_t)row * D, lane);
            mix_out(up, u, un, mv, mv + 256, MR + (size_t)row * D, lane);
            mix_out(up, u, un, mv + 512, mv + 768, MK + (size_t)row * D, lane);
            mix_out(up, u, un, mv + 1024, mv + 1280, MV + (size_t)row * D, lane);
            up = u; u = un; rA = rB; rB = rC;
        }
    }
}

constexpr int ATT_ROWS = 400, ATT_KS = 0, ATT_VS = ATT_ROWS * 128, ATT_TAB = 2 * ATT_ROWS * 128, ATT_TABN = 320;
constexpr float LOG2E = 1.4426950408889634f;
typedef short v4i16_t __attribute__((ext_vector_type(4)));
__device__ __forceinline__ v4i16_t lds_tr16(LAS const unsigned char* p) { return __builtin_amdgcn_ds_read_tr16_b64_v4i16((LAS v4i16_t*)p); }

__device__ __forceinline__ float fmax_q(float a, float b) { return __builtin_amdgcn_fmed3f(a, b, __builtin_inff()); }
__device__ __forceinline__ float rows_max(float x) {
    auto a = __builtin_amdgcn_permlane16_swap(__float_as_uint(x), __float_as_uint(x), false, false); x = fmax_q(__uint_as_float(a[0]), __uint_as_float(a[1]));
    auto b = __builtin_amdgcn_permlane32_swap(__float_as_uint(x), __float_as_uint(x), false, false); return fmax_q(__uint_as_float(b[0]), __uint_as_float(b[1])); }
__device__ __forceinline__ float rows_sum(float x) {
    auto a = __builtin_amdgcn_permlane16_swap(__float_as_uint(x), __float_as_uint(x), false, false); x = __uint_as_float(a[0]) + __uint_as_float(a[1]);
    auto b = __builtin_amdgcn_permlane32_swap(__float_as_uint(x), __float_as_uint(x), false, false); return __uint_as_float(b[0]) + __uint_as_float(b[1]); }
struct AttnIO { const bf16_t* QKV; const float* rel_table; const float* sink; bf16_t* O; bf16_t* OBR; float* LSE; };
struct AttnUnitD { int b, dil, res, l0, nq, L, R, colK, colV, head0, ngroups, nit, branch, isB; };
__device__ __forceinline__ AttnUnitD attn_decode(int u) {
    AttnUnitD A;
    if (u < 256) { A.isB = 1; A.b = u >> 5; const int kvg = (u >> 4) & 1, blk = u & 15; A.dil = 1; A.res = 0; A.l0 = blk * 128; A.nq = 128; A.L = SEQ; A.R = 128; A.colK = 32 + kvg; A.colV = 34 + kvg; A.head0 = kvg * 4; A.ngroups = 32; A.nit = 9; A.branch = 0; }
    else if (u < 1280) { A.isB = 0; const int a = u - 256, bh = a >> 4, k = a & 15; A.b = bh >> 3; A.head0 = bh & 7; A.nq = 256; A.R = 64; A.ngroups = 16; A.nit = 5;
        if (k < 8) { A.dil = 1; A.res = 0; A.l0 = k * 256; A.L = SEQ; A.branch = 0; } else { A.dil = 4; A.res = (k - 8) >> 1; A.l0 = ((k - 8) & 1) * 256; A.L = SEQ / 4; A.branch = 1; }
        A.colK = 8 + A.head0; A.colV = 16 + A.head0; }
    else { A.isB = 0; const int a = u - 1280, bh = a >> 4; A.b = bh >> 3; A.head0 = bh & 7; A.dil = 16; A.res = a & 15; A.l0 = 0; A.nq = 128; A.L = SEQ / 16; A.R = 64; A.ngroups = 8; A.nit = 5; A.branch = 2; A.colK = 8 + A.head0; A.colV = 16 + A.head0; }
    return A;
}
constexpr int ATT_NST = 7;
__device__ __forceinline__ void attn_issue(const AttnUnitD& A, const bf16_t* QKV, int tid, u32x4 (&kr)[ATT_NST], u32x4 (&vr)[ATT_NST]) {
    const int ndata = A.nq + 2 * A.R, rv0 = (A.R - A.l0) > 0 ? (A.R - A.l0) : 0, rv1 = (A.L + A.R - A.l0) < ndata ? (A.L + A.R - A.l0) : ndata;
    const bf16_t* kb = QKV + ((size_t)A.colK * M + (size_t)A.b * SEQ) * 64; const bf16_t* vb = QKV + ((size_t)A.colV * M + (size_t)A.b * SEQ) * 64;
#pragma unroll
    for (int i = 0; i < ATT_NST; ++i) { const int x = tid + NTHREADS * i, c = x & 7; int row = x >> 3; row = row < rv0 ? rv0 : (row >= rv1 ? rv1 - 1 : row);
        const size_t o = (size_t)(A.res + A.dil * (A.l0 - A.R + row)) * 64 + c * 8; kr[i] = *(const u32x4*)(kb + o); vr[i] = *(const u32x4*)(vb + o); }
}

__device__ __forceinline__ void phase_attn(LAS unsigned char* lds, const AttnIO& io, int vcu, int G) {
    int tid = threadIdx.x; asm volatile("" : "+v"(tid));
    const int lane = tid & 63, wid = __builtin_amdgcn_readfirstlane(tid >> 6), g4 = lane >> 4, qi = lane & 15;
    LAS unsigned char* Ks = lds + ATT_KS; LAS unsigned char* Vs = lds + ATT_VS; LAS float* tab = (LAS float*)(lds + ATT_TAB);
    constexpr int NU = 256 + 1024 + 1024;
    u32x4 kr[ATT_NST], vr[ATT_NST];
    if (vcu < NU) { const AttnUnitD A0 = attn_decode(vcu); attn_issue(A0, io.QKV, tid, kr, vr); }
    for (int u = vcu; u < NU; u += G) {
        const AttnUnitD A = attn_decode(u);
        const int b = A.b, dil = A.dil, res = A.res, l0 = A.l0, R = A.R, head0 = A.head0, ngroups = A.ngroups, nit = A.nit, branch = A.branch; const bool isB = A.isB != 0;
        const int ndata = A.nq + 2 * R, rv0 = (R - l0) > 0 ? (R - l0) : 0, rv1 = (A.L + R - l0) < ndata ? (A.L + R - l0) : ndata;
        auto qptr = [&](int gx) -> const bf16_t* { const int hq_ = isB ? (gx >> 3) : 0, gi_ = isB ? (gx & 7) : gx; const int posq_ = res + dil * (l0 + 16 * gi_ + qi);
            return io.QKV + ((size_t)((isB ? 24 : 0) + head0 + hq_) * M + (size_t)b * SEQ + posq_) * 64 + 8 * g4; };
        u32x4 qr0, qr1; { const bf16_t* qp0 = qptr(wid); qr0 = *(const u32x4*)qp0; qr1 = *(const u32x4*)(qp0 + 32); }
        for (int reps = 0; reps < REP_ATTS; ++reps) {
        __syncthreads();
#pragma unroll
        for (int i = 0; i < ATT_NST; ++i) { const int x = tid + NTHREADS * i, row = x >> 3, c = x & 7;
            if (x < ATT_ROWS * 8) { const int off = row * 128 + ((c ^ (row & 7)) << 4); const bool ok = row >= rv0 && row < rv1; const u32x4 z = (u32x4){0u, 0u, 0u, 0u};
                *(LAS u32x4*)(Ks + off) = ok ? kr[i] : z; *(LAS u32x4*)(Vs + off) = ok ? vr[i] : z; } }
        { const int ntab = isB ? 4 : 1;
          for (int x = tid; x < ntab * ATT_TABN; x += NTHREADS) { const int t = x / ATT_TABN, j = x % ATT_TABN, idx = j - 16;
              float v = -1e30f;
              if (idx >= 0 && idx <= 2 * R) v = io.rel_table[t5_bucket((idx - R) * dil) * 16 + (isB ? 8 + head0 + t : head0)] * LOG2E;
              tab[x] = v; } }
        }
        if (u + G < NU) { const AttnUnitD An = attn_decode(u + G); attn_issue(An, io.QKV, tid, kr, vr); }
        __syncthreads();
        for (int rep = 0; rep < REP_ATTC; ++rep)
        for (int gidx = wid; gidx < ngroups; gidx += NWAVES) {
            const int hq = isB ? (gidx >> 3) : 0, gi = isB ? (gidx & 7) : gidx, head = head0 + hq;
            const int ql = 16 * gi + qi, posq = res + dil * (l0 + ql);
            const LAS float* tb = tab + hq * ATT_TABN + 16;
            bf16x8 qf[2];
            { const u32x4 wq[2] = {qr0, qr1}; const float SC = 0.125f * LOG2E;
              { const int gn = gidx + NWAVES < ngroups ? gidx + NWAVES : gidx; const bf16_t* qpn = qptr(gn); qr0 = *(const u32x4*)qpn; qr1 = *(const u32x4*)(qpn + 32); }
#pragma unroll
              for (int ks = 0; ks < 2; ++ks) { const u32x4 w = wq[ks]; u32x4 o;
                  o.x = cvtpk(bflo(w.x) * SC, bfhi(w.x) * SC); o.y = cvtpk(bflo(w.y) * SC, bfhi(w.y) * SC); o.z = cvtpk(bflo(w.z) * SC, bfhi(w.z) * SC); o.w = cvtpk(bflo(w.w) * SC, bfhi(w.w) * SC);
                  qf[ks] = __builtin_bit_cast(bf16x8, o); } }
            f32x4 ot[4], lacc = (f32x4){0.f, 0.f, 0.f, 0.f};
#pragma unroll
            for (int dt = 0; dt < 4; ++dt) ot[dt] = (f32x4){0.f, 0.f, 0.f, 0.f};
            float m = -1e20f;
            const bf16x8 ones = __builtin_bit_cast(bf16x8, qi == 0 ? (u32x4){0x3F803F80u, 0x3F803F80u, 0x3F803F80u, 0x3F803F80u} : (u32x4){0u, 0u, 0u, 0u});
            bf16x8 kf[2][2];
            const LAS unsigned char* kp[2];
            { const int r0 = 16 * gi + qi;
#pragma unroll
              for (int ks = 0; ks < 2; ++ks) { const int c = g4 + 4 * ks; kp[ks] = Ks + r0 * 128 + ((c ^ (r0 & 7)) << 4); asm volatile("" : "+v"(kp[ks]));
                  kf[ks][0] = *(const LAS bf16x8*)(kp[ks]); kf[ks][1] = *(const LAS bf16x8*)(kp[ks] + 16 * 128); } }
            const LAS unsigned char* vp[4];
            { const int ra0 = 16 * gi + 4 * g4 + (qi >> 2);
#pragma unroll
              for (int dt = 0; dt < 4; ++dt) { const int ch = dt * 2 + ((qi & 3) >> 1); vp[dt] = Vs + ra0 * 128 + ((ch ^ (ra0 & 7)) << 4) + 8 * (qi & 1); asm volatile("" : "+v"(vp[dt])); } }
            const LAS float* tbq = tb + 4 * g4 - qi; asm volatile("" : "+v"(tbq));
            f32x4 c0, c1;
#pragma unroll
            for (int r = 0; r < 4; ++r) { c0[r] = tbq[r]; c1[r] = tbq[16 + r]; }
            for (int it = 0; it < nit; ++it) {
                const int rb = 16 * gi + 32 * it;
                v4i16_t vlo[4], vhi[4];
#pragma unroll
                for (int dt = 0; dt < 4; ++dt) { vlo[dt] = lds_tr16(vp[dt]); vhi[dt] = lds_tr16(vp[dt] + 16 * 128); vp[dt] += 4096; }
                f32x4 s0 = c0, s1 = c1;
#pragma unroll
                for (int ks = 0; ks < 2; ++ks) { s0 = __builtin_amdgcn_mfma_f32_16x16x32_bf16(kf[ks][0], qf[ks], s0, 0, 0, 0); s1 = __builtin_amdgcn_mfma_f32_16x16x32_bf16(kf[ks][1], qf[ks], s1, 0, 0, 0); }
                if (it + 1 < nit) {
#pragma unroll
                    for (int ks = 0; ks < 2; ++ks) { kp[ks] += 4096; kf[ks][0] = *(const LAS bf16x8*)(kp[ks]); kf[ks][1] = *(const LAS bf16x8*)(kp[ks] + 16 * 128); } }
                tbq += 32;
#pragma unroll
                for (int r = 0; r < 4; ++r) { c0[r] = tbq[r]; c1[r] = tbq[16 + r]; }
                float v[8];
                if (rb < rv0 || rb + 32 > rv1) {
#pragma unroll
                    for (int r = 0; r < 4; ++r) { const int row0 = rb + 4 * g4 + r, row1 = row0 + 16;
                        const bool ok0 = (unsigned)(row0 - rv0) < (unsigned)(rv1 - rv0), ok1 = (unsigned)(row1 - rv0) < (unsigned)(rv1 - rv0);
                        v[r] = ok0 ? s0[r] : -1e30f; v[4 + r] = ok1 ? s1[r] : -1e30f; }
                } else {
#pragma unroll
                    for (int r = 0; r < 4; ++r) { v[r] = s0[r]; v[4 + r] = s1[r]; }
                }
                float d[8];
#pragma unroll
                for (int i = 0; i < 8; ++i) d[i] = v[i] - m;
                const float dm = fmaxf(fmaxf(fmaxf(d[0], d[1]), fmaxf(d[2], d[3])), fmaxf(fmaxf(d[4], d[5]), fmaxf(d[6], d[7])));
                if (__builtin_amdgcn_ballot_w64(dm > 8.f) != 0ull) {
                    float tmax = fmaxf(fmaxf(fmaxf(v[0], v[1]), fmaxf(v[2], v[3])), fmaxf(fmaxf(v[4], v[5]), fmaxf(v[6], v[7])));
                    tmax = rows_max(tmax);
                    const float mn = fmaxf(m, tmax), alpha = __builtin_amdgcn_exp2f(m - mn); m = mn;
                    lacc[0] = lacc[0] * alpha;
#pragma unroll
                    for (int dt = 0; dt < 4; ++dt) ot[dt] = ot[dt] * alpha;
#pragma unroll
                    for (int i = 0; i < 8; ++i) d[i] = v[i] - mn;
                }
#pragma unroll
                for (int i = 0; i < 8; ++i) v[i] = __builtin_amdgcn_exp2f(d[i]);
                u32x4 pw; pw.x = cvtpk(v[0], v[1]); pw.y = cvtpk(v[2], v[3]); pw.z = cvtpk(v[4], v[5]); pw.w = cvtpk(v[6], v[7]);
                const bf16x8 pf = __builtin_bit_cast(bf16x8, pw);
                lacc = __builtin_amdgcn_mfma_f32_16x16x32_bf16(ones, pf, lacc, 0, 0, 0);
#pragma unroll
                for (int dt = 0; dt < 4; ++dt) { const bf16x8 vf = (bf16x8){vlo[dt][0], vlo[dt][1], vlo[dt][2], vlo[dt][3], vhi[dt][0], vhi[dt][1], vhi[dt][2], vhi[dt][3]};
                    ot[dt] = __builtin_amdgcn_mfma_f32_16x16x32_bf16(vf, pf, ot[dt], 0, 0, 0); }
            }
            float lsum = lacc[0];
            lsum = rows_sum(lsum);
            const size_t tok = (size_t)b * SEQ + posq;
            float scale;
            if (isB) { const float s2 = io.sink[head] * LOG2E, mf = fmaxf(m, s2), e = __builtin_amdgcn_exp2f(m - mf); scale = e / (lsum * e + __builtin_amdgcn_exp2f(s2 - mf)); }
            else { scale = 1.f / lsum; if (g4 == 0) io.LSE[((size_t)branch * M + tok) * 8 + head] = m + __builtin_amdgcn_logf(lsum); }
            bf16_t* op = isB ? io.O + tok * D + 512 + head * 64 : io.OBR + ((size_t)branch * M + tok) * 512 + head * 64;
#pragma unroll
            for (int dt = 0; dt < 4; ++dt) { const f32x4 o = ot[dt] * scale; u32x2 w; w.x = cvtpk(o[0], o[1]); w.y = cvtpk(o[2], o[3]); *(u32x2*)(op + dt * 16 + 4 * g4) = w; }
        }
    }
}
__device__ __forceinline__ void phase_attn_merge(const AttnIO& io, int gtid, int NGT) {
    for (int x = gtid; x < M * 64; x += NGT) { const int tok = x >> 6, head = (x >> 3) & 7, c8 = x & 7;
        const float l0 = io.LSE[((size_t)0 * M + tok) * 8 + head], l1 = io.LSE[((size_t)1 * M + tok) * 8 + head], l2 = io.LSE[((size_t)2 * M + tok) * 8 + head];
        const float mx = fmaxf(l0, fmaxf(l1, l2)); float w0 = __builtin_amdgcn_exp2f(l0 - mx), w1 = __builtin_amdgcn_exp2f(l1 - mx), w2 = __builtin_amdgcn_exp2f(l2 - mx);
        const float inv = 1.f / (w0 + w1 + w2); w0 *= inv; w1 *= inv; w2 *= inv;
        const size_t o = (size_t)tok * 512 + head * 64 + c8 * 8;
        const u32x4 a = *(const u32x4*)(io.OBR + o), bq = *(const u32x4*)(io.OBR + (size_t)M * 512 + o), c = *(const u32x4*)(io.OBR + (size_t)2 * M * 512 + o);
        u32x4 r;
        r.x = pk2(w0 * bflo(a.x) + w1 * bflo(bq.x) + w2 * bflo(c.x), w0 * bfhi(a.x) + w1 * bfhi(bq.x) + w2 * bfhi(c.x));
        r.y = pk2(w0 * bflo(a.y) + w1 * bflo(bq.y) + w2 * bflo(c.y), w0 * bfhi(a.y) + w1 * bfhi(bq.y) + w2 * bfhi(c.y));
        r.z = pk2(w0 * bflo(a.z) + w1 * bflo(bq.z) + w2 * bflo(c.z), w0 * bfhi(a.z) + w1 * bfhi(bq.z) + w2 * bfhi(c.z));
        r.w = pk2(w0 * bflo(a.w) + w1 * bflo(bq.w) + w2 * bflo(c.w), w0 * bfhi(a.w) + w1 * bfhi(bq.w) + w2 * bfhi(c.w));
        pg8::store16_wt(io.O + (size_t)tok * D + head * 64 + c8 * 8, r); }
}

constexpr int NCH = SEQ / 16;
constexpr int SC_LROW = 68, SC_LDROW = 528, SC_LSLOT = 4 * 16 * SC_LROW * 4 + 16 * SC_LDROW;
constexpr int CT_KHT = 0, CT_RHT = 2048, CT_BTT = 4096, CT_KTT = 6144, CT_VT = 8192, CT_WEND = 10240, CT_SLOT = CT_WEND + 256;
constexpr int GT_AKK = 0, GT_BB = 512, GT_BK = 1024, GT_TT = 1536, GT_SLOT = 2048;
constexpr int SC_LBUF = 0, SC_CT = SC_LBUF + 2 * SC_LSLOT, SC_GG = SC_CT + 3 * CT_SLOT, SC_RKR = SC_GG + 4 * 4096, SC_GT = SC_RKR + 4 * 256, SC_NB = SC_GT + 2 * GT_SLOT, SC_OUT = SC_NB + 1024, SC_END = SC_OUT + 2 * 4096;
static_assert(SC_END <= LDSCTL_OFF, "scan LDS map");
template <int CTRL> __device__ __forceinline__ float dpp_f(float x) { return __int_as_float(__builtin_amdgcn_update_dpp(0, __float_as_int(x), CTRL, 0xf, 0xf, true)); }
__device__ __forceinline__ float sum8(float x) { x += dpp_f<0xB1>(x); x += dpp_f<0x4E>(x); x += dpp_f<0x141>(x); return x; }
__device__ __forceinline__ float sum16(float x) { x += dpp_f<0xB1>(x); x += dpp_f<0x4E>(x); x += dpp_f<0x141>(x); x += dpp_f<0x140>(x); return x; }
__device__ __forceinline__ float fast_sigmoid(float z) { return __builtin_amdgcn_rcpf(1.f + __builtin_amdgcn_exp2f(-LOG2E * z)); }
__device__ __forceinline__ bf16x8 mk8(unsigned a, unsigned b, unsigned c, unsigned d) { return __builtin_bit_cast(bf16x8, (u32x4){a, b, c, d}); }

struct ScanPtrs { const bf16_t *R, *Kk, *V, *LDA; bf16_t* Y; const float *w2, *a2, *g2, *w0, *a0, *k_k, *k_a, *r_k, *gn_w, *gn_b; };
__device__ __forceinline__ void phase_scan(LAS unsigned char* lds, const ScanPtrs& P, int G) {
    int tid = threadIdx.x; asm volatile("" : "+v"(tid));
    const int lane = tid & 63, wid = __builtin_amdgcn_readfirstlane(tid >> 6), g4 = lane >> 4, c16 = lane & 15;
    for (int unit = blockIdx.x; unit < 256; unit += G) {
        const int b = unit >> 5, h = (unit >> 1) & 15, d = unit & 1, hc = h * 64;
        unsigned long long wait_acc = 0ull;
        __syncthreads();
        if (wid < 4) {
            f32x4 ST[4];
#pragma unroll
            for (int mt = 0; mt < 4; ++mt) ST[mt] = (f32x4){0.f, 0.f, 0.f, 0.f};
            const int pch = hc + 8 * (lane & 7);
            const f32x4 gw0 = *(const f32x4*)(P.gn_w + pch), gw1 = *(const f32x4*)(P.gn_w + pch + 4), gb0 = *(const f32x4*)(P.gn_b + pch), gb1 = *(const f32x4*)(P.gn_b + pch + 4);
            u32x4 pvA = {0u, 0u, 0u, 0u}, pvB = pvA;
            auto issueV = [&](int ch_, u32x4& dst) { const int s = 8 * (wid - 1) + (lane >> 3), t = d ? (SEQ - 1 - (ch_ * 16 + s)) : (ch_ * 16 + s); dst = *(const u32x4*)(P.V + ((size_t)b * SEQ + t) * D + pch); };
            if (wid == 1 || wid == 2) { issueV(0, pvA); issueV(1, pvB); }
            auto sw_interval = [&](int i, u32x4& pvset) {
                const int c = i - 3;
                int ln = lane; asm volatile("" : "+v"(ln)); const int g4 = ln >> 4, c16 = ln & 15;
                if (c >= 0 && c < NCH) {
                    const LAS unsigned char* Ct = lds + SC_CT + (c % 3) * CT_SLOT; const LAS unsigned char* Gt = lds + SC_GT + (c & 1) * GT_SLOT;
                    v4i16_t kha[2][2], rha[2][2];
#pragma unroll
                    for (int p = 0; p < 2; ++p)
#pragma unroll
                        for (int hh = 0; hh < 2; ++hh) { const int off = (32 * p + 16 * hh + 4 * g4 + (c16 >> 2)) * 32 + 8 * (c16 & 3); kha[p][hh] = lds_tr16(Ct + CT_KHT + off); rha[p][hh] = lds_tr16(Ct + CT_RHT + off); }
                    const u32x2 gakk = *(const LAS u32x2*)(Gt + GT_AKK + c16 * 32 + 8 * g4), gtt = *(const LAS u32x2*)(Gt + GT_TT + c16 * 32 + 8 * g4);
                    const u32x2 gbb = *(const LAS u32x2*)(Gt + GT_BB + c16 * 32 + 8 * g4), gbk = *(const LAS u32x2*)(Gt + GT_BK + c16 * 32 + 8 * g4);
                    const u32x2 vt = *(const LAS u32x2*)(Ct + CT_VT + (16 * wid + c16) * 32 + 8 * g4);
                    u32x2 btt[4], ktt[4]; f32x4 we[4];
#pragma unroll
                    for (int mt = 0; mt < 4; ++mt) { btt[mt] = *(const LAS u32x2*)(Ct + CT_BTT + (16 * mt + c16) * 32 + 8 * g4); ktt[mt] = *(const LAS u32x2*)(Ct + CT_KTT + (16 * mt + c16) * 32 + 8 * g4);
                        we[mt] = *(const LAS f32x4*)(Ct + CT_WEND + (16 * mt + 4 * g4) * 4); }
                    f32x4 pt = {0.f, 0.f, 0.f, 0.f}, prt = pt;
#pragma unroll
                    for (int p = 0; p < 2; ++p) { const bf16x8 sb = mk8(cvtpk(ST[2 * p][0], ST[2 * p][1]), cvtpk(ST[2 * p][2], ST[2 * p][3]), cvtpk(ST[2 * p + 1][0], ST[2 * p + 1][1]), cvtpk(ST[2 * p + 1][2], ST[2 * p + 1][3]));
                        pt = __builtin_amdgcn_mfma_f32_16x16x32_bf16((bf16x8){kha[p][0][0], kha[p][0][1], kha[p][0][2], kha[p][0][3], kha[p][1][0], kha[p][1][1], kha[p][1][2], kha[p][1][3]}, sb, pt, 0, 0, 0);
                        prt = __builtin_amdgcn_mfma_f32_16x16x32_bf16((bf16x8){rha[p][0][0], rha[p][0][1], rha[p][0][2], rha[p][0][3], rha[p][1][0], rha[p][1][1], rha[p][1][2], rha[p][1][3]}, sb, prt, 0, 0, 0); }
                    const f32x4 qt = __builtin_amdgcn_mfma_f32_16x16x32_bf16(mk8(gakk.x, gakk.y, 0u, 0u), mk8(vt.x, vt.y, 0u, 0u), pt, 0, 0, 0);
                    const f32x4 sat = __builtin_amdgcn_mfma_f32_16x16x32_bf16(mk8(gtt.x, gtt.y, 0u, 0u), mk8(cvtpk(qt[0], qt[1]), cvtpk(qt[2], qt[3]), 0u, 0u), (f32x4){0.f, 0.f, 0.f, 0.f}, 0, 0, 0);
                    const bf16x8 sv = mk8(cvtpk(sat[0], sat[1]), cvtpk(sat[2], sat[3]), vt.x, vt.y);
                    const f32x4 outt = __builtin_amdgcn_mfma_f32_16x16x32_bf16(mk8(gbb.x, gbb.y, gbk.x, gbk.y), sv, prt, 0, 0, 0);
#pragma unroll
                    for (int mt = 0; mt < 4; ++mt) { ST[mt] = __builtin_amdgcn_mfma_f32_16x16x32_bf16(mk8(btt[mt].x, btt[mt].y, ktt[mt].x, ktt[mt].y), sv, ST[mt], 0, 0, 0); ST[mt] = ST[mt] * we[mt]; }
                    LAS float* ob = (LAS float*)(lds + SC_OUT + (c & 1) * 4096) + 16 * wid + c16;
#pragma unroll
                    for (int r = 0; r < 4; ++r) ob[(4 * g4 + r) * 64] = outt[r];
                }
                for (int rep_ = 0; rep_ < REP_ST; ++rep_)
                if (i >= 2 && i - 2 < NCH) {
                    const int jg = i - 2, hw = wid;
                    const LAS unsigned char* Ct = lds + SC_CT + (jg % 3) * CT_SLOT; LAS unsigned char* Gt = lds + SC_GT + (jg & 1) * GT_SLOT;
                    const int aoff = (hw & 1) ? CT_KTT : CT_BTT, boff = (hw & 2) ? CT_RHT : CT_KHT;
                    f32x4 gm = {0.f, 0.f, 0.f, 0.f}, gmT = gm;
#pragma unroll
                    for (int ks = 0; ks < 2; ++ks) { const int o1 = (8 * g4 + 32 * ks + (c16 >> 2)) * 32 + 8 * (c16 & 3), o2 = o1 + 4 * 32;
                        const v4i16_t a0 = lds_tr16(Ct + aoff + o1), a1 = lds_tr16(Ct + aoff + o2), b0 = lds_tr16(Ct + boff + o1), b1 = lds_tr16(Ct + boff + o2);
                        const bf16x8 af = {a0[0], a0[1], a0[2], a0[3], a1[0], a1[1], a1[2], a1[3]}, bfr = {b0[0], b0[1], b0[2], b0[3], b1[0], b1[1], b1[2], b1[3]};
                        gm = __builtin_amdgcn_mfma_f32_16x16x32_bf16(af, bfr, gm, 0, 0, 0);
                        if (hw == 0) gmT = __builtin_amdgcn_mfma_f32_16x16x32_bf16(bfr, af, gmT, 0, 0, 0); }
#pragma unroll
                    for (int r = 0; r < 4; ++r) { const int s = 4 * g4 + r; const bool keep = (hw & 2) ? (s <= c16) : (s < c16); gm[r] = keep ? gm[r] : 0.f; gmT[r] = (c16 < s) ? gmT[r] : 0.f; }
                    if (hw != 0) { *(LAS u32x2*)(Gt + (hw == 1 ? GT_AKK : (hw == 2 ? GT_BB : GT_BK)) + c16 * 32 + 8 * g4) = (u32x2){cvtpk(gm[0], gm[1]), cvtpk(gm[2], gm[3])}; }
                    else {
#define SC_OPA(x) mk8(cvtpk((x)[0], (x)[1]), cvtpk((x)[2], (x)[3]), 0u, 0u)
                        const f32x4 z4 = {0.f, 0.f, 0.f, 0.f};
                        f32x4 Rm, RTm;
#pragma unroll
                        for (int r = 0; r < 4; ++r) { const float idn = (4 * g4 + r == c16) ? 1.f : 0.f; Rm[r] = idn - gm[r]; RTm[r] = idn - gmT[r]; }
                        const f32x4 N2 = __builtin_amdgcn_mfma_f32_16x16x32_bf16(SC_OPA(gmT), SC_OPA(gm), z4, 0, 0, 0), N2T = __builtin_amdgcn_mfma_f32_16x16x32_bf16(SC_OPA(gm), SC_OPA(gmT), z4, 0, 0, 0);
                        f32x4 R1 = __builtin_amdgcn_mfma_f32_16x16x32_bf16(SC_OPA(RTm), SC_OPA(N2), Rm, 0, 0, 0), R1T = __builtin_amdgcn_mfma_f32_16x16x32_bf16(SC_OPA(N2), SC_OPA(RTm), RTm, 0, 0, 0);
                        const f32x4 N4 = __builtin_amdgcn_mfma_f32_16x16x32_bf16(SC_OPA(N2T), SC_OPA(N2), z4, 0, 0, 0), N4T = __builtin_amdgcn_mfma_f32_16x16x32_bf16(SC_OPA(N2), SC_OPA(N2T), z4, 0, 0, 0);
                        f32x4 R2 = __builtin_amdgcn_mfma_f32_16x16x32_bf16(SC_OPA(R1T), SC_OPA(N4), R1, 0, 0, 0), R2T = __builtin_amdgcn_mfma_f32_16x16x32_bf16(SC_OPA(N4), SC_OPA(R1T), R1T, 0, 0, 0);
                        const f32x4 N8 = __builtin_amdgcn_mfma_f32_16x16x32_bf16(SC_OPA(N4T), SC_OPA(N4), z4, 0, 0, 0);
                        const f32x4 Tm = __builtin_amdgcn_mfma_f32_16x16x32_bf16(SC_OPA(R2T), SC_OPA(N8), R2, 0, 0, 0);
#undef SC_OPA
                        *(LAS u32x2*)(Gt + GT_TT + c16 * 32 + 8 * g4) = (u32x2){cvtpk(-Tm[0], -Tm[1]), cvtpk(-Tm[2], -Tm[3])};
                    }
                }
                if ((wid == 1 || wid == 2) && i >= 4 && i - 4 < NCH) {
                    const int jp = i - 4, tl = ln >> 3, c8 = ln & 7;
                    const int s = 8 * (wid - 1) + tl, t = d ? (SEQ - 1 - (jp * 16 + s)) : (jp * 16 + s);
                    const LAS float* ob = (const LAS float*)(lds + SC_OUT + (jp & 1) * 4096) + s * 64 + 8 * c8; const LAS float* gp = (const LAS float*)(lds + SC_GG + (jp & 3) * 4096) + s * 64 + 8 * c8;
                    const f32x4 o0 = *(const LAS f32x4*)(ob), o1 = *(const LAS f32x4*)(ob + 4), g0 = *(const LAS f32x4*)(gp), g1 = *(const LAS f32x4*)(gp + 4);
                    const f32x4 rk4 = *(const LAS f32x4*)((const LAS float*)(lds + SC_RKR + (jp & 3) * 256) + s * 4); const float rkr = (rk4[0] + rk4[1]) + (rk4[2] + rk4[3]);
                    const u32x4 pv = pvset; issueV(jp + 2 < NCH ? jp + 2 : NCH - 1, pvset);
                    const f32x4 v0 = {bflo(pv.x), bfhi(pv.x), bflo(pv.y), bfhi(pv.y)}, v1 = {bflo(pv.z), bfhi(pv.z), bflo(pv.w), bfhi(pv.w)};
                    float mu = ((o0[0] + o0[1]) + (o0[2] + o0[3])) + ((o1[0] + o1[1]) + (o1[2] + o1[3])); mu = sum8(mu) * (1.f / 64.f);
                    const f32x4 d0 = o0 - mu, d1 = o1 - mu; float var = ((d0[0] * d0[0] + d0[1] * d0[1]) + (d0[2] * d0[2] + d0[3] * d0[3])) + ((d1[0] * d1[0] + d1[1] * d1[1]) + (d1[2] * d1[2] + d1[3] * d1[3])); var = sum8(var) * (1.f / 64.f);
                    const float rs = rsqrtf(var + GN_EPS);
                    const f32x4 y0 = (d0 * rs * gw0 + gb0 + rkr * v0) * g0, y1 = (d1 * rs * gw1 + gb1 + rkr * v1) * g1;
                    pg8::store16_wt(P.Y + ((size_t)b * SEQ + t) * (2 * D) + d * D + hc + 8 * c8, (u32x4){cvtpk(y0[0], y0[1]), cvtpk(y0[2], y0[3]), cvtpk(y1[0], y1[1]), cvtpk(y1[2], y1[3])});
                }
                for (int rep_ = 0; rep_ < REP_SYNC; ++rep_) __syncthreads();
                if (WAITPROBE >= 0) { const unsigned long long t0_ = __builtin_amdgcn_s_memrealtime(); __syncthreads(); wait_acc += __builtin_amdgcn_s_memrealtime() - t0_; } else
                __syncthreads();
            };
            static_assert((NCH + 4) % 2 == 0, "interval loop is unrolled by two");
            __builtin_amdgcn_s_setprio(2);
            for (int i = 0; i < NCH + 4; i += 2) { sw_interval(i, pvA); sw_interval(i + 1, pvB); }
            __builtin_amdgcn_s_setprio(0);
        } else {
            const int hw = wid - 4;
            const int chC = hc + 16 * hw + c16, chT = hc + 4 * c16;
            bf16x8 bw[2], ba[2], bg[4];
#pragma unroll
            for (int ks = 0; ks < 2; ++ks) { u32x4 w, a;
#pragma unroll
                for (int jj = 0; jj < 4; ++jj) { const int k = 32 * ks + 8 * g4 + 2 * jj;
                    w[jj] = pk2(P.w2[(size_t)(d * 64 + k) * D + chC], P.w2[(size_t)(d * 64 + k + 1) * D + chC]); a[jj] = pk2(P.a2[(size_t)(d * 64 + k) * D + chC], P.a2[(size_t)(d * 64 + k + 1) * D + chC]); }
                bw[ks] = __builtin_bit_cast(bf16x8, w); ba[ks] = __builtin_bit_cast(bf16x8, a); }
#pragma unroll
            for (int ks = 0; ks < 4; ++ks) { u32x4 g;
#pragma unroll
                for (int jj = 0; jj < 4; ++jj) { const int k = 32 * ks + 8 * g4 + 2 * jj; g[jj] = pk2(P.g2[(size_t)(d * 128 + k) * D + chC], P.g2[(size_t)(d * 128 + k + 1) * D + chC]); }
                bg[ks] = __builtin_bit_cast(bf16x8, g); }
            const float w0c = P.w0[d * D + chC], a0c = P.a0[d * D + chC], kaC = P.k_a[chC], rkC = P.r_k[chC];
            const f32x4 kkT = *(const f32x4*)(P.k_k + chT);
            const int n0 = 16 * c16, lcol = n0 < 64 ? (d * 64 + n0) : (n0 < 128 ? (128 + d * 64 + (n0 - 64)) : (256 + d * 128 + (n0 - 128)));
            struct LSet { u32x2 r, k, v; u32x4 l0, l1; };
            LSet setA, setB;
            auto issueL = [&](int ch_, LSet& S) { const int s = 4 * hw + g4, t = d ? (SEQ - 1 - (ch_ * 16 + s)) : (ch_ * 16 + s); const size_t row = (size_t)b * SEQ + t;
                S.r = *(const u32x2*)(P.R + row * D + chT); S.k = *(const u32x2*)(P.Kk + row * D + chT); S.v = *(const u32x2*)(P.V + row * D + chT);
                S.l0 = *(const u32x4*)(P.LDA + row * 512 + lcol); S.l1 = *(const u32x4*)(P.LDA + row * 512 + lcol + 8); };
            issueL(0, setA); issueL(1, setB);
            auto hw_interval = [&](int i, LSet& LS) {
                const bool doL = i < NCH, doC = (i >= 1 && i - 1 < NCH);
                int ln = lane; asm volatile("" : "+v"(ln)); const int g4 = ln >> 4, c16 = ln & 15;
                const unsigned long long tb_ = (SECPROBE >= 0) ? __builtin_amdgcn_s_memrealtime() : 0ull;
                for (int rep_ = 0; rep_ < REP_HC; ++rep_)
                if (doC) {
                    const int jc = i - 1;
                    const LAS unsigned char* Ls = lds + SC_LBUF + (jc & 1) * SC_LSLOT;
                    const LAS unsigned char* ldp = Ls + 4 * 16 * SC_LROW * 4 + c16 * SC_LDROW + 16 * g4;
                    f32x4 zw = {0.f, 0.f, 0.f, 0.f}, za = zw, gg = zw;
#pragma unroll
                    for (int ks = 0; ks < 2; ++ks) { zw = __builtin_amdgcn_mfma_f32_16x16x32_bf16(*(const LAS bf16x8*)(ldp + 64 * ks), bw[ks], zw, 0, 0, 0);
                                                     za = __builtin_amdgcn_mfma_f32_16x16x32_bf16(*(const LAS bf16x8*)(ldp + 128 + 64 * ks), ba[ks], za, 0, 0, 0); }
#pragma unroll
                    for (int ks = 0; ks < 4; ++ks) gg = __builtin_amdgcn_mfma_f32_16x16x32_bf16(*(const LAS bf16x8*)(ldp + 256 + 64 * ks), bg[ks], gg, 0, 0, 0);
                    float lw[4], cw[4]; float tot = 0.f;
#pragma unroll
                    for (int r = 0; r < 4; ++r) { lw[r] = -0.6065306597f * fast_sigmoid(w0c + zw[r]); tot += lw[r]; cw[r] = tot; }
                    float pre;
                    { auto e = __builtin_amdgcn_permlane16_swap(__float_as_uint(tot), __float_as_uint(tot), false, false); const float e0 = __uint_as_float(e[0]), s01 = e0 + __uint_as_float(e[1]);
                      auto f = __builtin_amdgcn_permlane32_swap(__float_as_uint(s01), __float_as_uint(s01), false, false);
                      pre = ((g4 & 1) ? e0 : 0.f) + ((g4 & 2) ? __uint_as_float(f[0]) : 0.f); }
                    const LAS float* Lf = (const LAS float*)Ls + 16 * hw + c16;
                    LAS unsigned char* Ct = lds + SC_CT + (jc % 3) * CT_SLOT;
                    LAS float* ggw = (LAS float*)(lds + SC_GG + (jc & 3) * 4096) + 16 * hw + c16;
                    float kh[4], rh[4], bt[4], kt[4], vv[4], rkp[4];
#pragma unroll
                    for (int r = 0; r < 4; ++r) { const int tok = 4 * g4 + r; const float c = pre + cw[r];
                        const float Wc = __builtin_amdgcn_exp2f(LOG2E * c), Wp = __builtin_amdgcn_exp2f(LOG2E * (c - lw[r])), iW = __builtin_amdgcn_exp2f(-LOG2E * c);
                        const float a = fast_sigmoid(a0c + za[r]);
                        const float rr = Lf[tok * SC_LROW], kk_ = Lf[16 * SC_LROW + tok * SC_LROW], nk = Lf[32 * SC_LROW + tok * SC_LROW]; vv[r] = Lf[48 * SC_LROW + tok * SC_LROW];
                        const float kd = kk_ * (1.f + (a - 1.f) * kaC);
                        kh[r] = nk * Wp; rh[r] = rr * Wc; bt[r] = nk * a * iW; kt[r] = kd * iW; rkp[r] = rr * kd * rkC;
                        ggw[tok * 64] = gg[r];
                        if (tok == 15) ((LAS float*)(Ct + CT_WEND))[16 * hw + c16] = Wc; }
                    { LAS unsigned char* tq = Ct + (16 * hw + c16) * 32 + 8 * g4;
                      *(LAS u32x2*)(tq + CT_KHT) = (u32x2){cvtpk(kh[0], kh[1]), cvtpk(kh[2], kh[3])}; *(LAS u32x2*)(tq + CT_RHT) = (u32x2){cvtpk(rh[0], rh[1]), cvtpk(rh[2], rh[3])};
                      *(LAS u32x2*)(tq + CT_BTT) = (u32x2){cvtpk(bt[0], bt[1]), cvtpk(bt[2], bt[3])}; *(LAS u32x2*)(tq + CT_KTT) = (u32x2){cvtpk(kt[0], kt[1]), cvtpk(kt[2], kt[3])};
                      *(LAS u32x2*)(tq + CT_VT) = (u32x2){cvtpk(vv[0], vv[1]), cvtpk(vv[2], vv[3])}; }
#pragma unroll
                    for (int r = 0; r < 4; ++r) rkp[r] = sum16(rkp[r]);
                    if (c16 == 0) { LAS float* rk = (LAS float*)(lds + SC_RKR + (jc & 3) * 256) + hw;
#pragma unroll
                        for (int r = 0; r < 4; ++r) rk[(4 * g4 + r) * 4] = rkp[r]; }
                }
                const unsigned long long tc_ = (SECPROBE >= 0) ? __builtin_amdgcn_s_memrealtime() : 0ull;
                for (int rep_ = 0; rep_ < REP_HL; ++rep_)
                if (doL) {
                    LAS unsigned char* Ls = lds + SC_LBUF + (i & 1) * SC_LSLOT; LAS float* Lf = (LAS float*)Ls;
                    const int s = 4 * hw + g4;
                    const u32x2 lr = LS.r, lk = LS.k, lv = LS.v; const u32x4 l00 = LS.l0, l01 = LS.l1;
                    issueL(i + 2 < NCH ? i + 2 : NCH - 1, LS);
                    const f32x4 rr = {bflo(lr.x), bfhi(lr.x), bflo(lr.y), bfhi(lr.y)}, kk_ = {bflo(lk.x), bfhi(lk.x), bflo(lk.y), bfhi(lk.y)}, vv = {bflo(lv.x), bfhi(lv.x), bflo(lv.y), bfhi(lv.y)};
                    f32x4 nk = kk_ * kkT; float ss = nk[0] * nk[0] + nk[1] * nk[1] + nk[2] * nk[2] + nk[3] * nk[3];
                    ss = sum16(ss);
                    nk = nk * (1.f / fmaxf(sqrtf(ss), 1e-12f));
                    *(LAS f32x4*)(Lf + s * SC_LROW + 4 * c16) = rr; *(LAS f32x4*)(Lf + 16 * SC_LROW + s * SC_LROW + 4 * c16) = kk_;
                    *(LAS f32x4*)(Lf + 32 * SC_LROW + s * SC_LROW + 4 * c16) = nk; *(LAS f32x4*)(Lf + 48 * SC_LROW + s * SC_LROW + 4 * c16) = vv;
                    *(LAS u32x4*)(Ls + 4 * 16 * SC_LROW * 4 + s * SC_LDROW + 32 * c16) = l00; *(LAS u32x4*)(Ls + 4 * 16 * SC_LROW * 4 + s * SC_LDROW + 32 * c16 + 16) = l01;
                }
                for (int rep_ = 0; rep_ < REP_SYNC; ++rep_) __syncthreads();
                if (SECPROBE >= 0) { asm volatile("s_waitcnt vmcnt(0) lgkmcnt(0)" ::: "memory"); const unsigned long long te_ = __builtin_amdgcn_s_memrealtime(); wait_acc += (SECPROBE == 0) ? (tc_ - tb_) : ((SECPROBE == 1) ? (te_ - tc_) : (te_ - tb_)); __syncthreads(); } else
                if (WAITPROBE >= 0) { const unsigned long long t0_ = __builtin_amdgcn_s_memrealtime(); __syncthreads(); wait_acc += __builtin_amdgcn_s_memrealtime() - t0_; } else
                __syncthreads();
            };
            for (int i = 0; i < NCH + 4; i += 2) { hw_interval(i, setA); hw_interval(i + 1, setB); }
        }
        if ((WAITPROBE >= 0 || SECPROBE >= 0) && blockIdx.x == 0 && wid == (SECPROBE >= 0 ? 4 : WAITPROBE)) { const unsigned long long tgt_ = __builtin_amdgcn_s_memrealtime() + 4ull * wait_acc; while (__builtin_amdgcn_s_memrealtime() < tgt_) __builtin_amdgcn_s_sleep(8); }
    }
}

__global__ void __launch_bounds__(NTHREADS, 2) fwd_megakernel(Args args) {
    extern __shared__ __attribute__((aligned(16))) unsigned char lds_raw[];
    LAS unsigned char* lds = (LAS unsigned char*)lds_raw;
    volatile LAS unsigned* MISC = (volatile LAS unsigned*)(lds + MISC_OFF);
    const int tid0 = threadIdx.x, wave = __builtin_amdgcn_readfirstlane(tid0 >> 6);
#define FRESH_LANE() int tid = tid0; asm volatile("" : "+v"(tid)); const int lane = tid & 63; (void)lane
    const int G = gridDim.x;
    const int vcu = (G % 8 == 0) ? ((int)blockIdx.x % 8) * (G / 8) + (int)blockIdx.x / 8 : (int)blockIdx.x;
    const int gw = vcu * NWAVES + wave, NGW = G * NWAVES;
    unsigned char* ws = args.ws;
    unsigned* ctl = (unsigned*)(ws + WS_CTL);
    for (int u = tid0; u < (LDS_BYTES - LDSCTL_OFF) / 4; u += NTHREADS) ((LAS unsigned*)(lds + LDSCTL_OFF))[u] = 0u;
    __syncthreads();
    XcdBarrier bar = xcd_barrier_post(ctl + CW_BAR, MISC + 8);
    unsigned long long ts_a = 0ull; int ts_n = 0;
#define STAMP() do { if (TS_A >= 0) { const unsigned long long t_ = __builtin_amdgcn_s_memrealtime(); if (ts_n == TS_A) ts_a = t_; \
    if (ts_n == TS_B && blockIdx.x == 0) { const unsigned long long tgt_ = t_ + 4ull * (t_ - ts_a); while (__builtin_amdgcn_s_memrealtime() < tgt_) __builtin_amdgcn_s_sleep(8); } ++ts_n; } } while (0)
#define GRID_BAR() do { xcd_barrier(bar); STAMP(); } while (0)
    STAMP();

    const float* x = args.in[0]; const float* rel_table = args.in[1]; const float* norm_g = args.in[2]; const float* attn_w_in = args.in[3]; const float* attn_sink = args.in[4];
    const float* attn_w_out = args.in[5]; const float* mu_prev = args.in[6]; const float* mu_next = args.in[7]; const float* w_r = args.in[8]; const float* w_k = args.in[9];
    const float* w_v = args.in[10]; const float* w_o = args.in[11]; const float* mlp_w1 = args.in[25]; const float* mlp_w2 = args.in[26];
    bf16_t* HBa = (bf16_t*)args.out; bf16_t* HBb = HBa + (size_t)M * D; bf16_t* HBc = (bf16_t*)(ws + WS_HBC); bf16_t* TMP2 = (bf16_t*)(ws + WS_TMP2);
    bf16_t* XN = (bf16_t*)(ws + WS_XN); bf16_t* QKV = (bf16_t*)(ws + WS_QKV); bf16_t* Ob = (bf16_t*)(ws + WS_O); bf16_t* TMP = (bf16_t*)(ws + WS_TMP); bf16_t* Hb = (bf16_t*)(ws + WS_H);
    bf16_t* MIXA = (bf16_t*)(ws + WS_MIXA); bf16_t* MIXB = (bf16_t*)(ws + WS_MIXB); bf16_t* Rb = (bf16_t*)(ws + WS_R); bf16_t* Kb = (bf16_t*)(ws + WS_K); bf16_t* Vb = (bf16_t*)(ws + WS_V);
    bf16_t* LDO = (bf16_t*)(ws + WS_LDO); bf16_t* Yb = (bf16_t*)(ws + WS_Y);
    LAS float* scr = (LAS float*)(lds + wave * TR_SCR_BYTES);
    float* RS = (float*)(ws + WS_CTL + 128 * 1024);

    {
        FRESH_LANE();
        constexpr int I_IN = (D / 64) * (DIN / 64), I_OUT = (D / 64) * (D / 64), I_1 = (D / 64) * (DFF / 64), I_2 = (DFF / 64) * (D / 64);
        const bool tail = (G == 256);
        for (int it = gw; it < (tail ? I_IN : I_IN + I_OUT + I_1 + I_2); it += NGW) { int r = it;
            if (r < I_IN) { transpose_item(attn_w_in, DIN, DIN, (bf16_t*)(ws + WS_WIN_T), D, 0, 0, scr, r, lane, ScaleOne{}); continue; } r -= I_IN;
            if (r < I_OUT) { transpose_item(attn_w_out, D, D, (bf16_t*)(ws + WS_WOUT_T), D, 0, 0, scr, r, lane, ScaleOne{}); continue; } r -= I_OUT;
            if (r < I_1) { transpose_item(mlp_w1, DFF, DFF, (bf16_t*)(ws + WS_W1_T), D, 0, 0, scr, r, lane, ScaleVec{norm_g + 2 * D}); continue; } r -= I_1;
            transpose_item(mlp_w2, D, D, (bf16_t*)(ws + WS_W2_T), DFF, 0, 0, scr, r, lane, ScaleOne{}); }
        for (int row = gw; row < M; row += NGW) { Row16 r; row_load_f32(r, x + (size_t)row * D, lane); row_rmsnorm(r, norm_g, lane); row_store_bf16(r, XN + (size_t)row * D, lane); }
    }
    GRID_BAR();
    { pg8::StaticOrder S; S.init(M, DIN, G, (int)blockIdx.x); const EpiHeadMajor E{QKV};
      for (int rep = 0; rep < REP_GEMM; ++rep) pg8::gemm_phase<EpiHeadMajor, ProbPlain, true, true>(lds, ProbPlain{XN, (const bf16_t*)(ws + WS_WIN_T), D}, S, E); }
    if (G == 256 && blockIdx.x >= 64) {
        FRESH_LANE();
        constexpr int I_OUT = (D / 64) * (D / 64), I_1 = (D / 64) * (DFF / 64), I_2 = (DFF / 64) * (D / 64);
        for (int it = ((int)blockIdx.x - 64) * NWAVES + wave; it < I_OUT + I_1 + I_2; it += 192 * NWAVES) { int r = it;
            if (r < I_OUT) { transpose_item(attn_w_out, D, D, (bf16_t*)(ws + WS_WOUT_T), D, 0, 0, scr, r, lane, ScaleOne{}); continue; } r -= I_OUT;
            if (r < I_1) { transpose_item(mlp_w1, DFF, DFF, (bf16_t*)(ws + WS_W1_T), D, 0, 0, scr, r, lane, ScaleVec{norm_g + 2 * D}); continue; } r -= I_1;
            transpose_item(mlp_w2, D, D, (bf16_t*)(ws + WS_W2_T), DFF, 0, 0, scr, r, lane, ScaleOne{}); }
    }
    GRID_BAR();
    { const AttnIO io{QKV, rel_table, attn_sink, Ob, (bf16_t*)(ws + WS_OBR), (float*)(ws + WS_LSE)};
      for (int rep = 0; rep < REP_ATT; ++rep) phase_attn(lds, io, vcu, G);
      GRID_BAR();
      { FRESH_LANE(); phase_attn_merge(io, vcu * NTHREADS + tid, G * NTHREADS); } }
    GRID_BAR();
    for (int rep = 0; rep < REP_BAR; ++rep) GRID_BAR();
    run_gemm<0>(lds, ProbPlain{Ob, (const bf16_t*)(ws + WS_WOUT_T), D}, DstPlain{TMP, D}, M, D, G);
    GRID_BAR();
    { FRESH_LANE(); phase_resnorm<true, false>(x, TMP, norm_g + D, nullptr, HBa, nullptr, RS, gw, NGW, lane); }
    GRID_BAR();
    run_gemm_rs<1>(lds, ProbPlain{HBa, (const bf16_t*)(ws + WS_W1_T), D}, DstPlain{Hb, DFF}, RS, M, DFF, G);
    GRID_BAR();
    run_gemm<0>(lds, ProbPlain{Hb, (const bf16_t*)(ws + WS_W2_T), DFF}, DstPlain{TMP, D}, M, D, G);
    GRID_BAR();
    { FRESH_LANE(); phase_resnorm<false, false>(HBa, TMP, norm_g + 3 * D, nullptr, HBb, nullptr, nullptr, gw, NGW, lane); }
    GRID_BAR();
    {
        FRESH_LANE();
        const float* g1n = norm_g + 4 * D;
        constexpr int I_SQ = (D / 64) * (D / 64), I_1 = (D / 64) * (DFF / 64), I_2 = (DFF / 64) * (D / 64), I_LD = 384;
        const bool tail = (G == 256);
        for (int it = gw; it < (tail ? 2 * I_SQ + I_2 + I_LD : 4 * I_SQ + I_1 + I_2 + I_LD); it += NGW) { int r = it;
            if (r < I_SQ) { transpose_item(w_r, D, D, (bf16_t*)(ws + WS_WR_T), D, 0, 0, scr, r, lane, ScaleOne{}); continue; } r -= I_SQ;
            if (r < I_SQ) { transpose_item(w_k, D, D, (bf16_t*)(ws + WS_WK_T), D, 0, 0, scr, r, lane, ScaleOne{}); continue; } r -= I_SQ;
            if (!tail) {
                if (r < I_SQ) { transpose_item(w_v, D, D, (bf16_t*)(ws + WS_WV_T), D, 0, 0, scr, r, lane, ScaleOne{}); continue; } r -= I_SQ;
                if (r < I_SQ) { transpose_item(w_o, D, D, (bf16_t*)(ws + WS_WO2_T), D, 0, 0, scr, r, lane, ScaleOne{}); continue; } r -= I_SQ;
                if (r < I_1) { transpose_item(mlp_w1 + (size_t)D * DFF, DFF, DFF, (bf16_t*)(ws + WS_W1B_T), D, 0, 0, scr, r, lane, ScaleVec{norm_g + 6 * D}); continue; } r -= I_1; }
            if (r < I_2) { transpose_item(mlp_w2 + (size_t)DFF * D, D, D, (bf16_t*)(ws + WS_W2B_T), DFF, 0, 0, scr, r, lane, ScaleOne{}); continue; } r -= I_2;
            const int part = r / 128; int q = r % 128; int sub, li;
            if (q < 64) { sub = q / 16; li = q % 16; } else { sub = 4 + (q - 64) / 32; li = (q - 64) % 32; }
            const int dd = sub & 1, kind = sub >> 1;
            const int stream = kind == 0 ? 1 : (kind == 1 ? 4 : 5), Nn = kind == 2 ? 128 : 64;
            const float* src = kind == 0 ? args.in[18] + (size_t)dd * D * 64 : (kind == 1 ? args.in[21] + (size_t)dd * D * 64 : args.in[23] + (size_t)dd * D * 128);
            const int coloff = kind == 0 ? dd * 64 : (kind == 1 ? 128 + dd * 64 : 256 + dd * 128);
            transpose_item(src, Nn, Nn, (bf16_t*)(ws + WS_LDW_T), D, part * 512 + coloff, 0, scr, li, lane, ScaleMix{mu_prev + stream * D, mu_next + stream * D, part}); }
        phase_mix3(lds, HBb, g1n, mu_prev, mu_next, XN, MIXA, MIXB, HBa, gw, NGW, tid, lane);
    }
    GRID_BAR();
    run_gemm<0>(lds, ProbRKL{ws, D}, DstRKL{ws}, M, 14 * 256, G);
    if (G == 256 && blockIdx.x >= 128) {
        FRESH_LANE();
        constexpr int I_SQ = (D / 64) * (D / 64), I_1 = (D / 64) * (DFF / 64);
        for (int it = ((int)blockIdx.x - 128) * NWAVES + wave; it < 2 * I_SQ + I_1; it += 128 * NWAVES) { int r = it;
            if (r < I_SQ) { transpose_item(w_v, D, D, (bf16_t*)(ws + WS_WV_T), D, 0, 0, scr, r, lane, ScaleOne{}); continue; } r -= I_SQ;
            if (r < I_SQ) { transpose_item(w_o, D, D, (bf16_t*)(ws + WS_WO2_T), D, 0, 0, scr, r, lane, ScaleOne{}); continue; } r -= I_SQ;
            transpose_item(mlp_w1 + (size_t)D * DFF, DFF, DFF, (bf16_t*)(ws + WS_W1B_T), D, 0, 0, scr, r, lane, ScaleVec{norm_g + 6 * D}); }
    }
    GRID_BAR();
    { FRESH_LANE(); phase_lda(LDO, (bf16_t*)(ws + WS_LDA), gw, NGW, lane); }
    run_gemm<0>(lds, ProbPlain{HBa, (const bf16_t*)(ws + WS_WV_T), D}, DstPlain{Vb, D}, M, D, G);
    GRID_BAR();
    { ScanPtrs sp{Rb, Kb, Vb, (const bf16_t*)(ws + WS_LDA), Yb, args.in[19], args.in[22], args.in[24], args.in[17], args.in[20], args.in[12], args.in[13], args.in[14], args.in[15], args.in[16]};
      for (int rep = 0; rep < REP_SCAN; ++rep) phase_scan(lds, sp, G); }
    GRID_BAR();
    { FRESH_LANE();
      bf16_t* Ys = (bf16_t*)(ws + WS_YSUM);
      const bool grp_on = (G == 256);
      const int grow0 = 256 * (8 * ((int)blockIdx.x % 8) + ((int)blockIdx.x / 8) % 8) + 64 * ((int)blockIdx.x / 64);
      const int rfirst = grp_on ? grow0 + wave : gw, rend = grp_on ? grow0 + 64 : M, rstride = grp_on ? NWAVES : NGW;
      for (int row = rfirst; row < rend; row += rstride) {
          const u32x4* y0 = (const u32x4*)(Yb + (size_t)row * 2 * D); const u32x4* y1 = (const u32x4*)(Yb + (size_t)row * 2 * D + D);
#pragma unroll
          for (int hb = 0; hb < 2; ++hb) { const u32x4 a = y0[lane + 64 * hb], c = y1[lane + 64 * hb]; u32x4 o;
              o.x = cvtpk(bflo(a.x) + bflo(c.x), bfhi(a.x) + bfhi(c.x)); o.y = cvtpk(bflo(a.y) + bflo(c.y), bfhi(a.y) + bfhi(c.y));
              o.z = cvtpk(bflo(a.z) + bflo(c.z), bfhi(a.z) + bfhi(c.z)); o.w = cvtpk(bflo(a.w) + bflo(c.w), bfhi(a.w) + bfhi(c.w));
              pg8::store16_wt((u32x4*)(Ys + (size_t)row * D) + lane + 64 * hb, o); } }
      if (grp_on) { unsigned ep = 0u; grp_barrier(ctl + CW_BAR, (unsigned)blockIdx.x % 64u, ep); } else GRID_BAR();
      run_gemm<0>(lds, ProbPlain{Ys, (const bf16_t*)(ws + WS_WO2_T), D}, DstPlain{TMP2, D}, M, D, G); }
    GRID_BAR();
    { FRESH_LANE(); phase_resnorm<false, false>(HBb, TMP2, norm_g + 5 * D, nullptr, HBc, nullptr, RS, gw, NGW, lane); }
    GRID_BAR();
    run_gemm_rs<1>(lds, ProbPlain{HBc, (const bf16_t*)(ws + WS_W1B_T), D}, DstPlain{Hb, DFF}, RS, M, DFF, G);
    GRID_BAR();
    run_gemm<0>(lds, ProbPlain{Hb, (const bf16_t*)(ws + WS_W2B_T), DFF}, DstPlain{TMP2, D}, M, D, G);
    GRID_BAR();
    { FRESH_LANE(); phase_resnorm<false, true>(HBc, TMP2, norm_g + 7 * D, nullptr, args.out, nullptr, nullptr, gw, NGW, lane); }
    if (TS_A >= 0) { GRID_BAR(); }
#undef GRID_BAR
}

extern "C" void kernel_launch(void* const* d_in, const int* in_sizes, int n_in, void* d_out, int out_size, void* d_ws, size_t ws_size, hipStream_t stream) {
    static int grid = 0;
    if (grid == 0) {
        if (n_in != 27 || in_sizes[0] != M * D || out_size != M * D || ws_size < WS_END) { fprintf(stderr, "kernel_launch: unexpected shapes (n_in %d, in0 %d, out %d, ws %zu)\n", n_in, n_in > 0 ? in_sizes[0] : -1, out_size, ws_size); grid = -1; return; }
        int dev = 0, cus = 0, per_cu = 0;
        if (hipGetDevice(&dev) != hipSuccess || hipDeviceGetAttribute(&cus, hipDeviceAttributeMultiprocessorCount, dev) != hipSuccess) { grid = -1; return; }
        if (hipFuncSetAttribute((const void*)fwd_megakernel, hipFuncAttributeMaxDynamicSharedMemorySize, LDS_BYTES) != hipSuccess) { fprintf(stderr, "kernel_launch: hipFuncSetAttribute failed\n"); grid = -1; return; }
        if (hipOccupancyMaxActiveBlocksPerMultiprocessor(&per_cu, (const void*)fwd_megakernel, NTHREADS, LDS_BYTES) != hipSuccess || per_cu < 1) { fprintf(stderr, "kernel_launch: occupancy query says %d blocks/CU\n", per_cu); (void)hipGetLastError(); grid = -1; return; }
        grid = cus;
    }
    if (grid < 0) return;
    (void)hipMemsetAsync((char*)d_ws + WS_CTL, 0, CTL_ZERO_BYTES, stream);
    Args a{};
    for (int i = 0; i < 27; ++i) a.in[i] = (const float*)d_in[i];
    a.out = (float*)d_out; a.ws = (unsigned char*)d_ws;
    hipLaunchKernelGGL(fwd_megakernel, dim3(grid), dim3(NTHREADS), LDS_BYTES, stream, a);
}
```

```cpp
#include <hip/hip_runtime.h>
#include <cstdio>
#include <cstdint>

#define LAS __attribute__((address_space(3)))
#define GAS __attribute__((address_space(1)))
typedef unsigned short bf16_t;
typedef short bf16x8 __attribute__((ext_vector_type(8)));
typedef float f32x4 __attribute__((ext_vector_type(4)));
typedef float f32x2 __attribute__((ext_vector_type(2)));
typedef unsigned u32x4 __attribute__((ext_vector_type(4)));
typedef unsigned u32x2 __attribute__((ext_vector_type(2)));

#ifndef REP_SCAN
#define REP_SCAN 1
#endif
#ifndef REP_ATT
#define REP_ATT 1
#endif
#ifndef REP_GEMM
#define REP_GEMM 1
#endif
#ifndef REP_ATTC
#define REP_ATTC 1
#endif
#ifndef REP_BAR
#define REP_BAR 0
#endif
#ifndef REP_ATTS
#define REP_ATTS 1
#endif
#ifndef REP_HC
#define REP_HC 1
#endif
#ifndef REP_ST
#define REP_ST 1
#endif
#ifndef REP_HL
#define REP_HL 1
#endif
#ifndef REP_SYNC
#define REP_SYNC 0
#endif
#ifndef SECPROBE
#define SECPROBE -1
#endif
#ifndef WAITPROBE
#define WAITPROBE -1
#endif
#ifndef TS_A
#define TS_A -1
#endif
#ifndef TS_B
#define TS_B -1
#endif
constexpr int SEQ = 2048, D = 1024, NBATCH = 8, M = NBATCH * SEQ, DFF = 4096, DIN = 2304, NLD = 1536;
constexpr float NORM_EPS = 1e-6f, GN_EPS = 64e-5f;
constexpr int NWAVES = 8, NTHREADS = 512;

namespace pg8 {
constexpr int BM = 256, BK = 64, HALF = 128, HTB = HALF * BK * 2, STAGE_BYTES = 8 * HTB, NXCD = 8, WGM = 8;
__host__ __device__ __forceinline__ int lds_byte(int r, int c) { const int st = (r >> 4) * 2 + (c >> 5), rr = r & 15, cc = c & 31, ob = rr * 64 + cc * 2; return st * 1024 + (ob ^ (((ob >> 9) & 1) << 5)); }
__host__ __device__ __forceinline__ void stage_rc(int b, int& R, int& C) { const int st = b / 1024, sb = b % 1024, swz = sb ^ (((sb >> 9) & 1) << 5); R = (st >> 1) * 16 + swz / 64; C = (st & 1) * 32 + (swz % 64) / 2; }
__host__ __device__ __forceinline__ int perm32(int rho) { const int n = rho >> 4, i = rho & 15; return 8 * (i >> 2) + 4 * n + (i & 3); }

struct Unit { int pm, pn; };
struct StaticOrder {
    int nM, nN, nwg, G, c;
    __host__ __device__ void init(int Mr, int N, int G_, int c_) { nM = Mr / BM; nN = N / BM; nwg = nM * nN; G = G_; c = c_; }
    __host__ __device__ bool next(int i, Unit& u) const {
        const long L = (long)i * G + c; if (L >= nwg) return false;
        int wgid = (int)L; { const int q = nwg / NXCD, r = nwg % NXCD, xcd = wgid % NXCD, off = wgid / NXCD; wgid = (xcd < r ? xcd * (q + 1) : r * (q + 1) + (xcd - r) * q) + off; }
        const int nig = WGM * nN, gid = wgid / nig, fm = gid * WGM, gsz = (nM - fm) < WGM ? (nM - fm) : WGM;
        u.pm = fm + ((wgid % nig) % gsz); u.pn = (wgid % nig) / gsz; return true;
    }
};
__device__ __forceinline__ unsigned cvt_pk_bf16(float lo, float hi) { unsigned r; asm volatile("v_cvt_pk_bf16_f32 %0, %1, %2" : "=v"(r) : "v"(lo), "v"(hi)); return r; }

__device__ __forceinline__ void store16_wt(void* p, u32x4 v) { asm volatile("global_store_dwordx4 %0, %1, off sc1\n\ts_nop 1" :: "v"(p), "v"(v) : "memory"); }
template <int ACT, class DstFn, bool RS = false> struct EpiBf16 {
    static constexpr bool PERM = true;
    DstFn F; const float* rs;
    __device__ __forceinline__ void operator()(const f32x4 (&acc)[2][2][4][2], const Unit& u, int wr, int wc, int fr, int fq) const {
        bf16_t* base; int ldc; F(u, base, ldc);
        const int row0 = wr * 64 + fr, col0 = wc * 32 + 8 * fq;
        float rsc[2][4];
        if (RS) {
#pragma unroll
            for (int ai = 0; ai < 2; ++ai)
#pragma unroll
                for (int m = 0; m < 4; ++m) rsc[ai][m] = rs[u.pm * BM + row0 + ai * HALF + m * 16]; }
        if (RS && ACT == 1) {
            f32x4 t[2][2][4][2];
#pragma unroll
            for (int ai = 0; ai < 2; ++ai)
#pragma unroll
                for (int bj = 0; bj < 2; ++bj)
#pragma unroll
                    for (int m = 0; m < 4; ++m)
#pragma unroll
                        for (int n = 0; n < 2; ++n)
#pragma unroll
                            for (int e = 0; e < 4; ++e) { const float a = fmaxf(acc[ai][bj][m][n][e], 0.f); t[ai][bj][m][n][e] = a * a; }
#pragma unroll
            for (int ai = 0; ai < 2; ++ai)
#pragma unroll
                for (int m = 0; m < 4; ++m) { bf16_t* rowp = base + (size_t)(row0 + ai * HALF + m * 16) * ldc + col0; const float r2 = rsc[ai][m] * rsc[ai][m];
#pragma unroll
                    for (int bj = 0; bj < 2; ++bj) { const f32x4 v0 = t[ai][bj][m][0] * r2, v1 = t[ai][bj][m][1] * r2;
                        u32x4 w; w.x = cvt_pk_bf16(v0[0], v0[1]); w.y = cvt_pk_bf16(v0[2], v0[3]); w.z = cvt_pk_bf16(v1[0], v1[1]); w.w = cvt_pk_bf16(v1[2], v1[3]);
                        store16_wt(rowp + bj * HALF, w); } }
            return;
        }
#pragma unroll
        for (int ai = 0; ai < 2; ++ai)
#pragma unroll
            for (int m = 0; m < 4; ++m) { bf16_t* rowp = base + (size_t)(row0 + ai * HALF + m * 16) * ldc + col0;
#pragma unroll
                for (int bj = 0; bj < 2; ++bj) { f32x4 v0 = acc[ai][bj][m][0], v1 = acc[ai][bj][m][1];
                    if (RS) { v0 = v0 * rsc[ai][m]; v1 = v1 * rsc[ai][m]; }
                    if (ACT == 1) {
#pragma unroll
                        for (int e = 0; e < 4; ++e) { const float a = fmaxf(v0[e], 0.f), b = fmaxf(v1[e], 0.f); v0[e] = a * a; v1[e] = b * b; } }
                    u32x4 w; w.x = cvt_pk_bf16(v0[0], v0[1]); w.y = cvt_pk_bf16(v0[2], v0[3]); w.z = cvt_pk_bf16(v1[0], v1[1]); w.w = cvt_pk_bf16(v1[2], v1[3]);
                    store16_wt(rowp + bj * HALF, w); } }
    }
};

template <class Epi, class Prob, bool ALIGN_EPI, bool SP2>
__device__ __forceinline__ void gemm_phase(LAS unsigned char* lds, const Prob& P, const StaticOrder& S, const Epi& E) {
    int tid = threadIdx.x; asm volatile("" : "+v"(tid));
    const int wid = __builtin_amdgcn_readfirstlane(tid >> 6), lane = tid & 63, wr = wid >> 2, wc = wid & 3, fr = lane & 15, fq = lane >> 4;
    const int K = P.K, nt = K / BK;
    unsigned voffA[2], voffB[2];
#pragma unroll
    for (int i = 0; i < 2; ++i) { int R, C; stage_rc(tid * 16 + i * 8192, R, C); const int Rb = Epi::PERM ? ((R & ~31) + perm32(R & 31)) : R;
        voffA[i] = (unsigned)(R * K + C) * 2u; voffB[i] = (unsigned)(Rb * K + C) * 2u; }
    const size_t kstep = (size_t)(BK * 2);
    const size_t hstep = (size_t)HALF * K * 2;
    const unsigned ldsw = (unsigned)wid * 1024u;
    const int aoff = lds_byte(wr * 64 + fr, fq * 8), boff = lds_byte(wc * 32 + fr, fq * 8);
#define PG8_SA(b, h) (((b) * 2 + (h)) * HTB)
#define PG8_SB(b, h) ((4 + (b) * 2 + (h)) * HTB)
#define PG8_STAGE(bufoff, gbase, voff) do { _Pragma("unroll") for (int _i = 0; _i < 2; ++_i) \
        __builtin_amdgcn_global_load_lds((const unsigned*)((const char*)(gbase) + (voff)[_i]), (LAS unsigned*)(lds + (bufoff) + ldsw + _i * 8192), 16, 0, 0); } while (0)
#define PG8_LDA(dst, b, h) do { _Pragma("unroll") for (int m = 0; m < 4; ++m) _Pragma("unroll") for (int k = 0; k < 2; ++k) dst[m][k] = *(const LAS bf16x8*)(lds + PG8_SA(b, h) + aoff + m * 2048 + k * 1024); } while (0)
#define PG8_LDB(dst, b, h) do { _Pragma("unroll") for (int n = 0; n < 2; ++n) _Pragma("unroll") for (int k = 0; k < 2; ++k) dst[n][k] = *(const LAS bf16x8*)(lds + PG8_SB(b, h) + boff + n * 2048 + k * 1024); } while (0)
#define PG8_MMA(ai, bj, At, Bt) do { __builtin_amdgcn_s_setprio(1); _Pragma("unroll") for (int m = 0; m < 4; ++m) _Pragma("unroll") for (int n = 0; n < 2; ++n) _Pragma("unroll") for (int k = 0; k < 2; ++k) \
        acc[ai][bj][m][n] = __builtin_amdgcn_mfma_f32_16x16x32_bf16(Bt[n][k], At[m][k], acc[ai][bj][m][n], 0, 0, 0); __builtin_amdgcn_s_setprio(0); } while (0)
#define PG8_WAIT_V(n) asm volatile("s_waitcnt vmcnt(" #n ")" ::: "memory")
#define PG8_WAIT_L(n) asm volatile("s_waitcnt lgkmcnt(" #n ")" ::: "memory")
#define PG8_BAR __builtin_amdgcn_s_barrier()
#define PG8_SCHED __builtin_amdgcn_sched_barrier(0)
    Unit cur, nxt; int ui = 0;
    if (!S.next(0, cur)) return;
    f32x4 acc[2][2][4][2];
#pragma unroll
    for (int a = 0; a < 2; ++a)
#pragma unroll
        for (int b = 0; b < 2; ++b)
#pragma unroll
            for (int m = 0; m < 4; ++m)
#pragma unroll
                for (int n = 0; n < 2; ++n) acc[a][b][m][n] = (f32x4){0.f, 0.f, 0.f, 0.f};
    bf16x8 At[4][2], B0[2][2], B1[2][2];
    const char* cA = P.a_tile(cur); const char* cB = P.b_tile(cur);
    if constexpr (SP2) {
        PG8_STAGE(PG8_SB(0, 0), cB, voffB); PG8_STAGE(PG8_SB(0, 1), cB + hstep, voffB); PG8_STAGE(PG8_SA(0, 0), cA, voffA); PG8_STAGE(PG8_SA(0, 1), cA + hstep, voffA);
        if (wr == 1) PG8_BAR;
        PG8_WAIT_V(2); PG8_BAR;
        PG8_STAGE(PG8_SB(1, 0), cB + kstep, voffB); PG8_STAGE(PG8_SA(1, 0), cA + kstep, voffA); PG8_STAGE(PG8_SB(1, 1), cB + hstep + kstep, voffB);
        PG8_WAIT_V(6); PG8_BAR;
    } else {
        PG8_STAGE(PG8_SB(0, 0), cB, voffB); PG8_STAGE(PG8_SA(0, 0), cA, voffA); PG8_STAGE(PG8_SB(0, 1), cB + hstep, voffB); PG8_STAGE(PG8_SA(0, 1), cA + hstep, voffA);
        if (wr == 1) PG8_BAR;
        PG8_WAIT_V(4); PG8_BAR;
        PG8_STAGE(PG8_SB(1, 0), cB + kstep, voffB); PG8_STAGE(PG8_SA(1, 0), cA + kstep, voffA); PG8_STAGE(PG8_SB(1, 1), cB + hstep + kstep, voffB);
        PG8_WAIT_V(6); PG8_BAR;
    }
    for (;;) {
        const bool has_next = S.next(ui + 1, nxt);
        const char* nA = has_next ? P.a_tile(nxt) : cA; const char* nB = has_next ? P.b_tile(nxt) : cB;
        for (int t = 0; t < nt; t += 2) {
            const bool last = (t == nt - 2);
            const char* a1 = cA + (size_t)(t + 1) * kstep;
            const char* a2 = last ? nA : cA + (size_t)(t + 2) * kstep; const char* b2 = last ? nB : cB + (size_t)(t + 2) * kstep;
            const char* a3 = a2 + kstep; const char* b3 = b2 + kstep;
            if constexpr (SP2) {
            PG8_LDB(B0, 0, 0); PG8_LDB(B1, 0, 1); PG8_SCHED; PG8_LDA(At, 0, 0); PG8_STAGE(PG8_SA(1, 1), a1 + hstep, voffA);
            PG8_WAIT_V(8); PG8_WAIT_L(0); PG8_BAR; PG8_MMA(0, 0, At, B0); PG8_MMA(0, 1, At, B1); PG8_BAR; PG8_SCHED;
            PG8_LDA(At, 0, 1); PG8_STAGE(PG8_SB(0, 0), b2, voffB); PG8_STAGE(PG8_SB(0, 1), b2 + hstep, voffB); PG8_STAGE(PG8_SA(0, 0), a2, voffA);
            PG8_WAIT_V(8); PG8_WAIT_L(0); PG8_BAR; PG8_MMA(1, 0, At, B0); PG8_MMA(1, 1, At, B1); PG8_BAR; PG8_SCHED;
            PG8_LDB(B0, 1, 0); PG8_LDB(B1, 1, 1); PG8_SCHED; PG8_LDA(At, 1, 0); PG8_STAGE(PG8_SA(0, 1), a2 + hstep, voffA);
            PG8_WAIT_V(8); PG8_WAIT_L(0); PG8_BAR; PG8_MMA(0, 0, At, B0); PG8_MMA(0, 1, At, B1); PG8_BAR; PG8_SCHED;
            PG8_LDA(At, 1, 1); PG8_STAGE(PG8_SB(1, 0), b3, voffB); PG8_STAGE(PG8_SB(1, 1), b3 + hstep, voffB); PG8_STAGE(PG8_SA(1, 0), a3, voffA);
            PG8_WAIT_V(8); PG8_WAIT_L(0); PG8_BAR; PG8_MMA(1, 0, At, B0); PG8_MMA(1, 1, At, B1); PG8_BAR; PG8_SCHED;
            } else {
            PG8_LDB(B0, 0, 0); PG8_SCHED; PG8_LDA(At, 0, 0); PG8_STAGE(PG8_SA(1, 1), a1 + hstep, voffA);
            PG8_WAIT_L(8); PG8_BAR; PG8_WAIT_L(0); PG8_MMA(0, 0, At, B0); PG8_BAR; PG8_SCHED;
            PG8_LDB(B1, 0, 1); PG8_STAGE(PG8_SB(0, 0), b2, voffB);
            PG8_BAR; PG8_WAIT_L(0); PG8_MMA(0, 1, At, B1); PG8_BAR;
            PG8_LDA(At, 0, 1); PG8_STAGE(PG8_SA(0, 0), a2, voffA);
            PG8_BAR; PG8_WAIT_L(0); PG8_MMA(1, 0, At, B0); PG8_BAR; PG8_SCHED;
            PG8_STAGE(PG8_SB(0, 1), b2 + hstep, voffB);
            PG8_WAIT_V(6); PG8_BAR; PG8_MMA(1, 1, At, B1); PG8_BAR;
            PG8_LDB(B0, 1, 0); PG8_SCHED; PG8_LDA(At, 1, 0); PG8_STAGE(PG8_SA(0, 1), a2 + hstep, voffA);
            PG8_WAIT_L(8); PG8_BAR; PG8_WAIT_L(0); PG8_MMA(0, 0, At, B0); PG8_BAR; PG8_SCHED;
            PG8_LDB(B1, 1, 1); PG8_STAGE(PG8_SB(1, 0), b3, voffB);
            PG8_BAR; PG8_WAIT_L(0); PG8_MMA(0, 1, At, B1); PG8_BAR;
            PG8_LDA(At, 1, 1); PG8_STAGE(PG8_SA(1, 0), a3, voffA);
            PG8_BAR; PG8_WAIT_L(0); PG8_MMA(1, 0, At, B0); PG8_BAR; PG8_SCHED;
            PG8_STAGE(PG8_SB(1, 1), b3 + hstep, voffB);
            PG8_WAIT_V(6); PG8_BAR; PG8_MMA(1, 1, At, B1); PG8_BAR;
            }
        }
        if constexpr (ALIGN_EPI) { if (wr == 0) PG8_BAR; }
        E(acc, cur, wr, wc, fr, fq);
        if (!has_next) break;
#pragma unroll
        for (int a = 0; a < 2; ++a)
#pragma unroll
            for (int b = 0; b < 2; ++b)
#pragma unroll
                for (int m = 0; m < 4; ++m)
#pragma unroll
                    for (int n = 0; n < 2; ++n) acc[a][b][m][n] = (f32x4){0.f, 0.f, 0.f, 0.f};
        cur = nxt; cA = nA; cB = nB; ++ui;
        if constexpr (ALIGN_EPI) { if (wr == 1) PG8_BAR; }
    }
    PG8_WAIT_V(0);
    if constexpr (!ALIGN_EPI) { if (wr == 0) PG8_BAR; }
    PG8_BAR;
#undef PG8_SA
#undef PG8_SB
#undef PG8_STAGE
#undef PG8_LDA
#undef PG8_LDB
#undef PG8_MMA
#undef PG8_WAIT_V
#undef PG8_WAIT_L
#undef PG8_BAR
#undef PG8_SCHED
}
}

constexpr size_t MiB = 1u << 20;
constexpr size_t WS_CTL = 0, CTL_ZERO_BYTES = 64 * 1024;
constexpr size_t WS_W = 1 * MiB;
constexpr size_t WS_WIN_T = WS_W, WS_WOUT_T = WS_WIN_T + (size_t)DIN * D * 2, WS_W1_T = WS_WOUT_T + (size_t)D * D * 2, WS_W2_T = WS_W1_T + (size_t)DFF * D * 2;
constexpr size_t WS_WR_T = WS_W, WS_WK_T = WS_WR_T + 2 * MiB, WS_LDW_T = WS_WK_T + 2 * MiB, WS_WV_T = WS_LDW_T + 3 * MiB, WS_WO2_T = WS_WV_T + 2 * MiB, WS_W1B_T = WS_WO2_T + 4 * MiB, WS_W2B_T = WS_W1B_T + 8 * MiB;
static_assert(WS_W2_T + (size_t)D * DFF * 2 <= 31 * MiB && WS_W2B_T + (size_t)D * DFF * 2 <= 31 * MiB, "weight region");
constexpr size_t WS_XN = 31 * MiB, WS_QKV = 63 * MiB, WS_O = 135 * MiB, WS_OBR = 167 * MiB, WS_LSE = 215 * MiB, WS_TMP = 217 * MiB, WS_H = 63 * MiB;
constexpr size_t WS_MIXA = 63 * MiB, WS_MIXB = 95 * MiB, WS_R = 127 * MiB, WS_K = 159 * MiB, WS_V = 31 * MiB, WS_LDO = 191 * MiB, WS_Y = 63 * MiB, WS_LDA = 239 * MiB;
constexpr size_t WS_YSUM = 127 * MiB;
constexpr size_t WS_HBC = 191 * MiB, WS_TMP2 = 223 * MiB;
constexpr size_t WS_END = 256 * MiB;
static_assert(WS_HBC >= WS_H + (size_t)M * DFF * 2 && WS_HBC + (size_t)M * D * 2 <= WS_TMP2 && WS_TMP2 + (size_t)M * D * 2 <= WS_END, "layer-1 tail");
static_assert(WS_LDO + (size_t)M * NLD * 2 <= WS_LDA && WS_LDA + (size_t)M * 512 * 2 <= WS_END && WS_TMP + (size_t)M * D * 2 <= WS_END, "tail of the map");
static_assert(WS_MIXA == WS_XN + 32 * MiB && WS_MIXB == WS_XN + 64 * MiB && WS_K == WS_R + 32 * MiB && WS_LDO == WS_R + 64 * MiB && WS_WK_T == WS_WR_T + 2 * MiB && WS_LDW_T == WS_WR_T + 4 * MiB, "grouped GEMM strides");
constexpr int CW_BAR = 4096;

constexpr int RING_BYTES = 131072, LDSCTL_OFF = 143360, MISC_OFF = LDSCTL_OFF + 320, LDS_BYTES = 147456;

typedef __bf16 bf16x2_t __attribute__((ext_vector_type(2)));
__device__ __forceinline__ unsigned cvtpk(float lo, float hi) { const f32x2 v = {lo, hi}; const bf16x2_t b = __builtin_convertvector(v, bf16x2_t); return __builtin_bit_cast(unsigned, b); }
__device__ __forceinline__ float bf2f(unsigned short b) { return __uint_as_float((unsigned)b << 16); }
__device__ __forceinline__ float bflo(unsigned w) { return __uint_as_float(w << 16); }
__device__ __forceinline__ float bfhi(unsigned w) { return __uint_as_float(w & 0xffff0000u); }
__device__ __forceinline__ unsigned f2bf(float f) { unsigned u = __float_as_uint(f); return (u + 0x7fffu + ((u >> 16) & 1u)) >> 16; }
__device__ __forceinline__ unsigned pk2(float lo, float hi) { return f2bf(lo) | (f2bf(hi) << 16); }
__device__ __forceinline__ float wave_sum(float v) {
#pragma unroll
    for (int o = 1; o < 64; o <<= 1) v += __shfl_xor(v, o);
    return v;
}
__device__ __forceinline__ float sigmoidf_(float z) { return 1.f / (1.f + __expf(-z)); }
__device__ __forceinline__ int t5_bucket(int rel) {
    const int n = rel < 0 ? -rel : rel;
    int large;
    if (n < 8) large = n; else if (n < 15) large = 8; else if (n < 27) large = 9; else if (n < 50) large = 10; else if (n < 91) large = 11;
    else if (n < 166) large = 12; else if (n < 305) large = 13; else if (n < 559) large = 14; else large = 15;
    return (rel > 0 ? 16 : 0) + large;
}

#define XB_TMO      128
#define XB_XCNT(j)  (256  + 64 * (j))
#define XB_XSUB(j)  (1280 + 64 * (j))
#define XB_XGEN(j)  (2304 + 64 * (j))
#define XB_TOP      3328
#define XB_TOPGEN   3392
#define XCD_BAR_WORDS 3456
#define XB_SPIN_CAP (1u << 18)
__device__ __forceinline__ unsigned xb_ld(unsigned* p)              { return __hip_atomic_load(p, __ATOMIC_RELAXED, __HIP_MEMORY_SCOPE_AGENT); }
__device__ __forceinline__ unsigned xb_add(unsigned* p, unsigned v) { return __hip_atomic_fetch_add(p, v, __ATOMIC_RELAXED, __HIP_MEMORY_SCOPE_AGENT); }
__device__ __forceinline__ unsigned xb_xcc_id() { return (unsigned)__builtin_amdgcn_s_getreg((3 << 11) | 20) & 0xFu; }
#define XB_SPIN(cond, bar) do { unsigned _sp = 0; while (cond) { __builtin_amdgcn_s_sleep(1); \
    if ((++_sp & 255u) == 0u) { if (xb_ld(&(bar)[XB_TMO])) break; if (_sp > XB_SPIN_CAP) { atomicAdd(&(bar)[XB_TMO], 1u); break; } } } } while (0)
struct XcdBarrier { unsigned* bar; unsigned x; volatile LAS unsigned* st; };
__device__ __forceinline__ XcdBarrier xcd_barrier_post(unsigned* bar, volatile LAS unsigned* st) {
    XcdBarrier b; b.bar = bar; b.x = xb_xcc_id(); b.st = st;
    if (threadIdx.x == 0) (void)xb_add(&bar[XB_XCNT(b.x)], 1u);
    return b;
}
__device__ __forceinline__ void xcd_barrier_complete(unsigned* bar, unsigned x, unsigned& nloc, unsigned& nx) {
    const unsigned G = gridDim.x * gridDim.y * gridDim.z;
    unsigned sum, cnt, mine, sp = 0u;
    for (;;) {
        sum = 0u; cnt = 0u; mine = 0u;
#pragma unroll
        for (unsigned j = 0; j < 16; ++j) { const unsigned c = xb_ld(&bar[XB_XCNT(j)]); sum += c; cnt += (c > 0u) ? 1u : 0u; mine = (j == x) ? c : mine; }
        if (sum == G) break;
        __builtin_amdgcn_s_sleep(1);
        if ((++sp & 255u) == 0u) { if (xb_ld(&bar[XB_TMO])) break; if (sp > XB_SPIN_CAP) { atomicAdd(&bar[XB_TMO], 1u); break; } }
    }
    nloc = mine > 0u ? mine : 1u; nx = cnt > 0u ? cnt : 1u;
}
__device__ __forceinline__ void xcd_barrier(const XcdBarrier& b) {
    asm volatile("s_waitcnt vmcnt(0)" ::: "memory");
    __syncthreads();
    if (threadIdx.x == 0) {
        unsigned* bar = b.bar;
        __builtin_amdgcn_s_waitcnt(0);
        unsigned nloc = b.st[0], nx = b.st[1];
        if (nloc == 0u) { xcd_barrier_complete(bar, b.x, nloc, nx); b.st[0] = nloc; b.st[1] = nx; }
        const unsigned old = xb_add(&bar[XB_XSUB(b.x)], 1u);
        const unsigned gen = old / nloc;
        if (old + 1u == (gen + 1u) * nloc) {
            __builtin_amdgcn_fence(__ATOMIC_RELEASE, "agent");
            asm volatile("s_waitcnt vmcnt(0)" ::: "memory");
            const unsigned og = xb_add(&bar[XB_TOP], 1u);
            const unsigned tg = og / nx;
            if (og + 1u == (tg + 1u) * nx) xb_add(&bar[XB_TOPGEN], 1u);
            else XB_SPIN(xb_ld(&bar[XB_TOPGEN]) == tg, bar);
            __builtin_amdgcn_fence(__ATOMIC_ACQUIRE, "agent");
            xb_add(&bar[XB_XGEN(b.x)], 1u);
            asm volatile("s_waitcnt vmcnt(0)" ::: "memory");
        } else {
            XB_SPIN(xb_ld(&bar[XB_XGEN(b.x)]) == gen, bar);
            __builtin_amdgcn_fence(__ATOMIC_ACQUIRE, "agent");
            asm volatile("s_waitcnt vmcnt(0)" ::: "memory");
        }
    }
    __syncthreads();
}

#define XB_GRP(g)   (4096 + 16 * (g))
__device__ __forceinline__ void grp_barrier(unsigned* bar, unsigned g, unsigned& epoch) {
    asm volatile("s_waitcnt vmcnt(0)" ::: "memory");
    __syncthreads();
    ++epoch;
    if (threadIdx.x == 0) {
        unsigned* word = &bar[XB_GRP(g)];
        (void)xb_add(word, 1u);
        const unsigned tgt = 4u * epoch;
        XB_SPIN(xb_ld(word) < tgt, bar);
        __builtin_amdgcn_fence(__ATOMIC_ACQUIRE, "agent");
        asm volatile("s_waitcnt vmcnt(0)" ::: "memory");
    }
    __syncthreads();
}

struct Row16 { f32x4 v[4]; };
__device__ __forceinline__ int row_q(int lane, int j) { return 2 * lane + 128 * (j >> 1) + (j & 1); }
__device__ __forceinline__ void row_load_f32(Row16& r, const float* p, int lane) {
#pragma unroll
    for (int j = 0; j < 4; ++j) r.v[j] = ((const f32x4*)p)[row_q(lane, j)];
}
struct RowRaw { u32x4 w[2]; };
__device__ __forceinline__ void row_raw_load(RowRaw& r, const bf16_t* p, int lane) { r.w[0] = ((const u32x4*)p)[lane]; r.w[1] = ((const u32x4*)p)[lane + 64]; }
__device__ __forceinline__ void row_from_raw(Row16& r, const RowRaw& q) {
#pragma unroll
    for (int b = 0; b < 2; ++b) { const u32x4 w = q.w[b]; r.v[2 * b] = (f32x4){bflo(w.x), bfhi(w.x), bflo(w.y), bfhi(w.y)}; r.v[2 * b + 1] = (f32x4){bflo(w.z), bfhi(w.z), bflo(w.w), bfhi(w.w)}; }
}
__device__ __forceinline__ void row_load_bf16(Row16& r, const bf16_t* p, int lane) { RowRaw q; row_raw_load(q, p, lane); row_from_raw(r, q); }
__device__ __forceinline__ void row_store_f32(const Row16& r, float* p, int lane) {
#pragma unroll
    for (int j = 0; j < 4; ++j) pg8::store16_wt((f32x4*)p + row_q(lane, j), __builtin_bit_cast(u32x4, r.v[j]));
}
__device__ __forceinline__ void row_store_bf16(const Row16& r, bf16_t* p, int lane) {
#pragma unroll
    for (int b = 0; b < 2; ++b) { u32x4 w; w.x = cvtpk(r.v[2 * b][0], r.v[2 * b][1]); w.y = cvtpk(r.v[2 * b][2], r.v[2 * b][3]); w.z = cvtpk(r.v[2 * b + 1][0], r.v[2 * b + 1][1]); w.w = cvtpk(r.v[2 * b + 1][2], r.v[2 * b + 1][3]);
        pg8::store16_wt((u32x4*)p + lane + 64 * b, w); }
}
__device__ __forceinline__ void vec_load(Row16& r, const float* g, int lane) { row_load_f32(r, g, lane); }
__device__ __forceinline__ void row_rmsnorm_v(Row16& r, const Row16& g) {
    float s = 0.f;
#pragma unroll
    for (int j = 0; j < 4; ++j) s += r.v[j][0] * r.v[j][0] + r.v[j][1] * r.v[j][1] + r.v[j][2] * r.v[j][2] + r.v[j][3] * r.v[j][3];
    const float rs = rsqrtf(wave_sum(s) * (1.f / D) + NORM_EPS);
#pragma unroll
    for (int j = 0; j < 4; ++j) r.v[j] = r.v[j] * rs * g.v[j];
}
__device__ __forceinline__ void row_rmsnorm(Row16& r, const float* g, int lane) { Row16 gg; vec_load(gg, g, lane); row_rmsnorm_v(r, gg); }

constexpr int TR_SCR_BYTES = 64 * 65 * 4;
template <class ScaleFn>
__device__ __forceinline__ void transpose_item(const float* W, int ldw, int N, bf16_t* WT, int ldt, int row_off, int koff, LAS float* scr, int item, int lane, ScaleFn sc) {
    const int nblk = N / 64, kb = item / nblk, nb = item % nblk, k0 = 64 * kb, n0 = 64 * nb;
    const int lk = lane >> 4, ln4 = (lane & 15) * 4;
    f32x4 v[16];
#pragma unroll
    for (int i = 0; i < 16; ++i) v[i] = *(const f32x4*)(W + (size_t)(k0 + 4 * i + lk) * ldw + n0 + ln4);
#pragma unroll
    for (int i = 0; i < 16; ++i) { const int kk = 4 * i + lk; const float s = sc(k0 + kk); LAS float* d = scr + kk * 65 + ln4; d[0] = v[i][0] * s; d[1] = v[i][1] * s; d[2] = v[i][2] * s; d[3] = v[i][3] * s; }
    asm volatile("s_waitcnt lgkmcnt(0)" ::: "memory");
    const int c = lane >> 3, nn = lane & 7;
#pragma unroll
    for (int j = 0; j < 8; ++j) { const int n = nn + 8 * j; const LAS float* s = scr + (8 * c) * 65 + n;
        u32x4 o; o.x = cvtpk(s[0 * 65], s[1 * 65]); o.y = cvtpk(s[2 * 65], s[3 * 65]); o.z = cvtpk(s[4 * 65], s[5 * 65]); o.w = cvtpk(s[6 * 65], s[7 * 65]);
        pg8::store16_wt(WT + (size_t)(row_off + n0 + n) * ldt + koff + k0 + 8 * c, o); }
    asm volatile("s_waitcnt lgkmcnt(0)" ::: "memory");
}
struct ScaleOne { __device__ __forceinline__ float operator()(int) const { return 1.f; } };
struct ScaleVec { const float* g; __device__ __forceinline__ float operator()(int k) const { return g[k]; } };
struct ScaleMix { const float* mp; const float* mn; int part;
    __device__ __forceinline__ float operator()(int k) const { return part == 0 ? 1.f - mp[k] - mn[k] : (part == 1 ? mp[k] : mn[k]); } };

struct Args { const float* in[27]; float* out; unsigned char* ws; };

struct ProbPlain { const bf16_t* A; const bf16_t* Bt; int K;
    __device__ __forceinline__ const char* a_tile(const pg8::Unit& u) const { return (const char*)(A + (size_t)u.pm * 256 * K); }
    __device__ __forceinline__ const char* b_tile(const pg8::Unit& u) const { return (const char*)(Bt + (size_t)u.pn * 256 * K); } };
struct DstPlain { bf16_t* C; int ldc;
    __device__ __forceinline__ void operator()(const pg8::Unit& u, bf16_t*& base, int& ld) const { base = C + (size_t)u.pm * 256 * ldc + (size_t)u.pn * 256; ld = ldc; } };
struct ProbRKL { const unsigned char* ws; int K;
    __device__ __forceinline__ const char* a_tile(const pg8::Unit& u) const { const int g = u.pn < 4 ? 0 : (u.pn < 8 ? 1 : 2); const int ga = g == 2 ? 0 : g + 1;
        return (const char*)(ws + WS_XN + (size_t)ga * (32 * MiB) + (size_t)u.pm * 256 * D * 2); }
    __device__ __forceinline__ const char* b_tile(const pg8::Unit& u) const { const int g = u.pn < 4 ? 0 : (u.pn < 8 ? 1 : 2); const int t = u.pn - 4 * g;
        return (const char*)(ws + WS_WR_T + (size_t)g * (2 * MiB) + (size_t)t * 256 * D * 2); } };
struct DstRKL { unsigned char* ws;
    __device__ __forceinline__ void operator()(const pg8::Unit& u, bf16_t*& base, int& ld) const {
        const int g = u.pn < 4 ? 0 : (u.pn < 8 ? 1 : 2); const int t = u.pn - 4 * g; ld = g == 2 ? NLD : D;
        base = (bf16_t*)(ws + WS_R + (size_t)g * (32 * MiB)) + (size_t)u.pm * 256 * ld + (size_t)t * 256; } };


struct EpiHeadMajor {
    static constexpr bool PERM = true;
    bf16_t* O;
    __device__ __forceinline__ void operator()(const f32x4 (&acc)[2][2][4][2], const pg8::Unit& u, int wr, int wc, int fr, int fq) const {
        const int row0 = u.pm * 256 + wr * 64 + fr, col = (wc & 1) * 32 + 8 * fq;
#pragma unroll
        for (int bj = 0; bj < 2; ++bj) { bf16_t* hb = O + ((size_t)(u.pn * 4 + bj * 2 + (wc >> 1)) * M + row0) * 64 + col;
#pragma unroll
            for (int ai = 0; ai < 2; ++ai)
#pragma unroll
                for (int m = 0; m < 4; ++m) { const f32x4 v0 = acc[ai][bj][m][0], v1 = acc[ai][bj][m][1];
                    u32x4 w; w.x = cvtpk(v0[0], v0[1]); w.y = cvtpk(v0[2], v0[3]); w.z = cvtpk(v1[0], v1[1]); w.w = cvtpk(v1[2], v1[3]);
                    pg8::store16_wt(hb + (size_t)(ai * 128 + m * 16) * 64, w); } }
    }
};

template <int ACT, class Prob, class Dst>
__device__ __forceinline__ void run_gemm(LAS unsigned char* lds, const Prob& P, const Dst& Dd, int Mr, int Nv, int G) {
    pg8::StaticOrder S; S.init(Mr, Nv, G, (int)blockIdx.x);
    pg8::EpiBf16<ACT, Dst> E{Dd, nullptr};
    for (int rep = 0; rep < REP_GEMM; ++rep) pg8::gemm_phase<pg8::EpiBf16<ACT, Dst>, Prob, true, true>(lds, P, S, E);
}
template <int ACT, class Prob, class Dst>
__device__ __forceinline__ void run_gemm_rs(LAS unsigned char* lds, const Prob& P, const Dst& Dd, const float* rs, int Mr, int Nv, int G) {
    pg8::StaticOrder S; S.init(Mr, Nv, G, (int)blockIdx.x);
    pg8::EpiBf16<ACT, Dst, true> E{Dd, rs};
    pg8::gemm_phase<pg8::EpiBf16<ACT, Dst, true>, Prob, true, true>(lds, P, S, E);
}

template <bool BASE_F32, bool OUT_F32>
__device__ __forceinline__ void phase_resnorm(const void* base, const bf16_t* TMP, const float* g1, const float* g2, void* hout, bf16_t* XN, float* rs_out, int gw, int NGW, int lane) {
    Row16 G1, G2; vec_load(G1, g1, lane); if (XN) vec_load(G2, g2, lane);
    for (int row = gw; row < M; row += NGW) {
        Row16 t, b; row_load_bf16(t, TMP + (size_t)row * D, lane);
        if (BASE_F32) row_load_f32(b, (const float*)base + (size_t)row * D, lane); else row_load_bf16(b, (const bf16_t*)base + (size_t)row * D, lane);
        row_rmsnorm_v(t, G1);
#pragma unroll
        for (int j = 0; j < 4; ++j) b.v[j] = b.v[j] + t.v[j];
        if (OUT_F32) row_store_f32(b, (float*)hout + (size_t)row * D, lane); else row_store_bf16(b, (bf16_t*)hout + (size_t)row * D, lane);
        if (XN) { row_rmsnorm_v(b, G2); row_store_bf16(b, XN + (size_t)row * D, lane); }
        if (rs_out) {
            float s = 0.f;
#pragma unroll
            for (int j = 0; j < 4; ++j) s += b.v[j][0] * b.v[j][0] + b.v[j][1] * b.v[j][1] + b.v[j][2] * b.v[j][2] + b.v[j][3] * b.v[j][3];
            const float rsv = rsqrtf(wave_sum(s) * (1.f / D) + NORM_EPS);
            if (lane == 0) rs_out[row] = rsv; }
    }
}
__device__ __forceinline__ void phase_lda(const bf16_t* LDO, bf16_t* LDA, int gw, int NGW, int lane) {
    const float A = lane < 16 ? 2.f : 1.f, C = lane < 16 ? -1.f : 0.f; const bool id = lane >= 16 && lane < 32;
    for (int row = gw; row < M; row += NGW) { const int tt = row & (SEQ - 1);
        const u32x4 p0 = *(const u32x4*)(LDO + (size_t)row * NLD + 8 * lane);
        const u32x4 p1 = *(const u32x4*)(LDO + (size_t)(tt > 0 ? row - 1 : row) * NLD + 512 + 8 * lane), p2 = *(const u32x4*)(LDO + (size_t)(tt < SEQ - 1 ? row + 1 : row) * NLD + 1024 + 8 * lane);
        const float mp = tt > 0 ? 1.f : 0.f, mn = tt < SEQ - 1 ? 1.f : 0.f;
        u32x4 o;
#pragma unroll
        for (int w = 0; w < 4; ++w) { const float x0 = bflo(p0[w]) + mp * bflo(p1[w]) + mn * bflo(p2[w]), x1 = bfhi(p0[w]) + mp * bfhi(p1[w]) + mn * bfhi(p2[w]);
            const float y0 = A * __builtin_amdgcn_rcpf(1.f + __builtin_amdgcn_exp2f(-1.4426950408889634f * A * x0)) + C, y1 = A * __builtin_amdgcn_rcpf(1.f + __builtin_amdgcn_exp2f(-1.4426950408889634f * A * x1)) + C;
            o[w] = cvtpk(id ? x0 : y0, id ? x1 : y1); }
        pg8::store16_wt(LDA + (size_t)row * 512 + 8 * lane, o); }
}
__device__ __forceinline__ void mix_out(const Row16& up, const Row16& u, const Row16& un, const LAS f32x4* a, const LAS f32x4* b, bf16_t* dst, int lane) {
    Row16 o;
#pragma unroll
    for (int j = 0; j < 4; ++j) { const f32x4 av = a[j * 64 + lane], bv = b[j * 64 + lane]; o.v[j] = u.v[j] + (up.v[j] - u.v[j]) * av + (un.v[j] - u.v[j]) * bv; }
    row_store_bf16(o, dst, lane);
}
__device__ __forceinline__ void phase_mix3(LAS unsigned char* lds, const bf16_t* h, const float* g, const float* mup, const float* mun, bf16_t* XN, bf16_t* MR, bf16_t* MK, bf16_t* MV, int gw, int NGW, int tid, int lane) {
    LAS f32x4* mv = (LAS f32x4*)lds;
    __syncthreads();
    for (int x = tid; x < 6 * 256; x += NTHREADS) { const int vec = x >> 8, q = x & 255, c = vec < 2 ? 0 : (vec < 4 ? 2 : 3);
        const f32x4 val = ((const f32x4*)(((vec & 1) ? mun : mup) + c * D))[q];
        mv[vec * 256 + (2 * (q >> 7) + (q & 1)) * 64 + ((q & 127) >> 1)] = val; }
    __syncthreads();
    Row16 Gn; vec_load(Gn, g, lane);
    for (int ch = gw; ch < M / 8; ch += NGW) {
        const int r0 = ch * 8, t0 = r0 & (SEQ - 1);
        const bool hasp = t0 > 0, hasn = t0 + 8 < SEQ;
        const int rlast = hasn ? r0 + 8 : r0 + 7;
        RowRaw r0w, rA, rB, rC;
        row_raw_load(r0w, h + (size_t)(hasp ? r0 - 1 : r0) * D, lane);
        row_raw_load(rA, h + (size_t)r0 * D, lane); row_raw_load(rB, h + (size_t)(r0 + 1) * D, lane); row_raw_load(rC, h + (size_t)(r0 + 2) * D, lane);
        Row16 up, u, un;
        row_from_raw(up, r0w); row_rmsnorm_v(up, Gn);
        { const float m = hasp ? 1.f : 0.f;
#pragma unroll
          for (int j = 0; j < 4; ++j) up.v[j] = up.v[j] * m; }
        row_from_raw(u, rA); row_rmsnorm_v(u, Gn);
        rA = rB; rB = rC;
#pragma unroll 1
        for (int k = 1; k <= 8; ++k) {
            const int row = r0 - 1 + k;
            { const int nx = row + 3; row_raw_load(rC, h + (size_t)(nx < rlast ? nx : rlast) * D, lane); }
            row_from_raw(un, rA); row_rmsnorm_v(un, Gn);
            { const float m = (k == 8 && !hasn) ? 0.f : 1.f;
#pragma unroll
              for (int j = 0; j < 4; ++j) un.v[j] = un.v[j] * m; }
            row_store_bf16(u, XN + (size_t)row * D, lane);
            mix_out(up, u, un, mv, mv + 256, MR + (size_t)row * D, lane);
            mix_out(up, u, un, mv + 512, mv + 768, MK + (size_t)row * D, lane);
            mix_out(up, u, un, mv + 1024, mv + 1280, MV + (size_t)row * D, lane);
            up = u; u = un; rA = rB; rB = rC;
        }
    }
}

constexpr int ATT_ROWS = 400, ATT_KS = 0, ATT_VS = ATT_ROWS * 128, ATT_TAB = 2 * ATT_ROWS * 128, ATT_TABN = 320;
constexpr float LOG2E = 1.4426950408889634f;
typedef short v4i16_t __attribute__((ext_vector_type(4)));
__device__ __forceinline__ v4i16_t lds_tr16(LAS const unsigned char* p) { return __builtin_amdgcn_ds_read_tr16_b64_v4i16((LAS v4i16_t*)p); }

__device__ __forceinline__ float fmax_q(float a, float b) { return __builtin_amdgcn_fmed3f(a, b, __builtin_inff()); }
__device__ __forceinline__ float rows_max(float x) {
    auto a = __builtin_amdgcn_permlane16_swap(__float_as_uint(x), __float_as_uint(x), false, false); x = fmax_q(__uint_as_float(a[0]), __uint_as_float(a[1]));
    auto b = __builtin_amdgcn_permlane32_swap(__float_as_uint(x), __float_as_uint(x), false, false); return fmax_q(__uint_as_float(b[0]), __uint_as_float(b[1])); }
__device__ __forceinline__ float rows_sum(float x) {
    auto a = __builtin_amdgcn_permlane16_swap(__float_as_uint(x), __float_as_uint(x), false, false); x = __uint_as_float(a[0]) + __uint_as_float(a[1]);
    auto b = __builtin_amdgcn_permlane32_swap(__float_as_uint(x), __float_as_uint(x), false, false); return __uint_as_float(b[0]) + __uint_as_float(b[1]); }
struct AttnIO { const bf16_t* QKV; const float* rel_table; const float* sink; bf16_t* O; bf16_t* OBR; float* LSE; };
struct AttnUnitD { int b, dil, res, l0, nq, L, R, colK, colV, head0, ngroups, nit, branch, isB; };
__device__ __forceinline__ AttnUnitD attn_decode(int u) {
    AttnUnitD A;
    if (u < 256) { A.isB = 1; A.b = u >> 5; const int kvg = (u >> 4) & 1, blk = u & 15; A.dil = 1; A.res = 0; A.l0 = blk * 128; A.nq = 128; A.L = SEQ; A.R = 128; A.colK = 32 + kvg; A.colV = 34 + kvg; A.head0 = kvg * 4; A.ngroups = 32; A.nit = 9; A.branch = 0; }
    else if (u < 1280) { A.isB = 0; const int a = u - 256, bh = a >> 4, k = a & 15; A.b = bh >> 3; A.head0 = bh & 7; A.nq = 256; A.R = 64; A.ngroups = 16; A.nit = 5;
        if (k < 8) { A.dil = 1; A.res = 0; A.l0 = k * 256; A.L = SEQ; A.branch = 0; } else { A.dil = 4; A.res = (k - 8) >> 1; A.l0 = ((k - 8) & 1) * 256; A.L = SEQ / 4; A.branch = 1; }
        A.colK = 8 + A.head0; A.colV = 16 + A.head0; }
    else { A.isB = 0; const int a = u - 1280, bh = a >> 4; A.b = bh >> 3; A.head0 = bh & 7; A.dil = 16; A.res = a & 15; A.l0 = 0; A.nq = 128; A.L = SEQ / 16; A.R = 64; A.ngroups = 8; A.nit = 5; A.branch = 2; A.colK = 8 + A.head0; A.colV = 16 + A.head0; }
    return A;
}
constexpr int ATT_NST = 7;
__device__ __forceinline__ void attn_issue(const AttnUnitD& A, const bf16_t* QKV, int tid, u32x4 (&kr)[ATT_NST], u32x4 (&vr)[ATT_NST]) {
    const int ndata = A.nq + 2 * A.R, rv0 = (A.R - A.l0) > 0 ? (A.R - A.l0) : 0, rv1 = (A.L + A.R - A.l0) < ndata ? (A.L + A.R - A.l0) : ndata;
    const bf16_t* kb = QKV + ((size_t)A.colK * M + (size_t)A.b * SEQ) * 64; const bf16_t* vb = QKV + ((size_t)A.colV * M + (size_t)A.b * SEQ) * 64;
#pragma unroll
    for (int i = 0; i < ATT_NST; ++i) { const int x = tid + NTHREADS * i, c = x & 7; int row = x >> 3; row = row < rv0 ? rv0 : (row >= rv1 ? rv1 - 1 : row);
        const size_t o = (size_t)(A.res + A.dil * (A.l0 - A.R + row)) * 64 + c * 8; kr[i] = *(const u32x4*)(kb + o); vr[i] = *(const u32x4*)(vb + o); }
}

__device__ __forceinline__ void phase_attn(LAS unsigned char* lds, const AttnIO& io, int vcu, int G) {
    int tid = threadIdx.x; asm volatile("" : "+v"(tid));
    const int lane = tid & 63, wid = __builtin_amdgcn_readfirstlane(tid >> 6), g4 = lane >> 4, qi = lane & 15;
    LAS unsigned char* Ks = lds + ATT_KS; LAS unsigned char* Vs = lds + ATT_VS; LAS float* tab = (LAS float*)(lds + ATT_TAB);
    constexpr int NU = 256 + 1024 + 1024;
    u32x4 kr[ATT_NST], vr[ATT_NST];
    if (vcu < NU) { const AttnUnitD A0 = attn_decode(vcu); attn_issue(A0, io.QKV, tid, kr, vr); }
    for (int u = vcu; u < NU; u += G) {
        const AttnUnitD A = attn_decode(u);
        const int b = A.b, dil = A.dil, res = A.res, l0 = A.l0, R = A.R, head0 = A.head0, ngroups = A.ngroups, nit = A.nit, branch = A.branch; const bool isB = A.isB != 0;
        const int ndata = A.nq + 2 * R, rv0 = (R - l0) > 0 ? (R - l0) : 0, rv1 = (A.L + R - l0) < ndata ? (A.L + R - l0) : ndata;
        auto qptr = [&](int gx) -> const bf16_t* { const int hq_ = isB ? (gx >> 3) : 0, gi_ = isB ? (gx & 7) : gx; const int posq_ = res + dil * (l0 + 16 * gi_ + qi);
            return io.QKV + ((size_t)((isB ? 24 : 0) + head0 + hq_) * M + (size_t)b * SEQ + posq_) * 64 + 8 * g4; };
        u32x4 qr0, qr1; { const bf16_t* qp0 = qptr(wid); qr0 = *(const u32x4*)qp0; qr1 = *(const u32x4*)(qp0 + 32); }
        for (int reps = 0; reps < REP_ATTS; ++reps) {
        __syncthreads();
#pragma unroll
        for (int i = 0; i < ATT_NST; ++i) { const int x = tid + NTHREADS * i, row = x >> 3, c = x & 7;
            if (x < ATT_ROWS * 8) { const int off = row * 128 + ((c ^ (row & 7)) << 4); const bool ok = row >= rv0 && row < rv1; const u32x4 z = (u32x4){0u, 0u, 0u, 0u};
                *(LAS u32x4*)(Ks + off) = ok ? kr[i] : z; *(LAS u32x4*)(Vs + off) = ok ? vr[i] : z; } }
        { const int ntab = isB ? 4 : 1;
          for (int x = tid; x < ntab * ATT_TABN; x += NTHREADS) { const int t = x / ATT_TABN, j = x % ATT_TABN, idx = j - 16;
              float v = -1e30f;
              if (idx >= 0 && idx <= 2 * R) v = io.rel_table[t5_bucket((idx - R) * dil) * 16 + (isB ? 8 + head0 + t : head0)] * LOG2E;
              tab[x] = v; } }
        }
        if (u + G < NU) { const AttnUnitD An = attn_decode(u + G); attn_issue(An, io.QKV, tid, kr, vr); }
        __syncthreads();
        for (int rep = 0; rep < REP_ATTC; ++rep)
        for (int gidx = wid; gidx < ngroups; gidx += NWAVES) {
            const int hq = isB ? (gidx >> 3) : 0, gi = isB ? (gidx & 7) : gidx, head = head0 + hq;
            const int ql = 16 * gi + qi, posq = res + dil * (l0 + ql);
            const LAS float* tb = tab + hq * ATT_TABN + 16;
            bf16x8 qf[2];
            { const u32x4 wq[2] = {qr0, qr1}; const float SC = 0.125f * LOG2E;
              { const int gn = gidx + NWAVES < ngroups ? gidx + NWAVES : gidx; const bf16_t* qpn = qptr(gn); qr0 = *(const u32x4*)qpn; qr1 = *(const u32x4*)(qpn + 32); }
#pragma unroll
              for (int ks = 0; ks < 2; ++ks) { const u32x4 w = wq[ks]; u32x4 o;
                  o.x = cvtpk(bflo(w.x) * SC, bfhi(w.x) * SC); o.y = cvtpk(bflo(w.y) * SC, bfhi(w.y) * SC); o.z = cvtpk(bflo(w.z) * SC, bfhi(w.z) * SC); o.w = cvtpk(bflo(w.w) * SC, bfhi(w.w) * SC);
                  qf[ks] = __builtin_bit_cast(bf16x8, o); } }
            f32x4 ot[4], lacc = (f32x4){0.f, 0.f, 0.f, 0.f};
#pragma unroll
            for (int dt = 0; dt < 4; ++dt) ot[dt] = (f32x4){0.f, 0.f, 0.f, 0.f};
            float m = -1e20f;
            const bf16x8 ones = __builtin_bit_cast(bf16x8, qi == 0 ? (u32x4){0x3F803F80u, 0x3F803F80u, 0x3F803F80u, 0x3F803F80u} : (u32x4){0u, 0u, 0u, 0u});
            bf16x8 kf[2][2];
            const LAS unsigned char* kp[2];
            { const int r0 = 16 * gi + qi;
#pragma unroll
              for (int ks = 0; ks < 2; ++ks) { const int c = g4 + 4 * ks; kp[ks] = Ks + r0 * 128 + ((c ^ (r0 & 7)) << 4); asm volatile("" : "+v"(kp[ks]));
                  kf[ks][0] = *(const LAS bf16x8*)(kp[ks]); kf[ks][1] = *(const LAS bf16x8*)(kp[ks] + 16 * 128); } }
            const LAS unsigned char* vp[4];
            { const int ra0 = 16 * gi + 4 * g4 + (qi >> 2);
#pragma unroll
              for (int dt = 0; dt < 4; ++dt) { const int ch = dt * 2 + ((qi & 3) >> 1); vp[dt] = Vs + ra0 * 128 + ((ch ^ (ra0 & 7)) << 4) + 8 * (qi & 1); asm volatile("" : "+v"(vp[dt])); } }
            const LAS float* tbq = tb + 4 * g4 - qi; asm volatile("" : "+v"(tbq));
            f32x4 c0, c1;
#pragma unroll
            for (int r = 0; r < 4; ++r) { c0[r] = tbq[r]; c1[r] = tbq[16 + r]; }
            for (int it = 0; it < nit; ++it) {
                const int rb = 16 * gi + 32 * it;
                v4i16_t vlo[4], vhi[4];
#pragma unroll
                for (int dt = 0; dt < 4; ++dt) { vlo[dt] = lds_tr16(vp[dt]); vhi[dt] = lds_tr16(vp[dt] + 16 * 128); vp[dt] += 4096; }
                f32x4 s0 = c0, s1 = c1;
#pragma unroll
                for (int ks = 0; ks < 2; ++ks) { s0 = __builtin_amdgcn_mfma_f32_16x16x32_bf16(kf[ks][0], qf[ks], s0, 0, 0, 0); s1 = __builtin_amdgcn_mfma_f32_16x16x32_bf16(kf[ks][1], qf[ks], s1, 0, 0, 0); }
                if (it + 1 < nit) {
#pragma unroll
                    for (int ks = 0; ks < 2; ++ks) { kp[ks] += 4096; kf[ks][0] = *(const LAS bf16x8*)(kp[ks]); kf[ks][1] = *(const LAS bf16x8*)(kp[ks] + 16 * 128); } }
                tbq += 32;
#pragma unroll
                for (int r = 0; r < 4; ++r) { c0[r] = tbq[r]; c1[r] = tbq[16 + r]; }
                float v[8];
                if (rb < rv0 || rb + 32 > rv1) {
#pragma unroll
                    for (int r = 0; r < 4; ++r) { const int row0 = rb + 4 * g4 + r, row1 = row0 + 16;
                        const bool ok0 = (unsigned)(row0 - rv0) < (unsigned)(rv1 - rv0), ok1 = (unsigned)(row1 - rv0) < (unsigned)(rv1 - rv0);
                        v[r] = ok0 ? s0[r] : -1e30f; v[4 + r] = ok1 ? s1[r] : -1e30f; }
                } else {
#pragma unroll
                    for (int r = 0; r < 4; ++r) { v[r] = s0[r]; v[4 + r] = s1[r]; }
                }
                float d[8];
#pragma unroll
                for (int i = 0; i < 8; ++i) d[i] = v[i] - m;
                const float dm = fmaxf(fmaxf(fmaxf(d[0], d[1]), fmaxf(d[2], d[3])), fmaxf(fmaxf(d[4], d[5]), fmaxf(d[6], d[7])));
                if (__builtin_amdgcn_ballot_w64(dm > 8.f) != 0ull) {
                    float tmax = fmaxf(fmaxf(fmaxf(v[0], v[1]), fmaxf(v[2], v[3])), fmaxf(fmaxf(v[4], v[5]), fmaxf(v[6], v[7])));
                    tmax = rows_max(tmax);
                    const float mn = fmaxf(m, tmax), alpha = __builtin_amdgcn_exp2f(m - mn); m = mn;
                    lacc[0] = lacc[0] * alpha;
#pragma unroll
                    for (int dt = 0; dt < 4; ++dt) ot[dt] = ot[dt] * alpha;
#pragma unroll
                    for (int i = 0; i < 8; ++i) d[i] = v[i] - mn;
                }
#pragma unroll
                for (int i = 0; i < 8; ++i) v[i] = __builtin_amdgcn_exp2f(d[i]);
                u32x4 pw; pw.x = cvtpk(v[0], v[1]); pw.y = cvtpk(v[2], v[3]); pw.z = cvtpk(v[4], v[5]); pw.w = cvtpk(v[6], v[7]);
                const bf16x8 pf = __builtin_bit_cast(bf16x8, pw);
                lacc = __builtin_amdgcn_mfma_f32_16x16x32_bf16(ones, pf, lacc, 0, 0, 0);
#pragma unroll
                for (int dt = 0; dt < 4; ++dt) { const bf16x8 vf = (bf16x8){vlo[dt][0], vlo[dt][1], vlo[dt][2], vlo[dt][3], vhi[dt][0], vhi[dt][1], vhi[dt][2], vhi[dt][3]};
                    ot[dt] = __builtin_amdgcn_mfma_f32_16x16x32_bf16(vf, pf, ot[dt], 0, 0, 0); }
            }
            float lsum = lacc[0];
            lsum = rows_sum(lsum);
            const size_t tok = (size_t)b * SEQ + posq;
            float scale;
            if (isB) { const float s2 = io.sink[head] * LOG2E, mf = fmaxf(m, s2), e = __builtin_amdgcn_exp2f(m - mf); scale = e / (lsum * e + __builtin_amdgcn_exp2f(s2 - mf)); }
            else { scale = 1.f / lsum; if (g4 == 0) io.LSE[((size_t)branch * M + tok) * 8 + head] = m + __builtin_amdgcn_logf(lsum); }
            bf16_t* op = isB ? io.O + tok * D + 512 + head * 64 : io.OBR + ((size_t)branch * M + tok) * 512 + head * 64;
#pragma unroll
            for (int dt = 0; dt < 4; ++dt) { const f32x4 o = ot[dt] * scale; u32x2 w; w.x = cvtpk(o[0], o[1]); w.y = cvtpk(o[2], o[3]); *(u32x2*)(op + dt * 16 + 4 * g4) = w; }
        }
    }
}
__device__ __forceinline__ void phase_attn_merge(const AttnIO& io, int gtid, int NGT) {
    for (int x = gtid; x < M * 64; x += NGT) { const int tok = x >> 6, head = (x >> 3) & 7, c8 = x & 7;
        const float l0 = io.LSE[((size_t)0 * M + tok) * 8 + head], l1 = io.LSE[((size_t)1 * M + tok) * 8 + head], l2 = io.LSE[((size_t)2 * M + tok) * 8 + head];
        const float mx = fmaxf(l0, fmaxf(l1, l2)); float w0 = __builtin_amdgcn_exp2f(l0 - mx), w1 = __builtin_amdgcn_exp2f(l1 - mx), w2 = __builtin_amdgcn_exp2f(l2 - mx);
        const float inv = 1.f / (w0 + w1 + w2); w0 *= inv; w1 *= inv; w2 *= inv;
        const size_t o = (size_t)tok * 512 + head * 64 + c8 * 8;
        const u32x4 a = *(const u32x4*)(io.OBR + o), bq = *(const u32x4*)(io.OBR + (size_t)M * 512 + o), c = *(const u32x4*)(io.OBR + (size_t)2 * M * 512 + o);
        u32x4 r;
        r.x = pk2(w0 * bflo(a.x) + w1 * bflo(bq.x) + w2 * bflo(c.x), w0 * bfhi(a.x) + w1 * bfhi(bq.x) + w2 * bfhi(c.x));
        r.y = pk2(w0 * bflo(a.y) + w1 * bflo(bq.y) + w2 * bflo(c.y), w0 * bfhi(a.y) + w1 * bfhi(bq.y) + w2 * bfhi(c.y));
        r.z = pk2(w0 * bflo(a.z) + w1 * bflo(bq.z) + w2 * bflo(c.z), w0 * bfhi(a.z) + w1 * bfhi(bq.z) + w2 * bfhi(c.z));
        r.w = pk2(w0 * bflo(a.w) + w1 * bflo(bq.w) + w2 * bflo(c.w), w0 * bfhi(a.w) + w1 * bfhi(bq.w) + w2 * bfhi(c.w));
        pg8::store16_wt(io.O + (size_t)tok * D + head * 64 + c8 * 8, r); }
}

constexpr int NCH = SEQ / 16;
constexpr int SC_LROW = 68, SC_LDROW = 528, SC_LSLOT = 4 * 16 * SC_LROW * 4 + 16 * SC_LDROW;
constexpr int CT_KHT = 0, CT_RHT = 2048, CT_BTT = 4096, CT_KTT = 6144, CT_VT = 8192, CT_WEND = 10240, CT_SLOT = CT_WEND + 256;
constexpr int GT_AKK = 0, GT_BB = 512, GT_BK = 1024, GT_TT = 1536, GT_SLOT = 2048;
constexpr int SC_LBUF = 0, SC_CT = SC_LBUF + 2 * SC_LSLOT, SC_GG = SC_CT + 3 * CT_SLOT, SC_RKR = SC_GG + 4 * 4096, SC_GT = SC_RKR + 4 * 256, SC_NB = SC_GT + 2 * GT_SLOT, SC_OUT = SC_NB + 1024, SC_END = SC_OUT + 2 * 4096;
static_assert(SC_END <= LDSCTL_OFF, "scan LDS map");
template <int CTRL> __device__ __forceinline__ float dpp_f(float x) { return __int_as_float(__builtin_amdgcn_update_dpp(0, __float_as_int(x), CTRL, 0xf, 0xf, true)); }
__device__ __forceinline__ float sum8(float x) { x += dpp_f<0xB1>(x); x += dpp_f<0x4E>(x); x += dpp_f<0x141>(x); return x; }
__device__ __forceinline__ float sum16(float x) { x += dpp_f<0xB1>(x); x += dpp_f<0x4E>(x); x += dpp_f<0x141>(x); x += dpp_f<0x140>(x); return x; }
__device__ __forceinline__ float fast_sigmoid(float z) { return __builtin_amdgcn_rcpf(1.f + __builtin_amdgcn_exp2f(-LOG2E * z)); }
__device__ __forceinline__ bf16x8 mk8(unsigned a, unsigned b, unsigned c, unsigned d) { return __builtin_bit_cast(bf16x8, (u32x4){a, b, c, d}); }

struct ScanPtrs { const bf16_t *R, *Kk, *V, *LDA; bf16_t* Y; const float *w2, *a2, *g2, *w0, *a0, *k_k, *k_a, *r_k, *gn_w, *gn_b; };
__device__ __forceinline__ void phase_scan(LAS unsigned char* lds, const ScanPtrs& P, int G) {
    int tid = threadIdx.x; asm volatile("" : "+v"(tid));
    const int lane = tid & 63, wid = __builtin_amdgcn_readfirstlane(tid >> 6), g4 = lane >> 4, c16 = lane & 15;
    for (int unit = blockIdx.x; unit < 256; unit += G) {
        const int b = unit >> 5, h = (unit >> 1) & 15, d = unit & 1, hc = h * 64;
        unsigned long long wait_acc = 0ull;
        __syncthreads();
        if (wid < 4) {
            f32x4 ST[4];
#pragma unroll
            for (int mt = 0; mt < 4; ++mt) ST[mt] = (f32x4){0.f, 0.f, 0.f, 0.f};
            const int pch = hc + 8 * (lane & 7);
            const f32x4 gw0 = *(const f32x4*)(P.gn_w + pch), gw1 = *(const f32x4*)(P.gn_w + pch + 4), gb0 = *(const f32x4*)(P.gn_b + pch), gb1 = *(const f32x4*)(P.gn_b + pch + 4);
            u32x4 pvA = {0u, 0u, 0u, 0u}, pvB = pvA;
            auto issueV = [&](int ch_, u32x4& dst) { const int s = 8 * (wid - 1) + (lane >> 3), t = d ? (SEQ - 1 - (ch_ * 16 + s)) : (ch_ * 16 + s); dst = *(const u32x4*)(P.V + ((size_t)b * SEQ + t) * D + pch); };
            if (wid == 1 || wid == 2) { issueV(0, pvA); issueV(1, pvB); }
            auto sw_interval = [&](int i, u32x4& pvset) {
                const int c = i - 3;
                int ln = lane; asm volatile("" : "+v"(ln)); const int g4 = ln >> 4, c16 = ln & 15;
                if (c >= 0 && c < NCH) {
                    const LAS unsigned char* Ct = lds + SC_CT + (c % 3) * CT_SLOT; const LAS unsigned char* Gt = lds + SC_GT + (c & 1) * GT_SLOT;
                    v4i16_t kha[2][2], rha[2][2];
#pragma unroll
                    for (int p = 0; p < 2; ++p)
#pragma unroll
                        for (int hh = 0; hh < 2; ++hh) { const int off = (32 * p + 16 * hh + 4 * g4 + (c16 >> 2)) * 32 + 8 * (c16 & 3); kha[p][hh] = lds_tr16(Ct + CT_KHT + off); rha[p][hh] = lds_tr16(Ct + CT_RHT + off); }
                    const u32x2 gakk = *(const LAS u32x2*)(Gt + GT_AKK + c16 * 32 + 8 * g4), gtt = *(const LAS u32x2*)(Gt + GT_TT + c16 * 32 + 8 * g4);
                    const u32x2 gbb = *(const LAS u32x2*)(Gt + GT_BB + c16 * 32 + 8 * g4), gbk = *(const LAS u32x2*)(Gt + GT_BK + c16 * 32 + 8 * g4);
                    const u32x2 vt = *(const LAS u32x2*)(Ct + CT_VT + (16 * wid + c16) * 32 + 8 * g4);
                    u32x2 btt[4], ktt[4]; f32x4 we[4];
#pragma unroll
                    for (int mt = 0; mt < 4; ++mt) { btt[mt] = *(const LAS u32x2*)(Ct + CT_BTT + (16 * mt + c16) * 32 + 8 * g4); ktt[mt] = *(const LAS u32x2*)(Ct + CT_KTT + (16 * mt + c16) * 32 + 8 * g4);
                        we[mt] = *(const LAS f32x4*)(Ct + CT_WEND + (16 * mt + 4 * g4) * 4); }
                    f32x4 pt = {0.f, 0.f, 0.f, 0.f}, prt = pt;
#pragma unroll
                    for (int p = 0; p < 2; ++p) { const bf16x8 sb = mk8(cvtpk(ST[2 * p][0], ST[2 * p][1]), cvtpk(ST[2 * p][2], ST[2 * p][3]), cvtpk(ST[2 * p + 1][0], ST[2 * p + 1][1]), cvtpk(ST[2 * p + 1][2], ST[2 * p + 1][3]));
                        pt = __builtin_amdgcn_mfma_f32_16x16x32_bf16((bf16x8){kha[p][0][0], kha[p][0][1], kha[p][0][2], kha[p][0][3], kha[p][1][0], kha[p][1][1], kha[p][1][2], kha[p][1][3]}, sb, pt, 0, 0, 0);
                        prt = __builtin_amdgcn_mfma_f32_16x16x32_bf16((bf16x8){rha[p][0][0], rha[p][0][1], rha[p][0][2], rha[p][0][3], rha[p][1][0], rha[p][1][1], rha[p][1][2], rha[p][1][3]}, sb, prt, 0, 0, 0); }
                    const f32x4 qt = __builtin_amdgcn_mfma_f32_16x16x32_bf16(mk8(gakk.x, gakk.y, 0u, 0u), mk8(vt.x, vt.y, 0u, 0u), pt, 0, 0, 0);
                    const f32x4 sat = __builtin_amdgcn_mfma_f32_16x16x32_bf16(mk8(gtt.x, gtt.y, 0u, 0u), mk8(cvtpk(qt[0], qt[1]), cvtpk(qt[2], qt[3]), 0u, 0u), (f32x4){0.f, 0.f, 0.f, 0.f}, 0, 0, 0);
                    const bf16x8 sv = mk8(cvtpk(sat[0], sat[1]), cvtpk(sat[2], sat[3]), vt.x, vt.y);
                    const f32x4 outt = __builtin_amdgcn_mfma_f32_16x16x32_bf16(mk8(gbb.x, gbb.y, gbk.x, gbk.y), sv, prt, 0, 0, 0);
#pragma unroll
                    for (int mt = 0; mt < 4; ++mt) { ST[mt] = __builtin_amdgcn_mfma_f32_16x16x32_bf16(mk8(btt[mt].x, btt[mt].y, ktt[mt].x, ktt[mt].y), sv, ST[mt], 0, 0, 0); ST[mt] = ST[mt] * we[mt]; }
                    LAS float* ob = (LAS float*)(lds + SC_OUT + (c & 1) * 4096) + 16 * wid + c16;
#pragma unroll
                    for (int r = 0; r < 4; ++r) ob[(4 * g4 + r) * 64] = outt[r];
                }
                for (int rep_ = 0; rep_ < REP_ST; ++rep_)
                if (i >= 2 && i - 2 < NCH) {
                    const int jg = i - 2, hw = wid;
                    const LAS unsigned char* Ct = lds + SC_CT + (jg % 3) * CT_SLOT; LAS unsigned char* Gt = lds + SC_GT + (jg & 1) * GT_SLOT;
                    const int aoff = (hw & 1) ? CT_KTT : CT_BTT, boff = (hw & 2) ? CT_RHT : CT_KHT;
                    f32x4 gm = {0.f, 0.f, 0.f, 0.f}, gmT = gm;
#pragma unroll
                    for (int ks = 0; ks < 2; ++ks) { const int o1 = (8 * g4 + 32 * ks + (c16 >> 2)) * 32 + 8 * (c16 & 3), o2 = o1 + 4 * 32;
                        const v4i16_t a0 = lds_tr16(Ct + aoff + o1), a1 = lds_tr16(Ct + aoff + o2), b0 = lds_tr16(Ct + boff + o1), b1 = lds_tr16(Ct + boff + o2);
                        const bf16x8 af = {a0[0], a0[1], a0[2], a0[3], a1[0], a1[1], a1[2], a1[3]}, bfr = {b0[0], b0[1], b0[2], b0[3], b1[0], b1[1], b1[2], b1[3]};
                        gm = __builtin_amdgcn_mfma_f32_16x16x32_bf16(af, bfr, gm, 0, 0, 0);
                        if (hw == 0) gmT = __builtin_amdgcn_mfma_f32_16x16x32_bf16(bfr, af, gmT, 0, 0, 0); }
#pragma unroll
                    for (int r = 0; r < 4; ++r) { const int s = 4 * g4 + r; const bool keep = (hw & 2) ? (s <= c16) : (s < c16); gm[r] = keep ? gm[r] : 0.f; gmT[r] = (c16 < s) ? gmT[r] : 0.f; }
                    if (hw != 0) { *(LAS u32x2*)(Gt + (hw == 1 ? GT_AKK : (hw == 2 ? GT_BB : GT_BK)) + c16 * 32 + 8 * g4) = (u32x2){cvtpk(gm[0], gm[1]), cvtpk(gm[2], gm[3])}; }
                    else {
#define SC_OPA(x) mk8(cvtpk((x)[0], (x)[1]), cvtpk((x)[2], (x)[3]), 0u, 0u)
                        const f32x4 z4 = {0.f, 0.f, 0.f, 0.f};
                        f32x4 Rm, RTm;
#pragma unroll
                        for (int r = 0; r < 4; ++r) { const float idn = (4 * g4 + r == c16) ? 1.f : 0.f; Rm[r] = idn - gm[r]; RTm[r] = idn - gmT[r]; }
                        const f32x4 N2 = __builtin_amdgcn_mfma_f32_16x16x32_bf16(SC_OPA(gmT), SC_OPA(gm), z4, 0, 0, 0), N2T = __builtin_amdgcn_mfma_f32_16x16x32_bf16(SC_OPA(gm), SC_OPA(gmT), z4, 0, 0, 0);
                        f32x4 R1 = __builtin_amdgcn_mfma_f32_16x16x32_bf16(SC_OPA(RTm), SC_OPA(N2), Rm, 0, 0, 0), R1T = __builtin_amdgcn_mfma_f32_16x16x32_bf16(SC_OPA(N2), SC_OPA(RTm), RTm, 0, 0, 0);
                        const f32x4 N4 = __builtin_amdgcn_mfma_f32_16x16x32_bf16(SC_OPA(N2T), SC_OPA(N2), z4, 0, 0, 0), N4T = __builtin_amdgcn_mfma_f32_16x16x32_bf16(SC_OPA(N2), SC_OPA(N2T), z4, 0, 0, 0);
                        f32x4 R2 = __builtin_amdgcn_mfma_f32_16x16x32_bf16(SC_OPA(R1T), SC_OPA(N4), R1, 0, 0, 0), R2T = __builtin_amdgcn_mfma_f32_16x16x32_bf16(SC_OPA(N4), SC_OPA(R1T), R1T, 0, 0, 0);
                        const f32x4 N8 = __builtin_amdgcn_mfma_f32_16x16x32_bf16(SC_OPA(N4T), SC_OPA(N4), z4, 0, 0, 0);
                        const f32x4 Tm = __builtin_amdgcn_mfma_f32_16x16x32_bf16(SC_OPA(R2T), SC_OPA(N8), R2, 0, 0, 0);
#undef SC_OPA
                        *(LAS u32x2*)(Gt + GT_TT + c16 * 32 + 8 * g4) = (u32x2){cvtpk(-Tm[0], -Tm[1]), cvtpk(-Tm[2], -Tm[3])};
                    }
                }
                if ((wid == 1 || wid == 2) && i >= 4 && i - 4 < NCH) {
                    const int jp = i - 4, tl = ln >> 3, c8 = ln & 7;
                    const int s = 8 * (wid - 1) + tl, t = d ? (SEQ - 1 - (jp * 16 + s)) : (jp * 16 + s);
                    const LAS float* ob = (const LAS float*)(lds + SC_OUT + (jp & 1) * 4096) + s * 64 + 8 * c8; const LAS float* gp = (const LAS float*)(lds + SC_GG + (jp & 3) * 4096) + s * 64 + 8 * c8;
                    const f32x4 o0 = *(const LAS f32x4*)(ob), o1 = *(const LAS f32x4*)(ob + 4), g0 = *(const LAS f32x4*)(gp), g1 = *(const LAS f32x4*)(gp + 4);
                    const f32x4 rk4 = *(const LAS f32x4*)((const LAS float*)(lds + SC_RKR + (jp & 3) * 256) + s * 4); const float rkr = (rk4[0] + rk4[1]) + (rk4[2] + rk4[3]);
                    const u32x4 pv = pvset; issueV(jp + 2 < NCH ? jp + 2 : NCH - 1, pvset);
                    const f32x4 v0 = {bflo(pv.x), bfhi(pv.x), bflo(pv.y), bfhi(pv.y)}, v1 = {bflo(pv.z), bfhi(pv.z), bflo(pv.w), bfhi(pv.w)};
                    float mu = ((o0[0] + o0[1]) + (o0[2] + o0[3])) + ((o1[0] + o1[1]) + (o1[2] + o1[3])); mu = sum8(mu) * (1.f / 64.f);
                    const f32x4 d0 = o0 - mu, d1 = o1 - mu; float var = ((d0[0] * d0[0] + d0[1] * d0[1]) + (d0[2] * d0[2] + d0[3] * d0[3])) + ((d1[0] * d1[0] + d1[1] * d1[1]) + (d1[2] * d1[2] + d1[3] * d1[3])); var = sum8(var) * (1.f / 64.f);
                    const float rs = rsqrtf(var + GN_EPS);
                    const f32x4 y0 = (d0 * rs * gw0 + gb0 + rkr * v0) * g0, y1 = (d1 * rs * gw1 + gb1 + rkr * v1) * g1;
                    pg8::store16_wt(P.Y + ((size_t)b * SEQ + t) * (2 * D) + d * D + hc + 8 * c8, (u32x4){cvtpk(y0[0], y0[1]), cvtpk(y0[2], y0[3]), cvtpk(y1[0], y1[1]), cvtpk(y1[2], y1[3])});
                }
                for (int rep_ = 0; rep_ < REP_SYNC; ++rep_) __syncthreads();
                if (WAITPROBE >= 0) { const unsigned long long t0_ = __builtin_amdgcn_s_memrealtime(); __syncthreads(); wait_acc += __builtin_amdgcn_s_memrealtime() - t0_; } else
                __syncthreads();
            };
            static_assert((NCH + 4) % 2 == 0, "interval loop is unrolled by two");
            __builtin_amdgcn_s_setprio(2);
            for (int i = 0; i < NCH + 4; i += 2) { sw_interval(i, pvA); sw_interval(i + 1, pvB); }
            __builtin_amdgcn_s_setprio(0);
        } else {
            const int hw = wid - 4;
            const int chC = hc + 16 * hw + c16, chT = hc + 4 * c16;
            bf16x8 bw[2], ba[2], bg[4];
#pragma unroll
            for (int ks = 0; ks < 2; ++ks) { u32x4 w, a;
#pragma unroll
                for (int jj = 0; jj < 4; ++jj) { const int k = 32 * ks + 8 * g4 + 2 * jj;
                    w[jj] = pk2(-LOG2E * P.w2[(size_t)(d * 64 + k) * D + chC], -LOG2E * P.w2[(size_t)(d * 64 + k + 1) * D + chC]); a[jj] = pk2(-LOG2E * P.a2[(size_t)(d * 64 + k) * D + chC], -LOG2E * P.a2[(size_t)(d * 64 + k + 1) * D + chC]); }
                bw[ks] = __builtin_bit_cast(bf16x8, w); ba[ks] = __builtin_bit_cast(bf16x8, a); }
#pragma unroll
            for (int ks = 0; ks < 4; ++ks) { u32x4 g;
#pragma unroll
                for (int jj = 0; jj < 4; ++jj) { const int k = 32 * ks + 8 * g4 + 2 * jj; g[jj] = pk2(P.g2[(size_t)(d * 128 + k) * D + chC], P.g2[(size_t)(d * 128 + k + 1) * D + chC]); }
                bg[ks] = __builtin_bit_cast(bf16x8, g); }
            const float w0c = -LOG2E * P.w0[d * D + chC], a0c = -LOG2E * P.a0[d * D + chC], kaC = P.k_a[chC], rkC = P.r_k[chC];
            const f32x4 kkT = *(const f32x4*)(P.k_k + chT);
            const int n0 = 16 * c16, lcol = n0 < 64 ? (d * 64 + n0) : (n0 < 128 ? (128 + d * 64 + (n0 - 64)) : (256 + d * 128 + (n0 - 128)));
            struct LSet { u32x2 r, k, v; u32x4 l0, l1; };
            LSet setA, setB;
            auto issueL = [&](int ch_, LSet& S) { const int s = 4 * hw + g4, t = d ? (SEQ - 1 - (ch_ * 16 + s)) : (ch_ * 16 + s); const size_t row = (size_t)b * SEQ + t;
                S.r = *(const u32x2*)(P.R + row * D + chT); S.k = *(const u32x2*)(P.Kk + row * D + chT); S.v = *(const u32x2*)(P.V + row * D + chT);
                S.l0 = *(const u32x4*)(P.LDA + row * 512 + lcol); S.l1 = *(const u32x4*)(P.LDA + row * 512 + lcol + 8); };
            issueL(0, setA); issueL(1, setB);
            auto hw_interval = [&](int i, LSet& LS) {
                const bool doL = i < NCH, doC = (i >= 1 && i - 1 < NCH);
                int ln = lane; asm volatile("" : "+v"(ln)); const int g4 = ln >> 4, c16 = ln & 15;
                const unsigned long long tb_ = (SECPROBE >= 0) ? __builtin_amdgcn_s_memrealtime() : 0ull;
                for (int rep_ = 0; rep_ < REP_HC; ++rep_)
                if (doC) {
                    const int jc = i - 1;
                    const LAS unsigned char* Ls = lds + SC_LBUF + (jc & 1) * SC_LSLOT;
                    const LAS unsigned char* ldp = Ls + 4 * 16 * SC_LROW * 4 + c16 * SC_LDROW + 16 * g4;
                    f32x4 zw = {w0c, w0c, w0c, w0c}, za = {a0c, a0c, a0c, a0c}, gg = {0.f, 0.f, 0.f, 0.f};
#pragma unroll
                    for (int ks = 0; ks < 2; ++ks) { zw = __builtin_amdgcn_mfma_f32_16x16x32_bf16(*(const LAS bf16x8*)(ldp + 64 * ks), bw[ks], zw, 0, 0, 0);
                                                     za = __builtin_amdgcn_mfma_f32_16x16x32_bf16(*(const LAS bf16x8*)(ldp + 128 + 64 * ks), ba[ks], za, 0, 0, 0); }
#pragma unroll
                    for (int ks = 0; ks < 4; ++ks) gg = __builtin_amdgcn_mfma_f32_16x16x32_bf16(*(const LAS bf16x8*)(ldp + 256 + 64 * ks), bg[ks], gg, 0, 0, 0);
                    float lw[4], cw[4]; float tot = 0.f;
#pragma unroll
                    for (int r = 0; r < 4; ++r) { lw[r] = (-0.6065306597f * LOG2E) * __builtin_amdgcn_rcpf(1.f + __builtin_amdgcn_exp2f(zw[r])); tot += lw[r]; cw[r] = tot; }
                    float pre;
                    { auto e = __builtin_amdgcn_permlane16_swap(__float_as_uint(tot), __float_as_uint(tot), false, false); const float e0 = __uint_as_float(e[0]), s01 = e0 + __uint_as_float(e[1]);
                      auto f = __builtin_amdgcn_permlane32_swap(__float_as_uint(s01), __float_as_uint(s01), false, false);
                      pre = ((g4 & 1) ? e0 : 0.f) + ((g4 & 2) ? __uint_as_float(f[0]) : 0.f); }
                    const LAS float* Lf = (const LAS float*)Ls + 16 * hw + c16;
                    LAS unsigned char* Ct = lds + SC_CT + (jc % 3) * CT_SLOT;
                    LAS float* ggw = (LAS float*)(lds + SC_GG + (jc & 3) * 4096) + 16 * hw + c16;
                    float kh[4], rh[4], bt[4], kt[4], vv[4], rkp[4];
                    float Wprev = __builtin_amdgcn_exp2f(pre);
#pragma unroll
                    for (int r = 0; r < 4; ++r) { const int tok = 4 * g4 + r; const float c = pre + cw[r];
                        const float Wc = __builtin_amdgcn_exp2f(c), Wp = Wprev, iW = __builtin_amdgcn_exp2f(-c); Wprev = Wc;
                        const float a = __builtin_amdgcn_rcpf(1.f + __builtin_amdgcn_exp2f(za[r]));
                        const float rr = Lf[tok * SC_LROW], kk_ = Lf[16 * SC_LROW + tok * SC_LROW], nk = Lf[32 * SC_LROW + tok * SC_LROW]; vv[r] = Lf[48 * SC_LROW + tok * SC_LROW];
                        const float kd = kk_ * (1.f + (a - 1.f) * kaC);
                        kh[r] = nk * Wp; rh[r] = rr * Wc; bt[r] = nk * a * iW; kt[r] = kd * iW; rkp[r] = rr * kd * rkC;
                        ggw[tok * 64] = gg[r];
                        if (tok == 15) ((LAS float*)(Ct + CT_WEND))[16 * hw + c16] = Wc; }
                    { LAS unsigned char* tq = Ct + (16 * hw + c16) * 32 + 8 * g4;
                      *(LAS u32x2*)(tq + CT_KHT) = (u32x2){cvtpk(kh[0], kh[1]), cvtpk(kh[2], kh[3])}; *(LAS u32x2*)(tq + CT_RHT) = (u32x2){cvtpk(rh[0], rh[1]), cvtpk(rh[2], rh[3])};
                      *(LAS u32x2*)(tq + CT_BTT) = (u32x2){cvtpk(bt[0], bt[1]), cvtpk(bt[2], bt[3])}; *(LAS u32x2*)(tq + CT_KTT) = (u32x2){cvtpk(kt[0], kt[1]), cvtpk(kt[2], kt[3])};
                      *(LAS u32x2*)(tq + CT_VT) = (u32x2){cvtpk(vv[0], vv[1]), cvtpk(vv[2], vv[3])}; }
#pragma unroll
                    for (int r = 0; r < 4; ++r) rkp[r] = sum16(rkp[r]);
                    if (c16 == 0) { LAS float* rk = (LAS float*)(lds + SC_RKR + (jc & 3) * 256) + hw;
#pragma unroll
                        for (int r = 0; r < 4; ++r) rk[(4 * g4 + r) * 4] = rkp[r]; }
                }
                const unsigned long long tc_ = (SECPROBE >= 0) ? __builtin_amdgcn_s_memrealtime() : 0ull;
                for (int rep_ = 0; rep_ < REP_HL; ++rep_)
                if (doL) {
                    LAS unsigned char* Ls = lds + SC_LBUF + (i & 1) * SC_LSLOT; LAS float* Lf = (LAS float*)Ls;
                    const int s = 4 * hw + g4;
                    const u32x2 lr = LS.r, lk = LS.k, lv = LS.v; const u32x4 l00 = LS.l0, l01 = LS.l1;
                    issueL(i + 2 < NCH ? i + 2 : NCH - 1, LS);
                    const f32x4 rr = {bflo(lr.x), bfhi(lr.x), bflo(lr.y), bfhi(lr.y)}, kk_ = {bflo(lk.x), bfhi(lk.x), bflo(lk.y), bfhi(lk.y)}, vv = {bflo(lv.x), bfhi(lv.x), bflo(lv.y), bfhi(lv.y)};
                    f32x4 nk = kk_ * kkT; float ss = nk[0] * nk[0] + nk[1] * nk[1] + nk[2] * nk[2] + nk[3] * nk[3];
                    ss = sum16(ss);
                    nk = nk * (1.f / fmaxf(sqrtf(ss), 1e-12f));
                    *(LAS f32x4*)(Lf + s * SC_LROW + 4 * c16) = rr; *(LAS f32x4*)(Lf + 16 * SC_LROW + s * SC_LROW + 4 * c16) = kk_;
                    *(LAS f32x4*)(Lf + 32 * SC_LROW + s * SC_LROW + 4 * c16) = nk; *(LAS f32x4*)(Lf + 48 * SC_LROW + s * SC_LROW + 4 * c16) = vv;
                    *(LAS u32x4*)(Ls + 4 * 16 * SC_LROW * 4 + s * SC_LDROW + 32 * c16) = l00; *(LAS u32x4*)(Ls + 4 * 16 * SC_LROW * 4 + s * SC_LDROW + 32 * c16 + 16) = l01;
                }
                for (int rep_ = 0; rep_ < REP_SYNC; ++rep_) __syncthreads();
                if (SECPROBE >= 0) { asm volatile("s_waitcnt vmcnt(0) lgkmcnt(0)" ::: "memory"); const unsigned long long te_ = __builtin_amdgcn_s_memrealtime(); wait_acc += (SECPROBE == 0) ? (tc_ - tb_) : ((SECPROBE == 1) ? (te_ - tc_) : (te_ - tb_)); __syncthreads(); } else
                if (WAITPROBE >= 0) { const unsigned long long t0_ = __builtin_amdgcn_s_memrealtime(); __syncthreads(); wait_acc += __builtin_amdgcn_s_memrealtime() - t0_; } else
                __syncthreads();
            };
            for (int i = 0; i < NCH + 4; i += 2) { hw_interval(i, setA); hw_interval(i + 1, setB); }
        }
        if ((WAITPROBE >= 0 || SECPROBE >= 0) && blockIdx.x == 0 && wid == (SECPROBE >= 0 ? 4 : WAITPROBE)) { const unsigned long long tgt_ = __builtin_amdgcn_s_memrealtime() + 4ull * wait_acc; while (__builtin_amdgcn_s_memrealtime() < tgt_) __builtin_amdgcn_s_sleep(8); }
    }
}

__global__ void __launch_bounds__(NTHREADS, 2) fwd_megakernel(Args args) {
    extern __shared__ __attribute__((aligned(16))) unsigned char lds_raw[];
    LAS unsigned char* lds = (LAS unsigned char*)lds_raw;
    volatile LAS unsigned* MISC = (volatile LAS unsigned*)(lds + MISC_OFF);
    const int tid0 = threadIdx.x, wave = __builtin_amdgcn_readfirstlane(tid0 >> 6);
#define FRESH_LANE() int tid = tid0; asm volatile("" : "+v"(tid)); const int lane = tid & 63; (void)lane
    const int G = gridDim.x;
    const int vcu = (G % 8 == 0) ? ((int)blockIdx.x % 8) * (G / 8) + (int)blockIdx.x / 8 : (int)blockIdx.x;
    const int gw = vcu * NWAVES + wave, NGW = G * NWAVES;
    unsigned char* ws = args.ws;
    unsigned* ctl = (unsigned*)(ws + WS_CTL);
    for (int u = tid0; u < (LDS_BYTES - LDSCTL_OFF) / 4; u += NTHREADS) ((LAS unsigned*)(lds + LDSCTL_OFF))[u] = 0u;
    __syncthreads();
    XcdBarrier bar = xcd_barrier_post(ctl + CW_BAR, MISC + 8);
    unsigned long long ts_a = 0ull; int ts_n = 0;
#define STAMP() do { if (TS_A >= 0) { const unsigned long long t_ = __builtin_amdgcn_s_memrealtime(); if (ts_n == TS_A) ts_a = t_; \
    if (ts_n == TS_B && blockIdx.x == 0) { const unsigned long long tgt_ = t_ + 4ull * (t_ - ts_a); while (__builtin_amdgcn_s_memrealtime() < tgt_) __builtin_amdgcn_s_sleep(8); } ++ts_n; } } while (0)
#define GRID_BAR() do { xcd_barrier(bar); STAMP(); } while (0)
    STAMP();

    const float* x = args.in[0]; const float* rel_table = args.in[1]; const float* norm_g = args.in[2]; const float* attn_w_in = args.in[3]; const float* attn_sink = args.in[4];
    const float* attn_w_out = args.in[5]; const float* mu_prev = args.in[6]; const float* mu_next = args.in[7]; const float* w_r = args.in[8]; const float* w_k = args.in[9];
    const float* w_v = args.in[10]; const float* w_o = args.in[11]; const float* mlp_w1 = args.in[25]; const float* mlp_w2 = args.in[26];
    bf16_t* HBa = (bf16_t*)args.out; bf16_t* HBb = HBa + (size_t)M * D; bf16_t* HBc = (bf16_t*)(ws + WS_HBC); bf16_t* TMP2 = (bf16_t*)(ws + WS_TMP2);
    bf16_t* XN = (bf16_t*)(ws + WS_XN); bf16_t* QKV = (bf16_t*)(ws + WS_QKV); bf16_t* Ob = (bf16_t*)(ws + WS_O); bf16_t* TMP = (bf16_t*)(ws + WS_TMP); bf16_t* Hb = (bf16_t*)(ws + WS_H);
    bf16_t* MIXA = (bf16_t*)(ws + WS_MIXA); bf16_t* MIXB = (bf16_t*)(ws + WS_MIXB); bf16_t* Rb = (bf16_t*)(ws + WS_R); bf16_t* Kb = (bf16_t*)(ws + WS_K); bf16_t* Vb = (bf16_t*)(ws + WS_V);
    bf16_t* LDO = (bf16_t*)(ws + WS_LDO); bf16_t* Yb = (bf16_t*)(ws + WS_Y);
    LAS float* scr = (LAS float*)(lds + wave * TR_SCR_BYTES);
    float* RS = (float*)(ws + WS_CTL + 128 * 1024);

    {
        FRESH_LANE();
        constexpr int I_IN = (D / 64) * (DIN / 64), I_OUT = (D / 64) * (D / 64), I_1 = (D / 64) * (DFF / 64), I_2 = (DFF / 64) * (D / 64);
        const bool tail = (G == 256);
        for (int it = gw; it < (tail ? I_IN : I_IN + I_OUT + I_1 + I_2); it += NGW) { int r = it;
            if (r < I_IN) { transpose_item(attn_w_in, DIN, DIN, (bf16_t*)(ws + WS_WIN_T), D, 0, 0, scr, r, lane, ScaleOne{}); continue; } r -= I_IN;
            if (r < I_OUT) { transpose_item(attn_w_out, D, D, (bf16_t*)(ws + WS_WOUT_T), D, 0, 0, scr, r, lane, ScaleOne{}); continue; } r -= I_OUT;
            if (r < I_1) { transpose_item(mlp_w1, DFF, DFF, (bf16_t*)(ws + WS_W1_T), D, 0, 0, scr, r, lane, ScaleVec{norm_g + 2 * D}); continue; } r -= I_1;
            transpose_item(mlp_w2, D, D, (bf16_t*)(ws + WS_W2_T), DFF, 0, 0, scr, r, lane, ScaleOne{}); }
        for (int row = gw; row < M; row += NGW) { Row16 r; row_load_f32(r, x + (size_t)row * D, lane); row_rmsnorm(r, norm_g, lane); row_store_bf16(r, XN + (size_t)row * D, lane); }
    }
    GRID_BAR();
    { pg8::StaticOrder S; S.init(M, DIN, G, (int)blockIdx.x); const EpiHeadMajor E{QKV};
      for (int rep = 0; rep < REP_GEMM; ++rep) pg8::gemm_phase<EpiHeadMajor, ProbPlain, true, true>(lds, ProbPlain{XN, (const bf16_t*)(ws + WS_WIN_T), D}, S, E); }
    if (G == 256 && blockIdx.x >= 64) {
        FRESH_LANE();
        constexpr int I_OUT = (D / 64) * (D / 64), I_1 = (D / 64) * (DFF / 64), I_2 = (DFF / 64) * (D / 64);
        for (int it = ((int)blockIdx.x - 64) * NWAVES + wave; it < I_OUT + I_1 + I_2; it += 192 * NWAVES) { int r = it;
            if (r < I_OUT) { transpose_item(attn_w_out, D, D, (bf16_t*)(ws + WS_WOUT_T), D, 0, 0, scr, r, lane, ScaleOne{}); continue; } r -= I_OUT;
            if (r < I_1) { transpose_item(mlp_w1, DFF, DFF, (bf16_t*)(ws + WS_W1_T), D, 0, 0, scr, r, lane, ScaleVec{norm_g + 2 * D}); continue; } r -= I_1;
            transpose_item(mlp_w2, D, D, (bf16_t*)(ws + WS_W2_T), DFF, 0, 0, scr, r, lane, ScaleOne{}); }
    }
    GRID_BAR();
    { const AttnIO io{QKV, rel_table, attn_sink, Ob, (bf16_t*)(ws + WS_OBR), (float*)(ws + WS_LSE)};
      for (int rep = 0; rep < REP_ATT; ++rep) phase_attn(lds, io, vcu, G);
      GRID_BAR();
      { FRESH_LANE(); phase_attn_merge(io, vcu * NTHREADS + tid, G * NTHREADS); } }
    GRID_BAR();
    for (int rep = 0; rep < REP_BAR; ++rep) GRID_BAR();
    run_gemm<0>(lds, ProbPlain{Ob, (const bf16_t*)(ws + WS_WOUT_T), D}, DstPlain{TMP, D}, M, D, G);
    GRID_BAR();
    { FRESH_LANE(); phase_resnorm<true, false>(x, TMP, norm_g + D, nullptr, HBa, nullptr, RS, gw, NGW, lane); }
    GRID_BAR();
    run_gemm_rs<1>(lds, ProbPlain{HBa, (const bf16_t*)(ws + WS_W1_T), D}, DstPlain{Hb, DFF}, RS, M, DFF, G);
    GRID_BAR();
    run_gemm<0>(lds, ProbPlain{Hb, (const bf16_t*)(ws + WS_W2_T), DFF}, DstPlain{TMP, D}, M, D, G);
    GRID_BAR();
    { FRESH_LANE(); phase_resnorm<false, false>(HBa, TMP, norm_g + 3 * D, nullptr, HBb, nullptr, nullptr, gw, NGW, lane); }
    GRID_BAR();
    {
        FRESH_LANE();
        const float* g1n = norm_g + 4 * D;
        constexpr int I_SQ = (D / 64) * (D / 64), I_1 = (D / 64) * (DFF / 64), I_2 = (DFF / 64) * (D / 64), I_LD = 384;
        const bool tail = (G == 256);
        for (int it = gw; it < (tail ? 2 * I_SQ + I_2 + I_LD : 4 * I_SQ + I_1 + I_2 + I_LD); it += NGW) { int r = it;
            if (r < I_SQ) { transpose_item(w_r, D, D, (bf16_t*)(ws + WS_WR_T), D, 0, 0, scr, r, lane, ScaleOne{}); continue; } r -= I_SQ;
            if (r < I_SQ) { transpose_item(w_k, D, D, (bf16_t*)(ws + WS_WK_T), D, 0, 0, scr, r, lane, ScaleOne{}); continue; } r -= I_SQ;
            if (!tail) {
                if (r < I_SQ) { transpose_item(w_v, D, D, (bf16_t*)(ws + WS_WV_T), D, 0, 0, scr, r, lane, ScaleOne{}); continue; } r -= I_SQ;
                if (r < I_SQ) { transpose_item(w_o, D, D, (bf16_t*)(ws + WS_WO2_T), D, 0, 0, scr, r, lane, ScaleOne{}); continue; } r -= I_SQ;
                if (r < I_1) { transpose_item(mlp_w1 + (size_t)D * DFF, DFF, DFF, (bf16_t*)(ws + WS_W1B_T), D, 0, 0, scr, r, lane, ScaleVec{norm_g + 6 * D}); continue; } r -= I_1; }
            if (r < I_2) { transpose_item(mlp_w2 + (size_t)DFF * D, D, D, (bf16_t*)(ws + WS_W2B_T), DFF, 0, 0, scr, r, lane, ScaleOne{}); continue; } r -= I_2;
            const int part = r / 128; int q = r % 128; int sub, li;
            if (q < 64) { sub = q / 16; li = q % 16; } else { sub = 4 + (q - 64) / 32; li = (q - 64) % 32; }
            const int dd = sub & 1, kind = sub >> 1;
            const int stream = kind == 0 ? 1 : (kind == 1 ? 4 : 5), Nn = kind == 2 ? 128 : 64;
            const float* src = kind == 0 ? args.in[18] + (size_t)dd * D * 64 : (kind == 1 ? args.in[21] + (size_t)dd * D * 64 : args.in[23] + (size_t)dd * D * 128);
            const int coloff = kind == 0 ? dd * 64 : (kind == 1 ? 128 + dd * 64 : 256 + dd * 128);
            transpose_item(src, Nn, Nn, (bf16_t*)(ws + WS_LDW_T), D, part * 512 + coloff, 0, scr, li, lane, ScaleMix{mu_prev + stream * D, mu_next + stream * D, part}); }
        phase_mix3(lds, HBb, g1n, mu_prev, mu_next, XN, MIXA, MIXB, HBa, gw, NGW, tid, lane);
    }
    GRID_BAR();
    run_gemm<0>(lds, ProbRKL{ws, D}, DstRKL{ws}, M, 14 * 256, G);
    if (G == 256 && blockIdx.x >= 128) {
        FRESH_LANE();
        constexpr int I_SQ = (D / 64) * (D / 64), I_1 = (D / 64) * (DFF / 64);
        for (int it = ((int)blockIdx.x - 128) * NWAVES + wave; it < 2 * I_SQ + I_1; it += 128 * NWAVES) { int r = it;
            if (r < I_SQ) { transpose_item(w_v, D, D, (bf16_t*)(ws + WS_WV_T), D, 0, 0, scr, r, lane, ScaleOne{}); continue; } r -= I_SQ;
            if (r < I_SQ) { transpose_item(w_o, D, D, (bf16_t*)(ws + WS_WO2_T), D, 0, 0, scr, r, lane, ScaleOne{}); continue; } r -= I_SQ;
            transpose_item(mlp_w1 + (size_t)D * DFF, DFF, DFF, (bf16_t*)(ws + WS_W1B_T), D, 0, 0, scr, r, lane, ScaleVec{norm_g + 6 * D}); }
    }
    GRID_BAR();
    { FRESH_LANE(); phase_lda(LDO, (bf16_t*)(ws + WS_LDA), gw, NGW, lane); }
    run_gemm<0>(lds, ProbPlain{HBa, (const bf16_t*)(ws + WS_WV_T), D}, DstPlain{Vb, D}, M, D, G);
    GRID_BAR();
    { ScanPtrs sp{Rb, Kb, Vb, (const bf16_t*)(ws + WS_LDA), Yb, args.in[19], args.in[22], args.in[24], args.in[17], args.in[20], args.in[12], args.in[13], args.in[14], args.in[15], args.in[16]};
      for (int rep = 0; rep < REP_SCAN; ++rep) phase_scan(lds, sp, G); }
    GRID_BAR();
    { FRESH_LANE();
      bf16_t* Ys = (bf16_t*)(ws + WS_YSUM);
      const bool grp_on = (G == 256);
      const int grow0 = 256 * (8 * ((int)blockIdx.x % 8) + ((int)blockIdx.x / 8) % 8) + 64 * ((int)blockIdx.x / 64);
      const int rfirst = grp_on ? grow0 + wave : gw, rend = grp_on ? grow0 + 64 : M, rstride = grp_on ? NWAVES : NGW;
      for (int row = rfirst; row < rend; row += rstride) {
          const u32x4* y0 = (const u32x4*)(Yb + (size_t)row * 2 * D); const u32x4* y1 = (const u32x4*)(Yb + (size_t)row * 2 * D + D);
#pragma unroll
          for (int hb = 0; hb < 2; ++hb) { const u32x4 a = y0[lane + 64 * hb], c = y1[lane + 64 * hb]; u32x4 o;
              o.x = cvtpk(bflo(a.x) + bflo(c.x), bfhi(a.x) + bfhi(c.x)); o.y = cvtpk(bflo(a.y) + bflo(c.y), bfhi(a.y) + bfhi(c.y));
              o.z = cvtpk(bflo(a.z) + bflo(c.z), bfhi(a.z) + bfhi(c.z)); o.w = cvtpk(bflo(a.w) + bflo(c.w), bfhi(a.w) + bfhi(c.w));
              pg8::store16_wt((u32x4*)(Ys + (size_t)row * D) + lane + 64 * hb, o); } }
      if (grp_on) { unsigned ep = 0u; grp_barrier(ctl + CW_BAR, (unsigned)blockIdx.x % 64u, ep); } else GRID_BAR();
      run_gemm<0>(lds, ProbPlain{Ys, (const bf16_t*)(ws + WS_WO2_T), D}, DstPlain{TMP2, D}, M, D, G); }
    GRID_BAR();
    { FRESH_LANE(); phase_resnorm<false, false>(HBb, TMP2, norm_g + 5 * D, nullptr, HBc, nullptr, RS, gw, NGW, lane); }
    GRID_BAR();
    run_gemm_rs<1>(lds, ProbPlain{HBc, (const bf16_t*)(ws + WS_W1B_T), D}, DstPlain{Hb, DFF}, RS, M, DFF, G);
    GRID_BAR();
    run_gemm<0>(lds, ProbPlain{Hb, (const bf16_t*)(ws + WS_W2B_T), DFF}, DstPlain{TMP2, D}, M, D, G);
    GRID_BAR();
    { FRESH_LANE(); phase_resnorm<false, true>(HBc, TMP2, norm_g + 7 * D, nullptr, args.out, nullptr, nullptr, gw, NGW, lane); }
    if (TS_A >= 0) { GRID_BAR(); }
#undef GRID_BAR
}

extern "C" void kernel_launch(void* const* d_in, const int* in_sizes, int n_in, void* d_out, int out_size, void* d_ws, size_t ws_size, hipStream_t stream) {
    static int grid = 0;
    if (grid == 0) {
        if (n_in != 27 || in_sizes[0] != M * D || out_size != M * D || ws_size < WS_END) { fprintf(stderr, "kernel_launch: unexpected shapes (n_in %d, in0 %d, out %d, ws %zu)\n", n_in, n_in > 0 ? in_sizes[0] : -1, out_size, ws_size); grid = -1; return; }
        int dev = 0, cus = 0, per_cu = 0;
        if (hipGetDevice(&dev) != hipSuccess || hipDeviceGetAttribute(&cus, hipDeviceAttributeMultiprocessorCount, dev) != hipSuccess) { grid = -1; return; }
        if (hipFuncSetAttribute((const void*)fwd_megakernel, hipFuncAttributeMaxDynamicSharedMemorySize, LDS_BYTES) != hipSuccess) { fprintf(stderr, "kernel_launch: hipFuncSetAttribute failed\n"); grid = -1; return; }
        if (hipOccupancyMaxActiveBlocksPerMultiprocessor(&per_cu, (const void*)fwd_megakernel, NTHREADS, LDS_BYTES) != hipSuccess || per_cu < 1) { fprintf(stderr, "kernel_launch: occupancy query says %d blocks/CU\n", per_cu); (void)hipGetLastError(); grid = -1; return; }
        grid = cus;
    }
    if (grid < 0) return;
    (void)hipMemsetAsync((char*)d_ws + WS_CTL, 0, CTL_ZERO_BYTES, stream);
    Args a{};
    for (int i = 0; i < 27; ++i) a.in[i] = (const float*)d_in[i];
    a.out = (float*)d_out; a.ws = (unsigned char*)d_ws;
    hipLaunchKernelGGL(fwd_megakernel, dim3(grid), dim3(NTHREADS), LDS_BYTES, stream, a);
}
```

```cpp
#include <hip/hip_runtime.h>
#include <cstdio>
#include <cstdint>

#define LAS __attribute__((address_space(3)))
#define GAS __attribute__((address_space(1)))
typedef unsigned short bf16_t;
typedef short bf16x8 __attribute__((ext_vector_type(8)));
typedef float f32x4 __attribute__((ext_vector_type(4)));
typedef float f32x2 __attribute__((ext_vector_type(2)));
typedef unsigned u32x4 __attribute__((ext_vector_type(4)));
typedef unsigned u32x2 __attribute__((ext_vector_type(2)));

#ifndef REP_SCAN
#define REP_SCAN 1
#endif
#ifndef REP_ATT
#define REP_ATT 1
#endif
#ifndef REP_GEMM
#define REP_GEMM 1
#endif
#ifndef REP_ATTC
#define REP_ATTC 1
#endif
#ifndef REP_BAR
#define REP_BAR 0
#endif
#ifndef REP_ATTS
#define REP_ATTS 1
#endif
#ifndef REP_HC
#define REP_HC 1
#endif
#ifndef REP_ST
#define REP_ST 1
#endif
#ifndef REP_HL
#define REP_HL 1
#endif
#ifndef REP_SYNC
#define REP_SYNC 0
#endif
#ifndef SECPROBE
#define SECPROBE -1
#endif
#ifndef WAITPROBE
#define WAITPROBE -1
#endif
#ifndef TS_A
#define TS_A -1
#endif
#ifndef TS_B
#define TS_B -1
#endif
constexpr int SEQ = 2048, D = 1024, NBATCH = 8, M = NBATCH * SEQ, DFF = 4096, DIN = 2304, NLD = 1536;
constexpr float NORM_EPS = 1e-6f, GN_EPS = 64e-5f;
constexpr int NWAVES = 8, NTHREADS = 512;

namespace pg8 {
constexpr int BM = 256, BK = 64, HALF = 128, HTB = HALF * BK * 2, STAGE_BYTES = 8 * HTB, NXCD = 8, WGM = 8;
__host__ __device__ __forceinline__ int lds_byte(int r, int c) { const int st = (r >> 4) * 2 + (c >> 5), rr = r & 15, cc = c & 31, ob = rr * 64 + cc * 2; return st * 1024 + (ob ^ (((ob >> 9) & 1) << 5)); }
__host__ __device__ __forceinline__ void stage_rc(int b, int& R, int& C) { const int st = b / 1024, sb = b % 1024, swz = sb ^ (((sb >> 9) & 1) << 5); R = (st >> 1) * 16 + swz / 64; C = (st & 1) * 32 + (swz % 64) / 2; }
__host__ __device__ __forceinline__ int perm32(int rho) { const int n = rho >> 4, i = rho & 15; return 8 * (i >> 2) + 4 * n + (i & 3); }

struct Unit { int pm, pn; };
struct StaticOrder {
    int nM, nN, nwg, G, c;
    __host__ __device__ void init(int Mr, int N, int G_, int c_) { nM = Mr / BM; nN = N / BM; nwg = nM * nN; G = G_; c = c_; }
    __host__ __device__ bool next(int i, Unit& u) const {
        const long L = (long)i * G + c; if (L >= nwg) return false;
        int wgid = (int)L; { const int q = nwg / NXCD, r = nwg % NXCD, xcd = wgid % NXCD, off = wgid / NXCD; wgid = (xcd < r ? xcd * (q + 1) : r * (q + 1) + (xcd - r) * q) + off; }
        const int nig = WGM * nN, gid = wgid / nig, fm = gid * WGM, gsz = (nM - fm) < WGM ? (nM - fm) : WGM;
        u.pm = fm + ((wgid % nig) % gsz); u.pn = (wgid % nig) / gsz; return true;
    }
};
__device__ __forceinline__ unsigned cvt_pk_bf16(float lo, float hi) { unsigned r; asm volatile("v_cvt_pk_bf16_f32 %0, %1, %2" : "=v"(r) : "v"(lo), "v"(hi)); return r; }

__device__ __forceinline__ void store16_wt(void* p, u32x4 v) { asm volatile("global_store_dwordx4 %0, %1, off sc1\n\ts_nop 1" :: "v"(p), "v"(v) : "memory"); }
template <int ACT, class DstFn, bool RS = false> struct EpiBf16 {
    static constexpr bool PERM = true;
    DstFn F; const float* rs;
    __device__ __forceinline__ void operator()(const f32x4 (&acc)[2][2][4][2], const Unit& u, int wr, int wc, int fr, int fq) const {
        bf16_t* base; int ldc; F(u, base, ldc);
        const int row0 = wr * 64 + fr, col0 = wc * 32 + 8 * fq;
        float rsc[2][4];
        if (RS) {
#pragma unroll
            for (int ai = 0; ai < 2; ++ai)
#pragma unroll
                for (int m = 0; m < 4; ++m) rsc[ai][m] = rs[u.pm * BM + row0 + ai * HALF + m * 16]; }
        if (RS && ACT == 1) {
            f32x4 t[2][2][4][2];
#pragma unroll
            for (int ai = 0; ai < 2; ++ai)
#pragma unroll
                for (int bj = 0; bj < 2; ++bj)
#pragma unroll
                    for (int m = 0; m < 4; ++m)
#pragma unroll
                        for (int n = 0; n < 2; ++n)
#pragma unroll
                            for (int e = 0; e < 4; ++e) { const float a = fmaxf(acc[ai][bj][m][n][e], 0.f); t[ai][bj][m][n][e] = a * a; }
#pragma unroll
            for (int ai = 0; ai < 2; ++ai)
#pragma unroll
                for (int m = 0; m < 4; ++m) { bf16_t* rowp = base + (size_t)(row0 + ai * HALF + m * 16) * ldc + col0; const float r2 = rsc[ai][m] * rsc[ai][m];
#pragma unroll
                    for (int bj = 0; bj < 2; ++bj) { const f32x4 v0 = t[ai][bj][m][0] * r2, v1 = t[ai][bj][m][1] * r2;
                        u32x4 w; w.x = cvt_pk_bf16(v0[0], v0[1]); w.y = cvt_pk_bf16(v0[2], v0[3]); w.z = cvt_pk_bf16(v1[0], v1[1]); w.w = cvt_pk_bf16(v1[2], v1[3]);
                        store16_wt(rowp + bj * HALF, w); } }
            return;
        }
#pragma unroll
        for (int ai = 0; ai < 2; ++ai)
#pragma unroll
            for (int m = 0; m < 4; ++m) { bf16_t* rowp = base + (size_t)(row0 + ai * HALF + m * 16) * ldc + col0;
#pragma unroll
                for (int bj = 0; bj < 2; ++bj) { f32x4 v0 = acc[ai][bj][m][0], v1 = acc[ai][bj][m][1];
                    if (RS) { v0 = v0 * rsc[ai][m]; v1 = v1 * rsc[ai][m]; }
                    if (ACT == 1) {
#pragma unroll
                        for (int e = 0; e < 4; ++e) { const float a = fmaxf(v0[e], 0.f), b = fmaxf(v1[e], 0.f); v0[e] = a * a; v1[e] = b * b; } }
                    u32x4 w; w.x = cvt_pk_bf16(v0[0], v0[1]); w.y = cvt_pk_bf16(v0[2], v0[3]); w.z = cvt_pk_bf16(v1[0], v1[1]); w.w = cvt_pk_bf16(v1[2], v1[3]);
                    store16_wt(rowp + bj * HALF, w); } }
    }
};

template <class Epi, class Prob, bool ALIGN_EPI, bool SP2>
__device__ __forceinline__ void gemm_phase(LAS unsigned char* lds, const Prob& P, const StaticOrder& S, const Epi& E) {
    int tid = threadIdx.x; asm volatile("" : "+v"(tid));
    const int wid = __builtin_amdgcn_readfirstlane(tid >> 6), lane = tid & 63, wr = wid >> 2, wc = wid & 3, fr = lane & 15, fq = lane >> 4;
    const int K = P.K, nt = K / BK;
    unsigned voffA[2], voffB[2];
#pragma unroll
    for (int i = 0; i < 2; ++i) { int R, C; stage_rc(tid * 16 + i * 8192, R, C); const int Rb = Epi::PERM ? ((R & ~31) + perm32(R & 31)) : R;
        voffA[i] = (unsigned)(R * K + C) * 2u; voffB[i] = (unsigned)(Rb * K + C) * 2u; }
    const size_t kstep = (size_t)(BK * 2);
    const size_t hstep = (size_t)HALF * K * 2;
    const unsigned ldsw = (unsigned)wid * 1024u;
    const int aoff = lds_byte(wr * 64 + fr, fq * 8), boff = lds_byte(wc * 32 + fr, fq * 8);
#define PG8_SA(b, h) (((b) * 2 + (h)) * HTB)
#define PG8_SB(b, h) ((4 + (b) * 2 + (h)) * HTB)
#define PG8_STAGE(bufoff, gbase, voff) do { _Pragma("unroll") for (int _i = 0; _i < 2; ++_i) \
        __builtin_amdgcn_global_load_lds((const unsigned*)((const char*)(gbase) + (voff)[_i]), (LAS unsigned*)(lds + (bufoff) + ldsw + _i * 8192), 16, 0, 0); } while (0)
#define PG8_LDA(dst, b, h) do { _Pragma("unroll") for (int m = 0; m < 4; ++m) _Pragma("unroll") for (int k = 0; k < 2; ++k) dst[m][k] = *(const LAS bf16x8*)(lds + PG8_SA(b, h) + aoff + m * 2048 + k * 1024); } while (0)
#define PG8_LDB(dst, b, h) do { _Pragma("unroll") for (int n = 0; n < 2; ++n) _Pragma("unroll") for (int k = 0; k < 2; ++k) dst[n][k] = *(const LAS bf16x8*)(lds + PG8_SB(b, h) + boff + n * 2048 + k * 1024); } while (0)
#define PG8_MMA(ai, bj, At, Bt) do { __builtin_amdgcn_s_setprio(1); _Pragma("unroll") for (int m = 0; m < 4; ++m) _Pragma("unroll") for (int n = 0; n < 2; ++n) _Pragma("unroll") for (int k = 0; k < 2; ++k) \
        acc[ai][bj][m][n] = __builtin_amdgcn_mfma_f32_16x16x32_bf16(Bt[n][k], At[m][k], acc[ai][bj][m][n], 0, 0, 0); __builtin_amdgcn_s_setprio(0); } while (0)
#define PG8_WAIT_V(n) asm volatile("s_waitcnt vmcnt(" #n ")" ::: "memory")
#define PG8_WAIT_L(n) asm volatile("s_waitcnt lgkmcnt(" #n ")" ::: "memory")
#define PG8_BAR __builtin_amdgcn_s_barrier()
#define PG8_SCHED __builtin_amdgcn_sched_barrier(0)
    Unit cur, nxt; int ui = 0;
    if (!S.next(0, cur)) return;
    f32x4 acc[2][2][4][2];
#pragma unroll
    for (int a = 0; a < 2; ++a)
#pragma unroll
        for (int b = 0; b < 2; ++b)
#pragma unroll
            for (int m = 0; m < 4; ++m)
#pragma unroll
                for (int n = 0; n < 2; ++n) acc[a][b][m][n] = (f32x4){0.f, 0.f, 0.f, 0.f};
    bf16x8 At[4][2], B0[2][2], B1[2][2];
    const char* cA = P.a_tile(cur); const char* cB = P.b_tile(cur);
    if constexpr (SP2) {
        PG8_STAGE(PG8_SB(0, 0), cB, voffB); PG8_STAGE(PG8_SB(0, 1), cB + hstep, voffB); PG8_STAGE(PG8_SA(0, 0), cA, voffA); PG8_STAGE(PG8_SA(0, 1), cA + hstep, voffA);
        if (wr == 1) PG8_BAR;
        PG8_WAIT_V(2); PG8_BAR;
        PG8_STAGE(PG8_SB(1, 0), cB + kstep, voffB); PG8_STAGE(PG8_SA(1, 0), cA + kstep, voffA); PG8_STAGE(PG8_SB(1, 1), cB + hstep + kstep, voffB);
        PG8_WAIT_V(6); PG8_BAR;
    } else {
        PG8_STAGE(PG8_SB(0, 0), cB, voffB); PG8_STAGE(PG8_SA(0, 0), cA, voffA); PG8_STAGE(PG8_SB(0, 1), cB + hstep, voffB); PG8_STAGE(PG8_SA(0, 1), cA + hstep, voffA);
        if (wr == 1) PG8_BAR;
        PG8_WAIT_V(4); PG8_BAR;
        PG8_STAGE(PG8_SB(1, 0), cB + kstep, voffB); PG8_STAGE(PG8_SA(1, 0), cA + kstep, voffA); PG8_STAGE(PG8_SB(1, 1), cB + hstep + kstep, voffB);
        PG8_WAIT_V(6); PG8_BAR;
    }
    for (;;) {
        const bool has_next = S.next(ui + 1, nxt);
        const char* nA = has_next ? P.a_tile(nxt) : cA; const char* nB = has_next ? P.b_tile(nxt) : cB;
        for (int t = 0; t < nt; t += 2) {
            const bool last = (t == nt - 2);
            const char* a1 = cA + (size_t)(t + 1) * kstep;
            const char* a2 = last ? nA : cA + (size_t)(t + 2) * kstep; const char* b2 = last ? nB : cB + (size_t)(t + 2) * kstep;
            const char* a3 = a2 + kstep; const char* b3 = b2 + kstep;
            if constexpr (SP2) {
            PG8_LDB(B0, 0, 0); PG8_LDB(B1, 0, 1); PG8_SCHED; PG8_LDA(At, 0, 0); PG8_STAGE(PG8_SA(1, 1), a1 + hstep, voffA);
            PG8_WAIT_V(8); PG8_WAIT_L(0); PG8_BAR; PG8_MMA(0, 0, At, B0); PG8_MMA(0, 1, At, B1); PG8_BAR; PG8_SCHED;
            PG8_LDA(At, 0, 1); PG8_STAGE(PG8_SB(0, 0), b2, voffB); PG8_STAGE(PG8_SB(0, 1), b2 + hstep, voffB); PG8_STAGE(PG8_SA(0, 0), a2, voffA);
            PG8_WAIT_V(8); PG8_WAIT_L(0); PG8_BAR; PG8_MMA(1, 0, At, B0); PG8_MMA(1, 1, At, B1); PG8_BAR; PG8_SCHED;
            PG8_LDB(B0, 1, 0); PG8_LDB(B1, 1, 1); PG8_SCHED; PG8_LDA(At, 1, 0); PG8_STAGE(PG8_SA(0, 1), a2 + hstep, voffA);
            PG8_WAIT_V(8); PG8_WAIT_L(0); PG8_BAR; PG8_MMA(0, 0, At, B0); PG8_MMA(0, 1, At, B1); PG8_BAR; PG8_SCHED;
            PG8_LDA(At, 1, 1); PG8_STAGE(PG8_SB(1, 0), b3, voffB); PG8_STAGE(PG8_SB(1, 1), b3 + hstep, voffB); PG8_STAGE(PG8_SA(1, 0), a3, voffA);
            PG8_WAIT_V(8); PG8_WAIT_L(0); PG8_BAR; PG8_MMA(1, 0, At, B0); PG8_MMA(1, 1, At, B1); PG8_BAR; PG8_SCHED;
            } else {
            PG8_LDB(B0, 0, 0); PG8_SCHED; PG8_LDA(At, 0, 0); PG8_STAGE(PG8_SA(1, 1), a1 + hstep, voffA);
            PG8_WAIT_L(8); PG8_BAR; PG8_WAIT_L(0); PG8_MMA(0, 0, At, B0); PG8_BAR; PG8_SCHED;
            PG8_LDB(B1, 0, 1); PG8_STAGE(PG8_SB(0, 0), b2, voffB);
            PG8_BAR; PG8_WAIT_L(0); PG8_MMA(0, 1, At, B1); PG8_BAR;
            PG8_LDA(At, 0, 1); PG8_STAGE(PG8_SA(0, 0), a2, voffA);
            PG8_BAR; PG8_WAIT_L(0); PG8_MMA(1, 0, At, B0); PG8_BAR; PG8_SCHED;
            PG8_STAGE(PG8_SB(0, 1), b2 + hstep, voffB);
            PG8_WAIT_V(6); PG8_BAR; PG8_MMA(1, 1, At, B1); PG8_BAR;
            PG8_LDB(B0, 1, 0); PG8_SCHED; PG8_LDA(At, 1, 0); PG8_STAGE(PG8_SA(0, 1), a2 + hstep, voffA);
            PG8_WAIT_L(8); PG8_BAR; PG8_WAIT_L(0); PG8_MMA(0, 0, At, B0); PG8_BAR; PG8_SCHED;
            PG8_LDB(B1, 1, 1); PG8_STAGE(PG8_SB(1, 0), b3, voffB);
            PG8_BAR; PG8_WAIT_L(0); PG8_MMA(0, 1, At, B1); PG8_BAR;
            PG8_LDA(At, 1, 1); PG8_STAGE(PG8_SA(1, 0), a3, voffA);
            PG8_BAR; PG8_WAIT_L(0); PG8_MMA(1, 0, At, B0); PG8_BAR; PG8_SCHED;
            PG8_STAGE(PG8_SB(1, 1), b3 + hstep, voffB);
            PG8_WAIT_V(6); PG8_BAR; PG8_MMA(1, 1, At, B1); PG8_BAR;
            }
        }
        if constexpr (ALIGN_EPI) { if (wr == 0) PG8_BAR; }
        E(acc, cur, wr, wc, fr, fq);
        if (!has_next) break;
#pragma unroll
        for (int a = 0; a < 2; ++a)
#pragma unroll
            for (int b = 0; b < 2; ++b)
#pragma unroll
                for (int m = 0; m < 4; ++m)
#pragma unroll
                    for (int n = 0; n < 2; ++n) acc[a][b][m][n] = (f32x4){0.f, 0.f, 0.f, 0.f};
        cur = nxt; cA = nA; cB = nB; ++ui;
        if constexpr (ALIGN_EPI) { if (wr == 1) PG8_BAR; }
    }
    PG8_WAIT_V(0);
    if constexpr (!ALIGN_EPI) { if (wr == 0) PG8_BAR; }
    PG8_BAR;
#undef PG8_SA
#undef PG8_SB
#undef PG8_STAGE
#undef PG8_LDA
#undef PG8_LDB
#undef PG8_MMA
#undef PG8_WAIT_V
#undef PG8_WAIT_L
#undef PG8_BAR
#undef PG8_SCHED
}
}

constexpr size_t MiB = 1u << 20;
constexpr size_t WS_CTL = 0, CTL_ZERO_BYTES = 64 * 1024;
constexpr size_t WS_W = 1 * MiB;
constexpr size_t WS_WIN_T = WS_W, WS_WOUT_T = WS_WIN_T + (size_t)DIN * D * 2, WS_W1_T = WS_WOUT_T + (size_t)D * D * 2, WS_W2_T = WS_W1_T + (size_t)DFF * D * 2;
constexpr size_t WS_WR_T = WS_W, WS_WK_T = WS_WR_T + 2 * MiB, WS_LDW_T = WS_WK_T + 2 * MiB, WS_WV_T = WS_LDW_T + 3 * MiB, WS_WO2_T = WS_WV_T + 2 * MiB, WS_W1B_T = WS_WO2_T + 4 * MiB, WS_W2B_T = WS_W1B_T + 8 * MiB;
static_assert(WS_W2_T + (size_t)D * DFF * 2 <= 31 * MiB && WS_W2B_T + (size_t)D * DFF * 2 <= 31 * MiB, "weight region");
constexpr size_t WS_XN = 31 * MiB, WS_QKV = 63 * MiB, WS_O = 135 * MiB, WS_OBR = 167 * MiB, WS_LSE = 215 * MiB, WS_TMP = 217 * MiB, WS_H = 63 * MiB;
constexpr size_t WS_MIXA = 63 * MiB, WS_MIXB = 95 * MiB, WS_R = 127 * MiB, WS_K = 159 * MiB, WS_V = 31 * MiB, WS_LDO = 191 * MiB, WS_Y = 63 * MiB, WS_LDA = 239 * MiB;
constexpr size_t WS_YSUM = 127 * MiB;
constexpr size_t WS_HBC = 191 * MiB, WS_TMP2 = 223 * MiB;
constexpr size_t WS_END = 256 * MiB;
static_assert(WS_HBC >= WS_H + (size_t)M * DFF * 2 && WS_HBC + (size_t)M * D * 2 <= WS_TMP2 && WS_TMP2 + (size_t)M * D * 2 <= WS_END, "layer-1 tail");
static_assert(WS_LDO + (size_t)M * NLD * 2 <= WS_LDA && WS_LDA + (size_t)M * 512 * 2 <= WS_END && WS_TMP + (size_t)M * D * 2 <= WS_END, "tail of the map");
static_assert(WS_MIXA == WS_XN + 32 * MiB && WS_MIXB == WS_XN + 64 * MiB && WS_K == WS_R + 32 * MiB && WS_LDO == WS_R + 64 * MiB && WS_WK_T == WS_WR_T + 2 * MiB && WS_LDW_T == WS_WR_T + 4 * MiB, "grouped GEMM strides");
constexpr int CW_BAR = 4096;

constexpr int RING_BYTES = 131072, LDSCTL_OFF = 143360, MISC_OFF = LDSCTL_OFF + 320, LDS_BYTES = 147456;

typedef __bf16 bf16x2_t __attribute__((ext_vector_type(2)));
__device__ __forceinline__ unsigned cvtpk(float lo, float hi) { const f32x2 v = {lo, hi}; const bf16x2_t b = __builtin_convertvector(v, bf16x2_t); return __builtin_bit_cast(unsigned, b); }
__device__ __forceinline__ float bf2f(unsigned short b) { return __uint_as_float((unsigned)b << 16); }
__device__ __forceinline__ float bflo(unsigned w) { return __uint_as_float(w << 16); }
__device__ __forceinline__ float bfhi(unsigned w) { return __uint_as_float(w & 0xffff0000u); }
__device__ __forceinline__ unsigned f2bf(float f) { unsigned u = __float_as_uint(f); return (u + 0x7fffu + ((u >> 16) & 1u)) >> 16; }
__device__ __forceinline__ unsigned pk2(float lo, float hi) { return f2bf(lo) | (f2bf(hi) << 16); }
__device__ __forceinline__ float wave_sum(float v) {
#pragma unroll
    for (int o = 1; o < 64; o <<= 1) v += __shfl_xor(v, o);
    return v;
}
__device__ __forceinline__ float sigmoidf_(float z) { return 1.f / (1.f + __expf(-z)); }
__device__ __forceinline__ int t5_bucket(int rel) {
    const int n = rel < 0 ? -rel : rel;
    int large;
    if (n < 8) large = n; else if (n < 15) large = 8; else if (n < 27) large = 9; else if (n < 50) large = 10; else if (n < 91) large = 11;
    else if (n < 166) large = 12; else if (n < 305) large = 13; else if (n < 559) large = 14; else large = 15;
    return (rel > 0 ? 16 : 0) + large;
}

#define XB_TMO      128
#define XB_XCNT(j)  (256  + 64 * (j))
#define XB_XSUB(j)  (1280 + 64 * (j))
#define XB_XGEN(j)  (2304 + 64 * (j))
#define XB_TOP      3328
#define XB_TOPGEN   3392
#define XCD_BAR_WORDS 3456
#define XB_SPIN_CAP (1u << 18)
__device__ __forceinline__ unsigned xb_ld(unsigned* p)              { return __hip_atomic_load(p, __ATOMIC_RELAXED, __HIP_MEMORY_SCOPE_AGENT); }
__device__ __forceinline__ unsigned xb_add(unsigned* p, unsigned v) { return __hip_atomic_fetch_add(p, v, __ATOMIC_RELAXED, __HIP_MEMORY_SCOPE_AGENT); }
__device__ __forceinline__ unsigned xb_xcc_id() { return (unsigned)__builtin_amdgcn_s_getreg((3 << 11) | 20) & 0xFu; }
#define XB_SPIN(cond, bar) do { unsigned _sp = 0; while (cond) { __builtin_amdgcn_s_sleep(1); \
    if ((++_sp & 255u) == 0u) { if (xb_ld(&(bar)[XB_TMO])) break; if (_sp > XB_SPIN_CAP) { atomicAdd(&(bar)[XB_TMO], 1u); break; } } } } while (0)
struct XcdBarrier { unsigned* bar; unsigned x; volatile LAS unsigned* st; };
__device__ __forceinline__ XcdBarrier xcd_barrier_post(unsigned* bar, volatile LAS unsigned* st) {
    XcdBarrier b; b.bar = bar; b.x = xb_xcc_id(); b.st = st;
    if (threadIdx.x == 0) (void)xb_add(&bar[XB_XCNT(b.x)], 1u);
    return b;
}
__device__ __forceinline__ void xcd_barrier_complete(unsigned* bar, unsigned x, unsigned& nloc, unsigned& nx) {
    const unsigned G = gridDim.x * gridDim.y * gridDim.z;
    unsigned sum, cnt, mine, sp = 0u;
    for (;;) {
        sum = 0u; cnt = 0u; mine = 0u;
#pragma unroll
        for (unsigned j = 0; j < 16; ++j) { const unsigned c = xb_ld(&bar[XB_XCNT(j)]); sum += c; cnt += (c > 0u) ? 1u : 0u; mine = (j == x) ? c : mine; }
        if (sum == G) break;
        __builtin_amdgcn_s_sleep(1);
        if ((++sp & 255u) == 0u) { if (xb_ld(&bar[XB_TMO])) break; if (sp > XB_SPIN_CAP) { atomicAdd(&bar[XB_TMO], 1u); break; } }
    }
    nloc = mine > 0u ? mine : 1u; nx = cnt > 0u ? cnt : 1u;
}
__device__ __forceinline__ void xcd_barrier(const XcdBarrier& b) {
    asm volatile("s_waitcnt vmcnt(0)" ::: "memory");
    __syncthreads();
    if (threadIdx.x == 0) {
        unsigned* bar = b.bar;
        __builtin_amdgcn_s_waitcnt(0);
        unsigned nloc = b.st[0], nx = b.st[1];
        if (nloc == 0u) { xcd_barrier_complete(bar, b.x, nloc, nx); b.st[0] = nloc; b.st[1] = nx; }
        const unsigned old = xb_add(&bar[XB_XSUB(b.x)], 1u);
        const unsigned gen = old / nloc;
        if (old + 1u == (gen + 1u) * nloc) {
            __builtin_amdgcn_fence(__ATOMIC_RELEASE, "agent");
            asm volatile("s_waitcnt vmcnt(0)" ::: "memory");
            const unsigned og = xb_add(&bar[XB_TOP], 1u);
            const unsigned tg = og / nx;
            if (og + 1u == (tg + 1u) * nx) xb_add(&bar[XB_TOPGEN], 1u);
            else XB_SPIN(xb_ld(&bar[XB_TOPGEN]) == tg, bar);
            __builtin_amdgcn_fence(__ATOMIC_ACQUIRE, "agent");
            xb_add(&bar[XB_XGEN(b.x)], 1u);
            asm volatile("s_waitcnt vmcnt(0)" ::: "memory");
        } else {
            XB_SPIN(xb_ld(&bar[XB_XGEN(b.x)]) == gen, bar);
            __builtin_amdgcn_fence(__ATOMIC_ACQUIRE, "agent");
            asm volatile("s_waitcnt vmcnt(0)" ::: "memory");
        }
    }
    __syncthreads();
}

#define XB_GRP(g)   (4096 + 16 * (g))
__device__ __forceinline__ void grp_barrier(unsigned* bar, unsigned g, unsigned& epoch) {
    asm volatile("s_waitcnt vmcnt(0)" ::: "memory");
    __syncthreads();
    ++epoch;
    if (threadIdx.x == 0) {
        unsigned* word = &bar[XB_GRP(g)];
        (void)xb_add(word, 1u);
        const unsigned tgt = 4u * epoch;
        XB_SPIN(xb_ld(word) < tgt, bar);
        __builtin_amdgcn_fence(__ATOMIC_ACQUIRE, "agent");
        asm volatile("s_waitcnt vmcnt(0)" ::: "memory");
    }
    __syncthreads();
}

struct Row16 { f32x4 v[4]; };
__device__ __forceinline__ int row_q(int lane, int j) { return 2 * lane + 128 * (j >> 1) + (j & 1); }
__device__ __forceinline__ void row_load_f32(Row16& r, const float* p, int lane) {
#pragma unroll
    for (int j = 0; j < 4; ++j) r.v[j] = ((const f32x4*)p)[row_q(lane, j)];
}
struct RowRaw { u32x4 w[2]; };
__device__ __forceinline__ void row_raw_load(RowRaw& r, const bf16_t* p, int lane) { r.w[0] = ((const u32x4*)p)[lane]; r.w[1] = ((const u32x4*)p)[lane + 64]; }
__device__ __forceinline__ void row_from_raw(Row16& r, const RowRaw& q) {
#pragma unroll
    for (int b = 0; b < 2; ++b) { const u32x4 w = q.w[b]; r.v[2 * b] = (f32x4){bflo(w.x), bfhi(w.x), bflo(w.y), bfhi(w.y)}; r.v[2 * b + 1] = (f32x4){bflo(w.z), bfhi(w.z), bflo(w.w), bfhi(w.w)}; }
}
__device__ __forceinline__ void row_load_bf16(Row16& r, const bf16_t* p, int lane) { RowRaw q; row_raw_load(q, p, lane); row_from_raw(r, q); }
__device__ __forceinline__ void row_store_f32(const Row16& r, float* p, int lane) {
#pragma unroll
    for (int j = 0; j < 4; ++j) pg8::store16_wt((f32x4*)p + row_q(lane, j), __builtin_bit_cast(u32x4, r.v[j]));
}
__device__ __forceinline__ void row_store_bf16(const Row16& r, bf16_t* p, int lane) {
#pragma unroll
    for (int b = 0; b < 2; ++b) { u32x4 w; w.x = cvtpk(r.v[2 * b][0], r.v[2 * b][1]); w.y = cvtpk(r.v[2 * b][2], r.v[2 * b][3]); w.z = cvtpk(r.v[2 * b + 1][0], r.v[2 * b + 1][1]); w.w = cvtpk(r.v[2 * b + 1][2], r.v[2 * b + 1][3]);
        pg8::store16_wt((u32x4*)p + lane + 64 * b, w); }
}
__device__ __forceinline__ void vec_load(Row16& r, const float* g, int lane) { row_load_f32(r, g, lane); }
__device__ __forceinline__ void row_rmsnorm_v(Row16& r, const Row16& g) {
    float s = 0.f;
#pragma unroll
    for (int j = 0; j < 4; ++j) s += r.v[j][0] * r.v[j][0] + r.v[j][1] * r.v[j][1] + r.v[j][2] * r.v[j][2] + r.v[j][3] * r.v[j][3];
    const float rs = rsqrtf(wave_sum(s) * (1.f / D) + NORM_EPS);
#pragma unroll
    for (int j = 0; j < 4; ++j) r.v[j] = r.v[j] * rs * g.v[j];
}
__device__ __forceinline__ void row_rmsnorm(Row16& r, const float* g, int lane) { Row16 gg; vec_load(gg, g, lane); row_rmsnorm_v(r, gg); }

constexpr int TR_SCR_BYTES = 64 * 65 * 4;
template <class ScaleFn>
__device__ __forceinline__ void transpose_item(const float* W, int ldw, int N, bf16_t* WT, int ldt, int row_off, int koff, LAS float* scr, int item, int lane, ScaleFn sc) {
    const int nblk = N / 64, kb = item / nblk, nb = item % nblk, k0 = 64 * kb, n0 = 64 * nb;
    const int lk = lane >> 4, ln4 = (lane & 15) * 4;
    f32x4 v[16];
#pragma unroll
    for (int i = 0; i < 16; ++i) v[i] = *(const f32x4*)(W + (size_t)(k0 + 4 * i + lk) * ldw + n0 + ln4);
#pragma unroll
    for (int i = 0; i < 16; ++i) { const int kk = 4 * i + lk; const float s = sc(k0 + kk); LAS float* d = scr + kk * 65 + ln4; d[0] = v[i][0] * s; d[1] = v[i][1] * s; d[2] = v[i][2] * s; d[3] = v[i][3] * s; }
    asm volatile("s_waitcnt lgkmcnt(0)" ::: "memory");
    const int c = lane >> 3, nn = lane & 7;
#pragma unroll
    for (int j = 0; j < 8; ++j) { const int n = nn + 8 * j; const LAS float* s = scr + (8 * c) * 65 + n;
        u32x4 o; o.x = cvtpk(s[0 * 65], s[1 * 65]); o.y = cvtpk(s[2 * 65], s[3 * 65]); o.z = cvtpk(s[4 * 65], s[5 * 65]); o.w = cvtpk(s[6 * 65], s[7 * 65]);
        pg8::store16_wt(WT + (size_t)(row_off + n0 + n) * ldt + koff + k0 + 8 * c, o); }
    asm volatile("s_waitcnt lgkmcnt(0)" ::: "memory");
}
struct ScaleOne { __device__ __forceinline__ float operator()(int) const { return 1.f; } };
struct ScaleVec { const float* g; __device__ __forceinline__ float operator()(int k) const { return g[k]; } };
struct ScaleMix { const float* mp; const float* mn; int part;
    __device__ __forceinline__ float operator()(int k) const { return part == 0 ? 1.f - mp[k] - mn[k] : (part == 1 ? mp[k] : mn[k]); } };

struct Args { const float* in[27]; float* out; unsigned char* ws; };

struct ProbPlain { const bf16_t* A; const bf16_t* Bt; int K;
    __device__ __forceinline__ const char* a_tile(const pg8::Unit& u) const { return (const char*)(A + (size_t)u.pm * 256 * K); }
    __device__ __forceinline__ const char* b_tile(const pg8::Unit& u) const { return (const char*)(Bt + (size_t)u.pn * 256 * K); } };
struct DstPlain { bf16_t* C; int ldc;
    __device__ __forceinline__ void operator()(const pg8::Unit& u, bf16_t*& base, int& ld) const { base = C + (size_t)u.pm * 256 * ldc + (size_t)u.pn * 256; ld = ldc; } };
struct ProbRKL { const unsigned char* ws; int K;
    __device__ __forceinline__ const char* a_tile(const pg8::Unit& u) const { const int g = u.pn < 4 ? 0 : (u.pn < 8 ? 1 : 2); const int ga = g == 2 ? 0 : g + 1;
        return (const char*)(ws + WS_XN + (size_t)ga * (32 * MiB) + (size_t)u.pm * 256 * D * 2); }
    __device__ __forceinline__ const char* b_tile(const pg8::Unit& u) const { const int g = u.pn < 4 ? 0 : (u.pn < 8 ? 1 : 2); const int t = u.pn - 4 * g;
        return (const char*)(ws + WS_WR_T + (size_t)g * (2 * MiB) + (size_t)t * 256 * D * 2); } };
struct DstRKL { unsigned char* ws;
    __device__ __forceinline__ void operator()(const pg8::Unit& u, bf16_t*& base, int& ld) const {
        const int g = u.pn < 4 ? 0 : (u.pn < 8 ? 1 : 2); const int t = u.pn - 4 * g; ld = g == 2 ? NLD : D;
        base = (bf16_t*)(ws + WS_R + (size_t)g * (32 * MiB)) + (size_t)u.pm * 256 * ld + (size_t)t * 256; } };


struct EpiHeadMajor {
    static constexpr bool PERM = true;
    bf16_t* O;
    __device__ __forceinline__ void operator()(const f32x4 (&acc)[2][2][4][2], const pg8::Unit& u, int wr, int wc, int fr, int fq) const {
        const int row0 = u.pm * 256 + wr * 64 + fr, col = (wc & 1) * 32 + 8 * fq;
#pragma unroll
        for (int bj = 0; bj < 2; ++bj) { bf16_t* hb = O + ((size_t)(u.pn * 4 + bj * 2 + (wc >> 1)) * M + row0) * 64 + col;
#pragma unroll
            for (int ai = 0; ai < 2; ++ai)
#pragma unroll
                for (int m = 0; m < 4; ++m) { const f32x4 v0 = acc[ai][bj][m][0], v1 = acc[ai][bj][m][1];
                    u32x4 w; w.x = cvtpk(v0[0], v0[1]); w.y = cvtpk(v0[2], v0[3]); w.z = cvtpk(v1[0], v1[1]); w.w = cvtpk(v1[2], v1[3]);
                    pg8::store16_wt(hb + (size_t)(ai * 128 + m * 16) * 64, w); } }
    }
};

template <int ACT, class Prob, class Dst>
__device__ __forceinline__ void run_gemm(LAS unsigned char* lds, const Prob& P, const Dst& Dd, int Mr, int Nv, int G) {
    pg8::StaticOrder S; S.init(Mr, Nv, G, (int)blockIdx.x);
    pg8::EpiBf16<ACT, Dst> E{Dd, nullptr};
    for (int rep = 0; rep < REP_GEMM; ++rep) pg8::gemm_phase<pg8::EpiBf16<ACT, Dst>, Prob, true, true>(lds, P, S, E);
}
template <int ACT, class Prob, class Dst>
__device__ __forceinline__ void run_gemm_rs(LAS unsigned char* lds, const Prob& P, const Dst& Dd, const float* rs, int Mr, int Nv, int G) {
    pg8::StaticOrder S; S.init(Mr, Nv, G, (int)blockIdx.x);
    pg8::EpiBf16<ACT, Dst, true> E{Dd, rs};
    pg8::gemm_phase<pg8::EpiBf16<ACT, Dst, true>, Prob, true, true>(lds, P, S, E);
}

template <bool BASE_F32, bool OUT_F32>
__device__ __forceinline__ void phase_resnorm(const void* base, const bf16_t* TMP, const float* g1, const float* g2, void* hout, bf16_t* XN, float* rs_out, int gw, int NGW, int lane) {
    Row16 G1, G2; vec_load(G1, g1, lane); if (XN) vec_load(G2, g2, lane);
    for (int row = gw; row < M; row += NGW) {
        Row16 t, b; row_load_bf16(t, TMP + (size_t)row * D, lane);
        if (BASE_F32) row_load_f32(b, (const float*)base + (size_t)row * D, lane); else row_load_bf16(b, (const bf16_t*)base + (size_t)row * D, lane);
        row_rmsnorm_v(t, G1);
#pragma unroll
        for (int j = 0; j < 4; ++j) b.v[j] = b.v[j] + t.v[j];
        if (OUT_F32) row_store_f32(b, (float*)hout + (size_t)row * D, lane); else row_store_bf16(b, (bf16_t*)hout + (size_t)row * D, lane);
        if (XN) { row_rmsnorm_v(b, G2); row_store_bf16(b, XN + (size_t)row * D, lane); }
        if (rs_out) {
            float s = 0.f;
#pragma unroll
            for (int j = 0; j < 4; ++j) s += b.v[j][0] * b.v[j][0] + b.v[j][1] * b.v[j][1] + b.v[j][2] * b.v[j][2] + b.v[j][3] * b.v[j][3];
            const float rsv = rsqrtf(wave_sum(s) * (1.f / D) + NORM_EPS);
            if (lane == 0) rs_out[row] = rsv; }
    }
}
__device__ __forceinline__ void phase_lda(const bf16_t* LDO, bf16_t* LDA, int gw, int NGW, int lane) {
    const float A = lane < 16 ? 2.f : 1.f, C = lane < 16 ? -1.f : 0.f; const bool id = lane >= 16 && lane < 32;
    for (int row = gw; row < M; row += NGW) { const int tt = row & (SEQ - 1);
        const u32x4 p0 = *(const u32x4*)(LDO + (size_t)row * NLD + 8 * lane);
        const u32x4 p1 = *(const u32x4*)(LDO + (size_t)(tt > 0 ? row - 1 : row) * NLD + 512 + 8 * lane), p2 = *(const u32x4*)(LDO + (size_t)(tt < SEQ - 1 ? row + 1 : row) * NLD + 1024 + 8 * lane);
        const float mp = tt > 0 ? 1.f : 0.f, mn = tt < SEQ - 1 ? 1.f : 0.f;
        u32x4 o;
#pragma unroll
        for (int w = 0; w < 4; ++w) { const float x0 = bflo(p0[w]) + mp * bflo(p1[w]) + mn * bflo(p2[w]), x1 = bfhi(p0[w]) + mp * bfhi(p1[w]) + mn * bfhi(p2[w]);
            const float y0 = A * __builtin_amdgcn_rcpf(1.f + __builtin_amdgcn_exp2f(-1.4426950408889634f * A * x0)) + C, y1 = A * __builtin_amdgcn_rcpf(1.f + __builtin_amdgcn_exp2f(-1.4426950408889634f * A * x1)) + C;
            o[w] = cvtpk(id ? x0 : y0, id ? x1 : y1); }
        pg8::store16_wt(LDA + (size_t)row * 512 + 8 * lane, o); }
}
__device__ __forceinline__ void mix_out(const Row16& up, const Row16& u, const Row16& un, const LAS f32x4* a, const LAS f32x4* b, bf16_t* dst, int lane) {
    Row16 o;
#pragma unroll
    for (int j = 0; j < 4; ++j) { const f32x4 av = a[j * 64 + lane], bv = b[j * 64 + lane]; o.v[j] = u.v[j] + (up.v[j] - u.v[j]) * av + (un.v[j] - u.v[j]) * bv; }
    row_store_bf16(o, dst, lane);
}
__device__ __forceinline__ void phase_mix3(LAS unsigned char* lds, const bf16_t* h, const float* g, const float* mup, const float* mun, bf16_t* XN, bf16_t* MR, bf16_t* MK, bf16_t* MV, int gw, int NGW, int tid, int lane) {
    LAS f32x4* mv = (LAS f32x4*)lds;
    __syncthreads();
    for (int x = tid; x < 6 * 256; x += NTHREADS) { const int vec = x >> 8, q = x & 255, c = vec < 2 ? 0 : (vec < 4 ? 2 : 3);
        const f32x4 val = ((const f32x4*)(((vec & 1) ? mun : mup) + c * D))[q];
        mv[vec * 256 + (2 * (q >> 7) + (q & 1)) * 64 + ((q & 127) >> 1)] = val; }
    __syncthreads();
    Row16 Gn; vec_load(Gn, g, lane);
    for (int ch = gw; ch < M / 8; ch += NGW) {
        const int r0 = ch * 8, t0 = r0 & (SEQ - 1);
        const bool hasp = t0 > 0, hasn = t0 + 8 < SEQ;
        const int rlast = hasn ? r0 + 8 : r0 + 7;
        RowRaw r0w, rA, rB, rC;
        row_raw_load(r0w, h + (size_t)(hasp ? r0 - 1 : r0) * D, lane);
        row_raw_load(rA, h + (size_t)r0 * D, lane); row_raw_load(rB, h + (size_t)(r0 + 1) * D, lane); row_raw_load(rC, h + (size_t)(r0 + 2) * D, lane);
        Row16 up, u, un;
        row_from_raw(up, r0w); row_rmsnorm_v(up, Gn);
        { const float m = hasp ? 1.f : 0.f;
#pragma unroll
          for (int j = 0; j < 4; ++j) up.v[j] = up.v[j] * m; }
        row_from_raw(u, rA); row_rmsnorm_v(u, Gn);
        rA = rB; rB = rC;
#pragma unroll 1
        for (int k = 1; k <= 8; ++k) {
            const int row = r0 - 1 + k;
            { const int nx = row + 3; row_raw_load(rC, h + (size_t)(nx < rlast ? nx : rlast) * D, lane); }
            row_from_raw(un, rA); row_rmsnorm_v(un, Gn);
            { const float m = (k == 8 && !hasn) ? 0.f : 1.f;
#pragma unroll
              for (int j = 0; j < 4; ++j) un.v[j] = un.v[j] * m; }
            row_store_bf16(u, XN + (size_t)row * D, lane);
            mix_out(up, u, un, mv, mv + 256, MR + (size_t)row * D, lane);
            mix_out(up, u, un, mv + 512, mv + 768, MK + (size_t)row * D, lane);
            mix_out(up, u, un, mv + 1024, mv + 1280, MV + (size_t)row * D, lane);
            up = u; u = un; rA = rB; rB = rC;
        }
    }
}

constexpr int ATT_ROWS = 400, ATT_KS = 0, ATT_VS = ATT_ROWS * 128, ATT_TAB = 2 * ATT_ROWS * 128, ATT_TABN = 320;
constexpr float LOG2E = 1.4426950408889634f;
typedef short v4i16_t __attribute__((ext_vector_type(4)));
__device__ __forceinline__ v4i16_t lds_tr16(LAS const unsigned char* p) { return __builtin_amdgcn_ds_read_tr16_b64_v4i16((LAS v4i16_t*)p); }

__device__ __forceinline__ float fmax_q(float a, float b) { return __builtin_amdgcn_fmed3f(a, b, __builtin_inff()); }
__device__ __forceinline__ float rows_max(float x) {
    auto a = __builtin_amdgcn_permlane16_swap(__float_as_uint(x), __float_as_uint(x), false, false); x = fmax_q(__uint_as_float(a[0]), __uint_as_float(a[1]));
    auto b = __builtin_amdgcn_permlane32_swap(__float_as_uint(x), __float_as_uint(x), false, false); return fmax_q(__uint_as_float(b[0]), __uint_as_float(b[1])); }
__device__ __forceinline__ float rows_sum(float x) {
    auto a = __builtin_amdgcn_permlane16_swap(__float_as_uint(x), __float_as_uint(x), false, false); x = __uint_as_float(a[0]) + __uint_as_float(a[1]);
    auto b = __builtin_amdgcn_permlane32_swap(__float_as_uint(x), __float_as_uint(x), false, false); return __uint_as_float(b[0]) + __uint_as_float(b[1]); }
struct AttnIO { const bf16_t* QKV; const float* rel_table; const float* sink; bf16_t* O; bf16_t* OBR; float* LSE; };
struct AttnUnitD { int b, dil, res, l0, nq, L, R, colK, colV, head0, ngroups, nit, branch, isB; };
__device__ __forceinline__ AttnUnitD attn_decode(int u) {
    AttnUnitD A;
    if (u < 256) { A.isB = 1; A.b = u >> 5; const int kvg = (u >> 4) & 1, blk = u & 15; A.dil = 1; A.res = 0; A.l0 = blk * 128; A.nq = 128; A.L = SEQ; A.R = 128; A.colK = 32 + kvg; A.colV = 34 + kvg; A.head0 = kvg * 4; A.ngroups = 32; A.nit = 9; A.branch = 0; }
    else if (u < 1280) { A.isB = 0; const int a = u - 256, bh = a >> 4, k = a & 15; A.b = bh >> 3; A.head0 = bh & 7; A.nq = 256; A.R = 64; A.ngroups = 16; A.nit = 5;
        if (k < 8) { A.dil = 1; A.res = 0; A.l0 = k * 256; A.L = SEQ; A.branch = 0; } else { A.dil = 4; A.res = (k - 8) >> 1; A.l0 = ((k - 8) & 1) * 256; A.L = SEQ / 4; A.branch = 1; }
        A.colK = 8 + A.head0; A.colV = 16 + A.head0; }
    else { A.isB = 0; const int a = u - 1280, bh = a >> 4; A.b = bh >> 3; A.head0 = bh & 7; A.dil = 16; A.res = a & 15; A.l0 = 0; A.nq = 128; A.L = SEQ / 16; A.R = 64; A.ngroups = 8; A.nit = 5; A.branch = 2; A.colK = 8 + A.head0; A.colV = 16 + A.head0; }
    return A;
}
constexpr int ATT_NST = 7;
__device__ __forceinline__ void attn_issue(const AttnUnitD& A, const bf16_t* QKV, int tid, u32x4 (&kr)[ATT_NST], u32x4 (&vr)[ATT_NST]) {
    const int ndata = A.nq + 2 * A.R, rv0 = (A.R - A.l0) > 0 ? (A.R - A.l0) : 0, rv1 = (A.L + A.R - A.l0) < ndata ? (A.L + A.R - A.l0) : ndata;
    const bf16_t* kb = QKV + ((size_t)A.colK * M + (size_t)A.b * SEQ) * 64; const bf16_t* vb = QKV + ((size_t)A.colV * M + (size_t)A.b * SEQ) * 64;
#pragma unroll
    for (int i = 0; i < ATT_NST; ++i) { const int x = tid + NTHREADS * i, c = x & 7; int row = x >> 3; row = row < rv0 ? rv0 : (row >= rv1 ? rv1 - 1 : row);
        const size_t o = (size_t)(A.res + A.dil * (A.l0 - A.R + row)) * 64 + c * 8; kr[i] = *(const u32x4*)(kb + o); vr[i] = *(const u32x4*)(vb + o); }
}

__device__ __forceinline__ void phase_attn(LAS unsigned char* lds, const AttnIO& io, int vcu, int G) {
    int tid = threadIdx.x; asm volatile("" : "+v"(tid));
    const int lane = tid & 63, wid = __builtin_amdgcn_readfirstlane(tid >> 6), g4 = lane >> 4, qi = lane & 15;
    LAS unsigned char* Ks = lds + ATT_KS; LAS unsigned char* Vs = lds + ATT_VS; LAS float* tab = (LAS float*)(lds + ATT_TAB);
    constexpr int NU = 256 + 1024 + 1024;
    u32x4 kr[ATT_NST], vr[ATT_NST];
    if (vcu < NU) { const AttnUnitD A0 = attn_decode(vcu); attn_issue(A0, io.QKV, tid, kr, vr); }
    for (int u = vcu; u < NU; u += G) {
        const AttnUnitD A = attn_decode(u);
        const int b = A.b, dil = A.dil, res = A.res, l0 = A.l0, R = A.R, head0 = A.head0, ngroups = A.ngroups, nit = A.nit, branch = A.branch; const bool isB = A.isB != 0;
        const int ndata = A.nq + 2 * R, rv0 = (R - l0) > 0 ? (R - l0) : 0, rv1 = (A.L + R - l0) < ndata ? (A.L + R - l0) : ndata;
        auto qptr = [&](int gx) -> const bf16_t* { const int hq_ = isB ? (gx >> 3) : 0, gi_ = isB ? (gx & 7) : gx; const int posq_ = res + dil * (l0 + 16 * gi_ + qi);
            return io.QKV + ((size_t)((isB ? 24 : 0) + head0 + hq_) * M + (size_t)b * SEQ + posq_) * 64 + 8 * g4; };
        u32x4 qr0, qr1; { const bf16_t* qp0 = qptr(wid); qr0 = *(const u32x4*)qp0; qr1 = *(const u32x4*)(qp0 + 32); }
        for (int reps = 0; reps < REP_ATTS; ++reps) {
        __syncthreads();
#pragma unroll
        for (int i = 0; i < ATT_NST; ++i) { const int x = tid + NTHREADS * i, row = x >> 3, c = x & 7;
            if (x < ATT_ROWS * 8) { const int off = row * 128 + ((c ^ (row & 7)) << 4); const bool ok = row >= rv0 && row < rv1; const u32x4 z = (u32x4){0u, 0u, 0u, 0u};
                *(LAS u32x4*)(Ks + off) = ok ? kr[i] : z; *(LAS u32x4*)(Vs + off) = ok ? vr[i] : z; } }
        { const int ntab = isB ? 4 : 1;
          for (int x = tid; x < ntab * ATT_TABN; x += NTHREADS) { const int t = x / ATT_TABN, j = x % ATT_TABN, idx = j - 16;
              float v = -1e30f;
              if (idx >= 0 && idx <= 2 * R) v = io.rel_table[t5_bucket((idx - R) * dil) * 16 + (isB ? 8 + head0 + t : head0)] * LOG2E;
              tab[x] = v; } }
        }
        if (u + G < NU) { const AttnUnitD An = attn_decode(u + G); attn_issue(An, io.QKV, tid, kr, vr); }
        __syncthreads();
        for (int rep = 0; rep < REP_ATTC; ++rep)
        for (int gidx = wid; gidx < ngroups; gidx += NWAVES) {
            const int hq = isB ? (gidx >> 3) : 0, gi = isB ? (gidx & 7) : gidx, head = head0 + hq;
            const int ql = 16 * gi + qi, posq = res + dil * (l0 + ql);
            const LAS float* tb = tab + hq * ATT_TABN + 16;
            bf16x8 qf[2];
            { const u32x4 wq[2] = {qr0, qr1}; const float SC = 0.125f * LOG2E;
              { const int gn = gidx + NWAVES < ngroups ? gidx + NWAVES : gidx; const bf16_t* qpn = qptr(gn); qr0 = *(const u32x4*)qpn; qr1 = *(const u32x4*)(qpn + 32); }
#pragma unroll
              for (int ks = 0; ks < 2; ++ks) { const u32x4 w = wq[ks]; u32x4 o;
                  o.x = cvtpk(bflo(w.x) * SC, bfhi(w.x) * SC); o.y = cvtpk(bflo(w.y) * SC, bfhi(w.y) * SC); o.z = cvtpk(bflo(w.z) * SC, bfhi(w.z) * SC); o.w = cvtpk(bflo(w.w) * SC, bfhi(w.w) * SC);
                  qf[ks] = __builtin_bit_cast(bf16x8, o); } }
            f32x4 ot[4], lacc = (f32x4){0.f, 0.f, 0.f, 0.f};
#pragma unroll
            for (int dt = 0; dt < 4; ++dt) ot[dt] = (f32x4){0.f, 0.f, 0.f, 0.f};
            float m = -1e20f;
            const bf16x8 ones = __builtin_bit_cast(bf16x8, qi == 0 ? (u32x4){0x3F803F80u, 0x3F803F80u, 0x3F803F80u, 0x3F803F80u} : (u32x4){0u, 0u, 0u, 0u});
            bf16x8 kf[2][2];
            const LAS unsigned char* kp[2];
            { const int r0 = 16 * gi + qi;
#pragma unroll
              for (int ks = 0; ks < 2; ++ks) { const int c = g4 + 4 * ks; kp[ks] = Ks + r0 * 128 + ((c ^ (r0 & 7)) << 4); asm volatile("" : "+v"(kp[ks]));
                  kf[ks][0] = *(const LAS bf16x8*)(kp[ks]); kf[ks][1] = *(const LAS bf16x8*)(kp[ks] + 16 * 128); } }
            const LAS unsigned char* vp[4];
            { const int ra0 = 16 * gi + 4 * g4 + (qi >> 2);
#pragma unroll
              for (int dt = 0; dt < 4; ++dt) { const int ch = dt * 2 + ((qi & 3) >> 1); vp[dt] = Vs + ra0 * 128 + ((ch ^ (ra0 & 7)) << 4) + 8 * (qi & 1); asm volatile("" : "+v"(vp[dt])); } }
            const LAS float* tbq = tb + 4 * g4 - qi; asm volatile("" : "+v"(tbq));
            f32x4 c0, c1;
#pragma unroll
            for (int r = 0; r < 4; ++r) { c0[r] = tbq[r]; c1[r] = tbq[16 + r]; }
            for (int it = 0; it < nit; ++it) {
                const int rb = 16 * gi + 32 * it;
                v4i16_t vlo[4], vhi[4];
#pragma unroll
                for (int dt = 0; dt < 4; ++dt) { vlo[dt] = lds_tr16(vp[dt]); vhi[dt] = lds_tr16(vp[dt] + 16 * 128); vp[dt] += 4096; }
                f32x4 s0 = c0, s1 = c1;
#pragma unroll
                for (int ks = 0; ks < 2; ++ks) { s0 = __builtin_amdgcn_mfma_f32_16x16x32_bf16(kf[ks][0], qf[ks], s0, 0, 0, 0); s1 = __builtin_amdgcn_mfma_f32_16x16x32_bf16(kf[ks][1], qf[ks], s1, 0, 0, 0); }
                if (it + 1 < nit) {
#pragma unroll
                    for (int ks = 0; ks < 2; ++ks) { kp[ks] += 4096; kf[ks][0] = *(const LAS bf16x8*)(kp[ks]); kf[ks][1] = *(const LAS bf16x8*)(kp[ks] + 16 * 128); } }
                tbq += 32;
#pragma unroll
                for (int r = 0; r < 4; ++r) { c0[r] = tbq[r]; c1[r] = tbq[16 + r]; }
                float v[8];
                if (rb < rv0 || rb + 32 > rv1) {
#pragma unroll
                    for (int r = 0; r < 4; ++r) { const int row0 = rb + 4 * g4 + r, row1 = row0 + 16;
                        const bool ok0 = (unsigned)(row0 - rv0) < (unsigned)(rv1 - rv0), ok1 = (unsigned)(row1 - rv0) < (unsigned)(rv1 - rv0);
                        v[r] = ok0 ? s0[r] : -1e30f; v[4 + r] = ok1 ? s1[r] : -1e30f; }
                } else {
#pragma unroll
                    for (int r = 0; r < 4; ++r) { v[r] = s0[r]; v[4 + r] = s1[r]; }
                }
                float d[8];
#pragma unroll
                for (int i = 0; i < 8; ++i) d[i] = v[i] - m;
                const float dm = fmaxf(fmaxf(fmaxf(d[0], d[1]), fmaxf(d[2], d[3])), fmaxf(fmaxf(d[4], d[5]), fmaxf(d[6], d[7])));
                if (__builtin_amdgcn_ballot_w64(dm > 8.f) != 0ull) {
                    float tmax = fmaxf(fmaxf(fmaxf(v[0], v[1]), fmaxf(v[2], v[3])), fmaxf(fmaxf(v[4], v[5]), fmaxf(v[6], v[7])));
                    tmax = rows_max(tmax);
                    const float mn = fmaxf(m, tmax), alpha = __builtin_amdgcn_exp2f(m - mn); m = mn;
                    lacc[0] = lacc[0] * alpha;
#pragma unroll
                    for (int dt = 0; dt < 4; ++dt) ot[dt] = ot[dt] * alpha;
#pragma unroll
                    for (int i = 0; i < 8; ++i) d[i] = v[i] - mn;
                }
#pragma unroll
                for (int i = 0; i < 8; ++i) v[i] = __builtin_amdgcn_exp2f(d[i]);
                u32x4 pw; pw.x = cvtpk(v[0], v[1]); pw.y = cvtpk(v[2], v[3]); pw.z = cvtpk(v[4], v[5]); pw.w = cvtpk(v[6], v[7]);
                const bf16x8 pf = __builtin_bit_cast(bf16x8, pw);
                lacc = __builtin_amdgcn_mfma_f32_16x16x32_bf16(ones, pf, lacc, 0, 0, 0);
#pragma unroll
                for (int dt = 0; dt < 4; ++dt) { const bf16x8 vf = (bf16x8){vlo[dt][0], vlo[dt][1], vlo[dt][2], vlo[dt][3], vhi[dt][0], vhi[dt][1], vhi[dt][2], vhi[dt][3]};
                    ot[dt] = __builtin_amdgcn_mfma_f32_16x16x32_bf16(vf, pf, ot[dt], 0, 0, 0); }
            }
            float lsum = lacc[0];
            lsum = rows_sum(lsum);
            const size_t tok = (size_t)b * SEQ + posq;
            float scale;
            if (isB) { const float s2 = io.sink[head] * LOG2E, mf = fmaxf(m, s2), e = __builtin_amdgcn_exp2f(m - mf); scale = e / (lsum * e + __builtin_amdgcn_exp2f(s2 - mf)); }
            else { scale = 1.f / lsum; if (g4 == 0) io.LSE[((size_t)branch * M + tok) * 8 + head] = m + __builtin_amdgcn_logf(lsum); }
            bf16_t* op = isB ? io.O + tok * D + 512 + head * 64 : io.OBR + ((size_t)branch * M + tok) * 512 + head * 64;
#pragma unroll
            for (int dt = 0; dt < 4; ++dt) { const f32x4 o = ot[dt] * scale; u32x2 w; w.x = cvtpk(o[0], o[1]); w.y = cvtpk(o[2], o[3]); *(u32x2*)(op + dt * 16 + 4 * g4) = w; }
        }
    }
}
__device__ __forceinline__ void phase_attn_merge(const AttnIO& io, int gtid, int NGT) {
    for (int x = gtid; x < M * 64; x += NGT) { const int tok = x >> 6, head = (x >> 3) & 7, c8 = x & 7;
        const float l0 = io.LSE[((size_t)0 * M + tok) * 8 + head], l1 = io.LSE[((size_t)1 * M + tok) * 8 + head], l2 = io.LSE[((size_t)2 * M + tok) * 8 + head];
        const float mx = fmaxf(l0, fmaxf(l1, l2)); float w0 = __builtin_amdgcn_exp2f(l0 - mx), w1 = __builtin_amdgcn_exp2f(l1 - mx), w2 = __builtin_amdgcn_exp2f(l2 - mx);
        const float inv = 1.f / (w0 + w1 + w2); w0 *= inv; w1 *= inv; w2 *= inv;
        const size_t o = (size_t)tok * 512 + head * 64 + c8 * 8;
        const u32x4 a = *(const u32x4*)(io.OBR + o), bq = *(const u32x4*)(io.OBR + (size_t)M * 512 + o), c = *(const u32x4*)(io.OBR + (size_t)2 * M * 512 + o);
        u32x4 r;
        r.x = pk2(w0 * bflo(a.x) + w1 * bflo(bq.x) + w2 * bflo(c.x), w0 * bfhi(a.x) + w1 * bfhi(bq.x) + w2 * bfhi(c.x));
        r.y = pk2(w0 * bflo(a.y) + w1 * bflo(bq.y) + w2 * bflo(c.y), w0 * bfhi(a.y) + w1 * bfhi(bq.y) + w2 * bfhi(c.y));
        r.z = pk2(w0 * bflo(a.z) + w1 * bflo(bq.z) + w2 * bflo(c.z), w0 * bfhi(a.z) + w1 * bfhi(bq.z) + w2 * bfhi(c.z));
        r.w = pk2(w0 * bflo(a.w) + w1 * bflo(bq.w) + w2 * bflo(c.w), w0 * bfhi(a.w) + w1 * bfhi(bq.w) + w2 * bfhi(c.w));
        pg8::store16_wt(io.O + (size_t)tok * D + head * 64 + c8 * 8, r); }
}

constexpr int NCH = SEQ / 16;
constexpr int SC_LROW = 68, SC_LDROW = 528, SC_LSLOT = 4 * 16 * SC_LROW * 4 + 16 * SC_LDROW;
constexpr int CT_KHT = 0, CT_RHT = 2048, CT_BTT = 4096, CT_KTT = 6144, CT_VT = 8192, CT_WEND = 10240, CT_RKT = CT_WEND + 256, CT_SLOT = CT_RKT + 2048;
constexpr int GT_AKK = 0, GT_BB = 512, GT_BK = 1024, GT_TT = 1536, GT_SLOT = 2048;
constexpr int SC_LBUF = 0, SC_CT = SC_LBUF + 2 * SC_LSLOT, SC_GG = SC_CT + 3 * CT_SLOT, SC_RKR = SC_GG + 4 * 4096, SC_GT = SC_RKR + 4 * 256, SC_NB = SC_GT + 2 * GT_SLOT, SC_OUT = SC_NB + 1024, SC_END = SC_OUT + 2 * 4096;
static_assert(SC_END <= LDSCTL_OFF, "scan LDS map");
template <int CTRL> __device__ __forceinline__ float dpp_f(float x) { return __int_as_float(__builtin_amdgcn_update_dpp(0, __float_as_int(x), CTRL, 0xf, 0xf, true)); }
__device__ __forceinline__ float sum8(float x) { x += dpp_f<0xB1>(x); x += dpp_f<0x4E>(x); x += dpp_f<0x141>(x); return x; }
__device__ __forceinline__ float sum16(float x) { x += dpp_f<0xB1>(x); x += dpp_f<0x4E>(x); x += dpp_f<0x141>(x); x += dpp_f<0x140>(x); return x; }
__device__ __forceinline__ float fast_sigmoid(float z) { return __builtin_amdgcn_rcpf(1.f + __builtin_amdgcn_exp2f(-LOG2E * z)); }
__device__ __forceinline__ bf16x8 mk8(unsigned a, unsigned b, unsigned c, unsigned d) { return __builtin_bit_cast(bf16x8, (u32x4){a, b, c, d}); }

struct ScanPtrs { const bf16_t *R, *Kk, *V, *LDA; bf16_t* Y; const float *w2, *a2, *g2, *w0, *a0, *k_k, *k_a, *r_k, *gn_w, *gn_b; };
__device__ __forceinline__ void phase_scan(LAS unsigned char* lds, const ScanPtrs& P, int G) {
    int tid = threadIdx.x; asm volatile("" : "+v"(tid));
    const int lane = tid & 63, wid = __builtin_amdgcn_readfirstlane(tid >> 6), g4 = lane >> 4, c16 = lane & 15;
    for (int unit = blockIdx.x; unit < 256; unit += G) {
        const int b = unit >> 5, h = (unit >> 1) & 15, d = unit & 1, hc = h * 64;
        unsigned long long wait_acc = 0ull;
        __syncthreads();
        if (wid < 4) {
            f32x4 ST[4];
#pragma unroll
            for (int mt = 0; mt < 4; ++mt) ST[mt] = (f32x4){0.f, 0.f, 0.f, 0.f};
            const int pch = hc + 8 * (lane & 7);
            const f32x4 gw0 = *(const f32x4*)(P.gn_w + pch), gw1 = *(const f32x4*)(P.gn_w + pch + 4), gb0 = *(const f32x4*)(P.gn_b + pch), gb1 = *(const f32x4*)(P.gn_b + pch + 4);
            u32x4 pvA = {0u, 0u, 0u, 0u}, pvB = pvA;
            auto issueV = [&](int ch_, u32x4& dst) { const int s = 8 * (wid - 1) + (lane >> 3), t = d ? (SEQ - 1 - (ch_ * 16 + s)) : (ch_ * 16 + s); dst = *(const u32x4*)(P.V + ((size_t)b * SEQ + t) * D + pch); };
            if (wid == 1 || wid == 2) { issueV(0, pvA); issueV(1, pvB); }
            auto sw_interval = [&](int i, u32x4& pvset) {
                const int c = i - 3;
                int ln = lane; asm volatile("" : "+v"(ln)); const int g4 = ln >> 4, c16 = ln & 15;
                if (c >= 0 && c < NCH) {
                    const LAS unsigned char* Ct = lds + SC_CT + (c % 3) * CT_SLOT; const LAS unsigned char* Gt = lds + SC_GT + (c & 1) * GT_SLOT;
                    v4i16_t kha[2][2], rha[2][2];
#pragma unroll
                    for (int p = 0; p < 2; ++p)
#pragma unroll
                        for (int hh = 0; hh < 2; ++hh) { const int off = (32 * p + 16 * hh + 4 * g4 + (c16 >> 2)) * 32 + 8 * (c16 & 3); kha[p][hh] = lds_tr16(Ct + CT_KHT + off); rha[p][hh] = lds_tr16(Ct + CT_RHT + off); }
                    const u32x2 gakk = *(const LAS u32x2*)(Gt + GT_AKK + c16 * 32 + 8 * g4), gtt = *(const LAS u32x2*)(Gt + GT_TT + c16 * 32 + 8 * g4);
                    const u32x2 gbb = *(const LAS u32x2*)(Gt + GT_BB + c16 * 32 + 8 * g4), gbk = *(const LAS u32x2*)(Gt + GT_BK + c16 * 32 + 8 * g4);
                    const u32x2 vt = *(const LAS u32x2*)(Ct + CT_VT + (16 * wid + c16) * 32 + 8 * g4);
                    u32x2 btt[4], ktt[4]; f32x4 we[4];
#pragma unroll
                    for (int mt = 0; mt < 4; ++mt) { btt[mt] = *(const LAS u32x2*)(Ct + CT_BTT + (16 * mt + c16) * 32 + 8 * g4); ktt[mt] = *(const LAS u32x2*)(Ct + CT_KTT + (16 * mt + c16) * 32 + 8 * g4);
                        we[mt] = *(const LAS f32x4*)(Ct + CT_WEND + (16 * mt + 4 * g4) * 4); }
                    f32x4 pt = {0.f, 0.f, 0.f, 0.f}, prt = pt;
#pragma unroll
                    for (int p = 0; p < 2; ++p) { const bf16x8 sb = mk8(cvtpk(ST[2 * p][0], ST[2 * p][1]), cvtpk(ST[2 * p][2], ST[2 * p][3]), cvtpk(ST[2 * p + 1][0], ST[2 * p + 1][1]), cvtpk(ST[2 * p + 1][2], ST[2 * p + 1][3]));
                        pt = __builtin_amdgcn_mfma_f32_16x16x32_bf16((bf16x8){kha[p][0][0], kha[p][0][1], kha[p][0][2], kha[p][0][3], kha[p][1][0], kha[p][1][1], kha[p][1][2], kha[p][1][3]}, sb, pt, 0, 0, 0);
                        prt = __builtin_amdgcn_mfma_f32_16x16x32_bf16((bf16x8){rha[p][0][0], rha[p][0][1], rha[p][0][2], rha[p][0][3], rha[p][1][0], rha[p][1][1], rha[p][1][2], rha[p][1][3]}, sb, prt, 0, 0, 0); }
                    const f32x4 qt = __builtin_amdgcn_mfma_f32_16x16x32_bf16(mk8(gakk.x, gakk.y, 0u, 0u), mk8(vt.x, vt.y, 0u, 0u), pt, 0, 0, 0);
                    const f32x4 sat = __builtin_amdgcn_mfma_f32_16x16x32_bf16(mk8(gtt.x, gtt.y, 0u, 0u), mk8(cvtpk(qt[0], qt[1]), cvtpk(qt[2], qt[3]), 0u, 0u), (f32x4){0.f, 0.f, 0.f, 0.f}, 0, 0, 0);
                    const bf16x8 sv = mk8(cvtpk(sat[0], sat[1]), cvtpk(sat[2], sat[3]), vt.x, vt.y);
                    const f32x4 outt = __builtin_amdgcn_mfma_f32_16x16x32_bf16(mk8(gbb.x, gbb.y, gbk.x, gbk.y), sv, prt, 0, 0, 0);
#pragma unroll
                    for (int mt = 0; mt < 4; ++mt) { ST[mt] = __builtin_amdgcn_mfma_f32_16x16x32_bf16(mk8(btt[mt].x, btt[mt].y, ktt[mt].x, ktt[mt].y), sv, ST[mt], 0, 0, 0); ST[mt] = ST[mt] * we[mt]; }
                    LAS float* ob = (LAS float*)(lds + SC_OUT + (c & 1) * 4096) + 16 * wid + c16;
#pragma unroll
                    for (int r = 0; r < 4; ++r) ob[(4 * g4 + r) * 64] = outt[r];
                }
                for (int rep_ = 0; rep_ < REP_ST; ++rep_)
                if (i >= 2 && i - 2 < NCH) {
                    const int jg = i - 2, hw = wid;
                    const LAS unsigned char* Ct = lds + SC_CT + (jg % 3) * CT_SLOT; LAS unsigned char* Gt = lds + SC_GT + (jg & 1) * GT_SLOT;
                    const int aoff = (hw & 1) ? CT_KTT : CT_BTT, boff = (hw & 2) ? CT_RHT : CT_KHT;
                    f32x4 gm = {0.f, 0.f, 0.f, 0.f}, gmT = gm;
#pragma unroll
                    for (int ks = 0; ks < 2; ++ks) { const int o1 = (8 * g4 + 32 * ks + (c16 >> 2)) * 32 + 8 * (c16 & 3), o2 = o1 + 4 * 32;
                        const v4i16_t a0 = lds_tr16(Ct + aoff + o1), a1 = lds_tr16(Ct + aoff + o2), b0 = lds_tr16(Ct + boff + o1), b1 = lds_tr16(Ct + boff + o2);
                        const bf16x8 af = {a0[0], a0[1], a0[2], a0[3], a1[0], a1[1], a1[2], a1[3]}, bfr = {b0[0], b0[1], b0[2], b0[3], b1[0], b1[1], b1[2], b1[3]};
                        gm = __builtin_amdgcn_mfma_f32_16x16x32_bf16(af, bfr, gm, 0, 0, 0);
                        if (hw == 0) gmT = __builtin_amdgcn_mfma_f32_16x16x32_bf16(bfr, af, gmT, 0, 0, 0); }
                    if (hw == 3) {
                        const bf16x8 onesB = __builtin_bit_cast(bf16x8, c16 == 0 ? (u32x4){0x3F803F80u, 0x3F803F80u, 0x3F803F80u, 0x3F803F80u} : (u32x4){0u, 0u, 0u, 0u});
                        f32x4 rk = {0.f, 0.f, 0.f, 0.f};
#pragma unroll
                        for (int ks = 0; ks < 2; ++ks) { const int o1 = (8 * g4 + 32 * ks + (c16 >> 2)) * 32 + 8 * (c16 & 3), o2 = o1 + 4 * 32;
                            const v4i16_t r0 = lds_tr16(Ct + CT_RKT + o1), r1 = lds_tr16(Ct + CT_RKT + o2);
                            rk = __builtin_amdgcn_mfma_f32_16x16x32_bf16((bf16x8){r0[0], r0[1], r0[2], r0[3], r1[0], r1[1], r1[2], r1[3]}, onesB, rk, 0, 0, 0); }
                        if (c16 == 0) ((LAS f32x4*)(lds + SC_RKR + (jg & 3) * 256))[g4] = rk; }
#pragma unroll
                    for (int r = 0; r < 4; ++r) { const int s = 4 * g4 + r; const bool keep = (hw & 2) ? (s <= c16) : (s < c16); gm[r] = keep ? gm[r] : 0.f; gmT[r] = (c16 < s) ? gmT[r] : 0.f; }
                    if (hw != 0) { *(LAS u32x2*)(Gt + (hw == 1 ? GT_AKK : (hw == 2 ? GT_BB : GT_BK)) + c16 * 32 + 8 * g4) = (u32x2){cvtpk(gm[0], gm[1]), cvtpk(gm[2], gm[3])}; }
                    else {
#define SC_OPA(x) mk8(cvtpk((x)[0], (x)[1]), cvtpk((x)[2], (x)[3]), 0u, 0u)
                        const f32x4 z4 = {0.f, 0.f, 0.f, 0.f};
                        f32x4 Rm, RTm;
#pragma unroll
                        for (int r = 0; r < 4; ++r) { const float idn = (4 * g4 + r == c16) ? 1.f : 0.f; Rm[r] = idn - gm[r]; RTm[r] = idn - gmT[r]; }
                        const f32x4 N2 = __builtin_amdgcn_mfma_f32_16x16x32_bf16(SC_OPA(gmT), SC_OPA(gm), z4, 0, 0, 0), N2T = __builtin_amdgcn_mfma_f32_16x16x32_bf16(SC_OPA(gm), SC_OPA(gmT), z4, 0, 0, 0);
                        f32x4 R1 = __builtin_amdgcn_mfma_f32_16x16x32_bf16(SC_OPA(RTm), SC_OPA(N2), Rm, 0, 0, 0), R1T = __builtin_amdgcn_mfma_f32_16x16x32_bf16(SC_OPA(N2), SC_OPA(RTm), RTm, 0, 0, 0);
                        const f32x4 N4 = __builtin_amdgcn_mfma_f32_16x16x32_bf16(SC_OPA(N2T), SC_OPA(N2), z4, 0, 0, 0), N4T = __builtin_amdgcn_mfma_f32_16x16x32_bf16(SC_OPA(N2), SC_OPA(N2T), z4, 0, 0, 0);
                        f32x4 R2 = __builtin_amdgcn_mfma_f32_16x16x32_bf16(SC_OPA(R1T), SC_OPA(N4), R1, 0, 0, 0), R2T = __builtin_amdgcn_mfma_f32_16x16x32_bf16(SC_OPA(N4), SC_OPA(R1T), R1T, 0, 0, 0);
                        const f32x4 N8 = __builtin_amdgcn_mfma_f32_16x16x32_bf16(SC_OPA(N4T), SC_OPA(N4), z4, 0, 0, 0);
                        const f32x4 Tm = __builtin_amdgcn_mfma_f32_16x16x32_bf16(SC_OPA(R2T), SC_OPA(N8), R2, 0, 0, 0);
#undef SC_OPA
                        *(LAS u32x2*)(Gt + GT_TT + c16 * 32 + 8 * g4) = (u32x2){cvtpk(-Tm[0], -Tm[1]), cvtpk(-Tm[2], -Tm[3])};
                    }
                }
                if ((wid == 1 || wid == 2) && i >= 4 && i - 4 < NCH) {
                    const int jp = i - 4, tl = ln >> 3, c8 = ln & 7;
                    const int s = 8 * (wid - 1) + tl, t = d ? (SEQ - 1 - (jp * 16 + s)) : (jp * 16 + s);
                    const LAS float* ob = (const LAS float*)(lds + SC_OUT + (jp & 1) * 4096) + s * 64 + 8 * c8; const LAS float* gp = (const LAS float*)(lds + SC_GG + (jp & 3) * 4096) + s * 64 + 8 * c8;
                    const f32x4 o0 = *(const LAS f32x4*)(ob), o1 = *(const LAS f32x4*)(ob + 4), g0 = *(const LAS f32x4*)(gp), g1 = *(const LAS f32x4*)(gp + 4);
                    const float rkr = ((const LAS float*)(lds + SC_RKR + (jp & 3) * 256))[s];
                    const u32x4 pv = pvset; issueV(jp + 2 < NCH ? jp + 2 : NCH - 1, pvset);
                    const f32x4 v0 = {bflo(pv.x), bfhi(pv.x), bflo(pv.y), bfhi(pv.y)}, v1 = {bflo(pv.z), bfhi(pv.z), bflo(pv.w), bfhi(pv.w)};
                    float mu = ((o0[0] + o0[1]) + (o0[2] + o0[3])) + ((o1[0] + o1[1]) + (o1[2] + o1[3])); mu = sum8(mu) * (1.f / 64.f);
                    const f32x4 d0 = o0 - mu, d1 = o1 - mu; float var = ((d0[0] * d0[0] + d0[1] * d0[1]) + (d0[2] * d0[2] + d0[3] * d0[3])) + ((d1[0] * d1[0] + d1[1] * d1[1]) + (d1[2] * d1[2] + d1[3] * d1[3])); var = sum8(var) * (1.f / 64.f);
                    const float rs = rsqrtf(var + GN_EPS);
                    const f32x4 y0 = (d0 * rs * gw0 + gb0 + rkr * v0) * g0, y1 = (d1 * rs * gw1 + gb1 + rkr * v1) * g1;
                    pg8::store16_wt(P.Y + ((size_t)b * SEQ + t) * (2 * D) + d * D + hc + 8 * c8, (u32x4){cvtpk(y0[0], y0[1]), cvtpk(y0[2], y0[3]), cvtpk(y1[0], y1[1]), cvtpk(y1[2], y1[3])});
                }
                for (int rep_ = 0; rep_ < REP_SYNC; ++rep_) __syncthreads();
                if (WAITPROBE >= 0) { const unsigned long long t0_ = __builtin_amdgcn_s_memrealtime(); __syncthreads(); wait_acc += __builtin_amdgcn_s_memrealtime() - t0_; } else
                __syncthreads();
            };
            static_assert((NCH + 4) % 2 == 0, "interval loop is unrolled by two");
            __builtin_amdgcn_s_setprio(2);
            for (int i = 0; i < NCH + 4; i += 2) { sw_interval(i, pvA); sw_interval(i + 1, pvB); }
            __builtin_amdgcn_s_setprio(0);
        } else {
            const int hw = wid - 4;
            const int chC = hc + 16 * hw + c16, chT = hc + 4 * c16;
            bf16x8 bw[2], ba[2], bg[4];
#pragma unroll
            for (int ks = 0; ks < 2; ++ks) { u32x4 w, a;
#pragma unroll
                for (int jj = 0; jj < 4; ++jj) { const int k = 32 * ks + 8 * g4 + 2 * jj;
                    w[jj] = pk2(-LOG2E * P.w2[(size_t)(d * 64 + k) * D + chC], -LOG2E * P.w2[(size_t)(d * 64 + k + 1) * D + chC]); a[jj] = pk2(-LOG2E * P.a2[(size_t)(d * 64 + k) * D + chC], -LOG2E * P.a2[(size_t)(d * 64 + k + 1) * D + chC]); }
                bw[ks] = __builtin_bit_cast(bf16x8, w); ba[ks] = __builtin_bit_cast(bf16x8, a); }
#pragma unroll
            for (int ks = 0; ks < 4; ++ks) { u32x4 g;
#pragma unroll
                for (int jj = 0; jj < 4; ++jj) { const int k = 32 * ks + 8 * g4 + 2 * jj; g[jj] = pk2(P.g2[(size_t)(d * 128 + k) * D + chC], P.g2[(size_t)(d * 128 + k + 1) * D + chC]); }
                bg[ks] = __builtin_bit_cast(bf16x8, g); }
            const float w0c = -LOG2E * P.w0[d * D + chC], a0c = -LOG2E * P.a0[d * D + chC], kaC = P.k_a[chC], rkC = P.r_k[chC];
            const f32x4 kkT = *(const f32x4*)(P.k_k + chT);
            const int n0 = 16 * c16, lcol = n0 < 64 ? (d * 64 + n0) : (n0 < 128 ? (128 + d * 64 + (n0 - 64)) : (256 + d * 128 + (n0 - 128)));
            struct LSet { u32x2 r, k, v; u32x4 l0, l1; };
            LSet setA, setB;
            auto issueL = [&](int ch_, LSet& S) { const int s = 4 * hw + g4, t = d ? (SEQ - 1 - (ch_ * 16 + s)) : (ch_ * 16 + s); const size_t row = (size_t)b * SEQ + t;
                S.r = *(const u32x2*)(P.R + row * D + chT); S.k = *(const u32x2*)(P.Kk + row * D + chT); S.v = *(const u32x2*)(P.V + row * D + chT);
                S.l0 = *(const u32x4*)(P.LDA + row * 512 + lcol); S.l1 = *(const u32x4*)(P.LDA + row * 512 + lcol + 8); };
            issueL(0, setA); issueL(1, setB);
            auto hw_interval = [&](int i, LSet& LS) {
                const bool doL = i < NCH, doC = (i >= 1 && i - 1 < NCH);
                int ln = lane; asm volatile("" : "+v"(ln)); const int g4 = ln >> 4, c16 = ln & 15;
                const unsigned long long tb_ = (SECPROBE >= 0) ? __builtin_amdgcn_s_memrealtime() : 0ull;
                for (int rep_ = 0; rep_ < REP_HC; ++rep_)
                if (doC) {
                    const int jc = i - 1;
                    const LAS unsigned char* Ls = lds + SC_LBUF + (jc & 1) * SC_LSLOT;
                    const LAS unsigned char* ldp = Ls + 4 * 16 * SC_LROW * 4 + c16 * SC_LDROW + 16 * g4;
                    f32x4 zw = {w0c, w0c, w0c, w0c}, za = {a0c, a0c, a0c, a0c}, gg = {0.f, 0.f, 0.f, 0.f};
#pragma unroll
                    for (int ks = 0; ks < 2; ++ks) { zw = __builtin_amdgcn_mfma_f32_16x16x32_bf16(*(const LAS bf16x8*)(ldp + 64 * ks), bw[ks], zw, 0, 0, 0);
                                                     za = __builtin_amdgcn_mfma_f32_16x16x32_bf16(*(const LAS bf16x8*)(ldp + 128 + 64 * ks), ba[ks], za, 0, 0, 0); }
#pragma unroll
                    for (int ks = 0; ks < 4; ++ks) gg = __builtin_amdgcn_mfma_f32_16x16x32_bf16(*(const LAS bf16x8*)(ldp + 256 + 64 * ks), bg[ks], gg, 0, 0, 0);
                    float lw[4], cw[4]; float tot = 0.f;
#pragma unroll
                    for (int r = 0; r < 4; ++r) { lw[r] = (-0.6065306597f * LOG2E) * __builtin_amdgcn_rcpf(1.f + __builtin_amdgcn_exp2f(zw[r])); tot += lw[r]; cw[r] = tot; }
                    float pre;
                    { auto e = __builtin_amdgcn_permlane16_swap(__float_as_uint(tot), __float_as_uint(tot), false, false); const float e0 = __uint_as_float(e[0]), s01 = e0 + __uint_as_float(e[1]);
                      auto f = __builtin_amdgcn_permlane32_swap(__float_as_uint(s01), __float_as_uint(s01), false, false);
                      pre = ((g4 & 1) ? e0 : 0.f) + ((g4 & 2) ? __uint_as_float(f[0]) : 0.f); }
                    const LAS float* Lf = (const LAS float*)Ls + 16 * hw + c16;
                    LAS unsigned char* Ct = lds + SC_CT + (jc % 3) * CT_SLOT;
                    LAS float* ggw = (LAS float*)(lds + SC_GG + (jc & 3) * 4096) + 16 * hw + c16;
                    float kh[4], rh[4], bt[4], kt[4], vv[4], rkp[4];
                    float Wprev = __builtin_amdgcn_exp2f(pre);
#pragma unroll
                    for (int r = 0; r < 4; ++r) { const int tok = 4 * g4 + r; const float c = pre + cw[r];
                        const float Wc = __builtin_amdgcn_exp2f(c), Wp = Wprev, iW = __builtin_amdgcn_exp2f(-c); Wprev = Wc;
                        const float a = __builtin_amdgcn_rcpf(1.f + __builtin_amdgcn_exp2f(za[r]));
                        const float rr = Lf[tok * SC_LROW], kk_ = Lf[16 * SC_LROW + tok * SC_LROW], nk = Lf[32 * SC_LROW + tok * SC_LROW]; vv[r] = Lf[48 * SC_LROW + tok * SC_LROW];
                        const float kd = kk_ * (1.f + (a - 1.f) * kaC);
                        kh[r] = nk * Wp; rh[r] = rr * Wc; bt[r] = nk * a * iW; kt[r] = kd * iW; rkp[r] = rr * kd * rkC;
                        ggw[tok * 64] = gg[r];
                        if (tok == 15) ((LAS float*)(Ct + CT_WEND))[16 * hw + c16] = Wc; }
                    { LAS unsigned char* tq = Ct + (16 * hw + c16) * 32 + 8 * g4;
                      *(LAS u32x2*)(tq + CT_KHT) = (u32x2){cvtpk(kh[0], kh[1]), cvtpk(kh[2], kh[3])}; *(LAS u32x2*)(tq + CT_RHT) = (u32x2){cvtpk(rh[0], rh[1]), cvtpk(rh[2], rh[3])};
                      *(LAS u32x2*)(tq + CT_BTT) = (u32x2){cvtpk(bt[0], bt[1]), cvtpk(bt[2], bt[3])}; *(LAS u32x2*)(tq + CT_KTT) = (u32x2){cvtpk(kt[0], kt[1]), cvtpk(kt[2], kt[3])};
                      *(LAS u32x2*)(tq + CT_VT) = (u32x2){cvtpk(vv[0], vv[1]), cvtpk(vv[2], vv[3])};
                      *(LAS u32x2*)(tq + CT_RKT) = (u32x2){cvtpk(rkp[0], rkp[1]), cvtpk(rkp[2], rkp[3])}; }
                }
                const unsigned long long tc_ = (SECPROBE >= 0) ? __builtin_amdgcn_s_memrealtime() : 0ull;
                for (int rep_ = 0; rep_ < REP_HL; ++rep_)
                if (doL) {
                    LAS unsigned char* Ls = lds + SC_LBUF + (i & 1) * SC_LSLOT; LAS float* Lf = (LAS float*)Ls;
                    const int s = 4 * hw + g4;
                    const u32x2 lr = LS.r, lk = LS.k, lv = LS.v; const u32x4 l00 = LS.l0, l01 = LS.l1;
                    issueL(i + 2 < NCH ? i + 2 : NCH - 1, LS);
                    const f32x4 rr = {bflo(lr.x), bfhi(lr.x), bflo(lr.y), bfhi(lr.y)}, kk_ = {bflo(lk.x), bfhi(lk.x), bflo(lk.y), bfhi(lk.y)}, vv = {bflo(lv.x), bfhi(lv.x), bflo(lv.y), bfhi(lv.y)};
                    f32x4 nk = kk_ * kkT; float ss = nk[0] * nk[0] + nk[1] * nk[1] + nk[2] * nk[2] + nk[3] * nk[3];
                    ss = sum16(ss);
                    nk = nk * (1.f / fmaxf(sqrtf(ss), 1e-12f));
                    *(LAS f32x4*)(Lf + s * SC_LROW + 4 * c16) = rr; *(LAS f32x4*)(Lf + 16 * SC_LROW + s * SC_LROW + 4 * c16) = kk_;
                    *(LAS f32x4*)(Lf + 32 * SC_LROW + s * SC_LROW + 4 * c16) = nk; *(LAS f32x4*)(Lf + 48 * SC_LROW + s * SC_LROW + 4 * c16) = vv;
                    *(LAS u32x4*)(Ls + 4 * 16 * SC_LROW * 4 + s * SC_LDROW + 32 * c16) = l00; *(LAS u32x4*)(Ls + 4 * 16 * SC_LROW * 4 + s * SC_LDROW + 32 * c16 + 16) = l01;
                }
                for (int rep_ = 0; rep_ < REP_SYNC; ++rep_) __syncthreads();
                if (SECPROBE >= 0) { asm volatile("s_waitcnt vmcnt(0) lgkmcnt(0)" ::: "memory"); const unsigned long long te_ = __builtin_amdgcn_s_memrealtime(); wait_acc += (SECPROBE == 0) ? (tc_ - tb_) : ((SECPROBE == 1) ? (te_ - tc_) : (te_ - tb_)); __syncthreads(); } else
                if (WAITPROBE >= 0) { const unsigned long long t0_ = __builtin_amdgcn_s_memrealtime(); __syncthreads(); wait_acc += __builtin_amdgcn_s_memrealtime() - t0_; } else
                __syncthreads();
            };
            for (int i = 0; i < NCH + 4; i += 2) { hw_interval(i, setA); hw_interval(i + 1, setB); }
        }
        if ((WAITPROBE >= 0 || SECPROBE >= 0) && blockIdx.x == 0 && wid == (SECPROBE >= 0 ? 4 : WAITPROBE)) { const unsigned long long tgt_ = __builtin_amdgcn_s_memrealtime() + 4ull * wait_acc; while (__builtin_amdgcn_s_memrealtime() < tgt_) __builtin_amdgcn_s_sleep(8); }
    }
}

__global__ void __launch_bounds__(NTHREADS, 2) fwd_megakernel(Args args) {
    extern __shared__ __attribute__((aligned(16))) unsigned char lds_raw[];
    LAS unsigned char* lds = (LAS unsigned char*)lds_raw;
    volatile LAS unsigned* MISC = (volatile LAS unsigned*)(lds + MISC_OFF);
    const int tid0 = threadIdx.x, wave = __builtin_amdgcn_readfirstlane(tid0 >> 6);
#define FRESH_LANE() int tid = tid0; asm volatile("" : "+v"(tid)); const int lane = tid & 63; (void)lane
    const int G = gridDim.x;
    const int vcu = (G % 8 == 0) ? ((int)blockIdx.x % 8) * (G / 8) + (int)blockIdx.x / 8 : (int)blockIdx.x;
    const int gw = vcu * NWAVES + wave, NGW = G * NWAVES;
    unsigned char* ws = args.ws;
    unsigned* ctl = (unsigned*)(ws + WS_CTL);
    for (int u = tid0; u < (LDS_BYTES - LDSCTL_OFF) / 4; u += NTHREADS) ((LAS unsigned*)(lds + LDSCTL_OFF))[u] = 0u;
    __syncthreads();
    XcdBarrier bar = xcd_barrier_post(ctl + CW_BAR, MISC + 8);
    unsigned long long ts_a = 0ull; int ts_n = 0;
#define STAMP() do { if (TS_A >= 0) { const unsigned long long t_ = __builtin_amdgcn_s_memrealtime(); if (ts_n == TS_A) ts_a = t_; \
    if (ts_n == TS_B && blockIdx.x == 0) { const unsigned long long tgt_ = t_ + 4ull * (t_ - ts_a); while (__builtin_amdgcn_s_memrealtime() < tgt_) __builtin_amdgcn_s_sleep(8); } ++ts_n; } } while (0)
#define GRID_BAR() do { xcd_barrier(bar); STAMP(); } while (0)
    STAMP();

    const float* x = args.in[0]; const float* rel_table = args.in[1]; const float* norm_g = args.in[2]; const float* attn_w_in = args.in[3]; const float* attn_sink = args.in[4];
    const float* attn_w_out = args.in[5]; const float* mu_prev = args.in[6]; const float* mu_next = args.in[7]; const float* w_r = args.in[8]; const float* w_k = args.in[9];
    const float* w_v = args.in[10]; const float* w_o = args.in[11]; const float* mlp_w1 = args.in[25]; const float* mlp_w2 = args.in[26];
    bf16_t* HBa = (bf16_t*)args.out; bf16_t* HBb = HBa + (size_t)M * D; bf16_t* HBc = (bf16_t*)(ws + WS_HBC); bf16_t* TMP2 = (bf16_t*)(ws + WS_TMP2);
    bf16_t* XN = (bf16_t*)(ws + WS_XN); bf16_t* QKV = (bf16_t*)(ws + WS_QKV); bf16_t* Ob = (bf16_t*)(ws + WS_O); bf16_t* TMP = (bf16_t*)(ws + WS_TMP); bf16_t* Hb = (bf16_t*)(ws + WS_H);
    bf16_t* MIXA = (bf16_t*)(ws + WS_MIXA); bf16_t* MIXB = (bf16_t*)(ws + WS_MIXB); bf16_t* Rb = (bf16_t*)(ws + WS_R); bf16_t* Kb = (bf16_t*)(ws + WS_K); bf16_t* Vb = (bf16_t*)(ws + WS_V);
    bf16_t* LDO = (bf16_t*)(ws + WS_LDO); bf16_t* Yb = (bf16_t*)(ws + WS_Y);
    LAS float* scr = (LAS float*)(lds + wave * TR_SCR_BYTES);
    float* RS = (float*)(ws + WS_CTL + 128 * 1024);

    {
        FRESH_LANE();
        constexpr int I_IN = (D / 64) * (DIN / 64), I_OUT = (D / 64) * (D / 64), I_1 = (D / 64) * (DFF / 64), I_2 = (DFF / 64) * (D / 64);
        const bool tail = (G == 256);
        for (int it = gw; it < (tail ? I_IN : I_IN + I_OUT + I_1 + I_2); it += NGW) { int r = it;
            if (r < I_IN) { transpose_item(attn_w_in, DIN, DIN, (bf16_t*)(ws + WS_WIN_T), D, 0, 0, scr, r, lane, ScaleOne{}); continue; } r -= I_IN;
            if (r < I_OUT) { transpose_item(attn_w_out, D, D, (bf16_t*)(ws + WS_WOUT_T), D, 0, 0, scr, r, lane, ScaleOne{}); continue; } r -= I_OUT;
            if (r < I_1) { transpose_item(mlp_w1, DFF, DFF, (bf16_t*)(ws + WS_W1_T), D, 0, 0, scr, r, lane, ScaleVec{norm_g + 2 * D}); continue; } r -= I_1;
            transpose_item(mlp_w2, D, D, (bf16_t*)(ws + WS_W2_T), DFF, 0, 0, scr, r, lane, ScaleOne{}); }
        for (int row = gw; row < M; row += NGW) { Row16 r; row_load_f32(r, x + (size_t)row * D, lane); row_rmsnorm(r, norm_g, lane); row_store_bf16(r, XN + (size_t)row * D, lane); }
    }
    GRID_BAR();
    { pg8::StaticOrder S; S.init(M, DIN, G, (int)blockIdx.x); const EpiHeadMajor E{QKV};
      for (int rep = 0; rep < REP_GEMM; ++rep) pg8::gemm_phase<EpiHeadMajor, ProbPlain, true, true>(lds, ProbPlain{XN, (const bf16_t*)(ws + WS_WIN_T), D}, S, E); }
    if (G == 256 && blockIdx.x >= 64) {
        FRESH_LANE();
        constexpr int I_OUT = (D / 64) * (D / 64), I_1 = (D / 64) * (DFF / 64), I_2 = (DFF / 64) * (D / 64);
        for (int it = ((int)blockIdx.x - 64) * NWAVES + wave; it < I_OUT + I_1 + I_2; it += 192 * NWAVES) { int r = it;
            if (r < I_OUT) { transpose_item(attn_w_out, D, D, (bf16_t*)(ws + WS_WOUT_T), D, 0, 0, scr, r, lane, ScaleOne{}); continue; } r -= I_OUT;
            if (r < I_1) { transpose_item(mlp_w1, DFF, DFF, (bf16_t*)(ws + WS_W1_T), D, 0, 0, scr, r, lane, ScaleVec{norm_g + 2 * D}); continue; } r -= I_1;
            transpose_item(mlp_w2, D, D, (bf16_t*)(ws + WS_W2_T), DFF, 0, 0, scr, r, lane, ScaleOne{}); }
    }
    GRID_BAR();
    { const AttnIO io{QKV, rel_table, attn_sink, Ob, (bf16_t*)(ws + WS_OBR), (float*)(ws + WS_LSE)};
      for (int rep = 0; rep < REP_ATT; ++rep) phase_attn(lds, io, vcu, G);
      GRID_BAR();
      { FRESH_LANE(); phase_attn_merge(io, vcu * NTHREADS + tid, G * NTHREADS); } }
    GRID_BAR();
    for (int rep = 0; rep < REP_BAR; ++rep) GRID_BAR();
    run_gemm<0>(lds, ProbPlain{Ob, (const bf16_t*)(ws + WS_WOUT_T), D}, DstPlain{TMP, D}, M, D, G);
    GRID_BAR();
    { FRESH_LANE(); phase_resnorm<true, false>(x, TMP, norm_g + D, nullptr, HBa, nullptr, RS, gw, NGW, lane); }
    GRID_BAR();
    run_gemm_rs<1>(lds, ProbPlain{HBa, (const bf16_t*)(ws + WS_W1_T), D}, DstPlain{Hb, DFF}, RS, M, DFF, G);
    GRID_BAR();
    run_gemm<0>(lds, ProbPlain{Hb, (const bf16_t*)(ws + WS_W2_T), DFF}, DstPlain{TMP, D}, M, D, G);
    GRID_BAR();
    { FRESH_LANE(); phase_resnorm<false, false>(HBa, TMP, norm_g + 3 * D, nullptr, HBb, nullptr, nullptr, gw, NGW, lane); }
    GRID_BAR();
    {
        FRESH_LANE();
        const float* g1n = norm_g + 4 * D;
        constexpr int I_SQ = (D / 64) * (D / 64), I_1 = (D / 64) * (DFF / 64), I_2 = (DFF / 64) * (D / 64), I_LD = 384;
        const bool tail = (G == 256);
        for (int it = gw; it < (tail ? 2 * I_SQ + I_2 + I_LD : 4 * I_SQ + I_1 + I_2 + I_LD); it += NGW) { int r = it;
            if (r < I_SQ) { transpose_item(w_r, D, D, (bf16_t*)(ws + WS_WR_T), D, 0, 0, scr, r, lane, ScaleOne{}); continue; } r -= I_SQ;
            if (r < I_SQ) { transpose_item(w_k, D, D, (bf16_t*)(ws + WS_WK_T), D, 0, 0, scr, r, lane, ScaleOne{}); continue; } r -= I_SQ;
            if (!tail) {
                if (r < I_SQ) { transpose_item(w_v, D, D, (bf16_t*)(ws + WS_WV_T), D, 0, 0, scr, r, lane, ScaleOne{}); continue; } r -= I_SQ;
                if (r < I_SQ) { transpose_item(w_o, D, D, (bf16_t*)(ws + WS_WO2_T), D, 0, 0, scr, r, lane, ScaleOne{}); continue; } r -= I_SQ;
                if (r < I_1) { transpose_item(mlp_w1 + (size_t)D * DFF, DFF, DFF, (bf16_t*)(ws + WS_W1B_T), D, 0, 0, scr, r, lane, ScaleVec{norm_g + 6 * D}); continue; } r -= I_1; }
            if (r < I_2) { transpose_item(mlp_w2 + (size_t)DFF * D, D, D, (bf16_t*)(ws + WS_W2B_T), DFF, 0, 0, scr, r, lane, ScaleOne{}); continue; } r -= I_2;
            const int part = r / 128; int q = r % 128; int sub, li;
            if (q < 64) { sub = q / 16; li = q % 16; } else { sub = 4 + (q - 64) / 32; li = (q - 64) % 32; }
            const int dd = sub & 1, kind = sub >> 1;
            const int stream = kind == 0 ? 1 : (kind == 1 ? 4 : 5), Nn = kind == 2 ? 128 : 64;
            const float* src = kind == 0 ? args.in[18] + (size_t)dd * D * 64 : (kind == 1 ? args.in[21] + (size_t)dd * D * 64 : args.in[23] + (size_t)dd * D * 128);
            const int coloff = kind == 0 ? dd * 64 : (kind == 1 ? 128 + dd * 64 : 256 + dd * 128);
            transpose_item(src, Nn, Nn, (bf16_t*)(ws + WS_LDW_T), D, part * 512 + coloff, 0, scr, li, lane, ScaleMix{mu_prev + stream * D, mu_next + stream * D, part}); }
        phase_mix3(lds, HBb, g1n, mu_prev, mu_next, XN, MIXA, MIXB, HBa, gw, NGW, tid, lane);
    }
    GRID_BAR();
    run_gemm<0>(lds, ProbRKL{ws, D}, DstRKL{ws}, M, 14 * 256, G);
    if (G == 256 && blockIdx.x >= 128) {
        FRESH_LANE();
        constexpr int I_SQ = (D / 64) * (D / 64), I_1 = (D / 64) * (DFF / 64);
        for (int it = ((int)blockIdx.x - 128) * NWAVES + wave; it < 2 * I_SQ + I_1; it += 128 * NWAVES) { int r = it;
            if (r < I_SQ) { transpose_item(w_v, D, D, (bf16_t*)(ws + WS_WV_T), D, 0, 0, scr, r, lane, ScaleOne{}); continue; } r -= I_SQ;
            if (r < I_SQ) { transpose_item(w_o, D, D, (bf16_t*)(ws + WS_WO2_T), D, 0, 0, scr, r, lane, ScaleOne{}); continue; } r -= I_SQ;
            transpose_item(mlp_w1 + (size_t)D * DFF, DFF, DFF, (bf16_t*)(ws + WS_W1B_T), D, 0, 0, scr, r, lane, ScaleVec{norm_g + 6 * D}); }
    }
    GRID_BAR();
    { FRESH_LANE(); phase_lda(LDO, (bf16_t*)(ws + WS_LDA), gw, NGW, lane); }
    run_gemm<0>(lds, ProbPlain{HBa, (const bf16_t*)(ws + WS_WV_T), D}, DstPlain{Vb, D}, M, D, G);
    GRID_BAR();
    { ScanPtrs sp{Rb, Kb, Vb, (const bf16_t*)(ws + WS_LDA), Yb, args.in[19], args.in[22], args.in[24], args.in[17], args.in[20], args.in[12], args.in[13], args.in[14], args.in[15], args.in[16]};
      for (int rep = 0; rep < REP_SCAN; ++rep) phase_scan(lds, sp, G); }
    GRID_BAR();
    { FRESH_LANE();
      bf16_t* Ys = (bf16_t*)(ws + WS_YSUM);
      const bool grp_on = (G == 256);
      const int grow0 = 256 * (8 * ((int)blockIdx.x % 8) + ((int)blockIdx.x / 8) % 8) + 64 * ((int)blockIdx.x / 64);
      const int rfirst = grp_on ? grow0 + wave : gw, rend = grp_on ? grow0 + 64 : M, rstride = grp_on ? NWAVES : NGW;
      for (int row = rfirst; row < rend; row += rstride) {
          const u32x4* y0 = (const u32x4*)(Yb + (size_t)row * 2 * D); const u32x4* y1 = (const u32x4*)(Yb + (size_t)row * 2 * D + D);
#pragma unroll
          for (int hb = 0; hb < 2; ++hb) { const u32x4 a = y0[lane + 64 * hb], c = y1[lane + 64 * hb]; u32x4 o;
              o.x = cvtpk(bflo(a.x) + bflo(c.x), bfhi(a.x) + bfhi(c.x)); o.y = cvtpk(bflo(a.y) + bflo(c.y), bfhi(a.y) + bfhi(c.y));
              o.z = cvtpk(bflo(a.z) + bflo(c.z), bfhi(a.z) + bfhi(c.z)); o.w = cvtpk(bflo(a.w) + bflo(c.w), bfhi(a.w) + bfhi(c.w));
              pg8::store16_wt((u32x4*)(Ys + (size_t)row * D) + lane + 64 * hb, o); } }
      if (grp_on) { unsigned ep = 0u; grp_barrier(ctl + CW_BAR, (unsigned)blockIdx.x % 64u, ep); } else GRID_BAR();
      run_gemm<0>(lds, ProbPlain{Ys, (const bf16_t*)(ws + WS_WO2_T), D}, DstPlain{TMP2, D}, M, D, G); }
    GRID_BAR();
    { FRESH_LANE(); phase_resnorm<false, false>(HBb, TMP2, norm_g + 5 * D, nullptr, HBc, nullptr, RS, gw, NGW, lane); }
    GRID_BAR();
    run_gemm_rs<1>(lds, ProbPlain{HBc, (const bf16_t*)(ws + WS_W1B_T), D}, DstPlain{Hb, DFF}, RS, M, DFF, G);
    GRID_BAR();
    run_gemm<0>(lds, ProbPlain{Hb, (const bf16_t*)(ws + WS_W2B_T), DFF}, DstPlain{TMP2, D}, M, D, G);
    GRID_BAR();
    { FRESH_LANE(); phase_resnorm<false, true>(HBc, TMP2, norm_g + 7 * D, nullptr, args.out, nullptr, nullptr, gw, NGW, lane); }
    if (TS_A >= 0) { GRID_BAR(); }
#undef GRID_BAR
}

extern "C" void kernel_launch(void* const* d_in, const int* in_sizes, int n_in, void* d_out, int out_size, void* d_ws, size_t ws_size, hipStream_t stream) {
    static int grid = 0;
    if (grid == 0) {
        if (n_in != 27 || in_sizes[0] != M * D || out_size != M * D || ws_size < WS_END) { fprintf(stderr, "kernel_launch: unexpected shapes (n_in %d, in0 %d, out %d, ws %zu)\n", n_in, n_in > 0 ? in_sizes[0] : -1, out_size, ws_size); grid = -1; return; }
        int dev = 0, cus = 0, per_cu = 0;
        if (hipGetDevice(&dev) != hipSuccess || hipDeviceGetAttribute(&cus, hipDeviceAttributeMultiprocessorCount, dev) != hipSuccess) { grid = -1; return; }
        if (hipFuncSetAttribute((const void*)fwd_megakernel, hipFuncAttributeMaxDynamicSharedMemorySize, LDS_BYTES) != hipSuccess) { fprintf(stderr, "kernel_launch: hipFuncSetAttribute failed\n"); grid = -1; return; }
        if (hipOccupancyMaxActiveBlocksPerMultiprocessor(&per_cu, (const void*)fwd_megakernel, NTHREADS, LDS_BYTES) != hipSuccess || per_cu < 1) { fprintf(stderr, "kernel_launch: occupancy query says %d blocks/CU\n", per_cu); (void)hipGetLastError(); grid = -1; return; }
        grid = cus;
    }
    if (grid < 0) return;
    (void)hipMemsetAsync((char*)d_ws + WS_CTL, 0, CTL_ZERO_BYTES, stream);
    Args a{};
    for (int i = 0; i < 27; ++i) a.in[i] = (const float*)d_in[i];
    a.out = (float*)d_out; a.ws = (unsigned char*)d_ws;
    hipLaunchKernelGGL(fwd_megakernel, dim3(grid), dim3(NTHREADS), LDS_BYTES, stream, a);
}
```

```cpp
#include <hip/hip_runtime.h>
#include <cstdio>
#include <cstdint>

#define LAS __attribute__((address_space(3)))
#define GAS __attribute__((address_space(1)))
typedef unsigned short bf16_t;
typedef short bf16x8 __attribute__((ext_vector_type(8)));
typedef float f32x4 __attribute__((ext_vector_type(4)));
typedef float f32x2 __attribute__((ext_vector_type(2)));
typedef unsigned u32x4 __attribute__((ext_vector_type(4)));
typedef unsigned u32x2 __attribute__((ext_vector_type(2)));

#ifndef REP_SCAN
#define REP_SCAN 1
#endif
#ifndef REP_ATT
#define REP_ATT 1
#endif
#ifndef REP_GEMM
#define REP_GEMM 1
#endif
#ifndef REP_ATTC
#define REP_ATTC 1
#endif
#ifndef REP_BAR
#define REP_BAR 0
#endif
#ifndef REP_ATTS
#define REP_ATTS 1
#endif
#ifndef REP_HC
#define REP_HC 1
#endif
#ifndef REP_ST
#define REP_ST 1
#endif
#ifndef REP_HL
#define REP_HL 1
#endif
#ifndef REP_SYNC
#define REP_SYNC 0
#endif
#ifndef SECPROBE
#define SECPROBE -1
#endif
#ifndef WAITPROBE
#define WAITPROBE -1
#endif
#ifndef TS_A
#define TS_A -1
#endif
#ifndef TS_B
#define TS_B -1
#endif
constexpr int SEQ = 2048, D = 1024, NBATCH = 8, M = NBATCH * SEQ, DFF = 4096, DIN = 2304, NLD = 1536;
constexpr float NORM_EPS = 1e-6f, GN_EPS = 64e-5f;
constexpr int NWAVES = 8, NTHREADS = 512;

namespace pg8 {
constexpr int BM = 256, BK = 64, HALF = 128, HTB = HALF * BK * 2, STAGE_BYTES = 8 * HTB, NXCD = 8, WGM = 8;
__host__ __device__ __forceinline__ int lds_byte(int r, int c) { const int st = (r >> 4) * 2 + (c >> 5), rr = r & 15, cc = c & 31, ob = rr * 64 + cc * 2; return st * 1024 + (ob ^ (((ob >> 9) & 1) << 5)); }
__host__ __device__ __forceinline__ void stage_rc(int b, int& R, int& C) { const int st = b / 1024, sb = b % 1024, swz = sb ^ (((sb >> 9) & 1) << 5); R = (st >> 1) * 16 + swz / 64; C = (st & 1) * 32 + (swz % 64) / 2; }
__host__ __device__ __forceinline__ int perm32(int rho) { const int n = rho >> 4, i = rho & 15; return 8 * (i >> 2) + 4 * n + (i & 3); }

struct Unit { int pm, pn; };
struct StaticOrder {
    int nM, nN, nwg, G, c;
    __host__ __device__ void init(int Mr, int N, int G_, int c_) { nM = Mr / BM; nN = N / BM; nwg = nM * nN; G = G_; c = c_; }
    __host__ __device__ bool next(int i, Unit& u) const {
        const long L = (long)i * G + c; if (L >= nwg) return false;
        int wgid = (int)L; { const int q = nwg / NXCD, r = nwg % NXCD, xcd = wgid % NXCD, off = wgid / NXCD; wgid = (xcd < r ? xcd * (q + 1) : r * (q + 1) + (xcd - r) * q) + off; }
        const int nig = WGM * nN, gid = wgid / nig, fm = gid * WGM, gsz = (nM - fm) < WGM ? (nM - fm) : WGM;
        u.pm = fm + ((wgid % nig) % gsz); u.pn = (wgid % nig) / gsz; return true;
    }
};
__device__ __forceinline__ unsigned cvt_pk_bf16(float lo, float hi) { unsigned r; asm volatile("v_cvt_pk_bf16_f32 %0, %1, %2" : "=v"(r) : "v"(lo), "v"(hi)); return r; }

__device__ __forceinline__ void store16_wt(void* p, u32x4 v) { asm volatile("global_store_dwordx4 %0, %1, off sc1\n\ts_nop 1" :: "v"(p), "v"(v) : "memory"); }
template <int ACT, class DstFn, bool RS = false> struct EpiBf16 {
    static constexpr bool PERM = true;
    DstFn F; const float* rs;
    __device__ __forceinline__ void operator()(const f32x4 (&acc)[2][2][4][2], const Unit& u, int wr, int wc, int fr, int fq) const {
        bf16_t* base; int ldc; F(u, base, ldc);
        const int row0 = wr * 64 + fr, col0 = wc * 32 + 8 * fq;
        float rsc[2][4];
        if (RS) {
#pragma unroll
            for (int ai = 0; ai < 2; ++ai)
#pragma unroll
                for (int m = 0; m < 4; ++m) rsc[ai][m] = rs[u.pm * BM + row0 + ai * HALF + m * 16]; }
        if (RS && ACT == 1) {
            f32x4 t[2][2][4][2];
#pragma unroll
            for (int ai = 0; ai < 2; ++ai)
#pragma unroll
                for (int bj = 0; bj < 2; ++bj)
#pragma unroll
                    for (int m = 0; m < 4; ++m)
#pragma unroll
                        for (int n = 0; n < 2; ++n)
#pragma unroll
                            for (int e = 0; e < 4; ++e) { const float a = fmaxf(acc[ai][bj][m][n][e], 0.f); t[ai][bj][m][n][e] = a * a; }
#pragma unroll
            for (int ai = 0; ai < 2; ++ai)
#pragma unroll
                for (int m = 0; m < 4; ++m) { bf16_t* rowp = base + (size_t)(row0 + ai * HALF + m * 16) * ldc + col0; const float r2 = rsc[ai][m] * rsc[ai][m];
#pragma unroll
                    for (int bj = 0; bj < 2; ++bj) { const f32x4 v0 = t[ai][bj][m][0] * r2, v1 = t[ai][bj][m][1] * r2;
                        u32x4 w; w.x = cvt_pk_bf16(v0[0], v0[1]); w.y = cvt_pk_bf16(v0[2], v0[3]); w.z = cvt_pk_bf16(v1[0], v1[1]); w.w = cvt_pk_bf16(v1[2], v1[3]);
                        store16_wt(rowp + bj * HALF, w); } }
            return;
        }
#pragma unroll
        for (int ai = 0; ai < 2; ++ai)
#pragma unroll
            for (int m = 0; m < 4; ++m) { bf16_t* rowp = base + (size_t)(row0 + ai * HALF + m * 16) * ldc + col0;
#pragma unroll
                for (int bj = 0; bj < 2; ++bj) { f32x4 v0 = acc[ai][bj][m][0], v1 = acc[ai][bj][m][1];
                    if (RS) { v0 = v0 * rsc[ai][m]; v1 = v1 * rsc[ai][m]; }
                    if (ACT == 1) {
#pragma unroll
                        for (int e = 0; e < 4; ++e) { const float a = fmaxf(v0[e], 0.f), b = fmaxf(v1[e], 0.f); v0[e] = a * a; v1[e] = b * b; } }
                    u32x4 w; w.x = cvt_pk_bf16(v0[0], v0[1]); w.y = cvt_pk_bf16(v0[2], v0[3]); w.z = cvt_pk_bf16(v1[0], v1[1]); w.w = cvt_pk_bf16(v1[2], v1[3]);
                    store16_wt(rowp + bj * HALF, w); } }
    }
};

template <class Epi, class Prob, bool ALIGN_EPI, bool SP2>
__device__ __forceinline__ void gemm_phase(LAS unsigned char* lds, const Prob& P, const StaticOrder& S, const Epi& E) {
    int tid = threadIdx.x; asm volatile("" : "+v"(tid));
    const int wid = __builtin_amdgcn_readfirstlane(tid >> 6), lane = tid & 63, wr = wid >> 2, wc = wid & 3, fr = lane & 15, fq = lane >> 4;
    const int K = P.K, nt = K / BK;
    unsigned voffA[2], voffB[2];
#pragma unroll
    for (int i = 0; i < 2; ++i) { int R, C; stage_rc(tid * 16 + i * 8192, R, C); const int Rb = Epi::PERM ? ((R & ~31) + perm32(R & 31)) : R;
        voffA[i] = (unsigned)(R * K + C) * 2u; voffB[i] = (unsigned)(Rb * K + C) * 2u; }
    const size_t kstep = (size_t)(BK * 2);
    const size_t hstep = (size_t)HALF * K * 2;
    const unsigned ldsw = (unsigned)wid * 1024u;
    const int aoff = lds_byte(wr * 64 + fr, fq * 8), boff = lds_byte(wc * 32 + fr, fq * 8);
#define PG8_SA(b, h) (((b) * 2 + (h)) * HTB)
#define PG8_SB(b, h) ((4 + (b) * 2 + (h)) * HTB)
#define PG8_STAGE(bufoff, gbase, voff) do { _Pragma("unroll") for (int _i = 0; _i < 2; ++_i) \
        __builtin_amdgcn_global_load_lds((const unsigned*)((const char*)(gbase) + (voff)[_i]), (LAS unsigned*)(lds + (bufoff) + ldsw + _i * 8192), 16, 0, 0); } while (0)
#define PG8_LDA(dst, b, h) do { _Pragma("unroll") for (int m = 0; m < 4; ++m) _Pragma("unroll") for (int k = 0; k < 2; ++k) dst[m][k] = *(const LAS bf16x8*)(lds + PG8_SA(b, h) + aoff + m * 2048 + k * 1024); } while (0)
#define PG8_LDB(dst, b, h) do { _Pragma("unroll") for (int n = 0; n < 2; ++n) _Pragma("unroll") for (int k = 0; k < 2; ++k) dst[n][k] = *(const LAS bf16x8*)(lds + PG8_SB(b, h) + boff + n * 2048 + k * 1024); } while (0)
#define PG8_MMA(ai, bj, At, Bt) do { __builtin_amdgcn_s_setprio(1); _Pragma("unroll") for (int m = 0; m < 4; ++m) _Pragma("unroll") for (int n = 0; n < 2; ++n) _Pragma("unroll") for (int k = 0; k < 2; ++k) \
        acc[ai][bj][m][n] = __builtin_amdgcn_mfma_f32_16x16x32_bf16(Bt[n][k], At[m][k], acc[ai][bj][m][n], 0, 0, 0); __builtin_amdgcn_s_setprio(0); } while (0)
#define PG8_WAIT_V(n) asm volatile("s_waitcnt vmcnt(" #n ")" ::: "memory")
#define PG8_WAIT_L(n) asm volatile("s_waitcnt lgkmcnt(" #n ")" ::: "memory")
#define PG8_BAR __builtin_amdgcn_s_barrier()
#define PG8_SCHED __builtin_amdgcn_sched_barrier(0)
    Unit cur, nxt; int ui = 0;
    if (!S.next(0, cur)) return;
    f32x4 acc[2][2][4][2];
#pragma unroll
    for (int a = 0; a < 2; ++a)
#pragma unroll
        for (int b = 0; b < 2; ++b)
#pragma unroll
            for (int m = 0; m < 4; ++m)
#pragma unroll
                for (int n = 0; n < 2; ++n) acc[a][b][m][n] = (f32x4){0.f, 0.f, 0.f, 0.f};
    bf16x8 At[4][2], B0[2][2], B1[2][2];
    const char* cA = P.a_tile(cur); const char* cB = P.b_tile(cur);
    if constexpr (SP2) {
        PG8_STAGE(PG8_SB(0, 0), cB, voffB); PG8_STAGE(PG8_SB(0, 1), cB + hstep, voffB); PG8_STAGE(PG8_SA(0, 0), cA, voffA); PG8_STAGE(PG8_SA(0, 1), cA + hstep, voffA);
        if (wr == 1) PG8_BAR;
        PG8_WAIT_V(2); PG8_BAR;
        PG8_STAGE(PG8_SB(1, 0), cB + kstep, voffB); PG8_STAGE(PG8_SA(1, 0), cA + kstep, voffA); PG8_STAGE(PG8_SB(1, 1), cB + hstep + kstep, voffB);
        PG8_WAIT_V(6); PG8_BAR;
    } else {
        PG8_STAGE(PG8_SB(0, 0), cB, voffB); PG8_STAGE(PG8_SA(0, 0), cA, voffA); PG8_STAGE(PG8_SB(0, 1), cB + hstep, voffB); PG8_STAGE(PG8_SA(0, 1), cA + hstep, voffA);
        if (wr == 1) PG8_BAR;
        PG8_WAIT_V(4); PG8_BAR;
        PG8_STAGE(PG8_SB(1, 0), cB + kstep, voffB); PG8_STAGE(PG8_SA(1, 0), cA + kstep, voffA); PG8_STAGE(PG8_SB(1, 1), cB + hstep + kstep, voffB);
        PG8_WAIT_V(6); PG8_BAR;
    }
    for (;;) {
        const bool has_next = S.next(ui + 1, nxt);
        const char* nA = has_next ? P.a_tile(nxt) : cA; const char* nB = has_next ? P.b_tile(nxt) : cB;
        for (int t = 0; t < nt; t += 2) {
            const bool last = (t == nt - 2);
            const char* a1 = cA + (size_t)(t + 1) * kstep;
            const char* a2 = last ? nA : cA + (size_t)(t + 2) * kstep; const char* b2 = last ? nB : cB + (size_t)(t + 2) * kstep;
            const char* a3 = a2 + kstep; const char* b3 = b2 + kstep;
            if constexpr (SP2) {
            PG8_LDB(B0, 0, 0); PG8_LDB(B1, 0, 1); PG8_SCHED; PG8_LDA(At, 0, 0); PG8_STAGE(PG8_SA(1, 1), a1 + hstep, voffA);
            PG8_WAIT_V(8); PG8_WAIT_L(0); PG8_BAR; PG8_MMA(0, 0, At, B0); PG8_MMA(0, 1, At, B1); PG8_BAR; PG8_SCHED;
            PG8_LDA(At, 0, 1); PG8_STAGE(PG8_SB(0, 0), b2, voffB); PG8_STAGE(PG8_SB(0, 1), b2 + hstep, voffB); PG8_STAGE(PG8_SA(0, 0), a2, voffA);
            PG8_WAIT_V(8); PG8_WAIT_L(0); PG8_BAR; PG8_MMA(1, 0, At, B0); PG8_MMA(1, 1, At, B1); PG8_BAR; PG8_SCHED;
            PG8_LDB(B0, 1, 0); PG8_LDB(B1, 1, 1); PG8_SCHED; PG8_LDA(At, 1, 0); PG8_STAGE(PG8_SA(0, 1), a2 + hstep, voffA);
            PG8_WAIT_V(8); PG8_WAIT_L(0); PG8_BAR; PG8_MMA(0, 0, At, B0); PG8_MMA(0, 1, At, B1); PG8_BAR; PG8_SCHED;
            PG8_LDA(At, 1, 1); PG8_STAGE(PG8_SB(1, 0), b3, voffB); PG8_STAGE(PG8_SB(1, 1), b3 + hstep, voffB); PG8_STAGE(PG8_SA(1, 0), a3, voffA);
            PG8_WAIT_V(8); PG8_WAIT_L(0); PG8_BAR; PG8_MMA(1, 0, At, B0); PG8_MMA(1, 1, At, B1); PG8_BAR; PG8_SCHED;
            } else {
            PG8_LDB(B0, 0, 0); PG8_SCHED; PG8_LDA(At, 0, 0); PG8_STAGE(PG8_SA(1, 1), a1 + hstep, voffA);
            PG8_WAIT_L(8); PG8_BAR; PG8_WAIT_L(0); PG8_MMA(0, 0, At, B0); PG8_BAR; PG8_SCHED;
            PG8_LDB(B1, 0, 1); PG8_STAGE(PG8_SB(0, 0), b2, voffB);
            PG8_BAR; PG8_WAIT_L(0); PG8_MMA(0, 1, At, B1); PG8_BAR;
            PG8_LDA(At, 0, 1); PG8_STAGE(PG8_SA(0, 0), a2, voffA);
            PG8_BAR; PG8_WAIT_L(0); PG8_MMA(1, 0, At, B0); PG8_BAR; PG8_SCHED;
            PG8_STAGE(PG8_SB(0, 1), b2 + hstep, voffB);
            PG8_WAIT_V(6); PG8_BAR; PG8_MMA(1, 1, At, B1); PG8_BAR;
            PG8_LDB(B0, 1, 0); PG8_SCHED; PG8_LDA(At, 1, 0); PG8_STAGE(PG8_SA(0, 1), a2 + hstep, voffA);
            PG8_WAIT_L(8); PG8_BAR; PG8_WAIT_L(0); PG8_MMA(0, 0, At, B0); PG8_BAR; PG8_SCHED;
            PG8_LDB(B1, 1, 1); PG8_STAGE(PG8_SB(1, 0), b3, voffB);
            PG8_BAR; PG8_WAIT_L(0); PG8_MMA(0, 1, At, B1); PG8_BAR;
            PG8_LDA(At, 1, 1); PG8_STAGE(PG8_SA(1, 0), a3, voffA);
            PG8_BAR; PG8_WAIT_L(0); PG8_MMA(1, 0, At, B0); PG8_BAR; PG8_SCHED;
            PG8_STAGE(PG8_SB(1, 1), b3 + hstep, voffB);
            PG8_WAIT_V(6); PG8_BAR; PG8_MMA(1, 1, At, B1); PG8_BAR;
            }
        }
        if constexpr (ALIGN_EPI) { if (wr == 0) PG8_BAR; }
        E(acc, cur, wr, wc, fr, fq);
        if (!has_next) break;
#pragma unroll
        for (int a = 0; a < 2; ++a)
#pragma unroll
            for (int b = 0; b < 2; ++b)
#pragma unroll
                for (int m = 0; m < 4; ++m)
#pragma unroll
                    for (int n = 0; n < 2; ++n) acc[a][b][m][n] = (f32x4){0.f, 0.f, 0.f, 0.f};
        cur = nxt; cA = nA; cB = nB; ++ui;
        if constexpr (ALIGN_EPI) { if (wr == 1) PG8_BAR; }
    }
    PG8_WAIT_V(0);
    if constexpr (!ALIGN_EPI) { if (wr == 0) PG8_BAR; }
    PG8_BAR;
#undef PG8_SA
#undef PG8_SB
#undef PG8_STAGE
#undef PG8_LDA
#undef PG8_LDB
#undef PG8_MMA
#undef PG8_WAIT_V
#undef PG8_WAIT_L
#undef PG8_BAR
#undef PG8_SCHED
}
}

constexpr size_t MiB = 1u << 20;
constexpr size_t WS_CTL = 0, CTL_ZERO_BYTES = 64 * 1024;
constexpr size_t WS_W = 1 * MiB;
constexpr size_t WS_WIN_T = WS_W, WS_WOUT_T = WS_WIN_T + (size_t)DIN * D * 2, WS_W1_T = WS_WOUT_T + (size_t)D * D * 2, WS_W2_T = WS_W1_T + (size_t)DFF * D * 2;
constexpr size_t WS_WR_T = WS_W, WS_WK_T = WS_WR_T + 2 * MiB, WS_LDW_T = WS_WK_T + 2 * MiB, WS_WV_T = WS_LDW_T + 3 * MiB, WS_WO2_T = WS_WV_T + 2 * MiB, WS_W1B_T = WS_WO2_T + 4 * MiB, WS_W2B_T = WS_W1B_T + 8 * MiB;
static_assert(WS_W2_T + (size_t)D * DFF * 2 <= 31 * MiB && WS_W2B_T + (size_t)D * DFF * 2 <= 31 * MiB, "weight region");
constexpr size_t WS_XN = 31 * MiB, WS_QKV = 63 * MiB, WS_O = 135 * MiB, WS_OBR = 167 * MiB, WS_LSE = 215 * MiB, WS_TMP = 217 * MiB, WS_H = 63 * MiB;
constexpr size_t WS_MIXA = 63 * MiB, WS_MIXB = 95 * MiB, WS_R = 127 * MiB, WS_K = 159 * MiB, WS_V = 31 * MiB, WS_LDO = 191 * MiB, WS_Y = 63 * MiB, WS_LDA = 239 * MiB;
constexpr size_t WS_YSUM = 127 * MiB;
constexpr size_t WS_HBC = 191 * MiB, WS_TMP2 = 223 * MiB;
constexpr size_t WS_END = 256 * MiB;
static_assert(WS_HBC >= WS_H + (size_t)M * DFF * 2 && WS_HBC + (size_t)M * D * 2 <= WS_TMP2 && WS_TMP2 + (size_t)M * D * 2 <= WS_END, "layer-1 tail");
static_assert(WS_LDO + (size_t)M * NLD * 2 <= WS_LDA && WS_LDA + (size_t)M * 512 * 2 <= WS_END && WS_TMP + (size_t)M * D * 2 <= WS_END, "tail of the map");
static_assert(WS_MIXA == WS_XN + 32 * MiB && WS_MIXB == WS_XN + 64 * MiB && WS_K == WS_R + 32 * MiB && WS_LDO == WS_R + 64 * MiB && WS_WK_T == WS_WR_T + 2 * MiB && WS_LDW_T == WS_WR_T + 4 * MiB, "grouped GEMM strides");
constexpr int CW_BAR = 4096;

constexpr int RING_BYTES = 131072, LDSCTL_OFF = 143360, MISC_OFF = LDSCTL_OFF + 320, LDS_BYTES = 147456;

typedef __bf16 bf16x2_t __attribute__((ext_vector_type(2)));
__device__ __forceinline__ unsigned cvtpk(float lo, float hi) { const f32x2 v = {lo, hi}; const bf16x2_t b = __builtin_convertvector(v, bf16x2_t); return __builtin_bit_cast(unsigned, b); }
__device__ __forceinline__ float bf2f(unsigned short b) { return __uint_as_float((unsigned)b << 16); }
__device__ __forceinline__ float bflo(unsigned w) { return __uint_as_float(w << 16); }
__device__ __forceinline__ float bfhi(unsigned w) { return __uint_as_float(w & 0xffff0000u); }
__device__ __forceinline__ unsigned f2bf(float f) { unsigned u = __float_as_uint(f); return (u + 0x7fffu + ((u >> 16) & 1u)) >> 16; }
__device__ __forceinline__ unsigned pk2(float lo, float hi) { return f2bf(lo) | (f2bf(hi) << 16); }
__device__ __forceinline__ float wave_sum(float v) {
#pragma unroll
    for (int o = 1; o < 64; o <<= 1) v += __shfl_xor(v, o);
    return v;
}
__device__ __forceinline__ float sigmoidf_(float z) { return 1.f / (1.f + __expf(-z)); }
__device__ __forceinline__ int t5_bucket(int rel) {
    const int n = rel < 0 ? -rel : rel;
    int large;
    if (n < 8) large = n; else if (n < 15) large = 8; else if (n < 27) large = 9; else if (n < 50) large = 10; else if (n < 91) large = 11;
    else if (n < 166) large = 12; else if (n < 305) large = 13; else if (n < 559) large = 14; else large = 15;
    return (rel > 0 ? 16 : 0) + large;
}

#define XB_TMO      128
#define XB_XCNT(j)  (256  + 64 * (j))
#define XB_XSUB(j)  (1280 + 64 * (j))
#define XB_XGEN(j)  (2304 + 64 * (j))
#define XB_TOP      3328
#define XB_TOPGEN   3392
#define XCD_BAR_WORDS 3456
#define XB_SPIN_CAP (1u << 18)
__device__ __forceinline__ unsigned xb_ld(unsigned* p)              { return __hip_atomic_load(p, __ATOMIC_RELAXED, __HIP_MEMORY_SCOPE_AGENT); }
__device__ __forceinline__ unsigned xb_add(unsigned* p, unsigned v) { return __hip_atomic_fetch_add(p, v, __ATOMIC_RELAXED, __HIP_MEMORY_SCOPE_AGENT); }
__device__ __forceinline__ unsigned xb_xcc_id() { return (unsigned)__builtin_amdgcn_s_getreg((3 << 11) | 20) & 0xFu; }
#define XB_SPIN(cond, bar) do { unsigned _sp = 0; while (cond) { __builtin_amdgcn_s_sleep(1); \
    if ((++_sp & 255u) == 0u) { if (xb_ld(&(bar)[XB_TMO])) break; if (_sp > XB_SPIN_CAP) { atomicAdd(&(bar)[XB_TMO], 1u); break; } } } } while (0)
struct XcdBarrier { unsigned* bar; unsigned x; volatile LAS unsigned* st; };
__device__ __forceinline__ XcdBarrier xcd_barrier_post(unsigned* bar, volatile LAS unsigned* st) {
    XcdBarrier b; b.bar = bar; b.x = xb_xcc_id(); b.st = st;
    if (threadIdx.x == 0) (void)xb_add(&bar[XB_XCNT(b.x)], 1u);
    return b;
}
__device__ __forceinline__ void xcd_barrier_complete(unsigned* bar, unsigned x, unsigned& nloc, unsigned& nx) {
    const unsigned G = gridDim.x * gridDim.y * gridDim.z;
    unsigned sum, cnt, mine, sp = 0u;
    for (;;) {
        sum = 0u; cnt = 0u; mine = 0u;
#pragma unroll
        for (unsigned j = 0; j < 16; ++j) { const unsigned c = xb_ld(&bar[XB_XCNT(j)]); sum += c; cnt += (c > 0u) ? 1u : 0u; mine = (j == x) ? c : mine; }
        if (sum == G) break;
        __builtin_amdgcn_s_sleep(1);
        if ((++sp & 255u) == 0u) { if (xb_ld(&bar[XB_TMO])) break; if (sp > XB_SPIN_CAP) { atomicAdd(&bar[XB_TMO], 1u); break; } }
    }
    nloc = mine > 0u ? mine : 1u; nx = cnt > 0u ? cnt : 1u;
}
__device__ __forceinline__ void xcd_barrier(const XcdBarrier& b) {
    asm volatile("s_waitcnt vmcnt(0)" ::: "memory");
    __syncthreads();
    if (threadIdx.x == 0) {
        unsigned* bar = b.bar;
        __builtin_amdgcn_s_waitcnt(0);
        unsigned nloc = b.st[0], nx = b.st[1];
        if (nloc == 0u) { xcd_barrier_complete(bar, b.x, nloc, nx); b.st[0] = nloc; b.st[1] = nx; }
        const unsigned old = xb_add(&bar[XB_XSUB(b.x)], 1u);
        const unsigned gen = old / nloc;
        if (old + 1u == (gen + 1u) * nloc) {
            __builtin_amdgcn_fence(__ATOMIC_RELEASE, "agent");
            asm volatile("s_waitcnt vmcnt(0)" ::: "memory");
            const unsigned og = xb_add(&bar[XB_TOP], 1u);
            const unsigned tg = og / nx;
            if (og + 1u == (tg + 1u) * nx) xb_add(&bar[XB_TOPGEN], 1u);
            else XB_SPIN(xb_ld(&bar[XB_TOPGEN]) == tg, bar);
            __builtin_amdgcn_fence(__ATOMIC_ACQUIRE, "agent");
            xb_add(&bar[XB_XGEN(b.x)], 1u);
            asm volatile("s_waitcnt vmcnt(0)" ::: "memory");
        } else {
            XB_SPIN(xb_ld(&bar[XB_XGEN(b.x)]) == gen, bar);
            __builtin_amdgcn_fence(__ATOMIC_ACQUIRE, "agent");
            asm volatile("s_waitcnt vmcnt(0)" ::: "memory");
        }
    }
    __syncthreads();
}

#define XB_GRP(g)   (4096 + 16 * (g))
__device__ __forceinline__ void grp_barrier(unsigned* bar, unsigned g, unsigned& epoch) {
    asm volatile("s_waitcnt vmcnt(0)" ::: "memory");
    __syncthreads();
    ++epoch;
    if (threadIdx.x == 0) {
        unsigned* word = &bar[XB_GRP(g)];
        (void)xb_add(word, 1u);
        const unsigned tgt = 4u * epoch;
        XB_SPIN(xb_ld(word) < tgt, bar);
        __builtin_amdgcn_fence(__ATOMIC_ACQUIRE, "agent");
        asm volatile("s_waitcnt vmcnt(0)" ::: "memory");
    }
    __syncthreads();
}

struct Row16 { f32x4 v[4]; };
__device__ __forceinline__ int row_q(int lane, int j) { return 2 * lane + 128 * (j >> 1) + (j & 1); }
__device__ __forceinline__ void row_load_f32(Row16& r, const float* p, int lane) {
#pragma unroll
    for (int j = 0; j < 4; ++j) r.v[j] = ((const f32x4*)p)[row_q(lane, j)];
}
struct RowRaw { u32x4 w[2]; };
__device__ __forceinline__ void row_raw_load(RowRaw& r, const bf16_t* p, int lane) { r.w[0] = ((const u32x4*)p)[lane]; r.w[1] = ((const u32x4*)p)[lane + 64]; }
__device__ __forceinline__ void row_from_raw(Row16& r, const RowRaw& q) {
#pragma unroll
    for (int b = 0; b < 2; ++b) { const u32x4 w = q.w[b]; r.v[2 * b] = (f32x4){bflo(w.x), bfhi(w.x), bflo(w.y), bfhi(w.y)}; r.v[2 * b + 1] = (f32x4){bflo(w.z), bfhi(w.z), bflo(w.w), bfhi(w.w)}; }
}
__device__ __forceinline__ void row_load_bf16(Row16& r, const bf16_t* p, int lane) { RowRaw q; row_raw_load(q, p, lane); row_from_raw(r, q); }
__device__ __forceinline__ void row_store_f32(const Row16& r, float* p, int lane) {
#pragma unroll
    for (int j = 0; j < 4; ++j) pg8::store16_wt((f32x4*)p + row_q(lane, j), __builtin_bit_cast(u32x4, r.v[j]));
}
__device__ __forceinline__ void row_store_bf16(const Row16& r, bf16_t* p, int lane) {
#pragma unroll
    for (int b = 0; b < 2; ++b) { u32x4 w; w.x = cvtpk(r.v[2 * b][0], r.v[2 * b][1]); w.y = cvtpk(r.v[2 * b][2], r.v[2 * b][3]); w.z = cvtpk(r.v[2 * b + 1][0], r.v[2 * b + 1][1]); w.w = cvtpk(r.v[2 * b + 1][2], r.v[2 * b + 1][3]);
        pg8::store16_wt((u32x4*)p + lane + 64 * b, w); }
}
__device__ __forceinline__ void vec_load(Row16& r, const float* g, int lane) { row_load_f32(r, g, lane); }
__device__ __forceinline__ void row_rmsnorm_v(Row16& r, const Row16& g) {
    float s = 0.f;
#pragma unroll
    for (int j = 0; j < 4; ++j) s += r.v[j][0] * r.v[j][0] + r.v[j][1] * r.v[j][1] + r.v[j][2] * r.v[j][2] + r.v[j][3] * r.v[j][3];
    const float rs = rsqrtf(wave_sum(s) * (1.f / D) + NORM_EPS);
#pragma unroll
    for (int j = 0; j < 4; ++j) r.v[j] = r.v[j] * rs * g.v[j];
}
__device__ __forceinline__ void row_rmsnorm(Row16& r, const float* g, int lane) { Row16 gg; vec_load(gg, g, lane); row_rmsnorm_v(r, gg); }

constexpr int TR_SCR_BYTES = 64 * 65 * 4;
template <class ScaleFn>
__device__ __forceinline__ void transpose_item(const float* W, int ldw, int N, bf16_t* WT, int ldt, int row_off, int koff, LAS float* scr, int item, int lane, ScaleFn sc) {
    const int nblk = N / 64, kb = item / nblk, nb = item % nblk, k0 = 64 * kb, n0 = 64 * nb;
    const int lk = lane >> 4, ln4 = (lane & 15) * 4;
    f32x4 v[16];
#pragma unroll
    for (int i = 0; i < 16; ++i) v[i] = *(const f32x4*)(W + (size_t)(k0 + 4 * i + lk) * ldw + n0 + ln4);
#pragma unroll
    for (int i = 0; i < 16; ++i) { const int kk = 4 * i + lk; const float s = sc(k0 + kk); LAS float* d = scr + kk * 65 + ln4; d[0] = v[i][0] * s; d[1] = v[i][1] * s; d[2] = v[i][2] * s; d[3] = v[i][3] * s; }
    asm volatile("s_waitcnt lgkmcnt(0)" ::: "memory");
    const int c = lane >> 3, nn = lane & 7;
#pragma unroll
    for (int j = 0; j < 8; ++j) { const int n = nn + 8 * j; const LAS float* s = scr + (8 * c) * 65 + n;
        u32x4 o; o.x = cvtpk(s[0 * 65], s[1 * 65]); o.y = cvtpk(s[2 * 65], s[3 * 65]); o.z = cvtpk(s[4 * 65], s[5 * 65]); o.w = cvtpk(s[6 * 65], s[7 * 65]);
        pg8::store16_wt(WT + (size_t)(row_off + n0 + n) * ldt + koff + k0 + 8 * c, o); }
    asm volatile("s_waitcnt lgkmcnt(0)" ::: "memory");
}
struct ScaleOne { __device__ __forceinline__ float operator()(int) const { return 1.f; } };
struct ScaleVec { const float* g; __device__ __forceinline__ float operator()(int k) const { return g[k]; } };
struct ScaleMix { const float* mp; const float* mn; int part;
    __device__ __forceinline__ float operator()(int k) const { return part == 0 ? 1.f - mp[k] - mn[k] : (part == 1 ? mp[k] : mn[k]); } };

struct Args { const float* in[27]; float* out; unsigned char* ws; };

struct ProbPlain { const bf16_t* A; const bf16_t* Bt; int K;
    __device__ __forceinline__ const char* a_tile(const pg8::Unit& u) const { return (const char*)(A + (size_t)u.pm * 256 * K); }
    __device__ __forceinline__ const char* b_tile(const pg8::Unit& u) const { return (const char*)(Bt + (size_t)u.pn * 256 * K); } };
struct DstPlain { bf16_t* C; int ldc;
    __device__ __forceinline__ void operator()(const pg8::Unit& u, bf16_t*& base, int& ld) const { base = C + (size_t)u.pm * 256 * ldc + (size_t)u.pn * 256; ld = ldc; } };
struct ProbRKL { const unsigned char* ws; int K;
    __device__ __forceinline__ const char* a_tile(const pg8::Unit& u) const { const int g = u.pn < 4 ? 0 : (u.pn < 8 ? 1 : 2); const int ga = g == 2 ? 0 : g + 1;
        return (const char*)(ws + WS_XN + (size_t)ga * (32 * MiB) + (size_t)u.pm * 256 * D * 2); }
    __device__ __forceinline__ const char* b_tile(const pg8::Unit& u) const { const int g = u.pn < 4 ? 0 : (u.pn < 8 ? 1 : 2); const int t = u.pn - 4 * g;
        return (const char*)(ws + WS_WR_T + (size_t)g * (2 * MiB) + (size_t)t * 256 * D * 2); } };
struct DstRKL { unsigned char* ws;
    __device__ __forceinline__ void operator()(const pg8::Unit& u, bf16_t*& base, int& ld) const {
        const int g = u.pn < 4 ? 0 : (u.pn < 8 ? 1 : 2); const int t = u.pn - 4 * g; ld = g == 2 ? NLD : D;
        base = (bf16_t*)(ws + WS_R + (size_t)g * (32 * MiB)) + (size_t)u.pm * 256 * ld + (size_t)t * 256; } };


struct EpiHeadMajor {
    static constexpr bool PERM = true;
    bf16_t* O;
    __device__ __forceinline__ void operator()(const f32x4 (&acc)[2][2][4][2], const pg8::Unit& u, int wr, int wc, int fr, int fq) const {
        const int row0 = u.pm * 256 + wr * 64 + fr, col = (wc & 1) * 32 + 8 * fq;
#pragma unroll
        for (int bj = 0; bj < 2; ++bj) { const int slot = u.pn * 4 + bj * 2 + (wc >> 1); bf16_t* hb = O + ((size_t)slot * M + row0) * 64 + col;
            const float qs = (slot < 8 || (slot >= 24 && slot < 32)) ? 0.125f * 1.4426950408889634f : 1.f;
#pragma unroll
            for (int ai = 0; ai < 2; ++ai)
#pragma unroll
                for (int m = 0; m < 4; ++m) { const f32x4 v0 = acc[ai][bj][m][0] * qs, v1 = acc[ai][bj][m][1] * qs;
                    u32x4 w; w.x = cvtpk(v0[0], v0[1]); w.y = cvtpk(v0[2], v0[3]); w.z = cvtpk(v1[0], v1[1]); w.w = cvtpk(v1[2], v1[3]);
                    pg8::store16_wt(hb + (size_t)(ai * 128 + m * 16) * 64, w); } }
    }
};

template <int ACT, class Prob, class Dst>
__device__ __forceinline__ void run_gemm(LAS unsigned char* lds, const Prob& P, const Dst& Dd, int Mr, int Nv, int G) {
    pg8::StaticOrder S; S.init(Mr, Nv, G, (int)blockIdx.x);
    pg8::EpiBf16<ACT, Dst> E{Dd, nullptr};
    for (int rep = 0; rep < REP_GEMM; ++rep) pg8::gemm_phase<pg8::EpiBf16<ACT, Dst>, Prob, true, true>(lds, P, S, E);
}
template <int ACT, class Prob, class Dst>
__device__ __forceinline__ void run_gemm_rs(LAS unsigned char* lds, const Prob& P, const Dst& Dd, const float* rs, int Mr, int Nv, int G) {
    pg8::StaticOrder S; S.init(Mr, Nv, G, (int)blockIdx.x);
    pg8::EpiBf16<ACT, Dst, true> E{Dd, rs};
    pg8::gemm_phase<pg8::EpiBf16<ACT, Dst, true>, Prob, true, true>(lds, P, S, E);
}

template <bool BASE_F32, bool OUT_F32>
__device__ __forceinline__ void phase_resnorm(const void* base, const bf16_t* TMP, const float* g1, const float* g2, void* hout, bf16_t* XN, float* rs_out, int gw, int NGW, int lane) {
    Row16 G1, G2; vec_load(G1, g1, lane); if (XN) vec_load(G2, g2, lane);
    for (int row = gw; row < M; row += NGW) {
        Row16 t, b; row_load_bf16(t, TMP + (size_t)row * D, lane);
        if (BASE_F32) row_load_f32(b, (const float*)base + (size_t)row * D, lane); else row_load_bf16(b, (const bf16_t*)base + (size_t)row * D, lane);
        row_rmsnorm_v(t, G1);
#pragma unroll
        for (int j = 0; j < 4; ++j) b.v[j] = b.v[j] + t.v[j];
        if (OUT_F32) row_store_f32(b, (float*)hout + (size_t)row * D, lane); else row_store_bf16(b, (bf16_t*)hout + (size_t)row * D, lane);
        if (XN) { row_rmsnorm_v(b, G2); row_store_bf16(b, XN + (size_t)row * D, lane); }
        if (rs_out) {
            float s = 0.f;
#pragma unroll
            for (int j = 0; j < 4; ++j) s += b.v[j][0] * b.v[j][0] + b.v[j][1] * b.v[j][1] + b.v[j][2] * b.v[j][2] + b.v[j][3] * b.v[j][3];
            const float rsv = rsqrtf(wave_sum(s) * (1.f / D) + NORM_EPS);
            if (lane == 0) rs_out[row] = rsv; }
    }
}
__device__ __forceinline__ void phase_lda(const bf16_t* LDO, bf16_t* LDA, int gw, int NGW, int lane) {
    const float A = lane < 16 ? 2.f : 1.f, C = lane < 16 ? -1.f : 0.f; const bool id = lane >= 16 && lane < 32;
    for (int row = gw; row < M; row += NGW) { const int tt = row & (SEQ - 1);
        const u32x4 p0 = *(const u32x4*)(LDO + (size_t)row * NLD + 8 * lane);
        const u32x4 p1 = *(const u32x4*)(LDO + (size_t)(tt > 0 ? row - 1 : row) * NLD + 512 + 8 * lane), p2 = *(const u32x4*)(LDO + (size_t)(tt < SEQ - 1 ? row + 1 : row) * NLD + 1024 + 8 * lane);
        const float mp = tt > 0 ? 1.f : 0.f, mn = tt < SEQ - 1 ? 1.f : 0.f;
        u32x4 o;
#pragma unroll
        for (int w = 0; w < 4; ++w) { const float x0 = bflo(p0[w]) + mp * bflo(p1[w]) + mn * bflo(p2[w]), x1 = bfhi(p0[w]) + mp * bfhi(p1[w]) + mn * bfhi(p2[w]);
            const float y0 = A * __builtin_amdgcn_rcpf(1.f + __builtin_amdgcn_exp2f(-1.4426950408889634f * A * x0)) + C, y1 = A * __builtin_amdgcn_rcpf(1.f + __builtin_amdgcn_exp2f(-1.4426950408889634f * A * x1)) + C;
            o[w] = cvtpk(id ? x0 : y0, id ? x1 : y1); }
        pg8::store16_wt(LDA + (size_t)row * 512 + 8 * lane, o); }
}
__device__ __forceinline__ void mix_out(const Row16& up, const Row16& u, const Row16& un, const LAS f32x4* a, const LAS f32x4* b, bf16_t* dst, int lane) {
    Row16 o;
#pragma unroll
    for (int j = 0; j < 4; ++j) { const f32x4 av = a[j * 64 + lane], bv = b[j * 64 + lane]; o.v[j] = u.v[j] + (up.v[j] - u.v[j]) * av + (un.v[j] - u.v[j]) * bv; }
    row_store_bf16(o, dst, lane);
}
__device__ __forceinline__ void phase_mix3(LAS unsigned char* lds, const bf16_t* h, const float* g, const float* mup, const float* mun, bf16_t* XN, bf16_t* MR, bf16_t* MK, bf16_t* MV, int gw, int NGW, int tid, int lane) {
    LAS f32x4* mv = (LAS f32x4*)lds;
    __syncthreads();
    for (int x = tid; x < 6 * 256; x += NTHREADS) { const int vec = x >> 8, q = x & 255, c = vec < 2 ? 0 : (vec < 4 ? 2 : 3);
        const f32x4 val = ((const f32x4*)(((vec & 1) ? mun : mup) + c * D))[q];
        mv[vec * 256 + (2 * (q >> 7) + (q & 1)) * 64 + ((q & 127) >> 1)] = val; }
    __syncthreads();
    Row16 Gn; vec_load(Gn, g, lane);
    for (int ch = gw; ch < M / 8; ch += NGW) {
        const int r0 = ch * 8, t0 = r0 & (SEQ - 1);
        const bool hasp = t0 > 0, hasn = t0 + 8 < SEQ;
        const int rlast = hasn ? r0 + 8 : r0 + 7;
        RowRaw r0w, rA, rB, rC;
        row_raw_load(r0w, h + (size_t)(hasp ? r0 - 1 : r0) * D, lane);
        row_raw_load(rA, h + (size_t)r0 * D, lane); row_raw_load(rB, h + (size_t)(r0 + 1) * D, lane); row_raw_load(rC, h + (size_t)(r0 + 2) * D, lane);
        Row16 up, u, un;
        row_from_raw(up, r0w); row_rmsnorm_v(up, Gn);
        { const float m = hasp ? 1.f : 0.f;
#pragma unroll
          for (int j = 0; j < 4; ++j) up.v[j] = up.v[j] * m; }
        row_from_raw(u, rA); row_rmsnorm_v(u, Gn);
        rA = rB; rB = rC;
#pragma unroll 1
        for (int k = 1; k <= 8; ++k) {
            const int row = r0 - 1 + k;
            { const int nx = row + 3; row_raw_load(rC, h + (size_t)(nx < rlast ? nx : rlast) * D, lane); }
            row_from_raw(un, rA); row_rmsnorm_v(un, Gn);
            { const float m = (k == 8 && !hasn) ? 0.f : 1.f;
#pragma unroll
              for (int j = 0; j < 4; ++j) un.v[j] = un.v[j] * m; }
            row_store_bf16(u, XN + (size_t)row * D, lane);
            mix_out(up, u, un, mv, mv + 256, MR + (size_t)row * D, lane);
            mix_out(up, u, un, mv + 512, mv + 768, MK + (size_t)row * D, lane);
            mix_out(up, u, un, mv + 1024, mv + 1280, MV + (size_t)row * D, lane);
            up = u; u = un; rA = rB; rB = rC;
        }
    }
}

constexpr int ATT_ROWS = 400, ATT_KS = 0, ATT_VS = ATT_ROWS * 128, ATT_TAB = 2 * ATT_ROWS * 128, ATT_TABN = 320;
constexpr float LOG2E = 1.4426950408889634f;
typedef short v4i16_t __attribute__((ext_vector_type(4)));
__device__ __forceinline__ v4i16_t lds_tr16(LAS const unsigned char* p) { return __builtin_amdgcn_ds_read_tr16_b64_v4i16((LAS v4i16_t*)p); }

__device__ __forceinline__ float fmax_q(float a, float b) { return __builtin_amdgcn_fmed3f(a, b, __builtin_inff()); }
__device__ __forceinline__ float rows_max(float x) {
    auto a = __builtin_amdgcn_permlane16_swap(__float_as_uint(x), __float_as_uint(x), false, false); x = fmax_q(__uint_as_float(a[0]), __uint_as_float(a[1]));
    auto b = __builtin_amdgcn_permlane32_swap(__float_as_uint(x), __float_as_uint(x), false, false); return fmax_q(__uint_as_float(b[0]), __uint_as_float(b[1])); }
__device__ __forceinline__ float rows_sum(float x) {
    auto a = __builtin_amdgcn_permlane16_swap(__float_as_uint(x), __float_as_uint(x), false, false); x = __uint_as_float(a[0]) + __uint_as_float(a[1]);
    auto b = __builtin_amdgcn_permlane32_swap(__float_as_uint(x), __float_as_uint(x), false, false); return __uint_as_float(b[0]) + __uint_as_float(b[1]); }
struct AttnIO { const bf16_t* QKV; const float* rel_table; const float* sink; bf16_t* O; bf16_t* OBR; float* LSE; };
struct AttnUnitD { int b, dil, res, l0, nq, L, R, colK, colV, head0, ngroups, nit, branch, isB; };
__device__ __forceinline__ AttnUnitD attn_decode(int u) {
    AttnUnitD A;
    if (u < 256) { A.isB = 1; A.b = u >> 5; const int kvg = (u >> 4) & 1, blk = u & 15; A.dil = 1; A.res = 0; A.l0 = blk * 128; A.nq = 128; A.L = SEQ; A.R = 128; A.colK = 32 + kvg; A.colV = 34 + kvg; A.head0 = kvg * 4; A.ngroups = 32; A.nit = 9; A.branch = 0; }
    else if (u < 1280) { A.isB = 0; const int a = u - 256, bh = a >> 4, k = a & 15; A.b = bh >> 3; A.head0 = bh & 7; A.nq = 256; A.R = 64; A.ngroups = 16; A.nit = 5;
        if (k < 8) { A.dil = 1; A.res = 0; A.l0 = k * 256; A.L = SEQ; A.branch = 0; } else { A.dil = 4; A.res = (k - 8) >> 1; A.l0 = ((k - 8) & 1) * 256; A.L = SEQ / 4; A.branch = 1; }
        A.colK = 8 + A.head0; A.colV = 16 + A.head0; }
    else { A.isB = 0; const int a = u - 1280, bh = a >> 4; A.b = bh >> 3; A.head0 = bh & 7; A.dil = 16; A.res = a & 15; A.l0 = 0; A.nq = 128; A.L = SEQ / 16; A.R = 64; A.ngroups = 8; A.nit = 5; A.branch = 2; A.colK = 8 + A.head0; A.colV = 16 + A.head0; }
    return A;
}
constexpr int ATT_NST = 7;
__device__ __forceinline__ void attn_issue(const AttnUnitD& A, const bf16_t* QKV, int tid, u32x4 (&kr)[ATT_NST], u32x4 (&vr)[ATT_NST]) {
    const int ndata = A.nq + 2 * A.R, rv0 = (A.R - A.l0) > 0 ? (A.R - A.l0) : 0, rv1 = (A.L + A.R - A.l0) < ndata ? (A.L + A.R - A.l0) : ndata;
    const bf16_t* kb = QKV + ((size_t)A.colK * M + (size_t)A.b * SEQ) * 64; const bf16_t* vb = QKV + ((size_t)A.colV * M + (size_t)A.b * SEQ) * 64;
#pragma unroll
    for (int i = 0; i < ATT_NST; ++i) { const int x = tid + NTHREADS * i, c = x & 7; int row = x >> 3; row = row < rv0 ? rv0 : (row >= rv1 ? rv1 - 1 : row);
        const size_t o = (size_t)(A.res + A.dil * (A.l0 - A.R + row)) * 64 + c * 8; kr[i] = *(const u32x4*)(kb + o); vr[i] = *(const u32x4*)(vb + o); }
}

__device__ __forceinline__ void phase_attn(LAS unsigned char* lds, const AttnIO& io, int vcu, int G) {
    int tid = threadIdx.x; asm volatile("" : "+v"(tid));
    const int lane = tid & 63, wid = __builtin_amdgcn_readfirstlane(tid >> 6), g4 = lane >> 4, qi = lane & 15;
    LAS unsigned char* Ks = lds + ATT_KS; LAS unsigned char* Vs = lds + ATT_VS; LAS float* tab = (LAS float*)(lds + ATT_TAB);
    constexpr int NU = 256 + 1024 + 1024;
    u32x4 kr[ATT_NST], vr[ATT_NST];
    if (vcu < NU) { const AttnUnitD A0 = attn_decode(vcu); attn_issue(A0, io.QKV, tid, kr, vr); }
    for (int u = vcu; u < NU; u += G) {
        const AttnUnitD A = attn_decode(u);
        const int b = A.b, dil = A.dil, res = A.res, l0 = A.l0, R = A.R, head0 = A.head0, ngroups = A.ngroups, nit = A.nit, branch = A.branch; const bool isB = A.isB != 0;
        const int ndata = A.nq + 2 * R, rv0 = (R - l0) > 0 ? (R - l0) : 0, rv1 = (A.L + R - l0) < ndata ? (A.L + R - l0) : ndata;
        auto qptr = [&](int gx) -> const bf16_t* { const int hq_ = isB ? (gx >> 3) : 0, gi_ = isB ? (gx & 7) : gx; const int posq_ = res + dil * (l0 + 16 * gi_ + qi);
            return io.QKV + ((size_t)((isB ? 24 : 0) + head0 + hq_) * M + (size_t)b * SEQ + posq_) * 64 + 8 * g4; };
        u32x4 qr0, qr1; { const bf16_t* qp0 = qptr(wid); qr0 = *(const u32x4*)qp0; qr1 = *(const u32x4*)(qp0 + 32); }
        for (int reps = 0; reps < REP_ATTS; ++reps) {
        __syncthreads();
#pragma unroll
        for (int i = 0; i < ATT_NST; ++i) { const int x = tid + NTHREADS * i, row = x >> 3, c = x & 7;
            if (x < ATT_ROWS * 8) { const int off = row * 128 + ((c ^ (row & 7)) << 4); const bool ok = row >= rv0 && row < rv1; const u32x4 z = (u32x4){0u, 0u, 0u, 0u};
                *(LAS u32x4*)(Ks + off) = ok ? kr[i] : z; *(LAS u32x4*)(Vs + off) = ok ? vr[i] : z; } }
        { const int ntab = isB ? 4 : 1;
          for (int x = tid; x < ntab * ATT_TABN; x += NTHREADS) { const int t = x / ATT_TABN, j = x % ATT_TABN, idx = j - 16;
              float v = -1e30f;
              if (idx >= 0 && idx <= 2 * R) v = io.rel_table[t5_bucket((idx - R) * dil) * 16 + (isB ? 8 + head0 + t : head0)] * LOG2E;
              tab[x] = v; } }
        }
        if (u + G < NU) { const AttnUnitD An = attn_decode(u + G); attn_issue(An, io.QKV, tid, kr, vr); }
        __syncthreads();
        for (int rep = 0; rep < REP_ATTC; ++rep)
        for (int gidx = wid; gidx < ngroups; gidx += NWAVES) {
            const int hq = isB ? (gidx >> 3) : 0, gi = isB ? (gidx & 7) : gidx, head = head0 + hq;
            const int ql = 16 * gi + qi, posq = res + dil * (l0 + ql);
            const LAS float* tb = tab + hq * ATT_TABN + 16;
            bf16x8 qf[2];
            { const u32x4 wq[2] = {qr0, qr1};
              { const int gn = gidx + NWAVES < ngroups ? gidx + NWAVES : gidx; const bf16_t* qpn = qptr(gn); qr0 = *(const u32x4*)qpn; qr1 = *(const u32x4*)(qpn + 32); }
              qf[0] = __builtin_bit_cast(bf16x8, wq[0]); qf[1] = __builtin_bit_cast(bf16x8, wq[1]); }
            f32x4 ot[4], lacc = (f32x4){0.f, 0.f, 0.f, 0.f};
#pragma unroll
            for (int dt = 0; dt < 4; ++dt) ot[dt] = (f32x4){0.f, 0.f, 0.f, 0.f};
            float m = -1e20f;
            const bf16x8 ones = __builtin_bit_cast(bf16x8, qi == 0 ? (u32x4){0x3F803F80u, 0x3F803F80u, 0x3F803F80u, 0x3F803F80u} : (u32x4){0u, 0u, 0u, 0u});
            bf16x8 kf[2][2];
            const LAS unsigned char* kp[2];
            { const int r0 = 16 * gi + qi;
#pragma unroll
              for (int ks = 0; ks < 2; ++ks) { const int c = g4 + 4 * ks; kp[ks] = Ks + r0 * 128 + ((c ^ (r0 & 7)) << 4); asm volatile("" : "+v"(kp[ks]));
                  kf[ks][0] = *(const LAS bf16x8*)(kp[ks]); kf[ks][1] = *(const LAS bf16x8*)(kp[ks] + 16 * 128); } }
            const LAS unsigned char* vp[4];
            { const int ra0 = 16 * gi + 4 * g4 + (qi >> 2);
#pragma unroll
              for (int dt = 0; dt < 4; ++dt) { const int ch = dt * 2 + ((qi & 3) >> 1); vp[dt] = Vs + ra0 * 128 + ((ch ^ (ra0 & 7)) << 4) + 8 * (qi & 1); asm volatile("" : "+v"(vp[dt])); } }
            const LAS float* tbq = tb + 4 * g4 - qi; asm volatile("" : "+v"(tbq));
            f32x4 c0, c1;
#pragma unroll
            for (int r = 0; r < 4; ++r) { c0[r] = tbq[r]; c1[r] = tbq[16 + r]; }
            for (int it = 0; it < nit; ++it) {
                const int rb = 16 * gi + 32 * it;
                v4i16_t vlo[4], vhi[4];
#pragma unroll
                for (int dt = 0; dt < 4; ++dt) { vlo[dt] = lds_tr16(vp[dt]); vhi[dt] = lds_tr16(vp[dt] + 16 * 128); vp[dt] += 4096; }
                f32x4 s0 = c0, s1 = c1;
#pragma unroll
                for (int ks = 0; ks < 2; ++ks) { s0 = __builtin_amdgcn_mfma_f32_16x16x32_bf16(kf[ks][0], qf[ks], s0, 0, 0, 0); s1 = __builtin_amdgcn_mfma_f32_16x16x32_bf16(kf[ks][1], qf[ks], s1, 0, 0, 0); }
                if (it + 1 < nit) {
#pragma unroll
                    for (int ks = 0; ks < 2; ++ks) { kp[ks] += 4096; kf[ks][0] = *(const LAS bf16x8*)(kp[ks]); kf[ks][1] = *(const LAS bf16x8*)(kp[ks] + 16 * 128); } }
                tbq += 32;
#pragma unroll
                for (int r = 0; r < 4; ++r) { c0[r] = tbq[r]; c1[r] = tbq[16 + r]; }
                float v[8];
                if (rb < rv0 || rb + 32 > rv1) {
#pragma unroll
                    for (int r = 0; r < 4; ++r) { const int row0 = rb + 4 * g4 + r, row1 = row0 + 16;
                        const bool ok0 = (unsigned)(row0 - rv0) < (unsigned)(rv1 - rv0), ok1 = (unsigned)(row1 - rv0) < (unsigned)(rv1 - rv0);
                        v[r] = ok0 ? s0[r] : -1e30f; v[4 + r] = ok1 ? s1[r] : -1e30f; }
                } else {
#pragma unroll
                    for (int r = 0; r < 4; ++r) { v[r] = s0[r]; v[4 + r] = s1[r]; }
                }
                float d[8];
#pragma unroll
                for (int i = 0; i < 8; ++i) d[i] = v[i] - m;
                const float dm = fmaxf(fmaxf(fmaxf(d[0], d[1]), fmaxf(d[2], d[3])), fmaxf(fmaxf(d[4], d[5]), fmaxf(d[6], d[7])));
                if (__builtin_amdgcn_ballot_w64(dm > 8.f) != 0ull) {
                    float tmax = fmaxf(fmaxf(fmaxf(v[0], v[1]), fmaxf(v[2], v[3])), fmaxf(fmaxf(v[4], v[5]), fmaxf(v[6], v[7])));
                    tmax = rows_max(tmax);
                    const float mn = fmaxf(m, tmax), alpha = __builtin_amdgcn_exp2f(m - mn); m = mn;
                    lacc[0] = lacc[0] * alpha;
#pragma unroll
                    for (int dt = 0; dt < 4; ++dt) ot[dt] = ot[dt] * alpha;
#pragma unroll
                    for (int i = 0; i < 8; ++i) d[i] = v[i] - mn;
                }
#pragma unroll
                for (int i = 0; i < 8; ++i) v[i] = __builtin_amdgcn_exp2f(d[i]);
                u32x4 pw; pw.x = cvtpk(v[0], v[1]); pw.y = cvtpk(v[2], v[3]); pw.z = cvtpk(v[4], v[5]); pw.w = cvtpk(v[6], v[7]);
                const bf16x8 pf = __builtin_bit_cast(bf16x8, pw);
                lacc = __builtin_amdgcn_mfma_f32_16x16x32_bf16(ones, pf, lacc, 0, 0, 0);
#pragma unroll
                for (int dt = 0; dt < 4; ++dt) { const bf16x8 vf = (bf16x8){vlo[dt][0], vlo[dt][1], vlo[dt][2], vlo[dt][3], vhi[dt][0], vhi[dt][1], vhi[dt][2], vhi[dt][3]};
                    ot[dt] = __builtin_amdgcn_mfma_f32_16x16x32_bf16(vf, pf, ot[dt], 0, 0, 0); }
            }
            float lsum = lacc[0];
            lsum = rows_sum(lsum);
            const size_t tok = (size_t)b * SEQ + posq;
            float scale;
            if (isB) { const float s2 = io.sink[head] * LOG2E, mf = fmaxf(m, s2), e = __builtin_amdgcn_exp2f(m - mf); scale = e / (lsum * e + __builtin_amdgcn_exp2f(s2 - mf)); }
            else { scale = 1.f / lsum; if (g4 == 0) io.LSE[((size_t)branch * M + tok) * 8 + head] = m + __builtin_amdgcn_logf(lsum); }
            bf16_t* op = isB ? io.O + tok * D + 512 + head * 64 : io.OBR + ((size_t)branch * M + tok) * 512 + head * 64;
#pragma unroll
            for (int dt = 0; dt < 4; ++dt) { const f32x4 o = ot[dt] * scale; u32x2 w; w.x = cvtpk(o[0], o[1]); w.y = cvtpk(o[2], o[3]); *(u32x2*)(op + dt * 16 + 4 * g4) = w; }
        }
    }
}
__device__ __forceinline__ void phase_attn_merge(const AttnIO& io, int gtid, int NGT) {
    for (int x = gtid; x < M * 64; x += NGT) { const int tok = x >> 6, head = (x >> 3) & 7, c8 = x & 7;
        const float l0 = io.LSE[((size_t)0 * M + tok) * 8 + head], l1 = io.LSE[((size_t)1 * M + tok) * 8 + head], l2 = io.LSE[((size_t)2 * M + tok) * 8 + head];
        const float mx = fmaxf(l0, fmaxf(l1, l2)); float w0 = __builtin_amdgcn_exp2f(l0 - mx), w1 = __builtin_amdgcn_exp2f(l1 - mx), w2 = __builtin_amdgcn_exp2f(l2 - mx);
        const float inv = 1.f / (w0 + w1 + w2); w0 *= inv; w1 *= inv; w2 *= inv;
        const size_t o = (size_t)tok * 512 + head * 64 + c8 * 8;
        const u32x4 a = *(const u32x4*)(io.OBR + o), bq = *(const u32x4*)(io.OBR + (size_t)M * 512 + o), c = *(const u32x4*)(io.OBR + (size_t)2 * M * 512 + o);
        u32x4 r;
        r.x = pk2(w0 * bflo(a.x) + w1 * bflo(bq.x) + w2 * bflo(c.x), w0 * bfhi(a.x) + w1 * bfhi(bq.x) + w2 * bfhi(c.x));
        r.y = pk2(w0 * bflo(a.y) + w1 * bflo(bq.y) + w2 * bflo(c.y), w0 * bfhi(a.y) + w1 * bfhi(bq.y) + w2 * bfhi(c.y));
        r.z = pk2(w0 * bflo(a.z) + w1 * bflo(bq.z) + w2 * bflo(c.z), w0 * bfhi(a.z) + w1 * bfhi(bq.z) + w2 * bfhi(c.z));
        r.w = pk2(w0 * bflo(a.w) + w1 * bflo(bq.w) + w2 * bflo(c.w), w0 * bfhi(a.w) + w1 * bfhi(bq.w) + w2 * bfhi(c.w));
        pg8::store16_wt(io.O + (size_t)tok * D + head * 64 + c8 * 8, r); }
}

constexpr int NCH = SEQ / 16;
constexpr int SC_LROW = 68, SC_LDROW = 528, SC_LSLOT = 4 * 16 * SC_LROW * 4 + 16 * SC_LDROW;
constexpr int CT_KHT = 0, CT_RHT = 2048, CT_BTT = 4096, CT_KTT = 6144, CT_VT = 8192, CT_WEND = 10240, CT_RKT = CT_WEND + 256, CT_SLOT = CT_RKT + 2048;
constexpr int GT_AKK = 0, GT_BB = 512, GT_BK = 1024, GT_TT = 1536, GT_SLOT = 2048;
constexpr int SC_LBUF = 0, SC_CT = SC_LBUF + 2 * SC_LSLOT, SC_GG = SC_CT + 3 * CT_SLOT, SC_RKR = SC_GG + 4 * 4096, SC_GT = SC_RKR + 4 * 256, SC_NB = SC_GT + 2 * GT_SLOT, SC_OUT = SC_NB + 1024, SC_END = SC_OUT + 2 * 4096;
static_assert(SC_END <= LDSCTL_OFF, "scan LDS map");
template <int CTRL> __device__ __forceinline__ float dpp_f(float x) { return __int_as_float(__builtin_amdgcn_update_dpp(0, __float_as_int(x), CTRL, 0xf, 0xf, true)); }
__device__ __forceinline__ float sum8(float x) { x += dpp_f<0xB1>(x); x += dpp_f<0x4E>(x); x += dpp_f<0x141>(x); return x; }
__device__ __forceinline__ float sum16(float x) { x += dpp_f<0xB1>(x); x += dpp_f<0x4E>(x); x += dpp_f<0x141>(x); x += dpp_f<0x140>(x); return x; }
__device__ __forceinline__ float fast_sigmoid(float z) { return __builtin_amdgcn_rcpf(1.f + __builtin_amdgcn_exp2f(-LOG2E * z)); }
__device__ __forceinline__ bf16x8 mk8(unsigned a, unsigned b, unsigned c, unsigned d) { return __builtin_bit_cast(bf16x8, (u32x4){a, b, c, d}); }

struct ScanPtrs { const bf16_t *R, *Kk, *V, *LDA; bf16_t* Y; const float *w2, *a2, *g2, *w0, *a0, *k_k, *k_a, *r_k, *gn_w, *gn_b; };
__device__ __forceinline__ void phase_scan(LAS unsigned char* lds, const ScanPtrs& P, int G) {
    int tid = threadIdx.x; asm volatile("" : "+v"(tid));
    const int lane = tid & 63, wid = __builtin_amdgcn_readfirstlane(tid >> 6), g4 = lane >> 4, c16 = lane & 15;
    for (int unit = blockIdx.x; unit < 256; unit += G) {
        const int b = unit >> 5, h = (unit >> 1) & 15, d = unit & 1, hc = h * 64;
        unsigned long long wait_acc = 0ull;
        __syncthreads();
        if (wid < 4) {
            f32x4 ST[4];
#pragma unroll
            for (int mt = 0; mt < 4; ++mt) ST[mt] = (f32x4){0.f, 0.f, 0.f, 0.f};
            const int pch = hc + 8 * (lane & 7);
            const f32x4 gw0 = *(const f32x4*)(P.gn_w + pch), gw1 = *(const f32x4*)(P.gn_w + pch + 4), gb0 = *(const f32x4*)(P.gn_b + pch), gb1 = *(const f32x4*)(P.gn_b + pch + 4);
            u32x4 pvA = {0u, 0u, 0u, 0u}, pvB = pvA;
            auto issueV = [&](int ch_, u32x4& dst) { const int s = 8 * (wid - 1) + (lane >> 3), t = d ? (SEQ - 1 - (ch_ * 16 + s)) : (ch_ * 16 + s); dst = *(const u32x4*)(P.V + ((size_t)b * SEQ + t) * D + pch); };
            if (wid == 1 || wid == 2) { issueV(0, pvA); issueV(1, pvB); }
            auto sw_interval = [&](int i, u32x4& pvset) {
                const int c = i - 3;
                int ln = lane; asm volatile("" : "+v"(ln)); const int g4 = ln >> 4, c16 = ln & 15;
                if (c >= 0 && c < NCH) {
                    const LAS unsigned char* Ct = lds + SC_CT + (c % 3) * CT_SLOT; const LAS unsigned char* Gt = lds + SC_GT + (c & 1) * GT_SLOT;
                    v4i16_t kha[2][2], rha[2][2];
#pragma unroll
                    for (int p = 0; p < 2; ++p)
#pragma unroll
                        for (int hh = 0; hh < 2; ++hh) { const int off = (32 * p + 16 * hh + 4 * g4 + (c16 >> 2)) * 32 + 8 * (c16 & 3); kha[p][hh] = lds_tr16(Ct + CT_KHT + off); rha[p][hh] = lds_tr16(Ct + CT_RHT + off); }
                    const u32x2 gakk = *(const LAS u32x2*)(Gt + GT_AKK + c16 * 32 + 8 * g4), gtt = *(const LAS u32x2*)(Gt + GT_TT + c16 * 32 + 8 * g4);
                    const u32x2 gbb = *(const LAS u32x2*)(Gt + GT_BB + c16 * 32 + 8 * g4), gbk = *(const LAS u32x2*)(Gt + GT_BK + c16 * 32 + 8 * g4);
                    const u32x2 vt = *(const LAS u32x2*)(Ct + CT_VT + (16 * wid + c16) * 32 + 8 * g4);
                    u32x2 btt[4], ktt[4]; f32x4 we[4];
#pragma unroll
                    for (int mt = 0; mt < 4; ++mt) { btt[mt] = *(const LAS u32x2*)(Ct + CT_BTT + (16 * mt + c16) * 32 + 8 * g4); ktt[mt] = *(const LAS u32x2*)(Ct + CT_KTT + (16 * mt + c16) * 32 + 8 * g4);
                        we[mt] = *(const LAS f32x4*)(Ct + CT_WEND + (16 * mt + 4 * g4) * 4); }
                    f32x4 pt = {0.f, 0.f, 0.f, 0.f}, prt = pt;
#pragma unroll
                    for (int p = 0; p < 2; ++p) { const bf16x8 sb = mk8(cvtpk(ST[2 * p][0], ST[2 * p][1]), cvtpk(ST[2 * p][2], ST[2 * p][3]), cvtpk(ST[2 * p + 1][0], ST[2 * p + 1][1]), cvtpk(ST[2 * p + 1][2], ST[2 * p + 1][3]));
                        pt = __builtin_amdgcn_mfma_f32_16x16x32_bf16((bf16x8){kha[p][0][0], kha[p][0][1], kha[p][0][2], kha[p][0][3], kha[p][1][0], kha[p][1][1], kha[p][1][2], kha[p][1][3]}, sb, pt, 0, 0, 0);
                        prt = __builtin_amdgcn_mfma_f32_16x16x32_bf16((bf16x8){rha[p][0][0], rha[p][0][1], rha[p][0][2], rha[p][0][3], rha[p][1][0], rha[p][1][1], rha[p][1][2], rha[p][1][3]}, sb, prt, 0, 0, 0); }
                    const f32x4 qt = __builtin_amdgcn_mfma_f32_16x16x32_bf16(mk8(gakk.x, gakk.y, 0u, 0u), mk8(vt.x, vt.y, 0u, 0u), pt, 0, 0, 0);
                    const f32x4 sat = __builtin_amdgcn_mfma_f32_16x16x32_bf16(mk8(gtt.x, gtt.y, 0u, 0u), mk8(cvtpk(qt[0], qt[1]), cvtpk(qt[2], qt[3]), 0u, 0u), (f32x4){0.f, 0.f, 0.f, 0.f}, 0, 0, 0);
                    const bf16x8 sv = mk8(cvtpk(sat[0], sat[1]), cvtpk(sat[2], sat[3]), vt.x, vt.y);
                    const f32x4 outt = __builtin_amdgcn_mfma_f32_16x16x32_bf16(mk8(gbb.x, gbb.y, gbk.x, gbk.y), sv, prt, 0, 0, 0);
#pragma unroll
                    for (int mt = 0; mt < 4; ++mt) { ST[mt] = __builtin_amdgcn_mfma_f32_16x16x32_bf16(mk8(btt[mt].x, btt[mt].y, ktt[mt].x, ktt[mt].y), sv, ST[mt], 0, 0, 0); ST[mt] = ST[mt] * we[mt]; }
                    LAS float* ob = (LAS float*)(lds + SC_OUT + (c & 1) * 4096) + 16 * wid + c16;
#pragma unroll
                    for (int r = 0; r < 4; ++r) ob[(4 * g4 + r) * 64] = outt[r];
                }
                for (int rep_ = 0; rep_ < REP_ST; ++rep_)
                if (i >= 2 && i - 2 < NCH) {
                    const int jg = i - 2, hw = wid;
                    const LAS unsigned char* Ct = lds + SC_CT + (jg % 3) * CT_SLOT; LAS unsigned char* Gt = lds + SC_GT + (jg & 1) * GT_SLOT;
                    const int aoff = (hw & 1) ? CT_KTT : CT_BTT, boff = (hw & 2) ? CT_RHT : CT_KHT;
                    f32x4 gm = {0.f, 0.f, 0.f, 0.f}, gmT = gm;
#pragma unroll
                    for (int ks = 0; ks < 2; ++ks) { const int o1 = (8 * g4 + 32 * ks + (c16 >> 2)) * 32 + 8 * (c16 & 3), o2 = o1 + 4 * 32;
                        const v4i16_t a0 = lds_tr16(Ct + aoff + o1), a1 = lds_tr16(Ct + aoff + o2), b0 = lds_tr16(Ct + boff + o1), b1 = lds_tr16(Ct + boff + o2);
                        const bf16x8 af = {a0[0], a0[1], a0[2], a0[3], a1[0], a1[1], a1[2], a1[3]}, bfr = {b0[0], b0[1], b0[2], b0[3], b1[0], b1[1], b1[2], b1[3]};
                        gm = __builtin_amdgcn_mfma_f32_16x16x32_bf16(af, bfr, gm, 0, 0, 0);
                        if (hw == 0) gmT = __builtin_amdgcn_mfma_f32_16x16x32_bf16(bfr, af, gmT, 0, 0, 0); }
                    if (hw == 3) {
                        const bf16x8 onesB = __builtin_bit_cast(bf16x8, c16 == 0 ? (u32x4){0x3F803F80u, 0x3F803F80u, 0x3F803F80u, 0x3F803F80u} : (u32x4){0u, 0u, 0u, 0u});
                        f32x4 rk = {0.f, 0.f, 0.f, 0.f};
#pragma unroll
                        for (int ks = 0; ks < 2; ++ks) { const int o1 = (8 * g4 + 32 * ks + (c16 >> 2)) * 32 + 8 * (c16 & 3), o2 = o1 + 4 * 32;
                            const v4i16_t r0 = lds_tr16(Ct + CT_RKT + o1), r1 = lds_tr16(Ct + CT_RKT + o2);
                            rk = __builtin_amdgcn_mfma_f32_16x16x32_bf16((bf16x8){r0[0], r0[1], r0[2], r0[3], r1[0], r1[1], r1[2], r1[3]}, onesB, rk, 0, 0, 0); }
                        if (c16 == 0) ((LAS f32x4*)(lds + SC_RKR + (jg & 3) * 256))[g4] = rk; }
#pragma unroll
                    for (int r = 0; r < 4; ++r) { const int s = 4 * g4 + r; const bool keep = (hw & 2) ? (s <= c16) : (s < c16); gm[r] = keep ? gm[r] : 0.f; gmT[r] = (c16 < s) ? gmT[r] : 0.f; }
                    if (hw != 0) { *(LAS u32x2*)(Gt + (hw == 1 ? GT_AKK : (hw == 2 ? GT_BB : GT_BK)) + c16 * 32 + 8 * g4) = (u32x2){cvtpk(gm[0], gm[1]), cvtpk(gm[2], gm[3])}; }
                    else {
#define SC_OPA(x) mk8(cvtpk((x)[0], (x)[1]), cvtpk((x)[2], (x)[3]), 0u, 0u)
                        const f32x4 z4 = {0.f, 0.f, 0.f, 0.f};
                        f32x4 Rm, RTm;
#pragma unroll
                        for (int r = 0; r < 4; ++r) { const float idn = (4 * g4 + r == c16) ? 1.f : 0.f; Rm[r] = idn - gm[r]; RTm[r] = idn - gmT[r]; }
                        const f32x4 N2 = __builtin_amdgcn_mfma_f32_16x16x32_bf16(SC_OPA(gmT), SC_OPA(gm), z4, 0, 0, 0), N2T = __builtin_amdgcn_mfma_f32_16x16x32_bf16(SC_OPA(gm), SC_OPA(gmT), z4, 0, 0, 0);
                        f32x4 R1 = __builtin_amdgcn_mfma_f32_16x16x32_bf16(SC_OPA(RTm), SC_OPA(N2), Rm, 0, 0, 0), R1T = __builtin_amdgcn_mfma_f32_16x16x32_bf16(SC_OPA(N2), SC_OPA(RTm), RTm, 0, 0, 0);
                        const f32x4 N4 = __builtin_amdgcn_mfma_f32_16x16x32_bf16(SC_OPA(N2T), SC_OPA(N2), z4, 0, 0, 0), N4T = __builtin_amdgcn_mfma_f32_16x16x32_bf16(SC_OPA(N2), SC_OPA(N2T), z4, 0, 0, 0);
                        f32x4 R2 = __builtin_amdgcn_mfma_f32_16x16x32_bf16(SC_OPA(R1T), SC_OPA(N4), R1, 0, 0, 0), R2T = __builtin_amdgcn_mfma_f32_16x16x32_bf16(SC_OPA(N4), SC_OPA(R1T), R1T, 0, 0, 0);
                        const f32x4 N8 = __builtin_amdgcn_mfma_f32_16x16x32_bf16(SC_OPA(N4T), SC_OPA(N4), z4, 0, 0, 0);
                        const f32x4 Tm = __builtin_amdgcn_mfma_f32_16x16x32_bf16(SC_OPA(R2T), SC_OPA(N8), R2, 0, 0, 0);
#undef SC_OPA
                        *(LAS u32x2*)(Gt + GT_TT + c16 * 32 + 8 * g4) = (u32x2){cvtpk(-Tm[0], -Tm[1]), cvtpk(-Tm[2], -Tm[3])};
                    }
                }
                if ((wid == 1 || wid == 2) && i >= 4 && i - 4 < NCH) {
                    const int jp = i - 4, tl = ln >> 3, c8 = ln & 7;
                    const int s = 8 * (wid - 1) + tl, t = d ? (SEQ - 1 - (jp * 16 + s)) : (jp * 16 + s);
                    const LAS float* ob = (const LAS float*)(lds + SC_OUT + (jp & 1) * 4096) + s * 64 + 8 * c8; const LAS float* gp = (const LAS float*)(lds + SC_GG + (jp & 3) * 4096) + s * 64 + 8 * c8;
                    const f32x4 o0 = *(const LAS f32x4*)(ob), o1 = *(const LAS f32x4*)(ob + 4), g0 = *(const LAS f32x4*)(gp), g1 = *(const LAS f32x4*)(gp + 4);
                    const float rkr = ((const LAS float*)(lds + SC_RKR + (jp & 3) * 256))[s];
                    const u32x4 pv = pvset; issueV(jp + 2 < NCH ? jp + 2 : NCH - 1, pvset);
                    const f32x4 v0 = {bflo(pv.x), bfhi(pv.x), bflo(pv.y), bfhi(pv.y)}, v1 = {bflo(pv.z), bfhi(pv.z), bflo(pv.w), bfhi(pv.w)};
                    float mu = ((o0[0] + o0[1]) + (o0[2] + o0[3])) + ((o1[0] + o1[1]) + (o1[2] + o1[3])); mu = sum8(mu) * (1.f / 64.f);
                    const f32x4 d0 = o0 - mu, d1 = o1 - mu; float var = ((d0[0] * d0[0] + d0[1] * d0[1]) + (d0[2] * d0[2] + d0[3] * d0[3])) + ((d1[0] * d1[0] + d1[1] * d1[1]) + (d1[2] * d1[2] + d1[3] * d1[3])); var = sum8(var) * (1.f / 64.f);
                    const float rs = rsqrtf(var + GN_EPS);
                    const f32x4 y0 = (d0 * rs * gw0 + gb0 + rkr * v0) * g0, y1 = (d1 * rs * gw1 + gb1 + rkr * v1) * g1;
                    pg8::store16_wt(P.Y + ((size_t)b * SEQ + t) * (2 * D) + d * D + hc + 8 * c8, (u32x4){cvtpk(y0[0], y0[1]), cvtpk(y0[2], y0[3]), cvtpk(y1[0], y1[1]), cvtpk(y1[2], y1[3])});
                }
                for (int rep_ = 0; rep_ < REP_SYNC; ++rep_) __syncthreads();
                if (WAITPROBE >= 0) { const unsigned long long t0_ = __builtin_amdgcn_s_memrealtime(); __syncthreads(); wait_acc += __builtin_amdgcn_s_memrealtime() - t0_; } else
                __syncthreads();
            };
            static_assert((NCH + 4) % 2 == 0, "interval loop is unrolled by two");
            __builtin_amdgcn_s_setprio(2);
            for (int i = 0; i < NCH + 4; i += 2) { sw_interval(i, pvA); sw_interval(i + 1, pvB); }
            __builtin_amdgcn_s_setprio(0);
        } else {
            const int hw = wid - 4;
            const int chC = hc + 16 * hw + c16, chT = hc + 4 * c16;
            bf16x8 bw[2], ba[2], bg[4];
#pragma unroll
            for (int ks = 0; ks < 2; ++ks) { u32x4 w, a;
#pragma unroll
                for (int jj = 0; jj < 4; ++jj) { const int k = 32 * ks + 8 * g4 + 2 * jj;
                    w[jj] = pk2(-LOG2E * P.w2[(size_t)(d * 64 + k) * D + chC], -LOG2E * P.w2[(size_t)(d * 64 + k + 1) * D + chC]); a[jj] = pk2(-LOG2E * P.a2[(size_t)(d * 64 + k) * D + chC], -LOG2E * P.a2[(size_t)(d * 64 + k + 1) * D + chC]); }
                bw[ks] = __builtin_bit_cast(bf16x8, w); ba[ks] = __builtin_bit_cast(bf16x8, a); }
#pragma unroll
            for (int ks = 0; ks < 4; ++ks) { u32x4 g;
#pragma unroll
                for (int jj = 0; jj < 4; ++jj) { const int k = 32 * ks + 8 * g4 + 2 * jj; g[jj] = pk2(P.g2[(size_t)(d * 128 + k) * D + chC], P.g2[(size_t)(d * 128 + k + 1) * D + chC]); }
                bg[ks] = __builtin_bit_cast(bf16x8, g); }
            const float w0c = -LOG2E * P.w0[d * D + chC], a0c = -LOG2E * P.a0[d * D + chC], kaC = P.k_a[chC], rkC = P.r_k[chC];
            const f32x4 kkT = *(const f32x4*)(P.k_k + chT);
            const int n0 = 16 * c16, lcol = n0 < 64 ? (d * 64 + n0) : (n0 < 128 ? (128 + d * 64 + (n0 - 64)) : (256 + d * 128 + (n0 - 128)));
            struct LSet { u32x2 r, k, v; u32x4 l0, l1; };
            LSet setA, setB;
            auto issueL = [&](int ch_, LSet& S) { const int s = 4 * hw + g4, t = d ? (SEQ - 1 - (ch_ * 16 + s)) : (ch_ * 16 + s); const size_t row = (size_t)b * SEQ + t;
                S.r = *(const u32x2*)(P.R + row * D + chT); S.k = *(const u32x2*)(P.Kk + row * D + chT); S.v = *(const u32x2*)(P.V + row * D + chT);
                S.l0 = *(const u32x4*)(P.LDA + row * 512 + lcol); S.l1 = *(const u32x4*)(P.LDA + row * 512 + lcol + 8); };
            issueL(0, setA); issueL(1, setB);
            auto hw_interval = [&](int i, LSet& LS) {
                const bool doL = i < NCH, doC = (i >= 1 && i - 1 < NCH);
                int ln = lane; asm volatile("" : "+v"(ln)); const int g4 = ln >> 4, c16 = ln & 15;
                const unsigned long long tb_ = (SECPROBE >= 0) ? __builtin_amdgcn_s_memrealtime() : 0ull;
                for (int rep_ = 0; rep_ < REP_HC; ++rep_)
                if (doC) {
                    const int jc = i - 1;
                    const LAS unsigned char* Ls = lds + SC_LBUF + (jc & 1) * SC_LSLOT;
                    const LAS unsigned char* ldp = Ls + 4 * 16 * SC_LROW * 4 + c16 * SC_LDROW + 16 * g4;
                    f32x4 zw = {w0c, w0c, w0c, w0c}, za = {a0c, a0c, a0c, a0c}, gg = {0.f, 0.f, 0.f, 0.f};
#pragma unroll
                    for (int ks = 0; ks < 2; ++ks) { zw = __builtin_amdgcn_mfma_f32_16x16x32_bf16(*(const LAS bf16x8*)(ldp + 64 * ks), bw[ks], zw, 0, 0, 0);
                                                     za = __builtin_amdgcn_mfma_f32_16x16x32_bf16(*(const LAS bf16x8*)(ldp + 128 + 64 * ks), ba[ks], za, 0, 0, 0); }
#pragma unroll
                    for (int ks = 0; ks < 4; ++ks) gg = __builtin_amdgcn_mfma_f32_16x16x32_bf16(*(const LAS bf16x8*)(ldp + 256 + 64 * ks), bg[ks], gg, 0, 0, 0);
                    float lw[4], cw[4]; float tot = 0.f;
#pragma unroll
                    for (int r = 0; r < 4; ++r) { lw[r] = (-0.6065306597f * LOG2E) * __builtin_amdgcn_rcpf(1.f + __builtin_amdgcn_exp2f(zw[r])); tot += lw[r]; cw[r] = tot; }
                    float pre;
                    { auto e = __builtin_amdgcn_permlane16_swap(__float_as_uint(tot), __float_as_uint(tot), false, false); const float e0 = __uint_as_float(e[0]), s01 = e0 + __uint_as_float(e[1]);
                      auto f = __builtin_amdgcn_permlane32_swap(__float_as_uint(s01), __float_as_uint(s01), false, false);
                      pre = ((g4 & 1) ? e0 : 0.f) + ((g4 & 2) ? __uint_as_float(f[0]) : 0.f); }
                    const LAS float* Lf = (const LAS float*)Ls + 16 * hw + c16;
                    LAS unsigned char* Ct = lds + SC_CT + (jc % 3) * CT_SLOT;
                    LAS float* ggw = (LAS float*)(lds + SC_GG + (jc & 3) * 4096) + 16 * hw + c16;
                    float kh[4], rh[4], bt[4], kt[4], vv[4], rkp[4];
                    float Wprev = __builtin_amdgcn_exp2f(pre);
#pragma unroll
                    for (int r = 0; r < 4; ++r) { const int tok = 4 * g4 + r; const float c = pre + cw[r];
                        const float Wc = __builtin_amdgcn_exp2f(c), Wp = Wprev, iW = __builtin_amdgcn_exp2f(-c); Wprev = Wc;
                        const float a = __builtin_amdgcn_rcpf(1.f + __builtin_amdgcn_exp2f(za[r]));
                        const float rr = Lf[tok * SC_LROW], kk_ = Lf[16 * SC_LROW + tok * SC_LROW], nk = Lf[32 * SC_LROW + tok * SC_LROW]; vv[r] = Lf[48 * SC_LROW + tok * SC_LROW];
                        const float kd = kk_ * (1.f + (a - 1.f) * kaC);
                        kh[r] = nk * Wp; rh[r] = rr * Wc; bt[r] = nk * a * iW; kt[r] = kd * iW; rkp[r] = rr * kd * rkC;
                        ggw[tok * 64] = gg[r];
                        if (tok == 15) ((LAS float*)(Ct + CT_WEND))[16 * hw + c16] = Wc; }
                    { LAS unsigned char* tq = Ct + (16 * hw + c16) * 32 + 8 * g4;
                      *(LAS u32x2*)(tq + CT_KHT) = (u32x2){cvtpk(kh[0], kh[1]), cvtpk(kh[2], kh[3])}; *(LAS u32x2*)(tq + CT_RHT) = (u32x2){cvtpk(rh[0], rh[1]), cvtpk(rh[2], rh[3])};
                      *(LAS u32x2*)(tq + CT_BTT) = (u32x2){cvtpk(bt[0], bt[1]), cvtpk(bt[2], bt[3])}; *(LAS u32x2*)(tq + CT_KTT) = (u32x2){cvtpk(kt[0], kt[1]), cvtpk(kt[2], kt[3])};
                      *(LAS u32x2*)(tq + CT_VT) = (u32x2){cvtpk(vv[0], vv[1]), cvtpk(vv[2], vv[3])};
                      *(LAS u32x2*)(tq + CT_RKT) = (u32x2){cvtpk(rkp[0], rkp[1]), cvtpk(rkp[2], rkp[3])}; }
                }
                const unsigned long long tc_ = (SECPROBE >= 0) ? __builtin_amdgcn_s_memrealtime() : 0ull;
                for (int rep_ = 0; rep_ < REP_HL; ++rep_)
                if (doL) {
                    LAS unsigned char* Ls = lds + SC_LBUF + (i & 1) * SC_LSLOT; LAS float* Lf = (LAS float*)Ls;
                    const int s = 4 * hw + g4;
                    const u32x2 lr = LS.r, lk = LS.k, lv = LS.v; const u32x4 l00 = LS.l0, l01 = LS.l1;
                    issueL(i + 2 < NCH ? i + 2 : NCH - 1, LS);
                    const f32x4 rr = {bflo(lr.x), bfhi(lr.x), bflo(lr.y), bfhi(lr.y)}, kk_ = {bflo(lk.x), bfhi(lk.x), bflo(lk.y), bfhi(lk.y)}, vv = {bflo(lv.x), bfhi(lv.x), bflo(lv.y), bfhi(lv.y)};
                    f32x4 nk = kk_ * kkT; float ss = nk[0] * nk[0] + nk[1] * nk[1] + nk[2] * nk[2] + nk[3] * nk[3];
                    ss = sum16(ss);
                    nk = nk * (1.f / fmaxf(sqrtf(ss), 1e-12f));
                    *(LAS f32x4*)(Lf + s * SC_LROW + 4 * c16) = rr; *(LAS f32x4*)(Lf + 16 * SC_LROW + s * SC_LROW + 4 * c16) = kk_;
                    *(LAS f32x4*)(Lf + 32 * SC_LROW + s * SC_LROW + 4 * c16) = nk; *(LAS f32x4*)(Lf + 48 * SC_LROW + s * SC_LROW + 4 * c16) = vv;
                    *(LAS u32x4*)(Ls + 4 * 16 * SC_LROW * 4 + s * SC_LDROW + 32 * c16) = l00; *(LAS u32x4*)(Ls + 4 * 16 * SC_LROW * 4 + s * SC_LDROW + 32 * c16 + 16) = l01;
                }
                for (int rep_ = 0; rep_ < REP_SYNC; ++rep_) __syncthreads();
                if (SECPROBE >= 0) { asm volatile("s_waitcnt vmcnt(0) lgkmcnt(0)" ::: "memory"); const unsigned long long te_ = __builtin_amdgcn_s_memrealtime(); wait_acc += (SECPROBE == 0) ? (tc_ - tb_) : ((SECPROBE == 1) ? (te_ - tc_) : (te_ - tb_)); __syncthreads(); } else
                if (WAITPROBE >= 0) { const unsigned long long t0_ = __builtin_amdgcn_s_memrealtime(); __syncthreads(); wait_acc += __builtin_amdgcn_s_memrealtime() - t0_; } else
                __syncthreads();
            };
            for (int i = 0; i < NCH + 4; i += 2) { hw_interval(i, setA); hw_interval(i + 1, setB); }
        }
        if ((WAITPROBE >= 0 || SECPROBE >= 0) && blockIdx.x == 0 && wid == (SECPROBE >= 0 ? 4 : WAITPROBE)) { const unsigned long long tgt_ = __builtin_amdgcn_s_memrealtime() + 4ull * wait_acc; while (__builtin_amdgcn_s_memrealtime() < tgt_) __builtin_amdgcn_s_sleep(8); }
    }
}

__global__ void __launch_bounds__(NTHREADS, 2) fwd_megakernel(Args args) {
    extern __shared__ __attribute__((aligned(16))) unsigned char lds_raw[];
    LAS unsigned char* lds = (LAS unsigned char*)lds_raw;
    volatile LAS unsigned* MISC = (volatile LAS unsigned*)(lds + MISC_OFF);
    const int tid0 = threadIdx.x, wave = __builtin_amdgcn_readfirstlane(tid0 >> 6);
#define FRESH_LANE() int tid = tid0; asm volatile("" : "+v"(tid)); const int lane = tid & 63; (void)lane
    const int G = gridDim.x;
    const int vcu = (G % 8 == 0) ? ((int)blockIdx.x % 8) * (G / 8) + (int)blockIdx.x / 8 : (int)blockIdx.x;
    const int gw = vcu * NWAVES + wave, NGW = G * NWAVES;
    unsigned char* ws = args.ws;
    unsigned* ctl = (unsigned*)(ws + WS_CTL);
    for (int u = tid0; u < (LDS_BYTES - LDSCTL_OFF) / 4; u += NTHREADS) ((LAS unsigned*)(lds + LDSCTL_OFF))[u] = 0u;
    __syncthreads();
    XcdBarrier bar = xcd_barrier_post(ctl + CW_BAR, MISC + 8);
    unsigned long long ts_a = 0ull; int ts_n = 0;
#define STAMP() do { if (TS_A >= 0) { const unsigned long long t_ = __builtin_amdgcn_s_memrealtime(); if (ts_n == TS_A) ts_a = t_; \
    if (ts_n == TS_B && blockIdx.x == 0) { const unsigned long long tgt_ = t_ + 4ull * (t_ - ts_a); while (__builtin_amdgcn_s_memrealtime() < tgt_) __builtin_amdgcn_s_sleep(8); } ++ts_n; } } while (0)
#define GRID_BAR() do { xcd_barrier(bar); STAMP(); } while (0)
    STAMP();

    const float* x = args.in[0]; const float* rel_table = args.in[1]; const float* norm_g = args.in[2]; const float* attn_w_in = args.in[3]; const float* attn_sink = args.in[4];
    const float* attn_w_out = args.in[5]; const float* mu_prev = args.in[6]; const float* mu_next = args.in[7]; const float* w_r = args.in[8]; const float* w_k = args.in[9];
    const float* w_v = args.in[10]; const float* w_o = args.in[11]; const float* mlp_w1 = args.in[25]; const float* mlp_w2 = args.in[26];
    bf16_t* HBa = (bf16_t*)args.out; bf16_t* HBb = HBa + (size_t)M * D; bf16_t* HBc = (bf16_t*)(ws + WS_HBC); bf16_t* TMP2 = (bf16_t*)(ws + WS_TMP2);
    bf16_t* XN = (bf16_t*)(ws + WS_XN); bf16_t* QKV = (bf16_t*)(ws + WS_QKV); bf16_t* Ob = (bf16_t*)(ws + WS_O); bf16_t* TMP = (bf16_t*)(ws + WS_TMP); bf16_t* Hb = (bf16_t*)(ws + WS_H);
    bf16_t* MIXA = (bf16_t*)(ws + WS_MIXA); bf16_t* MIXB = (bf16_t*)(ws + WS_MIXB); bf16_t* Rb = (bf16_t*)(ws + WS_R); bf16_t* Kb = (bf16_t*)(ws + WS_K); bf16_t* Vb = (bf16_t*)(ws + WS_V);
    bf16_t* LDO = (bf16_t*)(ws + WS_LDO); bf16_t* Yb = (bf16_t*)(ws + WS_Y);
    LAS float* scr = (LAS float*)(lds + wave * TR_SCR_BYTES);
    float* RS = (float*)(ws + WS_CTL + 128 * 1024);

    {
        FRESH_LANE();
        constexpr int I_IN = (D / 64) * (DIN / 64), I_OUT = (D / 64) * (D / 64), I_1 = (D / 64) * (DFF / 64), I_2 = (DFF / 64) * (D / 64);
        const bool tail = (G == 256);
        for (int it = gw; it < (tail ? I_IN : I_IN + I_OUT + I_1 + I_2); it += NGW) { int r = it;
            if (r < I_IN) { transpose_item(attn_w_in, DIN, DIN, (bf16_t*)(ws + WS_WIN_T), D, 0, 0, scr, r, lane, ScaleOne{}); continue; } r -= I_IN;
            if (r < I_OUT) { transpose_item(attn_w_out, D, D, (bf16_t*)(ws + WS_WOUT_T), D, 0, 0, scr, r, lane, ScaleOne{}); continue; } r -= I_OUT;
            if (r < I_1) { transpose_item(mlp_w1, DFF, DFF, (bf16_t*)(ws + WS_W1_T), D, 0, 0, scr, r, lane, ScaleVec{norm_g + 2 * D}); continue; } r -= I_1;
            transpose_item(mlp_w2, D, D, (bf16_t*)(ws + WS_W2_T), DFF, 0, 0, scr, r, lane, ScaleOne{}); }
        for (int row = gw; row < M; row += NGW) { Row16 r; row_load_f32(r, x + (size_t)row * D, lane); row_rmsnorm(r, norm_g, lane); row_store_bf16(r, XN + (size_t)row * D, lane); }
    }
    GRID_BAR();
    { pg8::StaticOrder S; S.init(M, DIN, G, (int)blockIdx.x); const EpiHeadMajor E{QKV};
      for (int rep = 0; rep < REP_GEMM; ++rep) pg8::gemm_phase<EpiHeadMajor, ProbPlain, true, true>(lds, ProbPlain{XN, (const bf16_t*)(ws + WS_WIN_T), D}, S, E); }
    if (G == 256 && blockIdx.x >= 64) {
        FRESH_LANE();
        constexpr int I_OUT = (D / 64) * (D / 64), I_1 = (D / 64) * (DFF / 64), I_2 = (DFF / 64) * (D / 64);
        for (int it = ((int)blockIdx.x - 64) * NWAVES + wave; it < I_OUT + I_1 + I_2; it += 192 * NWAVES) { int r = it;
            if (r < I_OUT) { transpose_item(attn_w_out, D, D, (bf16_t*)(ws + WS_WOUT_T), D, 0, 0, scr, r, lane, ScaleOne{}); continue; } r -= I_OUT;
            if (r < I_1) { transpose_item(mlp_w1, DFF, DFF, (bf16_t*)(ws + WS_W1_T), D, 0, 0, scr, r, lane, ScaleVec{norm_g + 2 * D}); continue; } r -= I_1;
            transpose_item(mlp_w2, D, D, (bf16_t*)(ws + WS_W2_T), DFF, 0, 0, scr, r, lane, ScaleOne{}); }
    }
    GRID_BAR();
    { const AttnIO io{QKV, rel_table, attn_sink, Ob, (bf16_t*)(ws + WS_OBR), (float*)(ws + WS_LSE)};
      for (int rep = 0; rep < REP_ATT; ++rep) phase_attn(lds, io, vcu, G);
      GRID_BAR();
      { FRESH_LANE(); phase_attn_merge(io, vcu * NTHREADS + tid, G * NTHREADS); } }
    GRID_BAR();
    for (int rep = 0; rep < REP_BAR; ++rep) GRID_BAR();
    run_gemm<0>(lds, ProbPlain{Ob, (const bf16_t*)(ws + WS_WOUT_T), D}, DstPlain{TMP, D}, M, D, G);
    GRID_BAR();
    { FRESH_LANE(); phase_resnorm<true, false>(x, TMP, norm_g + D, nullptr, HBa, nullptr, RS, gw, NGW, lane); }
    GRID_BAR();
    run_gemm_rs<1>(lds, ProbPlain{HBa, (const bf16_t*)(ws + WS_W1_T), D}, DstPlain{Hb, DFF}, RS, M, DFF, G);
    GRID_BAR();
    run_gemm<0>(lds, ProbPlain{Hb, (const bf16_t*)(ws + WS_W2_T), DFF}, DstPlain{TMP, D}, M, D, G);
    GRID_BAR();
    { FRESH_LANE(); phase_resnorm<false, false>(HBa, TMP, norm_g + 3 * D, nullptr, HBb, nullptr, nullptr, gw, NGW, lane); }
    GRID_BAR();
    {
        FRESH_LANE();
        const float* g1n = norm_g + 4 * D;
        constexpr int I_SQ = (D / 64) * (D / 64), I_1 = (D / 64) * (DFF / 64), I_2 = (DFF / 64) * (D / 64), I_LD = 384;
        const bool tail = (G == 256);
        for (int it = gw; it < (tail ? 2 * I_SQ + I_2 + I_LD : 4 * I_SQ + I_1 + I_2 + I_LD); it += NGW) { int r = it;
            if (r < I_SQ) { transpose_item(w_r, D, D, (bf16_t*)(ws + WS_WR_T), D, 0, 0, scr, r, lane, ScaleOne{}); continue; } r -= I_SQ;
            if (r < I_SQ) { transpose_item(w_k, D, D, (bf16_t*)(ws + WS_WK_T), D, 0, 0, scr, r, lane, ScaleOne{}); continue; } r -= I_SQ;
            if (!tail) {
                if (r < I_SQ) { transpose_item(w_v, D, D, (bf16_t*)(ws + WS_WV_T), D, 0, 0, scr, r, lane, ScaleOne{}); continue; } r -= I_SQ;
                if (r < I_SQ) { transpose_item(w_o, D, D, (bf16_t*)(ws + WS_WO2_T), D, 0, 0, scr, r, lane, ScaleOne{}); continue; } r -= I_SQ;
                if (r < I_1) { transpose_item(mlp_w1 + (size_t)D * DFF, DFF, DFF, (bf16_t*)(ws + WS_W1B_T), D, 0, 0, scr, r, lane, ScaleVec{norm_g + 6 * D}); continue; } r -= I_1; }
            if (r < I_2) { transpose_item(mlp_w2 + (size_t)DFF * D, D, D, (bf16_t*)(ws + WS_W2B_T), DFF, 0, 0, scr, r, lane, ScaleOne{}); continue; } r -= I_2;
            const int part = r / 128; int q = r % 128; int sub, li;
            if (q < 64) { sub = q / 16; li = q % 16; } else { sub = 4 + (q - 64) / 32; li = (q - 64) % 32; }
            const int dd = sub & 1, kind = sub >> 1;
            const int stream = kind == 0 ? 1 : (kind == 1 ? 4 : 5), Nn = kind == 2 ? 128 : 64;
            const float* src = kind == 0 ? args.in[18] + (size_t)dd * D * 64 : (kind == 1 ? args.in[21] + (size_t)dd * D * 64 : args.in[23] + (size_t)dd * D * 128);
            const int coloff = kind == 0 ? dd * 64 : (kind == 1 ? 128 + dd * 64 : 256 + dd * 128);
            transpose_item(src, Nn, Nn, (bf16_t*)(ws + WS_LDW_T), D, part * 512 + coloff, 0, scr, li, lane, ScaleMix{mu_prev + stream * D, mu_next + stream * D, part}); }
        phase_mix3(lds, HBb, g1n, mu_prev, mu_next, XN, MIXA, MIXB, HBa, gw, NGW, tid, lane);
    }
    GRID_BAR();
    run_gemm<0>(lds, ProbRKL{ws, D}, DstRKL{ws}, M, 14 * 256, G);
    if (G == 256 && blockIdx.x >= 128) {
        FRESH_LANE();
        constexpr int I_SQ = (D / 64) * (D / 64), I_1 = (D / 64) * (DFF / 64);
        for (int it = ((int)blockIdx.x - 128) * NWAVES + wave; it < 2 * I_SQ + I_1; it += 128 * NWAVES) { int r = it;
            if (r < I_SQ) { transpose_item(w_v, D, D, (bf16_t*)(ws + WS_WV_T), D, 0, 0, scr, r, lane, ScaleOne{}); continue; } r -= I_SQ;
            if (r < I_SQ) { transpose_item(w_o, D, D, (bf16_t*)(ws + WS_WO2_T), D, 0, 0, scr, r, lane, ScaleOne{}); continue; } r -= I_SQ;
            transpose_item(mlp_w1 + (size_t)D * DFF, DFF, DFF, (bf16_t*)(ws + WS_W1B_T), D, 0, 0, scr, r, lane, ScaleVec{norm_g + 6 * D}); }
    }
    GRID_BAR();
    { FRESH_LANE(); phase_lda(LDO, (bf16_t*)(ws + WS_LDA), gw, NGW, lane); }
    run_gemm<0>(lds, ProbPlain{HBa, (const bf16_t*)(ws + WS_WV_T), D}, DstPlain{Vb, D}, M, D, G);
    GRID_BAR();
    { ScanPtrs sp{Rb, Kb, Vb, (const bf16_t*)(ws + WS_LDA), Yb, args.in[19], args.in[22], args.in[24], args.in[17], args.in[20], args.in[12], args.in[13], args.in[14], args.in[15], args.in[16]};
      for (int rep = 0; rep < REP_SCAN; ++rep) phase_scan(lds, sp, G); }
    GRID_BAR();
    { FRESH_LANE();
      bf16_t* Ys = (bf16_t*)(ws + WS_YSUM);
      const bool grp_on = (G == 256);
      const int grow0 = 256 * (8 * ((int)blockIdx.x % 8) + ((int)blockIdx.x / 8) % 8) + 64 * ((int)blockIdx.x / 64);
      const int rfirst = grp_on ? grow0 + wave : gw, rend = grp_on ? grow0 + 64 : M, rstride = grp_on ? NWAVES : NGW;
      for (int row = rfirst; row < rend; row += rstride) {
          const u32x4* y0 = (const u32x4*)(Yb + (size_t)row * 2 * D); const u32x4* y1 = (const u32x4*)(Yb + (size_t)row * 2 * D + D);
#pragma unroll
          for (int hb = 0; hb < 2; ++hb) { const u32x4 a = y0[lane + 64 * hb], c = y1[lane + 64 * hb]; u32x4 o;
              o.x = cvtpk(bflo(a.x) + bflo(c.x), bfhi(a.x) + bfhi(c.x)); o.y = cvtpk(bflo(a.y) + bflo(c.y), bfhi(a.y) + bfhi(c.y));
              o.z = cvtpk(bflo(a.z) + bflo(c.z), bfhi(a.z) + bfhi(c.z)); o.w = cvtpk(bflo(a.w) + bflo(c.w), bfhi(a.w) + bfhi(c.w));
              pg8::store16_wt((u32x4*)(Ys + (size_t)row * D) + lane + 64 * hb, o); } }
      if (grp_on) { unsigned ep = 0u; grp_barrier(ctl + CW_BAR, (unsigned)blockIdx.x % 64u, ep); } else GRID_BAR();
      run_gemm<0>(lds, ProbPlain{Ys, (const bf16_t*)(ws + WS_WO2_T), D}, DstPlain{TMP2, D}, M, D, G); }
    GRID_BAR();
    { FRESH_LANE(); phase_resnorm<false, false>(HBb, TMP2, norm_g + 5 * D, nullptr, HBc, nullptr, RS, gw, NGW, lane); }
    GRID_BAR();
    run_gemm_rs<1>(lds, ProbPlain{HBc, (const bf16_t*)(ws + WS_W1B_T), D}, DstPlain{Hb, DFF}, RS, M, DFF, G);
    GRID_BAR();
    run_gemm<0>(lds, ProbPlain{Hb, (const bf16_t*)(ws + WS_W2B_T), DFF}, DstPlain{TMP2, D}, M, D, G);
    GRID_BAR();
    { FRESH_LANE(); phase_resnorm<false, true>(HBc, TMP2, norm_g + 7 * D, nullptr, args.out, nullptr, nullptr, gw, NGW, lane); }
    if (TS_A >= 0) { GRID_BAR(); }
#undef GRID_BAR
}

extern "C" void kernel_launch(void* const* d_in, const int* in_sizes, int n_in, void* d_out, int out_size, void* d_ws, size_t ws_size, hipStream_t stream) {
    static int grid = 0;
    if (grid == 0) {
        if (n_in != 27 || in_sizes[0] != M * D || out_size != M * D || ws_size < WS_END) { fprintf(stderr, "kernel_launch: unexpected shapes (n_in %d, in0 %d, out %d, ws %zu)\n", n_in, n_in > 0 ? in_sizes[0] : -1, out_size, ws_size); grid = -1; return; }
        int dev = 0, cus = 0, per_cu = 0;
        if (hipGetDevice(&dev) != hipSuccess || hipDeviceGetAttribute(&cus, hipDeviceAttributeMultiprocessorCount, dev) != hipSuccess) { grid = -1; return; }
        if (hipFuncSetAttribute((const void*)fwd_megakernel, hipFuncAttributeMaxDynamicSharedMemorySize, LDS_BYTES) != hipSuccess) { fprintf(stderr, "kernel_launch: hipFuncSetAttribute failed\n"); grid = -1; return; }
        if (hipOccupancyMaxActiveBlocksPerMultiprocessor(&per_cu, (const void*)fwd_megakernel, NTHREADS, LDS_BYTES) != hipSuccess || per_cu < 1) { fprintf(stderr, "kernel_launch: occupancy query says %d blocks/CU\n", per_cu); (void)hipGetLastError(); grid = -1; return; }
        grid = cus;
    }
    if (grid < 0) return;
    (void)hipMemsetAsync((char*)d_ws + WS_CTL, 0, CTL_ZERO_BYTES, stream);
    Args a{};
    for (int i = 0; i < 27; ++i) a.in[i] = (const float*)d_in[i];
    a.out = (float*)d_out; a.ws = (unsigned char*)d_ws;
    hipLaunchKernelGGL(fwd_megakernel, dim3(grid), dim3(NTHREADS), LDS_BYTES, stream, a);
}
```

```cpp
#include <hip/hip_runtime.h>
#include <cstdio>
#include <cstdint>

#define LAS __attribute__((address_space(3)))
#define GAS __attribute__((address_space(1)))
typedef unsigned short bf16_t;
typedef short bf16x8 __attribute__((ext_vector_type(8)));
typedef float f32x4 __attribute__((ext_vector_type(4)));
typedef float f32x2 __attribute__((ext_vector_type(2)));
typedef unsigned u32x4 __attribute__((ext_vector_type(4)));
typedef unsigned u32x2 __attribute__((ext_vector_type(2)));

#ifndef REP_SCAN
#define REP_SCAN 1
#endif
#ifndef REP_ATT
#define REP_ATT 1
#endif
#ifndef REP_GEMM
#define REP_GEMM 1
#endif
#ifndef REP_ATTC
#define REP_ATTC 1
#endif
#ifndef REP_BAR
#define REP_BAR 0
#endif
#ifndef REP_ATTS
#define REP_ATTS 1
#endif
#ifndef REP_HC
#define REP_HC 1
#endif
#ifndef REP_ST
#define REP_ST 1
#endif
#ifndef REP_HL
#define REP_HL 1
#endif
#ifndef REP_SYNC
#define REP_SYNC 0
#endif
#ifndef SECPROBE
#define SECPROBE -1
#endif
#ifndef WAITPROBE
#define WAITPROBE -1
#endif
#ifndef TS_A
#define TS_A -1
#endif
#ifndef TS_B
#define TS_B -1
#endif
constexpr int SEQ = 2048, D = 1024, NBATCH = 8, M = NBATCH * SEQ, DFF = 4096, DIN = 2304, NLD = 1536;
constexpr float NORM_EPS = 1e-6f, GN_EPS = 64e-5f;
constexpr int NWAVES = 8, NTHREADS = 512;

namespace pg8 {
constexpr int BM = 256, BK = 64, HALF = 128, HTB = HALF * BK * 2, STAGE_BYTES = 8 * HTB, NXCD = 8, WGM = 8;
__host__ __device__ __forceinline__ int lds_byte(int r, int c) { const int st = (r >> 4) * 2 + (c >> 5), rr = r & 15, cc = c & 31, ob = rr * 64 + cc * 2; return st * 1024 + (ob ^ (((ob >> 9) & 1) << 5)); }
__host__ __device__ __forceinline__ void stage_rc(int b, int& R, int& C) { const int st = b / 1024, sb = b % 1024, swz = sb ^ (((sb >> 9) & 1) << 5); R = (st >> 1) * 16 + swz / 64; C = (st & 1) * 32 + (swz % 64) / 2; }
__host__ __device__ __forceinline__ int perm32(int rho) { const int n = rho >> 4, i = rho & 15; return 8 * (i >> 2) + 4 * n + (i & 3); }

struct Unit { int pm, pn; };
struct StaticOrder {
    int nM, nN, nwg, G, c;
    __host__ __device__ void init(int Mr, int N, int G_, int c_) { nM = Mr / BM; nN = N / BM; nwg = nM * nN; G = G_; c = c_; }
    __host__ __device__ bool next(int i, Unit& u) const {
        const long L = (long)i * G + c; if (L >= nwg) return false;
        int wgid = (int)L; { const int q = nwg / NXCD, r = nwg % NXCD, xcd = wgid % NXCD, off = wgid / NXCD; wgid = (xcd < r ? xcd * (q + 1) : r * (q + 1) + (xcd - r) * q) + off; }
        const int nig = WGM * nN, gid = wgid / nig, fm = gid * WGM, gsz = (nM - fm) < WGM ? (nM - fm) : WGM;
        u.pm = fm + ((wgid % nig) % gsz); u.pn = (wgid % nig) / gsz; return true;
    }
};
__device__ __forceinline__ unsigned cvt_pk_bf16(float lo, float hi) { unsigned r; asm volatile("v_cvt_pk_bf16_f32 %0, %1, %2" : "=v"(r) : "v"(lo), "v"(hi)); return r; }

__device__ __forceinline__ void store16_wt(void* p, u32x4 v) { asm volatile("global_store_dwordx4 %0, %1, off sc1\n\ts_nop 1" :: "v"(p), "v"(v) : "memory"); }
template <int ACT, class DstFn, bool RS = false> struct EpiBf16 {
    static constexpr bool PERM = true;
    DstFn F; const float* rs;
    __device__ __forceinline__ void operator()(const f32x4 (&acc)[2][2][4][2], const Unit& u, int wr, int wc, int fr, int fq) const {
        bf16_t* base; int ldc; F(u, base, ldc);
        const int row0 = wr * 64 + fr, col0 = wc * 32 + 8 * fq;
        float rsc[2][4];
        if (RS) {
#pragma unroll
            for (int ai = 0; ai < 2; ++ai)
#pragma unroll
                for (int m = 0; m < 4; ++m) rsc[ai][m] = rs[u.pm * BM + row0 + ai * HALF + m * 16]; }
        if (RS && ACT == 1) {
            f32x4 t[2][2][4][2];
#pragma unroll
            for (int ai = 0; ai < 2; ++ai)
#pragma unroll
                for (int bj = 0; bj < 2; ++bj)
#pragma unroll
                    for (int m = 0; m < 4; ++m)
#pragma unroll
                        for (int n = 0; n < 2; ++n)
#pragma unroll
                            for (int e = 0; e < 4; ++e) { const float a = fmaxf(acc[ai][bj][m][n][e], 0.f); t[ai][bj][m][n][e] = a * a; }
#pragma unroll
            for (int ai = 0; ai < 2; ++ai)
#pragma unroll
                for (int m = 0; m < 4; ++m) { bf16_t* rowp = base + (size_t)(row0 + ai * HALF + m * 16) * ldc + col0; const float r2 = rsc[ai][m] * rsc[ai][m];
#pragma unroll
                    for (int bj = 0; bj < 2; ++bj) { const f32x4 v0 = t[ai][bj][m][0] * r2, v1 = t[ai][bj][m][1] * r2;
                        u32x4 w; w.x = cvt_pk_bf16(v0[0], v0[1]); w.y = cvt_pk_bf16(v0[2], v0[3]); w.z = cvt_pk_bf16(v1[0], v1[1]); w.w = cvt_pk_bf16(v1[2], v1[3]);
                        store16_wt(rowp + bj * HALF, w); } }
            return;
        }
#pragma unroll
        for (int ai = 0; ai < 2; ++ai)
#pragma unroll
            for (int m = 0; m < 4; ++m) { bf16_t* rowp = base + (size_t)(row0 + ai * HALF + m * 16) * ldc + col0;
#pragma unroll
                for (int bj = 0; bj < 2; ++bj) { f32x4 v0 = acc[ai][bj][m][0], v1 = acc[ai][bj][m][1];
                    if (RS) { v0 = v0 * rsc[ai][m]; v1 = v1 * rsc[ai][m]; }
                    if (ACT == 1) {
#pragma unroll
                        for (int e = 0; e < 4; ++e) { const float a = fmaxf(v0[e], 0.f), b = fmaxf(v1[e], 0.f); v0[e] = a * a; v1[e] = b * b; } }
                    u32x4 w; w.x = cvt_pk_bf16(v0[0], v0[1]); w.y = cvt_pk_bf16(v0[2], v0[3]); w.z = cvt_pk_bf16(v1[0], v1[1]); w.w = cvt_pk_bf16(v1[2], v1[3]);
                    store16_wt(rowp + bj * HALF, w); } }
    }
};

template <class Epi, class Prob, bool ALIGN_EPI, bool SP2>
__device__ __forceinline__ void gemm_phase(LAS unsigned char* lds, const Prob& P, const StaticOrder& S, const Epi& E) {
    int tid = threadIdx.x; asm volatile("" : "+v"(tid));
    const int wid = __builtin_amdgcn_readfirstlane(tid >> 6), lane = tid & 63, wr = wid >> 2, wc = wid & 3, fr = lane & 15, fq = lane >> 4;
    const int K = P.K, nt = K / BK;
    unsigned voffA[2], voffB[2];
#pragma unroll
    for (int i = 0; i < 2; ++i) { int R, C; stage_rc(tid * 16 + i * 8192, R, C); const int Rb = Epi::PERM ? ((R & ~31) + perm32(R & 31)) : R;
        voffA[i] = (unsigned)(R * K + C) * 2u; voffB[i] = (unsigned)(Rb * K + C) * 2u; }
    const size_t kstep = (size_t)(BK * 2);
    const size_t hstep = (size_t)HALF * K * 2;
    const unsigned ldsw = (unsigned)wid * 1024u;
    const int aoff = lds_byte(wr * 64 + fr, fq * 8), boff = lds_byte(wc * 32 + fr, fq * 8);
#define PG8_SA(b, h) (((b) * 2 + (h)) * HTB)
#define PG8_SB(b, h) ((4 + (b) * 2 + (h)) * HTB)
#define PG8_STAGE(bufoff, gbase, voff) do { _Pragma("unroll") for (int _i = 0; _i < 2; ++_i) \
        __builtin_amdgcn_global_load_lds((const unsigned*)((const char*)(gbase) + (voff)[_i]), (LAS unsigned*)(lds + (bufoff) + ldsw + _i * 8192), 16, 0, 0); } while (0)
#define PG8_LDA(dst, b, h) do { _Pragma("unroll") for (int m = 0; m < 4; ++m) _Pragma("unroll") for (int k = 0; k < 2; ++k) dst[m][k] = *(const LAS bf16x8*)(lds + PG8_SA(b, h) + aoff + m * 2048 + k * 1024); } while (0)
#define PG8_LDB(dst, b, h) do { _Pragma("unroll") for (int n = 0; n < 2; ++n) _Pragma("unroll") for (int k = 0; k < 2; ++k) dst[n][k] = *(const LAS bf16x8*)(lds + PG8_SB(b, h) + boff + n * 2048 + k * 1024); } while (0)
#define PG8_MMA(ai, bj, At, Bt) do { __builtin_amdgcn_s_setprio(1); _Pragma("unroll") for (int m = 0; m < 4; ++m) _Pragma("unroll") for (int n = 0; n < 2; ++n) _Pragma("unroll") for (int k = 0; k < 2; ++k) \
        acc[ai][bj][m][n] = __builtin_amdgcn_mfma_f32_16x16x32_bf16(Bt[n][k], At[m][k], acc[ai][bj][m][n], 0, 0, 0); __builtin_amdgcn_s_setprio(0); } while (0)
#define PG8_WAIT_V(n) asm volatile("s_waitcnt vmcnt(" #n ")" ::: "memory")
#define PG8_WAIT_L(n) asm volatile("s_waitcnt lgkmcnt(" #n ")" ::: "memory")
#define PG8_BAR __builtin_amdgcn_s_barrier()
#define PG8_SCHED __builtin_amdgcn_sched_barrier(0)
    Unit cur, nxt; int ui = 0;
    if (!S.next(0, cur)) return;
    f32x4 acc[2][2][4][2];
#pragma unroll
    for (int a = 0; a < 2; ++a)
#pragma unroll
        for (int b = 0; b < 2; ++b)
#pragma unroll
            for (int m = 0; m < 4; ++m)
#pragma unroll
                for (int n = 0; n < 2; ++n) acc[a][b][m][n] = (f32x4){0.f, 0.f, 0.f, 0.f};
    bf16x8 At[4][2], B0[2][2], B1[2][2];
    const char* cA = P.a_tile(cur); const char* cB = P.b_tile(cur);
    if constexpr (SP2) {
        PG8_STAGE(PG8_SB(0, 0), cB, voffB); PG8_STAGE(PG8_SB(0, 1), cB + hstep, voffB); PG8_STAGE(PG8_SA(0, 0), cA, voffA); PG8_STAGE(PG8_SA(0, 1), cA + hstep, voffA);
        if (wr == 1) PG8_BAR;
        PG8_WAIT_V(2); PG8_BAR;
        PG8_STAGE(PG8_SB(1, 0), cB + kstep, voffB); PG8_STAGE(PG8_SA(1, 0), cA + kstep, voffA); PG8_STAGE(PG8_SB(1, 1), cB + hstep + kstep, voffB);
        PG8_WAIT_V(6); PG8_BAR;
    } else {
        PG8_STAGE(PG8_SB(0, 0), cB, voffB); PG8_STAGE(PG8_SA(0, 0), cA, voffA); PG8_STAGE(PG8_SB(0, 1), cB + hstep, voffB); PG8_STAGE(PG8_SA(0, 1), cA + hstep, voffA);
        if (wr == 1) PG8_BAR;
        PG8_WAIT_V(4); PG8_BAR;
        PG8_STAGE(PG8_SB(1, 0), cB + kstep, voffB); PG8_STAGE(PG8_SA(1, 0), cA + kstep, voffA); PG8_STAGE(PG8_SB(1, 1), cB + hstep + kstep, voffB);
        PG8_WAIT_V(6); PG8_BAR;
    }
    for (;;) {
        const bool has_next = S.next(ui + 1, nxt);
        const char* nA = has_next ? P.a_tile(nxt) : cA; const char* nB = has_next ? P.b_tile(nxt) : cB;
        for (int t = 0; t < nt; t += 2) {
            const bool last = (t == nt - 2);
            const char* a1 = cA + (size_t)(t + 1) * kstep;
            const char* a2 = last ? nA : cA + (size_t)(t + 2) * kstep; const char* b2 = last ? nB : cB + (size_t)(t + 2) * kstep;
            const char* a3 = a2 + kstep; const char* b3 = b2 + kstep;
            if constexpr (SP2) {
            PG8_LDB(B0, 0, 0); PG8_LDB(B1, 0, 1); PG8_SCHED; PG8_LDA(At, 0, 0); PG8_STAGE(PG8_SA(1, 1), a1 + hstep, voffA);
            PG8_WAIT_V(8); PG8_WAIT_L(0); PG8_BAR; PG8_MMA(0, 0, At, B0); PG8_MMA(0, 1, At, B1); PG8_BAR; PG8_SCHED;
            PG8_LDA(At, 0, 1); PG8_STAGE(PG8_SB(0, 0), b2, voffB); PG8_STAGE(PG8_SB(0, 1), b2 + hstep, voffB); PG8_STAGE(PG8_SA(0, 0), a2, voffA);
            PG8_WAIT_V(8); PG8_WAIT_L(0); PG8_BAR; PG8_MMA(1, 0, At, B0); PG8_MMA(1, 1, At, B1); PG8_BAR; PG8_SCHED;
            PG8_LDB(B0, 1, 0); PG8_LDB(B1, 1, 1); PG8_SCHED; PG8_LDA(At, 1, 0); PG8_STAGE(PG8_SA(0, 1), a2 + hstep, voffA);
            PG8_WAIT_V(8); PG8_WAIT_L(0); PG8_BAR; PG8_MMA(0, 0, At, B0); PG8_MMA(0, 1, At, B1); PG8_BAR; PG8_SCHED;
            PG8_LDA(At, 1, 1); PG8_STAGE(PG8_SB(1, 0), b3, voffB); PG8_STAGE(PG8_SB(1, 1), b3 + hstep, voffB); PG8_STAGE(PG8_SA(1, 0), a3, voffA);
            PG8_WAIT_V(8); PG8_WAIT_L(0); PG8_BAR; PG8_MMA(1, 0, At, B0); PG8_MMA(1, 1, At, B1); PG8_BAR; PG8_SCHED;
            } else {
            PG8_LDB(B0, 0, 0); PG8_SCHED; PG8_LDA(At, 0, 0); PG8_STAGE(PG8_SA(1, 1), a1 + hstep, voffA);
            PG8_WAIT_L(8); PG8_BAR; PG8_WAIT_L(0); PG8_MMA(0, 0, At, B0); PG8_BAR; PG8_SCHED;
            PG8_LDB(B1, 0, 1); PG8_STAGE(PG8_SB(0, 0), b2, voffB);
            PG8_BAR; PG8_WAIT_L(0); PG8_MMA(0, 1, At, B1); PG8_BAR;
            PG8_LDA(At, 0, 1); PG8_STAGE(PG8_SA(0, 0), a2, voffA);
            PG8_BAR; PG8_WAIT_L(0); PG8_MMA(1, 0, At, B0); PG8_BAR; PG8_SCHED;
            PG8_STAGE(PG8_SB(0, 1), b2 + hstep, voffB);
            PG8_WAIT_V(6); PG8_BAR; PG8_MMA(1, 1, At, B1); PG8_BAR;
            PG8_LDB(B0, 1, 0); PG8_SCHED; PG8_LDA(At, 1, 0); PG8_STAGE(PG8_SA(0, 1), a2 + hstep, voffA);
            PG8_WAIT_L(8); PG8_BAR; PG8_WAIT_L(0); PG8_MMA(0, 0, At, B0); PG8_BAR; PG8_SCHED;
            PG8_LDB(B1, 1, 1); PG8_STAGE(PG8_SB(1, 0), b3, voffB);
            PG8_BAR; PG8_WAIT_L(0); PG8_MMA(0, 1, At, B1); PG8_BAR;
            PG8_LDA(At, 1, 1); PG8_STAGE(PG8_SA(1, 0), a3, voffA);
            PG8_BAR; PG8_WAIT_L(0); PG8_MMA(1, 0, At, B0); PG8_BAR; PG8_SCHED;
            PG8_STAGE(PG8_SB(1, 1), b3 + hstep, voffB);
            PG8_WAIT_V(6); PG8_BAR; PG8_MMA(1, 1, At, B1); PG8_BAR;
            }
        }
        if constexpr (ALIGN_EPI) { if (wr == 0) PG8_BAR; }
        E(acc, cur, wr, wc, fr, fq);
        if (!has_next) break;
#pragma unroll
        for (int a = 0; a < 2; ++a)
#pragma unroll
            for (int b = 0; b < 2; ++b)
#pragma unroll
                for (int m = 0; m < 4; ++m)
#pragma unroll
                    for (int n = 0; n < 2; ++n) acc[a][b][m][n] = (f32x4){0.f, 0.f, 0.f, 0.f};
        cur = nxt; cA = nA; cB = nB; ++ui;
        if constexpr (ALIGN_EPI) { if (wr == 1) PG8_BAR; }
    }
    PG8_WAIT_V(0);
    if constexpr (!ALIGN_EPI) { if (wr == 0) PG8_BAR; }
    PG8_BAR;
#undef PG8_SA
#undef PG8_SB
#undef PG8_STAGE
#undef PG8_LDA
#undef PG8_LDB
#undef PG8_MMA
#undef PG8_WAIT_V
#undef PG8_WAIT_L
#undef PG8_BAR
#undef PG8_SCHED
}
}

constexpr size_t MiB = 1u << 20;
constexpr size_t WS_CTL = 0, CTL_ZERO_BYTES = 64 * 1024;
constexpr size_t WS_W = 1 * MiB;
constexpr size_t WS_WIN_T = WS_W, WS_WOUT_T = WS_WIN_T + (size_t)DIN * D * 2, WS_W1_T = WS_WOUT_T + (size_t)D * D * 2, WS_W2_T = WS_W1_T + (size_t)DFF * D * 2;
constexpr size_t WS_WR_T = WS_W, WS_WK_T = WS_WR_T + 2 * MiB, WS_LDW_T = WS_WK_T + 2 * MiB, WS_WV_T = WS_LDW_T + 3 * MiB, WS_WO2_T = WS_WV_T + 2 * MiB, WS_W1B_T = WS_WO2_T + 4 * MiB, WS_W2B_T = WS_W1B_T + 8 * MiB;
static_assert(WS_W2_T + (size_t)D * DFF * 2 <= 31 * MiB && WS_W2B_T + (size_t)D * DFF * 2 <= 31 * MiB, "weight region");
constexpr size_t WS_XN = 31 * MiB, WS_QKV = 63 * MiB, WS_O = 135 * MiB, WS_OBR = 167 * MiB, WS_LSE = 215 * MiB, WS_TMP = 217 * MiB, WS_H = 63 * MiB;
constexpr size_t WS_MIXA = 63 * MiB, WS_MIXB = 95 * MiB, WS_R = 127 * MiB, WS_K = 159 * MiB, WS_V = 31 * MiB, WS_LDO = 191 * MiB, WS_Y = 63 * MiB, WS_LDA = 239 * MiB;
constexpr size_t WS_YSUM = 127 * MiB;
constexpr size_t WS_HBC = 191 * MiB, WS_TMP2 = 223 * MiB;
constexpr size_t WS_END = 256 * MiB;
static_assert(WS_HBC >= WS_H + (size_t)M * DFF * 2 && WS_HBC + (size_t)M * D * 2 <= WS_TMP2 && WS_TMP2 + (size_t)M * D * 2 <= WS_END, "layer-1 tail");
static_assert(WS_LDO + (size_t)M * NLD * 2 <= WS_LDA && WS_LDA + (size_t)M * 512 * 2 <= WS_END && WS_TMP + (size_t)M * D * 2 <= WS_END, "tail of the map");
static_assert(WS_MIXA == WS_XN + 32 * MiB && WS_MIXB == WS_XN + 64 * MiB && WS_K == WS_R + 32 * MiB && WS_LDO == WS_R + 64 * MiB && WS_WK_T == WS_WR_T + 2 * MiB && WS_LDW_T == WS_WR_T + 4 * MiB, "grouped GEMM strides");
constexpr int CW_BAR = 4096;

constexpr int RING_BYTES = 131072, LDSCTL_OFF = 143360, MISC_OFF = LDSCTL_OFF + 320, LDS_BYTES = 147456;

typedef __bf16 bf16x2_t __attribute__((ext_vector_type(2)));
__device__ __forceinline__ unsigned cvtpk(float lo, float hi) { const f32x2 v = {lo, hi}; const bf16x2_t b = __builtin_convertvector(v, bf16x2_t); return __builtin_bit_cast(unsigned, b); }
__device__ __forceinline__ float bf2f(unsigned short b) { return __uint_as_float((unsigned)b << 16); }
__device__ __forceinline__ float bflo(unsigned w) { return __uint_as_float(w << 16); }
__device__ __forceinline__ float bfhi(unsigned w) { return __uint_as_float(w & 0xffff0000u); }
__device__ __forceinline__ unsigned f2bf(float f) { unsigned u = __float_as_uint(f); return (u + 0x7fffu + ((u >> 16) & 1u)) >> 16; }
__device__ __forceinline__ unsigned pk2(float lo, float hi) { return f2bf(lo) | (f2bf(hi) << 16); }
__device__ __forceinline__ float wave_sum(float v) {
#pragma unroll
    for (int o = 1; o < 64; o <<= 1) v += __shfl_xor(v, o);
    return v;
}
__device__ __forceinline__ float sigmoidf_(float z) { return 1.f / (1.f + __expf(-z)); }
__device__ __forceinline__ int t5_bucket(int rel) {
    const int n = rel < 0 ? -rel : rel;
    int large;
    if (n < 8) large = n; else if (n < 15) large = 8; else if (n < 27) large = 9; else if (n < 50) large = 10; else if (n < 91) large = 11;
    else if (n < 166) large = 12; else if (n < 305) large = 13; else if (n < 559) large = 14; else large = 15;
    return (rel > 0 ? 16 : 0) + large;
}

#define XB_TMO      128
#define XB_XCNT(j)  (256  + 64 * (j))
#define XB_XSUB(j)  (1280 + 64 * (j))
#define XB_XGEN(j)  (2304 + 64 * (j))
#define XB_TOP      3328
#define XB_TOPGEN   3392
#define XCD_BAR_WORDS 3456
#define XB_SPIN_CAP (1u << 18)
__device__ __forceinline__ unsigned xb_ld(unsigned* p)              { return __hip_atomic_load(p, __ATOMIC_RELAXED, __HIP_MEMORY_SCOPE_AGENT); }
__device__ __forceinline__ unsigned xb_add(unsigned* p, unsigned v) { return __hip_atomic_fetch_add(p, v, __ATOMIC_RELAXED, __HIP_MEMORY_SCOPE_AGENT); }
__device__ __forceinline__ unsigned xb_xcc_id() { return (unsigned)__builtin_amdgcn_s_getreg((3 << 11) | 20) & 0xFu; }
#define XB_SPIN(cond, bar) do { unsigned _sp = 0; while (cond) { __builtin_amdgcn_s_sleep(1); \
    if ((++_sp & 255u) == 0u) { if (xb_ld(&(bar)[XB_TMO])) break; if (_sp > XB_SPIN_CAP) { atomicAdd(&(bar)[XB_TMO], 1u); break; } } } } while (0)
struct XcdBarrier { unsigned* bar; unsigned x; volatile LAS unsigned* st; };
__device__ __forceinline__ XcdBarrier xcd_barrier_post(unsigned* bar, volatile LAS unsigned* st) {
    XcdBarrier b; b.bar = bar; b.x = xb_xcc_id(); b.st = st;
    if (threadIdx.x == 0) (void)xb_add(&bar[XB_XCNT(b.x)], 1u);
    return b;
}
__device__ __forceinline__ void xcd_barrier_complete(unsigned* bar, unsigned x, unsigned& nloc, unsigned& nx) {
    const unsigned G = gridDim.x * gridDim.y * gridDim.z;
    unsigned sum, cnt, mine, sp = 0u;
    for (;;) {
        sum = 0u; cnt = 0u; mine = 0u;
#pragma unroll
        for (unsigned j = 0; j < 16; ++j) { const unsigned c = xb_ld(&bar[XB_XCNT(j)]); sum += c; cnt += (c > 0u) ? 1u : 0u; mine = (j == x) ? c : mine; }
        if (sum == G) break;
        __builtin_amdgcn_s_sleep(1);
        if ((++sp & 255u) == 0u) { if (xb_ld(&bar[XB_TMO])) break; if (sp > XB_SPIN_CAP) { atomicAdd(&bar[XB_TMO], 1u); break; } }
    }
    nloc = mine > 0u ? mine : 1u; nx = cnt > 0u ? cnt : 1u;
}
__device__ __forceinline__ void xcd_barrier(const XcdBarrier& b) {
    asm volatile("s_waitcnt vmcnt(0)" ::: "memory");
    __syncthreads();
    if (threadIdx.x == 0) {
        unsigned* bar = b.bar;
        __builtin_amdgcn_s_waitcnt(0);
        unsigned nloc = b.st[0], nx = b.st[1];
        if (nloc == 0u) { xcd_barrier_complete(bar, b.x, nloc, nx); b.st[0] = nloc; b.st[1] = nx; }
        const unsigned old = xb_add(&bar[XB_XSUB(b.x)], 1u);
        const unsigned gen = old / nloc;
        if (old + 1u == (gen + 1u) * nloc) {
            __builtin_amdgcn_fence(__ATOMIC_RELEASE, "agent");
            asm volatile("s_waitcnt vmcnt(0)" ::: "memory");
            const unsigned og = xb_add(&bar[XB_TOP], 1u);
            const unsigned tg = og / nx;
            if (og + 1u == (tg + 1u) * nx) xb_add(&bar[XB_TOPGEN], 1u);
            else XB_SPIN(xb_ld(&bar[XB_TOPGEN]) == tg, bar);
            __builtin_amdgcn_fence(__ATOMIC_ACQUIRE, "agent");
            xb_add(&bar[XB_XGEN(b.x)], 1u);
            asm volatile("s_waitcnt vmcnt(0)" ::: "memory");
        } else {
            XB_SPIN(xb_ld(&bar[XB_XGEN(b.x)]) == gen, bar);
            __builtin_amdgcn_fence(__ATOMIC_ACQUIRE, "agent");
            asm volatile("s_waitcnt vmcnt(0)" ::: "memory");
        }
    }
    __syncthreads();
}

#define XB_GRP(g)   (4096 + 16 * (g))
__device__ __forceinline__ void grp_barrier(unsigned* bar, unsigned g, unsigned& epoch) {
    asm volatile("s_waitcnt vmcnt(0)" ::: "memory");
    __syncthreads();
    ++epoch;
    if (threadIdx.x == 0) {
        unsigned* word = &bar[XB_GRP(g)];
        (void)xb_add(word, 1u);
        const unsigned tgt = 4u * epoch;
        XB_SPIN(xb_ld(word) < tgt, bar);
        __builtin_amdgcn_fence(__ATOMIC_ACQUIRE, "agent");
        asm volatile("s_waitcnt vmcnt(0)" ::: "memory");
    }
    __syncthreads();
}

struct Row16 { f32x4 v[4]; };
__device__ __forceinline__ int row_q(int lane, int j) { return 2 * lane + 128 * (j >> 1) + (j & 1); }
__device__ __forceinline__ void row_load_f32(Row16& r, const float* p, int lane) {
#pragma unroll
    for (int j = 0; j < 4; ++j) r.v[j] = ((const f32x4*)p)[row_q(lane, j)];
}
struct RowRaw { u32x4 w[2]; };
__device__ __forceinline__ void row_raw_load(RowRaw& r, const bf16_t* p, int lane) { r.w[0] = ((const u32x4*)p)[lane]; r.w[1] = ((const u32x4*)p)[lane + 64]; }
__device__ __forceinline__ void row_from_raw(Row16& r, const RowRaw& q) {
#pragma unroll
    for (int b = 0; b < 2; ++b) { const u32x4 w = q.w[b]; r.v[2 * b] = (f32x4){bflo(w.x), bfhi(w.x), bflo(w.y), bfhi(w.y)}; r.v[2 * b + 1] = (f32x4){bflo(w.z), bfhi(w.z), bflo(w.w), bfhi(w.w)}; }
}
__device__ __forceinline__ void row_load_bf16(Row16& r, const bf16_t* p, int lane) { RowRaw q; row_raw_load(q, p, lane); row_from_raw(r, q); }
__device__ __forceinline__ void row_store_f32(const Row16& r, float* p, int lane) {
#pragma unroll
    for (int j = 0; j < 4; ++j) pg8::store16_wt((f32x4*)p + row_q(lane, j), __builtin_bit_cast(u32x4, r.v[j]));
}
__device__ __forceinline__ void row_store_bf16(const Row16& r, bf16_t* p, int lane) {
#pragma unroll
    for (int b = 0; b < 2; ++b) { u32x4 w; w.x = cvtpk(r.v[2 * b][0], r.v[2 * b][1]); w.y = cvtpk(r.v[2 * b][2], r.v[2 * b][3]); w.z = cvtpk(r.v[2 * b + 1][0], r.v[2 * b + 1][1]); w.w = cvtpk(r.v[2 * b + 1][2], r.v[2 * b + 1][3]);
        pg8::store16_wt((u32x4*)p + lane + 64 * b, w); }
}
__device__ __forceinline__ void vec_load(Row16& r, const float* g, int lane) { row_load_f32(r, g, lane); }
__device__ __forceinline__ void row_rmsnorm_v(Row16& r, const Row16& g) {
    float s = 0.f;
#pragma unroll
    for (int j = 0; j < 4; ++j) s += r.v[j][0] * r.v[j][0] + r.v[j][1] * r.v[j][1] + r.v[j][2] * r.v[j][2] + r.v[j][3] * r.v[j][3];
    const float rs = rsqrtf(wave_sum(s) * (1.f / D) + NORM_EPS);
#pragma unroll
    for (int j = 0; j < 4; ++j) r.v[j] = r.v[j] * rs * g.v[j];
}
__device__ __forceinline__ void row_rmsnorm(Row16& r, const float* g, int lane) { Row16 gg; vec_load(gg, g, lane); row_rmsnorm_v(r, gg); }

constexpr int TR_SCR_BYTES = 64 * 65 * 4;
template <class ScaleFn>
__device__ __forceinline__ void transpose_item(const float* W, int ldw, int N, bf16_t* WT, int ldt, int row_off, int koff, LAS float* scr, int item, int lane, ScaleFn sc) {
    const int nblk = N / 64, kb = item / nblk, nb = item % nblk, k0 = 64 * kb, n0 = 64 * nb;
    const int lk = lane >> 4, ln4 = (lane & 15) * 4;
    f32x4 v[16];
#pragma unroll
    for (int i = 0; i < 16; ++i) v[i] = *(const f32x4*)(W + (size_t)(k0 + 4 * i + lk) * ldw + n0 + ln4);
#pragma unroll
    for (int i = 0; i < 16; ++i) { const int kk = 4 * i + lk; const float s = sc(k0 + kk); LAS float* d = scr + kk * 65 + ln4; d[0] = v[i][0] * s; d[1] = v[i][1] * s; d[2] = v[i][2] * s; d[3] = v[i][3] * s; }
    asm volatile("s_waitcnt lgkmcnt(0)" ::: "memory");
    const int c = lane >> 3, nn = lane & 7;
#pragma unroll
    for (int j = 0; j < 8; ++j) { const int n = nn + 8 * j; const LAS float* s = scr + (8 * c) * 65 + n;
        u32x4 o; o.x = cvtpk(s[0 * 65], s[1 * 65]); o.y = cvtpk(s[2 * 65], s[3 * 65]); o.z = cvtpk(s[4 * 65], s[5 * 65]); o.w = cvtpk(s[6 * 65], s[7 * 65]);
        pg8::store16_wt(WT + (size_t)(row_off + n0 + n) * ldt + koff + k0 + 8 * c, o); }
    asm volatile("s_waitcnt lgkmcnt(0)" ::: "memory");
}
struct ScaleOne { __device__ __forceinline__ float operator()(int) const { return 1.f; } };
struct ScaleVec { const float* g; __device__ __forceinline__ float operator()(int k) const { return g[k]; } };
struct ScaleMix { const float* mp; const float* mn; int part;
    __device__ __forceinline__ float operator()(int k) const { return part == 0 ? 1.f - mp[k] - mn[k] : (part == 1 ? mp[k] : mn[k]); } };

struct Args { const float* in[27]; float* out; unsigned char* ws; };

struct ProbPlain { const bf16_t* A; const bf16_t* Bt; int K;
    __device__ __forceinline__ const char* a_tile(const pg8::Unit& u) const { return (const char*)(A + (size_t)u.pm * 256 * K); }
    __device__ __forceinline__ const char* b_tile(const pg8::Unit& u) const { return (const char*)(Bt + (size_t)u.pn * 256 * K); } };
struct DstPlain { bf16_t* C; int ldc;
    __device__ __forceinline__ void operator()(const pg8::Unit& u, bf16_t*& base, int& ld) const { base = C + (size_t)u.pm * 256 * ldc + (size_t)u.pn * 256; ld = ldc; } };
struct ProbRKL { const unsigned char* ws; int K;
    __device__ __forceinline__ const char* a_tile(const pg8::Unit& u) const { const int g = u.pn < 4 ? 0 : (u.pn < 8 ? 1 : 2); const int ga = g == 2 ? 0 : g + 1;
        return (const char*)(ws + WS_XN + (size_t)ga * (32 * MiB) + (size_t)u.pm * 256 * D * 2); }
    __device__ __forceinline__ const char* b_tile(const pg8::Unit& u) const { const int g = u.pn < 4 ? 0 : (u.pn < 8 ? 1 : 2); const int t = u.pn - 4 * g;
        return (const char*)(ws + WS_WR_T + (size_t)g * (2 * MiB) + (size_t)t * 256 * D * 2); } };
struct DstRKL { unsigned char* ws;
    __device__ __forceinline__ void operator()(const pg8::Unit& u, bf16_t*& base, int& ld) const {
        const int g = u.pn < 4 ? 0 : (u.pn < 8 ? 1 : 2); const int t = u.pn - 4 * g; ld = g == 2 ? NLD : D;
        base = (bf16_t*)(ws + WS_R + (size_t)g * (32 * MiB)) + (size_t)u.pm * 256 * ld + (size_t)t * 256; } };


struct EpiHeadMajor {
    static constexpr bool PERM = true;
    bf16_t* O;
    __device__ __forceinline__ void operator()(const f32x4 (&acc)[2][2][4][2], const pg8::Unit& u, int wr, int wc, int fr, int fq) const {
        const int row0 = u.pm * 256 + wr * 64 + fr, col = (wc & 1) * 32 + 8 * fq;
#pragma unroll
        for (int bj = 0; bj < 2; ++bj) { bf16_t* hb = O + ((size_t)(u.pn * 4 + bj * 2 + (wc >> 1)) * M + row0) * 64 + col;
#pragma unroll
            for (int ai = 0; ai < 2; ++ai)
#pragma unroll
                for (int m = 0; m < 4; ++m) { const f32x4 v0 = acc[ai][bj][m][0], v1 = acc[ai][bj][m][1];
                    u32x4 w; w.x = cvtpk(v0[0], v0[1]); w.y = cvtpk(v0[2], v0[3]); w.z = cvtpk(v1[0], v1[1]); w.w = cvtpk(v1[2], v1[3]);
                    pg8::store16_wt(hb + (size_t)(ai * 128 + m * 16) * 64, w); } }
    }
};

template <int ACT, class Prob, class Dst>
__device__ __forceinline__ void run_gemm(LAS unsigned char* lds, const Prob& P, const Dst& Dd, int Mr, int Nv, int G) {
    pg8::StaticOrder S; S.init(Mr, Nv, G, (int)blockIdx.x);
    pg8::EpiBf16<ACT, Dst> E{Dd, nullptr};
    for (int rep = 0; rep < REP_GEMM; ++rep) pg8::gemm_phase<pg8::EpiBf16<ACT, Dst>, Prob, true, true>(lds, P, S, E);
}
template <int ACT, class Prob, class Dst>
__device__ __forceinline__ void run_gemm_rs(LAS unsigned char* lds, const Prob& P, const Dst& Dd, const float* rs, int Mr, int Nv, int G) {
    pg8::StaticOrder S; S.init(Mr, Nv, G, (int)blockIdx.x);
    pg8::EpiBf16<ACT, Dst, true> E{Dd, rs};
    pg8::gemm_phase<pg8::EpiBf16<ACT, Dst, true>, Prob, true, true>(lds, P, S, E);
}

template <bool BASE_F32, bool OUT_F32>
__device__ __forceinline__ void phase_resnorm(const void* base, const bf16_t* TMP, const float* g1, const float* g2, void* hout, bf16_t* XN, float* rs_out, int gw, int NGW, int lane) {
    Row16 G1, G2; vec_load(G1, g1, lane); if (XN) vec_load(G2, g2, lane);
    for (int row = gw; row < M; row += NGW) {
        Row16 t, b; row_load_bf16(t, TMP + (size_t)row * D, lane);
        if (BASE_F32) row_load_f32(b, (const float*)base + (size_t)row * D, lane); else row_load_bf16(b, (const bf16_t*)base + (size_t)row * D, lane);
        row_rmsnorm_v(t, G1);
#pragma unroll
        for (int j = 0; j < 4; ++j) b.v[j] = b.v[j] + t.v[j];
        if (OUT_F32) row_store_f32(b, (float*)hout + (size_t)row * D, lane); else row_store_bf16(b, (bf16_t*)hout + (size_t)row * D, lane);
        if (XN) { row_rmsnorm_v(b, G2); row_store_bf16(b, XN + (size_t)row * D, lane); }
        if (rs_out) {
            float s = 0.f;
#pragma unroll
            for (int j = 0; j < 4; ++j) s += b.v[j][0] * b.v[j][0] + b.v[j][1] * b.v[j][1] + b.v[j][2] * b.v[j][2] + b.v[j][3] * b.v[j][3];
            const float rsv = rsqrtf(wave_sum(s) * (1.f / D) + NORM_EPS);
            if (lane == 0) rs_out[row] = rsv; }
    }
}
__device__ __forceinline__ void phase_lda(const bf16_t* LDO, bf16_t* LDA, int gw, int NGW, int lane) {
    const float A = lane < 16 ? 2.f : 1.f, C = lane < 16 ? -1.f : 0.f; const bool id = lane >= 16 && lane < 32;
    for (int row = gw; row < M; row += NGW) { const int tt = row & (SEQ - 1);
        const u32x4 p0 = *(const u32x4*)(LDO + (size_t)row * NLD + 8 * lane);
        const u32x4 p1 = *(const u32x4*)(LDO + (size_t)(tt > 0 ? row - 1 : row) * NLD + 512 + 8 * lane), p2 = *(const u32x4*)(LDO + (size_t)(tt < SEQ - 1 ? row + 1 : row) * NLD + 1024 + 8 * lane);
        const float mp = tt > 0 ? 1.f : 0.f, mn = tt < SEQ - 1 ? 1.f : 0.f;
        u32x4 o;
#pragma unroll
        for (int w = 0; w < 4; ++w) { const float x0 = bflo(p0[w]) + mp * bflo(p1[w]) + mn * bflo(p2[w]), x1 = bfhi(p0[w]) + mp * bfhi(p1[w]) + mn * bfhi(p2[w]);
            const float y0 = A * __builtin_amdgcn_rcpf(1.f + __builtin_amdgcn_exp2f(-1.4426950408889634f * A * x0)) + C, y1 = A * __builtin_amdgcn_rcpf(1.f + __builtin_amdgcn_exp2f(-1.4426950408889634f * A * x1)) + C;
            o[w] = cvtpk(id ? x0 : y0, id ? x1 : y1); }
        pg8::store16_wt(LDA + (size_t)row * 512 + 8 * lane, o); }
}
__device__ __forceinline__ void mix_out(const Row16& up, const Row16& u, const Row16& un, const LAS f32x4* a, const LAS f32x4* b, bf16_t* dst, int lane) {
    Row16 o;
#pragma unroll
    for (int j = 0; j < 4; ++j) { const f32x4 av = a[j * 64 + lane], bv = b[j * 64 + lane]; o.v[j] = u.v[j] + (up.v[j] - u.v[j]) * av + (un.v[j] - u.v[j]) * bv; }
    row_store_bf16(o, dst, lane);
}
__device__ __forceinline__ void phase_mix3(LAS unsigned char* lds, const bf16_t* h, const float* g, const float* mup, const float* mun, bf16_t* XN, bf16_t* MR, bf16_t* MK, bf16_t* MV, int gw, int NGW, int tid, int lane) {
    LAS f32x4* mv = (LAS f32x4*)lds;
    __syncthreads();
    for (int x = tid; x < 6 * 256; x += NTHREADS) { const int vec = x >> 8, q = x & 255, c = vec < 2 ? 0 : (vec < 4 ? 2 : 3);
        const f32x4 val = ((const f32x4*)(((vec & 1) ? mun : mup) + c * D))[q];
        mv[vec * 256 + (2 * (q >> 7) + (q & 1)) * 64 + ((q & 127) >> 1)] = val; }
    __syncthreads();
    Row16 Gn; vec_load(Gn, g, lane);
    for (int ch = gw; ch < M / 8; ch += NGW) {
        const int r0 = ch * 8, t0 = r0 & (SEQ - 1);
        const bool hasp = t0 > 0, hasn = t0 + 8 < SEQ;
        const int rlast = hasn ? r0 + 8 : r0 + 7;
        RowRaw r0w, rA, rB, rC;
        row_raw_load(r0w, h + (size_t)(hasp ? r0 - 1 : r0) * D, lane);
        row_raw_load(rA, h + (size_t)r0 * D, lane); row_raw_load(rB, h + (size_t)(r0 + 1) * D, lane); row_raw_load(rC, h + (size_t)(r0 + 2) * D, lane);
        Row16 up, u, un;
        row_from_raw(up, r0w); row_rmsnorm_v(up, Gn);
        { const float m = hasp ? 1.f : 0.f;
#pragma unroll
          for (int j = 0; j < 4; ++j) up.v[j] = up.v[j] * m; }
        row_from_raw(u, rA); row_rmsnorm_v(u, Gn);
        rA = rB; rB = rC;
#pragma unroll 1
        for (int k = 1; k <= 8; ++k) {
            const int row = r0 - 1 + k;
            { const int nx = row + 3; row_raw_load(rC, h + (size_t)(nx < rlast ? nx : rlast) * D, lane); }
            row_from_raw(un, rA); row_rmsnorm_v(un, Gn);
            { const float m = (k == 8 && !hasn) ? 0.f : 1.f;
#pragma unroll
              for (int j = 0; j < 4; ++j) un.v[j] = un.v[j] * m; }
            row_store_bf16(u, XN + (size_t)row * D, lane);
            mix_out(up, u, un, mv, mv + 256, MR + (size_t)row * D, lane);
            mix_out(up, u, un, mv + 512, mv + 768, MK + (size_t)row * D, lane);
            mix_out(up, u, un, mv + 1024, mv + 1280, MV + (size_t)row * D, lane);
            up = u; u = un; rA = rB; rB = rC;
        }
    }
}

constexpr int ATT_ROWS = 400, ATT_KS = 0, ATT_VS = ATT_ROWS * 128, ATT_TAB = 2 * ATT_ROWS * 128, ATT_TABN = 320;
constexpr float LOG2E = 1.4426950408889634f;
typedef short v4i16_t __attribute__((ext_vector_type(4)));
__device__ __forceinline__ v4i16_t lds_tr16(LAS const unsigned char* p) { return __builtin_amdgcn_ds_read_tr16_b64_v4i16((LAS v4i16_t*)p); }

__device__ __forceinline__ float fmax_q(float a, float b) { return __builtin_amdgcn_fmed3f(a, b, __builtin_inff()); }
__device__ __forceinline__ float rows_max(float x) {
    auto a = __builtin_amdgcn_permlane16_swap(__float_as_uint(x), __float_as_uint(x), false, false); x = fmax_q(__uint_as_float(a[0]), __uint_as_float(a[1]));
    auto b = __builtin_amdgcn_permlane32_swap(__float_as_uint(x), __float_as_uint(x), false, false); return fmax_q(__uint_as_float(b[0]), __uint_as_float(b[1])); }
__device__ __forceinline__ float rows_sum(float x) {
    auto a = __builtin_amdgcn_permlane16_swap(__float_as_uint(x), __float_as_uint(x), false, false); x = __uint_as_float(a[0]) + __uint_as_float(a[1]);
    auto b = __builtin_amdgcn_permlane32_swap(__float_as_uint(x), __float_as_uint(x), false, false); return __uint_as_float(b[0]) + __uint_as_float(b[1]); }
struct AttnIO { const bf16_t* QKV; const float* rel_table; const float* sink; bf16_t* O; bf16_t* OBR; float* LSE; };
struct AttnUnitD { int b, dil, res, l0, nq, L, R, colK, colV, head0, ngroups, nit, branch, isB; };
__device__ __forceinline__ AttnUnitD attn_decode(int u) {
    AttnUnitD A;
    if (u < 256) { A.isB = 1; A.b = u >> 5; const int kvg = (u >> 4) & 1, blk = u & 15; A.dil = 1; A.res = 0; A.l0 = blk * 128; A.nq = 128; A.L = SEQ; A.R = 128; A.colK = 32 + kvg; A.colV = 34 + kvg; A.head0 = kvg * 4; A.ngroups = 32; A.nit = 9; A.branch = 0; }
    else if (u < 1280) { A.isB = 0; const int a = u - 256, bh = a >> 4, k = a & 15; A.b = bh >> 3; A.head0 = bh & 7; A.nq = 256; A.R = 64; A.ngroups = 16; A.nit = 5;
        if (k < 8) { A.dil = 1; A.res = 0; A.l0 = k * 256; A.L = SEQ; A.branch = 0; } else { A.dil = 4; A.res = (k - 8) >> 1; A.l0 = ((k - 8) & 1) * 256; A.L = SEQ / 4; A.branch = 1; }
        A.colK = 8 + A.head0; A.colV = 16 + A.head0; }
    else { A.isB = 0; const int a = u - 1280, bh = a >> 4; A.b = bh >> 3; A.head0 = bh & 7; A.dil = 16; A.res = a & 15; A.l0 = 0; A.nq = 128; A.L = SEQ / 16; A.R = 64; A.ngroups = 8; A.nit = 5; A.branch = 2; A.colK = 8 + A.head0; A.colV = 16 + A.head0; }
    return A;
}
constexpr int ATT_NST = 7;
__device__ __forceinline__ void attn_issue(const AttnUnitD& A, const bf16_t* QKV, int tid, u32x4 (&kr)[ATT_NST], u32x4 (&vr)[ATT_NST]) {
    const int ndata = A.nq + 2 * A.R, rv0 = (A.R - A.l0) > 0 ? (A.R - A.l0) : 0, rv1 = (A.L + A.R - A.l0) < ndata ? (A.L + A.R - A.l0) : ndata;
    const bf16_t* kb = QKV + ((size_t)A.colK * M + (size_t)A.b * SEQ) * 64; const bf16_t* vb = QKV + ((size_t)A.colV * M + (size_t)A.b * SEQ) * 64;
#pragma unroll
    for (int i = 0; i < ATT_NST; ++i) { const int x = tid + NTHREADS * i, c = x & 7; int row = x >> 3; row = row < rv0 ? rv0 : (row >= rv1 ? rv1 - 1 : row);
        const size_t o = (size_t)(A.res + A.dil * (A.l0 - A.R + row)) * 64 + c * 8; kr[i] = *(const u32x4*)(kb + o); vr[i] = *(const u32x4*)(vb + o); }
}

__device__ __forceinline__ void phase_attn(LAS unsigned char* lds, const AttnIO& io, int vcu, int G) {
    int tid = threadIdx.x; asm volatile("" : "+v"(tid));
    const int lane = tid & 63, wid = __builtin_amdgcn_readfirstlane(tid >> 6), g4 = lane >> 4, qi = lane & 15;
    LAS unsigned char* Ks = lds + ATT_KS; LAS unsigned char* Vs = lds + ATT_VS; LAS float* tab = (LAS float*)(lds + ATT_TAB);
    constexpr int NU = 256 + 1024 + 1024;
    u32x4 kr[ATT_NST], vr[ATT_NST];
    if (vcu < NU) { const AttnUnitD A0 = attn_decode(vcu); attn_issue(A0, io.QKV, tid, kr, vr); }
    for (int u = vcu; u < NU; u += G) {
        const AttnUnitD A = attn_decode(u);
        const int b = A.b, dil = A.dil, res = A.res, l0 = A.l0, R = A.R, head0 = A.head0, ngroups = A.ngroups, nit = A.nit, branch = A.branch; const bool isB = A.isB != 0;
        const int ndata = A.nq + 2 * R, rv0 = (R - l0) > 0 ? (R - l0) : 0, rv1 = (A.L + R - l0) < ndata ? (A.L + R - l0) : ndata;
        auto qptr = [&](int gx) -> const bf16_t* { const int hq_ = isB ? (gx >> 3) : 0, gi_ = isB ? (gx & 7) : gx; const int posq_ = res + dil * (l0 + 16 * gi_ + qi);
            return io.QKV + ((size_t)((isB ? 24 : 0) + head0 + hq_) * M + (size_t)b * SEQ + posq_) * 64 + 8 * g4; };
        u32x4 qr0, qr1; { const bf16_t* qp0 = qptr(wid); qr0 = *(const u32x4*)qp0; qr1 = *(const u32x4*)(qp0 + 32); }
        for (int reps = 0; reps < REP_ATTS; ++reps) {
        __syncthreads();
#pragma unroll
        for (int i = 0; i < ATT_NST; ++i) { const int x = tid + NTHREADS * i, row = x >> 3, c = x & 7;
            if (x < ATT_ROWS * 8) { const int off = row * 128 + ((c ^ (row & 7)) << 4); const bool ok = row >= rv0 && row < rv1; const u32x4 z = (u32x4){0u, 0u, 0u, 0u};
                *(LAS u32x4*)(Ks + off) = ok ? kr[i] : z; *(LAS u32x4*)(Vs + off) = ok ? vr[i] : z; } }
        { const int ntab = isB ? 4 : 1;
          for (int x = tid; x < ntab * ATT_TABN; x += NTHREADS) { const int t = x / ATT_TABN, j = x % ATT_TABN, idx = j - 16;
              float v = -1e30f;
              if (idx >= 0 && idx <= 2 * R) v = io.rel_table[t5_bucket((idx - R) * dil) * 16 + (isB ? 8 + head0 + t : head0)] * LOG2E;
              tab[x] = v; } }
        }
        if (u + G < NU) { const AttnUnitD An = attn_decode(u + G); attn_issue(An, io.QKV, tid, kr, vr); }
        __syncthreads();
        for (int rep = 0; rep < REP_ATTC; ++rep)
        for (int gidx = wid; gidx < ngroups; gidx += NWAVES) {
            const int hq = isB ? (gidx >> 3) : 0, gi = isB ? (gidx & 7) : gidx, head = head0 + hq;
            const int ql = 16 * gi + qi, posq = res + dil * (l0 + ql);
            const LAS float* tb = tab + hq * ATT_TABN + 16;
            bf16x8 qf[2];
            { const u32x4 wq[2] = {qr0, qr1}; const float SC = 0.125f * LOG2E;
              { const int gn = gidx + NWAVES < ngroups ? gidx + NWAVES : gidx; const bf16_t* qpn = qptr(gn); qr0 = *(const u32x4*)qpn; qr1 = *(const u32x4*)(qpn + 32); }
#pragma unroll
              for (int ks = 0; ks < 2; ++ks) { const u32x4 w = wq[ks]; u32x4 o;
                  o.x = cvtpk(bflo(w.x) * SC, bfhi(w.x) * SC); o.y = cvtpk(bflo(w.y) * SC, bfhi(w.y) * SC); o.z = cvtpk(bflo(w.z) * SC, bfhi(w.z) * SC); o.w = cvtpk(bflo(w.w) * SC, bfhi(w.w) * SC);
                  qf[ks] = __builtin_bit_cast(bf16x8, o); } }
            f32x4 ot[4], lacc = (f32x4){0.f, 0.f, 0.f, 0.f};
#pragma unroll
            for (int dt = 0; dt < 4; ++dt) ot[dt] = (f32x4){0.f, 0.f, 0.f, 0.f};
            float m = -1e20f;
            const bf16x8 ones = __builtin_bit_cast(bf16x8, qi == 0 ? (u32x4){0x3F803F80u, 0x3F803F80u, 0x3F803F80u, 0x3F803F80u} : (u32x4){0u, 0u, 0u, 0u});
            bf16x8 kf[2][2];
            const LAS unsigned char* kp[2];
            { const int r0 = 16 * gi + qi;
#pragma unroll
              for (int ks = 0; ks < 2; ++ks) { const int c = g4 + 4 * ks; kp[ks] = Ks + r0 * 128 + ((c ^ (r0 & 7)) << 4); asm volatile("" : "+v"(kp[ks]));
                  kf[ks][0] = *(const LAS bf16x8*)(kp[ks]); kf[ks][1] = *(const LAS bf16x8*)(kp[ks] + 16 * 128); } }
            const LAS unsigned char* vp[4];
            { const int ra0 = 16 * gi + 4 * g4 + (qi >> 2);
#pragma unroll
              for (int dt = 0; dt < 4; ++dt) { const int ch = dt * 2 + ((qi & 3) >> 1); vp[dt] = Vs + ra0 * 128 + ((ch ^ (ra0 & 7)) << 4) + 8 * (qi & 1); asm volatile("" : "+v"(vp[dt])); } }
            const LAS float* tbq = tb + 4 * g4 - qi; asm volatile("" : "+v"(tbq));
            f32x4 c0, c1;
#pragma unroll
            for (int r = 0; r < 4; ++r) { c0[r] = tbq[r]; c1[r] = tbq[16 + r]; }
            for (int it = 0; it < nit; ++it) {
                const int rb = 16 * gi + 32 * it;
                v4i16_t vlo[4], vhi[4];
#pragma unroll
                for (int dt = 0; dt < 4; ++dt) { vlo[dt] = lds_tr16(vp[dt]); vhi[dt] = lds_tr16(vp[dt] + 16 * 128); vp[dt] += 4096; }
                f32x4 s0 = c0, s1 = c1;
#pragma unroll
                for (int ks = 0; ks < 2; ++ks) { s0 = __builtin_amdgcn_mfma_f32_16x16x32_bf16(kf[ks][0], qf[ks], s0, 0, 0, 0); s1 = __builtin_amdgcn_mfma_f32_16x16x32_bf16(kf[ks][1], qf[ks], s1, 0, 0, 0); }
                if (it + 1 < nit) {
#pragma unroll
                    for (int ks = 0; ks < 2; ++ks) { kp[ks] += 4096; kf[ks][0] = *(const LAS bf16x8*)(kp[ks]); kf[ks][1] = *(const LAS bf16x8*)(kp[ks] + 16 * 128); } }
                tbq += 32;
#pragma unroll
                for (int r = 0; r < 4; ++r) { c0[r] = tbq[r]; c1[r] = tbq[16 + r]; }
                float v[8];
                if (rb < rv0 || rb + 32 > rv1) {
#pragma unroll
                    for (int r = 0; r < 4; ++r) { const int row0 = rb + 4 * g4 + r, row1 = row0 + 16;
                        const bool ok0 = (unsigned)(row0 - rv0) < (unsigned)(rv1 - rv0), ok1 = (unsigned)(row1 - rv0) < (unsigned)(rv1 - rv0);
                        v[r] = ok0 ? s0[r] : -1e30f; v[4 + r] = ok1 ? s1[r] : -1e30f; }
                } else {
#pragma unroll
                    for (int r = 0; r < 4; ++r) { v[r] = s0[r]; v[4 + r] = s1[r]; }
                }
                float d[8];
#pragma unroll
                for (int i = 0; i < 8; ++i) d[i] = v[i] - m;
                const float dm = fmaxf(fmaxf(fmaxf(d[0], d[1]), fmaxf(d[2], d[3])), fmaxf(fmaxf(d[4], d[5]), fmaxf(d[6], d[7])));
                if (__builtin_amdgcn_ballot_w64(dm > 8.f) != 0ull) {
                    float tmax = fmaxf(fmaxf(fmaxf(v[0], v[1]), fmaxf(v[2], v[3])), fmaxf(fmaxf(v[4], v[5]), fmaxf(v[6], v[7])));
                    tmax = rows_max(tmax);
                    const float mn = fmaxf(m, tmax), alpha = __builtin_amdgcn_exp2f(m - mn); m = mn;
                    lacc[0] = lacc[0] * alpha;
#pragma unroll
                    for (int dt = 0; dt < 4; ++dt) ot[dt] = ot[dt] * alpha;
#pragma unroll
                    for (int i = 0; i < 8; ++i) d[i] = v[i] - mn;
                }
#pragma unroll
                for (int i = 0; i < 8; ++i) v[i] = __builtin_amdgcn_exp2f(d[i]);
                u32x4 pw; pw.x = cvtpk(v[0], v[1]); pw.y = cvtpk(v[2], v[3]); pw.z = cvtpk(v[4], v[5]); pw.w = cvtpk(v[6], v[7]);
                const bf16x8 pf = __builtin_bit_cast(bf16x8, pw);
                lacc = __builtin_amdgcn_mfma_f32_16x16x32_bf16(ones, pf, lacc, 0, 0, 0);
#pragma unroll
                for (int dt = 0; dt < 4; ++dt) { const bf16x8 vf = (bf16x8){vlo[dt][0], vlo[dt][1], vlo[dt][2], vlo[dt][3], vhi[dt][0], vhi[dt][1], vhi[dt][2], vhi[dt][3]};
                    ot[dt] = __builtin_amdgcn_mfma_f32_16x16x32_bf16(vf, pf, ot[dt], 0, 0, 0); }
            }
            float lsum = lacc[0];
            lsum = rows_sum(lsum);
            const size_t tok = (size_t)b * SEQ + posq;
            float scale;
            if (isB) { const float s2 = io.sink[head] * LOG2E, mf = fmaxf(m, s2), e = __builtin_amdgcn_exp2f(m - mf); scale = e / (lsum * e + __builtin_amdgcn_exp2f(s2 - mf)); }
            else { scale = 1.f / lsum; if (g4 == 0) io.LSE[((size_t)branch * M + tok) * 8 + head] = m + __builtin_amdgcn_logf(lsum); }
            bf16_t* op = isB ? io.O + tok * D + 512 + head * 64 : io.OBR + ((size_t)branch * M + tok) * 512 + head * 64;
#pragma unroll
            for (int dt = 0; dt < 4; ++dt) { const f32x4 o = ot[dt] * scale; u32x2 w; w.x = cvtpk(o[0], o[1]); w.y = cvtpk(o[2], o[3]); *(u32x2*)(op + dt * 16 + 4 * g4) = w; }
        }
    }
}
__device__ __forceinline__ void phase_attn_merge(const AttnIO& io, int gtid, int NGT) {
    for (int x = gtid; x < M * 64; x += NGT) { const int tok = x >> 6, head = (x >> 3) & 7, c8 = x & 7;
        const float l0 = io.LSE[((size_t)0 * M + tok) * 8 + head], l1 = io.LSE[((size_t)1 * M + tok) * 8 + head], l2 = io.LSE[((size_t)2 * M + tok) * 8 + head];
        const float mx = fmaxf(l0, fmaxf(l1, l2)); float w0 = __builtin_amdgcn_exp2f(l0 - mx), w1 = __builtin_amdgcn_exp2f(l1 - mx), w2 = __builtin_amdgcn_exp2f(l2 - mx);
        const float inv = 1.f / (w0 + w1 + w2); w0 *= inv; w1 *= inv; w2 *= inv;
        const size_t o = (size_t)tok * 512 + head * 64 + c8 * 8;
        const u32x4 a = *(const u32x4*)(io.OBR + o), bq = *(const u32x4*)(io.OBR + (size_t)M * 512 + o), c = *(const u32x4*)(io.OBR + (size_t)2 * M * 512 + o);
        u32x4 r;
        r.x = pk2(w0 * bflo(a.x) + w1 * bflo(bq.x) + w2 * bflo(c.x), w0 * bfhi(a.x) + w1 * bfhi(bq.x) + w2 * bfhi(c.x));
        r.y = pk2(w0 * bflo(a.y) + w1 * bflo(bq.y) + w2 * bflo(c.y), w0 * bfhi(a.y) + w1 * bfhi(bq.y) + w2 * bfhi(c.y));
        r.z = pk2(w0 * bflo(a.z) + w1 * bflo(bq.z) + w2 * bflo(c.z), w0 * bfhi(a.z) + w1 * bfhi(bq.z) + w2 * bfhi(c.z));
        r.w = pk2(w0 * bflo(a.w) + w1 * bflo(bq.w) + w2 * bflo(c.w), w0 * bfhi(a.w) + w1 * bfhi(bq.w) + w2 * bfhi(c.w));
        pg8::store16_wt(io.O + (size_t)tok * D + head * 64 + c8 * 8, r); }
}

constexpr int NCH = SEQ / 16;
constexpr int SC_LROW = 68, SC_LDROW = 528, SC_LSLOT = 4 * 16 * SC_LROW * 4 + 16 * SC_LDROW;
constexpr int CT_KHT = 0, CT_RHT = 2048, CT_BTT = 4096, CT_KTT = 6144, CT_VT = 8192, CT_WEND = 10240, CT_RKT = CT_WEND + 256, CT_SLOT = CT_RKT + 2048;
constexpr int GT_AKK = 0, GT_BB = 512, GT_BK = 1024, GT_TT = 1536, GT_SLOT = 2048;
constexpr int SC_LBUF = 0, SC_CT = SC_LBUF + 2 * SC_LSLOT, SC_GG = SC_CT + 3 * CT_SLOT, SC_RKR = SC_GG + 4 * 4096, SC_GT = SC_RKR + 4 * 256, SC_NB = SC_GT + 2 * GT_SLOT, SC_OUT = SC_NB + 1024, SC_END = SC_OUT + 2 * 4096;
static_assert(SC_END <= LDSCTL_OFF, "scan LDS map");
template <int CTRL> __device__ __forceinline__ float dpp_f(float x) { return __int_as_float(__builtin_amdgcn_update_dpp(0, __float_as_int(x), CTRL, 0xf, 0xf, true)); }
__device__ __forceinline__ float sum8(float x) { x += dpp_f<0xB1>(x); x += dpp_f<0x4E>(x); x += dpp_f<0x141>(x); return x; }
__device__ __forceinline__ float sum16(float x) { x += dpp_f<0xB1>(x); x += dpp_f<0x4E>(x); x += dpp_f<0x141>(x); x += dpp_f<0x140>(x); return x; }
__device__ __forceinline__ float fast_sigmoid(float z) { return __builtin_amdgcn_rcpf(1.f + __builtin_amdgcn_exp2f(-LOG2E * z)); }
__device__ __forceinline__ bf16x8 mk8(unsigned a, unsigned b, unsigned c, unsigned d) { return __builtin_bit_cast(bf16x8, (u32x4){a, b, c, d}); }

struct ScanPtrs { const bf16_t *R, *Kk, *V, *LDA; bf16_t* Y; const float *w2, *a2, *g2, *w0, *a0, *k_k, *k_a, *r_k, *gn_w, *gn_b; };
__device__ __forceinline__ void phase_scan(LAS unsigned char* lds, const ScanPtrs& P, int G) {
    int tid = threadIdx.x; asm volatile("" : "+v"(tid));
    const int lane = tid & 63, wid = __builtin_amdgcn_readfirstlane(tid >> 6), g4 = lane >> 4, c16 = lane & 15;
    for (int unit = blockIdx.x; unit < 256; unit += G) {
        const int b = unit >> 5, h = (unit >> 1) & 15, d = unit & 1, hc = h * 64;
        unsigned long long wait_acc = 0ull;
        __syncthreads();
        if (wid < 4) {
            f32x4 ST[4];
#pragma unroll
            for (int mt = 0; mt < 4; ++mt) ST[mt] = (f32x4){0.f, 0.f, 0.f, 0.f};
            const int pch = hc + 8 * (lane & 7);
            const f32x4 gw0 = *(const f32x4*)(P.gn_w + pch), gw1 = *(const f32x4*)(P.gn_w + pch + 4), gb0 = *(const f32x4*)(P.gn_b + pch), gb1 = *(const f32x4*)(P.gn_b + pch + 4);
            u32x4 pvA = {0u, 0u, 0u, 0u}, pvB = pvA;
            auto issueV = [&](int ch_, u32x4& dst) { const int s = 8 * (wid - 1) + (lane >> 3), t = d ? (SEQ - 1 - (ch_ * 16 + s)) : (ch_ * 16 + s); dst = *(const u32x4*)(P.V + ((size_t)b * SEQ + t) * D + pch); };
            if (wid == 1 || wid == 2) { issueV(0, pvA); issueV(1, pvB); }
            auto sw_interval = [&](int i, u32x4& pvset) {
                const int c = i - 3;
                int ln = lane; asm volatile("" : "+v"(ln)); const int g4 = ln >> 4, c16 = ln & 15;
                if (c >= 0 && c < NCH) {
                    const LAS unsigned char* Ct = lds + SC_CT + (c % 3) * CT_SLOT; const LAS unsigned char* Gt = lds + SC_GT + (c & 1) * GT_SLOT;
                    v4i16_t kha[2][2], rha[2][2];
#pragma unroll
                    for (int p = 0; p < 2; ++p)
#pragma unroll
                        for (int hh = 0; hh < 2; ++hh) { const int off = (32 * p + 16 * hh + 4 * g4 + (c16 >> 2)) * 32 + 8 * (c16 & 3); kha[p][hh] = lds_tr16(Ct + CT_KHT + off); rha[p][hh] = lds_tr16(Ct + CT_RHT + off); }
                    const u32x2 gakk = *(const LAS u32x2*)(Gt + GT_AKK + c16 * 32 + 8 * g4), gtt = *(const LAS u32x2*)(Gt + GT_TT + c16 * 32 + 8 * g4);
                    const u32x2 gbb = *(const LAS u32x2*)(Gt + GT_BB + c16 * 32 + 8 * g4), gbk = *(const LAS u32x2*)(Gt + GT_BK + c16 * 32 + 8 * g4);
                    const u32x2 vt = *(const LAS u32x2*)(Ct + CT_VT + (16 * wid + c16) * 32 + 8 * g4);
                    u32x2 btt[4], ktt[4]; f32x4 we[4];
#pragma unroll
                    for (int mt = 0; mt < 4; ++mt) { btt[mt] = *(const LAS u32x2*)(Ct + CT_BTT + (16 * mt + c16) * 32 + 8 * g4); ktt[mt] = *(const LAS u32x2*)(Ct + CT_KTT + (16 * mt + c16) * 32 + 8 * g4);
                        we[mt] = *(const LAS f32x4*)(Ct + CT_WEND + (16 * mt + 4 * g4) * 4); }
                    f32x4 pt = {0.f, 0.f, 0.f, 0.f}, prt = pt;
#pragma unroll
                    for (int p = 0; p < 2; ++p) { const bf16x8 sb = mk8(cvtpk(ST[2 * p][0], ST[2 * p][1]), cvtpk(ST[2 * p][2], ST[2 * p][3]), cvtpk(ST[2 * p + 1][0], ST[2 * p + 1][1]), cvtpk(ST[2 * p + 1][2], ST[2 * p + 1][3]));
                        pt = __builtin_amdgcn_mfma_f32_16x16x32_bf16((bf16x8){kha[p][0][0], kha[p][0][1], kha[p][0][2], kha[p][0][3], kha[p][1][0], kha[p][1][1], kha[p][1][2], kha[p][1][3]}, sb, pt, 0, 0, 0);
                        prt = __builtin_amdgcn_mfma_f32_16x16x32_bf16((bf16x8){rha[p][0][0], rha[p][0][1], rha[p][0][2], rha[p][0][3], rha[p][1][0], rha[p][1][1], rha[p][1][2], rha[p][1][3]}, sb, prt, 0, 0, 0); }
                    const f32x4 qt = __builtin_amdgcn_mfma_f32_16x16x32_bf16(mk8(gakk.x, gakk.y, 0u, 0u), mk8(vt.x, vt.y, 0u, 0u), pt, 0, 0, 0);
                    const f32x4 sat = __builtin_amdgcn_mfma_f32_16x16x32_bf16(mk8(gtt.x, gtt.y, 0u, 0u), mk8(cvtpk(qt[0], qt[1]), cvtpk(qt[2], qt[3]), 0u, 0u), (f32x4){0.f, 0.f, 0.f, 0.f}, 0, 0, 0);
                    const bf16x8 sv = mk8(cvtpk(sat[0], sat[1]), cvtpk(sat[2], sat[3]), vt.x, vt.y);
                    const f32x4 outt = __builtin_amdgcn_mfma_f32_16x16x32_bf16(mk8(gbb.x, gbb.y, gbk.x, gbk.y), sv, prt, 0, 0, 0);
#pragma unroll
                    for (int mt = 0; mt < 4; ++mt) { ST[mt] = __builtin_amdgcn_mfma_f32_16x16x32_bf16(mk8(btt[mt].x, btt[mt].y, ktt[mt].x, ktt[mt].y), sv, ST[mt], 0, 0, 0); ST[mt] = ST[mt] * we[mt]; }
                    LAS float* ob = (LAS float*)(lds + SC_OUT + (c & 1) * 4096) + 16 * wid + c16;
#pragma unroll
                    for (int r = 0; r < 4; ++r) ob[(4 * g4 + r) * 64] = outt[r];
                }
                for (int rep_ = 0; rep_ < REP_ST; ++rep_)
                if (i >= 2 && i - 2 < NCH) {
                    const int jg = i - 2, hw = wid;
                    const LAS unsigned char* Ct = lds + SC_CT + (jg % 3) * CT_SLOT; LAS unsigned char* Gt = lds + SC_GT + (jg & 1) * GT_SLOT;
                    const int aoff = (hw & 1) ? CT_KTT : CT_BTT, boff = (hw & 2) ? CT_RHT : CT_KHT;
                    f32x4 gm = {0.f, 0.f, 0.f, 0.f}, gmT = gm;
#pragma unroll
                    for (int ks = 0; ks < 2; ++ks) { const int o1 = (8 * g4 + 32 * ks + (c16 >> 2)) * 32 + 8 * (c16 & 3), o2 = o1 + 4 * 32;
                        const v4i16_t a0 = lds_tr16(Ct + aoff + o1), a1 = lds_tr16(Ct + aoff + o2), b0 = lds_tr16(Ct + boff + o1), b1 = lds_tr16(Ct + boff + o2);
                        const bf16x8 af = {a0[0], a0[1], a0[2], a0[3], a1[0], a1[1], a1[2], a1[3]}, bfr = {b0[0], b0[1], b0[2], b0[3], b1[0], b1[1], b1[2], b1[3]};
                        gm = __builtin_amdgcn_mfma_f32_16x16x32_bf16(af, bfr, gm, 0, 0, 0);
                        if (hw == 0) gmT = __builtin_amdgcn_mfma_f32_16x16x32_bf16(bfr, af, gmT, 0, 0, 0); }
                    if (hw == 3) {
                        const bf16x8 onesB = __builtin_bit_cast(bf16x8, c16 == 0 ? (u32x4){0x3F803F80u, 0x3F803F80u, 0x3F803F80u, 0x3F803F80u} : (u32x4){0u, 0u, 0u, 0u});
                        f32x4 rk = {0.f, 0.f, 0.f, 0.f};
#pragma unroll
                        for (int ks = 0; ks < 2; ++ks) { const int o1 = (8 * g4 + 32 * ks + (c16 >> 2)) * 32 + 8 * (c16 & 3), o2 = o1 + 4 * 32;
                            const v4i16_t r0 = lds_tr16(Ct + CT_RKT + o1), r1 = lds_tr16(Ct + CT_RKT + o2);
                            rk = __builtin_amdgcn_mfma_f32_16x16x32_bf16((bf16x8){r0[0], r0[1], r0[2], r0[3], r1[0], r1[1], r1[2], r1[3]}, onesB, rk, 0, 0, 0); }
                        if (c16 == 0) ((LAS f32x4*)(lds + SC_RKR + (jg & 3) * 256))[g4] = rk; }
#pragma unroll
                    for (int r = 0; r < 4; ++r) { const int s = 4 * g4 + r; const bool keep = (hw & 2) ? (s <= c16) : (s < c16); gm[r] = keep ? gm[r] : 0.f; gmT[r] = (c16 < s) ? gmT[r] : 0.f; }
                    if (hw != 0) { *(LAS u32x2*)(Gt + (hw == 1 ? GT_AKK : (hw == 2 ? GT_BB : GT_BK)) + c16 * 32 + 8 * g4) = (u32x2){cvtpk(gm[0], gm[1]), cvtpk(gm[2], gm[3])}; }
                    else {
#define SC_OPA(x) mk8(cvtpk((x)[0], (x)[1]), cvtpk((x)[2], (x)[3]), 0u, 0u)
                        const f32x4 z4 = {0.f, 0.f, 0.f, 0.f};
                        f32x4 Rm, RTm;
#pragma unroll
                        for (int r = 0; r < 4; ++r) { const float idn = (4 * g4 + r == c16) ? 1.f : 0.f; Rm[r] = idn - gm[r]; RTm[r] = idn - gmT[r]; }
                        const f32x4 N2 = __builtin_amdgcn_mfma_f32_16x16x32_bf16(SC_OPA(gmT), SC_OPA(gm), z4, 0, 0, 0), N2T = __builtin_amdgcn_mfma_f32_16x16x32_bf16(SC_OPA(gm), SC_OPA(gmT), z4, 0, 0, 0);
                        f32x4 R1 = __builtin_amdgcn_mfma_f32_16x16x32_bf16(SC_OPA(RTm), SC_OPA(N2), Rm, 0, 0, 0), R1T = __builtin_amdgcn_mfma_f32_16x16x32_bf16(SC_OPA(N2), SC_OPA(RTm), RTm, 0, 0, 0);
                        const f32x4 N4 = __builtin_amdgcn_mfma_f32_16x16x32_bf16(SC_OPA(N2T), SC_OPA(N2), z4, 0, 0, 0), N4T = __builtin_amdgcn_mfma_f32_16x16x32_bf16(SC_OPA(N2), SC_OPA(N2T), z4, 0, 0, 0);
                        f32x4 R2 = __builtin_amdgcn_mfma_f32_16x16x32_bf16(SC_OPA(R1T), SC_OPA(N4), R1, 0, 0, 0), R2T = __builtin_amdgcn_mfma_f32_16x16x32_bf16(SC_OPA(N4), SC_OPA(R1T), R1T, 0, 0, 0);
                        const f32x4 N8 = __builtin_amdgcn_mfma_f32_16x16x32_bf16(SC_OPA(N4T), SC_OPA(N4), z4, 0, 0, 0);
                        const f32x4 Tm = __builtin_amdgcn_mfma_f32_16x16x32_bf16(SC_OPA(R2T), SC_OPA(N8), R2, 0, 0, 0);
#undef SC_OPA
                        *(LAS u32x2*)(Gt + GT_TT + c16 * 32 + 8 * g4) = (u32x2){cvtpk(-Tm[0], -Tm[1]), cvtpk(-Tm[2], -Tm[3])};
                    }
                }
                if ((wid == 1 || wid == 2) && i >= 4 && i - 4 < NCH) {
                    const int jp = i - 4, tl = ln >> 3, c8 = ln & 7;
                    const int s = 8 * (wid - 1) + tl, t = d ? (SEQ - 1 - (jp * 16 + s)) : (jp * 16 + s);
                    const LAS float* ob = (const LAS float*)(lds + SC_OUT + (jp & 1) * 4096) + s * 64 + 8 * c8; const LAS float* gp = (const LAS float*)(lds + SC_GG + (jp & 3) * 4096) + s * 64 + 8 * c8;
                    const f32x4 o0 = *(const LAS f32x4*)(ob), o1 = *(const LAS f32x4*)(ob + 4), g0 = *(const LAS f32x4*)(gp), g1 = *(const LAS f32x4*)(gp + 4);
                    const float rkr = ((const LAS float*)(lds + SC_RKR + (jp & 3) * 256))[s];
                    const u32x4 pv = pvset;
                    const f32x4 v0 = {bflo(pv.x), bfhi(pv.x), bflo(pv.y), bfhi(pv.y)}, v1 = {bflo(pv.z), bfhi(pv.z), bflo(pv.w), bfhi(pv.w)};
                    float mu = ((o0[0] + o0[1]) + (o0[2] + o0[3])) + ((o1[0] + o1[1]) + (o1[2] + o1[3])); mu = sum8(mu) * (1.f / 64.f);
                    const f32x4 d0 = o0 - mu, d1 = o1 - mu; float var = ((d0[0] * d0[0] + d0[1] * d0[1]) + (d0[2] * d0[2] + d0[3] * d0[3])) + ((d1[0] * d1[0] + d1[1] * d1[1]) + (d1[2] * d1[2] + d1[3] * d1[3])); var = sum8(var) * (1.f / 64.f);
                    const float rs = rsqrtf(var + GN_EPS);
                    const f32x4 y0 = (d0 * rs * gw0 + gb0 + rkr * v0) * g0, y1 = (d1 * rs * gw1 + gb1 + rkr * v1) * g1;
                    pg8::store16_wt(P.Y + ((size_t)b * SEQ + t) * (2 * D) + d * D + hc + 8 * c8, (u32x4){cvtpk(y0[0], y0[1]), cvtpk(y0[2], y0[3]), cvtpk(y1[0], y1[1]), cvtpk(y1[2], y1[3])});
                    issueV(jp + 2 < NCH ? jp + 2 : NCH - 1, pvset);
                }
                for (int rep_ = 0; rep_ < REP_SYNC; ++rep_) __syncthreads();
                if (WAITPROBE >= 0) { const unsigned long long t0_ = __builtin_amdgcn_s_memrealtime(); __syncthreads(); wait_acc += __builtin_amdgcn_s_memrealtime() - t0_; } else
                __syncthreads();
            };
            static_assert((NCH + 4) % 2 == 0, "interval loop is unrolled by two");
            __builtin_amdgcn_s_setprio(2);
            for (int i = 0; i < NCH + 4; i += 2) { sw_interval(i, pvA); sw_interval(i + 1, pvB); }
            __builtin_amdgcn_s_setprio(0);
        } else {
            const int hw = wid - 4;
            const int chC = hc + 16 * hw + c16, chT = hc + 4 * c16;
            bf16x8 bw[2], ba[2], bg[4];
#pragma unroll
            for (int ks = 0; ks < 2; ++ks) { u32x4 w, a;
#pragma unroll
                for (int jj = 0; jj < 4; ++jj) { const int k = 32 * ks + 8 * g4 + 2 * jj;
                    w[jj] = pk2(-LOG2E * P.w2[(size_t)(d * 64 + k) * D + chC], -LOG2E * P.w2[(size_t)(d * 64 + k + 1) * D + chC]); a[jj] = pk2(-LOG2E * P.a2[(size_t)(d * 64 + k) * D + chC], -LOG2E * P.a2[(size_t)(d * 64 + k + 1) * D + chC]); }
                bw[ks] = __builtin_bit_cast(bf16x8, w); ba[ks] = __builtin_bit_cast(bf16x8, a); }
#pragma unroll
            for (int ks = 0; ks < 4; ++ks) { u32x4 g;
#pragma unroll
                for (int jj = 0; jj < 4; ++jj) { const int k = 32 * ks + 8 * g4 + 2 * jj; g[jj] = pk2(P.g2[(size_t)(d * 128 + k) * D + chC], P.g2[(size_t)(d * 128 + k + 1) * D + chC]); }
                bg[ks] = __builtin_bit_cast(bf16x8, g); }
            const float w0c = -LOG2E * P.w0[d * D + chC], a0c = -LOG2E * P.a0[d * D + chC], kaC = P.k_a[chC], rkC = P.r_k[chC];
            const f32x4 kkT = *(const f32x4*)(P.k_k + chT);
            const int n0 = 16 * c16, lcol = n0 < 64 ? (d * 64 + n0) : (n0 < 128 ? (128 + d * 64 + (n0 - 64)) : (256 + d * 128 + (n0 - 128)));
            struct LSet { u32x2 r, k, v; u32x4 l0, l1; };
            LSet setA, setB;
            auto issueL = [&](int ch_, LSet& S) { const int s = 4 * hw + g4, t = d ? (SEQ - 1 - (ch_ * 16 + s)) : (ch_ * 16 + s); const size_t row = (size_t)b * SEQ + t;
                S.r = *(const u32x2*)(P.R + row * D + chT); S.k = *(const u32x2*)(P.Kk + row * D + chT); S.v = *(const u32x2*)(P.V + row * D + chT);
                S.l0 = *(const u32x4*)(P.LDA + row * 512 + lcol); S.l1 = *(const u32x4*)(P.LDA + row * 512 + lcol + 8); };
            issueL(0, setA); issueL(1, setB);
            auto hw_interval = [&](int i, LSet& LS) {
                const bool doL = i < NCH, doC = (i >= 1 && i - 1 < NCH);
                int ln = lane; asm volatile("" : "+v"(ln)); const int g4 = ln >> 4, c16 = ln & 15;
                const unsigned long long tb_ = (SECPROBE >= 0) ? __builtin_amdgcn_s_memrealtime() : 0ull;
                for (int rep_ = 0; rep_ < REP_HC; ++rep_)
                if (doC) {
                    const int jc = i - 1;
                    const LAS unsigned char* Ls = lds + SC_LBUF + (jc & 1) * SC_LSLOT;
                    const LAS unsigned char* ldp = Ls + 4 * 16 * SC_LROW * 4 + c16 * SC_LDROW + 16 * g4;
                    f32x4 zw = {w0c, w0c, w0c, w0c}, za = {a0c, a0c, a0c, a0c}, gg = {0.f, 0.f, 0.f, 0.f};
#pragma unroll
                    for (int ks = 0; ks < 2; ++ks) { zw = __builtin_amdgcn_mfma_f32_16x16x32_bf16(*(const LAS bf16x8*)(ldp + 64 * ks), bw[ks], zw, 0, 0, 0);
                                                     za = __builtin_amdgcn_mfma_f32_16x16x32_bf16(*(const LAS bf16x8*)(ldp + 128 + 64 * ks), ba[ks], za, 0, 0, 0); }
#pragma unroll
                    for (int ks = 0; ks < 4; ++ks) gg = __builtin_amdgcn_mfma_f32_16x16x32_bf16(*(const LAS bf16x8*)(ldp + 256 + 64 * ks), bg[ks], gg, 0, 0, 0);
                    float lw[4], cw[4]; float tot = 0.f;
#pragma unroll
                    for (int r = 0; r < 4; ++r) { lw[r] = (-0.6065306597f * LOG2E) * __builtin_amdgcn_rcpf(1.f + __builtin_amdgcn_exp2f(zw[r])); tot += lw[r]; cw[r] = tot; }
                    float pre;
                    { auto e = __builtin_amdgcn_permlane16_swap(__float_as_uint(tot), __float_as_uint(tot), false, false); const float e0 = __uint_as_float(e[0]), s01 = e0 + __uint_as_float(e[1]);
                      auto f = __builtin_amdgcn_permlane32_swap(__float_as_uint(s01), __float_as_uint(s01), false, false);
                      pre = ((g4 & 1) ? e0 : 0.f) + ((g4 & 2) ? __uint_as_float(f[0]) : 0.f); }
                    const LAS float* Lf = (const LAS float*)Ls + 16 * hw + c16;
                    LAS unsigned char* Ct = lds + SC_CT + (jc % 3) * CT_SLOT;
                    LAS float* ggw = (LAS float*)(lds + SC_GG + (jc & 3) * 4096) + 16 * hw + c16;
                    float kh[4], rh[4], bt[4], kt[4], vv[4], rkp[4];
                    float Wprev = __builtin_amdgcn_exp2f(pre);
#pragma unroll
                    for (int r = 0; r < 4; ++r) { const int tok = 4 * g4 + r; const float c = pre + cw[r];
                        const float Wc = __builtin_amdgcn_exp2f(c), Wp = Wprev, iW = __builtin_amdgcn_exp2f(-c); Wprev = Wc;
                        const float a = __builtin_amdgcn_rcpf(1.f + __builtin_amdgcn_exp2f(za[r]));
                        const float rr = Lf[tok * SC_LROW], kk_ = Lf[16 * SC_LROW + tok * SC_LROW], nk = Lf[32 * SC_LROW + tok * SC_LROW]; vv[r] = Lf[48 * SC_LROW + tok * SC_LROW];
                        const float kd = kk_ * (1.f + (a - 1.f) * kaC);
                        kh[r] = nk * Wp; rh[r] = rr * Wc; bt[r] = nk * a * iW; kt[r] = kd * iW; rkp[r] = rr * kd * rkC;
                        ggw[tok * 64] = gg[r];
                        if (tok == 15) ((LAS float*)(Ct + CT_WEND))[16 * hw + c16] = Wc; }
                    { LAS unsigned char* tq = Ct + (16 * hw + c16) * 32 + 8 * g4;
                      *(LAS u32x2*)(tq + CT_KHT) = (u32x2){cvtpk(kh[0], kh[1]), cvtpk(kh[2], kh[3])}; *(LAS u32x2*)(tq + CT_RHT) = (u32x2){cvtpk(rh[0], rh[1]), cvtpk(rh[2], rh[3])};
                      *(LAS u32x2*)(tq + CT_BTT) = (u32x2){cvtpk(bt[0], bt[1]), cvtpk(bt[2], bt[3])}; *(LAS u32x2*)(tq + CT_KTT) = (u32x2){cvtpk(kt[0], kt[1]), cvtpk(kt[2], kt[3])};
                      *(LAS u32x2*)(tq + CT_VT) = (u32x2){cvtpk(vv[0], vv[1]), cvtpk(vv[2], vv[3])};
                      *(LAS u32x2*)(tq + CT_RKT) = (u32x2){cvtpk(rkp[0], rkp[1]), cvtpk(rkp[2], rkp[3])}; }
                }
                const unsigned long long tc_ = (SECPROBE >= 0) ? __builtin_amdgcn_s_memrealtime() : 0ull;
                for (int rep_ = 0; rep_ < REP_HL; ++rep_)
                if (doL) {
                    LAS unsigned char* Ls = lds + SC_LBUF + (i & 1) * SC_LSLOT; LAS float* Lf = (LAS float*)Ls;
                    const int s = 4 * hw + g4;
                    const u32x2 lr = LS.r, lk = LS.k, lv = LS.v; const u32x4 l00 = LS.l0, l01 = LS.l1;
                    issueL(i + 2 < NCH ? i + 2 : NCH - 1, LS);
                    const f32x4 rr = {bflo(lr.x), bfhi(lr.x), bflo(lr.y), bfhi(lr.y)}, kk_ = {bflo(lk.x), bfhi(lk.x), bflo(lk.y), bfhi(lk.y)}, vv = {bflo(lv.x), bfhi(lv.x), bflo(lv.y), bfhi(lv.y)};
                    f32x4 nk = kk_ * kkT; float ss = nk[0] * nk[0] + nk[1] * nk[1] + nk[2] * nk[2] + nk[3] * nk[3];
                    ss = sum16(ss);
                    nk = nk * (1.f / fmaxf(sqrtf(ss), 1e-12f));
                    *(LAS f32x4*)(Lf + s * SC_LROW + 4 * c16) = rr; *(LAS f32x4*)(Lf + 16 * SC_LROW + s * SC_LROW + 4 * c16) = kk_;
                    *(LAS f32x4*)(Lf + 32 * SC_LROW + s * SC_LROW + 4 * c16) = nk; *(LAS f32x4*)(Lf + 48 * SC_LROW + s * SC_LROW + 4 * c16) = vv;
                    *(LAS u32x4*)(Ls + 4 * 16 * SC_LROW * 4 + s * SC_LDROW + 32 * c16) = l00; *(LAS u32x4*)(Ls + 4 * 16 * SC_LROW * 4 + s * SC_LDROW + 32 * c16 + 16) = l01;
                }
                for (int rep_ = 0; rep_ < REP_SYNC; ++rep_) __syncthreads();
                if (SECPROBE >= 0) { asm volatile("s_waitcnt vmcnt(0) lgkmcnt(0)" ::: "memory"); const unsigned long long te_ = __builtin_amdgcn_s_memrealtime(); wait_acc += (SECPROBE == 0) ? (tc_ - tb_) : ((SECPROBE == 1) ? (te_ - tc_) : (te_ - tb_)); __syncthreads(); } else
                if (WAITPROBE >= 0) { const unsigned long long t0_ = __builtin_amdgcn_s_memrealtime(); __syncthreads(); wait_acc += __builtin_amdgcn_s_memrealtime() - t0_; } else
                __syncthreads();
            };
            for (int i = 0; i < NCH + 4; i += 2) { hw_interval(i, setA); hw_interval(i + 1, setB); }
        }
        if ((WAITPROBE >= 0 || SECPROBE >= 0) && blockIdx.x == 0 && wid == (SECPROBE >= 0 ? 4 : WAITPROBE)) { const unsigned long long tgt_ = __builtin_amdgcn_s_memrealtime() + 4ull * wait_acc; while (__builtin_amdgcn_s_memrealtime() < tgt_) __builtin_amdgcn_s_sleep(8); }
    }
}

__global__ void __launch_bounds__(NTHREADS, 2) fwd_megakernel(Args args) {
    extern __shared__ __attribute__((aligned(16))) unsigned char lds_raw[];
    LAS unsigned char* lds = (LAS unsigned char*)lds_raw;
    volatile LAS unsigned* MISC = (volatile LAS unsigned*)(lds + MISC_OFF);
    const int tid0 = threadIdx.x, wave = __builtin_amdgcn_readfirstlane(tid0 >> 6);
#define FRESH_LANE() int tid = tid0; asm volatile("" : "+v"(tid)); const int lane = tid & 63; (void)lane
    const int G = gridDim.x;
    const int vcu = (G % 8 == 0) ? ((int)blockIdx.x % 8) * (G / 8) + (int)blockIdx.x / 8 : (int)blockIdx.x;
    const int gw = vcu * NWAVES + wave, NGW = G * NWAVES;
    unsigned char* ws = args.ws;
    unsigned* ctl = (unsigned*)(ws + WS_CTL);
    for (int u = tid0; u < (LDS_BYTES - LDSCTL_OFF) / 4; u += NTHREADS) ((LAS unsigned*)(lds + LDSCTL_OFF))[u] = 0u;
    __syncthreads();
    XcdBarrier bar = xcd_barrier_post(ctl + CW_BAR, MISC + 8);
    unsigned long long ts_a = 0ull; int ts_n = 0;
#define STAMP() do { if (TS_A >= 0) { const unsigned long long t_ = __builtin_amdgcn_s_memrealtime(); if (ts_n == TS_A) ts_a = t_; \
    if (ts_n == TS_B && blockIdx.x == 0) { const unsigned long long tgt_ = t_ + 4ull * (t_ - ts_a); while (__builtin_amdgcn_s_memrealtime() < tgt_) __builtin_amdgcn_s_sleep(8); } ++ts_n; } } while (0)
#define GRID_BAR() do { xcd_barrier(bar); STAMP(); } while (0)
    STAMP();

    const float* x = args.in[0]; const float* rel_table = args.in[1]; const float* norm_g = args.in[2]; const float* attn_w_in = args.in[3]; const float* attn_sink = args.in[4];
    const float* attn_w_out = args.in[5]; const float* mu_prev = args.in[6]; const float* mu_next = args.in[7]; const float* w_r = args.in[8]; const float* w_k = args.in[9];
    const float* w_v = args.in[10]; const float* w_o = args.in[11]; const float* mlp_w1 = args.in[25]; const float* mlp_w2 = args.in[26];
    bf16_t* HBa = (bf16_t*)args.out; bf16_t* HBb = HBa + (size_t)M * D; bf16_t* HBc = (bf16_t*)(ws + WS_HBC); bf16_t* TMP2 = (bf16_t*)(ws + WS_TMP2);
    bf16_t* XN = (bf16_t*)(ws + WS_XN); bf16_t* QKV = (bf16_t*)(ws + WS_QKV); bf16_t* Ob = (bf16_t*)(ws + WS_O); bf16_t* TMP = (bf16_t*)(ws + WS_TMP); bf16_t* Hb = (bf16_t*)(ws + WS_H);
    bf16_t* MIXA = (bf16_t*)(ws + WS_MIXA); bf16_t* MIXB = (bf16_t*)(ws + WS_MIXB); bf16_t* Rb = (bf16_t*)(ws + WS_R); bf16_t* Kb = (bf16_t*)(ws + WS_K); bf16_t* Vb = (bf16_t*)(ws + WS_V);
    bf16_t* LDO = (bf16_t*)(ws + WS_LDO); bf16_t* Yb = (bf16_t*)(ws + WS_Y);
    LAS float* scr = (LAS float*)(lds + wave * TR_SCR_BYTES);
    float* RS = (float*)(ws + WS_CTL + 128 * 1024);

    {
        FRESH_LANE();
        constexpr int I_IN = (D / 64) * (DIN / 64), I_OUT = (D / 64) * (D / 64), I_1 = (D / 64) * (DFF / 64), I_2 = (DFF / 64) * (D / 64);
        const bool tail = (G == 256);
        for (int it = gw; it < (tail ? I_IN : I_IN + I_OUT + I_1 + I_2); it += NGW) { int r = it;
            if (r < I_IN) { transpose_item(attn_w_in, DIN, DIN, (bf16_t*)(ws + WS_WIN_T), D, 0, 0, scr, r, lane, ScaleOne{}); continue; } r -= I_IN;
            if (r < I_OUT) { transpose_item(attn_w_out, D, D, (bf16_t*)(ws + WS_WOUT_T), D, 0, 0, scr, r, lane, ScaleOne{}); continue; } r -= I_OUT;
            if (r < I_1) { transpose_item(mlp_w1, DFF, DFF, (bf16_t*)(ws + WS_W1_T), D, 0, 0, scr, r, lane, ScaleVec{norm_g + 2 * D}); continue; } r -= I_1;
            transpose_item(mlp_w2, D, D, (bf16_t*)(ws + WS_W2_T), DFF, 0, 0, scr, r, lane, ScaleOne{}); }
        for (int row = gw; row < M; row += NGW) { Row16 r; row_load_f32(r, x + (size_t)row * D, lane); row_rmsnorm(r, norm_g, lane); row_store_bf16(r, XN + (size_t)row * D, lane); }
    }
    GRID_BAR();
    { pg8::StaticOrder S; S.init(M, DIN, G, (int)blockIdx.x); const EpiHeadMajor E{QKV};
      for (int rep = 0; rep < REP_GEMM; ++rep) pg8::gemm_phase<EpiHeadMajor, ProbPlain, true, true>(lds, ProbPlain{XN, (const bf16_t*)(ws + WS_WIN_T), D}, S, E); }
    if (G == 256 && blockIdx.x >= 64) {
        FRESH_LANE();
        constexpr int I_OUT = (D / 64) * (D / 64), I_1 = (D / 64) * (DFF / 64), I_2 = (DFF / 64) * (D / 64);
        for (int it = ((int)blockIdx.x - 64) * NWAVES + wave; it < I_OUT + I_1 + I_2; it += 192 * NWAVES) { int r = it;
            if (r < I_OUT) { transpose_item(attn_w_out, D, D, (bf16_t*)(ws + WS_WOUT_T), D, 0, 0, scr, r, lane, ScaleOne{}); continue; } r -= I_OUT;
            if (r < I_1) { transpose_item(mlp_w1, DFF, DFF, (bf16_t*)(ws + WS_W1_T), D, 0, 0, scr, r, lane, ScaleVec{norm_g + 2 * D}); continue; } r -= I_1;
            transpose_item(mlp_w2, D, D, (bf16_t*)(ws + WS_W2_T), DFF, 0, 0, scr, r, lane, ScaleOne{}); }
    }
    GRID_BAR();
    { const AttnIO io{QKV, rel_table, attn_sink, Ob, (bf16_t*)(ws + WS_OBR), (float*)(ws + WS_LSE)};
      for (int rep = 0; rep < REP_ATT; ++rep) phase_attn(lds, io, vcu, G);
      GRID_BAR();
      { FRESH_LANE(); phase_attn_merge(io, vcu * NTHREADS + tid, G * NTHREADS); } }
    GRID_BAR();
    for (int rep = 0; rep < REP_BAR; ++rep) GRID_BAR();
    run_gemm<0>(lds, ProbPlain{Ob, (const bf16_t*)(ws + WS_WOUT_T), D}, DstPlain{TMP, D}, M, D, G);
    GRID_BAR();
    { FRESH_LANE(); phase_resnorm<true, false>(x, TMP, norm_g + D, nullptr, HBa, nullptr, RS, gw, NGW, lane); }
    GRID_BAR();
    run_gemm_rs<1>(lds, ProbPlain{HBa, (const bf16_t*)(ws + WS_W1_T), D}, DstPlain{Hb, DFF}, RS, M, DFF, G);
    GRID_BAR();
    run_gemm<0>(lds, ProbPlain{Hb, (const bf16_t*)(ws + WS_W2_T), DFF}, DstPlain{TMP, D}, M, D, G);
    GRID_BAR();
    { FRESH_LANE(); phase_resnorm<false, false>(HBa, TMP, norm_g + 3 * D, nullptr, HBb, nullptr, nullptr, gw, NGW, lane); }
    GRID_BAR();
    {
        FRESH_LANE();
        const float* g1n = norm_g + 4 * D;
        constexpr int I_SQ = (D / 64) * (D / 64), I_1 = (D / 64) * (DFF / 64), I_2 = (DFF / 64) * (D / 64), I_LD = 384;
        const bool tail = (G == 256);
        for (int it = gw; it < (tail ? 2 * I_SQ + I_2 + I_LD : 4 * I_SQ + I_1 + I_2 + I_LD); it += NGW) { int r = it;
            if (r < I_SQ) { transpose_item(w_r, D, D, (bf16_t*)(ws + WS_WR_T), D, 0, 0, scr, r, lane, ScaleOne{}); continue; } r -= I_SQ;
            if (r < I_SQ) { transpose_item(w_k, D, D, (bf16_t*)(ws + WS_WK_T), D, 0, 0, scr, r, lane, ScaleOne{}); continue; } r -= I_SQ;
            if (!tail) {
                if (r < I_SQ) { transpose_item(w_v, D, D, (bf16_t*)(ws + WS_WV_T), D, 0, 0, scr, r, lane, ScaleOne{}); continue; } r -= I_SQ;
                if (r < I_SQ) { transpose_item(w_o, D, D, (bf16_t*)(ws + WS_WO2_T), D, 0, 0, scr, r, lane, ScaleOne{}); continue; } r -= I_SQ;
                if (r < I_1) { transpose_item(mlp_w1 + (size_t)D * DFF, DFF, DFF, (bf16_t*)(ws + WS_W1B_T), D, 0, 0, scr, r, lane, ScaleVec{norm_g + 6 * D}); continue; } r -= I_1; }
            if (r < I_2) { transpose_item(mlp_w2 + (size_t)DFF * D, D, D, (bf16_t*)(ws + WS_W2B_T), DFF, 0, 0, scr, r, lane, ScaleOne{}); continue; } r -= I_2;
            const int part = r / 128; int q = r % 128; int sub, li;
            if (q < 64) { sub = q / 16; li = q % 16; } else { sub = 4 + (q - 64) / 32; li = (q - 64) % 32; }
            const int dd = sub & 1, kind = sub >> 1;
            const int stream = kind == 0 ? 1 : (kind == 1 ? 4 : 5), Nn = kind == 2 ? 128 : 64;
            const float* src = kind == 0 ? args.in[18] + (size_t)dd * D * 64 : (kind == 1 ? args.in[21] + (size_t)dd * D * 64 : args.in[23] + (size_t)dd * D * 128);
            const int coloff = kind == 0 ? dd * 64 : (kind == 1 ? 128 + dd * 64 : 256 + dd * 128);
            transpose_item(src, Nn, Nn, (bf16_t*)(ws + WS_LDW_T), D, part * 512 + coloff, 0, scr, li, lane, ScaleMix{mu_prev + stream * D, mu_next + stream * D, part}); }
        phase_mix3(lds, HBb, g1n, mu_prev, mu_next, XN, MIXA, MIXB, HBa, gw, NGW, tid, lane);
    }
    GRID_BAR();
    run_gemm<0>(lds, ProbRKL{ws, D}, DstRKL{ws}, M, 14 * 256, G);
    if (G == 256 && blockIdx.x >= 128) {
        FRESH_LANE();
        constexpr int I_SQ = (D / 64) * (D / 64), I_1 = (D / 64) * (DFF / 64);
        for (int it = ((int)blockIdx.x - 128) * NWAVES + wave; it < 2 * I_SQ + I_1; it += 128 * NWAVES) { int r = it;
            if (r < I_SQ) { transpose_item(w_v, D, D, (bf16_t*)(ws + WS_WV_T), D, 0, 0, scr, r, lane, ScaleOne{}); continue; } r -= I_SQ;
            if (r < I_SQ) { transpose_item(w_o, D, D, (bf16_t*)(ws + WS_WO2_T), D, 0, 0, scr, r, lane, ScaleOne{}); continue; } r -= I_SQ;
            transpose_item(mlp_w1 + (size_t)D * DFF, DFF, DFF, (bf16_t*)(ws + WS_W1B_T), D, 0, 0, scr, r, lane, ScaleVec{norm_g + 6 * D}); }
    }
    GRID_BAR();
    { FRESH_LANE(); phase_lda(LDO, (bf16_t*)(ws + WS_LDA), gw, NGW, lane); }
    run_gemm<0>(lds, ProbPlain{HBa, (const bf16_t*)(ws + WS_WV_T), D}, DstPlain{Vb, D}, M, D, G);
    GRID_BAR();
    { ScanPtrs sp{Rb, Kb, Vb, (const bf16_t*)(ws + WS_LDA), Yb, args.in[19], args.in[22], args.in[24], args.in[17], args.in[20], args.in[12], args.in[13], args.in[14], args.in[15], args.in[16]};
      for (int rep = 0; rep < REP_SCAN; ++rep) phase_scan(lds, sp, G); }
    GRID_BAR();
    { FRESH_LANE();
      bf16_t* Ys = (bf16_t*)(ws + WS_YSUM);
      const bool grp_on = (G == 256);
      const int grow0 = 256 * (8 * ((int)blockIdx.x % 8) + ((int)blockIdx.x / 8) % 8) + 64 * ((int)blockIdx.x / 64);
      const int rfirst = grp_on ? grow0 + wave : gw, rend = grp_on ? grow0 + 64 : M, rstride = grp_on ? NWAVES : NGW;
      for (int row = rfirst; row < rend; row += rstride) {
          const u32x4* y0 = (const u32x4*)(Yb + (size_t)row * 2 * D); const u32x4* y1 = (const u32x4*)(Yb + (size_t)row * 2 * D + D);
#pragma unroll
          for (int hb = 0; hb < 2; ++hb) { const u32x4 a = y0[lane + 64 * hb], c = y1[lane + 64 * hb]; u32x4 o;
              o.x = cvtpk(bflo(a.x) + bflo(c.x), bfhi(a.x) + bfhi(c.x)); o.y = cvtpk(bflo(a.y) + bflo(c.y), bfhi(a.y) + bfhi(c.y));
              o.z = cvtpk(bflo(a.z) + bflo(c.z), bfhi(a.z) + bfhi(c.z)); o.w = cvtpk(bflo(a.w) + bflo(c.w), bfhi(a.w) + bfhi(c.w));
              pg8::store16_wt((u32x4*)(Ys + (size_t)row * D) + lane + 64 * hb, o); } }
      if (grp_on) { unsigned ep = 0u; grp_barrier(ctl + CW_BAR, (unsigned)blockIdx.x % 64u, ep); } else GRID_BAR();
      run_gemm<0>(lds, ProbPlain{Ys, (const bf16_t*)(ws + WS_WO2_T), D}, DstPlain{TMP2, D}, M, D, G); }
    GRID_BAR();
    { FRESH_LANE(); phase_resnorm<false, false>(HBb, TMP2, norm_g + 5 * D, nullptr, HBc, nullptr, RS, gw, NGW, lane); }
    GRID_BAR();
    run_gemm_rs<1>(lds, ProbPlain{HBc, (const bf16_t*)(ws + WS_W1B_T), D}, DstPlain{Hb, DFF}, RS, M, DFF, G);
    GRID_BAR();
    run_gemm<0>(lds, ProbPlain{Hb, (const bf16_t*)(ws + WS_W2B_T), DFF}, DstPlain{TMP2, D}, M, D, G);
    GRID_BAR();
    { FRESH_LANE(); phase_resnorm<false, true>(HBc, TMP2, norm_g + 7 * D, nullptr, args.out, nullptr, nullptr, gw, NGW, lane); }
    if (TS_A >= 0) { GRID_BAR(); }
#undef GRID_BAR
}

extern "C" void kernel_launch(void* const* d_in, const int* in_sizes, int n_in, void* d_out, int out_size, void* d_ws, size_t ws_size, hipStream_t stream) {
    static int grid = 0;
    if (grid == 0) {
        if (n_in != 27 || in_sizes[0] != M * D || out_size != M * D || ws_size < WS_END) { fprintf(stderr, "kernel_launch: unexpected shapes (n_in %d, in0 %d, out %d, ws %zu)\n", n_in, n_in > 0 ? in_sizes[0] : -1, out_size, ws_size); grid = -1; return; }
        int dev = 0, cus = 0, per_cu = 0;
        if (hipGetDevice(&dev) != hipSuccess || hipDeviceGetAttribute(&cus, hipDeviceAttributeMultiprocessorCount, dev) != hipSuccess) { grid = -1; return; }
        if (hipFuncSetAttribute((const void*)fwd_megakernel, hipFuncAttributeMaxDynamicSharedMemorySize, LDS_BYTES) != hipSuccess) { fprintf(stderr, "kernel_launch: hipFuncSetAttribute failed\n"); grid = -1; return; }
        if (hipOccupancyMaxActiveBlocksPerMultiprocessor(&per_cu, (const void*)fwd_megakernel, NTHREADS, LDS_BYTES) != hipSuccess || per_cu < 1) { fprintf(stderr, "kernel_launch: occupancy query says %d blocks/CU\n", per_cu); (void)hipGetLastError(); grid = -1; return; }
        grid = cus;
    }
    if (grid < 0) return;
    (void)hipMemsetAsync((char*)d_ws + WS_CTL, 0, CTL_ZERO_BYTES, stream);
    Args a{};
    for (int i = 0; i < 27; ++i) a.in[i] = (const float*)d_in[i];
    a.out = (float*)d_out; a.ws = (unsigned char*)d_ws;
    hipLaunchKernelGGL(fwd_megakernel, dim3(grid), dim3(NTHREADS), LDS_BYTES, stream, a);
}
```

```cpp
#include <hip/hip_runtime.h>
#include <cstdio>
#include <cstdint>

#define LAS __attribute__((address_space(3)))
#define GAS __attribute__((address_space(1)))
typedef unsigned short bf16_t;
typedef short bf16x8 __attribute__((ext_vector_type(8)));
typedef float f32x4 __attribute__((ext_vector_type(4)));
typedef float f32x2 __attribute__((ext_vector_type(2)));
typedef unsigned u32x4 __attribute__((ext_vector_type(4)));
typedef unsigned u32x2 __attribute__((ext_vector_type(2)));

#ifndef REP_SCAN
#define REP_SCAN 1
#endif
#ifndef REP_ATT
#define REP_ATT 1
#endif
#ifndef REP_GEMM
#define REP_GEMM 1
#endif
#ifndef REP_ATTC
#define REP_ATTC 1
#endif
#ifndef REP_BAR
#define REP_BAR 0
#endif
#ifndef REP_ATTS
#define REP_ATTS 1
#endif
#ifndef REP_HC
#define REP_HC 1
#endif
#ifndef REP_ST
#define REP_ST 1
#endif
#ifndef REP_HL
#define REP_HL 1
#endif
#ifndef REP_SYNC
#define REP_SYNC 0
#endif
#ifndef SECPROBE
#define SECPROBE -1
#endif
#ifndef WAITPROBE
#define WAITPROBE -1
#endif
#ifndef TS_A
#define TS_A -1
#endif
#ifndef TS_B
#define TS_B -1
#endif
constexpr int SEQ = 2048, D = 1024, NBATCH = 8, M = NBATCH * SEQ, DFF = 4096, DIN = 2304, NLD = 1536;
constexpr float NORM_EPS = 1e-6f, GN_EPS = 64e-5f;
constexpr int NWAVES = 8, NTHREADS = 512;

namespace pg8 {
constexpr int BM = 256, BK = 64, HALF = 128, HTB = HALF * BK * 2, STAGE_BYTES = 8 * HTB, NXCD = 8, WGM = 8;
__host__ __device__ __forceinline__ int lds_byte(int r, int c) { const int st = (r >> 4) * 2 + (c >> 5), rr = r & 15, cc = c & 31, ob = rr * 64 + cc * 2; return st * 1024 + (ob ^ (((ob >> 9) & 1) << 5)); }
__host__ __device__ __forceinline__ void stage_rc(int b, int& R, int& C) { const int st = b / 1024, sb = b % 1024, swz = sb ^ (((sb >> 9) & 1) << 5); R = (st >> 1) * 16 + swz / 64; C = (st & 1) * 32 + (swz % 64) / 2; }
__host__ __device__ __forceinline__ int perm32(int rho) { const int n = rho >> 4, i = rho & 15; return 8 * (i >> 2) + 4 * n + (i & 3); }

struct Unit { int pm, pn; };
struct StaticOrder {
    int nM, nN, nwg, G, c;
    __host__ __device__ void init(int Mr, int N, int G_, int c_) { nM = Mr / BM; nN = N / BM; nwg = nM * nN; G = G_; c = c_; }
    __host__ __device__ bool next(int i, Unit& u) const {
        const long L = (long)i * G + c; if (L >= nwg) return false;
        int wgid = (int)L; { const int q = nwg / NXCD, r = nwg % NXCD, xcd = wgid % NXCD, off = wgid / NXCD; wgid = (xcd < r ? xcd * (q + 1) : r * (q + 1) + (xcd - r) * q) + off; }
        const int nig = WGM * nN, gid = wgid / nig, fm = gid * WGM, gsz = (nM - fm) < WGM ? (nM - fm) : WGM;
        u.pm = fm + ((wgid % nig) % gsz); u.pn = (wgid % nig) / gsz; return true;
    }
};
__device__ __forceinline__ unsigned cvt_pk_bf16(float lo, float hi) { unsigned r; asm volatile("v_cvt_pk_bf16_f32 %0, %1, %2" : "=v"(r) : "v"(lo), "v"(hi)); return r; }

__device__ __forceinline__ void store16_wt(void* p, u32x4 v) { asm volatile("global_store_dwordx4 %0, %1, off sc1\n\ts_nop 1" :: "v"(p), "v"(v) : "memory"); }
template <int ACT, class DstFn, bool RS = false> struct EpiBf16 {
    static constexpr bool PERM = true;
    DstFn F; const float* rs;
    __device__ __forceinline__ void operator()(const f32x4 (&acc)[2][2][4][2], const Unit& u, int wr, int wc, int fr, int fq) const {
        bf16_t* base; int ldc; F(u, base, ldc);
        const int row0 = wr * 64 + fr, col0 = wc * 32 + 8 * fq;
        float rsc[2][4];
        if (RS) {
#pragma unroll
            for (int ai = 0; ai < 2; ++ai)
#pragma unroll
                for (int m = 0; m < 4; ++m) rsc[ai][m] = rs[u.pm * BM + row0 + ai * HALF + m * 16]; }
        if (RS && ACT == 1) {
            f32x4 t[2][2][4][2];
#pragma unroll
            for (int ai = 0; ai < 2; ++ai)
#pragma unroll
                for (int bj = 0; bj < 2; ++bj)
#pragma unroll
                    for (int m = 0; m < 4; ++m)
#pragma unroll
                        for (int n = 0; n < 2; ++n)
#pragma unroll
                            for (int e = 0; e < 4; ++e) { const float a = fmaxf(acc[ai][bj][m][n][e], 0.f); t[ai][bj][m][n][e] = a * a; }
#pragma unroll
            for (int ai = 0; ai < 2; ++ai)
#pragma unroll
                for (int m = 0; m < 4; ++m) { bf16_t* rowp = base + (size_t)(row0 + ai * HALF + m * 16) * ldc + col0; const float r2 = rsc[ai][m] * rsc[ai][m];
#pragma unroll
                    for (int bj = 0; bj < 2; ++bj) { const f32x4 v0 = t[ai][bj][m][0] * r2, v1 = t[ai][bj][m][1] * r2;
                        u32x4 w; w.x = cvt_pk_bf16(v0[0], v0[1]); w.y = cvt_pk_bf16(v0[2], v0[3]); w.z = cvt_pk_bf16(v1[0], v1[1]); w.w = cvt_pk_bf16(v1[2], v1[3]);
                        store16_wt(rowp + bj * HALF, w); } }
            return;
        }
#pragma unroll
        for (int ai = 0; ai < 2; ++ai)
#pragma unroll
            for (int m = 0; m < 4; ++m) { bf16_t* rowp = base + (size_t)(row0 + ai * HALF + m * 16) * ldc + col0;
#pragma unroll
                for (int bj = 0; bj < 2; ++bj) { f32x4 v0 = acc[ai][bj][m][0], v1 = acc[ai][bj][m][1];
                    if (RS) { v0 = v0 * rsc[ai][m]; v1 = v1 * rsc[ai][m]; }
                    if (ACT == 1) {
#pragma unroll
                        for (int e = 0; e < 4; ++e) { const float a = fmaxf(v0[e], 0.f), b = fmaxf(v1[e], 0.f); v0[e] = a * a; v1[e] = b * b; } }
                    u32x4 w; w.x = cvt_pk_bf16(v0[0], v0[1]); w.y = cvt_pk_bf16(v0[2], v0[3]); w.z = cvt_pk_bf16(v1[0], v1[1]); w.w = cvt_pk_bf16(v1[2], v1[3]);
                    store16_wt(rowp + bj * HALF, w); } }
    }
};

template <class Epi, class Prob, bool ALIGN_EPI, bool SP2>
__device__ __forceinline__ void gemm_phase(LAS unsigned char* lds, const Prob& P, const StaticOrder& S, const Epi& E) {
    int tid = threadIdx.x; asm volatile("" : "+v"(tid));
    const int wid = __builtin_amdgcn_readfirstlane(tid >> 6), lane = tid & 63, wr = wid >> 2, wc = wid & 3, fr = lane & 15, fq = lane >> 4;
    const int K = P.K, nt = K / BK;
    unsigned voffA[2], voffB[2];
#pragma unroll
    for (int i = 0; i < 2; ++i) { int R, C; stage_rc(tid * 16 + i * 8192, R, C); const int Rb = Epi::PERM ? ((R & ~31) + perm32(R & 31)) : R;
        voffA[i] = (unsigned)(R * K + C) * 2u; voffB[i] = (unsigned)(Rb * K + C) * 2u; }
    const size_t kstep = (size_t)(BK * 2);
    const size_t hstep = (size_t)HALF * K * 2;
    const unsigned ldsw = (unsigned)wid * 1024u;
    const int aoff = lds_byte(wr * 64 + fr, fq * 8), boff = lds_byte(wc * 32 + fr, fq * 8);
#define PG8_SA(b, h) (((b) * 2 + (h)) * HTB)
#define PG8_SB(b, h) ((4 + (b) * 2 + (h)) * HTB)
#define PG8_STAGE(bufoff, gbase, voff) do { _Pragma("unroll") for (int _i = 0; _i < 2; ++_i) \
        __builtin_amdgcn_global_load_lds((const unsigned*)((const char*)(gbase) + (voff)[_i]), (LAS unsigned*)(lds + (bufoff) + ldsw + _i * 8192), 16, 0, 0); } while (0)
#define PG8_LDA(dst, b, h) do { _Pragma("unroll") for (int m = 0; m < 4; ++m) _Pragma("unroll") for (int k = 0; k < 2; ++k) dst[m][k] = *(const LAS bf16x8*)(lds + PG8_SA(b, h) + aoff + m * 2048 + k * 1024); } while (0)
#define PG8_LDB(dst, b, h) do { _Pragma("unroll") for (int n = 0; n < 2; ++n) _Pragma("unroll") for (int k = 0; k < 2; ++k) dst[n][k] = *(const LAS bf16x8*)(lds + PG8_SB(b, h) + boff + n * 2048 + k * 1024); } while (0)
#define PG8_MMA(ai, bj, At, Bt) do { __builtin_amdgcn_s_setprio(1); _Pragma("unroll") for (int m = 0; m < 4; ++m) _Pragma("unroll") for (int n = 0; n < 2; ++n) _Pragma("unroll") for (int k = 0; k < 2; ++k) \
        acc[ai][bj][m][n] = __builtin_amdgcn_mfma_f32_16x16x32_bf16(Bt[n][k], At[m][k], acc[ai][bj][m][n], 0, 0, 0); __builtin_amdgcn_s_setprio(0); } while (0)
#define PG8_WAIT_V(n) asm volatile("s_waitcnt vmcnt(" #n ")" ::: "memory")
#define PG8_WAIT_L(n) asm volatile("s_waitcnt lgkmcnt(" #n ")" ::: "memory")
#define PG8_BAR __builtin_amdgcn_s_barrier()
#define PG8_SCHED __builtin_amdgcn_sched_barrier(0)
    Unit cur, nxt; int ui = 0;
    if (!S.next(0, cur)) return;
    f32x4 acc[2][2][4][2];
#pragma unroll
    for (int a = 0; a < 2; ++a)
#pragma unroll
        for (int b = 0; b < 2; ++b)
#pragma unroll
            for (int m = 0; m < 4; ++m)
#pragma unroll
                for (int n = 0; n < 2; ++n) acc[a][b][m][n] = (f32x4){0.f, 0.f, 0.f, 0.f};
    bf16x8 At[4][2], B0[2][2], B1[2][2];
    const char* cA = P.a_tile(cur); const char* cB = P.b_tile(cur);
    if constexpr (SP2) {
        PG8_STAGE(PG8_SB(0, 0), cB, voffB); PG8_STAGE(PG8_SB(0, 1), cB + hstep, voffB); PG8_STAGE(PG8_SA(0, 0), cA, voffA); PG8_STAGE(PG8_SA(0, 1), cA + hstep, voffA);
        if (wr == 1) PG8_BAR;
        PG8_WAIT_V(2); PG8_BAR;
        PG8_STAGE(PG8_SB(1, 0), cB + kstep, voffB); PG8_STAGE(PG8_SA(1, 0), cA + kstep, voffA); PG8_STAGE(PG8_SB(1, 1), cB + hstep + kstep, voffB);
        PG8_WAIT_V(6); PG8_BAR;
    } else {
        PG8_STAGE(PG8_SB(0, 0), cB, voffB); PG8_STAGE(PG8_SA(0, 0), cA, voffA); PG8_STAGE(PG8_SB(0, 1), cB + hstep, voffB); PG8_STAGE(PG8_SA(0, 1), cA + hstep, voffA);
        if (wr == 1) PG8_BAR;
        PG8_WAIT_V(4); PG8_BAR;
        PG8_STAGE(PG8_SB(1, 0), cB + kstep, voffB); PG8_STAGE(PG8_SA(1, 0), cA + kstep, voffA); PG8_STAGE(PG8_SB(1, 1), cB + hstep + kstep, voffB);
        PG8_WAIT_V(6); PG8_BAR;
    }
    for (;;) {
        const bool has_next = S.next(ui + 1, nxt);
        const char* nA = has_next ? P.a_tile(nxt) : cA; const char* nB = has_next ? P.b_tile(nxt) : cB;
        for (int t = 0; t < nt; t += 2) {
            const bool last = (t == nt - 2);
            const char* a1 = cA + (size_t)(t + 1) * kstep;
            const char* a2 = last ? nA : cA + (size_t)(t + 2) * kstep; const char* b2 = last ? nB : cB + (size_t)(t + 2) * kstep;
            const char* a3 = a2 + kstep; const char* b3 = b2 + kstep;
            if constexpr (SP2) {
            PG8_LDB(B0, 0, 0); PG8_LDB(B1, 0, 1); PG8_SCHED; PG8_LDA(At, 0, 0); PG8_STAGE(PG8_SA(1, 1), a1 + hstep, voffA);
            PG8_WAIT_V(8); PG8_WAIT_L(0); PG8_BAR; PG8_MMA(0, 0, At, B0); PG8_MMA(0, 1, At, B1); PG8_BAR; PG8_SCHED;
            PG8_LDA(At, 0, 1); PG8_STAGE(PG8_SB(0, 0), b2, voffB); PG8_STAGE(PG8_SB(0, 1), b2 + hstep, voffB); PG8_STAGE(PG8_SA(0, 0), a2, voffA);
            PG8_WAIT_V(8); PG8_WAIT_L(0); PG8_BAR; PG8_MMA(1, 0, At, B0); PG8_MMA(1, 1, At, B1); PG8_BAR; PG8_SCHED;
            PG8_LDB(B0, 1, 0); PG8_LDB(B1, 1, 1); PG8_SCHED; PG8_LDA(At, 1, 0); PG8_STAGE(PG8_SA(0, 1), a2 + hstep, voffA);
            PG8_WAIT_V(8); PG8_WAIT_L(0); PG8_BAR; PG8_MMA(0, 0, At, B0); PG8_MMA(0, 1, At, B1); PG8_BAR; PG8_SCHED;
            PG8_LDA(At, 1, 1); PG8_STAGE(PG8_SB(1, 0), b3, voffB); PG8_STAGE(PG8_SB(1, 1), b3 + hstep, voffB); PG8_STAGE(PG8_SA(1, 0), a3, voffA);
            PG8_WAIT_V(8); PG8_WAIT_L(0); PG8_BAR; PG8_MMA(1, 0, At, B0); PG8_MMA(1, 1, At, B1); PG8_BAR; PG8_SCHED;
            } else {
            PG8_LDB(B0, 0, 0); PG8_SCHED; PG8_LDA(At, 0, 0); PG8_STAGE(PG8_SA(1, 1), a1 + hstep, voffA);
            PG8_WAIT_L(8); PG8_BAR; PG8_WAIT_L(0); PG8_MMA(0, 0, At, B0); PG8_BAR; PG8_SCHED;
            PG8_LDB(B1, 0, 1); PG8_STAGE(PG8_SB(0, 0), b2, voffB);
            PG8_BAR; PG8_WAIT_L(0); PG8_MMA(0, 1, At, B1); PG8_BAR;
            PG8_LDA(At, 0, 1); PG8_STAGE(PG8_SA(0, 0), a2, voffA);
            PG8_BAR; PG8_WAIT_L(0); PG8_MMA(1, 0, At, B0); PG8_BAR; PG8_SCHED;
            PG8_STAGE(PG8_SB(0, 1), b2 + hstep, voffB);
            PG8_WAIT_V(6); PG8_BAR; PG8_MMA(1, 1, At, B1); PG8_BAR;
            PG8_LDB(B0, 1, 0); PG8_SCHED; PG8_LDA(At, 1, 0); PG8_STAGE(PG8_SA(0, 1), a2 + hstep, voffA);
            PG8_WAIT_L(8); PG8_BAR; PG8_WAIT_L(0); PG8_MMA(0, 0, At, B0); PG8_BAR; PG8_SCHED;
            PG8_LDB(B1, 1, 1); PG8_STAGE(PG8_SB(1, 0), b3, voffB);
            PG8_BAR; PG8_WAIT_L(0); PG8_MMA(0, 1, At, B1); PG8_BAR;
            PG8_LDA(At, 1, 1); PG8_STAGE(PG8_SA(1, 0), a3, voffA);
            PG8_BAR; PG8_WAIT_L(0); PG8_MMA(1, 0, At, B0); PG8_BAR; PG8_SCHED;
            PG8_STAGE(PG8_SB(1, 1), b3 + hstep, voffB);
            PG8_WAIT_V(6); PG8_BAR; PG8_MMA(1, 1, At, B1); PG8_BAR;
            }
        }
        if constexpr (ALIGN_EPI) { if (wr == 0) PG8_BAR; }
        E(acc, cur, wr, wc, fr, fq);
        if (!has_next) break;
#pragma unroll
        for (int a = 0; a < 2; ++a)
#pragma unroll
            for (int b = 0; b < 2; ++b)
#pragma unroll
                for (int m = 0; m < 4; ++m)
#pragma unroll
                    for (int n = 0; n < 2; ++n) acc[a][b][m][n] = (f32x4){0.f, 0.f, 0.f, 0.f};
        cur = nxt; cA = nA; cB = nB; ++ui;
        if constexpr (ALIGN_EPI) { if (wr == 1) PG8_BAR; }
    }
    PG8_WAIT_V(0);
    if constexpr (!ALIGN_EPI) { if (wr == 0) PG8_BAR; }
    PG8_BAR;
#undef PG8_SA
#undef PG8_SB
#undef PG8_STAGE
#undef PG8_LDA
#undef PG8_LDB
#undef PG8_MMA
#undef PG8_WAIT_V
#undef PG8_WAIT_L
#undef PG8_BAR
#undef PG8_SCHED
}
}

constexpr size_t MiB = 1u << 20;
constexpr size_t WS_CTL = 0, CTL_ZERO_BYTES = 64 * 1024;
constexpr size_t WS_W = 1 * MiB;
constexpr size_t WS_WIN_T = WS_W, WS_WOUT_T = WS_WIN_T + (size_t)DIN * D * 2, WS_W1_T = WS_WOUT_T + (size_t)D * D * 2, WS_W2_T = WS_W1_T + (size_t)DFF * D * 2;
constexpr size_t WS_WR_T = WS_W, WS_WK_T = WS_WR_T + 2 * MiB, WS_LDW_T = WS_WK_T + 2 * MiB, WS_WV_T = WS_LDW_T + 3 * MiB, WS_WO2_T = WS_WV_T + 2 * MiB, WS_W1B_T = WS_WO2_T + 4 * MiB, WS_W2B_T = WS_W1B_T + 8 * MiB;
static_assert(WS_W2_T + (size_t)D * DFF * 2 <= 31 * MiB && WS_W2B_T + (size_t)D * DFF * 2 <= 31 * MiB, "weight region");
constexpr size_t WS_XN = 31 * MiB, WS_QKV = 63 * MiB, WS_O = 135 * MiB, WS_OBR = 167 * MiB, WS_LSE = 215 * MiB, WS_TMP = 217 * MiB, WS_H = 63 * MiB;
constexpr size_t WS_MIXA = 63 * MiB, WS_MIXB = 95 * MiB, WS_R = 127 * MiB, WS_K = 159 * MiB, WS_V = 31 * MiB, WS_LDO = 191 * MiB, WS_Y = 63 * MiB, WS_LDA = 239 * MiB;
constexpr size_t WS_YSUM = 127 * MiB;
constexpr size_t WS_HBC = 191 * MiB, WS_TMP2 = 223 * MiB;
constexpr size_t WS_END = 256 * MiB;
static_assert(WS_HBC >= WS_H + (size_t)M * DFF * 2 && WS_HBC + (size_t)M * D * 2 <= WS_TMP2 && WS_TMP2 + (size_t)M * D * 2 <= WS_END, "layer-1 tail");
static_assert(WS_LDO + (size_t)M * NLD * 2 <= WS_LDA && WS_LDA + (size_t)M * 512 * 2 <= WS_END && WS_TMP + (size_t)M * D * 2 <= WS_END, "tail of the map");
static_assert(WS_MIXA == WS_XN + 32 * MiB && WS_MIXB == WS_XN + 64 * MiB && WS_K == WS_R + 32 * MiB && WS_LDO == WS_R + 64 * MiB && WS_WK_T == WS_WR_T + 2 * MiB && WS_LDW_T == WS_WR_T + 4 * MiB, "grouped GEMM strides");
constexpr int CW_BAR = 4096;

constexpr int RING_BYTES = 131072, LDSCTL_OFF = 143360, MISC_OFF = LDSCTL_OFF + 320, LDS_BYTES = 147456;

typedef __bf16 bf16x2_t __attribute__((ext_vector_type(2)));
__device__ __forceinline__ unsigned cvtpk(float lo, float hi) { const f32x2 v = {lo, hi}; const bf16x2_t b = __builtin_convertvector(v, bf16x2_t); return __builtin_bit_cast(unsigned, b); }
__device__ __forceinline__ float bf2f(unsigned short b) { return __uint_as_float((unsigned)b << 16); }
__device__ __forceinline__ float bflo(unsigned w) { return __uint_as_float(w << 16); }
__device__ __forceinline__ float bfhi(unsigned w) { return __uint_as_float(w & 0xffff0000u); }
__device__ __forceinline__ unsigned f2bf(float f) { unsigned u = __float_as_uint(f); return (u + 0x7fffu + ((u >> 16) & 1u)) >> 16; }
__device__ __forceinline__ unsigned pk2(float lo, float hi) { return f2bf(lo) | (f2bf(hi) << 16); }
__device__ __forceinline__ float wave_sum(float v) {
#pragma unroll
    for (int o = 1; o < 64; o <<= 1) v += __shfl_xor(v, o);
    return v;
}
__device__ __forceinline__ float sigmoidf_(float z) { return 1.f / (1.f + __expf(-z)); }
__device__ __forceinline__ int t5_bucket(int rel) {
    const int n = rel < 0 ? -rel : rel;
    int large;
    if (n < 8) large = n; else if (n < 15) large = 8; else if (n < 27) large = 9; else if (n < 50) large = 10; else if (n < 91) large = 11;
    else if (n < 166) large = 12; else if (n < 305) large = 13; else if (n < 559) large = 14; else large = 15;
    return (rel > 0 ? 16 : 0) + large;
}

#define XB_TMO      128
#define XB_XCNT(j)  (256  + 64 * (j))
#define XB_XSUB(j)  (1280 + 64 * (j))
#define XB_XGEN(j)  (2304 + 64 * (j))
#define XB_TOP      3328
#define XB_TOPGEN   3392
#define XCD_BAR_WORDS 3456
#define XB_SPIN_CAP (1u << 18)
__device__ __forceinline__ unsigned xb_ld(unsigned* p)              { return __hip_atomic_load(p, __ATOMIC_RELAXED, __HIP_MEMORY_SCOPE_AGENT); }
__device__ __forceinline__ unsigned xb_add(unsigned* p, unsigned v) { return __hip_atomic_fetch_add(p, v, __ATOMIC_RELAXED, __HIP_MEMORY_SCOPE_AGENT); }
__device__ __forceinline__ unsigned xb_xcc_id() { return (unsigned)__builtin_amdgcn_s_getreg((3 << 11) | 20) & 0xFu; }
#define XB_SPIN(cond, bar) do { unsigned _sp = 0; while (cond) { __builtin_amdgcn_s_sleep(1); \
    if ((++_sp & 255u) == 0u) { if (xb_ld(&(bar)[XB_TMO])) break; if (_sp > XB_SPIN_CAP) { atomicAdd(&(bar)[XB_TMO], 1u); break; } } } } while (0)
struct XcdBarrier { unsigned* bar; unsigned x; volatile LAS unsigned* st; };
__device__ __forceinline__ XcdBarrier xcd_barrier_post(unsigned* bar, volatile LAS unsigned* st) {
    XcdBarrier b; b.bar = bar; b.x = xb_xcc_id(); b.st = st;
    if (threadIdx.x == 0) (void)xb_add(&bar[XB_XCNT(b.x)], 1u);
    return b;
}
__device__ __forceinline__ void xcd_barrier_complete(unsigned* bar, unsigned x, unsigned& nloc, unsigned& nx) {
    const unsigned G = gridDim.x * gridDim.y * gridDim.z;
    unsigned sum, cnt, mine, sp = 0u;
    for (;;) {
        sum = 0u; cnt = 0u; mine = 0u;
#pragma unroll
        for (unsigned j = 0; j < 16; ++j) { const unsigned c = xb_ld(&bar[XB_XCNT(j)]); sum += c; cnt += (c > 0u) ? 1u : 0u; mine = (j == x) ? c : mine; }
        if (sum == G) break;
        __builtin_amdgcn_s_sleep(1);
        if ((++sp & 255u) == 0u) { if (xb_ld(&bar[XB_TMO])) break; if (sp > XB_SPIN_CAP) { atomicAdd(&bar[XB_TMO], 1u); break; } }
    }
    nloc = mine > 0u ? mine : 1u; nx = cnt > 0u ? cnt : 1u;
}
__device__ __forceinline__ void xcd_barrier(const XcdBarrier& b) {
    asm volatile("s_waitcnt vmcnt(0)" ::: "memory");
    __syncthreads();
    if (threadIdx.x == 0) {
        unsigned* bar = b.bar;
        __builtin_amdgcn_s_waitcnt(0);
        unsigned nloc = b.st[0], nx = b.st[1];
        if (nloc == 0u) { xcd_barrier_complete(bar, b.x, nloc, nx); b.st[0] = nloc; b.st[1] = nx; }
        const unsigned old = xb_add(&bar[XB_XSUB(b.x)], 1u);
        const unsigned gen = old / nloc;
        if (old + 1u == (gen + 1u) * nloc) {
            __builtin_amdgcn_fence(__ATOMIC_RELEASE, "agent");
            asm volatile("s_waitcnt vmcnt(0)" ::: "memory");
            const unsigned og = xb_add(&bar[XB_TOP], 1u);
            const unsigned tg = og / nx;
            if (og + 1u == (tg + 1u) * nx) xb_add(&bar[XB_TOPGEN], 1u);
            else XB_SPIN(xb_ld(&bar[XB_TOPGEN]) == tg, bar);
            __builtin_amdgcn_fence(__ATOMIC_ACQUIRE, "agent");
            xb_add(&bar[XB_XGEN(b.x)], 1u);
            asm volatile("s_waitcnt vmcnt(0)" ::: "memory");
        } else {
            XB_SPIN(xb_ld(&bar[XB_XGEN(b.x)]) == gen, bar);
            __builtin_amdgcn_fence(__ATOMIC_ACQUIRE, "agent");
            asm volatile("s_waitcnt vmcnt(0)" ::: "memory");
        }
    }
    __syncthreads();
}

#define XB_GRP(g)   (4096 + 16 * (g))
__device__ __forceinline__ void grp_barrier(unsigned* bar, unsigned g, unsigned& epoch) {
    asm volatile("s_waitcnt vmcnt(0)" ::: "memory");
    __syncthreads();
    ++epoch;
    if (threadIdx.x == 0) {
        unsigned* word = &bar[XB_GRP(g)];
        (void)xb_add(word, 1u);
        const unsigned tgt = 4u * epoch;
        XB_SPIN(xb_ld(word) < tgt, bar);
        __builtin_amdgcn_fence(__ATOMIC_ACQUIRE, "agent");
        asm volatile("s_waitcnt vmcnt(0)" ::: "memory");
    }
    __syncthreads();
}

struct Row16 { f32x4 v[4]; };
__device__ __forceinline__ int row_q(int lane, int j) { return 2 * lane + 128 * (j >> 1) + (j & 1); }
__device__ __forceinline__ void row_load_f32(Row16& r, const float* p, int lane) {
#pragma unroll
    for (int j = 0; j < 4; ++j) r.v[j] = ((const f32x4*)p)[row_q(lane, j)];
}
struct RowRaw { u32x4 w[2]; };
__device__ __forceinline__ void row_raw_load(RowRaw& r, const bf16_t* p, int lane) { r.w[0] = ((const u32x4*)p)[lane]; r.w[1] = ((const u32x4*)p)[lane + 64]; }
__device__ __forceinline__ void row_from_raw(Row16& r, const RowRaw& q) {
#pragma unroll
    for (int b = 0; b < 2; ++b) { const u32x4 w = q.w[b]; r.v[2 * b] = (f32x4){bflo(w.x), bfhi(w.x), bflo(w.y), bfhi(w.y)}; r.v[2 * b + 1] = (f32x4){bflo(w.z), bfhi(w.z), bflo(w.w), bfhi(w.w)}; }
}
__device__ __forceinline__ void row_load_bf16(Row16& r, const bf16_t* p, int lane) { RowRaw q; row_raw_load(q, p, lane); row_from_raw(r, q); }
__device__ __forceinline__ void row_store_f32(const Row16& r, float* p, int lane) {
#pragma unroll
    for (int j = 0; j < 4; ++j) pg8::store16_wt((f32x4*)p + row_q(lane, j), __builtin_bit_cast(u32x4, r.v[j]));
}
__device__ __forceinline__ void row_store_bf16(const Row16& r, bf16_t* p, int lane) {
#pragma unroll
    for (int b = 0; b < 2; ++b) { u32x4 w; w.x = cvtpk(r.v[2 * b][0], r.v[2 * b][1]); w.y = cvtpk(r.v[2 * b][2], r.v[2 * b][3]); w.z = cvtpk(r.v[2 * b + 1][0], r.v[2 * b + 1][1]); w.w = cvtpk(r.v[2 * b + 1][2], r.v[2 * b + 1][3]);
        pg8::store16_wt((u32x4*)p + lane + 64 * b, w); }
}
__device__ __forceinline__ void vec_load(Row16& r, const float* g, int lane) { row_load_f32(r, g, lane); }
__device__ __forceinline__ void row_rmsnorm_v(Row16& r, const Row16& g) {
    float s = 0.f;
#pragma unroll
    for (int j = 0; j < 4; ++j) s += r.v[j][0] * r.v[j][0] + r.v[j][1] * r.v[j][1] + r.v[j][2] * r.v[j][2] + r.v[j][3] * r.v[j][3];
    const float rs = rsqrtf(wave_sum(s) * (1.f / D) + NORM_EPS);
#pragma unroll
    for (int j = 0; j < 4; ++j) r.v[j] = r.v[j] * rs * g.v[j];
}
__device__ __forceinline__ void row_rmsnorm(Row16& r, const float* g, int lane) { Row16 gg; vec_load(gg, g, lane); row_rmsnorm_v(r, gg); }

constexpr int TR_SCR_BYTES = 64 * 65 * 4;
template <class ScaleFn>
__device__ __forceinline__ void transpose_item(const float* W, int ldw, int N, bf16_t* WT, int ldt, int row_off, int koff, LAS float* scr, int item, int lane, ScaleFn sc) {
    const int nblk = N / 64, kb = item / nblk, nb = item % nblk, k0 = 64 * kb, n0 = 64 * nb;
    const int lk = lane >> 4, ln4 = (lane & 15) * 4;
    f32x4 v[16];
#pragma unroll
    for (int i = 0; i < 16; ++i) v[i] = *(const f32x4*)(W + (size_t)(k0 + 4 * i + lk) * ldw + n0 + ln4);
#pragma unroll
    for (int i = 0; i < 16; ++i) { const int kk = 4 * i + lk; const float s = sc(k0 + kk); LAS float* d = scr + kk * 65 + ln4; d[0] = v[i][0] * s; d[1] = v[i][1] * s; d[2] = v[i][2] * s; d[3] = v[i][3] * s; }
    asm volatile("s_waitcnt lgkmcnt(0)" ::: "memory");
    const int c = lane >> 3, nn = lane & 7;
#pragma unroll
    for (int j = 0; j < 8; ++j) { const int n = nn + 8 * j; const LAS float* s = scr + (8 * c) * 65 + n;
        u32x4 o; o.x = cvtpk(s[0 * 65], s[1 * 65]); o.y = cvtpk(s[2 * 65], s[3 * 65]); o.z = cvtpk(s[4 * 65], s[5 * 65]); o.w = cvtpk(s[6 * 65], s[7 * 65]);
        pg8::store16_wt(WT + (size_t)(row_off + n0 + n) * ldt + koff + k0 + 8 * c, o); }
    asm volatile("s_waitcnt lgkmcnt(0)" ::: "memory");
}
struct ScaleOne { __device__ __forceinline__ float operator()(int) const { return 1.f; } };
struct ScaleVec { const float* g; __device__ __forceinline__ float operator()(int k) const { return g[k]; } };
struct ScaleMix { const float* mp; const float* mn; int part;
    __device__ __forceinline__ float operator()(int k) const { return part == 0 ? 1.f - mp[k] - mn[k] : (part == 1 ? mp[k] : mn[k]); } };

struct Args { const float* in[27]; float* out; unsigned char* ws; };

struct ProbPlain { const bf16_t* A; const bf16_t* Bt; int K;
    __device__ __forceinline__ const char* a_tile(const pg8::Unit& u) const { return (const char*)(A + (size_t)u.pm * 256 * K); }
    __device__ __forceinline__ const char* b_tile(const pg8::Unit& u) const { return (const char*)(Bt + (size_t)u.pn * 256 * K); } };
struct DstPlain { bf16_t* C; int ldc;
    __device__ __forceinline__ void operator()(const pg8::Unit& u, bf16_t*& base, int& ld) const { base = C + (size_t)u.pm * 256 * ldc + (size_t)u.pn * 256; ld = ldc; } };
struct ProbRKL { const unsigned char* ws; int K;
    __device__ __forceinline__ const char* a_tile(const pg8::Unit& u) const { const int g = u.pn < 4 ? 0 : (u.pn < 8 ? 1 : 2); const int ga = g == 2 ? 0 : g + 1;
        return (const char*)(ws + WS_XN + (size_t)ga * (32 * MiB) + (size_t)u.pm * 256 * D * 2); }
    __device__ __forceinline__ const char* b_tile(const pg8::Unit& u) const { const int g = u.pn < 4 ? 0 : (u.pn < 8 ? 1 : 2); const int t = u.pn - 4 * g;
        return (const char*)(ws + WS_WR_T + (size_t)g * (2 * MiB) + (size_t)t * 256 * D * 2); } };
struct DstRKL { unsigned char* ws;
    __device__ __forceinline__ void operator()(const pg8::Unit& u, bf16_t*& base, int& ld) const {
        const int g = u.pn < 4 ? 0 : (u.pn < 8 ? 1 : 2); const int t = u.pn - 4 * g; ld = g == 2 ? NLD : D;
        base = (bf16_t*)(ws + WS_R + (size_t)g * (32 * MiB)) + (size_t)u.pm * 256 * ld + (size_t)t * 256; } };


struct EpiHeadMajor {
    static constexpr bool PERM = true;
    bf16_t* O;
    __device__ __forceinline__ void operator()(const f32x4 (&acc)[2][2][4][2], const pg8::Unit& u, int wr, int wc, int fr, int fq) const {
        const int row0 = u.pm * 256 + wr * 64 + fr, col = (wc & 1) * 32 + 8 * fq;
#pragma unroll
        for (int bj = 0; bj < 2; ++bj) { bf16_t* hb = O + ((size_t)(u.pn * 4 + bj * 2 + (wc >> 1)) * M + row0) * 64 + col;
#pragma unroll
            for (int ai = 0; ai < 2; ++ai)
#pragma unroll
                for (int m = 0; m < 4; ++m) { const f32x4 v0 = acc[ai][bj][m][0], v1 = acc[ai][bj][m][1];
                    u32x4 w; w.x = cvtpk(v0[0], v0[1]); w.y = cvtpk(v0[2], v0[3]); w.z = cvtpk(v1[0], v1[1]); w.w = cvtpk(v1[2], v1[3]);
                    pg8::store16_wt(hb + (size_t)(ai * 128 + m * 16) * 64, w); } }
    }
};

template <int ACT, class Prob, class Dst>
__device__ __forceinline__ void run_gemm(LAS unsigned char* lds, const Prob& P, const Dst& Dd, int Mr, int Nv, int G) {
    pg8::StaticOrder S; S.init(Mr, Nv, G, (int)blockIdx.x);
    pg8::EpiBf16<ACT, Dst> E{Dd, nullptr};
    for (int rep = 0; rep < REP_GEMM; ++rep) pg8::gemm_phase<pg8::EpiBf16<ACT, Dst>, Prob, true, true>(lds, P, S, E);
}
template <int ACT, class Prob, class Dst>
__device__ __forceinline__ void run_gemm_rs(LAS unsigned char* lds, const Prob& P, const Dst& Dd, const float* rs, int Mr, int Nv, int G) {
    pg8::StaticOrder S; S.init(Mr, Nv, G, (int)blockIdx.x);
    pg8::EpiBf16<ACT, Dst, true> E{Dd, rs};
    pg8::gemm_phase<pg8::EpiBf16<ACT, Dst, true>, Prob, true, true>(lds, P, S, E);
}

template <bool BASE_F32, bool OUT_F32>
__device__ __forceinline__ void phase_resnorm(const void* base, const bf16_t* TMP, const float* g1, const float* g2, void* hout, bf16_t* XN, float* rs_out, int gw, int NGW, int lane) {
    Row16 G1, G2; vec_load(G1, g1, lane); if (XN) vec_load(G2, g2, lane);
    for (int row = gw; row < M; row += NGW) {
        Row16 t, b; row_load_bf16(t, TMP + (size_t)row * D, lane);
        if (BASE_F32) row_load_f32(b, (const float*)base + (size_t)row * D, lane); else row_load_bf16(b, (const bf16_t*)base + (size_t)row * D, lane);
        row_rmsnorm_v(t, G1);
#pragma unroll
        for (int j = 0; j < 4; ++j) b.v[j] = b.v[j] + t.v[j];
        if (OUT_F32) row_store_f32(b, (float*)hout + (size_t)row * D, lane); else row_store_bf16(b, (bf16_t*)hout + (size_t)row * D, lane);
        if (XN) { row_rmsnorm_v(b, G2); row_store_bf16(b, XN + (size_t)row * D, lane); }
        if (rs_out) {
            float s = 0.f;
#pragma unroll
            for (int j = 0; j < 4; ++j) s += b.v[j][0] * b.v[j][0] + b.v[j][1] * b.v[j][1] + b.v[j][2] * b.v[j][2] + b.v[j][3] * b.v[j][3];
            const float rsv = rsqrtf(wave_sum(s) * (1.f / D) + NORM_EPS);
            if (lane == 0) rs_out[row] = rsv; }
    }
}
__device__ __forceinline__ void phase_lda(const bf16_t* LDO, bf16_t* LDA, int gw, int NGW, int lane) {
    const float A = lane < 16 ? 2.f : 1.f, C = lane < 16 ? -1.f : 0.f; const bool id = lane >= 16 && lane < 32;
    for (int row = gw; row < M; row += NGW) { const int tt = row & (SEQ - 1);
        const u32x4 p0 = *(const u32x4*)(LDO + (size_t)row * NLD + 8 * lane);
        const u32x4 p1 = *(const u32x4*)(LDO + (size_t)(tt > 0 ? row - 1 : row) * NLD + 512 + 8 * lane), p2 = *(const u32x4*)(LDO + (size_t)(tt < SEQ - 1 ? row + 1 : row) * NLD + 1024 + 8 * lane);
        const float mp = tt > 0 ? 1.f : 0.f, mn = tt < SEQ - 1 ? 1.f : 0.f;
        u32x4 o;
#pragma unroll
        for (int w = 0; w < 4; ++w) { const float x0 = bflo(p0[w]) + mp * bflo(p1[w]) + mn * bflo(p2[w]), x1 = bfhi(p0[w]) + mp * bfhi(p1[w]) + mn * bfhi(p2[w]);
            const float y0 = A * __builtin_amdgcn_rcpf(1.f + __builtin_amdgcn_exp2f(-1.4426950408889634f * A * x0)) + C, y1 = A * __builtin_amdgcn_rcpf(1.f + __builtin_amdgcn_exp2f(-1.4426950408889634f * A * x1)) + C;
            o[w] = cvtpk(id ? x0 : y0, id ? x1 : y1); }
        pg8::store16_wt(LDA + (size_t)row * 512 + 8 * lane, o); }
}
__device__ __forceinline__ void mix_out(const Row16& up, const Row16& u, const Row16& un, const LAS f32x4* a, const LAS f32x4* b, bf16_t* dst, int lane) {
    Row16 o;
#pragma unroll
    for (int j = 0; j < 4; ++j) { const f32x4 av = a[j * 64 + lane], bv = b[j * 64 + lane]; o.v[j] = u.v[j] + (up.v[j] - u.v[j]) * av + (un.v[j] - u.v[j]) * bv; }
    row_store_bf16(o, dst, lane);
}
__device__ __forceinline__ void phase_mix3(LAS unsigned char* lds, const bf16_t* h, const float* g, const float* mup, const float* mun, bf16_t* XN, bf16_t* MR, bf16_t* MK, bf16_t* MV, int gw, int NGW, int tid, int lane) {
    LAS f32x4* mv = (LAS f32x4*)lds;
    __syncthreads();
    for (int x = tid; x < 6 * 256; x += NTHREADS) { const int vec = x >> 8, q = x & 255, c = vec < 2 ? 0 : (vec < 4 ? 2 : 3);
        const f32x4 val = ((const f32x4*)(((vec & 1) ? mun : mup) + c * D))[q];
        mv[vec * 256 + (2 * (q >> 7) + (q & 1)) * 64 + ((q & 127) >> 1)] = val; }
    __syncthreads();
    Row16 Gn; vec_load(Gn, g, lane);
    for (int ch = gw; ch < M / 8; ch += NGW) {
        const int r0 = ch * 8, t0 = r0 & (SEQ - 1);
        const bool hasp = t0 > 0, hasn = t0 + 8 < SEQ;
        const int rlast = hasn ? r0 + 8 : r0 + 7;
        RowRaw r0w, rA, rB, rC;
        row_raw_load(r0w, h + (size_t)(hasp ? r0 - 1 : r0) * D, lane);
        row_raw_load(rA, h + (size_t)r0 * D, lane); row_raw_load(rB, h + (size_t)(r0 + 1) * D, lane); row_raw_load(rC, h + (size_t)(r0 + 2) * D, lane);
        Row16 up, u, un;
        row_from_raw(up, r0w); row_rmsnorm_v(up, Gn);
        { const float m = hasp ? 1.f : 0.f;
#pragma unroll
          for (int j = 0; j < 4; ++j) up.v[j] = up.v[j] * m; }
        row_from_raw(u, rA); row_rmsnorm_v(u, Gn);
        rA = rB; rB = rC;
#pragma unroll 1
        for (int k = 1; k <= 8; ++k) {
            const int row = r0 - 1 + k;
            { const int nx = row + 3; row_raw_load(rC, h + (size_t)(nx < rlast ? nx : rlast) * D, lane); }
            row_from_raw(un, rA); row_rmsnorm_v(un, Gn);
            { const float m = (k == 8 && !hasn) ? 0.f : 1.f;
#pragma unroll
              for (int j = 0; j < 4; ++j) un.v[j] = un.v[j] * m; }
            row_store_bf16(u, XN + (size_t)row * D, lane);
            mix_out(up, u, un, mv, mv + 256, MR + (size_t)row * D, lane);
            mix_out(up, u, un, mv + 512, mv + 768, MK + (size_t)row * D, lane);
            mix_out(up, u, un, mv + 1024, mv + 1280, MV + (size_t)row * D, lane);
            up = u; u = un; rA = rB; rB = rC;
        }
    }
}

constexpr int ATT_ROWS = 400, ATT_KS = 0, ATT_VS = ATT_ROWS * 128, ATT_TAB = 2 * ATT_ROWS * 128, ATT_TABN = 320;
constexpr float LOG2E = 1.4426950408889634f;
typedef short v4i16_t __attribute__((ext_vector_type(4)));
__device__ __forceinline__ v4i16_t lds_tr16(LAS const unsigned char* p) { return __builtin_amdgcn_ds_read_tr16_b64_v4i16((LAS v4i16_t*)p); }

__device__ __forceinline__ float fmax_q(float a, float b) { return __builtin_amdgcn_fmed3f(a, b, __builtin_inff()); }
__device__ __forceinline__ float rows_max(float x) {
    auto a = __builtin_amdgcn_permlane16_swap(__float_as_uint(x), __float_as_uint(x), false, false); x = fmax_q(__uint_as_float(a[0]), __uint_as_float(a[1]));
    auto b = __builtin_amdgcn_permlane32_swap(__float_as_uint(x), __float_as_uint(x), false, false); return fmax_q(__uint_as_float(b[0]), __uint_as_float(b[1])); }
__device__ __forceinline__ float rows_sum(float x) {
    auto a = __builtin_amdgcn_permlane16_swap(__float_as_uint(x), __float_as_uint(x), false, false); x = __uint_as_float(a[0]) + __uint_as_float(a[1]);
    auto b = __builtin_amdgcn_permlane32_swap(__float_as_uint(x), __float_as_uint(x), false, false); return __uint_as_float(b[0]) + __uint_as_float(b[1]); }
struct AttnIO { const bf16_t* QKV; const float* rel_table; const float* sink; bf16_t* O; bf16_t* OBR; float* LSE; };
struct AttnUnitD { int b, dil, res, l0, nq, L, R, colK, colV, head0, ngroups, nit, branch, isB; };
__device__ __forceinline__ AttnUnitD attn_decode(int u) {
    AttnUnitD A;
    if (u < 256) { A.isB = 1; A.b = u >> 5; const int kvg = (u >> 4) & 1, blk = u & 15; A.dil = 1; A.res = 0; A.l0 = blk * 128; A.nq = 128; A.L = SEQ; A.R = 128; A.colK = 32 + kvg; A.colV = 34 + kvg; A.head0 = kvg * 4; A.ngroups = 32; A.nit = 9; A.branch = 0; }
    else if (u < 1280) { A.isB = 0; const int a = u - 256, bh = a >> 4, k = a & 15; A.b = bh >> 3; A.head0 = bh & 7; A.nq = 256; A.R = 64; A.ngroups = 16; A.nit = 5;
        if (k < 8) { A.dil = 1; A.res = 0; A.l0 = k * 256; A.L = SEQ; A.branch = 0; } else { A.dil = 4; A.res = (k - 8) >> 1; A.l0 = ((k - 8) & 1) * 256; A.L = SEQ / 4; A.branch = 1; }
        A.colK = 8 + A.head0; A.colV = 16 + A.head0; }
    else { A.isB = 0; const int a = u - 1280, bh = a >> 4; A.b = bh >> 3; A.head0 = bh & 7; A.dil = 16; A.res = a & 15; A.l0 = 0; A.nq = 128; A.L = SEQ / 16; A.R = 64; A.ngroups = 8; A.nit = 5; A.branch = 2; A.colK = 8 + A.head0; A.colV = 16 + A.head0; }
    return A;
}
constexpr int ATT_NST = 7;
__device__ __forceinline__ void attn_issue(const AttnUnitD& A, const bf16_t* QKV, int tid, u32x4 (&kr)[ATT_NST], u32x4 (&vr)[ATT_NST]) {
    const int ndata = A.nq + 2 * A.R, rv0 = (A.R - A.l0) > 0 ? (A.R - A.l0) : 0, rv1 = (A.L + A.R - A.l0) < ndata ? (A.L + A.R - A.l0) : ndata;
    const bf16_t* kb = QKV + ((size_t)A.colK * M + (size_t)A.b * SEQ) * 64; const bf16_t* vb = QKV + ((size_t)A.colV * M + (size_t)A.b * SEQ) * 64;
#pragma unroll
    for (int i = 0; i < ATT_NST; ++i) { const int x = tid + NTHREADS * i, c = x & 7; int row = x >> 3; row = row < rv0 ? rv0 : (row >= rv1 ? rv1 - 1 : row);
        const size_t o = (size_t)(A.res + A.dil * (A.l0 - A.R + row)) * 64 + c * 8; kr[i] = *(const u32x4*)(kb + o); vr[i] = *(const u32x4*)(vb + o); }
}

__device__ __forceinline__ void phase_attn(LAS unsigned char* lds, const AttnIO& io, int vcu, int G) {
    int tid = threadIdx.x; asm volatile("" : "+v"(tid));
    const int lane = tid & 63, wid = __builtin_amdgcn_readfirstlane(tid >> 6), g4 = lane >> 4, qi = lane & 15;
    LAS unsigned char* Ks = lds + ATT_KS; LAS unsigned char* Vs = lds + ATT_VS; LAS float* tab = (LAS float*)(lds + ATT_TAB);
    constexpr int NU = 256 + 1024 + 1024;
    u32x4 kr[ATT_NST], vr[ATT_NST];
    if (vcu < NU) { const AttnUnitD A0 = attn_decode(vcu); attn_issue(A0, io.QKV, tid, kr, vr); }
    for (int u = vcu; u < NU; u += G) {
        const AttnUnitD A = attn_decode(u);
        const int b = A.b, dil = A.dil, res = A.res, l0 = A.l0, R = A.R, head0 = A.head0, ngroups = A.ngroups, nit = A.nit, branch = A.branch; const bool isB = A.isB != 0;
        const int ndata = A.nq + 2 * R, rv0 = (R - l0) > 0 ? (R - l0) : 0, rv1 = (A.L + R - l0) < ndata ? (A.L + R - l0) : ndata;
        auto qptr = [&](int gx) -> const bf16_t* { const int hq_ = isB ? (gx >> 3) : 0, gi_ = isB ? (gx & 7) : gx; const int posq_ = res + dil * (l0 + 16 * gi_ + qi);
            return io.QKV + ((size_t)((isB ? 24 : 0) + head0 + hq_) * M + (size_t)b * SEQ + posq_) * 64 + 8 * g4; };
        u32x4 qr0, qr1; { const bf16_t* qp0 = qptr(wid); qr0 = *(const u32x4*)qp0; qr1 = *(const u32x4*)(qp0 + 32); }
        for (int reps = 0; reps < REP_ATTS; ++reps) {
        __syncthreads();
#pragma unroll
        for (int i = 0; i < ATT_NST; ++i) { const int x = tid + NTHREADS * i, row = x >> 3, c = x & 7;
            if (x < ATT_ROWS * 8) { const int off = row * 128 + ((c ^ (row & 7)) << 4); const bool ok = row >= rv0 && row < rv1; const u32x4 z = (u32x4){0u, 0u, 0u, 0u};
                *(LAS u32x4*)(Ks + off) = ok ? kr[i] : z; *(LAS u32x4*)(Vs + off) = ok ? vr[i] : z; } }
        { const int ntab = isB ? 4 : 1;
          for (int x = tid; x < ntab * ATT_TABN; x += NTHREADS) { const int t = x / ATT_TABN, j = x % ATT_TABN, idx = j - 16;
              float v = -1e30f;
              if (idx >= 0 && idx <= 2 * R) v = io.rel_table[t5_bucket((idx - R) * dil) * 16 + (isB ? 8 + head0 + t : head0)] * LOG2E;
              tab[x] = v; } }
        }
        if (u + G < NU) { const AttnUnitD An = attn_decode(u + G); attn_issue(An, io.QKV, tid, kr, vr); }
        __syncthreads();
        for (int rep = 0; rep < REP_ATTC; ++rep)
        for (int gidx = wid; gidx < ngroups; gidx += NWAVES) {
            const int hq = isB ? (gidx >> 3) : 0, gi = isB ? (gidx & 7) : gidx, head = head0 + hq;
            const int ql = 16 * gi + qi, posq = res + dil * (l0 + ql);
            const LAS float* tb = tab + hq * ATT_TABN + 16;
            bf16x8 qf[2];
            { const u32x4 wq[2] = {qr0, qr1}; const float SC = 0.125f * LOG2E;
              { const int gn = gidx + NWAVES < ngroups ? gidx + NWAVES : gidx; const bf16_t* qpn = qptr(gn); qr0 = *(const u32x4*)qpn; qr1 = *(const u32x4*)(qpn + 32); }
#pragma unroll
              for (int ks = 0; ks < 2; ++ks) { const u32x4 w = wq[ks]; u32x4 o;
                  o.x = cvtpk(bflo(w.x) * SC, bfhi(w.x) * SC); o.y = cvtpk(bflo(w.y) * SC, bfhi(w.y) * SC); o.z = cvtpk(bflo(w.z) * SC, bfhi(w.z) * SC); o.w = cvtpk(bflo(w.w) * SC, bfhi(w.w) * SC);
                  qf[ks] = __builtin_bit_cast(bf16x8, o); } }
            f32x4 ot[4], lacc = (f32x4){0.f, 0.f, 0.f, 0.f};
#pragma unroll
            for (int dt = 0; dt < 4; ++dt) ot[dt] = (f32x4){0.f, 0.f, 0.f, 0.f};
            float m = -1e20f;
            const bf16x8 ones = __builtin_bit_cast(bf16x8, qi == 0 ? (u32x4){0x3F803F80u, 0x3F803F80u, 0x3F803F80u, 0x3F803F80u} : (u32x4){0u, 0u, 0u, 0u});
            bf16x8 kf[2][2];
            const LAS unsigned char* kp[2];
            { const int r0 = 16 * gi + qi;
#pragma unroll
              for (int ks = 0; ks < 2; ++ks) { const int c = g4 + 4 * ks; kp[ks] = Ks + r0 * 128 + ((c ^ (r0 & 7)) << 4); asm volatile("" : "+v"(kp[ks]));
                  kf[ks][0] = *(const LAS bf16x8*)(kp[ks]); kf[ks][1] = *(const LAS bf16x8*)(kp[ks] + 16 * 128); } }
            const LAS unsigned char* vp[4];
            { const int ra0 = 16 * gi + 4 * g4 + (qi >> 2);
#pragma unroll
              for (int dt = 0; dt < 4; ++dt) { const int ch = dt * 2 + ((qi & 3) >> 1); vp[dt] = Vs + ra0 * 128 + ((ch ^ (ra0 & 7)) << 4) + 8 * (qi & 1); asm volatile("" : "+v"(vp[dt])); } }
            const LAS float* tbq = tb + 4 * g4 - qi; asm volatile("" : "+v"(tbq));
            f32x4 c0, c1;
#pragma unroll
            for (int r = 0; r < 4; ++r) { c0[r] = tbq[r]; c1[r] = tbq[16 + r]; }
            for (int it = 0; it < nit; ++it) {
                const int rb = 16 * gi + 32 * it;
                v4i16_t vlo[4], vhi[4];
#pragma unroll
                for (int dt = 0; dt < 4; ++dt) { vlo[dt] = lds_tr16(vp[dt]); vhi[dt] = lds_tr16(vp[dt] + 16 * 128); vp[dt] += 4096; }
                f32x4 s0 = c0, s1 = c1;
#pragma unroll
                for (int ks = 0; ks < 2; ++ks) { s0 = __builtin_amdgcn_mfma_f32_16x16x32_bf16(kf[ks][0], qf[ks], s0, 0, 0, 0); s1 = __builtin_amdgcn_mfma_f32_16x16x32_bf16(kf[ks][1], qf[ks], s1, 0, 0, 0); }
                if (it + 1 < nit) {
#pragma unroll
                    for (int ks = 0; ks < 2; ++ks) { kp[ks] += 4096; kf[ks][0] = *(const LAS bf16x8*)(kp[ks]); kf[ks][1] = *(const LAS bf16x8*)(kp[ks] + 16 * 128); } }
                tbq += 32;
#pragma unroll
                for (int r = 0; r < 4; ++r) { c0[r] = tbq[r]; c1[r] = tbq[16 + r]; }
                float v[8];
                if (rb < rv0 || rb + 32 > rv1) {
#pragma unroll
                    for (int r = 0; r < 4; ++r) { const int row0 = rb + 4 * g4 + r, row1 = row0 + 16;
                        const bool ok0 = (unsigned)(row0 - rv0) < (unsigned)(rv1 - rv0), ok1 = (unsigned)(row1 - rv0) < (unsigned)(rv1 - rv0);
                        v[r] = ok0 ? s0[r] : -1e30f; v[4 + r] = ok1 ? s1[r] : -1e30f; }
                } else {
#pragma unroll
                    for (int r = 0; r < 4; ++r) { v[r] = s0[r]; v[4 + r] = s1[r]; }
                }
                float d[8];
#pragma unroll
                for (int i = 0; i < 8; ++i) d[i] = v[i] - m;
                const float dm = fmaxf(fmaxf(fmaxf(d[0], d[1]), fmaxf(d[2], d[3])), fmaxf(fmaxf(d[4], d[5]), fmaxf(d[6], d[7])));
                if (__builtin_amdgcn_ballot_w64(dm > 8.f) != 0ull) {
                    float tmax = fmaxf(fmaxf(fmaxf(v[0], v[1]), fmaxf(v[2], v[3])), fmaxf(fmaxf(v[4], v[5]), fmaxf(v[6], v[7])));
                    tmax = rows_max(tmax);
                    const float mn = fmaxf(m, tmax), alpha = __builtin_amdgcn_exp2f(m - mn); m = mn;
                    lacc[0] = lacc[0] * alpha;
#pragma unroll
                    for (int dt = 0; dt < 4; ++dt) ot[dt] = ot[dt] * alpha;
#pragma unroll
                    for (int i = 0; i < 8; ++i) d[i] = v[i] - mn;
                }
#pragma unroll
                for (int i = 0; i < 8; ++i) v[i] = __builtin_amdgcn_exp2f(d[i]);
                u32x4 pw; pw.x = cvtpk(v[0], v[1]); pw.y = cvtpk(v[2], v[3]); pw.z = cvtpk(v[4], v[5]); pw.w = cvtpk(v[6], v[7]);
                const bf16x8 pf = __builtin_bit_cast(bf16x8, pw);
                lacc = __builtin_amdgcn_mfma_f32_16x16x32_bf16(ones, pf, lacc, 0, 0, 0);
#pragma unroll
                for (int dt = 0; dt < 4; ++dt) { const bf16x8 vf = (bf16x8){vlo[dt][0], vlo[dt][1], vlo[dt][2], vlo[dt][3], vhi[dt][0], vhi[dt][1], vhi[dt][2], vhi[dt][3]};
                    ot[dt] = __builtin_amdgcn_mfma_f32_16x16x32_bf16(vf, pf, ot[dt], 0, 0, 0); }
            }
            float lsum = lacc[0];
            lsum = rows_sum(lsum);
            const size_t tok = (size_t)b * SEQ + posq;
            float scale;
            if (isB) { const float s2 = io.sink[head] * LOG2E, mf = fmaxf(m, s2), e = __builtin_amdgcn_exp2f(m - mf); scale = e / (lsum * e + __builtin_amdgcn_exp2f(s2 - mf)); }
            else { scale = 1.f / lsum; if (g4 == 0) io.LSE[((size_t)branch * M + tok) * 8 + head] = m + __builtin_amdgcn_logf(lsum); }
            bf16_t* op = isB ? io.O + tok * D + 512 + head * 64 : io.OBR + ((size_t)branch * M + tok) * 512 + head * 64;
#pragma unroll
            for (int dt = 0; dt < 4; ++dt) { const f32x4 o = ot[dt] * scale; u32x2 w; w.x = cvtpk(o[0], o[1]); w.y = cvtpk(o[2], o[3]); *(u32x2*)(op + dt * 16 + 4 * g4) = w; }
        }
    }
}
__device__ __forceinline__ void phase_attn_merge(const AttnIO& io, int gtid, int NGT) {
    for (int x = gtid; x < M * 64; x += NGT) { const int tok = x >> 6, head = (x >> 3) & 7, c8 = x & 7;
        const float l0 = io.LSE[((size_t)0 * M + tok) * 8 + head], l1 = io.LSE[((size_t)1 * M + tok) * 8 + head], l2 = io.LSE[((size_t)2 * M + tok) * 8 + head];
        const float mx = fmaxf(l0, fmaxf(l1, l2)); float w0 = __builtin_amdgcn_exp2f(l0 - mx), w1 = __builtin_amdgcn_exp2f(l1 - mx), w2 = __builtin_amdgcn_exp2f(l2 - mx);
        const float inv = 1.f / (w0 + w1 + w2); w0 *= inv; w1 *= inv; w2 *= inv;
        const size_t o = (size_t)tok * 512 + head * 64 + c8 * 8;
        const u32x4 a = *(const u32x4*)(io.OBR + o), bq = *(const u32x4*)(io.OBR + (size_t)M * 512 + o), c = *(const u32x4*)(io.OBR + (size_t)2 * M * 512 + o);
        u32x4 r;
        r.x = pk2(w0 * bflo(a.x) + w1 * bflo(bq.x) + w2 * bflo(c.x), w0 * bfhi(a.x) + w1 * bfhi(bq.x) + w2 * bfhi(c.x));
        r.y = pk2(w0 * bflo(a.y) + w1 * bflo(bq.y) + w2 * bflo(c.y), w0 * bfhi(a.y) + w1 * bfhi(bq.y) + w2 * bfhi(c.y));
        r.z = pk2(w0 * bflo(a.z) + w1 * bflo(bq.z) + w2 * bflo(c.z), w0 * bfhi(a.z) + w1 * bfhi(bq.z) + w2 * bfhi(c.z));
        r.w = pk2(w0 * bflo(a.w) + w1 * bflo(bq.w) + w2 * bflo(c.w), w0 * bfhi(a.w) + w1 * bfhi(bq.w) + w2 * bfhi(c.w));
        pg8::store16_wt(io.O + (size_t)tok * D + head * 64 + c8 * 8, r); }
}

constexpr int NCH = SEQ / 16;
constexpr int SC_LROW = 68, SC_LDROW = 528, SC_LSLOT = 4 * 16 * SC_LROW * 4 + 16 * SC_LDROW;
constexpr int CT_KHT = 0, CT_RHT = 2048, CT_BTT = 4096, CT_KTT = 6144, CT_VT = 8192, CT_WEND = 10240, CT_RKT = CT_WEND + 256, CT_SLOT = CT_RKT + 2048;
constexpr int GT_AKK = 0, GT_BB = 512, GT_BK = 1024, GT_TT = 1536, GT_SLOT = 2048;
constexpr int SC_LBUF = 0, SC_CT = SC_LBUF + 2 * SC_LSLOT, SC_GG = SC_CT + 3 * CT_SLOT, SC_RKR = SC_GG + 4 * 4096, SC_GT = SC_RKR + 4 * 256, SC_NB = SC_GT + 2 * GT_SLOT, SC_OUT = SC_NB + 1024, SC_END = SC_OUT + 2 * 4096;
static_assert(SC_END <= LDSCTL_OFF, "scan LDS map");
template <int CTRL> __device__ __forceinline__ float dpp_f(float x) { return __int_as_float(__builtin_amdgcn_update_dpp(0, __float_as_int(x), CTRL, 0xf, 0xf, true)); }
__device__ __forceinline__ float sum8(float x) { x += dpp_f<0xB1>(x); x += dpp_f<0x4E>(x); x += dpp_f<0x141>(x); return x; }
__device__ __forceinline__ float sum16(float x) { x += dpp_f<0xB1>(x); x += dpp_f<0x4E>(x); x += dpp_f<0x141>(x); x += dpp_f<0x140>(x); return x; }
__device__ __forceinline__ float fast_sigmoid(float z) { return __builtin_amdgcn_rcpf(1.f + __builtin_amdgcn_exp2f(-LOG2E * z)); }
__device__ __forceinline__ bf16x8 mk8(unsigned a, unsigned b, unsigned c, unsigned d) { return __builtin_bit_cast(bf16x8, (u32x4){a, b, c, d}); }

struct ScanPtrs { const bf16_t *R, *Kk, *V, *LDA; bf16_t* Y; const float *w2, *a2, *g2, *w0, *a0, *k_k, *k_a, *r_k, *gn_w, *gn_b; };
__device__ __forceinline__ void phase_scan(LAS unsigned char* lds, const ScanPtrs& P, int G) {
    int tid = threadIdx.x; asm volatile("" : "+v"(tid));
    const int lane = tid & 63, wid = __builtin_amdgcn_readfirstlane(tid >> 6), g4 = lane >> 4, c16 = lane & 15;
    for (int unit = blockIdx.x; unit < 256; unit += G) {
        const int b = unit >> 5, h = (unit >> 1) & 15, d = unit & 1, hc = h * 64;
        unsigned long long wait_acc = 0ull;
        __syncthreads();
        if (wid < 4) {
            f32x4 ST[4];
#pragma unroll
            for (int mt = 0; mt < 4; ++mt) ST[mt] = (f32x4){0.f, 0.f, 0.f, 0.f};
            const int pch = hc + 8 * (lane & 7);
            const f32x4 gw0 = *(const f32x4*)(P.gn_w + pch), gw1 = *(const f32x4*)(P.gn_w + pch + 4), gb0 = *(const f32x4*)(P.gn_b + pch), gb1 = *(const f32x4*)(P.gn_b + pch + 4);
            u32x4 pvA = {0u, 0u, 0u, 0u}, pvB = pvA;
            auto issueV = [&](int ch_, u32x4& dst) { const int s = 8 * (wid - 1) + (lane >> 3), t = d ? (SEQ - 1 - (ch_ * 16 + s)) : (ch_ * 16 + s); dst = *(const u32x4*)(P.V + ((size_t)b * SEQ + t) * D + pch); };
            if (wid == 1 || wid == 2) { issueV(0, pvA); issueV(1, pvB); }
            auto sw_interval = [&](int i, u32x4& pvset) {
                const int c = i - 3;
                int ln = lane; asm volatile("" : "+v"(ln)); const int g4 = ln >> 4, c16 = ln & 15;
                if (c >= 0 && c < NCH) {
                    const LAS unsigned char* Ct = lds + SC_CT + (c % 3) * CT_SLOT; const LAS unsigned char* Gt = lds + SC_GT + (c & 1) * GT_SLOT;
                    v4i16_t kha[2][2], rha[2][2];
#pragma unroll
                    for (int p = 0; p < 2; ++p)
#pragma unroll
                        for (int hh = 0; hh < 2; ++hh) { const int off = (32 * p + 16 * hh + 4 * g4 + (c16 >> 2)) * 32 + 8 * (c16 & 3); kha[p][hh] = lds_tr16(Ct + CT_KHT + off); rha[p][hh] = lds_tr16(Ct + CT_RHT + off); }
                    const u32x2 gakk = *(const LAS u32x2*)(Gt + GT_AKK + c16 * 32 + 8 * g4), gtt = *(const LAS u32x2*)(Gt + GT_TT + c16 * 32 + 8 * g4);
                    const u32x2 gbb = *(const LAS u32x2*)(Gt + GT_BB + c16 * 32 + 8 * g4), gbk = *(const LAS u32x2*)(Gt + GT_BK + c16 * 32 + 8 * g4);
                    const u32x2 vt = *(const LAS u32x2*)(Ct + CT_VT + (16 * wid + c16) * 32 + 8 * g4);
                    u32x2 btt[4], ktt[4]; f32x4 we[4];
#pragma unroll
                    for (int mt = 0; mt < 4; ++mt) { btt[mt] = *(const LAS u32x2*)(Ct + CT_BTT + (16 * mt + c16) * 32 + 8 * g4); ktt[mt] = *(const LAS u32x2*)(Ct + CT_KTT + (16 * mt + c16) * 32 + 8 * g4);
                        we[mt] = *(const LAS f32x4*)(Ct + CT_WEND + (16 * mt + 4 * g4) * 4); }
                    f32x4 pt = {0.f, 0.f, 0.f, 0.f}, prt = pt;
#pragma unroll
                    for (int p = 0; p < 2; ++p) { const bf16x8 sb = mk8(cvtpk(ST[2 * p][0], ST[2 * p][1]), cvtpk(ST[2 * p][2], ST[2 * p][3]), cvtpk(ST[2 * p + 1][0], ST[2 * p + 1][1]), cvtpk(ST[2 * p + 1][2], ST[2 * p + 1][3]));
                        pt = __builtin_amdgcn_mfma_f32_16x16x32_bf16((bf16x8){kha[p][0][0], kha[p][0][1], kha[p][0][2], kha[p][0][3], kha[p][1][0], kha[p][1][1], kha[p][1][2], kha[p][1][3]}, sb, pt, 0, 0, 0);
                        prt = __builtin_amdgcn_mfma_f32_16x16x32_bf16((bf16x8){rha[p][0][0], rha[p][0][1], rha[p][0][2], rha[p][0][3], rha[p][1][0], rha[p][1][1], rha[p][1][2], rha[p][1][3]}, sb, prt, 0, 0, 0); }
                    const f32x4 qt = __builtin_amdgcn_mfma_f32_16x16x32_bf16(mk8(gakk.x, gakk.y, 0u, 0u), mk8(vt.x, vt.y, 0u, 0u), pt, 0, 0, 0);
                    const f32x4 sat = __builtin_amdgcn_mfma_f32_16x16x32_bf16(mk8(gtt.x, gtt.y, 0u, 0u), mk8(cvtpk(qt[0], qt[1]), cvtpk(qt[2], qt[3]), 0u, 0u), (f32x4){0.f, 0.f, 0.f, 0.f}, 0, 0, 0);
                    const bf16x8 sv = mk8(cvtpk(sat[0], sat[1]), cvtpk(sat[2], sat[3]), vt.x, vt.y);
                    const f32x4 outt = __builtin_amdgcn_mfma_f32_16x16x32_bf16(mk8(gbb.x, gbb.y, gbk.x, gbk.y), sv, prt, 0, 0, 0);
#pragma unroll
                    for (int mt = 0; mt < 4; ++mt) { ST[mt] = __builtin_amdgcn_mfma_f32_16x16x32_bf16(mk8(btt[mt].x, btt[mt].y, ktt[mt].x, ktt[mt].y), sv, ST[mt], 0, 0, 0); ST[mt] = ST[mt] * we[mt]; }
                    LAS float* ob = (LAS float*)(lds + SC_OUT + (c & 1) * 4096) + 16 * wid + c16;
#pragma unroll
                    for (int r = 0; r < 4; ++r) ob[(4 * g4 + r) * 64] = outt[r];
                }
                for (int rep_ = 0; rep_ < REP_ST; ++rep_)
                if (i >= 2 && i - 2 < NCH) {
                    const int jg = i - 2, hw = wid;
                    const LAS unsigned char* Ct = lds + SC_CT + (jg % 3) * CT_SLOT; LAS unsigned char* Gt = lds + SC_GT + (jg & 1) * GT_SLOT;
                    const int aoff = (hw & 1) ? CT_KTT : CT_BTT, boff = (hw & 2) ? CT_RHT : CT_KHT;
                    f32x4 gm = {0.f, 0.f, 0.f, 0.f}, gmT = gm;
#pragma unroll
                    for (int ks = 0; ks < 2; ++ks) { const int o1 = (8 * g4 + 32 * ks + (c16 >> 2)) * 32 + 8 * (c16 & 3), o2 = o1 + 4 * 32;
                        const v4i16_t a0 = lds_tr16(Ct + aoff + o1), a1 = lds_tr16(Ct + aoff + o2), b0 = lds_tr16(Ct + boff + o1), b1 = lds_tr16(Ct + boff + o2);
                        const bf16x8 af = {a0[0], a0[1], a0[2], a0[3], a1[0], a1[1], a1[2], a1[3]}, bfr = {b0[0], b0[1], b0[2], b0[3], b1[0], b1[1], b1[2], b1[3]};
                        gm = __builtin_amdgcn_mfma_f32_16x16x32_bf16(af, bfr, gm, 0, 0, 0);
                        if (hw == 0) gmT = __builtin_amdgcn_mfma_f32_16x16x32_bf16(bfr, af, gmT, 0, 0, 0); }
                    if (hw == 3) {
                        const bf16x8 onesB = __builtin_bit_cast(bf16x8, c16 == 0 ? (u32x4){0x3F803F80u, 0x3F803F80u, 0x3F803F80u, 0x3F803F80u} : (u32x4){0u, 0u, 0u, 0u});
                        f32x4 rk = {0.f, 0.f, 0.f, 0.f};
#pragma unroll
                        for (int ks = 0; ks < 2; ++ks) { const int o1 = (8 * g4 + 32 * ks + (c16 >> 2)) * 32 + 8 * (c16 & 3), o2 = o1 + 4 * 32;
                            const v4i16_t r0 = lds_tr16(Ct + CT_RKT + o1), r1 = lds_tr16(Ct + CT_RKT + o2);
                            rk = __builtin_amdgcn_mfma_f32_16x16x32_bf16((bf16x8){r0[0], r0[1], r0[2], r0[3], r1[0], r1[1], r1[2], r1[3]}, onesB, rk, 0, 0, 0); }
                        if (c16 == 0) ((LAS f32x4*)(lds + SC_RKR + (jg & 3) * 256))[g4] = rk; }
#pragma unroll
                    for (int r = 0; r < 4; ++r) { const int s = 4 * g4 + r; const bool keep = (hw & 2) ? (s <= c16) : (s < c16); gm[r] = keep ? gm[r] : 0.f; gmT[r] = (c16 < s) ? gmT[r] : 0.f; }
                    if (hw != 0) { *(LAS u32x2*)(Gt + (hw == 1 ? GT_AKK : (hw == 2 ? GT_BB : GT_BK)) + c16 * 32 + 8 * g4) = (u32x2){cvtpk(gm[0], gm[1]), cvtpk(gm[2], gm[3])}; }
                    else {
#define SC_OPA(x) mk8(cvtpk((x)[0], (x)[1]), cvtpk((x)[2], (x)[3]), 0u, 0u)
                        const f32x4 z4 = {0.f, 0.f, 0.f, 0.f};
                        f32x4 Rm, RTm;
#pragma unroll
                        for (int r = 0; r < 4; ++r) { const float idn = (4 * g4 + r == c16) ? 1.f : 0.f; Rm[r] = idn - gm[r]; RTm[r] = idn - gmT[r]; }
                        const f32x4 N2 = __builtin_amdgcn_mfma_f32_16x16x32_bf16(SC_OPA(gmT), SC_OPA(gm), z4, 0, 0, 0), N2T = __builtin_amdgcn_mfma_f32_16x16x32_bf16(SC_OPA(gm), SC_OPA(gmT), z4, 0, 0, 0);
                        f32x4 R1 = __builtin_amdgcn_mfma_f32_16x16x32_bf16(SC_OPA(RTm), SC_OPA(N2), Rm, 0, 0, 0), R1T = __builtin_amdgcn_mfma_f32_16x16x32_bf16(SC_OPA(N2), SC_OPA(RTm), RTm, 0, 0, 0);
                        const f32x4 N4 = __builtin_amdgcn_mfma_f32_16x16x32_bf16(SC_OPA(N2T), SC_OPA(N2), z4, 0, 0, 0), N4T = __builtin_amdgcn_mfma_f32_16x16x32_bf16(SC_OPA(N2), SC_OPA(N2T), z4, 0, 0, 0);
                        f32x4 R2 = __builtin_amdgcn_mfma_f32_16x16x32_bf16(SC_OPA(R1T), SC_OPA(N4), R1, 0, 0, 0), R2T = __builtin_amdgcn_mfma_f32_16x16x32_bf16(SC_OPA(N4), SC_OPA(R1T), R1T, 0, 0, 0);
                        const f32x4 N8 = __builtin_amdgcn_mfma_f32_16x16x32_bf16(SC_OPA(N4T), SC_OPA(N4), z4, 0, 0, 0);
                        const f32x4 Tm = __builtin_amdgcn_mfma_f32_16x16x32_bf16(SC_OPA(R2T), SC_OPA(N8), R2, 0, 0, 0);
#undef SC_OPA
                        *(LAS u32x2*)(Gt + GT_TT + c16 * 32 + 8 * g4) = (u32x2){cvtpk(-Tm[0], -Tm[1]), cvtpk(-Tm[2], -Tm[3])};
                    }
                }
                if ((wid == 1 || wid == 2) && i >= 4 && i - 4 < NCH) {
                    const int jp = i - 4, tl = ln >> 3, c8 = ln & 7;
                    const int s = 8 * (wid - 1) + tl, t = d ? (SEQ - 1 - (jp * 16 + s)) : (jp * 16 + s);
                    const LAS float* ob = (const LAS float*)(lds + SC_OUT + (jp & 1) * 4096) + s * 64 + 8 * c8; const LAS float* gp = (const LAS float*)(lds + SC_GG + (jp & 3) * 4096) + s * 64 + 8 * c8;
                    const f32x4 o0 = *(const LAS f32x4*)(ob), o1 = *(const LAS f32x4*)(ob + 4), g0 = *(const LAS f32x4*)(gp), g1 = *(const LAS f32x4*)(gp + 4);
                    const float rkr = ((const LAS float*)(lds + SC_RKR + (jp & 3) * 256))[s];
                    const u32x4 pv = pvset;
                    const f32x4 v0 = {bflo(pv.x), bfhi(pv.x), bflo(pv.y), bfhi(pv.y)}, v1 = {bflo(pv.z), bfhi(pv.z), bflo(pv.w), bfhi(pv.w)};
                    float mu = ((o0[0] + o0[1]) + (o0[2] + o0[3])) + ((o1[0] + o1[1]) + (o1[2] + o1[3])); mu = sum8(mu) * (1.f / 64.f);
                    const f32x4 d0 = o0 - mu, d1 = o1 - mu; float var = ((d0[0] * d0[0] + d0[1] * d0[1]) + (d0[2] * d0[2] + d0[3] * d0[3])) + ((d1[0] * d1[0] + d1[1] * d1[1]) + (d1[2] * d1[2] + d1[3] * d1[3])); var = sum8(var) * (1.f / 64.f);
                    const float rs = rsqrtf(var + GN_EPS);
                    const f32x4 y0 = (d0 * rs * gw0 + gb0 + rkr * v0) * g0, y1 = (d1 * rs * gw1 + gb1 + rkr * v1) * g1;
                    pg8::store16_wt(P.Y + ((size_t)b * SEQ + t) * (2 * D) + d * D + hc + 8 * c8, (u32x4){cvtpk(y0[0], y0[1]), cvtpk(y0[2], y0[3]), cvtpk(y1[0], y1[1]), cvtpk(y1[2], y1[3])});
                    issueV(jp + 2 < NCH ? jp + 2 : NCH - 1, pvset);
                }
                for (int rep_ = 0; rep_ < REP_SYNC; ++rep_) __syncthreads();
                if (WAITPROBE >= 0) { const unsigned long long t0_ = __builtin_amdgcn_s_memrealtime(); __syncthreads(); wait_acc += __builtin_amdgcn_s_memrealtime() - t0_; } else
                __syncthreads();
            };
            static_assert((NCH + 4) % 2 == 0, "interval loop is unrolled by two");
            __builtin_amdgcn_s_setprio(2);
            for (int i = 0; i < NCH + 4; i += 2) { sw_interval(i, pvA); sw_interval(i + 1, pvB); }
            __builtin_amdgcn_s_setprio(0);
        } else {
            const int hw = wid - 4;
            const int chC = hc + 16 * hw + c16, chT = hc + 4 * c16;
            bf16x8 bw[2], ba[2], bg[4];
#pragma unroll
            for (int ks = 0; ks < 2; ++ks) { u32x4 w, a;
#pragma unroll
                for (int jj = 0; jj < 4; ++jj) { const int k = 32 * ks + 8 * g4 + 2 * jj;
                    w[jj] = pk2(-LOG2E * P.w2[(size_t)(d * 64 + k) * D + chC], -LOG2E * P.w2[(size_t)(d * 64 + k + 1) * D + chC]); a[jj] = pk2(-LOG2E * P.a2[(size_t)(d * 64 + k) * D + chC], -LOG2E * P.a2[(size_t)(d * 64 + k + 1) * D + chC]); }
                bw[ks] = __builtin_bit_cast(bf16x8, w); ba[ks] = __builtin_bit_cast(bf16x8, a); }
#pragma unroll
            for (int ks = 0; ks < 4; ++ks) { u32x4 g;
#pragma unroll
                for (int jj = 0; jj < 4; ++jj) { const int k = 32 * ks + 8 * g4 + 2 * jj; g[jj] = pk2(P.g2[(size_t)(d * 128 + k) * D + chC], P.g2[(size_t)(d * 128 + k + 1) * D + chC]); }
                bg[ks] = __builtin_bit_cast(bf16x8, g); }
            const float w0c = -LOG2E * P.w0[d * D + chC], a0c = -LOG2E * P.a0[d * D + chC], kaC = P.k_a[chC], rkC = P.r_k[chC];
            const f32x4 kkT = *(const f32x4*)(P.k_k + chT);
            const int n0 = 16 * c16, lcol = n0 < 64 ? (d * 64 + n0) : (n0 < 128 ? (128 + d * 64 + (n0 - 64)) : (256 + d * 128 + (n0 - 128)));
            struct LSet { u32x2 r, k, v; u32x4 l0, l1; };
            LSet setA, setB;
            auto issueL = [&](int ch_, LSet& S) { const int s = 4 * hw + g4, t = d ? (SEQ - 1 - (ch_ * 16 + s)) : (ch_ * 16 + s); const size_t row = (size_t)b * SEQ + t;
                S.r = *(const u32x2*)(P.R + row * D + chT); S.k = *(const u32x2*)(P.Kk + row * D + chT); S.v = *(const u32x2*)(P.V + row * D + chT);
                S.l0 = *(const u32x4*)(P.LDA + row * 512 + lcol); S.l1 = *(const u32x4*)(P.LDA + row * 512 + lcol + 8); };
            issueL(0, setA); issueL(1, setB);
            auto hw_interval = [&](int i, LSet& LS) {
                const bool doL = i < NCH, doC = (i >= 1 && i - 1 < NCH);
                int ln = lane; asm volatile("" : "+v"(ln)); const int g4 = ln >> 4, c16 = ln & 15;
                const unsigned long long tb_ = (SECPROBE >= 0) ? __builtin_amdgcn_s_memrealtime() : 0ull;
                for (int rep_ = 0; rep_ < REP_HC; ++rep_)
                if (doC) {
                    const int jc = i - 1;
                    const LAS unsigned char* Ls = lds + SC_LBUF + (jc & 1) * SC_LSLOT;
                    const LAS unsigned char* ldp = Ls + 4 * 16 * SC_LROW * 4 + c16 * SC_LDROW + 16 * g4;
                    f32x4 zw = {w0c, w0c, w0c, w0c}, za = {a0c, a0c, a0c, a0c}, gg = {0.f, 0.f, 0.f, 0.f};
#pragma unroll
                    for (int ks = 0; ks < 2; ++ks) { zw = __builtin_amdgcn_mfma_f32_16x16x32_bf16(*(const LAS bf16x8*)(ldp + 64 * ks), bw[ks], zw, 0, 0, 0);
                                                     za = __builtin_amdgcn_mfma_f32_16x16x32_bf16(*(const LAS bf16x8*)(ldp + 128 + 64 * ks), ba[ks], za, 0, 0, 0); }
#pragma unroll
                    for (int ks = 0; ks < 4; ++ks) gg = __builtin_amdgcn_mfma_f32_16x16x32_bf16(*(const LAS bf16x8*)(ldp + 256 + 64 * ks), bg[ks], gg, 0, 0, 0);
                    float lw[4], cw[4]; float tot = 0.f;
#pragma unroll
                    for (int r = 0; r < 4; ++r) { lw[r] = (-0.6065306597f * LOG2E) * __builtin_amdgcn_rcpf(1.f + __builtin_amdgcn_exp2f(zw[r])); tot += lw[r]; cw[r] = tot; }
                    float pre;
                    { auto e = __builtin_amdgcn_permlane16_swap(__float_as_uint(tot), __float_as_uint(tot), false, false); const float e0 = __uint_as_float(e[0]), s01 = e0 + __uint_as_float(e[1]);
                      auto f = __builtin_amdgcn_permlane32_swap(__float_as_uint(s01), __float_as_uint(s01), false, false);
                      pre = ((g4 & 1) ? e0 : 0.f) + ((g4 & 2) ? __uint_as_float(f[0]) : 0.f); }
                    const LAS float* Lf = (const LAS float*)Ls + 16 * hw + c16;
                    LAS unsigned char* Ct = lds + SC_CT + (jc % 3) * CT_SLOT;
                    LAS float* ggw = (LAS float*)(lds + SC_GG + (jc & 3) * 4096) + 16 * hw + c16;
                    float kh[4], rh[4], bt[4], kt[4], vv[4], rkp[4];
                    float Wprev = __builtin_amdgcn_exp2f(pre);
#pragma unroll
                    for (int r = 0; r < 4; ++r) { const int tok = 4 * g4 + r; const float c = pre + cw[r];
                        const float Wc = __builtin_amdgcn_exp2f(c), Wp = Wprev, iW = __builtin_amdgcn_exp2f(-c); Wprev = Wc;
                        const float a = __builtin_amdgcn_rcpf(1.f + __builtin_amdgcn_exp2f(za[r]));
                        const float rr = Lf[tok * SC_LROW], kk_ = Lf[16 * SC_LROW + tok * SC_LROW], nk = Lf[32 * SC_LROW + tok * SC_LROW]; vv[r] = Lf[48 * SC_LROW + tok * SC_LROW];
                        const float kd = kk_ * (1.f + (a - 1.f) * kaC);
                        kh[r] = nk * Wp; rh[r] = rr * Wc; bt[r] = nk * a * iW; kt[r] = kd * iW; rkp[r] = rr * kd * rkC;
                        ggw[tok * 64] = gg[r];
                        if (tok == 15) ((LAS float*)(Ct + CT_WEND))[16 * hw + c16] = Wc; }
                    { LAS unsigned char* tq = Ct + (16 * hw + c16) * 32 + 8 * g4;
                      *(LAS u32x2*)(tq + CT_KHT) = (u32x2){cvtpk(kh[0], kh[1]), cvtpk(kh[2], kh[3])}; *(LAS u32x2*)(tq + CT_RHT) = (u32x2){cvtpk(rh[0], rh[1]), cvtpk(rh[2], rh[3])};
                      *(LAS u32x2*)(tq + CT_BTT) = (u32x2){cvtpk(bt[0], bt[1]), cvtpk(bt[2], bt[3])}; *(LAS u32x2*)(tq + CT_KTT) = (u32x2){cvtpk(kt[0], kt[1]), cvtpk(kt[2], kt[3])};
                      *(LAS u32x2*)(tq + CT_VT) = (u32x2){cvtpk(vv[0], vv[1]), cvtpk(vv[2], vv[3])};
                      *(LAS u32x2*)(tq + CT_RKT) = (u32x2){cvtpk(rkp[0], rkp[1]), cvtpk(rkp[2], rkp[3])}; }
                }
                const unsigned long long tc_ = (SECPROBE >= 0) ? __builtin_amdgcn_s_memrealtime() : 0ull;
                for (int rep_ = 0; rep_ < REP_HL; ++rep_)
                if (doL) {
                    LAS unsigned char* Ls = lds + SC_LBUF + (i & 1) * SC_LSLOT; LAS float* Lf = (LAS float*)Ls;
                    const int s = 4 * hw + g4;
                    const u32x2 lr = LS.r, lk = LS.k, lv = LS.v; const u32x4 l00 = LS.l0, l01 = LS.l1;
                    const f32x4 rr = {bflo(lr.x), bfhi(lr.x), bflo(lr.y), bfhi(lr.y)}, kk_ = {bflo(lk.x), bfhi(lk.x), bflo(lk.y), bfhi(lk.y)}, vv = {bflo(lv.x), bfhi(lv.x), bflo(lv.y), bfhi(lv.y)};
                    f32x4 nk = kk_ * kkT; float ss = nk[0] * nk[0] + nk[1] * nk[1] + nk[2] * nk[2] + nk[3] * nk[3];
                    ss = sum16(ss);
                    nk = nk * __builtin_amdgcn_rsqf(fmaxf(ss, 1e-24f));
                    *(LAS f32x4*)(Lf + s * SC_LROW + 4 * c16) = rr; *(LAS f32x4*)(Lf + 16 * SC_LROW + s * SC_LROW + 4 * c16) = kk_;
                    *(LAS f32x4*)(Lf + 32 * SC_LROW + s * SC_LROW + 4 * c16) = nk; *(LAS f32x4*)(Lf + 48 * SC_LROW + s * SC_LROW + 4 * c16) = vv;
                    *(LAS u32x4*)(Ls + 4 * 16 * SC_LROW * 4 + s * SC_LDROW + 32 * c16) = l00; *(LAS u32x4*)(Ls + 4 * 16 * SC_LROW * 4 + s * SC_LDROW + 32 * c16 + 16) = l01;
                    issueL(i + 2 < NCH ? i + 2 : NCH - 1, LS);
                }
                for (int rep_ = 0; rep_ < REP_SYNC; ++rep_) __syncthreads();
                if (SECPROBE >= 0) { asm volatile("s_waitcnt vmcnt(0) lgkmcnt(0)" ::: "memory"); const unsigned long long te_ = __builtin_amdgcn_s_memrealtime(); wait_acc += (SECPROBE == 0) ? (tc_ - tb_) : ((SECPROBE == 1) ? (te_ - tc_) : (te_ - tb_)); __syncthreads(); } else
                if (WAITPROBE >= 0) { const unsigned long long t0_ = __builtin_amdgcn_s_memrealtime(); __syncthreads(); wait_acc += __builtin_amdgcn_s_memrealtime() - t0_; } else
                __syncthreads();
            };
            for (int i = 0; i < NCH + 4; i += 2) { hw_interval(i, setA); hw_interval(i + 1, setB); }
        }
        if ((WAITPROBE >= 0 || SECPROBE >= 0) && blockIdx.x == 0 && wid == (SECPROBE >= 0 ? 4 : WAITPROBE)) { const unsigned long long tgt_ = __builtin_amdgcn_s_memrealtime() + 4ull * wait_acc; while (__builtin_amdgcn_s_memrealtime() < tgt_) __builtin_amdgcn_s_sleep(8); }
    }
}

__global__ void __launch_bounds__(NTHREADS, 2) fwd_megakernel(Args args) {
    extern __shared__ __attribute__((aligned(16))) unsigned char lds_raw[];
    LAS unsigned char* lds = (LAS unsigned char*)lds_raw;
    volatile LAS unsigned* MISC = (volatile LAS unsigned*)(lds + MISC_OFF);
    const int tid0 = threadIdx.x, wave = __builtin_amdgcn_readfirstlane(tid0 >> 6);
#define FRESH_LANE() int tid = tid0; asm volatile("" : "+v"(tid)); const int lane = tid & 63; (void)lane
    const int G = gridDim.x;
    const int vcu = (G % 8 == 0) ? ((int)blockIdx.x % 8) * (G / 8) + (int)blockIdx.x / 8 : (int)blockIdx.x;
    const int gw = vcu * NWAVES + wave, NGW = G * NWAVES;
    unsigned char* ws = args.ws;
    unsigned* ctl = (unsigned*)(ws + WS_CTL);
    for (int u = tid0; u < (LDS_BYTES - LDSCTL_OFF) / 4; u += NTHREADS) ((LAS unsigned*)(lds + LDSCTL_OFF))[u] = 0u;
    __syncthreads();
    XcdBarrier bar = xcd_barrier_post(ctl + CW_BAR, MISC + 8);
    unsigned long long ts_a = 0ull; int ts_n = 0;
#define STAMP() do { if (TS_A >= 0) { const unsigned long long t_ = __builtin_amdgcn_s_memrealtime(); if (ts_n == TS_A) ts_a = t_; \
    if (ts_n == TS_B && blockIdx.x == 0) { const unsigned long long tgt_ = t_ + 4ull * (t_ - ts_a); while (__builtin_amdgcn_s_memrealtime() < tgt_) __builtin_amdgcn_s_sleep(8); } ++ts_n; } } while (0)
#define GRID_BAR() do { xcd_barrier(bar); STAMP(); } while (0)
    STAMP();

    const float* x = args.in[0]; const float* rel_table = args.in[1]; const float* norm_g = args.in[2]; const float* attn_w_in = args.in[3]; const float* attn_sink = args.in[4];
    const float* attn_w_out = args.in[5]; const float* mu_prev = args.in[6]; const float* mu_next = args.in[7]; const float* w_r = args.in[8]; const float* w_k = args.in[9];
    const float* w_v = args.in[10]; const float* w_o = args.in[11]; const float* mlp_w1 = args.in[25]; const float* mlp_w2 = args.in[26];
    bf16_t* HBa = (bf16_t*)args.out; bf16_t* HBb = HBa + (size_t)M * D; bf16_t* HBc = (bf16_t*)(ws + WS_HBC); bf16_t* TMP2 = (bf16_t*)(ws + WS_TMP2);
    bf16_t* XN = (bf16_t*)(ws + WS_XN); bf16_t* QKV = (bf16_t*)(ws + WS_QKV); bf16_t* Ob = (bf16_t*)(ws + WS_O); bf16_t* TMP = (bf16_t*)(ws + WS_TMP); bf16_t* Hb = (bf16_t*)(ws + WS_H);
    bf16_t* MIXA = (bf16_t*)(ws + WS_MIXA); bf16_t* MIXB = (bf16_t*)(ws + WS_MIXB); bf16_t* Rb = (bf16_t*)(ws + WS_R); bf16_t* Kb = (bf16_t*)(ws + WS_K); bf16_t* Vb = (bf16_t*)(ws + WS_V);
    bf16_t* LDO = (bf16_t*)(ws + WS_LDO); bf16_t* Yb = (bf16_t*)(ws + WS_Y);
    LAS float* scr = (LAS float*)(lds + wave * TR_SCR_BYTES);
    float* RS = (float*)(ws + WS_CTL + 128 * 1024);

    {
        FRESH_LANE();
        constexpr int I_IN = (D / 64) * (DIN / 64), I_OUT = (D / 64) * (D / 64), I_1 = (D / 64) * (DFF / 64), I_2 = (DFF / 64) * (D / 64);
        const bool tail = (G == 256);
        for (int it = gw; it < (tail ? I_IN : I_IN + I_OUT + I_1 + I_2); it += NGW) { int r = it;
            if (r < I_IN) { transpose_item(attn_w_in, DIN, DIN, (bf16_t*)(ws + WS_WIN_T), D, 0, 0, scr, r, lane, ScaleOne{}); continue; } r -= I_IN;
            if (r < I_OUT) { transpose_item(attn_w_out, D, D, (bf16_t*)(ws + WS_WOUT_T), D, 0, 0, scr, r, lane, ScaleOne{}); continue; } r -= I_OUT;
            if (r < I_1) { transpose_item(mlp_w1, DFF, DFF, (bf16_t*)(ws + WS_W1_T), D, 0, 0, scr, r, lane, ScaleVec{norm_g + 2 * D}); continue; } r -= I_1;
            transpose_item(mlp_w2, D, D, (bf16_t*)(ws + WS_W2_T), DFF, 0, 0, scr, r, lane, ScaleOne{}); }
        for (int row = gw; row < M; row += NGW) { Row16 r; row_load_f32(r, x + (size_t)row * D, lane); row_rmsnorm(r, norm_g, lane); row_store_bf16(r, XN + (size_t)row * D, lane); }
    }
    GRID_BAR();
    { pg8::StaticOrder S; S.init(M, DIN, G, (int)blockIdx.x); const EpiHeadMajor E{QKV};
      for (int rep = 0; rep < REP_GEMM; ++rep) pg8::gemm_phase<EpiHeadMajor, ProbPlain, true, true>(lds, ProbPlain{XN, (const bf16_t*)(ws + WS_WIN_T), D}, S, E); }
    if (G == 256 && blockIdx.x >= 64) {
        FRESH_LANE();
        constexpr int I_OUT = (D / 64) * (D / 64), I_1 = (D / 64) * (DFF / 64), I_2 = (DFF / 64) * (D / 64);
        for (int it = ((int)blockIdx.x - 64) * NWAVES + wave; it < I_OUT + I_1 + I_2; it += 192 * NWAVES) { int r = it;
            if (r < I_OUT) { transpose_item(attn_w_out, D, D, (bf16_t*)(ws + WS_WOUT_T), D, 0, 0, scr, r, lane, ScaleOne{}); continue; } r -= I_OUT;
            if (r < I_1) { transpose_item(mlp_w1, DFF, DFF, (bf16_t*)(ws + WS_W1_T), D, 0, 0, scr, r, lane, ScaleVec{norm_g + 2 * D}); continue; } r -= I_1;
            transpose_item(mlp_w2, D, D, (bf16_t*)(ws + WS_W2_T), DFF, 0, 0, scr, r, lane, ScaleOne{}); }
    }
    GRID_BAR();
    { const AttnIO io{QKV, rel_table, attn_sink, Ob, (bf16_t*)(ws + WS_OBR), (float*)(ws + WS_LSE)};
      for (int rep = 0; rep < REP_ATT; ++rep) phase_attn(lds, io, vcu, G);
      GRID_BAR();
      { FRESH_LANE(); phase_attn_merge(io, vcu * NTHREADS + tid, G * NTHREADS); } }
    GRID_BAR();
    for (int rep = 0; rep < REP_BAR; ++rep) GRID_BAR();
    run_gemm<0>(lds, ProbPlain{Ob, (const bf16_t*)(ws + WS_WOUT_T), D}, DstPlain{TMP, D}, M, D, G);
    GRID_BAR();
    { FRESH_LANE(); phase_resnorm<true, false>(x, TMP, norm_g + D, nullptr, HBa, nullptr, RS, gw, NGW, lane); }
    GRID_BAR();
    run_gemm_rs<1>(lds, ProbPlain{HBa, (const bf16_t*)(ws + WS_W1_T), D}, DstPlain{Hb, DFF}, RS, M, DFF, G);
    GRID_BAR();
    run_gemm<0>(lds, ProbPlain{Hb, (const bf16_t*)(ws + WS_W2_T), DFF}, DstPlain{TMP, D}, M, D, G);
    GRID_BAR();
    { FRESH_LANE(); phase_resnorm<false, false>(HBa, TMP, norm_g + 3 * D, nullptr, HBb, nullptr, nullptr, gw, NGW, lane); }
    GRID_BAR();
    {
        FRESH_LANE();
        const float* g1n = norm_g + 4 * D;
        constexpr int I_SQ = (D / 64) * (D / 64), I_1 = (D / 64) * (DFF / 64), I_2 = (DFF / 64) * (D / 64), I_LD = 384;
        const bool tail = (G == 256);
        for (int it = gw; it < (tail ? 2 * I_SQ + I_2 + I_LD : 4 * I_SQ + I_1 + I_2 + I_LD); it += NGW) { int r = it;
            if (r < I_SQ) { transpose_item(w_r, D, D, (bf16_t*)(ws + WS_WR_T), D, 0, 0, scr, r, lane, ScaleOne{}); continue; } r -= I_SQ;
            if (r < I_SQ) { transpose_item(w_k, D, D, (bf16_t*)(ws + WS_WK_T), D, 0, 0, scr, r, lane, ScaleOne{}); continue; } r -= I_SQ;
            if (!tail) {
                if (r < I_SQ) { transpose_item(w_v, D, D, (bf16_t*)(ws + WS_WV_T), D, 0, 0, scr, r, lane, ScaleOne{}); continue; } r -= I_SQ;
                if (r < I_SQ) { transpose_item(w_o, D, D, (bf16_t*)(ws + WS_WO2_T), D, 0, 0, scr, r, lane, ScaleOne{}); continue; } r -= I_SQ;
                if (r < I_1) { transpose_item(mlp_w1 + (size_t)D * DFF, DFF, DFF, (bf16_t*)(ws + WS_W1B_T), D, 0, 0, scr, r, lane, ScaleVec{norm_g + 6 * D}); continue; } r -= I_1; }
            if (r < I_2) { transpose_item(mlp_w2 + (size_t)DFF * D, D, D, (bf16_t*)(ws + WS_W2B_T), DFF, 0, 0, scr, r, lane, ScaleOne{}); continue; } r -= I_2;
            const int part = r / 128; int q = r % 128; int sub, li;
            if (q < 64) { sub = q / 16; li = q % 16; } else { sub = 4 + (q - 64) / 32; li = (q - 64) % 32; }
            const int dd = sub & 1, kind = sub >> 1;
            const int stream = kind == 0 ? 1 : (kind == 1 ? 4 : 5), Nn = kind == 2 ? 128 : 64;
            const float* src = kind == 0 ? args.in[18] + (size_t)dd * D * 64 : (kind == 1 ? args.in[21] + (size_t)dd * D * 64 : args.in[23] + (size_t)dd * D * 128);
            const int coloff = kind == 0 ? dd * 64 : (kind == 1 ? 128 + dd * 64 : 256 + dd * 128);
            transpose_item(src, Nn, Nn, (bf16_t*)(ws + WS_LDW_T), D, part * 512 + coloff, 0, scr, li, lane, ScaleMix{mu_prev + stream * D, mu_next + stream * D, part}); }
        phase_mix3(lds, HBb, g1n, mu_prev, mu_next, XN, MIXA, MIXB, HBa, gw, NGW, tid, lane);
    }
    GRID_BAR();
    run_gemm<0>(lds, ProbRKL{ws, D}, DstRKL{ws}, M, 14 * 256, G);
    if (G == 256 && blockIdx.x >= 128) {
        FRESH_LANE();
        constexpr int I_SQ = (D / 64) * (D / 64), I_1 = (D / 64) * (DFF / 64);
        for (int it = ((int)blockIdx.x - 128) * NWAVES + wave; it < 2 * I_SQ + I_1; it += 128 * NWAVES) { int r = it;
            if (r < I_SQ) { transpose_item(w_v, D, D, (bf16_t*)(ws + WS_WV_T), D, 0, 0, scr, r, lane, ScaleOne{}); continue; } r -= I_SQ;
            if (r < I_SQ) { transpose_item(w_o, D, D, (bf16_t*)(ws + WS_WO2_T), D, 0, 0, scr, r, lane, ScaleOne{}); continue; } r -= I_SQ;
            transpose_item(mlp_w1 + (size_t)D * DFF, DFF, DFF, (bf16_t*)(ws + WS_W1B_T), D, 0, 0, scr, r, lane, ScaleVec{norm_g + 6 * D}); }
    }
    GRID_BAR();
    { FRESH_LANE(); phase_lda(LDO, (bf16_t*)(ws + WS_LDA), gw, NGW, lane); }
    run_gemm<0>(lds, ProbPlain{HBa, (const bf16_t*)(ws + WS_WV_T), D}, DstPlain{Vb, D}, M, D, G);
    GRID_BAR();
    { ScanPtrs sp{Rb, Kb, Vb, (const bf16_t*)(ws + WS_LDA), Yb, args.in[19], args.in[22], args.in[24], args.in[17], args.in[20], args.in[12], args.in[13], args.in[14], args.in[15], args.in[16]};
      for (int rep = 0; rep < REP_SCAN; ++rep) phase_scan(lds, sp, G); }
    GRID_BAR();
    { FRESH_LANE();
      bf16_t* Ys = (bf16_t*)(ws + WS_YSUM);
      const bool grp_on = (G == 256);
      const int grow0 = 256 * (8 * ((int)blockIdx.x % 8) + ((int)blockIdx.x / 8) % 8) + 64 * ((int)blockIdx.x / 64);
      const int rfirst = grp_on ? grow0 + wave : gw, rend = grp_on ? grow0 + 64 : M, rstride = grp_on ? NWAVES : NGW;
      for (int row = rfirst; row < rend; row += rstride) {
          const u32x4* y0 = (const u32x4*)(Yb + (size_t)row * 2 * D); const u32x4* y1 = (const u32x4*)(Yb + (size_t)row * 2 * D + D);
#pragma unroll
          for (int hb = 0; hb < 2; ++hb) { const u32x4 a = y0[lane + 64 * hb], c = y1[lane + 64 * hb]; u32x4 o;
              o.x = cvtpk(bflo(a.x) + bflo(c.x), bfhi(a.x) + bfhi(c.x)); o.y = cvtpk(bflo(a.y) + bflo(c.y), bfhi(a.y) + bfhi(c.y));
              o.z = cvtpk(bflo(a.z) + bflo(c.z), bfhi(a.z) + bfhi(c.z)); o.w = cvtpk(bflo(a.w) + bflo(c.w), bfhi(a.w) + bfhi(c.w));
              pg8::store16_wt((u32x4*)(Ys + (size_t)row * D) + lane + 64 * hb, o); } }
      if (grp_on) { unsigned ep = 0u; grp_barrier(ctl + CW_BAR, (unsigned)blockIdx.x % 64u, ep); } else GRID_BAR();
      run_gemm<0>(lds, ProbPlain{Ys, (const bf16_t*)(ws + WS_WO2_T), D}, DstPlain{TMP2, D}, M, D, G); }
    GRID_BAR();
    { FRESH_LANE(); phase_resnorm<false, false>(HBb, TMP2, norm_g + 5 * D, nullptr, HBc, nullptr, RS, gw, NGW, lane); }
    GRID_BAR();
    run_gemm_rs<1>(lds, ProbPlain{HBc, (const bf16_t*)(ws + WS_W1B_T), D}, DstPlain{Hb, DFF}, RS, M, DFF, G);
    GRID_BAR();
    run_gemm<0>(lds, ProbPlain{Hb, (const bf16_t*)(ws + WS_W2B_T), DFF}, DstPlain{TMP2, D}, M, D, G);
    GRID_BAR();
    { FRESH_LANE(); phase_resnorm<false, true>(HBc, TMP2, norm_g + 7 * D, nullptr, args.out, nullptr, nullptr, gw, NGW, lane); }
    if (TS_A >= 0) { GRID_BAR(); }
#undef GRID_BAR
}

extern "C" void kernel_launch(void* const* d_in, const int* in_sizes, int n_in, void* d_out, int out_size, void* d_ws, size_t ws_size, hipStream_t stream) {
    static int grid = 0;
    if (grid == 0) {
        if (n_in != 27 || in_sizes[0] != M * D || out_size != M * D || ws_size < WS_END) { fprintf(stderr, "kernel_launch: unexpected shapes (n_in %d, in0 %d, out %d, ws %zu)\n", n_in, n_in > 0 ? in_sizes[0] : -1, out_size, ws_size); grid = -1; return; }
        int dev = 0, cus = 0, per_cu = 0;
        if (hipGetDevice(&dev) != hipSuccess || hipDeviceGetAttribute(&cus, hipDeviceAttributeMultiprocessorCount, dev) != hipSuccess) { grid = -1; return; }
        if (hipFuncSetAttribute((const void*)fwd_megakernel, hipFuncAttributeMaxDynamicSharedMemorySize, LDS_BYTES) != hipSuccess) { fprintf(stderr, "kernel_launch: hipFuncSetAttribute failed\n"); grid = -1; return; }
        if (hipOccupancyMaxActiveBlocksPerMultiprocessor(&per_cu, (const void*)fwd_megakernel, NTHREADS, LDS_BYTES) != hipSuccess || per_cu < 1) { fprintf(stderr, "kernel_launch: occupancy query says %d blocks/CU\n", per_cu); (void)hipGetLastError(); grid = -1; return; }
        grid = cus;
    }
    if (grid < 0) return;
    (void)hipMemsetAsync((char*)d_ws + WS_CTL, 0, CTL_ZERO_BYTES, stream);
    Args a{};
    for (int i = 0; i < 27; ++i) a.in[i] = (const float*)d_in[i];
    a.out = (float*)d_out; a.ws = (unsigned char*)d_ws;
    hipLaunchKernelGGL(fwd_megakernel, dim3(grid), dim3(NTHREADS), LDS_BYTES, stream, a);
}
```

```cpp
#include <hip/hip_runtime.h>
#include <cstdio>
#include <cstdint>

#define LAS __attribute__((address_space(3)))
#define GAS __attribute__((address_space(1)))
typedef unsigned short bf16_t;
typedef short bf16x8 __attribute__((ext_vector_type(8)));
typedef float f32x4 __attribute__((ext_vector_type(4)));
typedef float f32x2 __attribute__((ext_vector_type(2)));
typedef unsigned u32x4 __attribute__((ext_vector_type(4)));
typedef unsigned u32x2 __attribute__((ext_vector_type(2)));

#ifndef REP_SCAN
#define REP_SCAN 1
#endif
#ifndef REP_ATT
#define REP_ATT 1
#endif
#ifndef REP_GEMM
#define REP_GEMM 1
#endif
#ifndef REP_ATTC
#define REP_ATTC 1
#endif
#ifndef REP_BAR
#define REP_BAR 0
#endif
#ifndef REP_ATTS
#define REP_ATTS 1
#endif
#ifndef REP_HC
#define REP_HC 1
#endif
#ifndef REP_ST
#define REP_ST 1
#endif
#ifndef REP_HL
#define REP_HL 1
#endif
#ifndef REP_SYNC
#define REP_SYNC 0
#endif
#ifndef SECPROBE
#define SECPROBE -1
#endif
#ifndef WAITPROBE
#define WAITPROBE -1
#endif
#ifndef TS_A
#define TS_A -1
#endif
#ifndef TS_B
#define TS_B -1
#endif
constexpr int SEQ = 2048, D = 1024, NBATCH = 8, M = NBATCH * SEQ, DFF = 4096, DIN = 2304, NLD = 1536;
constexpr float NORM_EPS = 1e-6f, GN_EPS = 64e-5f;
constexpr int NWAVES = 8, NTHREADS = 512;

namespace pg8 {
constexpr int BM = 256, BK = 64, HALF = 128, HTB = HALF * BK * 2, STAGE_BYTES = 8 * HTB, NXCD = 8, WGM = 8;
__host__ __device__ __forceinline__ int lds_byte(int r, int c) { const int st = (r >> 4) * 2 + (c >> 5), rr = r & 15, cc = c & 31, ob = rr * 64 + cc * 2; return st * 1024 + (ob ^ (((ob >> 9) & 1) << 5)); }
__host__ __device__ __forceinline__ void stage_rc(int b, int& R, int& C) { const int st = b / 1024, sb = b % 1024, swz = sb ^ (((sb >> 9) & 1) << 5); R = (st >> 1) * 16 + swz / 64; C = (st & 1) * 32 + (swz % 64) / 2; }
__host__ __device__ __forceinline__ int perm32(int rho) { const int n = rho >> 4, i = rho & 15; return 8 * (i >> 2) + 4 * n + (i & 3); }

struct Unit { int pm, pn; };
struct StaticOrder {
    int nM, nN, nwg, G, c;
    __host__ __device__ void init(int Mr, int N, int G_, int c_) { nM = Mr / BM; nN = N / BM; nwg = nM * nN; G = G_; c = c_; }
    __host__ __device__ bool next(int i, Unit& u) const {
        const long L = (long)i * G + c; if (L >= nwg) return false;
        int wgid = (int)L; { const int q = nwg / NXCD, r = nwg % NXCD, xcd = wgid % NXCD, off = wgid / NXCD; wgid = (xcd < r ? xcd * (q + 1) : r * (q + 1) + (xcd - r) * q) + off; }
        const int nig = WGM * nN, gid = wgid / nig, fm = gid * WGM, gsz = (nM - fm) < WGM ? (nM - fm) : WGM;
        u.pm = fm + ((wgid % nig) % gsz); u.pn = (wgid % nig) / gsz; return true;
    }
};
__device__ __forceinline__ unsigned cvt_pk_bf16(float lo, float hi) { unsigned r; asm volatile("v_cvt_pk_bf16_f32 %0, %1, %2" : "=v"(r) : "v"(lo), "v"(hi)); return r; }

__device__ __forceinline__ void store16_wt(void* p, u32x4 v) { asm volatile("global_store_dwordx4 %0, %1, off sc1\n\ts_nop 1" :: "v"(p), "v"(v) : "memory"); }
template <int ACT, class DstFn, bool RS = false> struct EpiBf16 {
    static constexpr bool PERM = true;
    DstFn F; const float* rs;
    __device__ __forceinline__ void operator()(const f32x4 (&acc)[2][2][4][2], const Unit& u, int wr, int wc, int fr, int fq) const {
        bf16_t* base; int ldc; F(u, base, ldc);
        const int row0 = wr * 64 + fr, col0 = wc * 32 + 8 * fq;
        float rsc[2][4];
        if (RS) {
#pragma unroll
            for (int ai = 0; ai < 2; ++ai)
#pragma unroll
                for (int m = 0; m < 4; ++m) rsc[ai][m] = rs[u.pm * BM + row0 + ai * HALF + m * 16]; }
        if (RS && ACT == 1) {
            f32x4 t[2][2][4][2];
#pragma unroll
            for (int ai = 0; ai < 2; ++ai)
#pragma unroll
                for (int bj = 0; bj < 2; ++bj)
#pragma unroll
                    for (int m = 0; m < 4; ++m)
#pragma unroll
                        for (int n = 0; n < 2; ++n)
#pragma unroll
                            for (int e = 0; e < 4; ++e) { const float a = fmaxf(acc[ai][bj][m][n][e], 0.f); t[ai][bj][m][n][e] = a * a; }
#pragma unroll
            for (int ai = 0; ai < 2; ++ai)
#pragma unroll
                for (int m = 0; m < 4; ++m) { bf16_t* rowp = base + (size_t)(row0 + ai * HALF + m * 16) * ldc + col0; const float r2 = rsc[ai][m] * rsc[ai][m];
#pragma unroll
                    for (int bj = 0; bj < 2; ++bj) { const f32x4 v0 = t[ai][bj][m][0] * r2, v1 = t[ai][bj][m][1] * r2;
                        u32x4 w; w.x = cvt_pk_bf16(v0[0], v0[1]); w.y = cvt_pk_bf16(v0[2], v0[3]); w.z = cvt_pk_bf16(v1[0], v1[1]); w.w = cvt_pk_bf16(v1[2], v1[3]);
                        store16_wt(rowp + bj * HALF, w); } }
            return;
        }
#pragma unroll
        for (int ai = 0; ai < 2; ++ai)
#pragma unroll
            for (int m = 0; m < 4; ++m) { bf16_t* rowp = base + (size_t)(row0 + ai * HALF + m * 16) * ldc + col0;
#pragma unroll
                for (int bj = 0; bj < 2; ++bj) { f32x4 v0 = acc[ai][bj][m][0], v1 = acc[ai][bj][m][1];
                    if (RS) { v0 = v0 * rsc[ai][m]; v1 = v1 * rsc[ai][m]; }
                    if (ACT == 1) {
#pragma unroll
                        for (int e = 0; e < 4; ++e) { const float a = fmaxf(v0[e], 0.f), b = fmaxf(v1[e], 0.f); v0[e] = a * a; v1[e] = b * b; } }
                    u32x4 w; w.x = cvt_pk_bf16(v0[0], v0[1]); w.y = cvt_pk_bf16(v0[2], v0[3]); w.z = cvt_pk_bf16(v1[0], v1[1]); w.w = cvt_pk_bf16(v1[2], v1[3]);
                    store16_wt(rowp + bj * HALF, w); } }
    }
};

template <class Epi, class Prob, bool ALIGN_EPI, bool SP2>
__device__ __forceinline__ void gemm_phase(LAS unsigned char* lds, const Prob& P, const StaticOrder& S, const Epi& E) {
    int tid = threadIdx.x; asm volatile("" : "+v"(tid));
    const int wid = __builtin_amdgcn_readfirstlane(tid >> 6), lane = tid & 63, wr = wid >> 2, wc = wid & 3, fr = lane & 15, fq = lane >> 4;
    const int K = P.K, nt = K / BK;
    unsigned voffA[2], voffB[2];
#pragma unroll
    for (int i = 0; i < 2; ++i) { int R, C; stage_rc(tid * 16 + i * 8192, R, C); const int Rb = Epi::PERM ? ((R & ~31) + perm32(R & 31)) : R;
        voffA[i] = (unsigned)(R * K + C) * 2u; voffB[i] = (unsigned)(Rb * K + C) * 2u; }
    const size_t kstep = (size_t)(BK * 2);
    const size_t hstep = (size_t)HALF * K * 2;
    const unsigned ldsw = (unsigned)wid * 1024u;
    const int aoff = lds_byte(wr * 64 + fr, fq * 8), boff = lds_byte(wc * 32 + fr, fq * 8);
#define PG8_SA(b, h) (((b) * 2 + (h)) * HTB)
#define PG8_SB(b, h) ((4 + (b) * 2 + (h)) * HTB)
#define PG8_STAGE(bufoff, gbase, voff) do { _Pragma("unroll") for (int _i = 0; _i < 2; ++_i) \
        __builtin_amdgcn_global_load_lds((const unsigned*)((const char*)(gbase) + (voff)[_i]), (LAS unsigned*)(lds + (bufoff) + ldsw + _i * 8192), 16, 0, 0); } while (0)
#define PG8_LDA(dst, b, h) do { _Pragma("unroll") for (int m = 0; m < 4; ++m) _Pragma("unroll") for (int k = 0; k < 2; ++k) dst[m][k] = *(const LAS bf16x8*)(lds + PG8_SA(b, h) + aoff + m * 2048 + k * 1024); } while (0)
#define PG8_LDB(dst, b, h) do { _Pragma("unroll") for (int n = 0; n < 2; ++n) _Pragma("unroll") for (int k = 0; k < 2; ++k) dst[n][k] = *(const LAS bf16x8*)(lds + PG8_SB(b, h) + boff + n * 2048 + k * 1024); } while (0)
#define PG8_MMA(ai, bj, At, Bt) do { __builtin_amdgcn_s_setprio(1); _Pragma("unroll") for (int m = 0; m < 4; ++m) _Pragma("unroll") for (int n = 0; n < 2; ++n) _Pragma("unroll") for (int k = 0; k < 2; ++k) \
        acc[ai][bj][m][n] = __builtin_amdgcn_mfma_f32_16x16x32_bf16(Bt[n][k], At[m][k], acc[ai][bj][m][n], 0, 0, 0); __builtin_amdgcn_s_setprio(0); } while (0)
#define PG8_WAIT_V(n) asm volatile("s_waitcnt vmcnt(" #n ")" ::: "memory")
#define PG8_WAIT_L(n) asm volatile("s_waitcnt lgkmcnt(" #n ")" ::: "memory")
#define PG8_BAR __builtin_amdgcn_s_barrier()
#define PG8_SCHED __builtin_amdgcn_sched_barrier(0)
    Unit cur, nxt; int ui = 0;
    if (!S.next(0, cur)) return;
    f32x4 acc[2][2][4][2];
#pragma unroll
    for (int a = 0; a < 2; ++a)
#pragma unroll
        for (int b = 0; b < 2; ++b)
#pragma unroll
            for (int m = 0; m < 4; ++m)
#pragma unroll
                for (int n = 0; n < 2; ++n) acc[a][b][m][n] = (f32x4){0.f, 0.f, 0.f, 0.f};
    bf16x8 At[4][2], B0[2][2], B1[2][2];
    const char* cA = P.a_tile(cur); const char* cB = P.b_tile(cur);
    if constexpr (SP2) {
        PG8_STAGE(PG8_SB(0, 0), cB, voffB); PG8_STAGE(PG8_SB(0, 1), cB + hstep, voffB); PG8_STAGE(PG8_SA(0, 0), cA, voffA); PG8_STAGE(PG8_SA(0, 1), cA + hstep, voffA);
        if (wr == 1) PG8_BAR;
        PG8_WAIT_V(2); PG8_BAR;
        PG8_STAGE(PG8_SB(1, 0), cB + kstep, voffB); PG8_STAGE(PG8_SA(1, 0), cA + kstep, voffA); PG8_STAGE(PG8_SB(1, 1), cB + hstep + kstep, voffB);
        PG8_WAIT_V(6); PG8_BAR;
    } else {
        PG8_STAGE(PG8_SB(0, 0), cB, voffB); PG8_STAGE(PG8_SA(0, 0), cA, voffA); PG8_STAGE(PG8_SB(0, 1), cB + hstep, voffB); PG8_STAGE(PG8_SA(0, 1), cA + hstep, voffA);
        if (wr == 1) PG8_BAR;
        PG8_WAIT_V(4); PG8_BAR;
        PG8_STAGE(PG8_SB(1, 0), cB + kstep, voffB); PG8_STAGE(PG8_SA(1, 0), cA + kstep, voffA); PG8_STAGE(PG8_SB(1, 1), cB + hstep + kstep, voffB);
        PG8_WAIT_V(6); PG8_BAR;
    }
    for (;;) {
        const bool has_next = S.next(ui + 1, nxt);
        const char* nA = has_next ? P.a_tile(nxt) : cA; const char* nB = has_next ? P.b_tile(nxt) : cB;
        for (int t = 0; t < nt; t += 2) {
            const bool last = (t == nt - 2);
            const char* a1 = cA + (size_t)(t + 1) * kstep;
            const char* a2 = last ? nA : cA + (size_t)(t + 2) * kstep; const char* b2 = last ? nB : cB + (size_t)(t + 2) * kstep;
            const char* a3 = a2 + kstep; const char* b3 = b2 + kstep;
            if constexpr (SP2) {
            PG8_LDB(B0, 0, 0); PG8_LDB(B1, 0, 1); PG8_SCHED; PG8_LDA(At, 0, 0); PG8_STAGE(PG8_SA(1, 1), a1 + hstep, voffA);
            PG8_WAIT_V(8); PG8_WAIT_L(0); PG8_BAR; PG8_MMA(0, 0, At, B0); PG8_MMA(0, 1, At, B1); PG8_BAR; PG8_SCHED;
            PG8_LDA(At, 0, 1); PG8_STAGE(PG8_SB(0, 0), b2, voffB); PG8_STAGE(PG8_SB(0, 1), b2 + hstep, voffB); PG8_STAGE(PG8_SA(0, 0), a2, voffA);
            PG8_WAIT_V(8); PG8_WAIT_L(0); PG8_BAR; PG8_MMA(1, 0, At, B0); PG8_MMA(1, 1, At, B1); PG8_BAR; PG8_SCHED;
            PG8_LDB(B0, 1, 0); PG8_LDB(B1, 1, 1); PG8_SCHED; PG8_LDA(At, 1, 0); PG8_STAGE(PG8_SA(0, 1), a2 + hstep, voffA);
            PG8_WAIT_V(8); PG8_WAIT_L(0); PG8_BAR; PG8_MMA(0, 0, At, B0); PG8_MMA(0, 1, At, B1); PG8_BAR; PG8_SCHED;
            PG8_LDA(At, 1, 1); PG8_STAGE(PG8_SB(1, 0), b3, voffB); PG8_STAGE(PG8_SB(1, 1), b3 + hstep, voffB); PG8_STAGE(PG8_SA(1, 0), a3, voffA);
            PG8_WAIT_V(8); PG8_WAIT_L(0); PG8_BAR; PG8_MMA(1, 0, At, B0); PG8_MMA(1, 1, At, B1); PG8_BAR; PG8_SCHED;
            } else {
            PG8_LDB(B0, 0, 0); PG8_SCHED; PG8_LDA(At, 0, 0); PG8_STAGE(PG8_SA(1, 1), a1 + hstep, voffA);
            PG8_WAIT_L(8); PG8_BAR; PG8_WAIT_L(0); PG8_MMA(0, 0, At, B0); PG8_BAR; PG8_SCHED;
            PG8_LDB(B1, 0, 1); PG8_STAGE(PG8_SB(0, 0), b2, voffB);
            PG8_BAR; PG8_WAIT_L(0); PG8_MMA(0, 1, At, B1); PG8_BAR;
            PG8_LDA(At, 0, 1); PG8_STAGE(PG8_SA(0, 0), a2, voffA);
            PG8_BAR; PG8_WAIT_L(0); PG8_MMA(1, 0, At, B0); PG8_BAR; PG8_SCHED;
            PG8_STAGE(PG8_SB(0, 1), b2 + hstep, voffB);
            PG8_WAIT_V(6); PG8_BAR; PG8_MMA(1, 1, At, B1); PG8_BAR;
            PG8_LDB(B0, 1, 0); PG8_SCHED; PG8_LDA(At, 1, 0); PG8_STAGE(PG8_SA(0, 1), a2 + hstep, voffA);
            PG8_WAIT_L(8); PG8_BAR; PG8_WAIT_L(0); PG8_MMA(0, 0, At, B0); PG8_BAR; PG8_SCHED;
            PG8_LDB(B1, 1, 1); PG8_STAGE(PG8_SB(1, 0), b3, voffB);
            PG8_BAR; PG8_WAIT_L(0); PG8_MMA(0, 1, At, B1); PG8_BAR;
            PG8_LDA(At, 1, 1); PG8_STAGE(PG8_SA(1, 0), a3, voffA);
            PG8_BAR; PG8_WAIT_L(0); PG8_MMA(1, 0, At, B0); PG8_BAR; PG8_SCHED;
            PG8_STAGE(PG8_SB(1, 1), b3 + hstep, voffB);
            PG8_WAIT_V(6); PG8_BAR; PG8_MMA(1, 1, At, B1); PG8_BAR;
            }
        }
        if constexpr (ALIGN_EPI) { if (wr == 0) PG8_BAR; }
        E(acc, cur, wr, wc, fr, fq);
        if (!has_next) break;
#pragma unroll
        for (int a = 0; a < 2; ++a)
#pragma unroll
            for (int b = 0; b < 2; ++b)
#pragma unroll
                for (int m = 0; m < 4; ++m)
#pragma unroll
                    for (int n = 0; n < 2; ++n) acc[a][b][m][n] = (f32x4){0.f, 0.f, 0.f, 0.f};
        cur = nxt; cA = nA; cB = nB; ++ui;
        if constexpr (ALIGN_EPI) { if (wr == 1) PG8_BAR; }
    }
    PG8_WAIT_V(0);
    if constexpr (!ALIGN_EPI) { if (wr == 0) PG8_BAR; }
    PG8_BAR;
#undef PG8_SA
#undef PG8_SB
#undef PG8_STAGE
#undef PG8_LDA
#undef PG8_LDB
#undef PG8_MMA
#undef PG8_WAIT_V
#undef PG8_WAIT_L
#undef PG8_BAR
#undef PG8_SCHED
}
}

constexpr size_t MiB = 1u << 20;
constexpr size_t WS_CTL = 0, CTL_ZERO_BYTES = 64 * 1024;
constexpr size_t WS_W = 1 * MiB;
constexpr size_t WS_WIN_T = WS_W, WS_WOUT_T = WS_WIN_T + (size_t)DIN * D * 2, WS_W1_T = WS_WOUT_T + (size_t)D * D * 2, WS_W2_T = WS_W1_T + (size_t)DFF * D * 2;
constexpr size_t WS_WR_T = WS_W, WS_WK_T = WS_WR_T + 2 * MiB, WS_LDW_T = WS_WK_T + 2 * MiB, WS_WV_T = WS_LDW_T + 3 * MiB, WS_WO2_T = WS_WV_T + 2 * MiB, WS_W1B_T = WS_WO2_T + 4 * MiB, WS_W2B_T = WS_W1B_T + 8 * MiB;
static_assert(WS_W2_T + (size_t)D * DFF * 2 <= 31 * MiB && WS_W2B_T + (size_t)D * DFF * 2 <= 31 * MiB, "weight region");
constexpr size_t WS_XN = 31 * MiB, WS_QKV = 63 * MiB, WS_O = 135 * MiB, WS_OBR = 167 * MiB, WS_LSE = 215 * MiB, WS_TMP = 217 * MiB, WS_H = 63 * MiB;
constexpr size_t WS_MIXA = 63 * MiB, WS_MIXB = 95 * MiB, WS_R = 127 * MiB, WS_K = 159 * MiB, WS_V = 31 * MiB, WS_LDO = 191 * MiB, WS_Y = 63 * MiB, WS_LDA = 239 * MiB;
constexpr size_t WS_YSUM = 127 * MiB;
constexpr size_t WS_HBC = 191 * MiB, WS_TMP2 = 223 * MiB;
constexpr size_t WS_END = 256 * MiB;
static_assert(WS_HBC >= WS_H + (size_t)M * DFF * 2 && WS_HBC + (size_t)M * D * 2 <= WS_TMP2 && WS_TMP2 + (size_t)M * D * 2 <= WS_END, "layer-1 tail");
static_assert(WS_LDO + (size_t)M * NLD * 2 <= WS_LDA && WS_LDA + (size_t)M * 512 * 2 <= WS_END && WS_TMP + (size_t)M * D * 2 <= WS_END, "tail of the map");
static_assert(WS_MIXA == WS_XN + 32 * MiB && WS_MIXB == WS_XN + 64 * MiB && WS_K == WS_R + 32 * MiB && WS_LDO == WS_R + 64 * MiB && WS_WK_T == WS_WR_T + 2 * MiB && WS_LDW_T == WS_WR_T + 4 * MiB, "grouped GEMM strides");
constexpr int CW_BAR = 4096;

constexpr int RING_BYTES = 131072, LDSCTL_OFF = 143360, MISC_OFF = LDSCTL_OFF + 320, LDS_BYTES = 147456;

typedef __bf16 bf16x2_t __attribute__((ext_vector_type(2)));
__device__ __forceinline__ unsigned cvtpk(float lo, float hi) { const f32x2 v = {lo, hi}; const bf16x2_t b = __builtin_convertvector(v, bf16x2_t); return __builtin_bit_cast(unsigned, b); }
__device__ __forceinline__ float bf2f(unsigned short b) { return __uint_as_float((unsigned)b << 16); }
__device__ __forceinline__ float bflo(unsigned w) { return __uint_as_float(w << 16); }
__device__ __forceinline__ float bfhi(unsigned w) { return __uint_as_float(w & 0xffff0000u); }
__device__ __forceinline__ unsigned f2bf(float f) { unsigned u = __float_as_uint(f); return (u + 0x7fffu + ((u >> 16) & 1u)) >> 16; }
__device__ __forceinline__ unsigned pk2(float lo, float hi) { return f2bf(lo) | (f2bf(hi) << 16); }
__device__ __forceinline__ float wave_sum(float v) {
#pragma unroll
    for (int o = 1; o < 64; o <<= 1) v += __shfl_xor(v, o);
    return v;
}
__device__ __forceinline__ float sigmoidf_(float z) { return 1.f / (1.f + __expf(-z)); }
__device__ __forceinline__ int t5_bucket(int rel) {
    const int n = rel < 0 ? -rel : rel;
    int large;
    if (n < 8) large = n; else if (n < 15) large = 8; else if (n < 27) large = 9; else if (n < 50) large = 10; else if (n < 91) large = 11;
    else if (n < 166) large = 12; else if (n < 305) large = 13; else if (n < 559) large = 14; else large = 15;
    return (rel > 0 ? 16 : 0) + large;
}

#define XB_TMO      128
#define XB_XCNT(j)  (256  + 64 * (j))
#define XB_XSUB(j)  (1280 + 64 * (j))
#define XB_XGEN(j)  (2304 + 64 * (j))
#define XB_TOP      3328
#define XB_TOPGEN   3392
#define XCD_BAR_WORDS 3456
#define XB_SPIN_CAP (1u << 18)
__device__ __forceinline__ unsigned xb_ld(unsigned* p)              { return __hip_atomic_load(p, __ATOMIC_RELAXED, __HIP_MEMORY_SCOPE_AGENT); }
__device__ __forceinline__ unsigned xb_add(unsigned* p, unsigned v) { return __hip_atomic_fetch_add(p, v, __ATOMIC_RELAXED, __HIP_MEMORY_SCOPE_AGENT); }
__device__ __forceinline__ unsigned xb_xcc_id() { return (unsigned)__builtin_amdgcn_s_getreg((3 << 11) | 20) & 0xFu; }
#define XB_SPIN(cond, bar) do { unsigned _sp = 0; while (cond) { __builtin_amdgcn_s_sleep(1); \
    if ((++_sp & 255u) == 0u) { if (xb_ld(&(bar)[XB_TMO])) break; if (_sp > XB_SPIN_CAP) { atomicAdd(&(bar)[XB_TMO], 1u); break; } } } } while (0)
struct XcdBarrier { unsigned* bar; unsigned x; volatile LAS unsigned* st; };
__device__ __forceinline__ XcdBarrier xcd_barrier_post(unsigned* bar, volatile LAS unsigned* st) {
    XcdBarrier b; b.bar = bar; b.x = xb_xcc_id(); b.st = st;
    if (threadIdx.x == 0) (void)xb_add(&bar[XB_XCNT(b.x)], 1u);
    return b;
}
__device__ __forceinline__ void xcd_barrier_complete(unsigned* bar, unsigned x, unsigned& nloc, unsigned& nx) {
    const unsigned G = gridDim.x * gridDim.y * gridDim.z;
    unsigned sum, cnt, mine, sp = 0u;
    for (;;) {
        sum = 0u; cnt = 0u; mine = 0u;
#pragma unroll
        for (unsigned j = 0; j < 16; ++j) { const unsigned c = xb_ld(&bar[XB_XCNT(j)]); sum += c; cnt += (c > 0u) ? 1u : 0u; mine = (j == x) ? c : mine; }
        if (sum == G) break;
        __builtin_amdgcn_s_sleep(1);
        if ((++sp & 255u) == 0u) { if (xb_ld(&bar[XB_TMO])) break; if (sp > XB_SPIN_CAP) { atomicAdd(&bar[XB_TMO], 1u); break; } }
    }
    nloc = mine > 0u ? mine : 1u; nx = cnt > 0u ? cnt : 1u;
}
__device__ __forceinline__ void xcd_barrier(const XcdBarrier& b) {
    asm volatile("s_waitcnt vmcnt(0)" ::: "memory");
    __syncthreads();
    if (threadIdx.x == 0) {
        unsigned* bar = b.bar;
        __builtin_amdgcn_s_waitcnt(0);
        unsigned nloc = b.st[0], nx = b.st[1];
        if (nloc == 0u) { xcd_barrier_complete(bar, b.x, nloc, nx); b.st[0] = nloc; b.st[1] = nx; }
        const unsigned old = xb_add(&bar[XB_XSUB(b.x)], 1u);
        const unsigned gen = old / nloc;
        if (old + 1u == (gen + 1u) * nloc) {
            __builtin_amdgcn_fence(__ATOMIC_RELEASE, "agent");
            asm volatile("s_waitcnt vmcnt(0)" ::: "memory");
            const unsigned og = xb_add(&bar[XB_TOP], 1u);
            const unsigned tg = og / nx;
            if (og + 1u == (tg + 1u) * nx) xb_add(&bar[XB_TOPGEN], 1u);
            else XB_SPIN(xb_ld(&bar[XB_TOPGEN]) == tg, bar);
            __builtin_amdgcn_fence(__ATOMIC_ACQUIRE, "agent");
            xb_add(&bar[XB_XGEN(b.x)], 1u);
            asm volatile("s_waitcnt vmcnt(0)" ::: "memory");
        } else {
            XB_SPIN(xb_ld(&bar[XB_XGEN(b.x)]) == gen, bar);
            __builtin_amdgcn_fence(__ATOMIC_ACQUIRE, "agent");
            asm volatile("s_waitcnt vmcnt(0)" ::: "memory");
        }
    }
    __syncthreads();
}

#define XB_GRP(g)   (4096 + 16 * (g))
__device__ __forceinline__ void grp_barrier(unsigned* bar, unsigned g, unsigned& epoch) {
    asm volatile("s_waitcnt vmcnt(0)" ::: "memory");
    __syncthreads();
    ++epoch;
    if (threadIdx.x == 0) {
        unsigned* word = &bar[XB_GRP(g)];
        (void)xb_add(word, 1u);
        const unsigned tgt = 4u * epoch;
        XB_SPIN(xb_ld(word) < tgt, bar);
        __builtin_amdgcn_fence(__ATOMIC_ACQUIRE, "agent");
        asm volatile("s_waitcnt vmcnt(0)" ::: "memory");
    }
    __syncthreads();
}

struct Row16 { f32x4 v[4]; };
__device__ __forceinline__ int row_q(int lane, int j) { return 2 * lane + 128 * (j >> 1) + (j & 1); }
__device__ __forceinline__ void row_load_f32(Row16& r, const float* p, int lane) {
#pragma unroll
    for (int j = 0; j < 4; ++j) r.v[j] = ((const f32x4*)p)[row_q(lane, j)];
}
struct RowRaw { u32x4 w[2]; };
__device__ __forceinline__ void row_raw_load(RowRaw& r, const bf16_t* p, int lane) { r.w[0] = ((const u32x4*)p)[lane]; r.w[1] = ((const u32x4*)p)[lane + 64]; }
__device__ __forceinline__ void row_from_raw(Row16& r, const RowRaw& q) {
#pragma unroll
    for (int b = 0; b < 2; ++b) { const u32x4 w = q.w[b]; r.v[2 * b] = (f32x4){bflo(w.x), bfhi(w.x), bflo(w.y), bfhi(w.y)}; r.v[2 * b + 1] = (f32x4){bflo(w.z), bfhi(w.z), bflo(w.w), bfhi(w.w)}; }
}
__device__ __forceinline__ void row_load_bf16(Row16& r, const bf16_t* p, int lane) { RowRaw q; row_raw_load(q, p, lane); row_from_raw(r, q); }
__device__ __forceinline__ void row_store_f32(const Row16& r, float* p, int lane) {
#pragma unroll
    for (int j = 0; j < 4; ++j) pg8::store16_wt((f32x4*)p + row_q(lane, j), __builtin_bit_cast(u32x4, r.v[j]));
}
__device__ __forceinline__ void row_store_bf16(const Row16& r, bf16_t* p, int lane) {
#pragma unroll
    for (int b = 0; b < 2; ++b) { u32x4 w; w.x = cvtpk(r.v[2 * b][0], r.v[2 * b][1]); w.y = cvtpk(r.v[2 * b][2], r.v[2 * b][3]); w.z = cvtpk(r.v[2 * b + 1][0], r.v[2 * b + 1][1]); w.w = cvtpk(r.v[2 * b + 1][2], r.v[2 * b + 1][3]);
        pg8::store16_wt((u32x4*)p + lane + 64 * b, w); }
}
__device__ __forceinline__ void vec_load(Row16& r, const float* g, int lane) { row_load_f32(r, g, lane); }
__device__ __forceinline__ void row_rmsnorm_v(Row16& r, const Row16& g) {
    float s = 0.f;
#pragma unroll
    for (int j = 0; j < 4; ++j) s += r.v[j][0] * r.v[j][0] + r.v[j][1] * r.v[j][1] + r.v[j][2] * r.v[j][2] + r.v[j][3] * r.v[j][3];
    const float rs = rsqrtf(wave_sum(s) * (1.f / D) + NORM_EPS);
#pragma unroll
    for (int j = 0; j < 4; ++j) r.v[j] = r.v[j] * rs * g.v[j];
}
__device__ __forceinline__ void row_rmsnorm(Row16& r, const float* g, int lane) { Row16 gg; vec_load(gg, g, lane); row_rmsnorm_v(r, gg); }

constexpr int TR_SCR_BYTES = 64 * 65 * 4;
template <class ScaleFn>
__device__ __forceinline__ void transpose_item(const float* W, int ldw, int N, bf16_t* WT, int ldt, int row_off, int koff, LAS float* scr, int item, int lane, ScaleFn sc) {
    const int nblk = N / 64, kb = item / nblk, nb = item % nblk, k0 = 64 * kb, n0 = 64 * nb;
    const int lk = lane >> 4, ln4 = (lane & 15) * 4;
    f32x4 v[16];
#pragma unroll
    for (int i = 0; i < 16; ++i) v[i] = *(const f32x4*)(W + (size_t)(k0 + 4 * i + lk) * ldw + n0 + ln4);
#pragma unroll
    for (int i = 0; i < 16; ++i) { const int kk = 4 * i + lk; const float s = sc(k0 + kk); LAS float* d = scr + kk * 65 + ln4; d[0] = v[i][0] * s; d[1] = v[i][1] * s; d[2] = v[i][2] * s; d[3] = v[i][3] * s; }
    asm volatile("s_waitcnt lgkmcnt(0)" ::: "memory");
    const int c = lane >> 3, nn = lane & 7;
#pragma unroll
    for (int j = 0; j < 8; ++j) { const int n = nn + 8 * j; const LAS float* s = scr + (8 * c) * 65 + n;
        u32x4 o; o.x = cvtpk(s[0 * 65], s[1 * 65]); o.y = cvtpk(s[2 * 65], s[3 * 65]); o.z = cvtpk(s[4 * 65], s[5 * 65]); o.w = cvtpk(s[6 * 65], s[7 * 65]);
        pg8::store16_wt(WT + (size_t)(row_off + n0 + n) * ldt + koff + k0 + 8 * c, o); }
    asm volatile("s_waitcnt lgkmcnt(0)" ::: "memory");
}
struct ScaleOne { __device__ __forceinline__ float operator()(int) const { return 1.f; } };
struct ScaleVec { const float* g; __device__ __forceinline__ float operator()(int k) const { return g[k]; } };
struct ScaleMix { const float* mp; const float* mn; int part;
    __device__ __forceinline__ float operator()(int k) const { return part == 0 ? 1.f - mp[k] - mn[k] : (part == 1 ? mp[k] : mn[k]); } };

struct Args { const float* in[27]; float* out; unsigned char* ws; };

struct ProbPlain { const bf16_t* A; const bf16_t* Bt; int K;
    __device__ __forceinline__ const char* a_tile(const pg8::Unit& u) const { return (const char*)(A + (size_t)u.pm * 256 * K); }
    __device__ __forceinline__ const char* b_tile(const pg8::Unit& u) const { return (const char*)(Bt + (size_t)u.pn * 256 * K); } };
struct DstPlain { bf16_t* C; int ldc;
    __device__ __forceinline__ void operator()(const pg8::Unit& u, bf16_t*& base, int& ld) const { base = C + (size_t)u.pm * 256 * ldc + (size_t)u.pn * 256; ld = ldc; } };
struct ProbRKL { const unsigned char* ws; int K;
    __device__ __forceinline__ const char* a_tile(const pg8::Unit& u) const { const int g = u.pn < 4 ? 0 : (u.pn < 8 ? 1 : 2); const int ga = g == 2 ? 0 : g + 1;
        return (const char*)(ws + WS_XN + (size_t)ga * (32 * MiB) + (size_t)u.pm * 256 * D * 2); }
    __device__ __forceinline__ const char* b_tile(const pg8::Unit& u) const { const int g = u.pn < 4 ? 0 : (u.pn < 8 ? 1 : 2); const int t = u.pn - 4 * g;
        return (const char*)(ws + WS_WR_T + (size_t)g * (2 * MiB) + (size_t)t * 256 * D * 2); } };
struct DstRKL { unsigned char* ws;
    __device__ __forceinline__ void operator()(const pg8::Unit& u, bf16_t*& base, int& ld) const {
        const int g = u.pn < 4 ? 0 : (u.pn < 8 ? 1 : 2); const int t = u.pn - 4 * g; ld = g == 2 ? NLD : D;
        base = (bf16_t*)(ws + WS_R + (size_t)g * (32 * MiB)) + (size_t)u.pm * 256 * ld + (size_t)t * 256; } };


struct EpiHeadMajor {
    static constexpr bool PERM = true;
    bf16_t* O;
    __device__ __forceinline__ void operator()(const f32x4 (&acc)[2][2][4][2], const pg8::Unit& u, int wr, int wc, int fr, int fq) const {
        const int row0 = u.pm * 256 + wr * 64 + fr, col = (wc & 1) * 32 + 8 * fq;
#pragma unroll
        for (int bj = 0; bj < 2; ++bj) { bf16_t* hb = O + ((size_t)(u.pn * 4 + bj * 2 + (wc >> 1)) * M + row0) * 64 + col;
#pragma unroll
            for (int ai = 0; ai < 2; ++ai)
#pragma unroll
                for (int m = 0; m < 4; ++m) { const f32x4 v0 = acc[ai][bj][m][0], v1 = acc[ai][bj][m][1];
                    u32x4 w; w.x = cvtpk(v0[0], v0[1]); w.y = cvtpk(v0[2], v0[3]); w.z = cvtpk(v1[0], v1[1]); w.w = cvtpk(v1[2], v1[3]);
                    pg8::store16_wt(hb + (size_t)(ai * 128 + m * 16) * 64, w); } }
    }
};

template <int ACT, class Prob, class Dst>
__device__ __forceinline__ void run_gemm(LAS unsigned char* lds, const Prob& P, const Dst& Dd, int Mr, int Nv, int G) {
    pg8::StaticOrder S; S.init(Mr, Nv, G, (int)blockIdx.x);
    pg8::EpiBf16<ACT, Dst> E{Dd, nullptr};
    for (int rep = 0; rep < REP_GEMM; ++rep) pg8::gemm_phase<pg8::EpiBf16<ACT, Dst>, Prob, true, true>(lds, P, S, E);
}
template <int ACT, class Prob, class Dst>
__device__ __forceinline__ void run_gemm_rs(LAS unsigned char* lds, const Prob& P, const Dst& Dd, const float* rs, int Mr, int Nv, int G) {
    pg8::StaticOrder S; S.init(Mr, Nv, G, (int)blockIdx.x);
    pg8::EpiBf16<ACT, Dst, true> E{Dd, rs};
    pg8::gemm_phase<pg8::EpiBf16<ACT, Dst, true>, Prob, true, true>(lds, P, S, E);
}

template <bool BASE_F32, bool OUT_F32>
__device__ __forceinline__ void phase_resnorm(const void* base, const bf16_t* TMP, const float* g1, const float* g2, void* hout, bf16_t* XN, float* rs_out, int gw, int NGW, int lane) {
    Row16 G1, G2; vec_load(G1, g1, lane); if (XN) vec_load(G2, g2, lane);
    for (int row = gw; row < M; row += NGW) {
        Row16 t, b; row_load_bf16(t, TMP + (size_t)row * D, lane);
        if (BASE_F32) row_load_f32(b, (const float*)base + (size_t)row * D, lane); else row_load_bf16(b, (const bf16_t*)base + (size_t)row * D, lane);
        row_rmsnorm_v(t, G1);
#pragma unroll
        for (int j = 0; j < 4; ++j) b.v[j] = b.v[j] + t.v[j];
        if (OUT_F32) row_store_f32(b, (float*)hout + (size_t)row * D, lane); else row_store_bf16(b, (bf16_t*)hout + (size_t)row * D, lane);
        if (XN) { row_rmsnorm_v(b, G2); row_store_bf16(b, XN + (size_t)row * D, lane); }
        if (rs_out) {
            float s = 0.f;
#pragma unroll
            for (int j = 0; j < 4; ++j) s += b.v[j][0] * b.v[j][0] + b.v[j][1] * b.v[j][1] + b.v[j][2] * b.v[j][2] + b.v[j][3] * b.v[j][3];
            const float rsv = rsqrtf(wave_sum(s) * (1.f / D) + NORM_EPS);
            if (lane == 0) rs_out[row] = rsv; }
    }
}
__device__ __forceinline__ void phase_lda(const bf16_t* LDO, bf16_t* LDA, int gw, int NGW, int lane) {
    const float A = lane < 16 ? 2.f : 1.f, C = lane < 16 ? -1.f : 0.f; const bool id = lane >= 16 && lane < 32;
    for (int row = gw; row < M; row += NGW) { const int tt = row & (SEQ - 1);
        const u32x4 p0 = *(const u32x4*)(LDO + (size_t)row * NLD + 8 * lane);
        const u32x4 p1 = *(const u32x4*)(LDO + (size_t)(tt > 0 ? row - 1 : row) * NLD + 512 + 8 * lane), p2 = *(const u32x4*)(LDO + (size_t)(tt < SEQ - 1 ? row + 1 : row) * NLD + 1024 + 8 * lane);
        const float mp = tt > 0 ? 1.f : 0.f, mn = tt < SEQ - 1 ? 1.f : 0.f;
        u32x4 o;
#pragma unroll
        for (int w = 0; w < 4; ++w) { const float x0 = bflo(p0[w]) + mp * bflo(p1[w]) + mn * bflo(p2[w]), x1 = bfhi(p0[w]) + mp * bfhi(p1[w]) + mn * bfhi(p2[w]);
            const float y0 = A * __builtin_amdgcn_rcpf(1.f + __builtin_amdgcn_exp2f(-1.4426950408889634f * A * x0)) + C, y1 = A * __builtin_amdgcn_rcpf(1.f + __builtin_amdgcn_exp2f(-1.4426950408889634f * A * x1)) + C;
            o[w] = cvtpk(id ? x0 : y0, id ? x1 : y1); }
        pg8::store16_wt(LDA + (size_t)row * 512 + 8 * lane, o); }
}
__device__ __forceinline__ void mix_out(const Row16& up, const Row16& u, const Row16& un, const LAS f32x4* a, const LAS f32x4* b, bf16_t* dst, int lane) {
    Row16 o;
#pragma unroll
    for (int j = 0; j < 4; ++j) { const f32x4 av = a[j * 64 + lane], bv = b[j * 64 + lane]; o.v[j] = u.v[j] + (up.v[j] - u.v[j]) * av + (un.v[j] - u.v[j]) * bv; }
    row_store_bf16(o, dst, lane);
}
__device__ __forceinline__ void phase_mix3(LAS unsigned char* lds, const bf16_t* h, const float* g, const float* mup, const float* mun, bf16_t* XN, bf16_t* MR, bf16_t* MK, bf16_t* MV, int gw, int NGW, int tid, int lane) {
    LAS f32x4* mv = (LAS f32x4*)lds;
    __syncthreads();
    for (int x = tid; x < 6 * 256; x += NTHREADS) { const int vec = x >> 8, q = x & 255, c = vec < 2 ? 0 : (vec < 4 ? 2 : 3);
        const f32x4 val = ((const f32x4*)(((vec & 1) ? mun : mup) + c * D))[q];
        mv[vec * 256 + (2 * (q >> 7) + (q & 1)) * 64 + ((q & 127) >> 1)] = val; }
    __syncthreads();
    Row16 Gn; vec_load(Gn, g, lane);
    for (int ch = gw; ch < M / 8; ch += NGW) {
        const int r0 = ch * 8, t0 = r0 & (SEQ - 1);
        const bool hasp = t0 > 0, hasn = t0 + 8 < SEQ;
        const int rlast = hasn ? r0 + 8 : r0 + 7;
        RowRaw r0w, rA, rB, rC;
        row_raw_load(r0w, h + (size_t)(hasp ? r0 - 1 : r0) * D, lane);
        row_raw_load(rA, h + (size_t)r0 * D, lane); row_raw_load(rB, h + (size_t)(r0 + 1) * D, lane); row_raw_load(rC, h + (size_t)(r0 + 2) * D, lane);
        Row16 up, u, un;
        row_from_raw(up, r0w); row_rmsnorm_v(up, Gn);
        { const float m = hasp ? 1.f : 0.f;
#pragma unroll
          for (int j = 0; j < 4; ++j) up.v[j] = up.v[j] * m; }
        row_from_raw(u, rA); row_rmsnorm_v(u, Gn);
        rA = rB; rB = rC;
#pragma unroll 1
        for (int k = 1; k <= 8; ++k) {
            const int row = r0 - 1 + k;
            { const int nx = row + 3; row_raw_load(rC, h + (size_t)(nx < rlast ? nx : rlast) * D, lane); }
            row_from_raw(un, rA); row_rmsnorm_v(un, Gn);
            { const float m = (k == 8 && !hasn) ? 0.f : 1.f;
#pragma unroll
              for (int j = 0; j < 4; ++j) un.v[j] = un.v[j] * m; }
            row_store_bf16(u, XN + (size_t)row * D, lane);
            mix_out(up, u, un, mv, mv + 256, MR + (size_t)row * D, lane);
            mix_out(up, u, un, mv + 512, mv + 768, MK + (size_t)row * D, lane);
            mix_out(up, u, un, mv + 1024, mv + 1280, MV + (size_t)row * D, lane);
            up = u; u = un; rA = rB; rB = rC;
        }
    }
}

constexpr int ATT_ROWS = 400, ATT_KS = 0, ATT_VS = ATT_ROWS * 128, ATT_TAB = 2 * ATT_ROWS * 128, ATT_TABN = 320;
constexpr float LOG2E = 1.4426950408889634f;
typedef short v4i16_t __attribute__((ext_vector_type(4)));
__device__ __forceinline__ v4i16_t lds_tr16(LAS const unsigned char* p) { return __builtin_amdgcn_ds_read_tr16_b64_v4i16((LAS v4i16_t*)p); }

__device__ __forceinline__ float fmax_q(float a, float b) { return __builtin_amdgcn_fmed3f(a, b, __builtin_inff()); }
__device__ __forceinline__ float rows_max(float x) {
    auto a = __builtin_amdgcn_permlane16_swap(__float_as_uint(x), __float_as_uint(x), false, false); x = fmax_q(__uint_as_float(a[0]), __uint_as_float(a[1]));
    auto b = __builtin_amdgcn_permlane32_swap(__float_as_uint(x), __float_as_uint(x), false, false); return fmax_q(__uint_as_float(b[0]), __uint_as_float(b[1])); }
__device__ __forceinline__ float rows_sum(float x) {
    auto a = __builtin_amdgcn_permlane16_swap(__float_as_uint(x), __float_as_uint(x), false, false); x = __uint_as_float(a[0]) + __uint_as_float(a[1]);
    auto b = __builtin_amdgcn_permlane32_swap(__float_as_uint(x), __float_as_uint(x), false, false); return __uint_as_float(b[0]) + __uint_as_float(b[1]); }
struct AttnIO { const bf16_t* QKV; const float* rel_table; const float* sink; bf16_t* O; bf16_t* OBR; float* LSE; };
struct AttnUnitD { int b, dil, res, l0, nq, L, R, colK, colV, head0, ngroups, nit, branch, isB; };
__device__ __forceinline__ AttnUnitD attn_decode(int u) {
    AttnUnitD A;
    if (u < 256) { A.isB = 1; A.b = u >> 5; const int kvg = (u >> 4) & 1, blk = u & 15; A.dil = 1; A.res = 0; A.l0 = blk * 128; A.nq = 128; A.L = SEQ; A.R = 128; A.colK = 32 + kvg; A.colV = 34 + kvg; A.head0 = kvg * 4; A.ngroups = 32; A.nit = 9; A.branch = 0; }
    else if (u < 1280) { A.isB = 0; const int a = u - 256, bh = a >> 4, k = a & 15; A.b = bh >> 3; A.head0 = bh & 7; A.nq = 256; A.R = 64; A.ngroups = 16; A.nit = 5;
        if (k < 8) { A.dil = 1; A.res = 0; A.l0 = k * 256; A.L = SEQ; A.branch = 0; } else { A.dil = 4; A.res = (k - 8) >> 1; A.l0 = ((k - 8) & 1) * 256; A.L = SEQ / 4; A.branch = 1; }
        A.colK = 8 + A.head0; A.colV = 16 + A.head0; }
    else { A.isB = 0; const int a = u - 1280, bh = a >> 4; A.b = bh >> 3; A.head0 = bh & 7; A.dil = 16; A.res = a & 15; A.l0 = 0; A.nq = 128; A.L = SEQ / 16; A.R = 64; A.ngroups = 8; A.nit = 5; A.branch = 2; A.colK = 8 + A.head0; A.colV = 16 + A.head0; }
    return A;
}
constexpr int ATT_NST = 7;
__device__ __forceinline__ void attn_issue(const AttnUnitD& A, const bf16_t* QKV, int tid, u32x4 (&kr)[ATT_NST], u32x4 (&vr)[ATT_NST]) {
    const int ndata = A.nq + 2 * A.R, rv0 = (A.R - A.l0) > 0 ? (A.R - A.l0) : 0, rv1 = (A.L + A.R - A.l0) < ndata ? (A.L + A.R - A.l0) : ndata;
    const bf16_t* kb = QKV + ((size_t)A.colK * M + (size_t)A.b * SEQ) * 64; const bf16_t* vb = QKV + ((size_t)A.colV * M + (size_t)A.b * SEQ) * 64;
#pragma unroll
    for (int i = 0; i < ATT_NST; ++i) { const int x = tid + NTHREADS * i, c = x & 7; int row = x >> 3; row = row < rv0 ? rv0 : (row >= rv1 ? rv1 - 1 : row);
        const size_t o = (size_t)(A.res + A.dil * (A.l0 - A.R + row)) * 64 + c * 8; kr[i] = *(const u32x4*)(kb + o); vr[i] = *(const u32x4*)(vb + o); }
}

__device__ __forceinline__ void phase_attn(LAS unsigned char* lds, const AttnIO& io, int vcu, int G) {
    int tid = threadIdx.x; asm volatile("" : "+v"(tid));
    const int lane = tid & 63, wid = __builtin_amdgcn_readfirstlane(tid >> 6), g4 = lane >> 4, qi = lane & 15;
    LAS unsigned char* Ks = lds + ATT_KS; LAS unsigned char* Vs = lds + ATT_VS; LAS float* tab = (LAS float*)(lds + ATT_TAB);
    constexpr int NU = 256 + 1024 + 1024;
    u32x4 kr[ATT_NST], vr[ATT_NST];
    if (vcu < NU) { const AttnUnitD A0 = attn_decode(vcu); attn_issue(A0, io.QKV, tid, kr, vr); }
    for (int u = vcu; u < NU; u += G) {
        const AttnUnitD A = attn_decode(u);
        const int b = A.b, dil = A.dil, res = A.res, l0 = A.l0, R = A.R, head0 = A.head0, ngroups = A.ngroups, nit = A.nit, branch = A.branch; const bool isB = A.isB != 0;
        const int ndata = A.nq + 2 * R, rv0 = (R - l0) > 0 ? (R - l0) : 0, rv1 = (A.L + R - l0) < ndata ? (A.L + R - l0) : ndata;
        auto qptr = [&](int gx) -> const bf16_t* { const int hq_ = isB ? (gx >> 3) : 0, gi_ = isB ? (gx & 7) : gx; const int posq_ = res + dil * (l0 + 16 * gi_ + qi);
            return io.QKV + ((size_t)((isB ? 24 : 0) + head0 + hq_) * M + (size_t)b * SEQ + posq_) * 64 + 8 * g4; };
        u32x4 qr0, qr1; { const bf16_t* qp0 = qptr(wid); qr0 = *(const u32x4*)qp0; qr1 = *(const u32x4*)(qp0 + 32); }
        for (int reps = 0; reps < REP_ATTS; ++reps) {
        __syncthreads();
#pragma unroll
        for (int i = 0; i < ATT_NST; ++i) { const int x = tid + NTHREADS * i, row = x >> 3, c = x & 7;
            if (x < ATT_ROWS * 8) { const int off = row * 128 + ((c ^ (row & 7)) << 4); const bool ok = row >= rv0 && row < rv1; const u32x4 z = (u32x4){0u, 0u, 0u, 0u};
                *(LAS u32x4*)(Ks + off) = ok ? kr[i] : z; *(LAS u32x4*)(Vs + off) = ok ? vr[i] : z; } }
        { const int ntab = isB ? 4 : 1;
          for (int x = tid; x < ntab * ATT_TABN; x += NTHREADS) { const int t = x / ATT_TABN, j = x % ATT_TABN, idx = j - 16;
              float v = -1e30f;
              if (idx >= 0 && idx <= 2 * R) v = io.rel_table[t5_bucket((idx - R) * dil) * 16 + (isB ? 8 + head0 + t : head0)] * LOG2E;
              tab[x] = v; } }
        }
        if (u + G < NU) { const AttnUnitD An = attn_decode(u + G); attn_issue(An, io.QKV, tid, kr, vr); }
        __syncthreads();
        u32x2 pend_w[4]; bf16_t* pend_op = nullptr; float* pend_lse = nullptr; float pend_lv = 0.f;
#pragma unroll
        for (int dt = 0; dt < 4; ++dt) pend_w[dt] = (u32x2){0u, 0u};
        auto flush = [&]() { if (pend_op) {
#pragma unroll
                for (int dt = 0; dt < 4; ++dt) *(u32x2*)(pend_op + dt * 16 + 4 * g4) = pend_w[dt];
                if (pend_lse && g4 == 0) *pend_lse = pend_lv; } };
        for (int rep = 0; rep < REP_ATTC; ++rep)
        for (int gidx = wid; gidx < ngroups; gidx += NWAVES) {
            const int hq = isB ? (gidx >> 3) : 0, gi = isB ? (gidx & 7) : gidx, head = head0 + hq;
            const int ql = 16 * gi + qi, posq = res + dil * (l0 + ql);
            const LAS float* tb = tab + hq * ATT_TABN + 16;
            bf16x8 qf[2];
            { const u32x4 wq[2] = {qr0, qr1}; const float SC = 0.125f * LOG2E;
#pragma unroll
              for (int ks = 0; ks < 2; ++ks) { const u32x4 w = wq[ks]; u32x4 o;
                  o.x = cvtpk(bflo(w.x) * SC, bfhi(w.x) * SC); o.y = cvtpk(bflo(w.y) * SC, bfhi(w.y) * SC); o.z = cvtpk(bflo(w.z) * SC, bfhi(w.z) * SC); o.w = cvtpk(bflo(w.w) * SC, bfhi(w.w) * SC);
                  qf[ks] = __builtin_bit_cast(bf16x8, o); }
              asm volatile("" : "+v"(qf[0]), "+v"(qf[1]));
              { const int gn = gidx + NWAVES < ngroups ? gidx + NWAVES : gidx; const bf16_t* qpn = qptr(gn); qr0 = *(const u32x4*)qpn; qr1 = *(const u32x4*)(qpn + 32); } }
            flush();
            f32x4 ot[4], lacc = (f32x4){0.f, 0.f, 0.f, 0.f};
#pragma unroll
            for (int dt = 0; dt < 4; ++dt) ot[dt] = (f32x4){0.f, 0.f, 0.f, 0.f};
            float m = -1e20f;
            const bf16x8 ones = __builtin_bit_cast(bf16x8, qi == 0 ? (u32x4){0x3F803F80u, 0x3F803F80u, 0x3F803F80u, 0x3F803F80u} : (u32x4){0u, 0u, 0u, 0u});
            bf16x8 kf[2][2];
            const LAS unsigned char* kp[2];
            { const int r0 = 16 * gi + qi;
#pragma unroll
              for (int ks = 0; ks < 2; ++ks) { const int c = g4 + 4 * ks; kp[ks] = Ks + r0 * 128 + ((c ^ (r0 & 7)) << 4); asm volatile("" : "+v"(kp[ks]));
                  kf[ks][0] = *(const LAS bf16x8*)(kp[ks]); kf[ks][1] = *(const LAS bf16x8*)(kp[ks] + 16 * 128); } }
            const LAS unsigned char* vp[4];
            { const int ra0 = 16 * gi + 4 * g4 + (qi >> 2);
#pragma unroll
              for (int dt = 0; dt < 4; ++dt) { const int ch = dt * 2 + ((qi & 3) >> 1); vp[dt] = Vs + ra0 * 128 + ((ch ^ (ra0 & 7)) << 4) + 8 * (qi & 1); asm volatile("" : "+v"(vp[dt])); } }
            const LAS float* tbq = tb + 4 * g4 - qi; asm volatile("" : "+v"(tbq));
            f32x4 c0, c1;
#pragma unroll
            for (int r = 0; r < 4; ++r) { c0[r] = tbq[r]; c1[r] = tbq[16 + r]; }
            for (int it = 0; it < nit; ++it) {
                const int rb = 16 * gi + 32 * it;
                v4i16_t vlo[4], vhi[4];
#pragma unroll
                for (int dt = 0; dt < 4; ++dt) { vlo[dt] = lds_tr16(vp[dt]); vhi[dt] = lds_tr16(vp[dt] + 16 * 128); vp[dt] += 4096; }
                f32x4 s0 = c0, s1 = c1;
#pragma unroll
                for (int ks = 0; ks < 2; ++ks) { s0 = __builtin_amdgcn_mfma_f32_16x16x32_bf16(kf[ks][0], qf[ks], s0, 0, 0, 0); s1 = __builtin_amdgcn_mfma_f32_16x16x32_bf16(kf[ks][1], qf[ks], s1, 0, 0, 0); }
                if (it + 1 < nit) {
#pragma unroll
                    for (int ks = 0; ks < 2; ++ks) { kp[ks] += 4096; kf[ks][0] = *(const LAS bf16x8*)(kp[ks]); kf[ks][1] = *(const LAS bf16x8*)(kp[ks] + 16 * 128); } }
                tbq += 32;
#pragma unroll
                for (int r = 0; r < 4; ++r) { c0[r] = tbq[r]; c1[r] = tbq[16 + r]; }
                float v[8];
                if (rb < rv0 || rb + 32 > rv1) {
#pragma unroll
                    for (int r = 0; r < 4; ++r) { const int row0 = rb + 4 * g4 + r, row1 = row0 + 16;
                        const bool ok0 = (unsigned)(row0 - rv0) < (unsigned)(rv1 - rv0), ok1 = (unsigned)(row1 - rv0) < (unsigned)(rv1 - rv0);
                        v[r] = ok0 ? s0[r] : -1e30f; v[4 + r] = ok1 ? s1[r] : -1e30f; }
                } else {
#pragma unroll
                    for (int r = 0; r < 4; ++r) { v[r] = s0[r]; v[4 + r] = s1[r]; }
                }
                float d[8];
#pragma unroll
                for (int i = 0; i < 8; ++i) d[i] = v[i] - m;
                const float dm = fmaxf(fmaxf(fmaxf(d[0], d[1]), fmaxf(d[2], d[3])), fmaxf(fmaxf(d[4], d[5]), fmaxf(d[6], d[7])));
                if (__builtin_amdgcn_ballot_w64(dm > 8.f) != 0ull) {
                    float tmax = fmaxf(fmaxf(fmaxf(v[0], v[1]), fmaxf(v[2], v[3])), fmaxf(fmaxf(v[4], v[5]), fmaxf(v[6], v[7])));
                    tmax = rows_max(tmax);
                    const float mn = fmaxf(m, tmax), alpha = __builtin_amdgcn_exp2f(m - mn); m = mn;
                    lacc[0] = lacc[0] * alpha;
#pragma unroll
                    for (int dt = 0; dt < 4; ++dt) ot[dt] = ot[dt] * alpha;
#pragma unroll
                    for (int i = 0; i < 8; ++i) d[i] = v[i] - mn;
                }
#pragma unroll
                for (int i = 0; i < 8; ++i) v[i] = __builtin_amdgcn_exp2f(d[i]);
                u32x4 pw; pw.x = cvtpk(v[0], v[1]); pw.y = cvtpk(v[2], v[3]); pw.z = cvtpk(v[4], v[5]); pw.w = cvtpk(v[6], v[7]);
                const bf16x8 pf = __builtin_bit_cast(bf16x8, pw);
                lacc = __builtin_amdgcn_mfma_f32_16x16x32_bf16(ones, pf, lacc, 0, 0, 0);
#pragma unroll
                for (int dt = 0; dt < 4; ++dt) { const bf16x8 vf = (bf16x8){vlo[dt][0], vlo[dt][1], vlo[dt][2], vlo[dt][3], vhi[dt][0], vhi[dt][1], vhi[dt][2], vhi[dt][3]};
                    ot[dt] = __builtin_amdgcn_mfma_f32_16x16x32_bf16(vf, pf, ot[dt], 0, 0, 0); }
            }
            float lsum = lacc[0];
            lsum = rows_sum(lsum);
            const size_t tok = (size_t)b * SEQ + posq;
            float scale;
            if (isB) { const float s2 = io.sink[head] * LOG2E, mf = fmaxf(m, s2), e = __builtin_amdgcn_exp2f(m - mf); scale = e / (lsum * e + __builtin_amdgcn_exp2f(s2 - mf)); }
            else { scale = 1.f / lsum; pend_lv = m + __builtin_amdgcn_logf(lsum); }
            pend_lse = isB ? nullptr : io.LSE + ((size_t)branch * M + tok) * 8 + head;
            pend_op = isB ? io.O + tok * D + 512 + head * 64 : io.OBR + ((size_t)branch * M + tok) * 512 + head * 64;
#pragma unroll
            for (int dt = 0; dt < 4; ++dt) { const f32x4 o = ot[dt] * scale; pend_w[dt].x = cvtpk(o[0], o[1]); pend_w[dt].y = cvtpk(o[2], o[3]); }
        }
        flush();
    }
}
__device__ __forceinline__ void phase_attn_merge(const AttnIO& io, int gtid, int NGT) {
    for (int x = gtid; x < M * 64; x += NGT) { const int tok = x >> 6, head = (x >> 3) & 7, c8 = x & 7;
        const float l0 = io.LSE[((size_t)0 * M + tok) * 8 + head], l1 = io.LSE[((size_t)1 * M + tok) * 8 + head], l2 = io.LSE[((size_t)2 * M + tok) * 8 + head];
        const float mx = fmaxf(l0, fmaxf(l1, l2)); float w0 = __builtin_amdgcn_exp2f(l0 - mx), w1 = __builtin_amdgcn_exp2f(l1 - mx), w2 = __builtin_amdgcn_exp2f(l2 - mx);
        const float inv = 1.f / (w0 + w1 + w2); w0 *= inv; w1 *= inv; w2 *= inv;
        const size_t o = (size_t)tok * 512 + head * 64 + c8 * 8;
        const u32x4 a = *(const u32x4*)(io.OBR + o), bq = *(const u32x4*)(io.OBR + (size_t)M * 512 + o), c = *(const u32x4*)(io.OBR + (size_t)2 * M * 512 + o);
        u32x4 r;
        r.x = pk2(w0 * bflo(a.x) + w1 * bflo(bq.x) + w2 * bflo(c.x), w0 * bfhi(a.x) + w1 * bfhi(bq.x) + w2 * bfhi(c.x));
        r.y = pk2(w0 * bflo(a.y) + w1 * bflo(bq.y) + w2 * bflo(c.y), w0 * bfhi(a.y) + w1 * bfhi(bq.y) + w2 * bfhi(c.y));
        r.z = pk2(w0 * bflo(a.z) + w1 * bflo(bq.z) + w2 * bflo(c.z), w0 * bfhi(a.z) + w1 * bfhi(bq.z) + w2 * bfhi(c.z));
        r.w = pk2(w0 * bflo(a.w) + w1 * bflo(bq.w) + w2 * bflo(c.w), w0 * bfhi(a.w) + w1 * bfhi(bq.w) + w2 * bfhi(c.w));
        pg8::store16_wt(io.O + (size_t)tok * D + head * 64 + c8 * 8, r); }
}

constexpr int NCH = SEQ / 16;
constexpr int SC_LROW = 68, SC_LDROW = 528, SC_LSLOT = 4 * 16 * SC_LROW * 4 + 16 * SC_LDROW;
constexpr int CT_KHT = 0, CT_RHT = 2048, CT_BTT = 4096, CT_KTT = 6144, CT_VT = 8192, CT_WEND = 10240, CT_RKT = CT_WEND + 256, CT_SLOT = CT_RKT + 2048;
constexpr int GT_AKK = 0, GT_BB = 512, GT_BK = 1024, GT_TT = 1536, GT_SLOT = 2048;
constexpr int SC_LBUF = 0, SC_CT = SC_LBUF + 2 * SC_LSLOT, SC_GG = SC_CT + 3 * CT_SLOT, SC_RKR = SC_GG + 4 * 4096, SC_GT = SC_RKR + 4 * 256, SC_NB = SC_GT + 2 * GT_SLOT, SC_OUT = SC_NB + 1024, SC_END = SC_OUT + 2 * 4096;
static_assert(SC_END <= LDSCTL_OFF, "scan LDS map");
template <int CTRL> __device__ __forceinline__ float dpp_f(float x) { return __int_as_float(__builtin_amdgcn_update_dpp(0, __float_as_int(x), CTRL, 0xf, 0xf, true)); }
__device__ __forceinline__ float sum8(float x) { x += dpp_f<0xB1>(x); x += dpp_f<0x4E>(x); x += dpp_f<0x141>(x); return x; }
__device__ __forceinline__ float sum16(float x) { x += dpp_f<0xB1>(x); x += dpp_f<0x4E>(x); x += dpp_f<0x141>(x); x += dpp_f<0x140>(x); return x; }
__device__ __forceinline__ float fast_sigmoid(float z) { return __builtin_amdgcn_rcpf(1.f + __builtin_amdgcn_exp2f(-LOG2E * z)); }
__device__ __forceinline__ bf16x8 mk8(unsigned a, unsigned b, unsigned c, unsigned d) { return __builtin_bit_cast(bf16x8, (u32x4){a, b, c, d}); }

struct ScanPtrs { const bf16_t *R, *Kk, *V, *LDA; bf16_t* Y; const float *w2, *a2, *g2, *w0, *a0, *k_k, *k_a, *r_k, *gn_w, *gn_b; };
__device__ __forceinline__ void phase_scan(LAS unsigned char* lds, const ScanPtrs& P, int G) {
    int tid = threadIdx.x; asm volatile("" : "+v"(tid));
    const int lane = tid & 63, wid = __builtin_amdgcn_readfirstlane(tid >> 6), g4 = lane >> 4, c16 = lane & 15;
    for (int unit = blockIdx.x; unit < 256; unit += G) {
        const int b = unit >> 5, h = (unit >> 1) & 15, d = unit & 1, hc = h * 64;
        unsigned long long wait_acc = 0ull;
        __syncthreads();
        if (wid < 4) {
            f32x4 ST[4];
#pragma unroll
            for (int mt = 0; mt < 4; ++mt) ST[mt] = (f32x4){0.f, 0.f, 0.f, 0.f};
            const int pch = hc + 8 * (lane & 7);
            const f32x4 gw0 = *(const f32x4*)(P.gn_w + pch), gw1 = *(const f32x4*)(P.gn_w + pch + 4), gb0 = *(const f32x4*)(P.gn_b + pch), gb1 = *(const f32x4*)(P.gn_b + pch + 4);
            u32x4 pvA = {0u, 0u, 0u, 0u}, pvB = pvA;
            auto issueV = [&](int ch_, u32x4& dst) { const int s = 8 * (wid - 1) + (lane >> 3), t = d ? (SEQ - 1 - (ch_ * 16 + s)) : (ch_ * 16 + s); dst = *(const u32x4*)(P.V + ((size_t)b * SEQ + t) * D + pch); };
            if (wid == 1 || wid == 2) { issueV(0, pvA); issueV(1, pvB); }
            auto sw_interval = [&](int i, u32x4& pvset) {
                const int c = i - 3;
                int ln = lane; asm volatile("" : "+v"(ln)); const int g4 = ln >> 4, c16 = ln & 15;
                if (c >= 0 && c < NCH) {
                    const LAS unsigned char* Ct = lds + SC_CT + (c % 3) * CT_SLOT; const LAS unsigned char* Gt = lds + SC_GT + (c & 1) * GT_SLOT;
                    v4i16_t kha[2][2], rha[2][2];
#pragma unroll
                    for (int p = 0; p < 2; ++p)
#pragma unroll
                        for (int hh = 0; hh < 2; ++hh) { const int off = (32 * p + 16 * hh + 4 * g4 + (c16 >> 2)) * 32 + 8 * (c16 & 3); kha[p][hh] = lds_tr16(Ct + CT_KHT + off); rha[p][hh] = lds_tr16(Ct + CT_RHT + off); }
                    const u32x2 gakk = *(const LAS u32x2*)(Gt + GT_AKK + c16 * 32 + 8 * g4), gtt = *(const LAS u32x2*)(Gt + GT_TT + c16 * 32 + 8 * g4);
                    const u32x2 gbb = *(const LAS u32x2*)(Gt + GT_BB + c16 * 32 + 8 * g4), gbk = *(const LAS u32x2*)(Gt + GT_BK + c16 * 32 + 8 * g4);
                    const u32x2 vt = *(const LAS u32x2*)(Ct + CT_VT + (16 * wid + c16) * 32 + 8 * g4);
                    u32x2 btt[4], ktt[4]; f32x4 we[4];
#pragma unroll
                    for (int mt = 0; mt < 4; ++mt) { btt[mt] = *(const LAS u32x2*)(Ct + CT_BTT + (16 * mt + c16) * 32 + 8 * g4); ktt[mt] = *(const LAS u32x2*)(Ct + CT_KTT + (16 * mt + c16) * 32 + 8 * g4);
                        we[mt] = *(const LAS f32x4*)(Ct + CT_WEND + (16 * mt + 4 * g4) * 4); }
                    f32x4 pt = {0.f, 0.f, 0.f, 0.f}, prt = pt;
#pragma unroll
                    for (int p = 0; p < 2; ++p) { const bf16x8 sb = mk8(cvtpk(ST[2 * p][0], ST[2 * p][1]), cvtpk(ST[2 * p][2], ST[2 * p][3]), cvtpk(ST[2 * p + 1][0], ST[2 * p + 1][1]), cvtpk(ST[2 * p + 1][2], ST[2 * p + 1][3]));
                        pt = __builtin_amdgcn_mfma_f32_16x16x32_bf16((bf16x8){kha[p][0][0], kha[p][0][1], kha[p][0][2], kha[p][0][3], kha[p][1][0], kha[p][1][1], kha[p][1][2], kha[p][1][3]}, sb, pt, 0, 0, 0);
                        prt = __builtin_amdgcn_mfma_f32_16x16x32_bf16((bf16x8){rha[p][0][0], rha[p][0][1], rha[p][0][2], rha[p][0][3], rha[p][1][0], rha[p][1][1], rha[p][1][2], rha[p][1][3]}, sb, prt, 0, 0, 0); }
                    const f32x4 qt = __builtin_amdgcn_mfma_f32_16x16x32_bf16(mk8(gakk.x, gakk.y, 0u, 0u), mk8(vt.x, vt.y, 0u, 0u), pt, 0, 0, 0);
                    const f32x4 sat = __builtin_amdgcn_mfma_f32_16x16x32_bf16(mk8(gtt.x, gtt.y, 0u, 0u), mk8(cvtpk(qt[0], qt[1]), cvtpk(qt[2], qt[3]), 0u, 0u), (f32x4){0.f, 0.f, 0.f, 0.f}, 0, 0, 0);
                    const bf16x8 sv = mk8(cvtpk(sat[0], sat[1]), cvtpk(sat[2], sat[3]), vt.x, vt.y);
                    const f32x4 outt = __builtin_amdgcn_mfma_f32_16x16x32_bf16(mk8(gbb.x, gbb.y, gbk.x, gbk.y), sv, prt, 0, 0, 0);
#pragma unroll
                    for (int mt = 0; mt < 4; ++mt) { ST[mt] = __builtin_amdgcn_mfma_f32_16x16x32_bf16(mk8(btt[mt].x, btt[mt].y, ktt[mt].x, ktt[mt].y), sv, ST[mt], 0, 0, 0); ST[mt] = ST[mt] * we[mt]; }
                    LAS float* ob = (LAS float*)(lds + SC_OUT + (c & 1) * 4096) + 16 * wid + c16;
#pragma unroll
                    for (int r = 0; r < 4; ++r) ob[(4 * g4 + r) * 64] = outt[r];
                }
                for (int rep_ = 0; rep_ < REP_ST; ++rep_)
                if (i >= 2 && i - 2 < NCH) {
                    const int jg = i - 2, hw = wid;
                    const LAS unsigned char* Ct = lds + SC_CT + (jg % 3) * CT_SLOT; LAS unsigned char* Gt = lds + SC_GT + (jg & 1) * GT_SLOT;
                    const int aoff = (hw & 1) ? CT_KTT : CT_BTT, boff = (hw & 2) ? CT_RHT : CT_KHT;
                    f32x4 gm = {0.f, 0.f, 0.f, 0.f}, gmT = gm;
#pragma unroll
                    for (int ks = 0; ks < 2; ++ks) { const int o1 = (8 * g4 + 32 * ks + (c16 >> 2)) * 32 + 8 * (c16 & 3), o2 = o1 + 4 * 32;
                        const v4i16_t a0 = lds_tr16(Ct + aoff + o1), a1 = lds_tr16(Ct + aoff + o2), b0 = lds_tr16(Ct + boff + o1), b1 = lds_tr16(Ct + boff + o2);
                        const bf16x8 af = {a0[0], a0[1], a0[2], a0[3], a1[0], a1[1], a1[2], a1[3]}, bfr = {b0[0], b0[1], b0[2], b0[3], b1[0], b1[1], b1[2], b1[3]};
                        gm = __builtin_amdgcn_mfma_f32_16x16x32_bf16(af, bfr, gm, 0, 0, 0);
                        if (hw == 0) gmT = __builtin_amdgcn_mfma_f32_16x16x32_bf16(bfr, af, gmT, 0, 0, 0); }
                    if (hw == 3) {
                        const bf16x8 onesB = __builtin_bit_cast(bf16x8, c16 == 0 ? (u32x4){0x3F803F80u, 0x3F803F80u, 0x3F803F80u, 0x3F803F80u} : (u32x4){0u, 0u, 0u, 0u});
                        f32x4 rk = {0.f, 0.f, 0.f, 0.f};
#pragma unroll
                        for (int ks = 0; ks < 2; ++ks) { const int o1 = (8 * g4 + 32 * ks + (c16 >> 2)) * 32 + 8 * (c16 & 3), o2 = o1 + 4 * 32;
                            const v4i16_t r0 = lds_tr16(Ct + CT_RKT + o1), r1 = lds_tr16(Ct + CT_RKT + o2);
                            rk = __builtin_amdgcn_mfma_f32_16x16x32_bf16((bf16x8){r0[0], r0[1], r0[2], r0[3], r1[0], r1[1], r1[2], r1[3]}, onesB, rk, 0, 0, 0); }
                        if (c16 == 0) ((LAS f32x4*)(lds + SC_RKR + (jg & 3) * 256))[g4] = rk; }
#pragma unroll
                    for (int r = 0; r < 4; ++r) { const int s = 4 * g4 + r; const bool keep = (hw & 2) ? (s <= c16) : (s < c16); gm[r] = keep ? gm[r] : 0.f; gmT[r] = (c16 < s) ? gmT[r] : 0.f; }
                    if (hw != 0) { *(LAS u32x2*)(Gt + (hw == 1 ? GT_AKK : (hw == 2 ? GT_BB : GT_BK)) + c16 * 32 + 8 * g4) = (u32x2){cvtpk(gm[0], gm[1]), cvtpk(gm[2], gm[3])}; }
                    else {
#define SC_OPA(x) mk8(cvtpk((x)[0], (x)[1]), cvtpk((x)[2], (x)[3]), 0u, 0u)
                        const f32x4 z4 = {0.f, 0.f, 0.f, 0.f};
                        f32x4 Rm, RTm;
#pragma unroll
                        for (int r = 0; r < 4; ++r) { const float idn = (4 * g4 + r == c16) ? 1.f : 0.f; Rm[r] = idn - gm[r]; RTm[r] = idn - gmT[r]; }
                        const f32x4 N2 = __builtin_amdgcn_mfma_f32_16x16x32_bf16(SC_OPA(gmT), SC_OPA(gm), z4, 0, 0, 0), N2T = __builtin_amdgcn_mfma_f32_16x16x32_bf16(SC_OPA(gm), SC_OPA(gmT), z4, 0, 0, 0);
                        f32x4 R1 = __builtin_amdgcn_mfma_f32_16x16x32_bf16(SC_OPA(RTm), SC_OPA(N2), Rm, 0, 0, 0), R1T = __builtin_amdgcn_mfma_f32_16x16x32_bf16(SC_OPA(N2), SC_OPA(RTm), RTm, 0, 0, 0);
                        const f32x4 N4 = __builtin_amdgcn_mfma_f32_16x16x32_bf16(SC_OPA(N2T), SC_OPA(N2), z4, 0, 0, 0), N4T = __builtin_amdgcn_mfma_f32_16x16x32_bf16(SC_OPA(N2), SC_OPA(N2T), z4, 0, 0, 0);
                        f32x4 R2 = __builtin_amdgcn_mfma_f32_16x16x32_bf16(SC_OPA(R1T), SC_OPA(N4), R1, 0, 0, 0), R2T = __builtin_amdgcn_mfma_f32_16x16x32_bf16(SC_OPA(N4), SC_OPA(R1T), R1T, 0, 0, 0);
                        const f32x4 N8 = __builtin_amdgcn_mfma_f32_16x16x32_bf16(SC_OPA(N4T), SC_OPA(N4), z4, 0, 0, 0);
                        const f32x4 Tm = __builtin_amdgcn_mfma_f32_16x16x32_bf16(SC_OPA(R2T), SC_OPA(N8), R2, 0, 0, 0);
#undef SC_OPA
                        *(LAS u32x2*)(Gt + GT_TT + c16 * 32 + 8 * g4) = (u32x2){cvtpk(-Tm[0], -Tm[1]), cvtpk(-Tm[2], -Tm[3])};
                    }
                }
                if ((wid == 1 || wid == 2) && i >= 4 && i - 4 < NCH) {
                    const int jp = i - 4, tl = ln >> 3, c8 = ln & 7;
                    const int s = 8 * (wid - 1) + tl, t = d ? (SEQ - 1 - (jp * 16 + s)) : (jp * 16 + s);
                    const LAS float* ob = (const LAS float*)(lds + SC_OUT + (jp & 1) * 4096) + s * 64 + 8 * c8; const LAS float* gp = (const LAS float*)(lds + SC_GG + (jp & 3) * 4096) + s * 64 + 8 * c8;
                    const f32x4 o0 = *(const LAS f32x4*)(ob), o1 = *(const LAS f32x4*)(ob + 4), g0 = *(const LAS f32x4*)(gp), g1 = *(const LAS f32x4*)(gp + 4);
                    const float rkr = ((const LAS float*)(lds + SC_RKR + (jp & 3) * 256))[s];
                    const u32x4 pv = pvset;
                    const f32x4 v0 = {bflo(pv.x), bfhi(pv.x), bflo(pv.y), bfhi(pv.y)}, v1 = {bflo(pv.z), bfhi(pv.z), bflo(pv.w), bfhi(pv.w)};
                    float mu = ((o0[0] + o0[1]) + (o0[2] + o0[3])) + ((o1[0] + o1[1]) + (o1[2] + o1[3])); mu = sum8(mu) * (1.f / 64.f);
                    const f32x4 d0 = o0 - mu, d1 = o1 - mu; float var = ((d0[0] * d0[0] + d0[1] * d0[1]) + (d0[2] * d0[2] + d0[3] * d0[3])) + ((d1[0] * d1[0] + d1[1] * d1[1]) + (d1[2] * d1[2] + d1[3] * d1[3])); var = sum8(var) * (1.f / 64.f);
                    const float rs = rsqrtf(var + GN_EPS);
                    const f32x4 y0 = (d0 * rs * gw0 + gb0 + rkr * v0) * g0, y1 = (d1 * rs * gw1 + gb1 + rkr * v1) * g1;
                    pg8::store16_wt(P.Y + ((size_t)b * SEQ + t) * (2 * D) + d * D + hc + 8 * c8, (u32x4){cvtpk(y0[0], y0[1]), cvtpk(y0[2], y0[3]), cvtpk(y1[0], y1[1]), cvtpk(y1[2], y1[3])});
                    issueV(jp + 2 < NCH ? jp + 2 : NCH - 1, pvset);
                }
                for (int rep_ = 0; rep_ < REP_SYNC; ++rep_) __syncthreads();
                if (WAITPROBE >= 0) { const unsigned long long t0_ = __builtin_amdgcn_s_memrealtime(); __syncthreads(); wait_acc += __builtin_amdgcn_s_memrealtime() - t0_; } else
                __syncthreads();
            };
            static_assert((NCH + 4) % 2 == 0, "interval loop is unrolled by two");
            __builtin_amdgcn_s_setprio(2);
            for (int i = 0; i < NCH + 4; i += 2) { sw_interval(i, pvA); sw_interval(i + 1, pvB); }
            __builtin_amdgcn_s_setprio(0);
        } else {
            const int hw = wid - 4;
            const int chC = hc + 16 * hw + c16, chT = hc + 4 * c16;
            bf16x8 bw[2], ba[2], bg[4];
#pragma unroll
            for (int ks = 0; ks < 2; ++ks) { u32x4 w, a;
#pragma unroll
                for (int jj = 0; jj < 4; ++jj) { const int k = 32 * ks + 8 * g4 + 2 * jj;
                    w[jj] = pk2(-LOG2E * P.w2[(size_t)(d * 64 + k) * D + chC], -LOG2E * P.w2[(size_t)(d * 64 + k + 1) * D + chC]); a[jj] = pk2(-LOG2E * P.a2[(size_t)(d * 64 + k) * D + chC], -LOG2E * P.a2[(size_t)(d * 64 + k + 1) * D + chC]); }
                bw[ks] = __builtin_bit_cast(bf16x8, w); ba[ks] = __builtin_bit_cast(bf16x8, a); }
#pragma unroll
            for (int ks = 0; ks < 4; ++ks) { u32x4 g;
#pragma unroll
                for (int jj = 0; jj < 4; ++jj) { const int k = 32 * ks + 8 * g4 + 2 * jj; g[jj] = pk2(P.g2[(size_t)(d * 128 + k) * D + chC], P.g2[(size_t)(d * 128 + k + 1) * D + chC]); }
                bg[ks] = __builtin_bit_cast(bf16x8, g); }
            const float w0c = -LOG2E * P.w0[d * D + chC], a0c = -LOG2E * P.a0[d * D + chC], kaC = P.k_a[chC], rkC = P.r_k[chC];
            const f32x4 kkT = *(const f32x4*)(P.k_k + chT);
            const int n0 = 16 * c16, lcol = n0 < 64 ? (d * 64 + n0) : (n0 < 128 ? (128 + d * 64 + (n0 - 64)) : (256 + d * 128 + (n0 - 128)));
            struct LSet { u32x2 r, k, v; u32x4 l0, l1; };
            LSet setA, setB;
            auto issueL = [&](int ch_, LSet& S) { const int s = 4 * hw + g4, t = d ? (SEQ - 1 - (ch_ * 16 + s)) : (ch_ * 16 + s); const size_t row = (size_t)b * SEQ + t;
                S.r = *(const u32x2*)(P.R + row * D + chT); S.k = *(const u32x2*)(P.Kk + row * D + chT); S.v = *(const u32x2*)(P.V + row * D + chT);
                S.l0 = *(const u32x4*)(P.LDA + row * 512 + lcol); S.l1 = *(const u32x4*)(P.LDA + row * 512 + lcol + 8); };
            issueL(0, setA); issueL(1, setB);
            auto hw_interval = [&](int i, LSet& LS) {
                const bool doL = i < NCH, doC = (i >= 1 && i - 1 < NCH);
                int ln = lane; asm volatile("" : "+v"(ln)); const int g4 = ln >> 4, c16 = ln & 15;
                const unsigned long long tb_ = (SECPROBE >= 0) ? __builtin_amdgcn_s_memrealtime() : 0ull;
                for (int rep_ = 0; rep_ < REP_HC; ++rep_)
                if (doC) {
                    const int jc = i - 1;
                    const LAS unsigned char* Ls = lds + SC_LBUF + (jc & 1) * SC_LSLOT;
                    const LAS unsigned char* ldp = Ls + 4 * 16 * SC_LROW * 4 + c16 * SC_LDROW + 16 * g4;
                    f32x4 zw = {w0c, w0c, w0c, w0c}, za = {a0c, a0c, a0c, a0c}, gg = {0.f, 0.f, 0.f, 0.f};
#pragma unroll
                    for (int ks = 0; ks < 2; ++ks) { zw = __builtin_amdgcn_mfma_f32_16x16x32_bf16(*(const LAS bf16x8*)(ldp + 64 * ks), bw[ks], zw, 0, 0, 0);
                                                     za = __builtin_amdgcn_mfma_f32_16x16x32_bf16(*(const LAS bf16x8*)(ldp + 128 + 64 * ks), ba[ks], za, 0, 0, 0); }
#pragma unroll
                    for (int ks = 0; ks < 4; ++ks) gg = __builtin_amdgcn_mfma_f32_16x16x32_bf16(*(const LAS bf16x8*)(ldp + 256 + 64 * ks), bg[ks], gg, 0, 0, 0);
                    float lw[4], cw[4]; float tot = 0.f;
#pragma unroll
                    for (int r = 0; r < 4; ++r) { lw[r] = (-0.6065306597f * LOG2E) * __builtin_amdgcn_rcpf(1.f + __builtin_amdgcn_exp2f(zw[r])); tot += lw[r]; cw[r] = tot; }
                    float pre;
                    { auto e = __builtin_amdgcn_permlane16_swap(__float_as_uint(tot), __float_as_uint(tot), false, false); const float e0 = __uint_as_float(e[0]), s01 = e0 + __uint_as_float(e[1]);
                      auto f = __builtin_amdgcn_permlane32_swap(__float_as_uint(s01), __float_as_uint(s01), false, false);
                      pre = ((g4 & 1) ? e0 : 0.f) + ((g4 & 2) ? __uint_as_float(f[0]) : 0.f); }
                    const LAS float* Lf = (const LAS float*)Ls + 16 * hw + c16;
                    LAS unsigned char* Ct = lds + SC_CT + (jc % 3) * CT_SLOT;
                    LAS float* ggw = (LAS float*)(lds + SC_GG + (jc & 3) * 4096) + 16 * hw + c16;
                    float kh[4], rh[4], bt[4], kt[4], vv[4], rkp[4];
                    float Wprev = __builtin_amdgcn_exp2f(pre);
#pragma unroll
                    for (int r = 0; r < 4; ++r) { const int tok = 4 * g4 + r; const float c = pre + cw[r];
                        const float Wc = __builtin_amdgcn_exp2f(c), Wp = Wprev, iW = __builtin_amdgcn_exp2f(-c); Wprev = Wc;
                        const float a = __builtin_amdgcn_rcpf(1.f + __builtin_amdgcn_exp2f(za[r]));
                        const float rr = Lf[tok * SC_LROW], kk_ = Lf[16 * SC_LROW + tok * SC_LROW], nk = Lf[32 * SC_LROW + tok * SC_LROW]; vv[r] = Lf[48 * SC_LROW + tok * SC_LROW];
                        const float kd = kk_ * (1.f + (a - 1.f) * kaC);
                        kh[r] = nk * Wp; rh[r] = rr * Wc; bt[r] = nk * a * iW; kt[r] = kd * iW; rkp[r] = rr * kd * rkC;
                        ggw[tok * 64] = gg[r];
                        if (tok == 15) ((LAS float*)(Ct + CT_WEND))[16 * hw + c16] = Wc; }
                    { LAS unsigned char* tq = Ct + (16 * hw + c16) * 32 + 8 * g4;
                      *(LAS u32x2*)(tq + CT_KHT) = (u32x2){cvtpk(kh[0], kh[1]), cvtpk(kh[2], kh[3])}; *(LAS u32x2*)(tq + CT_RHT) = (u32x2){cvtpk(rh[0], rh[1]), cvtpk(rh[2], rh[3])};
                      *(LAS u32x2*)(tq + CT_BTT) = (u32x2){cvtpk(bt[0], bt[1]), cvtpk(bt[2], bt[3])}; *(LAS u32x2*)(tq + CT_KTT) = (u32x2){cvtpk(kt[0], kt[1]), cvtpk(kt[2], kt[3])};
                      *(LAS u32x2*)(tq + CT_VT) = (u32x2){cvtpk(vv[0], vv[1]), cvtpk(vv[2], vv[3])};
                      *(LAS u32x2*)(tq + CT_RKT) = (u32x2){cvtpk(rkp[0], rkp[1]), cvtpk(rkp[2], rkp[3])}; }
                }
                const unsigned long long tc_ = (SECPROBE >= 0) ? __builtin_amdgcn_s_memrealtime() : 0ull;
                for (int rep_ = 0; rep_ < REP_HL; ++rep_)
                if (doL) {
                    LAS unsigned char* Ls = lds + SC_LBUF + (i & 1) * SC_LSLOT; LAS float* Lf = (LAS float*)Ls;
                    const int s = 4 * hw + g4;
                    const u32x2 lr = LS.r, lk = LS.k, lv = LS.v; const u32x4 l00 = LS.l0, l01 = LS.l1;
                    const f32x4 rr = {bflo(lr.x), bfhi(lr.x), bflo(lr.y), bfhi(lr.y)}, kk_ = {bflo(lk.x), bfhi(lk.x), bflo(lk.y), bfhi(lk.y)}, vv = {bflo(lv.x), bfhi(lv.x), bflo(lv.y), bfhi(lv.y)};
                    f32x4 nk = kk_ * kkT; float ss = nk[0] * nk[0] + nk[1] * nk[1] + nk[2] * nk[2] + nk[3] * nk[3];
                    ss = sum16(ss);
                    nk = nk * __builtin_amdgcn_rsqf(fmaxf(ss, 1e-24f));
                    *(LAS f32x4*)(Lf + s * SC_LROW + 4 * c16) = rr; *(LAS f32x4*)(Lf + 16 * SC_LROW + s * SC_LROW + 4 * c16) = kk_;
                    *(LAS f32x4*)(Lf + 32 * SC_LROW + s * SC_LROW + 4 * c16) = nk; *(LAS f32x4*)(Lf + 48 * SC_LROW + s * SC_LROW + 4 * c16) = vv;
                    *(LAS u32x4*)(Ls + 4 * 16 * SC_LROW * 4 + s * SC_LDROW + 32 * c16) = l00; *(LAS u32x4*)(Ls + 4 * 16 * SC_LROW * 4 + s * SC_LDROW + 32 * c16 + 16) = l01;
                    issueL(i + 2 < NCH ? i + 2 : NCH - 1, LS);
                }
                for (int rep_ = 0; rep_ < REP_SYNC; ++rep_) __syncthreads();
                if (SECPROBE >= 0) { asm volatile("s_waitcnt vmcnt(0) lgkmcnt(0)" ::: "memory"); const unsigned long long te_ = __builtin_amdgcn_s_memrealtime(); wait_acc += (SECPROBE == 0) ? (tc_ - tb_) : ((SECPROBE == 1) ? (te_ - tc_) : (te_ - tb_)); __syncthreads(); } else
                if (WAITPROBE >= 0) { const unsigned long long t0_ = __builtin_amdgcn_s_memrealtime(); __syncthreads(); wait_acc += __builtin_amdgcn_s_memrealtime() - t0_; } else
                __syncthreads();
            };
            for (int i = 0; i < NCH + 4; i += 2) { hw_interval(i, setA); hw_interval(i + 1, setB); }
        }
        if ((WAITPROBE >= 0 || SECPROBE >= 0) && blockIdx.x == 0 && wid == (SECPROBE >= 0 ? 4 : WAITPROBE)) { const unsigned long long tgt_ = __builtin_amdgcn_s_memrealtime() + 4ull * wait_acc; while (__builtin_amdgcn_s_memrealtime() < tgt_) __builtin_amdgcn_s_sleep(8); }
    }
}

__global__ void __launch_bounds__(NTHREADS, 2) fwd_megakernel(Args args) {
    extern __shared__ __attribute__((aligned(16))) unsigned char lds_raw[];
    LAS unsigned char* lds = (LAS unsigned char*)lds_raw;
    volatile LAS unsigned* MISC = (volatile LAS unsigned*)(lds + MISC_OFF);
    const int tid0 = threadIdx.x, wave = __builtin_amdgcn_readfirstlane(tid0 >> 6);
#define FRESH_LANE() int tid = tid0; asm volatile("" : "+v"(tid)); const int lane = tid & 63; (void)lane
    const int G = gridDim.x;
    const int vcu = (G % 8 == 0) ? ((int)blockIdx.x % 8) * (G / 8) + (int)blockIdx.x / 8 : (int)blockIdx.x;
    const int gw = vcu * NWAVES + wave, NGW = G * NWAVES;
    unsigned char* ws = args.ws;
    unsigned* ctl = (unsigned*)(ws + WS_CTL);
    for (int u = tid0; u < (LDS_BYTES - LDSCTL_OFF) / 4; u += NTHREADS) ((LAS unsigned*)(lds + LDSCTL_OFF))[u] = 0u;
    __syncthreads();
    XcdBarrier bar = xcd_barrier_post(ctl + CW_BAR, MISC + 8);
    unsigned long long ts_a = 0ull; int ts_n = 0;
#define STAMP() do { if (TS_A >= 0) { const unsigned long long t_ = __builtin_amdgcn_s_memrealtime(); if (ts_n == TS_A) ts_a = t_; \
    if (ts_n == TS_B && blockIdx.x == 0) { const unsigned long long tgt_ = t_ + 4ull * (t_ - ts_a); while (__builtin_amdgcn_s_memrealtime() < tgt_) __builtin_amdgcn_s_sleep(8); } ++ts_n; } } while (0)
#define GRID_BAR() do { xcd_barrier(bar); STAMP(); } while (0)
    STAMP();

    const float* x = args.in[0]; const float* rel_table = args.in[1]; const float* norm_g = args.in[2]; const float* attn_w_in = args.in[3]; const float* attn_sink = args.in[4];
    const float* attn_w_out = args.in[5]; const float* mu_prev = args.in[6]; const float* mu_next = args.in[7]; const float* w_r = args.in[8]; const float* w_k = args.in[9];
    const float* w_v = args.in[10]; const float* w_o = args.in[11]; const float* mlp_w1 = args.in[25]; const float* mlp_w2 = args.in[26];
    bf16_t* HBa = (bf16_t*)args.out; bf16_t* HBb = HBa + (size_t)M * D; bf16_t* HBc = (bf16_t*)(ws + WS_HBC); bf16_t* TMP2 = (bf16_t*)(ws + WS_TMP2);
    bf16_t* XN = (bf16_t*)(ws + WS_XN); bf16_t* QKV = (bf16_t*)(ws + WS_QKV); bf16_t* Ob = (bf16_t*)(ws + WS_O); bf16_t* TMP = (bf16_t*)(ws + WS_TMP); bf16_t* Hb = (bf16_t*)(ws + WS_H);
    bf16_t* MIXA = (bf16_t*)(ws + WS_MIXA); bf16_t* MIXB = (bf16_t*)(ws + WS_MIXB); bf16_t* Rb = (bf16_t*)(ws + WS_R); bf16_t* Kb = (bf16_t*)(ws + WS_K); bf16_t* Vb = (bf16_t*)(ws + WS_V);
    bf16_t* LDO = (bf16_t*)(ws + WS_LDO); bf16_t* Yb = (bf16_t*)(ws + WS_Y);
    LAS float* scr = (LAS float*)(lds + wave * TR_SCR_BYTES);
    float* RS = (float*)(ws + WS_CTL + 128 * 1024);

    {
        FRESH_LANE();
        constexpr int I_IN = (D / 64) * (DIN / 64), I_OUT = (D / 64) * (D / 64), I_1 = (D / 64) * (DFF / 64), I_2 = (DFF / 64) * (D / 64);
        const bool tail = (G == 256);
        for (int it = gw; it < (tail ? I_IN : I_IN + I_OUT + I_1 + I_2); it += NGW) { int r = it;
            if (r < I_IN) { transpose_item(attn_w_in, DIN, DIN, (bf16_t*)(ws + WS_WIN_T), D, 0, 0, scr, r, lane, ScaleOne{}); continue; } r -= I_IN;
            if (r < I_OUT) { transpose_item(attn_w_out, D, D, (bf16_t*)(ws + WS_WOUT_T), D, 0, 0, scr, r, lane, ScaleOne{}); continue; } r -= I_OUT;
            if (r < I_1) { transpose_item(mlp_w1, DFF, DFF, (bf16_t*)(ws + WS_W1_T), D, 0, 0, scr, r, lane, ScaleVec{norm_g + 2 * D}); continue; } r -= I_1;
            transpose_item(mlp_w2, D, D, (bf16_t*)(ws + WS_W2_T), DFF, 0, 0, scr, r, lane, ScaleOne{}); }
        for (int row = gw; row < M; row += NGW) { Row16 r; row_load_f32(r, x + (size_t)row * D, lane); row_rmsnorm(r, norm_g, lane); row_store_bf16(r, XN + (size_t)row * D, lane); }
    }
    GRID_BAR();
    { pg8::StaticOrder S; S.init(M, DIN, G, (int)blockIdx.x); const EpiHeadMajor E{QKV};
      for (int rep = 0; rep < REP_GEMM; ++rep) pg8::gemm_phase<EpiHeadMajor, ProbPlain, true, true>(lds, ProbPlain{XN, (const bf16_t*)(ws + WS_WIN_T), D}, S, E); }
    if (G == 256 && blockIdx.x >= 64) {
        FRESH_LANE();
        constexpr int I_OUT = (D / 64) * (D / 64), I_1 = (D / 64) * (DFF / 64), I_2 = (DFF / 64) * (D / 64);
        for (int it = ((int)blockIdx.x - 64) * NWAVES + wave; it < I_OUT + I_1 + I_2; it += 192 * NWAVES) { int r = it;
            if (r < I_OUT) { transpose_item(attn_w_out, D, D, (bf16_t*)(ws + WS_WOUT_T), D, 0, 0, scr, r, lane, ScaleOne{}); continue; } r -= I_OUT;
            if (r < I_1) { transpose_item(mlp_w1, DFF, DFF, (bf16_t*)(ws + WS_W1_T), D, 0, 0, scr, r, lane, ScaleVec{norm_g + 2 * D}); continue; } r -= I_1;
            transpose_item(mlp_w2, D, D, (bf16_t*)(ws + WS_W2_T), DFF, 0, 0, scr, r, lane, ScaleOne{}); }
    }
    GRID_BAR();
    { const AttnIO io{QKV, rel_table, attn_sink, Ob, (bf16_t*)(ws + WS_OBR), (float*)(ws + WS_LSE)};
      for (int rep = 0; rep < REP_ATT; ++rep) phase_attn(lds, io, vcu, G);
      GRID_BAR();
      { FRESH_LANE(); phase_attn_merge(io, vcu * NTHREADS + tid, G * NTHREADS); } }
    GRID_BAR();
    for (int rep = 0; rep < REP_BAR; ++rep) GRID_BAR();
    run_gemm<0>(lds, ProbPlain{Ob, (const bf16_t*)(ws + WS_WOUT_T), D}, DstPlain{TMP, D}, M, D, G);
    GRID_BAR();
    { FRESH_LANE(); phase_resnorm<true, false>(x, TMP, norm_g + D, nullptr, HBa, nullptr, RS, gw, NGW, lane); }
    GRID_BAR();
    run_gemm_rs<1>(lds, ProbPlain{HBa, (const bf16_t*)(ws + WS_W1_T), D}, DstPlain{Hb, DFF}, RS, M, DFF, G);
    GRID_BAR();
    run_gemm<0>(lds, ProbPlain{Hb, (const bf16_t*)(ws + WS_W2_T), DFF}, DstPlain{TMP, D}, M, D, G);
    GRID_BAR();
    { FRESH_LANE(); phase_resnorm<false, false>(HBa, TMP, norm_g + 3 * D, nullptr, HBb, nullptr, nullptr, gw, NGW, lane); }
    GRID_BAR();
    {
        FRESH_LANE();
        const float* g1n = norm_g + 4 * D;
        constexpr int I_SQ = (D / 64) * (D / 64), I_1 = (D / 64) * (DFF / 64), I_2 = (DFF / 64) * (D / 64), I_LD = 384;
        const bool tail = (G == 256);
        for (int it = gw; it < (tail ? 2 * I_SQ + I_2 + I_LD : 4 * I_SQ + I_1 + I_2 + I_LD); it += NGW) { int r = it;
            if (r < I_SQ) { transpose_item(w_r, D, D, (bf16_t*)(ws + WS_WR_T), D, 0, 0, scr, r, lane, ScaleOne{}); continue; } r -= I_SQ;
            if (r < I_SQ) { transpose_item(w_k, D, D, (bf16_t*)(ws + WS_WK_T), D, 0, 0, scr, r, lane, ScaleOne{}); continue; } r -= I_SQ;
            if (!tail) {
                if (r < I_SQ) { transpose_item(w_v, D, D, (bf16_t*)(ws + WS_WV_T), D, 0, 0, scr, r, lane, ScaleOne{}); continue; } r -= I_SQ;
                if (r < I_SQ) { transpose_item(w_o, D, D, (bf16_t*)(ws + WS_WO2_T), D, 0, 0, scr, r, lane, ScaleOne{}); continue; } r -= I_SQ;
                if (r < I_1) { transpose_item(mlp_w1 + (size_t)D * DFF, DFF, DFF, (bf16_t*)(ws + WS_W1B_T), D, 0, 0, scr, r, lane, ScaleVec{norm_g + 6 * D}); continue; } r -= I_1; }
            if (r < I_2) { transpose_item(mlp_w2 + (size_t)DFF * D, D, D, (bf16_t*)(ws + WS_W2B_T), DFF, 0, 0, scr, r, lane, ScaleOne{}); continue; } r -= I_2;
            const int part = r / 128; int q = r % 128; int sub, li;
            if (q < 64) { sub = q / 16; li = q % 16; } else { sub = 4 + (q - 64) / 32; li = (q - 64) % 32; }
            const int dd = sub & 1, kind = sub >> 1;
            const int stream = kind == 0 ? 1 : (kind == 1 ? 4 : 5), Nn = kind == 2 ? 128 : 64;
            const float* src = kind == 0 ? args.in[18] + (size_t)dd * D * 64 : (kind == 1 ? args.in[21] + (size_t)dd * D * 64 : args.in[23] + (size_t)dd * D * 128);
            const int coloff = kind == 0 ? dd * 64 : (kind == 1 ? 128 + dd * 64 : 256 + dd * 128);
            transpose_item(src, Nn, Nn, (bf16_t*)(ws + WS_LDW_T), D, part * 512 + coloff, 0, scr, li, lane, ScaleMix{mu_prev + stream * D, mu_next + stream * D, part}); }
        phase_mix3(lds, HBb, g1n, mu_prev, mu_next, XN, MIXA, MIXB, HBa, gw, NGW, tid, lane);
    }
    GRID_BAR();
    run_gemm<0>(lds, ProbRKL{ws, D}, DstRKL{ws}, M, 14 * 256, G);
    if (G == 256 && blockIdx.x >= 128) {
        FRESH_LANE();
        constexpr int I_SQ = (D / 64) * (D / 64), I_1 = (D / 64) * (DFF / 64);
        for (int it = ((int)blockIdx.x - 128) * NWAVES + wave; it < 2 * I_SQ + I_1; it += 128 * NWAVES) { int r = it;
            if (r < I_SQ) { transpose_item(w_v, D, D, (bf16_t*)(ws + WS_WV_T), D, 0, 0, scr, r, lane, ScaleOne{}); continue; } r -= I_SQ;
            if (r < I_SQ) { transpose_item(w_o, D, D, (bf16_t*)(ws + WS_WO2_T), D, 0, 0, scr, r, lane, ScaleOne{}); continue; } r -= I_SQ;
            transpose_item(mlp_w1 + (size_t)D * DFF, DFF, DFF, (bf16_t*)(ws + WS_W1B_T), D, 0, 0, scr, r, lane, ScaleVec{norm_g + 6 * D}); }
    }
    GRID_BAR();
    { FRESH_LANE(); phase_lda(LDO, (bf16_t*)(ws + WS_LDA), gw, NGW, lane); }
    run_gemm<0>(lds, ProbPlain{HBa, (const bf16_t*)(ws + WS_WV_T), D}, DstPlain{Vb, D}, M, D, G);
    GRID_BAR();
    { ScanPtrs sp{Rb, Kb, Vb, (const bf16_t*)(ws + WS_LDA), Yb, args.in[19], args.in[22], args.in[24], args.in[17], args.in[20], args.in[12], args.in[13], args.in[14], args.in[15], args.in[16]};
      for (int rep = 0; rep < REP_SCAN; ++rep) phase_scan(lds, sp, G); }
    GRID_BAR();
    { FRESH_LANE();
      bf16_t* Ys = (bf16_t*)(ws + WS_YSUM);
      const bool grp_on = (G == 256);
      const int grow0 = 256 * (8 * ((int)blockIdx.x % 8) + ((int)blockIdx.x / 8) % 8) + 64 * ((int)blockIdx.x / 64);
      const int rfirst = grp_on ? grow0 + wave : gw, rend = grp_on ? grow0 + 64 : M, rstride = grp_on ? NWAVES : NGW;
      for (int row = rfirst; row < rend; row += rstride) {
          const u32x4* y0 = (const u32x4*)(Yb + (size_t)row * 2 * D); const u32x4* y1 = (const u32x4*)(Yb + (size_t)row * 2 * D + D);
#pragma unroll
          for (int hb = 0; hb < 2; ++hb) { const u32x4 a = y0[lane + 64 * hb], c = y1[lane + 64 * hb]; u32x4 o;
              o.x = cvtpk(bflo(a.x) + bflo(c.x), bfhi(a.x) + bfhi(c.x)); o.y = cvtpk(bflo(a.y) + bflo(c.y), bfhi(a.y) + bfhi(c.y));
              o.z = cvtpk(bflo(a.z) + bflo(c.z), bfhi(a.z) + bfhi(c.z)); o.w = cvtpk(bflo(a.w) + bflo(c.w), bfhi(a.w) + bfhi(c.w));
              pg8::store16_wt((u32x4*)(Ys + (size_t)row * D) + lane + 64 * hb, o); } }
      if (grp_on) { unsigned ep = 0u; grp_barrier(ctl + CW_BAR, (unsigned)blockIdx.x % 64u, ep); } else GRID_BAR();
      run_gemm<0>(lds, ProbPlain{Ys, (const bf16_t*)(ws + WS_WO2_T), D}, DstPlain{TMP2, D}, M, D, G); }
    GRID_BAR();
    { FRESH_LANE(); phase_resnorm<false, false>(HBb, TMP2, norm_g + 5 * D, nullptr, HBc, nullptr, RS, gw, NGW, lane); }
    GRID_BAR();
    run_gemm_rs<1>(lds, ProbPlain{HBc, (const bf16_t*)(ws + WS_W1B_T), D}, DstPlain{Hb, DFF}, RS, M, DFF, G);
    GRID_BAR();
    run_gemm<0>(lds, ProbPlain{Hb, (const bf16_t*)(ws + WS_W2B_T), DFF}, DstPlain{TMP2, D}, M, D, G);
    GRID_BAR();
    { FRESH_LANE(); phase_resnorm<false, true>(HBc, TMP2, norm_g + 7 * D, nullptr, args.out, nullptr, nullptr, gw, NGW, lane); }
    if (TS_A >= 0) { GRID_BAR(); }
#undef GRID_BAR
}

extern "C" void kernel_launch(void* const* d_in, const int* in_sizes, int n_in, void* d_out, int out_size, void* d_ws, size_t ws_size, hipStream_t stream) {
    static int grid = 0;
    if (grid == 0) {
        if (n_in != 27 || in_sizes[0] != M * D || out_size != M * D || ws_size < WS_END) { fprintf(stderr, "kernel_launch: unexpected shapes (n_in %d, in0 %d, out %d, ws %zu)\n", n_in, n_in > 0 ? in_sizes[0] : -1, out_size, ws_size); grid = -1; return; }
        int dev = 0, cus = 0, per_cu = 0;
        if (hipGetDevice(&dev) != hipSuccess || hipDeviceGetAttribute(&cus, hipDeviceAttributeMultiprocessorCount, dev) != hipSuccess) { grid = -1; return; }
        if (hipFuncSetAttribute((const void*)fwd_megakernel, hipFuncAttributeMaxDynamicSharedMemorySize, LDS_BYTES) != hipSuccess) { fprintf(stderr, "kernel_launch: hipFuncSetAttribute failed\n"); grid = -1; return; }
        if (hipOccupancyMaxActiveBlocksPerMultiprocessor(&per_cu, (const void*)fwd_megakernel, NTHREADS, LDS_BYTES) != hipSuccess || per_cu < 1) { fprintf(stderr, "kernel_launch: occupancy query says %d blocks/CU\n", per_cu); (void)hipGetLastError(); grid = -1; return; }
        grid = cus;
    }
    if (grid < 0) return;
    (void)hipMemsetAsync((char*)d_ws + WS_CTL, 0, CTL_ZERO_BYTES, stream);
    Args a{};
    for (int i = 0; i < 27; ++i) a.in[i] = (const float*)d_in[i];
    a.out = (float*)d_out; a.ws = (unsigned char*)d_ws;
    hipLaunchKernelGGL(fwd_megakernel, dim3(grid), dim3(NTHREADS), LDS_BYTES, stream, a);
}
```

```cpp
#include <hip/hip_runtime.h>
#include <cstdio>
#include <cstdint>

#define LAS __attribute__((address_space(3)))
#define GAS __attribute__((address_space(1)))
typedef unsigned short bf16_t;
typedef short bf16x8 __attribute__((ext_vector_type(8)));
typedef float f32x4 __attribute__((ext_vector_type(4)));
typedef float f32x2 __attribute__((ext_vector_type(2)));
typedef unsigned u32x4 __attribute__((ext_vector_type(4)));
typedef unsigned u32x2 __attribute__((ext_vector_type(2)));

#ifndef REP_SCAN
#define REP_SCAN 1
#endif
#ifndef REP_ATT
#define REP_ATT 1
#endif
#ifndef REP_GEMM
#define REP_GEMM 1
#endif
#ifndef REP_ATTC
#define REP_ATTC 1
#endif
#ifndef REP_BAR
#define REP_BAR 0
#endif
#ifndef REP_ATTS
#define REP_ATTS 1
#endif
#ifndef REP_HC
#define REP_HC 1
#endif
#ifndef REP_ST
#define REP_ST 1
#endif
#ifndef REP_HL
#define REP_HL 1
#endif
#ifndef REP_SYNC
#define REP_SYNC 0
#endif
#ifndef SECPROBE
#define SECPROBE -1
#endif
#ifndef WAITPROBE
#define WAITPROBE -1
#endif
#ifndef TS_A
#define TS_A -1
#endif
#ifndef TS_B
#define TS_B -1
#endif
constexpr int SEQ = 2048, D = 1024, NBATCH = 8, M = NBATCH * SEQ, DFF = 4096, DIN = 2304, NLD = 1536;
constexpr float NORM_EPS = 1e-6f, GN_EPS = 64e-5f;
constexpr int NWAVES = 8, NTHREADS = 512;

namespace pg8 {
constexpr int BM = 256, BK = 64, HALF = 128, HTB = HALF * BK * 2, STAGE_BYTES = 8 * HTB, NXCD = 8, WGM = 8;
__host__ __device__ __forceinline__ int lds_byte(int r, int c) { const int st = (r >> 4) * 2 + (c >> 5), rr = r & 15, cc = c & 31, ob = rr * 64 + cc * 2; return st * 1024 + (ob ^ (((ob >> 9) & 1) << 5)); }
__host__ __device__ __forceinline__ void stage_rc(int b, int& R, int& C) { const int st = b / 1024, sb = b % 1024, swz = sb ^ (((sb >> 9) & 1) << 5); R = (st >> 1) * 16 + swz / 64; C = (st & 1) * 32 + (swz % 64) / 2; }
__host__ __device__ __forceinline__ int perm32(int rho) { const int n = rho >> 4, i = rho & 15; return 8 * (i >> 2) + 4 * n + (i & 3); }

struct Unit { int pm, pn; };
struct StaticOrder {
    int nM, nN, nwg, G, c;
    __host__ __device__ void init(int Mr, int N, int G_, int c_) { nM = Mr / BM; nN = N / BM; nwg = nM * nN; G = G_; c = c_; }
    __host__ __device__ bool next(int i, Unit& u) const {
        const long L = (long)i * G + c; if (L >= nwg) return false;
        int wgid = (int)L; { const int q = nwg / NXCD, r = nwg % NXCD, xcd = wgid % NXCD, off = wgid / NXCD; wgid = (xcd < r ? xcd * (q + 1) : r * (q + 1) + (xcd - r) * q) + off; }
        const int nig = WGM * nN, gid = wgid / nig, fm = gid * WGM, gsz = (nM - fm) < WGM ? (nM - fm) : WGM;
        u.pm = fm + ((wgid % nig) % gsz); u.pn = (wgid % nig) / gsz; return true;
    }
};
__device__ __forceinline__ unsigned cvt_pk_bf16(float lo, float hi) { unsigned r; asm volatile("v_cvt_pk_bf16_f32 %0, %1, %2" : "=v"(r) : "v"(lo), "v"(hi)); return r; }

__device__ __forceinline__ void store16_wt(void* p, u32x4 v) { asm volatile("global_store_dwordx4 %0, %1, off sc1\n\ts_nop 1" :: "v"(p), "v"(v) : "memory"); }
__device__ __forceinline__ void store_rows16_full(bf16_t* tile, int ldc, int R0, int wc, int fr, int fq, u32x4 w0, u32x4 w1) {
    const bool lo = fr < 8;
    u32x4 x, y;
#pragma unroll
    for (int e = 0; e < 4; ++e) { x[e] = lo ? w1[e] : w0[e]; y[e] = (unsigned)__builtin_amdgcn_update_dpp(0, (int)x[e], 0x128, 0xF, 0xF, true); }
    u32x4 pa, pb;
#pragma unroll
    for (int e = 0; e < 4; ++e) { pa[e] = lo ? w0[e] : y[e]; pb[e] = lo ? y[e] : w1[e]; }
    bf16_t* p = tile + (size_t)(R0 + (fr & 7)) * ldc + wc * 64 + (lo ? 0 : 32) + 8 * fq;
    store16_wt(p, pa); store16_wt(p + (size_t)8 * ldc, pb);
}
template <int ACT, class DstFn, bool RS = false> struct EpiBf16 {
    static constexpr bool PERM = true;
    DstFn F; const float* rs;
    __device__ __forceinline__ void operator()(const f32x4 (&acc)[2][2][4][2], const Unit& u, int wr, int wc, int fr, int fq) const {
        bf16_t* base; int ldc; F(u, base, ldc);
        const int row0 = wr * 64 + fr, col0 = wc * 64 + 8 * fq;
        float rsc[2][4];
        if (RS) {
#pragma unroll
            for (int ai = 0; ai < 2; ++ai)
#pragma unroll
                for (int m = 0; m < 4; ++m) rsc[ai][m] = rs[u.pm * BM + row0 + ai * HALF + m * 16]; }
        if (RS && ACT == 1) {
            f32x4 t[2][2][4][2];
#pragma unroll
            for (int ai = 0; ai < 2; ++ai)
#pragma unroll
                for (int bj = 0; bj < 2; ++bj)
#pragma unroll
                    for (int m = 0; m < 4; ++m)
#pragma unroll
                        for (int n = 0; n < 2; ++n)
#pragma unroll
                            for (int e = 0; e < 4; ++e) { const float a = fmaxf(acc[ai][bj][m][n][e], 0.f); t[ai][bj][m][n][e] = a * a; }
#pragma unroll
            for (int ai = 0; ai < 2; ++ai)
#pragma unroll
                for (int m = 0; m < 4; ++m) { const float r2 = rsc[ai][m] * rsc[ai][m]; u32x4 w[2];
#pragma unroll
                    for (int bj = 0; bj < 2; ++bj) { const f32x4 v0 = t[ai][bj][m][0] * r2, v1 = t[ai][bj][m][1] * r2;
                        w[bj].x = cvt_pk_bf16(v0[0], v0[1]); w[bj].y = cvt_pk_bf16(v0[2], v0[3]); w[bj].z = cvt_pk_bf16(v1[0], v1[1]); w[bj].w = cvt_pk_bf16(v1[2], v1[3]); }
                    store_rows16_full(base, ldc, wr * 64 + ai * HALF + m * 16, wc, fr, fq, w[0], w[1]); }
            return;
        }
#pragma unroll
        for (int ai = 0; ai < 2; ++ai)
#pragma unroll
            for (int m = 0; m < 4; ++m) { u32x4 w[2];
#pragma unroll
                for (int bj = 0; bj < 2; ++bj) { f32x4 v0 = acc[ai][bj][m][0], v1 = acc[ai][bj][m][1];
                    if (RS) { v0 = v0 * rsc[ai][m]; v1 = v1 * rsc[ai][m]; }
                    if (ACT == 1) {
#pragma unroll
                        for (int e = 0; e < 4; ++e) { const float a = fmaxf(v0[e], 0.f), b = fmaxf(v1[e], 0.f); v0[e] = a * a; v1[e] = b * b; } }
                    w[bj].x = cvt_pk_bf16(v0[0], v0[1]); w[bj].y = cvt_pk_bf16(v0[2], v0[3]); w[bj].z = cvt_pk_bf16(v1[0], v1[1]); w[bj].w = cvt_pk_bf16(v1[2], v1[3]); }
                store_rows16_full(base, ldc, wr * 64 + ai * HALF + m * 16, wc, fr, fq, w[0], w[1]); }
    }
};

template <class Epi, class Prob, bool ALIGN_EPI, bool SP2>
__device__ __forceinline__ void gemm_phase(LAS unsigned char* lds, const Prob& P, const StaticOrder& S, const Epi& E) {
    int tid = threadIdx.x; asm volatile("" : "+v"(tid));
    const int wid = __builtin_amdgcn_readfirstlane(tid >> 6), lane = tid & 63, wr = wid >> 2, wc = wid & 3, fr = lane & 15, fq = lane >> 4;
    const int K = P.K, nt = K / BK;
    unsigned voffA[2], voffB[2];
#pragma unroll
    for (int i = 0; i < 2; ++i) { int R, C; stage_rc(tid * 16 + i * 8192, R, C); const int Rb = Epi::PERM ? ((R & ~31) + perm32(R & 31)) : R;
        voffA[i] = (unsigned)(R * K + C) * 2u; voffB[i] = (unsigned)(Rb * K + C) * 2u; }
    const size_t kstep = (size_t)(BK * 2);
    const size_t hstep = (size_t)HALF * K * 2;
    const unsigned ldsw = (unsigned)wid * 1024u;
    const int aoff = lds_byte(wr * 64 + fr, fq * 8);
    const int boffH0 = (wc >> 1) * HTB + lds_byte((wc & 1) * 64 + fr, fq * 8), boffH1 = (wc >> 1) * HTB + lds_byte((wc & 1) * 64 + 32 + fr, fq * 8);
#define PG8_SA(b, h) (((b) * 2 + (h)) * HTB)
#define PG8_SB(b, h) ((4 + (b) * 2 + (h)) * HTB)
#define PG8_STAGE(bufoff, gbase, voff) do { _Pragma("unroll") for (int _i = 0; _i < 2; ++_i) \
        __builtin_amdgcn_global_load_lds((const unsigned*)((const char*)(gbase) + (voff)[_i]), (LAS unsigned*)(lds + (bufoff) + ldsw + _i * 8192), 16, 0, 0); } while (0)
#define PG8_LDA(dst, b, h) do { _Pragma("unroll") for (int m = 0; m < 4; ++m) _Pragma("unroll") for (int k = 0; k < 2; ++k) dst[m][k] = *(const LAS bf16x8*)(lds + PG8_SA(b, h) + aoff + m * 2048 + k * 1024); } while (0)
#define PG8_LDB(dst, b, h) do { _Pragma("unroll") for (int n = 0; n < 2; ++n) _Pragma("unroll") for (int k = 0; k < 2; ++k) dst[n][k] = *(const LAS bf16x8*)(lds + PG8_SB(b, 0) + ((h) ? boffH1 : boffH0) + n * 2048 + k * 1024); } while (0)
#define PG8_MMA(ai, bj, At, Bt) do { __builtin_amdgcn_s_setprio(1); _Pragma("unroll") for (int m = 0; m < 4; ++m) _Pragma("unroll") for (int n = 0; n < 2; ++n) _Pragma("unroll") for (int k = 0; k < 2; ++k) \
        acc[ai][bj][m][n] = __builtin_amdgcn_mfma_f32_16x16x32_bf16(Bt[n][k], At[m][k], acc[ai][bj][m][n], 0, 0, 0); __builtin_amdgcn_s_setprio(0); } while (0)
#define PG8_WAIT_V(n) asm volatile("s_waitcnt vmcnt(" #n ")" ::: "memory")
#define PG8_WAIT_L(n) asm volatile("s_waitcnt lgkmcnt(" #n ")" ::: "memory")
#define PG8_BAR __builtin_amdgcn_s_barrier()
#define PG8_SCHED __builtin_amdgcn_sched_barrier(0)
    Unit cur, nxt; int ui = 0;
    if (!S.next(0, cur)) return;
    f32x4 acc[2][2][4][2];
#pragma unroll
    for (int a = 0; a < 2; ++a)
#pragma unroll
        for (int b = 0; b < 2; ++b)
#pragma unroll
            for (int m = 0; m < 4; ++m)
#pragma unroll
                for (int n = 0; n < 2; ++n) acc[a][b][m][n] = (f32x4){0.f, 0.f, 0.f, 0.f};
    bf16x8 At[4][2], B0[2][2], B1[2][2];
    const char* cA = P.a_tile(cur); const char* cB = P.b_tile(cur);
    if constexpr (SP2) {
        PG8_STAGE(PG8_SB(0, 0), cB, voffB); PG8_STAGE(PG8_SB(0, 1), cB + hstep, voffB); PG8_STAGE(PG8_SA(0, 0), cA, voffA); PG8_STAGE(PG8_SA(0, 1), cA + hstep, voffA);
        if (wr == 1) PG8_BAR;
        PG8_WAIT_V(2); PG8_BAR;
        PG8_STAGE(PG8_SB(1, 0), cB + kstep, voffB); PG8_STAGE(PG8_SA(1, 0), cA + kstep, voffA); PG8_STAGE(PG8_SB(1, 1), cB + hstep + kstep, voffB);
        PG8_WAIT_V(6); PG8_BAR;
    } else {
        PG8_STAGE(PG8_SB(0, 0), cB, voffB); PG8_STAGE(PG8_SA(0, 0), cA, voffA); PG8_STAGE(PG8_SB(0, 1), cB + hstep, voffB); PG8_STAGE(PG8_SA(0, 1), cA + hstep, voffA);
        if (wr == 1) PG8_BAR;
        PG8_WAIT_V(4); PG8_BAR;
        PG8_STAGE(PG8_SB(1, 0), cB + kstep, voffB); PG8_STAGE(PG8_SA(1, 0), cA + kstep, voffA); PG8_STAGE(PG8_SB(1, 1), cB + hstep + kstep, voffB);
        PG8_WAIT_V(6); PG8_BAR;
    }
    for (;;) {
        const bool has_next = S.next(ui + 1, nxt);
        const char* nA = has_next ? P.a_tile(nxt) : cA; const char* nB = has_next ? P.b_tile(nxt) : cB;
        for (int t = 0; t < nt; t += 2) {
            const bool last = (t == nt - 2);
            const char* a1 = cA + (size_t)(t + 1) * kstep;
            const char* a2 = last ? nA : cA + (size_t)(t + 2) * kstep; const char* b2 = last ? nB : cB + (size_t)(t + 2) * kstep;
            const char* a3 = a2 + kstep; const char* b3 = b2 + kstep;
            if constexpr (SP2) {
            PG8_LDB(B0, 0, 0); PG8_LDB(B1, 0, 1); PG8_SCHED; PG8_LDA(At, 0, 0); PG8_STAGE(PG8_SA(1, 1), a1 + hstep, voffA);
            PG8_WAIT_V(8); PG8_WAIT_L(0); PG8_BAR; PG8_MMA(0, 0, At, B0); PG8_MMA(0, 1, At, B1); PG8_BAR; PG8_SCHED;
            PG8_LDA(At, 0, 1); PG8_STAGE(PG8_SB(0, 0), b2, voffB); PG8_STAGE(PG8_SB(0, 1), b2 + hstep, voffB); PG8_STAGE(PG8_SA(0, 0), a2, voffA);
            PG8_WAIT_V(8); PG8_WAIT_L(0); PG8_BAR; PG8_MMA(1, 0, At, B0); PG8_MMA(1, 1, At, B1); PG8_BAR; PG8_SCHED;
            PG8_LDB(B0, 1, 0); PG8_LDB(B1, 1, 1); PG8_SCHED; PG8_LDA(At, 1, 0); PG8_STAGE(PG8_SA(0, 1), a2 + hstep, voffA);
            PG8_WAIT_V(8); PG8_WAIT_L(0); PG8_BAR; PG8_MMA(0, 0, At, B0); PG8_MMA(0, 1, At, B1); PG8_BAR; PG8_SCHED;
            PG8_LDA(At, 1, 1); PG8_STAGE(PG8_SB(1, 0), b3, voffB); PG8_STAGE(PG8_SB(1, 1), b3 + hstep, voffB); PG8_STAGE(PG8_SA(1, 0), a3, voffA);
            PG8_WAIT_V(8); PG8_WAIT_L(0); PG8_BAR; PG8_MMA(1, 0, At, B0); PG8_MMA(1, 1, At, B1); PG8_BAR; PG8_SCHED;
            } else {
            PG8_LDB(B0, 0, 0); PG8_SCHED; PG8_LDA(At, 0, 0); PG8_STAGE(PG8_SA(1, 1), a1 + hstep, voffA);
            PG8_WAIT_L(8); PG8_BAR; PG8_WAIT_L(0); PG8_MMA(0, 0, At, B0); PG8_BAR; PG8_SCHED;
            PG8_LDB(B1, 0, 1); PG8_STAGE(PG8_SB(0, 0), b2, voffB);
            PG8_BAR; PG8_WAIT_L(0); PG8_MMA(0, 1, At, B1); PG8_BAR;
            PG8_LDA(At, 0, 1); PG8_STAGE(PG8_SA(0, 0), a2, voffA);
            PG8_BAR; PG8_WAIT_L(0); PG8_MMA(1, 0, At, B0); PG8_BAR; PG8_SCHED;
            PG8_STAGE(PG8_SB(0, 1), b2 + hstep, voffB);
            PG8_WAIT_V(6); PG8_BAR; PG8_MMA(1, 1, At, B1); PG8_BAR;
            PG8_LDB(B0, 1, 0); PG8_SCHED; PG8_LDA(At, 1, 0); PG8_STAGE(PG8_SA(0, 1), a2 + hstep, voffA);
            PG8_WAIT_L(8); PG8_BAR; PG8_WAIT_L(0); PG8_MMA(0, 0, At, B0); PG8_BAR; PG8_SCHED;
            PG8_LDB(B1, 1, 1); PG8_STAGE(PG8_SB(1, 0), b3, voffB);
            PG8_BAR; PG8_WAIT_L(0); PG8_MMA(0, 1, At, B1); PG8_BAR;
            PG8_LDA(At, 1, 1); PG8_STAGE(PG8_SA(1, 0), a3, voffA);
            PG8_BAR; PG8_WAIT_L(0); PG8_MMA(1, 0, At, B0); PG8_BAR; PG8_SCHED;
            PG8_STAGE(PG8_SB(1, 1), b3 + hstep, voffB);
            PG8_WAIT_V(6); PG8_BAR; PG8_MMA(1, 1, At, B1); PG8_BAR;
            }
        }
        if constexpr (ALIGN_EPI) { if (wr == 0) PG8_BAR; }
        E(acc, cur, wr, wc, fr, fq);
        if (!has_next) break;
#pragma unroll
        for (int a = 0; a < 2; ++a)
#pragma unroll
            for (int b = 0; b < 2; ++b)
#pragma unroll
                for (int m = 0; m < 4; ++m)
#pragma unroll
                    for (int n = 0; n < 2; ++n) acc[a][b][m][n] = (f32x4){0.f, 0.f, 0.f, 0.f};
        cur = nxt; cA = nA; cB = nB; ++ui;
        if constexpr (ALIGN_EPI) { if (wr == 1) PG8_BAR; }
    }
    PG8_WAIT_V(0);
    if constexpr (!ALIGN_EPI) { if (wr == 0) PG8_BAR; }
    PG8_BAR;
#undef PG8_SA
#undef PG8_SB
#undef PG8_STAGE
#undef PG8_LDA
#undef PG8_LDB
#undef PG8_MMA
#undef PG8_WAIT_V
#undef PG8_WAIT_L
#undef PG8_BAR
#undef PG8_SCHED
}
}

constexpr size_t MiB = 1u << 20;
constexpr size_t WS_CTL = 0, CTL_ZERO_BYTES = 64 * 1024;
constexpr size_t WS_W = 1 * MiB;
constexpr size_t WS_WIN_T = WS_W, WS_WOUT_T = WS_WIN_T + (size_t)DIN * D * 2, WS_W1_T = WS_WOUT_T + (size_t)D * D * 2, WS_W2_T = WS_W1_T + (size_t)DFF * D * 2;
constexpr size_t WS_WR_T = WS_W, WS_WK_T = WS_WR_T + 2 * MiB, WS_LDW_T = WS_WK_T + 2 * MiB, WS_WV_T = WS_LDW_T + 3 * MiB, WS_WO2_T = WS_WV_T + 2 * MiB, WS_W1B_T = WS_WO2_T + 4 * MiB, WS_W2B_T = WS_W1B_T + 8 * MiB;
static_assert(WS_W2_T + (size_t)D * DFF * 2 <= 31 * MiB && WS_W2B_T + (size_t)D * DFF * 2 <= 31 * MiB, "weight region");
constexpr size_t WS_XN = 31 * MiB, WS_QKV = 63 * MiB, WS_O = 135 * MiB, WS_OBR = 167 * MiB, WS_LSE = 215 * MiB, WS_TMP = 217 * MiB, WS_H = 63 * MiB;
constexpr size_t WS_MIXA = 63 * MiB, WS_MIXB = 95 * MiB, WS_R = 127 * MiB, WS_K = 159 * MiB, WS_V = 31 * MiB, WS_LDO = 191 * MiB, WS_Y = 63 * MiB, WS_LDA = 239 * MiB;
constexpr size_t WS_YSUM = 127 * MiB;
constexpr size_t WS_HBC = 191 * MiB, WS_TMP2 = 223 * MiB;
constexpr size_t WS_END = 256 * MiB;
static_assert(WS_HBC >= WS_H + (size_t)M * DFF * 2 && WS_HBC + (size_t)M * D * 2 <= WS_TMP2 && WS_TMP2 + (size_t)M * D * 2 <= WS_END, "layer-1 tail");
static_assert(WS_LDO + (size_t)M * NLD * 2 <= WS_LDA && WS_LDA + (size_t)M * 512 * 2 <= WS_END && WS_TMP + (size_t)M * D * 2 <= WS_END, "tail of the map");
static_assert(WS_MIXA == WS_XN + 32 * MiB && WS_MIXB == WS_XN + 64 * MiB && WS_K == WS_R + 32 * MiB && WS_LDO == WS_R + 64 * MiB && WS_WK_T == WS_WR_T + 2 * MiB && WS_LDW_T == WS_WR_T + 4 * MiB, "grouped GEMM strides");
constexpr int CW_BAR = 4096;

constexpr int RING_BYTES = 131072, LDSCTL_OFF = 143360, MISC_OFF = LDSCTL_OFF + 320, LDS_BYTES = 147456;

typedef __bf16 bf16x2_t __attribute__((ext_vector_type(2)));
__device__ __forceinline__ unsigned cvtpk(float lo, float hi) { const f32x2 v = {lo, hi}; const bf16x2_t b = __builtin_convertvector(v, bf16x2_t); return __builtin_bit_cast(unsigned, b); }
__device__ __forceinline__ float bf2f(unsigned short b) { return __uint_as_float((unsigned)b << 16); }
__device__ __forceinline__ float bflo(unsigned w) { return __uint_as_float(w << 16); }
__device__ __forceinline__ float bfhi(unsigned w) { return __uint_as_float(w & 0xffff0000u); }
__device__ __forceinline__ unsigned f2bf(float f) { unsigned u = __float_as_uint(f); return (u + 0x7fffu + ((u >> 16) & 1u)) >> 16; }
__device__ __forceinline__ unsigned pk2(float lo, float hi) { return f2bf(lo) | (f2bf(hi) << 16); }
__device__ __forceinline__ float wave_sum(float v) {
#pragma unroll
    for (int o = 1; o < 64; o <<= 1) v += __shfl_xor(v, o);
    return v;
}
__device__ __forceinline__ float sigmoidf_(float z) { return 1.f / (1.f + __expf(-z)); }
__device__ __forceinline__ int t5_bucket(int rel) {
    const int n = rel < 0 ? -rel : rel;
    int large;
    if (n < 8) large = n; else if (n < 15) large = 8; else if (n < 27) large = 9; else if (n < 50) large = 10; else if (n < 91) large = 11;
    else if (n < 166) large = 12; else if (n < 305) large = 13; else if (n < 559) large = 14; else large = 15;
    return (rel > 0 ? 16 : 0) + large;
}

#define XB_TMO      128
#define XB_XCNT(j)  (256  + 64 * (j))
#define XB_XSUB(j)  (1280 + 64 * (j))
#define XB_XGEN(j)  (2304 + 64 * (j))
#define XB_TOP      3328
#define XB_TOPGEN   3392
#define XCD_BAR_WORDS 3456
#define XB_SPIN_CAP (1u << 18)
__device__ __forceinline__ unsigned xb_ld(unsigned* p)              { return __hip_atomic_load(p, __ATOMIC_RELAXED, __HIP_MEMORY_SCOPE_AGENT); }
__device__ __forceinline__ unsigned xb_add(unsigned* p, unsigned v) { return __hip_atomic_fetch_add(p, v, __ATOMIC_RELAXED, __HIP_MEMORY_SCOPE_AGENT); }
__device__ __forceinline__ unsigned xb_xcc_id() { return (unsigned)__builtin_amdgcn_s_getreg((3 << 11) | 20) & 0xFu; }
#define XB_SPIN(cond, bar) do { unsigned _sp = 0; while (cond) { __builtin_amdgcn_s_sleep(1); \
    if ((++_sp & 255u) == 0u) { if (xb_ld(&(bar)[XB_TMO])) break; if (_sp > XB_SPIN_CAP) { atomicAdd(&(bar)[XB_TMO], 1u); break; } } } } while (0)
struct XcdBarrier { unsigned* bar; unsigned x; volatile LAS unsigned* st; };
__device__ __forceinline__ XcdBarrier xcd_barrier_post(unsigned* bar, volatile LAS unsigned* st) {
    XcdBarrier b; b.bar = bar; b.x = xb_xcc_id(); b.st = st;
    if (threadIdx.x == 0) (void)xb_add(&bar[XB_XCNT(b.x)], 1u);
    return b;
}
__device__ __forceinline__ void xcd_barrier_complete(unsigned* bar, unsigned x, unsigned& nloc, unsigned& nx) {
    const unsigned G = gridDim.x * gridDim.y * gridDim.z;
    unsigned sum, cnt, mine, sp = 0u;
    for (;;) {
        sum = 0u; cnt = 0u; mine = 0u;
#pragma unroll
        for (unsigned j = 0; j < 16; ++j) { const unsigned c = xb_ld(&bar[XB_XCNT(j)]); sum += c; cnt += (c > 0u) ? 1u : 0u; mine = (j == x) ? c : mine; }
        if (sum == G) break;
        __builtin_amdgcn_s_sleep(1);
        if ((++sp & 255u) == 0u) { if (xb_ld(&bar[XB_TMO])) break; if (sp > XB_SPIN_CAP) { atomicAdd(&bar[XB_TMO], 1u); break; } }
    }
    nloc = mine > 0u ? mine : 1u; nx = cnt > 0u ? cnt : 1u;
}
__device__ __forceinline__ void xcd_barrier(const XcdBarrier& b) {
    asm volatile("s_waitcnt vmcnt(0)" ::: "memory");
    __syncthreads();
    if (threadIdx.x == 0) {
        unsigned* bar = b.bar;
        __builtin_amdgcn_s_waitcnt(0);
        unsigned nloc = b.st[0], nx = b.st[1];
        if (nloc == 0u) { xcd_barrier_complete(bar, b.x, nloc, nx); b.st[0] = nloc; b.st[1] = nx; }
        const unsigned old = xb_add(&bar[XB_XSUB(b.x)], 1u);
        const unsigned gen = old / nloc;
        asm volatile("buffer_inv sc1" ::: "memory");
        if (old + 1u == (gen + 1u) * nloc) {
#pragma unroll
            for (unsigned j = 0; j < 16; ++j) __hip_atomic_fetch_add(&bar[XB_XGEN(j)], 1u, __ATOMIC_RELAXED, __HIP_MEMORY_SCOPE_AGENT);
        }
        { const unsigned tgt = nx * (gen + 1u);
          XB_SPIN(xb_ld(&bar[XB_XGEN(b.x)]) < tgt, bar); }
        asm volatile("s_waitcnt vmcnt(0)" ::: "memory");
    }
    __syncthreads();
}

#define XB_GRP(g)   (4096 + 16 * (g))
__device__ __forceinline__ void grp_barrier_tgt(unsigned* bar, unsigned g, unsigned tgt) {
    asm volatile("s_waitcnt vmcnt(0)" ::: "memory");
    __syncthreads();
    if (threadIdx.x == 0) {
        unsigned* word = &bar[XB_GRP(g)];
        (void)xb_add(word, 1u);
        asm volatile("buffer_inv sc1" ::: "memory");
        XB_SPIN(xb_ld(word) < tgt, bar);
        asm volatile("s_waitcnt vmcnt(0)" ::: "memory");
    }
    __syncthreads();
}

struct Row16 { f32x4 v[4]; };
__device__ __forceinline__ int row_q(int lane, int j) { return 2 * lane + 128 * (j >> 1) + (j & 1); }
__device__ __forceinline__ void row_load_f32(Row16& r, const float* p, int lane) {
#pragma unroll
    for (int j = 0; j < 4; ++j) r.v[j] = ((const f32x4*)p)[row_q(lane, j)];
}
struct RowRaw { u32x4 w[2]; };
__device__ __forceinline__ void row_raw_load(RowRaw& r, const bf16_t* p, int lane) { r.w[0] = ((const u32x4*)p)[lane]; r.w[1] = ((const u32x4*)p)[lane + 64]; }
__device__ __forceinline__ void row_from_raw(Row16& r, const RowRaw& q) {
#pragma unroll
    for (int b = 0; b < 2; ++b) { const u32x4 w = q.w[b]; r.v[2 * b] = (f32x4){bflo(w.x), bfhi(w.x), bflo(w.y), bfhi(w.y)}; r.v[2 * b + 1] = (f32x4){bflo(w.z), bfhi(w.z), bflo(w.w), bfhi(w.w)}; }
}
__device__ __forceinline__ void row_load_bf16(Row16& r, const bf16_t* p, int lane) { RowRaw q; row_raw_load(q, p, lane); row_from_raw(r, q); }
__device__ __forceinline__ void row_store_f32(const Row16& r, float* p, int lane) {
    const int k = lane & 31; const bool hi = lane >= 32;
#pragma unroll
    for (int b = 0; b < 2; ++b) { u32x4 pa, pb;
#pragma unroll
        for (int e = 0; e < 4; ++e) { auto sw = __builtin_amdgcn_permlane32_swap(__float_as_uint(r.v[2 * b][e]), __float_as_uint(r.v[2 * b + 1][e]), false, false); pa[e] = sw[0]; pb[e] = sw[1]; }
        f32x4* q = (f32x4*)p + 128 * b + 2 * k + (hi ? 1 : 0);
        pg8::store16_wt(q, pa); pg8::store16_wt(q + 64, pb); }
}
__device__ __forceinline__ void row_store_bf16(const Row16& r, bf16_t* p, int lane) {
#pragma unroll
    for (int b = 0; b < 2; ++b) { u32x4 w; w.x = cvtpk(r.v[2 * b][0], r.v[2 * b][1]); w.y = cvtpk(r.v[2 * b][2], r.v[2 * b][3]); w.z = cvtpk(r.v[2 * b + 1][0], r.v[2 * b + 1][1]); w.w = cvtpk(r.v[2 * b + 1][2], r.v[2 * b + 1][3]);
        pg8::store16_wt((u32x4*)p + lane + 64 * b, w); }
}
__device__ __forceinline__ void vec_load(Row16& r, const float* g, int lane) { row_load_f32(r, g, lane); }
__device__ __forceinline__ void row_rmsnorm_v(Row16& r, const Row16& g) {
    float s = 0.f;
#pragma unroll
    for (int j = 0; j < 4; ++j) s += r.v[j][0] * r.v[j][0] + r.v[j][1] * r.v[j][1] + r.v[j][2] * r.v[j][2] + r.v[j][3] * r.v[j][3];
    const float rs = rsqrtf(wave_sum(s) * (1.f / D) + NORM_EPS);
#pragma unroll
    for (int j = 0; j < 4; ++j) r.v[j] = r.v[j] * rs * g.v[j];
}
__device__ __forceinline__ void row_rmsnorm(Row16& r, const float* g, int lane) { Row16 gg; vec_load(gg, g, lane); row_rmsnorm_v(r, gg); }

constexpr int TR_SCR_BYTES = 64 * 65 * 4;
template <class ScaleFn>
__device__ __forceinline__ void transpose_item(const float* W, int ldw, int N, bf16_t* WT, int ldt, int row_off, int koff, LAS float* scr, int item, int lane, ScaleFn sc) {
    const int nblk = N / 64, kb = item / nblk, nb = item % nblk, k0 = 64 * kb, n0 = 64 * nb;
    const int lk = lane >> 4, ln4 = (lane & 15) * 4;
    f32x4 v[16];
#pragma unroll
    for (int i = 0; i < 16; ++i) v[i] = *(const f32x4*)(W + (size_t)(k0 + 4 * i + lk) * ldw + n0 + ln4);
#pragma unroll
    for (int i = 0; i < 16; ++i) { const int kk = 4 * i + lk; const float s = sc(k0 + kk); LAS float* d = scr + kk * 65 + ln4; d[0] = v[i][0] * s; d[1] = v[i][1] * s; d[2] = v[i][2] * s; d[3] = v[i][3] * s; }
    asm volatile("s_waitcnt lgkmcnt(0)" ::: "memory");
    const int c = lane >> 3, nn = lane & 7;
#pragma unroll
    for (int j = 0; j < 8; ++j) { const int n = nn + 8 * j; const LAS float* s = scr + (8 * c) * 65 + n;
        u32x4 o; o.x = cvtpk(s[0 * 65], s[1 * 65]); o.y = cvtpk(s[2 * 65], s[3 * 65]); o.z = cvtpk(s[4 * 65], s[5 * 65]); o.w = cvtpk(s[6 * 65], s[7 * 65]);
        pg8::store16_wt(WT + (size_t)(row_off + n0 + n) * ldt + koff + k0 + 8 * c, o); }
    asm volatile("s_waitcnt lgkmcnt(0)" ::: "memory");
}
struct ScaleOne { __device__ __forceinline__ float operator()(int) const { return 1.f; } };
struct ScaleVec { const float* g; __device__ __forceinline__ float operator()(int k) const { return g[k]; } };
struct ScaleMix { const float* mp; const float* mn; int part;
    __device__ __forceinline__ float operator()(int k) const { return part == 0 ? 1.f - mp[k] - mn[k] : (part == 1 ? mp[k] : mn[k]); } };

struct Args { const float* in[27]; float* out; unsigned char* ws; };

struct ProbPlain { const bf16_t* A; const bf16_t* Bt; int K;
    __device__ __forceinline__ const char* a_tile(const pg8::Unit& u) const { return (const char*)(A + (size_t)u.pm * 256 * K); }
    __device__ __forceinline__ const char* b_tile(const pg8::Unit& u) const { return (const char*)(Bt + (size_t)u.pn * 256 * K); } };
struct DstPlain { bf16_t* C; int ldc;
    __device__ __forceinline__ void operator()(const pg8::Unit& u, bf16_t*& base, int& ld) const { base = C + (size_t)u.pm * 256 * ldc + (size_t)u.pn * 256; ld = ldc; } };
struct ProbRKL { const unsigned char* ws; int K; int pn0;
    __device__ __forceinline__ const char* a_tile(const pg8::Unit& u) const { const int pn = u.pn + pn0; const int g = pn < 4 ? 0 : (pn < 8 ? 1 : 2); const int ga = g == 2 ? 0 : g + 1;
        return (const char*)(ws + WS_XN + (size_t)ga * (32 * MiB) + (size_t)u.pm * 256 * D * 2); }
    __device__ __forceinline__ const char* b_tile(const pg8::Unit& u) const { const int pn = u.pn + pn0; const int g = pn < 4 ? 0 : (pn < 8 ? 1 : 2); const int t = pn - 4 * g;
        return (const char*)(ws + WS_WR_T + (size_t)g * (2 * MiB) + (size_t)t * 256 * D * 2); } };
struct DstRKL { unsigned char* ws; int pn0;
    __device__ __forceinline__ void operator()(const pg8::Unit& u, bf16_t*& base, int& ld) const { const int pn = u.pn + pn0;
        const int g = pn < 4 ? 0 : (pn < 8 ? 1 : 2); const int t = pn - 4 * g; ld = g == 2 ? NLD : D;
        base = (bf16_t*)(ws + WS_R + (size_t)g * (32 * MiB)) + (size_t)u.pm * 256 * ld + (size_t)t * 256; } };
struct ProbVR { const bf16_t* mixv; const bf16_t* mixa; const bf16_t* wv; const bf16_t* wr; int K;
    __device__ __forceinline__ const char* a_tile(const pg8::Unit& u) const { return (const char*)((u.pn < 4 ? mixv : mixa) + (size_t)u.pm * 256 * K); }
    __device__ __forceinline__ const char* b_tile(const pg8::Unit& u) const { return (const char*)(u.pn < 4 ? wv + (size_t)u.pn * 256 * K : wr + (size_t)(u.pn - 4) * 256 * K); } };
struct DstVR { bf16_t* V; bf16_t* R;
    __device__ __forceinline__ void operator()(const pg8::Unit& u, bf16_t*& base, int& ld) const { ld = D;
        base = (u.pn < 4 ? V + (size_t)u.pn * 256 : R + (size_t)(u.pn - 4) * 256) + (size_t)u.pm * 256 * D; } };


struct EpiHeadMajor {
    static constexpr bool PERM = true;
    bf16_t* O;
    __device__ __forceinline__ void operator()(const f32x4 (&acc)[2][2][4][2], const pg8::Unit& u, int wr, int wc, int fr, int fq) const {
        bf16_t* tile = O + ((size_t)(u.pn * 4 + wc) * M + (size_t)u.pm * 256) * 64;
#pragma unroll
        for (int ai = 0; ai < 2; ++ai)
#pragma unroll
            for (int m = 0; m < 4; ++m) { u32x4 w[2];
#pragma unroll
                for (int bj = 0; bj < 2; ++bj) { const f32x4 v0 = acc[ai][bj][m][0], v1 = acc[ai][bj][m][1];
                    w[bj].x = cvtpk(v0[0], v0[1]); w[bj].y = cvtpk(v0[2], v0[3]); w[bj].z = cvtpk(v1[0], v1[1]); w[bj].w = cvtpk(v1[2], v1[3]); }
                pg8::store_rows16_full(tile, 64, wr * 64 + ai * 128 + m * 16, 0, fr, fq, w[0], w[1]); }
    }
};

__device__ __forceinline__ void store_rows16_full_f32(float* tile, int ldc, int R0, int cb, int fr, int fq, f32x4 v0, f32x4 v1) {
    u32x4 a, b;
#pragma unroll
    for (int e = 0; e < 4; ++e) { auto s1 = __builtin_amdgcn_permlane16_swap(__float_as_uint(v0[e]), __float_as_uint(v1[e]), false, false);
        auto s2 = __builtin_amdgcn_permlane32_swap(s1[0], s1[1], false, false); a[e] = s2[0]; b[e] = s2[1]; }
    const bool lo = fr < 8;
    u32x4 x, y, pa, pb;
#pragma unroll
    for (int e = 0; e < 4; ++e) { x[e] = lo ? b[e] : a[e]; y[e] = (unsigned)__builtin_amdgcn_update_dpp(0, (int)x[e], 0x128, 0xF, 0xF, true); }
#pragma unroll
    for (int e = 0; e < 4; ++e) { pa[e] = lo ? a[e] : y[e]; pb[e] = lo ? y[e] : b[e]; }
    float* q = tile + (size_t)(R0 + (fr & 7)) * ldc + cb + (lo ? 0 : 16) + 4 * fq;
    pg8::store16_wt(q, pa); pg8::store16_wt(q + (size_t)8 * ldc, pb);
}
__device__ __forceinline__ float epi_rows_sum(float x) {
    auto a = __builtin_amdgcn_permlane16_swap(__float_as_uint(x), __float_as_uint(x), false, false); x = __uint_as_float(a[0]) + __uint_as_float(a[1]);
    auto b = __builtin_amdgcn_permlane32_swap(__float_as_uint(x), __float_as_uint(x), false, false); return __uint_as_float(b[0]) + __uint_as_float(b[1]); }
constexpr int N_XREG = 6; constexpr size_t XREG_BYTES = 256 * 1024;
__host__ __device__ constexpr size_t ws_xreg(int r) { return r < 3 ? (size_t)(256 + 256 * r) * 1024 : (size_t)30 * 1024 * 1024 + (size_t)(r - 3) * XREG_BYTES; }
__device__ __forceinline__ float xreg_ld(const float* p) { return __hip_atomic_load(p, __ATOMIC_RELAXED, __HIP_MEMORY_SCOPE_AGENT); }
template <bool RESID_F32, bool WITH_RS, bool OUT_F32 = false>
struct EpiResNorm {
    static constexpr bool PERM = true;
    const void* resid; void* hout; const float* g; float* rs_out; unsigned char* ws; unsigned* bar; LAS unsigned char* lds; int reg;
    __device__ __forceinline__ void operator()(const f32x4 (&acc)[2][2][4][2], const pg8::Unit& u, int wr, int wc, int fr_in, int fq_in) const {
        int fr = fr_in, fq = fq_in; asm volatile("" : "+v"(fr), "+v"(fq));
        LAS float* lp = (LAS float*)(lds + RING_BYTES);
        float* part = (float*)(ws + ws_xreg(reg)); float* part2 = (float*)(ws + ws_xreg(reg + 1));
        const int tid = (wr * 4 + wc) * 64 + fq * 16 + fr;
        const int col0 = wc * 64 + 8 * fq;
        f32x4 gv[2][2];
#pragma unroll
        for (int bj = 0; bj < 2; ++bj)
#pragma unroll
            for (int n = 0; n < 2; ++n) gv[bj][n] = *(const f32x4*)(g + u.pn * 256 + col0 + 32 * bj + 4 * n);
#pragma unroll
        for (int ai = 0; ai < 2; ++ai)
#pragma unroll
            for (int m = 0; m < 4; ++m) { float sq = 0.f;
#pragma unroll
                for (int bj = 0; bj < 2; ++bj)
#pragma unroll
                    for (int n = 0; n < 2; ++n)
#pragma unroll
                        for (int e = 0; e < 4; ++e) sq += acc[ai][bj][m][n][e] * acc[ai][bj][m][n][e];
                sq = epi_rows_sum(sq);
                if (fq == 0) lp[wc * 256 + wr * 64 + ai * 128 + m * 16 + fr] = sq; }
        const size_t toff = (size_t)u.pm * 256 * D + (size_t)u.pn * 256;
        u32x4 pq[4][2]; f32x4 pf[2][2][2];
        if (RESID_F32) {
#pragma unroll
            for (int m = 0; m < 2; ++m)
#pragma unroll
                for (int bj = 0; bj < 2; ++bj) { const float* rp = (const float*)resid + toff + (size_t)(wr * 64 + m * 16 + fr) * D + col0 + 32 * bj; pf[m][bj][0] = *(const f32x4*)rp; pf[m][bj][1] = *(const f32x4*)(rp + 4); }
        } else {
#pragma unroll
            for (int m = 0; m < 4; ++m)
#pragma unroll
                for (int bj = 0; bj < 2; ++bj) pq[m][bj] = *(const u32x4*)((const bf16_t*)resid + toff + (size_t)(wr * 64 + m * 16 + fr) * D + col0 + 32 * bj);
        }
        __syncthreads();
        if (tid < 256) { const float t = (lp[tid] + lp[256 + tid]) + (lp[512 + tid] + lp[768 + tid]);
            __hip_atomic_store(part + ((size_t)u.pm * 4 + u.pn) * 256 + tid, t, __ATOMIC_RELAXED, __HIP_MEMORY_SCOPE_AGENT); }
        if (tid < 256) { const float* pp = part + (size_t)u.pm * 1024 + tid; float p0, p1, p2, p3;
            XB_SPIN(((p0 = xreg_ld(pp)) < 0.f) | ((p1 = xreg_ld(pp + 256)) < 0.f) | ((p2 = xreg_ld(pp + 512)) < 0.f) | ((p3 = xreg_ld(pp + 768)) < 0.f), bar);
            lp[1024 + tid] = rsqrtf(((p0 + p1) + (p2 + p3)) * (1.f / D) + NORM_EPS); }
        __syncthreads();
        bf16_t* ot = (bf16_t*)hout + toff;
        float sq2[2][4];
#pragma unroll
        for (int ai = 0; ai < 2; ++ai)
#pragma unroll
            for (int m = 0; m < 4; ++m) { const int R0 = wr * 64 + ai * 128 + m * 16; const float r = lp[1024 + R0 + fr]; u32x4 w[2]; float s2 = 0.f;
#pragma unroll
                for (int bj = 0; bj < 2; ++bj) {
                    f32x4 v0 = acc[ai][bj][m][0] * r * gv[bj][0], v1 = acc[ai][bj][m][1] * r * gv[bj][1];
                    if (RESID_F32) { const float* rp = (const float*)resid + toff + (size_t)(R0 + fr) * D + col0 + 32 * bj;
                        if (ai == 0 && m < 2) { v0 = v0 + pf[m & 1][bj][0]; v1 = v1 + pf[m & 1][bj][1]; } else { v0 = v0 + *(const f32x4*)rp; v1 = v1 + *(const f32x4*)(rp + 4); } }
                    else { const u32x4 q = (ai == 0) ? pq[m][bj] : *(const u32x4*)((const bf16_t*)resid + toff + (size_t)(R0 + fr) * D + col0 + 32 * bj);
                        v0[0] += bflo(q.x); v0[1] += bfhi(q.x); v0[2] += bflo(q.y); v0[3] += bfhi(q.y); v1[0] += bflo(q.z); v1[1] += bfhi(q.z); v1[2] += bflo(q.w); v1[3] += bfhi(q.w); }
                    if (WITH_RS) {
#pragma unroll
                        for (int e = 0; e < 4; ++e) s2 += v0[e] * v0[e] + v1[e] * v1[e]; }
                    if (OUT_F32) store_rows16_full_f32((float*)hout + toff, D, R0, wc * 64 + 32 * bj, fr, fq, v0, v1);
                    else { w[bj].x = pg8::cvt_pk_bf16(v0[0], v0[1]); w[bj].y = pg8::cvt_pk_bf16(v0[2], v0[3]); w[bj].z = pg8::cvt_pk_bf16(v1[0], v1[1]); w[bj].w = pg8::cvt_pk_bf16(v1[2], v1[3]); } }
                sq2[ai][m] = s2;
                if (!OUT_F32) pg8::store_rows16_full(ot, D, R0, wc, fr, fq, w[0], w[1]);
                if (RESID_F32 && (m & 1) == 1) __builtin_amdgcn_sched_barrier(0); }
        if (WITH_RS) {
#pragma unroll
            for (int ai = 0; ai < 2; ++ai)
#pragma unroll
                for (int m = 0; m < 4; ++m) { float sq = sq2[ai][m]; sq = epi_rows_sum(sq);
                    if (fq == 0) lp[wc * 256 + wr * 64 + ai * 128 + m * 16 + fr] = sq; }
            __syncthreads();
            if (tid < 256) { const float t = (lp[tid] + lp[256 + tid]) + (lp[512 + tid] + lp[768 + tid]);
                __hip_atomic_store(part2 + ((size_t)u.pm * 4 + u.pn) * 256 + tid, t, __ATOMIC_RELAXED, __HIP_MEMORY_SCOPE_AGENT); }
            if (u.pn == 0 && tid < 256) { const float* pp = part2 + (size_t)u.pm * 1024 + tid; float p0, p1, p2, p3;
                XB_SPIN(((p0 = xreg_ld(pp)) < 0.f) | ((p1 = xreg_ld(pp + 256)) < 0.f) | ((p2 = xreg_ld(pp + 512)) < 0.f) | ((p3 = xreg_ld(pp + 768)) < 0.f), bar);
                __hip_atomic_store(rs_out + u.pm * 256 + tid, rsqrtf(((p0 + p1) + (p2 + p3)) * (1.f / D) + NORM_EPS), __ATOMIC_RELAXED, __HIP_MEMORY_SCOPE_AGENT); }
        }
    }
};
template <int ACT, class Prob, class Dst>
__device__ __forceinline__ void run_gemm(LAS unsigned char* lds, const Prob& P, const Dst& Dd, int Mr, int Nv, int G) {
    pg8::StaticOrder S; S.init(Mr, Nv, G, (int)blockIdx.x);
    pg8::EpiBf16<ACT, Dst> E{Dd, nullptr};
    for (int rep = 0; rep < REP_GEMM; ++rep) pg8::gemm_phase<pg8::EpiBf16<ACT, Dst>, Prob, true, true>(lds, P, S, E);
}
template <int ACT, class Prob, class Dst>
__device__ __forceinline__ void run_gemm_rs(LAS unsigned char* lds, const Prob& P, const Dst& Dd, const float* rs, int Mr, int Nv, int G) {
    pg8::StaticOrder S; S.init(Mr, Nv, G, (int)blockIdx.x);
    pg8::EpiBf16<ACT, Dst, true> E{Dd, rs};
    pg8::gemm_phase<pg8::EpiBf16<ACT, Dst, true>, Prob, true, true>(lds, P, S, E);
}

template <bool BASE_F32, bool OUT_F32>
__device__ __forceinline__ void phase_resnorm(const void* base, const bf16_t* TMP, const float* g1, const float* g2, void* hout, bf16_t* XN, float* rs_out, int gw, int NGW, int lane) {
    Row16 G1, G2; vec_load(G1, g1, lane); if (XN) vec_load(G2, g2, lane);
    for (int row = gw; row < M; row += NGW) {
        Row16 t, b; row_load_bf16(t, TMP + (size_t)row * D, lane);
        if (BASE_F32) row_load_f32(b, (const float*)base + (size_t)row * D, lane); else row_load_bf16(b, (const bf16_t*)base + (size_t)row * D, lane);
        row_rmsnorm_v(t, G1);
#pragma unroll
        for (int j = 0; j < 4; ++j) b.v[j] = b.v[j] + t.v[j];
        if (OUT_F32) row_store_f32(b, (float*)hout + (size_t)row * D, lane); else row_store_bf16(b, (bf16_t*)hout + (size_t)row * D, lane);
        if (XN) { row_rmsnorm_v(b, G2); row_store_bf16(b, XN + (size_t)row * D, lane); }
        if (rs_out) {
            float s = 0.f;
#pragma unroll
            for (int j = 0; j < 4; ++j) s += b.v[j][0] * b.v[j][0] + b.v[j][1] * b.v[j][1] + b.v[j][2] * b.v[j][2] + b.v[j][3] * b.v[j][3];
            const float rsv = rsqrtf(wave_sum(s) * (1.f / D) + NORM_EPS);
            if (lane == 0) __hip_atomic_store(rs_out + row, rsv, __ATOMIC_RELAXED, __HIP_MEMORY_SCOPE_AGENT); }
    }
}
__device__ __forceinline__ void phase_lda(const bf16_t* LDO, bf16_t* LDA, int gw, int NGW, int lane) {
    const float A = lane < 16 ? 2.f : 1.f, C = lane < 16 ? -1.f : 0.f; const bool id = lane >= 16 && lane < 32;
    for (int row = gw; row < M; row += NGW) { const int tt = row & (SEQ - 1);
        const u32x4 p0 = *(const u32x4*)(LDO + (size_t)row * NLD + 8 * lane);
        const u32x4 p1 = *(const u32x4*)(LDO + (size_t)(tt > 0 ? row - 1 : row) * NLD + 512 + 8 * lane), p2 = *(const u32x4*)(LDO + (size_t)(tt < SEQ - 1 ? row + 1 : row) * NLD + 1024 + 8 * lane);
        const float mp = tt > 0 ? 1.f : 0.f, mn = tt < SEQ - 1 ? 1.f : 0.f;
        u32x4 o;
#pragma unroll
        for (int w = 0; w < 4; ++w) { const float x0 = bflo(p0[w]) + mp * bflo(p1[w]) + mn * bflo(p2[w]), x1 = bfhi(p0[w]) + mp * bfhi(p1[w]) + mn * bfhi(p2[w]);
            const float y0 = A * __builtin_amdgcn_rcpf(1.f + __builtin_amdgcn_exp2f(-1.4426950408889634f * A * x0)) + C, y1 = A * __builtin_amdgcn_rcpf(1.f + __builtin_amdgcn_exp2f(-1.4426950408889634f * A * x1)) + C;
            o[w] = cvtpk(id ? x0 : y0, id ? x1 : y1); }
        pg8::store16_wt(LDA + (size_t)row * 512 + 8 * lane, o); }
}
__device__ __forceinline__ void mix_out(const Row16& up, const Row16& u, const Row16& un, const LAS f32x4* a, const LAS f32x4* b, bf16_t* dst, int lane) {
    Row16 o;
#pragma unroll
    for (int j = 0; j < 4; ++j) { const f32x4 av = a[j * 64 + lane], bv = b[j * 64 + lane]; o.v[j] = u.v[j] + (up.v[j] - u.v[j]) * av + (un.v[j] - u.v[j]) * bv; }
    row_store_bf16(o, dst, lane);
}
__device__ __forceinline__ void phase_mix3(LAS unsigned char* lds, const bf16_t* h, const float* g, const float* mup, const float* mun, bf16_t* XN, bf16_t* MR, bf16_t* MK, bf16_t* MV, int gw, int NGW, int tid, int lane) {
    LAS f32x4* mv = (LAS f32x4*)lds;
    __syncthreads();
    for (int x = tid; x < 6 * 256; x += NTHREADS) { const int vec = x >> 8, q = x & 255, c = vec < 2 ? 0 : (vec < 4 ? 2 : 3);
        const f32x4 val = ((const f32x4*)(((vec & 1) ? mun : mup) + c * D))[q];
        mv[vec * 256 + (2 * (q >> 7) + (q & 1)) * 64 + ((q & 127) >> 1)] = val; }
    __syncthreads();
    Row16 Gn; vec_load(Gn, g, lane);
    for (int ch = gw; ch < M / 8; ch += NGW) {
        const int r0 = ch * 8, t0 = r0 & (SEQ - 1);
        const bool hasp = t0 > 0, hasn = t0 + 8 < SEQ;
        const int rlast = hasn ? r0 + 8 : r0 + 7;
        RowRaw r0w, rA, rB, rC;
        row_raw_load(r0w, h + (size_t)(hasp ? r0 - 1 : r0) * D, lane);
        row_raw_load(rA, h + (size_t)r0 * D, lane); row_raw_load(rB, h + (size_t)(r0 + 1) * D, lane); row_raw_load(rC, h + (size_t)(r0 + 2) * D, lane);
        Row16 up, u, un;
        row_from_raw(up, r0w); row_rmsnorm_v(up, Gn);
        { const float m = hasp ? 1.f : 0.f;
#pragma unroll
          for (int j = 0; j < 4; ++j) up.v[j] = up.v[j] * m; }
        row_from_raw(u, rA); row_rmsnorm_v(u, Gn);
        rA = rB; rB = rC;
#pragma unroll 1
        for (int k = 1; k <= 8; ++k) {
            const int row = r0 - 1 + k;
            { const int nx = row + 3; row_raw_load(rC, h + (size_t)(nx < rlast ? nx : rlast) * D, lane); }
            row_from_raw(un, rA); row_rmsnorm_v(un, Gn);
            { const float m = (k == 8 && !hasn) ? 0.f : 1.f;
#pragma unroll
              for (int j = 0; j < 4; ++j) un.v[j] = un.v[j] * m; }
            row_store_bf16(u, XN + (size_t)row * D, lane);
            mix_out(up, u, un, mv, mv + 256, MR + (size_t)row * D, lane);
            mix_out(up, u, un, mv + 512, mv + 768, MK + (size_t)row * D, lane);
            mix_out(up, u, un, mv + 1024, mv + 1280, MV + (size_t)row * D, lane);
            up = u; u = un; rA = rB; rB = rC;
        }
    }
}

constexpr int ATT_ROWS = 400, ATT_KS = 0, ATT_VS = ATT_ROWS * 128, ATT_TAB = 2 * ATT_ROWS * 128, ATT_TABN = 320;
constexpr float LOG2E = 1.4426950408889634f;
typedef short v4i16_t __attribute__((ext_vector_type(4)));
__device__ __forceinline__ v4i16_t lds_tr16(LAS const unsigned char* p) { return __builtin_amdgcn_ds_read_tr16_b64_v4i16((LAS v4i16_t*)p); }

__device__ __forceinline__ float fmax_q(float a, float b) { return __builtin_amdgcn_fmed3f(a, b, __builtin_inff()); }
__device__ __forceinline__ float rows_max(float x) {
    auto a = __builtin_amdgcn_permlane16_swap(__float_as_uint(x), __float_as_uint(x), false, false); x = fmax_q(__uint_as_float(a[0]), __uint_as_float(a[1]));
    auto b = __builtin_amdgcn_permlane32_swap(__float_as_uint(x), __float_as_uint(x), false, false); return fmax_q(__uint_as_float(b[0]), __uint_as_float(b[1])); }
__device__ __forceinline__ float rows_sum(float x) {
    auto a = __builtin_amdgcn_permlane16_swap(__float_as_uint(x), __float_as_uint(x), false, false); x = __uint_as_float(a[0]) + __uint_as_float(a[1]);
    auto b = __builtin_amdgcn_permlane32_swap(__float_as_uint(x), __float_as_uint(x), false, false); return __uint_as_float(b[0]) + __uint_as_float(b[1]); }
struct AttnIO { const bf16_t* QKV; const float* rel_table; const float* sink; bf16_t* O; bf16_t* OBR; float* LSE; };
struct AttnUnitD { int b, dil, res, l0, nq, L, R, colK, colV, head0, ngroups, nit, branch, isB; };
__device__ __forceinline__ AttnUnitD attn_decode(int u) {
    AttnUnitD A;
    if (u < 256) { A.isB = 1; A.b = u >> 5; const int kvg = (u >> 4) & 1, blk = u & 15; A.dil = 1; A.res = 0; A.l0 = blk * 128; A.nq = 128; A.L = SEQ; A.R = 128; A.colK = 32 + kvg; A.colV = 34 + kvg; A.head0 = kvg * 4; A.ngroups = 32; A.nit = 9; A.branch = 0; }
    else if (u < 1280) { A.isB = 0; const int a = u - 256, bh = a >> 4, k = a & 15; A.b = bh >> 3; A.head0 = bh & 7; A.nq = 256; A.R = 64; A.ngroups = 16; A.nit = 5;
        if (k < 8) { A.dil = 1; A.res = 0; A.l0 = k * 256; A.L = SEQ; A.branch = 0; } else { A.dil = 4; A.res = (k - 8) >> 1; A.l0 = ((k - 8) & 1) * 256; A.L = SEQ / 4; A.branch = 1; }
        A.colK = 8 + A.head0; A.colV = 16 + A.head0; }
    else { A.isB = 0; const int a = u - 1280, bh = a >> 4; A.b = bh >> 3; A.head0 = bh & 7; A.dil = 16; A.res = a & 15; A.l0 = 0; A.nq = 128; A.L = SEQ / 16; A.R = 64; A.ngroups = 8; A.nit = 5; A.branch = 2; A.colK = 8 + A.head0; A.colV = 16 + A.head0; }
    return A;
}
constexpr int ATT_NST = 7;
__device__ __forceinline__ void attn_issue(const AttnUnitD& A, const bf16_t* QKV, int tid, u32x4 (&kr)[ATT_NST], u32x4 (&vr)[ATT_NST]) {
    const int ndata = A.nq + 2 * A.R, rv0 = (A.R - A.l0) > 0 ? (A.R - A.l0) : 0, rv1 = (A.L + A.R - A.l0) < ndata ? (A.L + A.R - A.l0) : ndata;
    const bf16_t* kb = QKV + ((size_t)A.colK * M + (size_t)A.b * SEQ) * 64; const bf16_t* vb = QKV + ((size_t)A.colV * M + (size_t)A.b * SEQ) * 64;
#pragma unroll
    for (int i = 0; i < ATT_NST; ++i) { const int x = tid + NTHREADS * i, c = x & 7; int row = x >> 3; row = row < rv0 ? rv0 : (row >= rv1 ? rv1 - 1 : row);
        const size_t o = (size_t)(A.res + A.dil * (A.l0 - A.R + row)) * 64 + c * 8; kr[i] = *(const u32x4*)(kb + o); vr[i] = *(const u32x4*)(vb + o); }
}

__device__ __forceinline__ void phase_attn(LAS unsigned char* lds, const AttnIO& io, int vcu, int G) {
    int tid = threadIdx.x; asm volatile("" : "+v"(tid));
    const int lane = tid & 63, wid = __builtin_amdgcn_readfirstlane(tid >> 6), g4 = lane >> 4, qi = lane & 15;
    LAS unsigned char* Ks = lds + ATT_KS; LAS unsigned char* Vs = lds + ATT_VS; LAS float* tab = (LAS float*)(lds + ATT_TAB);
    constexpr int NU = 256 + 1024 + 1024;
    u32x4 kr[ATT_NST], vr[ATT_NST];
    if (vcu < NU) { const AttnUnitD A0 = attn_decode(vcu); attn_issue(A0, io.QKV, tid, kr, vr); }
    for (int u = vcu; u < NU; u += G) {
        const AttnUnitD A = attn_decode(u);
        const int b = A.b, dil = A.dil, res = A.res, l0 = A.l0, R = A.R, head0 = A.head0, ngroups = A.ngroups, nit = A.nit, branch = A.branch; const bool isB = A.isB != 0;
        const int ndata = A.nq + 2 * R, rv0 = (R - l0) > 0 ? (R - l0) : 0, rv1 = (A.L + R - l0) < ndata ? (A.L + R - l0) : ndata;
        auto qptr = [&](int gx) -> const bf16_t* { const int hq_ = isB ? (gx >> 3) : 0, gi_ = isB ? (gx & 7) : gx; const int posq_ = res + dil * (l0 + 16 * gi_ + qi);
            return io.QKV + ((size_t)((isB ? 24 : 0) + head0 + hq_) * M + (size_t)b * SEQ + posq_) * 64 + 8 * g4; };
        u32x4 qr0, qr1; { const bf16_t* qp0 = qptr(wid); qr0 = *(const u32x4*)qp0; qr1 = *(const u32x4*)(qp0 + 32); }
        for (int reps = 0; reps < REP_ATTS; ++reps) {
        __syncthreads();
#pragma unroll
        for (int i = 0; i < ATT_NST; ++i) { const int x = tid + NTHREADS * i, row = x >> 3, c = x & 7;
            if (x < ATT_ROWS * 8) { const int off = row * 128 + ((c ^ (row & 7)) << 4); const bool ok = row >= rv0 && row < rv1; const u32x4 z = (u32x4){0u, 0u, 0u, 0u};
                *(LAS u32x4*)(Ks + off) = ok ? kr[i] : z; *(LAS u32x4*)(Vs + off) = ok ? vr[i] : z; } }
        { const int ntab = isB ? 4 : 1;
          for (int x = tid; x < ntab * ATT_TABN; x += NTHREADS) { const int t = x / ATT_TABN, j = x % ATT_TABN, idx = j - 16;
              float v = -1e30f;
              if (idx >= 0 && idx <= 2 * R) v = io.rel_table[t5_bucket((idx - R) * dil) * 16 + (isB ? 8 + head0 + t : head0)] * LOG2E;
              tab[x] = v; } }
        }
        if (u + G < NU) { const AttnUnitD An = attn_decode(u + G); attn_issue(An, io.QKV, tid, kr, vr); }
        __syncthreads();
        u32x4 pend_a = {0u, 0u, 0u, 0u}, pend_b = pend_a; bf16_t* pend_op = nullptr; float* pend_lse = nullptr; float pend_lv = 0.f;
        auto flush = [&]() { if (pend_op) { bf16_t* q = pend_op + 16 * (g4 & 1) + 8 * (g4 >> 1);
                pg8::store16_wt(q, pend_a); pg8::store16_wt(q + 32, pend_b);
                if (pend_lse && g4 == 0) __hip_atomic_store(pend_lse, pend_lv, __ATOMIC_RELAXED, __HIP_MEMORY_SCOPE_AGENT); } };
        for (int rep = 0; rep < REP_ATTC; ++rep)
        for (int gidx = wid; gidx < ngroups; gidx += NWAVES) {
            const int hq = isB ? (gidx >> 3) : 0, gi = isB ? (gidx & 7) : gidx, head = head0 + hq;
            const int ql = 16 * gi + qi, posq = res + dil * (l0 + ql);
            const LAS float* tb = tab + hq * ATT_TABN + 16;
            bf16x8 qf[2];
            { const u32x4 wq[2] = {qr0, qr1}; const float SC = 0.125f * LOG2E;
#pragma unroll
              for (int ks = 0; ks < 2; ++ks) { const u32x4 w = wq[ks]; u32x4 o;
                  o.x = cvtpk(bflo(w.x) * SC, bfhi(w.x) * SC); o.y = cvtpk(bflo(w.y) * SC, bfhi(w.y) * SC); o.z = cvtpk(bflo(w.z) * SC, bfhi(w.z) * SC); o.w = cvtpk(bflo(w.w) * SC, bfhi(w.w) * SC);
                  qf[ks] = __builtin_bit_cast(bf16x8, o); }
              asm volatile("" : "+v"(qf[0]), "+v"(qf[1]));
              { const int gn = gidx + NWAVES < ngroups ? gidx + NWAVES : gidx; const bf16_t* qpn = qptr(gn); qr0 = *(const u32x4*)qpn; qr1 = *(const u32x4*)(qpn + 32); } }
            flush();
            f32x4 ot[4], lacc = (f32x4){0.f, 0.f, 0.f, 0.f};
#pragma unroll
            for (int dt = 0; dt < 4; ++dt) ot[dt] = (f32x4){0.f, 0.f, 0.f, 0.f};
            float m = -1e20f;
            const bf16x8 ones = __builtin_bit_cast(bf16x8, qi == 0 ? (u32x4){0x3F803F80u, 0x3F803F80u, 0x3F803F80u, 0x3F803F80u} : (u32x4){0u, 0u, 0u, 0u});
            bf16x8 kf[2][2];
            const LAS unsigned char* kp[2];
            { const int r0 = 16 * gi + qi;
#pragma unroll
              for (int ks = 0; ks < 2; ++ks) { const int c = g4 + 4 * ks; kp[ks] = Ks + r0 * 128 + ((c ^ (r0 & 7)) << 4); asm volatile("" : "+v"(kp[ks]));
                  kf[ks][0] = *(const LAS bf16x8*)(kp[ks]); kf[ks][1] = *(const LAS bf16x8*)(kp[ks] + 16 * 128); } }
            const LAS unsigned char* vp[4];
            { const int ra0 = 16 * gi + 4 * g4 + (qi >> 2);
#pragma unroll
              for (int dt = 0; dt < 4; ++dt) { const int ch = dt * 2 + ((qi & 3) >> 1); vp[dt] = Vs + ra0 * 128 + ((ch ^ (ra0 & 7)) << 4) + 8 * (qi & 1); asm volatile("" : "+v"(vp[dt])); } }
            const LAS float* tbq = tb + 4 * g4 - qi; asm volatile("" : "+v"(tbq));
            f32x4 c0, c1;
#pragma unroll
            for (int r = 0; r < 4; ++r) { c0[r] = tbq[r]; c1[r] = tbq[16 + r]; }
            for (int it = 0; it < nit; ++it) {
                const int rb = 16 * gi + 32 * it;
                v4i16_t vlo[4], vhi[4];
#pragma unroll
                for (int dt = 0; dt < 4; ++dt) { vlo[dt] = lds_tr16(vp[dt]); vhi[dt] = lds_tr16(vp[dt] + 16 * 128); vp[dt] += 4096; }
                f32x4 s0 = c0, s1 = c1;
#pragma unroll
                for (int ks = 0; ks < 2; ++ks) { s0 = __builtin_amdgcn_mfma_f32_16x16x32_bf16(kf[ks][0], qf[ks], s0, 0, 0, 0); s1 = __builtin_amdgcn_mfma_f32_16x16x32_bf16(kf[ks][1], qf[ks], s1, 0, 0, 0); }
                if (it + 1 < nit) {
#pragma unroll
                    for (int ks = 0; ks < 2; ++ks) { kp[ks] += 4096; kf[ks][0] = *(const LAS bf16x8*)(kp[ks]); kf[ks][1] = *(const LAS bf16x8*)(kp[ks] + 16 * 128); } }
                tbq += 32;
#pragma unroll
                for (int r = 0; r < 4; ++r) { c0[r] = tbq[r]; c1[r] = tbq[16 + r]; }
                float v[8];
                if (rb < rv0 || rb + 32 > rv1) {
#pragma unroll
                    for (int r = 0; r < 4; ++r) { const int row0 = rb + 4 * g4 + r, row1 = row0 + 16;
                        const bool ok0 = (unsigned)(row0 - rv0) < (unsigned)(rv1 - rv0), ok1 = (unsigned)(row1 - rv0) < (unsigned)(rv1 - rv0);
                        v[r] = ok0 ? s0[r] : -1e30f; v[4 + r] = ok1 ? s1[r] : -1e30f; }
                } else {
#pragma unroll
                    for (int r = 0; r < 4; ++r) { v[r] = s0[r]; v[4 + r] = s1[r]; }
                }
                float d[8];
#pragma unroll
                for (int i = 0; i < 8; ++i) d[i] = v[i] - m;
                const float dm = fmaxf(fmaxf(fmaxf(d[0], d[1]), fmaxf(d[2], d[3])), fmaxf(fmaxf(d[4], d[5]), fmaxf(d[6], d[7])));
                if (__builtin_amdgcn_ballot_w64(dm > 8.f) != 0ull) {
                    float tmax = fmaxf(fmaxf(fmaxf(v[0], v[1]), fmaxf(v[2], v[3])), fmaxf(fmaxf(v[4], v[5]), fmaxf(v[6], v[7])));
                    tmax = rows_max(tmax);
                    const float mn = fmaxf(m, tmax), alpha = __builtin_amdgcn_exp2f(m - mn); m = mn;
                    lacc[0] = lacc[0] * alpha;
#pragma unroll
                    for (int dt = 0; dt < 4; ++dt) ot[dt] = ot[dt] * alpha;
#pragma unroll
                    for (int i = 0; i < 8; ++i) d[i] = v[i] - mn;
                }
#pragma unroll
                for (int i = 0; i < 8; ++i) v[i] = __builtin_amdgcn_exp2f(d[i]);
                u32x4 pw; pw.x = cvtpk(v[0], v[1]); pw.y = cvtpk(v[2], v[3]); pw.z = cvtpk(v[4], v[5]); pw.w = cvtpk(v[6], v[7]);
                const bf16x8 pf = __builtin_bit_cast(bf16x8, pw);
                lacc = __builtin_amdgcn_mfma_f32_16x16x32_bf16(ones, pf, lacc, 0, 0, 0);
#pragma unroll
                for (int dt = 0; dt < 4; ++dt) { const bf16x8 vf = (bf16x8){vlo[dt][0], vlo[dt][1], vlo[dt][2], vlo[dt][3], vhi[dt][0], vhi[dt][1], vhi[dt][2], vhi[dt][3]};
                    ot[dt] = __builtin_amdgcn_mfma_f32_16x16x32_bf16(vf, pf, ot[dt], 0, 0, 0); }
            }
            float lsum = lacc[0];
            lsum = rows_sum(lsum);
            const size_t tok = (size_t)b * SEQ + posq;
            float scale;
            if (isB) { const float s2 = io.sink[head] * LOG2E, mf = fmaxf(m, s2), e = __builtin_amdgcn_exp2f(m - mf); scale = e / (lsum * e + __builtin_amdgcn_exp2f(s2 - mf)); }
            else { scale = 1.f / lsum; pend_lv = m + __builtin_amdgcn_logf(lsum); }
            pend_lse = isB ? nullptr : io.LSE + ((size_t)branch * M + tok) * 8 + head;
            pend_op = isB ? io.O + tok * D + 512 + head * 64 : io.OBR + ((size_t)branch * M + tok) * 512 + head * 64;
            { unsigned pw[4][2];
#pragma unroll
              for (int dt = 0; dt < 4; ++dt) { const f32x4 o = ot[dt] * scale; pw[dt][0] = cvtpk(o[0], o[1]); pw[dt][1] = cvtpk(o[2], o[3]); }
#pragma unroll
              for (int e = 0; e < 2; ++e) { auto s01 = __builtin_amdgcn_permlane16_swap(pw[0][e], pw[1][e], false, false); auto s23 = __builtin_amdgcn_permlane16_swap(pw[2][e], pw[3][e], false, false);
                  pend_a[e] = s01[0]; pend_a[2 + e] = s01[1]; pend_b[e] = s23[0]; pend_b[2 + e] = s23[1]; } }
        }
        flush();
    }
}
__device__ __forceinline__ void phase_attn_merge(const AttnIO& io, int xfirst, int xend, int NGT) {
    for (int x = xfirst; x < xend; x += NGT) { const int tok = x >> 6, head = (x >> 3) & 7, c8 = x & 7;
        const float l0 = io.LSE[((size_t)0 * M + tok) * 8 + head], l1 = io.LSE[((size_t)1 * M + tok) * 8 + head], l2 = io.LSE[((size_t)2 * M + tok) * 8 + head];
        const float mx = fmaxf(l0, fmaxf(l1, l2)); float w0 = __builtin_amdgcn_exp2f(l0 - mx), w1 = __builtin_amdgcn_exp2f(l1 - mx), w2 = __builtin_amdgcn_exp2f(l2 - mx);
        const float inv = 1.f / (w0 + w1 + w2); w0 *= inv; w1 *= inv; w2 *= inv;
        const size_t o = (size_t)tok * 512 + head * 64 + c8 * 8;
        const u32x4 a = *(const u32x4*)(io.OBR + o), bq = *(const u32x4*)(io.OBR + (size_t)M * 512 + o), c = *(const u32x4*)(io.OBR + (size_t)2 * M * 512 + o);
        u32x4 r;
        r.x = pk2(w0 * bflo(a.x) + w1 * bflo(bq.x) + w2 * bflo(c.x), w0 * bfhi(a.x) + w1 * bfhi(bq.x) + w2 * bfhi(c.x));
        r.y = pk2(w0 * bflo(a.y) + w1 * bflo(bq.y) + w2 * bflo(c.y), w0 * bfhi(a.y) + w1 * bfhi(bq.y) + w2 * bfhi(c.y));
        r.z = pk2(w0 * bflo(a.z) + w1 * bflo(bq.z) + w2 * bflo(c.z), w0 * bfhi(a.z) + w1 * bfhi(bq.z) + w2 * bfhi(c.z));
        r.w = pk2(w0 * bflo(a.w) + w1 * bflo(bq.w) + w2 * bflo(c.w), w0 * bfhi(a.w) + w1 * bfhi(bq.w) + w2 * bfhi(c.w));
        pg8::store16_wt(io.O + (size_t)tok * D + head * 64 + c8 * 8, r); }
}

constexpr int NCH = SEQ / 16;
constexpr int SC_LROW = 68, SC_LDROW = 528, SC_LSLOT = 4 * 16 * SC_LROW * 4 + 16 * SC_LDROW;
constexpr int CT_KHT = 0, CT_RHT = 2048, CT_BTT = 4096, CT_KTT = 6144, CT_VT = 8192, CT_WEND = 10240, CT_RKT = CT_WEND + 256, CT_SLOT = CT_RKT + 2048;
constexpr int GT_AKK = 0, GT_BB = 512, GT_BK = 1024, GT_TT = 1536, GT_SLOT = 2048;
constexpr int SC_LBUF = 0, SC_CT = SC_LBUF + 2 * SC_LSLOT, SC_GG = SC_CT + 3 * CT_SLOT, SC_RKR = SC_GG + 4 * 4096, SC_GT = SC_RKR + 4 * 256, SC_NB = SC_GT + 2 * GT_SLOT, SC_OUT = SC_NB + 1024, SC_END = SC_OUT + 2 * 4096;
static_assert(SC_END <= LDSCTL_OFF, "scan LDS map");
template <int CTRL> __device__ __forceinline__ float dpp_f(float x) { return __int_as_float(__builtin_amdgcn_update_dpp(0, __float_as_int(x), CTRL, 0xf, 0xf, true)); }
__device__ __forceinline__ float sum8(float x) { x += dpp_f<0xB1>(x); x += dpp_f<0x4E>(x); x += dpp_f<0x141>(x); return x; }
__device__ __forceinline__ float sum16(float x) { x += dpp_f<0xB1>(x); x += dpp_f<0x4E>(x); x += dpp_f<0x141>(x); x += dpp_f<0x140>(x); return x; }
__device__ __forceinline__ float fast_sigmoid(float z) { return __builtin_amdgcn_rcpf(1.f + __builtin_amdgcn_exp2f(-LOG2E * z)); }
__device__ __forceinline__ bf16x8 mk8(unsigned a, unsigned b, unsigned c, unsigned d) { return __builtin_bit_cast(bf16x8, (u32x4){a, b, c, d}); }

struct ScanPtrs { const bf16_t *R, *Kk, *V, *LDA; bf16_t* Y; const float *w2, *a2, *g2, *w0, *a0, *k_k, *k_a, *r_k, *gn_w, *gn_b; };
__device__ __forceinline__ void phase_scan(LAS unsigned char* lds, const ScanPtrs& P, int G) {
    int tid = threadIdx.x; asm volatile("" : "+v"(tid));
    const int lane = tid & 63, wid = __builtin_amdgcn_readfirstlane(tid >> 6), g4 = lane >> 4, c16 = lane & 15;
    for (int unit = blockIdx.x; unit < 256; unit += G) {
        const int b = unit >> 5, h = (unit >> 1) & 15, d = unit & 1, hc = h * 64;
        unsigned long long wait_acc = 0ull;
        __syncthreads();
        if (wid < 4) {
            f32x4 ST[4];
#pragma unroll
            for (int mt = 0; mt < 4; ++mt) ST[mt] = (f32x4){0.f, 0.f, 0.f, 0.f};
            const int pch = hc + 8 * (lane & 7);
            const f32x4 gw0 = *(const f32x4*)(P.gn_w + pch), gw1 = *(const f32x4*)(P.gn_w + pch + 4), gb0 = *(const f32x4*)(P.gn_b + pch), gb1 = *(const f32x4*)(P.gn_b + pch + 4);
            u32x4 pvA = {0u, 0u, 0u, 0u}, pvB = pvA;
            auto issueV = [&](int ch_, u32x4& dst) { const int s = 8 * (wid - 1) + (lane >> 3), t = d ? (SEQ - 1 - (ch_ * 16 + s)) : (ch_ * 16 + s); dst = *(const u32x4*)(P.V + ((size_t)b * SEQ + t) * D + pch); };
            if (wid == 1 || wid == 2) { issueV(0, pvA); issueV(1, pvB); }
            auto sw_interval = [&](int i, u32x4& pvset) {
                const int c = i - 3;
                int ln = lane; asm volatile("" : "+v"(ln)); const int g4 = ln >> 4, c16 = ln & 15;
                if (c >= 0 && c < NCH) {
                    const LAS unsigned char* Ct = lds + SC_CT + (c % 3) * CT_SLOT; const LAS unsigned char* Gt = lds + SC_GT + (c & 1) * GT_SLOT;
                    v4i16_t kha[2][2], rha[2][2];
#pragma unroll
                    for (int p = 0; p < 2; ++p)
#pragma unroll
                        for (int hh = 0; hh < 2; ++hh) { const int off = (32 * p + 16 * hh + 4 * g4 + (c16 >> 2)) * 32 + 8 * (c16 & 3); kha[p][hh] = lds_tr16(Ct + CT_KHT + off); rha[p][hh] = lds_tr16(Ct + CT_RHT + off); }
                    const u32x2 gakk = *(const LAS u32x2*)(Gt + GT_AKK + c16 * 32 + 8 * g4), gtt = *(const LAS u32x2*)(Gt + GT_TT + c16 * 32 + 8 * g4);
                    const u32x2 gbb = *(const LAS u32x2*)(Gt + GT_BB + c16 * 32 + 8 * g4), gbk = *(const LAS u32x2*)(Gt + GT_BK + c16 * 32 + 8 * g4);
                    const u32x2 vt = *(const LAS u32x2*)(Ct + CT_VT + (16 * wid + c16) * 32 + 8 * g4);
                    u32x2 btt[4], ktt[4]; f32x4 we[4];
#pragma unroll
                    for (int mt = 0; mt < 4; ++mt) { btt[mt] = *(const LAS u32x2*)(Ct + CT_BTT + (16 * mt + c16) * 32 + 8 * g4); ktt[mt] = *(const LAS u32x2*)(Ct + CT_KTT + (16 * mt + c16) * 32 + 8 * g4);
                        we[mt] = *(const LAS f32x4*)(Ct + CT_WEND + (16 * mt + 4 * g4) * 4); }
                    f32x4 pt = {0.f, 0.f, 0.f, 0.f}, prt = pt;
#pragma unroll
                    for (int p = 0; p < 2; ++p) { const bf16x8 sb = mk8(cvtpk(ST[2 * p][0], ST[2 * p][1]), cvtpk(ST[2 * p][2], ST[2 * p][3]), cvtpk(ST[2 * p + 1][0], ST[2 * p + 1][1]), cvtpk(ST[2 * p + 1][2], ST[2 * p + 1][3]));
                        pt = __builtin_amdgcn_mfma_f32_16x16x32_bf16((bf16x8){kha[p][0][0], kha[p][0][1], kha[p][0][2], kha[p][0][3], kha[p][1][0], kha[p][1][1], kha[p][1][2], kha[p][1][3]}, sb, pt, 0, 0, 0);
                        prt = __builtin_amdgcn_mfma_f32_16x16x32_bf16((bf16x8){rha[p][0][0], rha[p][0][1], rha[p][0][2], rha[p][0][3], rha[p][1][0], rha[p][1][1], rha[p][1][2], rha[p][1][3]}, sb, prt, 0, 0, 0); }
                    const f32x4 qt = __builtin_amdgcn_mfma_f32_16x16x32_bf16(mk8(gakk.x, gakk.y, 0u, 0u), mk8(vt.x, vt.y, 0u, 0u), pt, 0, 0, 0);
                    const f32x4 sat = __builtin_amdgcn_mfma_f32_16x16x32_bf16(mk8(gtt.x, gtt.y, 0u, 0u), mk8(cvtpk(qt[0], qt[1]), cvtpk(qt[2], qt[3]), 0u, 0u), (f32x4){0.f, 0.f, 0.f, 0.f}, 0, 0, 0);
                    const bf16x8 sv = mk8(cvtpk(sat[0], sat[1]), cvtpk(sat[2], sat[3]), vt.x, vt.y);
                    const f32x4 outt = __builtin_amdgcn_mfma_f32_16x16x32_bf16(mk8(gbb.x, gbb.y, gbk.x, gbk.y), sv, prt, 0, 0, 0);
#pragma unroll
                    for (int mt = 0; mt < 4; ++mt) { ST[mt] = __builtin_amdgcn_mfma_f32_16x16x32_bf16(mk8(btt[mt].x, btt[mt].y, ktt[mt].x, ktt[mt].y), sv, ST[mt], 0, 0, 0); ST[mt] = ST[mt] * we[mt]; }
                    LAS float* ob = (LAS float*)(lds + SC_OUT + (c & 1) * 4096) + 16 * wid + c16;
#pragma unroll
                    for (int r = 0; r < 4; ++r) ob[(4 * g4 + r) * 64] = outt[r];
                }
                for (int rep_ = 0; rep_ < REP_ST; ++rep_)
                if (i >= 2 && i - 2 < NCH) {
                    const int jg = i - 2, hw = wid;
                    const LAS unsigned char* Ct = lds + SC_CT + (jg % 3) * CT_SLOT; LAS unsigned char* Gt = lds + SC_GT + (jg & 1) * GT_SLOT;
                    const int aoff = (hw & 1) ? CT_KTT : CT_BTT, boff = (hw & 2) ? CT_RHT : CT_KHT;
                    f32x4 gm = {0.f, 0.f, 0.f, 0.f}, gmT = gm;
#pragma unroll
                    for (int ks = 0; ks < 2; ++ks) { const int o1 = (8 * g4 + 32 * ks + (c16 >> 2)) * 32 + 8 * (c16 & 3), o2 = o1 + 4 * 32;
                        const v4i16_t a0 = lds_tr16(Ct + aoff + o1), a1 = lds_tr16(Ct + aoff + o2), b0 = lds_tr16(Ct + boff + o1), b1 = lds_tr16(Ct + boff + o2);
                        const bf16x8 af = {a0[0], a0[1], a0[2], a0[3], a1[0], a1[1], a1[2], a1[3]}, bfr = {b0[0], b0[1], b0[2], b0[3], b1[0], b1[1], b1[2], b1[3]};
                        gm = __builtin_amdgcn_mfma_f32_16x16x32_bf16(af, bfr, gm, 0, 0, 0);
                        if (hw == 0) gmT = __builtin_amdgcn_mfma_f32_16x16x32_bf16(bfr, af, gmT, 0, 0, 0); }
                    if (hw == 3) {
                        const bf16x8 onesB = __builtin_bit_cast(bf16x8, c16 == 0 ? (u32x4){0x3F803F80u, 0x3F803F80u, 0x3F803F80u, 0x3F803F80u} : (u32x4){0u, 0u, 0u, 0u});
                        f32x4 rk = {0.f, 0.f, 0.f, 0.f};
#pragma unroll
                        for (int ks = 0; ks < 2; ++ks) { const int o1 = (8 * g4 + 32 * ks + (c16 >> 2)) * 32 + 8 * (c16 & 3), o2 = o1 + 4 * 32;
                            const v4i16_t r0 = lds_tr16(Ct + CT_RKT + o1), r1 = lds_tr16(Ct + CT_RKT + o2);
                            rk = __builtin_amdgcn_mfma_f32_16x16x32_bf16((bf16x8){r0[0], r0[1], r0[2], r0[3], r1[0], r1[1], r1[2], r1[3]}, onesB, rk, 0, 0, 0); }
                        if (c16 == 0) ((LAS f32x4*)(lds + SC_RKR + (jg & 3) * 256))[g4] = rk; }
#pragma unroll
                    for (int r = 0; r < 4; ++r) { const int s = 4 * g4 + r; const bool keep = (hw & 2) ? (s <= c16) : (s < c16); gm[r] = keep ? gm[r] : 0.f; gmT[r] = (c16 < s) ? gmT[r] : 0.f; }
                    if (hw != 0) { *(LAS u32x2*)(Gt + (hw == 1 ? GT_AKK : (hw == 2 ? GT_BB : GT_BK)) + c16 * 32 + 8 * g4) = (u32x2){cvtpk(gm[0], gm[1]), cvtpk(gm[2], gm[3])}; }
                    else {
#define SC_OPA(x) mk8(cvtpk((x)[0], (x)[1]), cvtpk((x)[2], (x)[3]), 0u, 0u)
                        const f32x4 z4 = {0.f, 0.f, 0.f, 0.f};
                        f32x4 Rm, RTm;
#pragma unroll
                        for (int r = 0; r < 4; ++r) { const float idn = (4 * g4 + r == c16) ? 1.f : 0.f; Rm[r] = idn - gm[r]; RTm[r] = idn - gmT[r]; }
                        const f32x4 N2 = __builtin_amdgcn_mfma_f32_16x16x32_bf16(SC_OPA(gmT), SC_OPA(gm), z4, 0, 0, 0), N2T = __builtin_amdgcn_mfma_f32_16x16x32_bf16(SC_OPA(gm), SC_OPA(gmT), z4, 0, 0, 0);
                        f32x4 R1 = __builtin_amdgcn_mfma_f32_16x16x32_bf16(SC_OPA(RTm), SC_OPA(N2), Rm, 0, 0, 0), R1T = __builtin_amdgcn_mfma_f32_16x16x32_bf16(SC_OPA(N2), SC_OPA(RTm), RTm, 0, 0, 0);
                        const f32x4 N4 = __builtin_amdgcn_mfma_f32_16x16x32_bf16(SC_OPA(N2T), SC_OPA(N2), z4, 0, 0, 0), N4T = __builtin_amdgcn_mfma_f32_16x16x32_bf16(SC_OPA(N2), SC_OPA(N2T), z4, 0, 0, 0);
                        f32x4 R2 = __builtin_amdgcn_mfma_f32_16x16x32_bf16(SC_OPA(R1T), SC_OPA(N4), R1, 0, 0, 0), R2T = __builtin_amdgcn_mfma_f32_16x16x32_bf16(SC_OPA(N4), SC_OPA(R1T), R1T, 0, 0, 0);
                        const f32x4 N8 = __builtin_amdgcn_mfma_f32_16x16x32_bf16(SC_OPA(N4T), SC_OPA(N4), z4, 0, 0, 0);
                        const f32x4 Tm = __builtin_amdgcn_mfma_f32_16x16x32_bf16(SC_OPA(R2T), SC_OPA(N8), R2, 0, 0, 0);
#undef SC_OPA
                        *(LAS u32x2*)(Gt + GT_TT + c16 * 32 + 8 * g4) = (u32x2){cvtpk(-Tm[0], -Tm[1]), cvtpk(-Tm[2], -Tm[3])};
                    }
                }
                if ((wid == 1 || wid == 2) && i >= 4 && i - 4 < NCH) {
                    const int jp = i - 4, tl = ln >> 3, c8 = ln & 7;
                    const int s = 8 * (wid - 1) + tl, t = d ? (SEQ - 1 - (jp * 16 + s)) : (jp * 16 + s);
                    const LAS float* ob = (const LAS float*)(lds + SC_OUT + (jp & 1) * 4096) + s * 64 + 8 * c8; const LAS float* gp = (const LAS float*)(lds + SC_GG + (jp & 3) * 4096) + s * 64 + 8 * c8;
                    const f32x4 o0 = *(const LAS f32x4*)(ob), o1 = *(const LAS f32x4*)(ob + 4), g0 = *(const LAS f32x4*)(gp), g1 = *(const LAS f32x4*)(gp + 4);
                    const float rkr = ((const LAS float*)(lds + SC_RKR + (jp & 3) * 256))[s];
                    const u32x4 pv = pvset;
                    const f32x4 v0 = {bflo(pv.x), bfhi(pv.x), bflo(pv.y), bfhi(pv.y)}, v1 = {bflo(pv.z), bfhi(pv.z), bflo(pv.w), bfhi(pv.w)};
                    float mu = ((o0[0] + o0[1]) + (o0[2] + o0[3])) + ((o1[0] + o1[1]) + (o1[2] + o1[3])); mu = sum8(mu) * (1.f / 64.f);
                    const f32x4 d0 = o0 - mu, d1 = o1 - mu; float var = ((d0[0] * d0[0] + d0[1] * d0[1]) + (d0[2] * d0[2] + d0[3] * d0[3])) + ((d1[0] * d1[0] + d1[1] * d1[1]) + (d1[2] * d1[2] + d1[3] * d1[3])); var = sum8(var) * (1.f / 64.f);
                    const float rs = rsqrtf(var + GN_EPS);
                    const f32x4 y0 = (d0 * rs * gw0 + gb0 + rkr * v0) * g0, y1 = (d1 * rs * gw1 + gb1 + rkr * v1) * g1;
                    pg8::store16_wt(P.Y + ((size_t)b * SEQ + t) * (2 * D) + d * D + hc + 8 * c8, (u32x4){cvtpk(y0[0], y0[1]), cvtpk(y0[2], y0[3]), cvtpk(y1[0], y1[1]), cvtpk(y1[2], y1[3])});
                    issueV(jp + 2 < NCH ? jp + 2 : NCH - 1, pvset);
                }
                for (int rep_ = 0; rep_ < REP_SYNC; ++rep_) __syncthreads();
                if (WAITPROBE >= 0) { const unsigned long long t0_ = __builtin_amdgcn_s_memrealtime(); __syncthreads(); wait_acc += __builtin_amdgcn_s_memrealtime() - t0_; } else
                __syncthreads();
            };
            static_assert((NCH + 4) % 2 == 0, "interval loop is unrolled by two");
            __builtin_amdgcn_s_setprio(2);
            for (int i = 0; i < NCH + 4; i += 2) { sw_interval(i, pvA); sw_interval(i + 1, pvB); }
            __builtin_amdgcn_s_setprio(0);
        } else {
            const int hw = wid - 4;
            const int chC = hc + 16 * hw + c16, chT = hc + 4 * c16;
            bf16x8 bw[2], ba[2], bg[4];
#pragma unroll
            for (int ks = 0; ks < 2; ++ks) { u32x4 w, a;
#pragma unroll
                for (int jj = 0; jj < 4; ++jj) { const int k = 32 * ks + 8 * g4 + 2 * jj;
                    w[jj] = pk2(-LOG2E * P.w2[(size_t)(d * 64 + k) * D + chC], -LOG2E * P.w2[(size_t)(d * 64 + k + 1) * D + chC]); a[jj] = pk2(-LOG2E * P.a2[(size_t)(d * 64 + k) * D + chC], -LOG2E * P.a2[(size_t)(d * 64 + k + 1) * D + chC]); }
                bw[ks] = __builtin_bit_cast(bf16x8, w); ba[ks] = __builtin_bit_cast(bf16x8, a); }
#pragma unroll
            for (int ks = 0; ks < 4; ++ks) { u32x4 g;
#pragma unroll
                for (int jj = 0; jj < 4; ++jj) { const int k = 32 * ks + 8 * g4 + 2 * jj; g[jj] = pk2(P.g2[(size_t)(d * 128 + k) * D + chC], P.g2[(size_t)(d * 128 + k + 1) * D + chC]); }
                bg[ks] = __builtin_bit_cast(bf16x8, g); }
            const float w0c = -LOG2E * P.w0[d * D + chC], a0c = -LOG2E * P.a0[d * D + chC], kaC = P.k_a[chC], rkC = P.r_k[chC];
            const f32x4 kkT = *(const f32x4*)(P.k_k + chT);
            const int n0 = 16 * c16, lcol = n0 < 64 ? (d * 64 + n0) : (n0 < 128 ? (128 + d * 64 + (n0 - 64)) : (256 + d * 128 + (n0 - 128)));
            struct LSet { u32x2 r, k, v; u32x4 l0, l1; };
            LSet setA, setB;
            auto issueL = [&](int ch_, LSet& S) { const int s = 4 * hw + g4, t = d ? (SEQ - 1 - (ch_ * 16 + s)) : (ch_ * 16 + s); const size_t row = (size_t)b * SEQ + t;
                asm volatile("global_load_dwordx2 %0, %1, off" : "=v"(S.r) : "v"(P.R + row * D + chT) : "memory");
                asm volatile("global_load_dwordx2 %0, %1, off" : "=v"(S.k) : "v"(P.Kk + row * D + chT) : "memory");
                asm volatile("global_load_dwordx2 %0, %1, off" : "=v"(S.v) : "v"(P.V + row * D + chT) : "memory");
                asm volatile("global_load_dwordx4 %0, %1, off" : "=v"(S.l0) : "v"(P.LDA + row * 512 + lcol) : "memory");
                asm volatile("global_load_dwordx4 %0, %1, off" : "=v"(S.l1) : "v"(P.LDA + row * 512 + lcol + 8) : "memory"); };
            issueL(0, setA); issueL(1, setB);
            auto hw_interval = [&](int i, LSet& LS) {
                const bool doL = i < NCH, doC = (i >= 1 && i - 1 < NCH);
                int ln = lane; asm volatile("" : "+v"(ln)); const int g4 = ln >> 4, c16 = ln & 15;
                const unsigned long long tb_ = (SECPROBE >= 0) ? __builtin_amdgcn_s_memrealtime() : 0ull;
                for (int rep_ = 0; rep_ < REP_HC; ++rep_)
                if (doC) {
                    const int jc = i - 1;
                    const LAS unsigned char* Ls = lds + SC_LBUF + (jc & 1) * SC_LSLOT;
                    const LAS unsigned char* ldp = Ls + 4 * 16 * SC_LROW * 4 + c16 * SC_LDROW + 16 * g4;
                    f32x4 zw = {w0c, w0c, w0c, w0c}, za = {a0c, a0c, a0c, a0c}, gg = {0.f, 0.f, 0.f, 0.f};
#pragma unroll
                    for (int ks = 0; ks < 2; ++ks) { zw = __builtin_amdgcn_mfma_f32_16x16x32_bf16(*(const LAS bf16x8*)(ldp + 64 * ks), bw[ks], zw, 0, 0, 0);
                                                     za = __builtin_amdgcn_mfma_f32_16x16x32_bf16(*(const LAS bf16x8*)(ldp + 128 + 64 * ks), ba[ks], za, 0, 0, 0); }
#pragma unroll
                    for (int ks = 0; ks < 4; ++ks) gg = __builtin_amdgcn_mfma_f32_16x16x32_bf16(*(const LAS bf16x8*)(ldp + 256 + 64 * ks), bg[ks], gg, 0, 0, 0);
                    float lw[4], cw[4]; float tot = 0.f;
#pragma unroll
                    for (int r = 0; r < 4; ++r) { lw[r] = (-0.6065306597f * LOG2E) * __builtin_amdgcn_rcpf(1.f + __builtin_amdgcn_exp2f(zw[r])); tot += lw[r]; cw[r] = tot; }
                    float pre;
                    { auto e = __builtin_amdgcn_permlane16_swap(__float_as_uint(tot), __float_as_uint(tot), false, false); const float e0 = __uint_as_float(e[0]), s01 = e0 + __uint_as_float(e[1]);
                      auto f = __builtin_amdgcn_permlane32_swap(__float_as_uint(s01), __float_as_uint(s01), false, false);
                      pre = ((g4 & 1) ? e0 : 0.f) + ((g4 & 2) ? __uint_as_float(f[0]) : 0.f); }
                    const LAS float* Lf = (const LAS float*)Ls + 16 * hw + c16;
                    LAS unsigned char* Ct = lds + SC_CT + (jc % 3) * CT_SLOT;
                    LAS float* ggw = (LAS float*)(lds + SC_GG + (jc & 3) * 4096) + 16 * hw + c16;
                    float kh[4], rh[4], bt[4], kt[4], vv[4], rkp[4];
                    float Wprev = __builtin_amdgcn_exp2f(pre);
#pragma unroll
                    for (int r = 0; r < 4; ++r) { const int tok = 4 * g4 + r; const float c = pre + cw[r];
                        const float Wc = __builtin_amdgcn_exp2f(c), Wp = Wprev, iW = __builtin_amdgcn_exp2f(-c); Wprev = Wc;
                        const float a = __builtin_amdgcn_rcpf(1.f + __builtin_amdgcn_exp2f(za[r]));
                        const float rr = Lf[tok * SC_LROW], kk_ = Lf[16 * SC_LROW + tok * SC_LROW], nk = Lf[32 * SC_LROW + tok * SC_LROW]; vv[r] = Lf[48 * SC_LROW + tok * SC_LROW];
                        const float kd = kk_ * (1.f + (a - 1.f) * kaC);
                        kh[r] = nk * Wp; rh[r] = rr * Wc; bt[r] = nk * a * iW; kt[r] = kd * iW; rkp[r] = rr * kd * rkC;
                        ggw[tok * 64] = gg[r];
                        if (tok == 15) ((LAS float*)(Ct + CT_WEND))[16 * hw + c16] = Wc; }
                    { LAS unsigned char* tq = Ct + (16 * hw + c16) * 32 + 8 * g4;
                      *(LAS u32x2*)(tq + CT_KHT) = (u32x2){cvtpk(kh[0], kh[1]), cvtpk(kh[2], kh[3])}; *(LAS u32x2*)(tq + CT_RHT) = (u32x2){cvtpk(rh[0], rh[1]), cvtpk(rh[2], rh[3])};
                      *(LAS u32x2*)(tq + CT_BTT) = (u32x2){cvtpk(bt[0], bt[1]), cvtpk(bt[2], bt[3])}; *(LAS u32x2*)(tq + CT_KTT) = (u32x2){cvtpk(kt[0], kt[1]), cvtpk(kt[2], kt[3])};
                      *(LAS u32x2*)(tq + CT_VT) = (u32x2){cvtpk(vv[0], vv[1]), cvtpk(vv[2], vv[3])};
                      *(LAS u32x2*)(tq + CT_RKT) = (u32x2){cvtpk(rkp[0], rkp[1]), cvtpk(rkp[2], rkp[3])}; }
                }
                const unsigned long long tc_ = (SECPROBE >= 0) ? __builtin_amdgcn_s_memrealtime() : 0ull;
                for (int rep_ = 0; rep_ < REP_HL; ++rep_)
                if (doL) {
                    LAS unsigned char* Ls = lds + SC_LBUF + (i & 1) * SC_LSLOT; LAS float* Lf = (LAS float*)Ls;
                    const int s = 4 * hw + g4;
                    asm volatile("s_waitcnt vmcnt(5)" : "+v"(LS.r), "+v"(LS.k), "+v"(LS.v), "+v"(LS.l0), "+v"(LS.l1));
                    const u32x2 lr = LS.r, lk = LS.k, lv = LS.v; const u32x4 l00 = LS.l0, l01 = LS.l1;
                    const f32x4 rr = {bflo(lr.x), bfhi(lr.x), bflo(lr.y), bfhi(lr.y)}, kk_ = {bflo(lk.x), bfhi(lk.x), bflo(lk.y), bfhi(lk.y)}, vv = {bflo(lv.x), bfhi(lv.x), bflo(lv.y), bfhi(lv.y)};
                    f32x4 nk = kk_ * kkT; float ss = nk[0] * nk[0] + nk[1] * nk[1] + nk[2] * nk[2] + nk[3] * nk[3];
                    ss = sum16(ss);
                    nk = nk * __builtin_amdgcn_rsqf(fmaxf(ss, 1e-24f));
                    *(LAS f32x4*)(Lf + s * SC_LROW + 4 * c16) = rr; *(LAS f32x4*)(Lf + 16 * SC_LROW + s * SC_LROW + 4 * c16) = kk_;
                    *(LAS f32x4*)(Lf + 32 * SC_LROW + s * SC_LROW + 4 * c16) = nk; *(LAS f32x4*)(Lf + 48 * SC_LROW + s * SC_LROW + 4 * c16) = vv;
                    *(LAS u32x4*)(Ls + 4 * 16 * SC_LROW * 4 + s * SC_LDROW + 32 * c16) = l00; *(LAS u32x4*)(Ls + 4 * 16 * SC_LROW * 4 + s * SC_LDROW + 32 * c16 + 16) = l01;
                    issueL(i + 2 < NCH ? i + 2 : NCH - 1, LS);
                }
                for (int rep_ = 0; rep_ < REP_SYNC; ++rep_) __syncthreads();
                if (SECPROBE >= 0) { asm volatile("s_waitcnt vmcnt(0) lgkmcnt(0)" ::: "memory"); const unsigned long long te_ = __builtin_amdgcn_s_memrealtime(); wait_acc += (SECPROBE == 0) ? (tc_ - tb_) : ((SECPROBE == 1) ? (te_ - tc_) : (te_ - tb_)); __syncthreads(); } else
                if (WAITPROBE >= 0) { const unsigned long long t0_ = __builtin_amdgcn_s_memrealtime(); __syncthreads(); wait_acc += __builtin_amdgcn_s_memrealtime() - t0_; } else
                __syncthreads();
            };
            for (int i = 0; i < NCH + 4; i += 2) { hw_interval(i, setA); hw_interval(i + 1, setB); }
        }
        if ((WAITPROBE >= 0 || SECPROBE >= 0) && blockIdx.x == 0 && wid == (SECPROBE >= 0 ? 4 : WAITPROBE)) { const unsigned long long tgt_ = __builtin_amdgcn_s_memrealtime() + 4ull * wait_acc; while (__builtin_amdgcn_s_memrealtime() < tgt_) __builtin_amdgcn_s_sleep(8); }
    }
}

__global__ void __launch_bounds__(NTHREADS, 2) fwd_megakernel(Args args) {
    extern __shared__ __attribute__((aligned(16))) unsigned char lds_raw[];
    LAS unsigned char* lds = (LAS unsigned char*)lds_raw;
    volatile LAS unsigned* MISC = (volatile LAS unsigned*)(lds + MISC_OFF);
    const int tid0 = threadIdx.x, wave = __builtin_amdgcn_readfirstlane(tid0 >> 6);
#define FRESH_LANE() int tid = tid0; asm volatile("" : "+v"(tid)); const int lane = tid & 63; (void)lane
    const int G = gridDim.x;
    const int vcu = (G % 8 == 0) ? ((int)blockIdx.x % 8) * (G / 8) + (int)blockIdx.x / 8 : (int)blockIdx.x;
    const int gw = vcu * NWAVES + wave, NGW = G * NWAVES;
    unsigned char* ws = args.ws;
    unsigned* ctl = (unsigned*)(ws + WS_CTL);
    for (int u = tid0; u < (LDS_BYTES - LDSCTL_OFF) / 4; u += NTHREADS) ((LAS unsigned*)(lds + LDSCTL_OFF))[u] = 0u;
    __syncthreads();
    XcdBarrier bar = xcd_barrier_post(ctl + CW_BAR, MISC + 8);
    unsigned long long ts_a = 0ull; int ts_n = 0;
#define STAMP() do { if (TS_A >= 0) { const unsigned long long t_ = __builtin_amdgcn_s_memrealtime(); if (ts_n == TS_A) ts_a = t_; \
    if (ts_n == TS_B && blockIdx.x == 0) { const unsigned long long tgt_ = t_ + 4ull * (t_ - ts_a); while (__builtin_amdgcn_s_memrealtime() < tgt_) __builtin_amdgcn_s_sleep(8); } ++ts_n; } } while (0)
#define GRID_BAR() do { xcd_barrier(bar); STAMP(); } while (0)
    STAMP();

    const float* x = args.in[0]; const float* rel_table = args.in[1]; const float* norm_g = args.in[2]; const float* attn_w_in = args.in[3]; const float* attn_sink = args.in[4];
    const float* attn_w_out = args.in[5]; const float* mu_prev = args.in[6]; const float* mu_next = args.in[7]; const float* w_r = args.in[8]; const float* w_k = args.in[9];
    const float* w_v = args.in[10]; const float* w_o = args.in[11]; const float* mlp_w1 = args.in[25]; const float* mlp_w2 = args.in[26];
    bf16_t* HBa = (bf16_t*)args.out; bf16_t* HBb = HBa + (size_t)M * D; bf16_t* HBc = (bf16_t*)(ws + WS_HBC); bf16_t* TMP2 = (bf16_t*)(ws + WS_TMP2);
    bf16_t* XN = (bf16_t*)(ws + WS_XN); bf16_t* QKV = (bf16_t*)(ws + WS_QKV); bf16_t* Ob = (bf16_t*)(ws + WS_O); bf16_t* TMP = (bf16_t*)(ws + WS_TMP); bf16_t* Hb = (bf16_t*)(ws + WS_H);
    bf16_t* MIXA = (bf16_t*)(ws + WS_MIXA); bf16_t* MIXB = (bf16_t*)(ws + WS_MIXB); bf16_t* Rb = (bf16_t*)(ws + WS_R); bf16_t* Kb = (bf16_t*)(ws + WS_K); bf16_t* Vb = (bf16_t*)(ws + WS_V);
    bf16_t* LDO = (bf16_t*)(ws + WS_LDO); bf16_t* Yb = (bf16_t*)(ws + WS_Y);
    LAS float* scr = (LAS float*)(lds + wave * TR_SCR_BYTES);
    unsigned grp_ep = 0u;
    float* RS = (float*)(ws + WS_CTL + 128 * 1024);

    {
        FRESH_LANE();
        constexpr int I_IN = (D / 64) * (DIN / 64), I_OUT = (D / 64) * (D / 64), I_1 = (D / 64) * (DFF / 64), I_2 = (DFF / 64) * (D / 64);
        const bool tail = (G == 256);
        for (int it = gw; it < (tail ? I_IN : I_IN + I_OUT + I_1 + I_2); it += NGW) { int r = it;
            if (r < I_IN) { transpose_item(attn_w_in, DIN, DIN, (bf16_t*)(ws + WS_WIN_T), D, 0, 0, scr, r, lane, ScaleOne{}); continue; } r -= I_IN;
            if (r < I_OUT) { transpose_item(attn_w_out, D, D, (bf16_t*)(ws + WS_WOUT_T), D, 0, 0, scr, r, lane, ScaleOne{}); continue; } r -= I_OUT;
            if (r < I_1) { transpose_item(mlp_w1, DFF, DFF, (bf16_t*)(ws + WS_W1_T), D, 0, 0, scr, r, lane, ScaleVec{norm_g + 2 * D}); continue; } r -= I_1;
            transpose_item(mlp_w2, D, D, (bf16_t*)(ws + WS_W2_T), DFF, 0, 0, scr, r, lane, ScaleOne{}); }
        if (G == 256) {
            const unsigned sb = __float_as_uint(-1.f); const u32x4 sv = {sb, sb, sb, sb};
            for (int i = (int)blockIdx.x * NTHREADS + tid; i < N_XREG * (int)(XREG_BYTES / 16); i += G * NTHREADS) { const int r = i / (int)(XREG_BYTES / 16), o = i % (int)(XREG_BYTES / 16);
                pg8::store16_wt(ws + ws_xreg(r) + (size_t)o * 16, sv); } }
        const int rlim = (tail && gw < I_IN) ? M - NGW : M;
        for (int row = gw; row < rlim; row += NGW) { Row16 r; row_load_f32(r, x + (size_t)row * D, lane); row_rmsnorm(r, norm_g, lane); row_store_bf16(r, XN + (size_t)row * D, lane); }
        if (tail && gw >= I_IN && gw < 2 * I_IN) { const int row = (M - NGW) + (gw - I_IN); Row16 r; row_load_f32(r, x + (size_t)row * D, lane); row_rmsnorm(r, norm_g, lane); row_store_bf16(r, XN + (size_t)row * D, lane); }
    }
    GRID_BAR();
    { pg8::StaticOrder S; S.init(M, DIN, G, (int)blockIdx.x); const EpiHeadMajor E{QKV};
      for (int rep = 0; rep < REP_GEMM; ++rep) pg8::gemm_phase<EpiHeadMajor, ProbPlain, true, true>(lds, ProbPlain{XN, (const bf16_t*)(ws + WS_WIN_T), D}, S, E); }
    if (G == 256 && blockIdx.x >= 64) {
        FRESH_LANE();
        constexpr int I_OUT = (D / 64) * (D / 64), I_1 = (D / 64) * (DFF / 64), I_2 = (DFF / 64) * (D / 64);
        for (int it = ((int)blockIdx.x - 64) * NWAVES + wave; it < I_OUT + I_1 + I_2; it += 192 * NWAVES) { int r = it;
            if (r < I_OUT) { transpose_item(attn_w_out, D, D, (bf16_t*)(ws + WS_WOUT_T), D, 0, 0, scr, r, lane, ScaleOne{}); continue; } r -= I_OUT;
            if (r < I_1) { transpose_item(mlp_w1, DFF, DFF, (bf16_t*)(ws + WS_W1_T), D, 0, 0, scr, r, lane, ScaleVec{norm_g + 2 * D}); continue; } r -= I_1;
            transpose_item(mlp_w2, D, D, (bf16_t*)(ws + WS_W2_T), DFF, 0, 0, scr, r, lane, ScaleOne{}); }
    }
    GRID_BAR();
    { const AttnIO io{QKV, rel_table, attn_sink, Ob, (bf16_t*)(ws + WS_OBR), (float*)(ws + WS_LSE)};
      for (int rep = 0; rep < REP_ATT; ++rep) phase_attn(lds, io, vcu, G);
      GRID_BAR();
      { FRESH_LANE();
        if (G == 256) { const int grow0 = 256 * (8 * ((int)blockIdx.x % 8) + ((int)blockIdx.x / 8) % 8) + 64 * ((int)blockIdx.x / 64);
            phase_attn_merge(io, grow0 * 64 + tid, (grow0 + 64) * 64, NTHREADS);
            grp_barrier_tgt(ctl + CW_BAR, (unsigned)blockIdx.x % 64u, 4u * (++grp_ep)); }
        else { phase_attn_merge(io, vcu * NTHREADS + tid, M * 64, G * NTHREADS); GRID_BAR(); } } }
    for (int rep = 0; rep < REP_BAR; ++rep) GRID_BAR();
    if (G == 256) {
        pg8::StaticOrder S; S.init(M, D, G, (int)blockIdx.x);
        const EpiResNorm<true, true> E{x, HBa, norm_g + D, RS, ws, ctl + CW_BAR, lds, 0};
        pg8::gemm_phase<EpiResNorm<true, true>, ProbPlain, true, true>(lds, ProbPlain{Ob, (const bf16_t*)(ws + WS_WOUT_T), D}, S, E);
    } else {
        run_gemm<0>(lds, ProbPlain{Ob, (const bf16_t*)(ws + WS_WOUT_T), D}, DstPlain{TMP, D}, M, D, G);
        GRID_BAR();
        { FRESH_LANE(); phase_resnorm<true, false>(x, TMP, norm_g + D, nullptr, HBa, nullptr, RS, gw, NGW, lane); }
    }
    GRID_BAR();
    run_gemm_rs<1>(lds, ProbPlain{HBa, (const bf16_t*)(ws + WS_W1_T), D}, DstPlain{Hb, DFF}, RS, M, DFF, G);
    GRID_BAR();
    if (G == 256) {
        pg8::StaticOrder S; S.init(M, D, G, (int)blockIdx.x);
        const EpiResNorm<false, false> E{HBa, HBb, norm_g + 3 * D, nullptr, ws, ctl + CW_BAR, lds, 2};
        pg8::gemm_phase<EpiResNorm<false, false>, ProbPlain, true, true>(lds, ProbPlain{Hb, (const bf16_t*)(ws + WS_W2_T), DFF}, S, E);
    } else {
        run_gemm<0>(lds, ProbPlain{Hb, (const bf16_t*)(ws + WS_W2_T), DFF}, DstPlain{TMP, D}, M, D, G);
        GRID_BAR();
        { FRESH_LANE(); phase_resnorm<false, false>(HBa, TMP, norm_g + 3 * D, nullptr, HBb, nullptr, nullptr, gw, NGW, lane); }
    }
    GRID_BAR();
    {
        FRESH_LANE();
        const float* g1n = norm_g + 4 * D;
        constexpr int I_SQ = (D / 64) * (D / 64), I_1 = (D / 64) * (DFF / 64), I_2 = (DFF / 64) * (D / 64), I_LD = 384;
        const bool tail = (G == 256);
        for (int it = gw; it < (tail ? 3 * I_SQ + I_2 + I_LD : 4 * I_SQ + I_1 + I_2 + I_LD); it += NGW) { int r = it;
            if (r < I_SQ) { transpose_item(w_r, D, D, (bf16_t*)(ws + WS_WR_T), D, 0, 0, scr, r, lane, ScaleOne{}); continue; } r -= I_SQ;
            if (r < I_SQ) { transpose_item(w_k, D, D, (bf16_t*)(ws + WS_WK_T), D, 0, 0, scr, r, lane, ScaleOne{}); continue; } r -= I_SQ;
            if (r < I_SQ) { transpose_item(w_v, D, D, (bf16_t*)(ws + WS_WV_T), D, 0, 0, scr, r, lane, ScaleOne{}); continue; } r -= I_SQ;
            if (!tail) {
                if (r < I_SQ) { transpose_item(w_o, D, D, (bf16_t*)(ws + WS_WO2_T), D, 0, 0, scr, r, lane, ScaleOne{}); continue; } r -= I_SQ;
                if (r < I_1) { transpose_item(mlp_w1 + (size_t)D * DFF, DFF, DFF, (bf16_t*)(ws + WS_W1B_T), D, 0, 0, scr, r, lane, ScaleVec{norm_g + 6 * D}); continue; } r -= I_1; }
            if (r < I_2) { transpose_item(mlp_w2 + (size_t)DFF * D, D, D, (bf16_t*)(ws + WS_W2B_T), DFF, 0, 0, scr, r, lane, ScaleOne{}); continue; } r -= I_2;
            const int part = r / 128; int q = r % 128; int sub, li;
            if (q < 64) { sub = q / 16; li = q % 16; } else { sub = 4 + (q - 64) / 32; li = (q - 64) % 32; }
            const int dd = sub & 1, kind = sub >> 1;
            const int stream = kind == 0 ? 1 : (kind == 1 ? 4 : 5), Nn = kind == 2 ? 128 : 64;
            const float* src = kind == 0 ? args.in[18] + (size_t)dd * D * 64 : (kind == 1 ? args.in[21] + (size_t)dd * D * 64 : args.in[23] + (size_t)dd * D * 128);
            const int coloff = kind == 0 ? dd * 64 : (kind == 1 ? 128 + dd * 64 : 256 + dd * 128);
            transpose_item(src, Nn, Nn, (bf16_t*)(ws + WS_LDW_T), D, part * 512 + coloff, 0, scr, li, lane, ScaleMix{mu_prev + stream * D, mu_next + stream * D, part}); }
        phase_mix3(lds, HBb, g1n, mu_prev, mu_next, XN, MIXA, MIXB, HBa, gw, NGW, tid, lane);
    }
    GRID_BAR();
    if (G == 256) {
        run_gemm<0>(lds, ProbRKL{ws, D, 2}, DstRKL{ws, 2}, M, 12 * 256, G);
        GRID_BAR();
        run_gemm<0>(lds, ProbVR{HBa, MIXA, (const bf16_t*)(ws + WS_WV_T), (const bf16_t*)(ws + WS_WR_T), D}, DstVR{Vb, Rb}, M, 6 * 256, G);
        if (blockIdx.x >= 128) {
            FRESH_LANE();
            phase_lda(LDO, (bf16_t*)(ws + WS_LDA), ((int)blockIdx.x - 128) * NWAVES + wave, 128 * NWAVES, lane);
            constexpr int I_SQ = (D / 64) * (D / 64), I_1 = (D / 64) * (DFF / 64);
            for (int it = ((int)blockIdx.x - 128) * NWAVES + wave; it < I_SQ + I_1; it += 128 * NWAVES) { int r = it;
                if (r < I_SQ) { transpose_item(w_o, D, D, (bf16_t*)(ws + WS_WO2_T), D, 0, 0, scr, r, lane, ScaleOne{}); continue; } r -= I_SQ;
                transpose_item(mlp_w1 + (size_t)D * DFF, DFF, DFF, (bf16_t*)(ws + WS_W1B_T), D, 0, 0, scr, r, lane, ScaleVec{norm_g + 6 * D}); }
        }
    } else {
        run_gemm<0>(lds, ProbRKL{ws, D, 0}, DstRKL{ws, 0}, M, 14 * 256, G);
        GRID_BAR();
        { FRESH_LANE(); phase_lda(LDO, (bf16_t*)(ws + WS_LDA), gw, NGW, lane); }
        run_gemm<0>(lds, ProbPlain{HBa, (const bf16_t*)(ws + WS_WV_T), D}, DstPlain{Vb, D}, M, D, G);
    }
    GRID_BAR();
    { ScanPtrs sp{Rb, Kb, Vb, (const bf16_t*)(ws + WS_LDA), Yb, args.in[19], args.in[22], args.in[24], args.in[17], args.in[20], args.in[12], args.in[13], args.in[14], args.in[15], args.in[16]};
      for (int rep = 0; rep < REP_SCAN; ++rep) phase_scan(lds, sp, G); }
    GRID_BAR();
    { FRESH_LANE();
      bf16_t* Ys = (bf16_t*)(ws + WS_YSUM);
      const bool grp_on = (G == 256);
      const int grow0 = 256 * (8 * ((int)blockIdx.x % 8) + ((int)blockIdx.x / 8) % 8) + 64 * ((int)blockIdx.x / 64);
      const int rfirst = grp_on ? grow0 + wave : gw, rend = grp_on ? grow0 + 64 : M, rstride = grp_on ? NWAVES : NGW;
      for (int row = rfirst; row < rend; row += rstride) {
          const u32x4* y0 = (const u32x4*)(Yb + (size_t)row * 2 * D); const u32x4* y1 = (const u32x4*)(Yb + (size_t)row * 2 * D + D);
#pragma unroll
          for (int hb = 0; hb < 2; ++hb) { const u32x4 a = y0[lane + 64 * hb], c = y1[lane + 64 * hb]; u32x4 o;
              o.x = cvtpk(bflo(a.x) + bflo(c.x), bfhi(a.x) + bfhi(c.x)); o.y = cvtpk(bflo(a.y) + bflo(c.y), bfhi(a.y) + bfhi(c.y));
              o.z = cvtpk(bflo(a.z) + bflo(c.z), bfhi(a.z) + bfhi(c.z)); o.w = cvtpk(bflo(a.w) + bflo(c.w), bfhi(a.w) + bfhi(c.w));
              pg8::store16_wt((u32x4*)(Ys + (size_t)row * D) + lane + 64 * hb, o); } }
      if (grp_on) grp_barrier_tgt(ctl + CW_BAR, (unsigned)blockIdx.x % 64u, 4u * (++grp_ep)); else GRID_BAR();
      if (grp_on) {
          pg8::StaticOrder S; S.init(M, D, G, (int)blockIdx.x);
          const EpiResNorm<false, true> E{HBb, HBc, norm_g + 5 * D, RS, ws, ctl + CW_BAR, lds, 3};
          pg8::gemm_phase<EpiResNorm<false, true>, ProbPlain, true, true>(lds, ProbPlain{Ys, (const bf16_t*)(ws + WS_WO2_T), D}, S, E);
      } else {
          run_gemm<0>(lds, ProbPlain{Ys, (const bf16_t*)(ws + WS_WO2_T), D}, DstPlain{TMP2, D}, M, D, G);
          GRID_BAR();
          { FRESH_LANE(); phase_resnorm<false, false>(HBb, TMP2, norm_g + 5 * D, nullptr, HBc, nullptr, RS, gw, NGW, lane); }
      } }
    GRID_BAR();
    run_gemm_rs<1>(lds, ProbPlain{HBc, (const bf16_t*)(ws + WS_W1B_T), D}, DstPlain{Hb, DFF}, RS, M, DFF, G);
    GRID_BAR();
    if (G == 256) {
        pg8::StaticOrder S; S.init(M, D, G, (int)blockIdx.x);
        const EpiResNorm<false, false, true> E{HBc, args.out, norm_g + 7 * D, nullptr, ws, ctl + CW_BAR, lds, 5};
        pg8::gemm_phase<EpiResNorm<false, false, true>, ProbPlain, true, true>(lds, ProbPlain{Hb, (const bf16_t*)(ws + WS_W2B_T), DFF}, S, E);
    } else {
        run_gemm<0>(lds, ProbPlain{Hb, (const bf16_t*)(ws + WS_W2B_T), DFF}, DstPlain{TMP2, D}, M, D, G);
        GRID_BAR();
        { FRESH_LANE(); phase_resnorm<false, true>(HBc, TMP2, norm_g + 7 * D, nullptr, args.out, nullptr, nullptr, gw, NGW, lane); }
    }
    if (TS_A >= 0) { GRID_BAR(); }
#undef GRID_BAR
}

extern "C" void kernel_launch(void* const* d_in, const int* in_sizes, int n_in, void* d_out, int out_size, void* d_ws, size_t ws_size, hipStream_t stream) {
    static int grid = 0;
    if (grid == 0) {
        if (n_in != 27 || in_sizes[0] != M * D || out_size != M * D || ws_size < WS_END) { fprintf(stderr, "kernel_launch: unexpected shapes (n_in %d, in0 %d, out %d, ws %zu)\n", n_in, n_in > 0 ? in_sizes[0] : -1, out_size, ws_size); grid = -1; return; }
        int dev = 0, cus = 0, per_cu = 0;
        if (hipGetDevice(&dev) != hipSuccess || hipDeviceGetAttribute(&cus, hipDeviceAttributeMultiprocessorCount, dev) != hipSuccess) { grid = -1; return; }
        if (hipFuncSetAttribute((const void*)fwd_megakernel, hipFuncAttributeMaxDynamicSharedMemorySize, LDS_BYTES) != hipSuccess) { fprintf(stderr, "kernel_launch: hipFuncSetAttribute failed\n"); grid = -1; return; }
        if (hipOccupancyMaxActiveBlocksPerMultiprocessor(&per_cu, (const void*)fwd_megakernel, NTHREADS, LDS_BYTES) != hipSuccess || per_cu < 1) { fprintf(stderr, "kernel_launch: occupancy query says %d blocks/CU\n", per_cu); (void)hipGetLastError(); grid = -1; return; }
        grid = cus;
    }
    if (grid < 0) return;
    (void)hipMemsetAsync((char*)d_ws + WS_CTL, 0, CTL_ZERO_BYTES, stream);
    Args a{};
    for (int i = 0; i < 27; ++i) a.in[i] = (const float*)d_in[i];
    a.out = (float*)d_out; a.ws = (unsigned char*)d_ws;
    hipLaunchKernelGGL(fwd_megakernel, dim3(grid), dim3(NTHREADS), LDS_BYTES, stream, a);
}
```
